# Optimizing an MI355X kernel written in HIP

```python
import math
import jax, jax.numpy as jnp
from jax import lax
import numpy as np

D_MODEL = 1024
BATCH = 4
SEQ = 4096
DEPTH = 4

N_EVEN = (DEPTH + 1) // 2
N_ODD = DEPTH // 2
CHUNK = 128
EPS = 1e-6
F32 = jnp.float32

RET_HEADS = 4
RET_DK = 256
RET_DV = 256
RET_QK = RET_HEADS * RET_DK
RET_V = RET_HEADS * RET_DV
ROPE_BASE = 10000.0

SSD_INNER = D_MODEL
SSD_HEADDIM = 64
SSD_HEADS = SSD_INNER // SSD_HEADDIM
SSD_GROUPS = 2
SSD_HPG = SSD_HEADS // SSD_GROUPS
SSD_STATE = 128
SSD_CONV = 4
SSD_CONV_CH = SSD_INNER + 2 * SSD_GROUPS * SSD_STATE

IN_SIZES = (RET_QK, RET_QK, RET_V, RET_V, SSD_INNER, SSD_CONV_CH, SSD_HEADS)
IN_PROJ = sum(IN_SIZES)
MIX_WIDTH = RET_V + SSD_INNER

S5_GROUP = 16
S5_GROUPS = D_MODEL // S5_GROUP
S5_STATE = 64

D_FF = 4 * D_MODEL

kernel_name = "hybrid_retention_ssd_s5_trunk"


def rms_norm(x, w):
    x32 = x.astype(F32)
    y = x32 * lax.rsqrt(jnp.mean(x32 * x32, axis=-1, keepdims=True) + EPS)
    return (y * w.astype(F32)).astype(x.dtype)


def rotary(x, pos):
    d = x.shape[-1]
    half = d // 2
    inv = ROPE_BASE ** (-jnp.arange(half, dtype=F32) / half)
    ang = pos.astype(F32)[:, None] * inv[None, :]
    cos = jnp.cos(ang)[None, :, None, :]
    sin = jnp.sin(ang)[None, :, None, :]
    x1, x2 = x[..., :half], x[..., half:]
    return jnp.concatenate([x1 * cos - x2 * sin, x2 * cos + x1 * sin], axis=-1)


def retention(q, k, v):
    b, L, h, dk = q.shape
    dv = v.shape[-1]
    nc = L // CHUNK
    pos = jnp.arange(L)
    q = rotary(q, pos)
    k = rotary(k, pos) * (dk ** -0.5)
    log_g = jnp.log1p(-(2.0 ** (-5.0 - jnp.arange(h, dtype=F32))))
    idx = jnp.arange(CHUNK, dtype=F32)
    rel = idx[:, None] - idx[None, :]
    decay = jnp.where(rel[None] >= 0, jnp.exp(jnp.maximum(rel, 0.0)[None] * log_g[:, None, None]), 0.0)
    qc = q.reshape(b, nc, CHUNK, h, dk)
    kc = k.reshape(b, nc, CHUNK, h, dk)
    vc = v.reshape(b, nc, CHUNK, h, dv)
    scores = jnp.einsum('bcnhd,bcmhd->bchnm', qc, kc) * decay[None, None]
    y_in = jnp.einsum('bchnm,bcmhe->bcnhe', scores, vc)
    zeta = jnp.exp((CHUNK - 1.0 - idx)[None, :] * log_g[:, None])
    xi = jnp.exp((idx + 1.0)[None, :] * log_g[:, None]).T
    g_chunk = jnp.exp(CHUNK * log_g)

    def step(R, inp):
        qi, ki, vi = inp
        y = jnp.einsum('bnhd,bhde->bnhe', qi, R) * xi[None, :, :, None]
        R = g_chunk[None, :, None, None] * R + jnp.einsum('bmhd,hm,bmhe->bhde', ki, zeta, vi)
        return R, y

    R0 = jnp.zeros((b, h, dk, dv), F32)
    _, y_x = lax.scan(step, R0, (qc.swapaxes(0, 1), kc.swapaxes(0, 1), vc.swapaxes(0, 1)))
    y = (y_in + y_x.swapaxes(0, 1)).reshape(b, L, h, dv)
    mu = jnp.mean(y, axis=-1, keepdims=True)
    var = jnp.mean(jnp.square(y - mu), axis=-1, keepdims=True)
    return (y - mu) * lax.rsqrt(var + EPS)


def causal_dwconv(x, w, bias):
    K, ch = w.shape
    y = lax.conv_general_dilated(x, w[:, None, :], window_strides=(1,), padding=[(K - 1, 0)],
                                 dimension_numbers=('NWC', 'WIO', 'NWC'), feature_group_count=ch)
    return y + bias


def ssd(xs, Bm, Cm, dt, a_log, d_skip):
    b, L, G, R, P = xs.shape
    N = Bm.shape[-1]
    nc = L // CHUNK
    A = -jnp.exp(a_log)
    dA = (dt * A).reshape(b, nc, CHUNK, G, R).transpose(0, 3, 4, 1, 2)
    X = (xs * dt.reshape(b, L, G, R)[..., None]).reshape(b, nc, CHUNK, G, R, P)
    Bc = Bm.reshape(b, nc, CHUNK, G, N)
    Cc = Cm.reshape(b, nc, CHUNK, G, N)
    cs = jnp.cumsum(dA, axis=-1)
    tril = jnp.tril(jnp.ones((CHUNK, CHUNK), dtype=bool))
    seg = cs[..., :, None] - cs[..., None, :]
    Lmat = jnp.where(tril, jnp.exp(jnp.minimum(seg, 0.0)), 0.0)
    CB = jnp.einsum('bclgn,bcsgn->bgcls', Cc, Bc)
    M = CB[:, :, None] * Lmat
    y_diag = jnp.einsum('bgrcls,bcsgrp->bclgrp', M, X)
    decay_st = jnp.exp(cs[..., -1:] - cs)
    states = jnp.einsum('bclgn,bgrcl,bclgrp->cbgrpn', Bc, decay_st, X)
    chunk_decay = jnp.exp(cs[..., -1]).transpose(3, 0, 1, 2)

    def step(S, inp):
        st, dec = inp
        return dec[..., None, None] * S + st, S

    S0 = jnp.zeros((b, G, R, P, N), F32)
    _, prev = lax.scan(step, S0, (states, chunk_decay))
    y_off = jnp.einsum('bclgn,cbgrpn,bgrcl->bclgrp', Cc, prev, jnp.exp(cs))
    y = (y_diag + y_off).reshape(b, L, G, R, P) + d_skip.reshape(G, R)[..., None] * xs
    return y.reshape(b, L, G * R * P)


def ret_ssd_mixer(h, w_in, conv_w, conv_b, dt_bias, a_log, d_ssd, ssd_norm, w_out):
    b, L, _ = h.shape
    proj = (h @ w_in).astype(F32)
    splits = [int(s) for s in np.cumsum(IN_SIZES)[:-1]]
    q, k, v, g, z, xbc, dt = jnp.split(proj, splits, axis=-1)
    yr = retention(q.reshape(b, L, RET_HEADS, RET_DK), k.reshape(b, L, RET_HEADS, RET_DK),
                   v.reshape(b, L, RET_HEADS, RET_DV))
    yr = jax.nn.silu(g) * yr.reshape(b, L, RET_V)
    xbc = jax.nn.silu(causal_dwconv(xbc, conv_w.astype(F32), conv_b.astype(F32)))
    xs, Bm, Cm = jnp.split(xbc, [SSD_INNER, SSD_INNER + SSD_GROUPS * SSD_STATE], axis=-1)
    dt = jax.nn.softplus(dt + dt_bias.astype(F32))
    ys = ssd(xs.reshape(b, L, SSD_GROUPS, SSD_HPG, SSD_HEADDIM),
             Bm.reshape(b, L, SSD_GROUPS, SSD_STATE), Cm.reshape(b, L, SSD_GROUPS, SSD_STATE),
             dt, a_log.astype(F32), d_ssd.astype(F32))
    ys = (ys * jax.nn.silu(z)).reshape(b, L, SSD_GROUPS, SSD_INNER // SSD_GROUPS)
    ys = ys * lax.rsqrt(jnp.mean(ys * ys, axis=-1, keepdims=True) + EPS)
    ys = ys.reshape(b, L, SSD_INNER) * ssd_norm.astype(F32)
    y = jnp.concatenate([yr, ys], axis=-1).astype(h.dtype)
    return y @ w_out


def s5_mixer(h, lam_re, lam_im, log_step, b_re, b_im, c_re, c_im, d_s5, w_glu_a, w_glu_b):
    b, L, _ = h.shape
    h32 = h.astype(F32)
    u = h32.reshape(b, L, S5_GROUPS, S5_GROUP)
    lr = jnp.minimum(lam_re.astype(F32), -1e-4)
    li = lam_im.astype(F32)
    delta = jnp.exp(log_step.astype(F32))[:, None]
    mag = jnp.exp(lr * delta)
    ab_re = mag * jnp.cos(li * delta)
    ab_im = mag * jnp.sin(li * delta)
    den = lr * lr + li * li
    nr, ni = ab_re - 1.0, ab_im
    coef_re = ((nr * lr + ni * li) / den)[..., None]
    coef_im = ((ni * lr - nr * li) / den)[..., None]
    br, bi = b_re.astype(F32), b_im.astype(F32)
    bb_re = coef_re * br - coef_im * bi
    bb_im = coef_re * bi + coef_im * br
    bu_re = jnp.einsum('blgc,gpc->lbgp', u, bb_re)
    bu_im = jnp.einsum('blgc,gpc->lbgp', u, bb_im)
    a_re = jnp.broadcast_to(ab_re[None, None], (L, 1, S5_GROUPS, S5_STATE))
    a_im = jnp.broadcast_to(ab_im[None, None], (L, 1, S5_GROUPS, S5_STATE))

    def combine(e1, e2):
        a1r, a1i, b1r, b1i = e1
        a2r, a2i, b2r, b2i = e2
        return (a2r * a1r - a2i * a1i, a2r * a1i + a2i * a1r,
                a2r * b1r - a2i * b1i + b2r, a2r * b1i + a2i * b1r + b2i)

    _, _, xr, xi = lax.associative_scan(combine, (a_re, a_im, bu_re, bu_im), axis=0)
    y = (jnp.einsum('lbgp,gcp->blgc', xr, c_re.astype(F32))
         - jnp.einsum('lbgp,gcp->blgc', xi, c_im.astype(F32)))
    y = y.reshape(b, L, D_MODEL) + d_s5.astype(F32) * h32
    y = jax.nn.gelu(y).astype(h.dtype)
    return (y @ w_glu_a) * jax.nn.sigmoid(y @ w_glu_b)


def setup_inputs(seed: int = 0) -> dict:
    key = jax.random.key(seed)
    ks = jax.random.split(key, 32)
    nrm = lambda k, s, sc: jax.random.normal(k, s, F32) * sc
    gain = lambda k, s: 1.0 + 0.02 * jax.random.normal(k, s, F32)
    x = jax.random.normal(ks[0], (BATCH, SEQ, D_MODEL), F32)
    dt0 = jnp.exp(jax.random.uniform(ks[8], (N_EVEN, SSD_HEADS), F32, math.log(1e-3), math.log(1e-1)))
    lam_im0 = math.pi * jnp.arange(S5_STATE, dtype=F32)
    return {
        "x": x,
        "pre_mix_norm": gain(ks[1], (DEPTH, D_MODEL)),
        "post_mix_norm": gain(ks[2], (DEPTH, D_MODEL)),
        "pre_mlp_norm": gain(ks[3], (DEPTH, D_MODEL)),
        "post_mlp_norm": gain(ks[4], (DEPTH, D_MODEL)),
        "w_in": nrm(ks[5], (N_EVEN, D_MODEL, IN_PROJ), D_MODEL ** -0.5),
        "conv_w": nrm(ks[6], (N_EVEN, SSD_CONV, SSD_CONV_CH), SSD_CONV ** -0.5),
        "conv_b": nrm(ks[7], (N_EVEN, SSD_CONV_CH), 0.02),
        "dt_bias": dt0 + jnp.log(-jnp.expm1(-dt0)),
        "a_log": jnp.log(jax.random.uniform(ks[9], (N_EVEN, SSD_HEADS), F32, 1.0, 16.0)),
        "d_ssd": 1.0 + 0.1 * jax.random.normal(ks[10], (N_EVEN, SSD_HEADS), F32),
        "ssd_norm": gain(ks[11], (N_EVEN, SSD_INNER)),
        "w_out": nrm(ks[12], (N_EVEN, MIX_WIDTH, D_MODEL), MIX_WIDTH ** -0.5),
        "lam_re": -0.5 + 0.01 * jax.random.normal(ks[13], (N_ODD, S5_GROUPS, S5_STATE), F32),
        "lam_im": lam_im0 + 0.01 * jax.random.normal(ks[14], (N_ODD, S5_GROUPS, S5_STATE), F32),
        "log_step": jax.random.uniform(ks[15], (N_ODD, S5_GROUPS), F32, math.log(1e-3), math.log(1e-1)),
        "b_re": nrm(ks[16], (N_ODD, S5_GROUPS, S5_STATE, S5_GROUP), (2 * S5_GROUP) ** -0.5),
        "b_im": nrm(ks[17], (N_ODD, S5_GROUPS, S5_STATE, S5_GROUP), (2 * S5_GROUP) ** -0.5),
        "c_re": nrm(ks[18], (N_ODD, S5_GROUPS, S5_GROUP, S5_STATE), S5_STATE ** -0.5),
        "c_im": nrm(ks[19], (N_ODD, S5_GROUPS, S5_GROUP, S5_STATE), S5_STATE ** -0.5),
        "d_s5": nrm(ks[20], (N_ODD, D_MODEL), 1.0),
        "w_glu_a": nrm(ks[21], (N_ODD, D_MODEL, D_MODEL), D_MODEL ** -0.5),
        "w_glu_b": nrm(ks[22], (N_ODD, D_MODEL, D_MODEL), D_MODEL ** -0.5),
        "w_up": nrm(ks[23], (DEPTH, D_MODEL, D_FF), D_MODEL ** -0.5),
        "w_down": nrm(ks[24], (DEPTH, D_FF, D_MODEL), D_FF ** -0.5),
    }


def reference(x, pre_mix_norm, post_mix_norm, pre_mlp_norm, post_mlp_norm, w_in, conv_w, conv_b,
              dt_bias, a_log, d_ssd, ssd_norm, w_out, lam_re, lam_im, log_step, b_re, b_im,
              c_re, c_im, d_s5, w_glu_a, w_glu_b, w_up, w_down):
    h = x
    for i in range(DEPTH):
        j = i // 2
        hn = rms_norm(h, pre_mix_norm[i])
        if i % 2 == 0:
            m = ret_ssd_mixer(hn, w_in[j], conv_w[j], conv_b[j], dt_bias[j], a_log[j], d_ssd[j],
                              ssd_norm[j], w_out[j])
        else:
            m = s5_mixer(hn, lam_re[j], lam_im[j], log_step[j], b_re[j], b_im[j], c_re[j], c_im[j],
                         d_s5[j], w_glu_a[j], w_glu_b[j])
        h = h + rms_norm(m, post_mix_norm[i])
        hn = rms_norm(h, pre_mlp_norm[i])
        f = jnp.square(jax.nn.relu(hn @ w_up[i])) @ w_down[i]
        h = h + rms_norm(f, post_mlp_norm[i])
    return h
```

```cpp
#include <hip/hip_runtime.h>
#include <cstdio>
#include <cstdint>
namespace pg8 {
#define PG8_LAS __attribute__((address_space(3)))
typedef unsigned short bf16_t;
typedef short bf16x8 __attribute__((ext_vector_type(8)));
typedef float f32x4 __attribute__((ext_vector_type(4)));
typedef unsigned u32x4 __attribute__((ext_vector_type(4)));
constexpr int BM = 256, BK = 64, HALF = 128, HTB = HALF * BK * 2  , STAGE_BYTES = 8 * HTB, NXCD = 8, WGM = 8;

__host__ __device__ __forceinline__ int lds_byte(int r, int c) { const int st = (r >> 4) * 2 + (c >> 5), rr = r & 15, cc = c & 31, ob = rr * 64 + cc * 2; return st * 1024 + (ob ^ (((ob >> 9) & 1) << 5)); }
__host__ __device__ __forceinline__ void stage_rc(int b, int& R, int& C) { const int st = b / 1024, sb = b % 1024, swz = sb ^ (((sb >> 9) & 1) << 5); R = (st >> 1) * 16 + swz / 64; C = (st & 1) * 32 + (swz % 64) / 2; }
__host__ __device__ __forceinline__ int perm32(int rho) { const int n = rho >> 4, i = rho & 15; return 8 * (i >> 2) + 4 * n + (i & 3); }

struct Unit { int pm, pn; };
struct Gemm { const bf16_t* A; const bf16_t* Bt; int M, N, K; };

struct StaticOrder {
    int nM, nN, nwg, G, c;
    __host__ __device__ void init(int M, int N, int G_, int c_) { nM = M / BM; nN = N / BM; nwg = nM * nN; G = G_; c = c_; }
    __host__ __device__ bool next(int i, Unit& u) const {
        const long L = (long)i * G + c; if (L >= nwg) return false;
        int wgid = (int)L; { const int q = nwg / NXCD, r = nwg % NXCD, xcd = wgid % NXCD, off = wgid / NXCD; wgid = (xcd < r ? xcd * (q + 1) : r * (q + 1) + (xcd - r) * q) + off; }
        const int nig = WGM * nN, gid = wgid / nig, fm = gid * WGM, gsz = (nM - fm) < WGM ? (nM - fm) : WGM;
        u.pm = fm + ((wgid % nig) % gsz); u.pn = (wgid % nig) / gsz; return true;
    }
    __device__ __forceinline__ void a_ready(const Unit&) const {}
    __device__ __forceinline__ void done(const Unit&) const {}
};

__device__ __forceinline__ unsigned cvt_pk_bf16(float lo, float hi) { unsigned r; asm volatile("v_cvt_pk_bf16_f32 %0, %1, %2" : "=v"(r) : "v"(lo), "v"(hi)); return r; }
typedef float f32x2 __attribute__((ext_vector_type(2)));
struct EpiF32 {
    static constexpr bool PERM = false, AFTER_DRAIN = false;
    float* C; int ldc;
    __device__ __forceinline__ void operator()(const f32x4 (&acc)[2][2][4][2], const Unit& u, int wr, int wc, int fr, int fq) const {
        const int row0 = u.pm * BM + wr * 64 + fr, col0 = u.pn * BM + wc * 32 + 4 * fq;
#pragma unroll
        for (int ai = 0; ai < 2; ++ai)
#pragma unroll
            for (int m = 0; m < 4; ++m) { float* rowp = C + (size_t)(row0 + ai * HALF + m * 16) * ldc + col0;
#pragma unroll
                for (int bj = 0; bj < 2; ++bj)
#pragma unroll
                    for (int n = 0; n < 2; ++n) *(f32x4*)(rowp + bj * HALF + n * 16) = acc[ai][bj][m][n]; }
    }
};
struct EpiGlu {
    static constexpr bool PERM = false, AFTER_DRAIN = false;
    float* C; int ldc;
    __device__ __forceinline__ void operator()(const f32x4 (&acc)[2][2][4][2], const Unit& u, int wr, int wc, int fr, int fq) const {
        const int row0 = u.pm * BM + wr * 64 + fr, col0 = u.pn * HALF + wc * 32 + 4 * fq;
#pragma unroll
        for (int ai = 0; ai < 2; ++ai)
#pragma unroll
            for (int m = 0; m < 4; ++m) { float* rowp = C + (size_t)(row0 + ai * HALF + m * 16) * ldc + col0;
#pragma unroll
                for (int n = 0; n < 2; ++n) { const f32x4 a = acc[ai][0][m][n], b = acc[ai][1][m][n]; f32x4 o;
#pragma unroll
                    for (int j = 0; j < 4; ++j) o[j] = a[j] / (1.0f + __expf(-b[j]));
                    *(f32x4*)(rowp + n * 16) = o; } }
    }
};
struct EpiRelu2 {
    static constexpr bool PERM = true, AFTER_DRAIN = false;
    bf16_t* O; int ldc;
    __device__ __forceinline__ void operator()(const f32x4 (&acc)[2][2][4][2], const Unit& u, int wr, int wc, int fr, int fq) const {
        const int row0 = u.pm * BM + wr * 64 + fr, col0 = u.pn * BM + wc * 32 + 8 * fq;
#pragma unroll
        for (int ai = 0; ai < 2; ++ai)
#pragma unroll
            for (int m = 0; m < 4; ++m) { bf16_t* rowp = O + (size_t)(row0 + ai * HALF + m * 16) * ldc + col0;
#pragma unroll
                for (int bj = 0; bj < 2; ++bj) { f32x4 v0 = acc[ai][bj][m][0], v1 = acc[ai][bj][m][1];
#pragma unroll
                    for (int j = 0; j < 4; ++j) { const float a = fmaxf(v0[j], 0.f), b = fmaxf(v1[j], 0.f); v0[j] = a * a; v1[j] = b * b; }
                    u32x4 w; w.x = cvt_pk_bf16(v0[0], v0[1]); w.y = cvt_pk_bf16(v0[2], v0[3]); w.z = cvt_pk_bf16(v1[0], v1[1]); w.w = cvt_pk_bf16(v1[2], v1[3]);
                    *(u32x4*)(rowp + bj * HALF) = w; } }
    }
};
struct EpiInProj {
    static constexpr bool PERM = true, AFTER_DRAIN = false;
    bf16_t* QKV; bf16_t* GZ; bf16_t* XBC; float* DT; const float* rope; const float* dt_bias;
    __device__ __forceinline__ void operator()(const f32x4 (&acc)[2][2][4][2], const Unit& u, int wr, int wc, int fr, int fq) const {
        const int pn = u.pn, row0 = u.pm * BM + wr * 64 + fr, cin = wc * 32 + 8 * fq;
        if (pn < 8) {
            const int hd = pn & 3; const bool isk = pn >= 4;
            const float lg2 = __log2f(1.0f - exp2f(-5.0f - (float)hd));
#pragma unroll
            for (int ai = 0; ai < 2; ++ai)
#pragma unroll
                for (int m = 0; m < 4; ++m) { const int row = row0 + ai * HALF + m * 16, pos = row & 4095, r = pos & 127;
                    const float sc = isk ? exp2f(-(float)r * lg2) * 0.0625f : exp2f((float)r * lg2);
                    const f32x4* rp = (const f32x4*)(rope + ((size_t)pos * 128 + cin) * 2);
                    f32x4 o1[2], o2[2];
#pragma unroll
                    for (int n = 0; n < 2; ++n) { const f32x4 cs0 = rp[2 * n], cs1 = rp[2 * n + 1];
                        const f32x4 x1 = acc[ai][0][m][n], x2 = acc[ai][1][m][n];
                        const float c[4] = {cs0[0], cs0[2], cs1[0], cs1[2]}, s[4] = {cs0[1], cs0[3], cs1[1], cs1[3]};
#pragma unroll
                        for (int j = 0; j < 4; ++j) { o1[n][j] = (x1[j] * c[j] - x2[j] * s[j]) * sc; o2[n][j] = (x2[j] * c[j] + x1[j] * s[j]) * sc; } }
                    bf16_t* rowp = QKV + (size_t)row * 3072 + pn * 256 + cin;
                    u32x4 w; w.x = cvt_pk_bf16(o1[0][0], o1[0][1]); w.y = cvt_pk_bf16(o1[0][2], o1[0][3]); w.z = cvt_pk_bf16(o1[1][0], o1[1][1]); w.w = cvt_pk_bf16(o1[1][2], o1[1][3]);
                    *(u32x4*)rowp = w;
                    w.x = cvt_pk_bf16(o2[0][0], o2[0][1]); w.y = cvt_pk_bf16(o2[0][2], o2[0][3]); w.z = cvt_pk_bf16(o2[1][0], o2[1][1]); w.w = cvt_pk_bf16(o2[1][2], o2[1][3]);
                    *(u32x4*)(rowp + HALF) = w; }
        } else if (pn < 26) {
            bf16_t* base; int ldc, colt;
            if (pn < 12) { base = QKV; ldc = 3072; colt = pn * 256; } else if (pn < 20) { base = GZ; ldc = 2048; colt = (pn - 12) * 256; } else { base = XBC; ldc = 1536; colt = (pn - 20) * 256; }
#pragma unroll
            for (int ai = 0; ai < 2; ++ai)
#pragma unroll
                for (int m = 0; m < 4; ++m) { bf16_t* rowp = base + (size_t)(row0 + ai * HALF + m * 16) * ldc + colt + cin;
#pragma unroll
                    for (int bj = 0; bj < 2; ++bj) { const f32x4 v0 = acc[ai][bj][m][0], v1 = acc[ai][bj][m][1];
                        u32x4 w; w.x = cvt_pk_bf16(v0[0], v0[1]); w.y = cvt_pk_bf16(v0[2], v0[3]); w.z = cvt_pk_bf16(v1[0], v1[1]); w.w = cvt_pk_bf16(v1[2], v1[3]);
                        *(u32x4*)(rowp + bj * HALF) = w; } }
        } else {
            if (cin < 16) {
#pragma unroll
                for (int ai = 0; ai < 2; ++ai)
#pragma unroll
                    for (int m = 0; m < 4; ++m) { float* rowp = DT + (size_t)(row0 + ai * HALF + m * 16) * 16 + cin;
#pragma unroll
                        for (int n = 0; n < 2; ++n) { f32x4 o;
#pragma unroll
                            for (int j = 0; j < 4; ++j) { const float x = acc[ai][0][m][n][j] + dt_bias[cin + 4 * n + j]; o[j] = x > 20.f ? x : log1pf(__expf(x)); }
                            *(f32x4*)(rowp + 4 * n) = o; } }
            }
        }
    }
};
template <class Epi, class Sched, bool ALIGN_EPI = false, bool SP2 = false>
__device__ __forceinline__ void gemm_phase(PG8_LAS unsigned char* lds, const Gemm g, const Sched& S, const Epi& E, const int tid) {
    const int wid = __builtin_amdgcn_readfirstlane(tid >> 6), lane = tid & 63, wr = wid >> 2, wc = wid & 3, fr = lane & 15, fq = lane >> 4;
    const int K = g.K, nt = K / BK;
    unsigned voffA[2], voffB[2];
#pragma unroll
    for (int i = 0; i < 2; ++i) { int R, C; stage_rc(tid * 16 + i * 8192, R, C); const int Rb = Epi::PERM ? ((R & ~31) + perm32(R & 31)) : R;
        voffA[i] = (unsigned)(R * K + C) * 2u; voffB[i] = (unsigned)(Rb * K + C) * 2u; }
    const size_t kstep = (size_t)(BK * 2);
    const size_t hstep = (size_t)HALF * K * 2;
    const size_t tstep = 2 * hstep;
    const unsigned ldsw = (unsigned)wid * 1024u;
    const int aoff = lds_byte(wr * 64 + fr, fq * 8), boff = lds_byte(wc * 32 + fr, fq * 8);
#define PG8_SA(b, h) (((b) * 2 + (h)) * HTB)
#define PG8_SB(b, h) ((4 + (b) * 2 + (h)) * HTB)
#define PG8_STAGE(bufoff, gbase, voff) do { _Pragma("unroll") for (int _i = 0; _i < 2; ++_i) \
        __builtin_amdgcn_global_load_lds((const unsigned*)((const char*)(gbase) + (voff)[_i]), (PG8_LAS unsigned*)(lds + (bufoff) + ldsw + _i * 8192), 16, 0, 0); } while (0)
#define PG8_LDA(dst, b, h) do { _Pragma("unroll") for (int m = 0; m < 4; ++m) _Pragma("unroll") for (int k = 0; k < 2; ++k) dst[m][k] = *(const PG8_LAS bf16x8*)(lds + PG8_SA(b, h) + aoff + m * 2048 + k * 1024); } while (0)
#define PG8_LDB(dst, b, h) do { _Pragma("unroll") for (int n = 0; n < 2; ++n) _Pragma("unroll") for (int k = 0; k < 2; ++k) dst[n][k] = *(const PG8_LAS bf16x8*)(lds + PG8_SB(b, h) + boff + n * 2048 + k * 1024); } while (0)
#define PG8_MMA(ai, bj, At, Bt) do { __builtin_amdgcn_s_setprio(1); _Pragma("unroll") for (int m = 0; m < 4; ++m) _Pragma("unroll") for (int n = 0; n < 2; ++n) _Pragma("unroll") for (int k = 0; k < 2; ++k) \
        acc[ai][bj][m][n] = __builtin_amdgcn_mfma_f32_16x16x32_bf16(Bt[n][k], At[m][k], acc[ai][bj][m][n], 0, 0, 0); __builtin_amdgcn_s_setprio(0); } while (0)
#define PG8_WAIT_V(n) asm volatile("s_waitcnt vmcnt(" #n ")" ::: "memory")
#define PG8_WAIT_L(n) asm volatile("s_waitcnt lgkmcnt(" #n ")" ::: "memory")
#define PG8_BAR __builtin_amdgcn_s_barrier()
#define PG8_SCHED __builtin_amdgcn_sched_barrier(0)
    Unit cur, nxt; int ui = 0;
    if (!S.next(0, cur)) return;
    f32x4 acc[2][2][4][2];
#pragma unroll
    for (int a = 0; a < 2; ++a)
#pragma unroll
        for (int b = 0; b < 2; ++b)
#pragma unroll
            for (int m = 0; m < 4; ++m)
#pragma unroll
                for (int n = 0; n < 2; ++n) acc[a][b][m][n] = (f32x4){0.f, 0.f, 0.f, 0.f};
    bf16x8 At[4][2], B0[2][2], B1[2][2];
    const char* cA = (const char*)g.A + (size_t)cur.pm * tstep; const char* cB = (const char*)g.Bt + (size_t)cur.pn * tstep;
    S.a_ready(cur);
    if constexpr (SP2) {
        PG8_STAGE(PG8_SB(0, 0), cB, voffB); PG8_STAGE(PG8_SB(0, 1), cB + hstep, voffB); PG8_STAGE(PG8_SA(0, 0), cA, voffA); PG8_STAGE(PG8_SA(0, 1), cA + hstep, voffA);
        if (wr == 1) PG8_BAR;
        PG8_WAIT_V(2); PG8_BAR;
        PG8_STAGE(PG8_SB(1, 0), cB + kstep, voffB); PG8_STAGE(PG8_SA(1, 0), cA + kstep, voffA); PG8_STAGE(PG8_SB(1, 1), cB + hstep + kstep, voffB);
        PG8_WAIT_V(6); PG8_BAR;
    } else {
        PG8_STAGE(PG8_SB(0, 0), cB, voffB); PG8_STAGE(PG8_SA(0, 0), cA, voffA); PG8_STAGE(PG8_SB(0, 1), cB + hstep, voffB); PG8_STAGE(PG8_SA(0, 1), cA + hstep, voffA);
        if (wr == 1) PG8_BAR;
        PG8_WAIT_V(4); PG8_BAR;
        PG8_STAGE(PG8_SB(1, 0), cB + kstep, voffB); PG8_STAGE(PG8_SA(1, 0), cA + kstep, voffA); PG8_STAGE(PG8_SB(1, 1), cB + hstep + kstep, voffB);
        PG8_WAIT_V(6); PG8_BAR;
    }
    for (;;) {
        const bool has_next = S.next(ui + 1, nxt);
        const char* nA = has_next ? (const char*)g.A + (size_t)nxt.pm * tstep : cA; const char* nB = has_next ? (const char*)g.Bt + (size_t)nxt.pn * tstep : cB;
        for (int t = 0; t < nt; t += 2) {
            const bool last = (t == nt - 2);
            const char* a1 = cA + (size_t)(t + 1) * kstep;
            const char* a2 = last ? nA : cA + (size_t)(t + 2) * kstep; const char* b2 = last ? nB : cB + (size_t)(t + 2) * kstep;
            const char* a3 = a2 + kstep; const char* b3 = b2 + kstep;
            if (last && has_next) S.a_ready(nxt);
            if constexpr (SP2) {
            PG8_LDB(B0, 0, 0); PG8_LDB(B1, 0, 1); PG8_SCHED; PG8_LDA(At, 0, 0); PG8_STAGE(PG8_SA(1, 1), a1 + hstep, voffA);
            PG8_WAIT_V(8); PG8_WAIT_L(0); PG8_BAR; PG8_MMA(0, 0, At, B0); PG8_MMA(0, 1, At, B1); PG8_BAR; PG8_SCHED;
            PG8_LDA(At, 0, 1); PG8_STAGE(PG8_SB(0, 0), b2, voffB); PG8_STAGE(PG8_SB(0, 1), b2 + hstep, voffB); PG8_STAGE(PG8_SA(0, 0), a2, voffA);
            PG8_WAIT_V(8); PG8_WAIT_L(0); PG8_BAR; PG8_MMA(1, 0, At, B0); PG8_MMA(1, 1, At, B1); PG8_BAR; PG8_SCHED;
            PG8_LDB(B0, 1, 0); PG8_LDB(B1, 1, 1); PG8_SCHED; PG8_LDA(At, 1, 0); PG8_STAGE(PG8_SA(0, 1), a2 + hstep, voffA);
            PG8_WAIT_V(8); PG8_WAIT_L(0); PG8_BAR; PG8_MMA(0, 0, At, B0); PG8_MMA(0, 1, At, B1); PG8_BAR; PG8_SCHED;
            PG8_LDA(At, 1, 1); PG8_STAGE(PG8_SB(1, 0), b3, voffB); PG8_STAGE(PG8_SB(1, 1), b3 + hstep, voffB); PG8_STAGE(PG8_SA(1, 0), a3, voffA);
            PG8_WAIT_V(8); PG8_WAIT_L(0); PG8_BAR; PG8_MMA(1, 0, At, B0); PG8_MMA(1, 1, At, B1); PG8_BAR; PG8_SCHED;
            } else {
            PG8_LDB(B0, 0, 0); PG8_SCHED; PG8_LDA(At, 0, 0); PG8_STAGE(PG8_SA(1, 1), a1 + hstep, voffA);
            PG8_WAIT_L(8); PG8_BAR; PG8_WAIT_L(0); PG8_MMA(0, 0, At, B0); PG8_BAR; PG8_SCHED;
            PG8_LDB(B1, 0, 1); PG8_STAGE(PG8_SB(0, 0), b2, voffB);
            PG8_BAR; PG8_WAIT_L(0); PG8_MMA(0, 1, At, B1); PG8_BAR;
            PG8_LDA(At, 0, 1); PG8_STAGE(PG8_SA(0, 0), a2, voffA);
            PG8_BAR; PG8_WAIT_L(0); PG8_MMA(1, 0, At, B0); PG8_BAR; PG8_SCHED;
            PG8_STAGE(PG8_SB(0, 1), b2 + hstep, voffB);
            PG8_WAIT_V(6); PG8_BAR; PG8_MMA(1, 1, At, B1); PG8_BAR;
            PG8_LDB(B0, 1, 0); PG8_SCHED; PG8_LDA(At, 1, 0); PG8_STAGE(PG8_SA(0, 1), a2 + hstep, voffA);
            PG8_WAIT_L(8); PG8_BAR; PG8_WAIT_L(0); PG8_MMA(0, 0, At, B0); PG8_BAR; PG8_SCHED;
            PG8_LDB(B1, 1, 1); PG8_STAGE(PG8_SB(1, 0), b3, voffB);
            PG8_BAR; PG8_WAIT_L(0); PG8_MMA(0, 1, At, B1); PG8_BAR;
            PG8_LDA(At, 1, 1); PG8_STAGE(PG8_SA(1, 0), a3, voffA);
            PG8_BAR; PG8_WAIT_L(0); PG8_MMA(1, 0, At, B0); PG8_BAR; PG8_SCHED;
            PG8_STAGE(PG8_SB(1, 1), b3 + hstep, voffB);
            PG8_WAIT_V(6); PG8_BAR; PG8_MMA(1, 1, At, B1); PG8_BAR;
            }
        }
        if constexpr (ALIGN_EPI) { if (wr == 0) PG8_BAR; }
        if constexpr (!Epi::AFTER_DRAIN) { E(acc, cur, wr, wc, fr, fq); S.done(cur); }
        if (!has_next) break;
#pragma unroll
        for (int a = 0; a < 2; ++a)
#pragma unroll
            for (int b = 0; b < 2; ++b)
#pragma unroll
                for (int m = 0; m < 4; ++m)
#pragma unroll
                    for (int n = 0; n < 2; ++n) acc[a][b][m][n] = (f32x4){0.f, 0.f, 0.f, 0.f};
        cur = nxt; cA = nA; cB = nB; ++ui;
        if constexpr (ALIGN_EPI) { if (wr == 1) PG8_BAR; }
    }
    PG8_WAIT_V(0);
    if constexpr (!ALIGN_EPI) { if (wr == 0) PG8_BAR; }
    PG8_BAR;
    if constexpr (Epi::AFTER_DRAIN) { E.fused(acc, cur, wr, wc, fr, fq, lds, wid, lane); S.done(cur); }
#undef PG8_SA
#undef PG8_SB
#undef PG8_STAGE
#undef PG8_LDA
#undef PG8_LDB
#undef PG8_MMA
#undef PG8_WAIT_V
#undef PG8_WAIT_L
#undef PG8_BAR
#undef PG8_SCHED
}
}
constexpr int NWAVES = 8, NTHR = 512;
constexpr int BATCH = 4, SEQ = 4096, D = 1024, M = BATCH * SEQ, FF = 4096, DEPTH = 4;
constexpr int INP = 6672, INP_PAD = 6912;
constexpr float EPS = 1e-6f;
enum { I_X = 0, I_PRE_MIX, I_POST_MIX, I_PRE_MLP, I_POST_MLP, I_W_IN, I_CONV_W, I_CONV_B, I_DT_BIAS, I_A_LOG, I_D_SSD, I_SSD_NORM, I_W_OUT,
       I_LAM_RE, I_LAM_IM, I_LOG_STEP, I_B_RE, I_B_IM, I_C_RE, I_C_IM, I_D_S5, I_W_GLU_A, I_W_GLU_B, I_W_UP, I_W_DOWN, N_IN };
constexpr size_t MiB = 1u << 20;
constexpr size_t WS_CTL = 0, CTL_ZERO_BYTES = 64 * 1024;
constexpr size_t WS_MISC = 512 * 1024;
constexpr size_t WS_ROPE = 1 * MiB;
constexpr size_t WS_W4 = 5 * MiB;
constexpr size_t WS_SLOT16 = 9 * MiB;
constexpr size_t WS_SLOT32 = 25 * MiB;
constexpr size_t WS_QKV = 57 * MiB;
constexpr size_t WS_GZ = 153 * MiB;
constexpr size_t WS_XBC = 217 * MiB;
constexpr size_t WS_DT = 265 * MiB;
constexpr size_t WS_END = 266 * MiB;
constexpr size_t WS_M32A = 57 * MiB;
constexpr size_t WS_M32B = 185 * MiB;
constexpr size_t WS_U = 57 * MiB;
constexpr size_t WS_S5MAT = 57 * MiB;
constexpr size_t WS_S5E = 73 * MiB;
constexpr size_t WS_S5X = 105 * MiB;
constexpr size_t WS_Y = 121 * MiB;
constexpr int SCR_BYTES = 143360;
constexpr int MISC_OFF = SCR_BYTES;
constexpr int LDS_BYTES = 147456;

#define GAS __attribute__((address_space(1)))
#define LAS __attribute__((address_space(3)))
#define DI __device__ __forceinline__
typedef unsigned short bf16;
typedef unsigned v4u __attribute__((ext_vector_type(4)));
typedef unsigned v2u __attribute__((ext_vector_type(2)));
typedef float f32x4 __attribute__((ext_vector_type(4)));
typedef float f32x2v __attribute__((ext_vector_type(2)));
typedef short bf16x8 __attribute__((ext_vector_type(8)));
typedef short v4i16_t __attribute__((ext_vector_type(4)));
typedef GAS unsigned gu32;
#define RLX_AGENT __ATOMIC_RELAXED, __HIP_MEMORY_SCOPE_AGENT
#define LDS_WAIT() asm volatile("s_waitcnt lgkmcnt(0)" ::: "memory")
#define VM_WAIT() asm volatile("s_waitcnt vmcnt(0)" ::: "memory")
DI unsigned f2bf(float f) { unsigned u = __builtin_bit_cast(unsigned, f); return (u + 0x7fffu + ((u >> 16) & 1u)) >> 16; }
DI unsigned pk2(float lo, float hi) { return f2bf(lo) | (f2bf(hi) << 16); }
DI float bf2f(unsigned short b) { return __builtin_bit_cast(float, ((unsigned)b) << 16); }
DI float bflo(unsigned w) { return __builtin_bit_cast(float, w << 16); }
DI float bfhi(unsigned w) { return __builtin_bit_cast(float, w & 0xffff0000u); }
DI float wave_sum(float v) {
#pragma unroll
    for (int o = 1; o < 64; o <<= 1) v += __shfl_xor(v, o);
    return v;
}
DI float silu_f(float x) { return x / (1.0f + __expf(-x)); }
DI void sincos_d(double x, double& s, double& c) {
    const double k = rint(x * 0.15915494309189533576888376337251);
    const double r = fma(-k, 6.283185307179586476925286766559, x), r2 = r * r;
    double ps = 1.0 / 1.0888869450418352e28, pc = 1.0 / 3.0488834461171384e29;
    const double fs[13] = {1.0 / 1.5511210043330986e25, 1.0 / 2.5852016738884978e22, 1.0 / 5.109094217170944e19, 1.0 / 1.21645100408832e17, 1.0 / 355687428096000.0, 1.0 / 1307674368000.0,
                           1.0 / 6227020800.0, 1.0 / 39916800.0, 1.0 / 362880.0, 1.0 / 5040.0, 1.0 / 120.0, 1.0 / 6.0, 1.0};
    const double fc[14] = {1.0 / 4.0329146112660565e26, 1.0 / 6.204484017332394e23, 1.0 / 1.1240007277776077e21, 1.0 / 2.43290200817664e18, 1.0 / 6402373705728000.0, 1.0 / 20922789888000.0,
                           1.0 / 87178291200.0, 1.0 / 479001600.0, 1.0 / 3628800.0, 1.0 / 40320.0, 1.0 / 720.0, 1.0 / 24.0, 1.0 / 2.0, 1.0};
#pragma unroll
    for (int i = 0; i < 13; ++i) ps = fs[i] - ps * r2;
#pragma unroll
    for (int i = 0; i < 14; ++i) pc = fc[i] - pc * r2;
    s = ps * r; c = pc;
}
#define XB_TMO      128
#define XB_XCNT(j)  (256  + 64 * (j))
#define XB_XSUB(j)  (1280 + 64 * (j))
#define XB_XGEN(j)  (2304 + 64 * (j))
#define XB_TOP      3328
#define XB_TOPGEN   3392
#define XCD_BAR_WORDS 3456
#define XB_SPIN_CAP (1u << 18)

__device__ __forceinline__ unsigned xb_ld(unsigned* p)              { return __hip_atomic_load(p, __ATOMIC_RELAXED, __HIP_MEMORY_SCOPE_AGENT); }
__device__ __forceinline__ unsigned xb_add(unsigned* p, unsigned v) { return __hip_atomic_fetch_add(p, v, __ATOMIC_RELAXED, __HIP_MEMORY_SCOPE_AGENT); }
__device__ __forceinline__ unsigned xb_xcc_id() { return (unsigned)__builtin_amdgcn_s_getreg((3 << 11) | 20) & 0xFu; }
#define XB_SPIN(cond, bar) do { unsigned _sp = 0; while (cond) { __builtin_amdgcn_s_sleep(1); \
    if ((++_sp & 255u) == 0u) { if (xb_ld(&(bar)[XB_TMO])) break; if (_sp > XB_SPIN_CAP) { atomicAdd(&(bar)[XB_TMO], 1u); break; } } } } while (0)

struct XcdBarrier {
    unsigned* bar; unsigned x; int tid;
    volatile LAS unsigned* st;
};

__device__ __forceinline__ XcdBarrier xcd_barrier_post(unsigned* bar, volatile LAS unsigned* st) {
    XcdBarrier b; b.bar = bar; b.x = xb_xcc_id(); b.st = st;
    if (threadIdx.x == 0) (void)xb_add(&bar[XB_XCNT(b.x)], 1u);
    return b;
}
__device__ __forceinline__ void xcd_barrier_complete(unsigned* bar, unsigned x, unsigned& nloc, unsigned& nx) {
    const unsigned G = gridDim.x * gridDim.y * gridDim.z;
    unsigned sum, cnt, mine, sp = 0u;
    for (;;) {
        sum = 0u; cnt = 0u; mine = 0u;
#pragma unroll
        for (unsigned j = 0; j < 16; ++j) { const unsigned c = xb_ld(&bar[XB_XCNT(j)]); sum += c; cnt += (c > 0u) ? 1u : 0u; mine = (j == x) ? c : mine; }
        if (sum == G) break;
        __builtin_amdgcn_s_sleep(1);
        if ((++sp & 255u) == 0u) { if (xb_ld(&bar[XB_TMO])) break; if (sp > XB_SPIN_CAP) { atomicAdd(&bar[XB_TMO], 1u); break; } }
    }
    nloc = mine > 0u ? mine : 1u; nx = cnt > 0u ? cnt : 1u;
}

__device__ __forceinline__ void xcd_barrier(const XcdBarrier& b) {
    asm volatile("s_waitcnt vmcnt(0)" ::: "memory");
    __syncthreads();
    if (b.tid == 0) {
        unsigned* bar = b.bar;
        __builtin_amdgcn_s_waitcnt(0);
        unsigned nloc = b.st[0], nx = b.st[1];
        if (nloc == 0u) { xcd_barrier_complete(bar, b.x, nloc, nx); b.st[0] = nloc; b.st[1] = nx; }
        const unsigned old = xb_add(&bar[XB_XSUB(b.x)], 1u);
        const unsigned gen = old / nloc;
        if (old + 1u == (gen + 1u) * nloc) {
            __builtin_amdgcn_fence(__ATOMIC_RELEASE, "agent");
            asm volatile("s_waitcnt vmcnt(0)" ::: "memory");
            const unsigned og = xb_add(&bar[XB_TOP], 1u);
            const unsigned tg = og / nx;
            if (og + 1u == (tg + 1u) * nx) xb_add(&bar[XB_TOPGEN], 1u);
            else XB_SPIN(xb_ld(&bar[XB_TOPGEN]) == tg, bar);
            __builtin_amdgcn_fence(__ATOMIC_ACQUIRE, "agent");
            xb_add(&bar[XB_XGEN(b.x)], 1u);
            asm volatile("s_waitcnt vmcnt(0)" ::: "memory");
        } else {
            XB_SPIN(xb_ld(&bar[XB_XGEN(b.x)]) == gen, bar);
            __builtin_amdgcn_fence(__ATOMIC_ACQUIRE, "agent");
            asm volatile("s_waitcnt vmcnt(0)" ::: "memory");
        }
    }
    __syncthreads();
}

struct Frame {
    LAS unsigned char* lds;
    int tid, lane, wave, G, bid;
    float* out; unsigned char* ws;
};
DI unsigned long long lds_ptr(const Frame& F, int i) {
    const unsigned long long v = ((const volatile LAS unsigned long long*)(F.lds + MISC_OFF + 256))[i];
    const unsigned lo = __builtin_amdgcn_readfirstlane((unsigned)v), hi = __builtin_amdgcn_readfirstlane((unsigned)(v >> 32));
    return ((unsigned long long)hi << 32) | lo;
}
#define INP(i) ((const float*)(const GAS float*)lds_ptr(F, (i)))
DI int gwave(const Frame& F) { return F.bid * NWAVES + F.wave; }

DI bf16x8 frag_rm(const LAS unsigned char* t, int S, int r0, int k0, int lane) { return *(const LAS bf16x8*)(t + (r0 + (lane & 15)) * S + (k0 + 8 * (lane >> 4)) * 2); }
DI bf16x8 frag_tr(const LAS unsigned char* t, int S, int r0, int k0, int lane) {
    const int g = lane >> 4, q = (lane & 15) >> 2, p = lane & 3;
    const LAS unsigned char* a = t + (k0 + 8 * g + q) * S + (r0 + 4 * p) * 2;
    const v4i16_t lo = __builtin_amdgcn_ds_read_tr16_b64_v4i16((LAS v4i16_t*)a);
    const v4i16_t hi = __builtin_amdgcn_ds_read_tr16_b64_v4i16((LAS v4i16_t*)(a + 4 * S));
    return __builtin_shufflevector(lo, hi, 0, 1, 2, 3, 4, 5, 6, 7);
}
DI f32x4 mma(bf16x8 a, bf16x8 b, f32x4 c) { return __builtin_amdgcn_mfma_f32_16x16x32_bf16(a, b, c, 0, 0, 0); }

DI void load_tile(LAS unsigned char* dst, int S, const bf16* src, size_t ld, int rows, int cols, int tid) {
    const int cpr = cols >> 3, n = rows * cpr;
    for (int i = tid; i < n; i += NTHR) { const int r = i / cpr, c = i - r * cpr;
        *(LAS v4u*)(dst + r * S + c * 16) = *(const v4u*)(src + (size_t)r * ld + c * 8); }
}

DI void transpose_item(const float* W, int K, int N, bf16* WT, int mode, LAS float* scr, int item, int lane) {
    const int nblk = (N + 31) / 32, kb = item / nblk, nb = item % nblk, k0 = 64 * kb, n0 = 32 * nb;
    const int nl = n0 + (lane & 31);
#pragma unroll 8
    for (int i = 0; i < 32; ++i) { const int kk = 2 * i + (lane >> 5); scr[kk * 33 + (lane & 31)] = nl < N ? W[(size_t)(k0 + kk) * N + nl] : 0.f; }
    LDS_WAIT(); asm volatile("" ::: "memory");
    const int c = lane & 7;
#pragma unroll
    for (int j = 0; j < 4; ++j) { const int n = (lane >> 3) + 8 * j; const LAS float* s = scr + (8 * c) * 33 + n;
        v4u o; o.x = pk2(s[0 * 33], s[1 * 33]); o.y = pk2(s[2 * 33], s[3 * 33]); o.z = pk2(s[4 * 33], s[5 * 33]); o.w = pk2(s[6 * 33], s[7 * 33]);
        const int ng = n0 + n; const int row = mode == 0 ? ng : (256 * (ng >> 7) + (ng & 127) + (mode == 2 ? 128 : 0));
        *(v4u*)(WT + (size_t)row * K + k0 + 8 * c) = o; }
    LDS_WAIT(); asm volatile("" ::: "memory");
}
DI void convert_weight(Frame& F, const float* W, int K, int N, bf16* WT, int mode) {
    LAS float* scr = (LAS float*)(F.lds + F.wave * 16384);
    const int nitems = (K / 64) * ((N + 31) / 32), NGW = F.G * NWAVES;
    for (int it = gwave(F); it < nitems; it += NGW) transpose_item(W, K, N, WT, mode, scr, it, F.lane);
}
DI void zero_fill(Frame& F, void* p, size_t bytes) {
    v4u* q = (v4u*)p; const size_t n = bytes / 16;
    for (size_t i = (size_t)F.bid * NTHR + F.tid; i < n; i += (size_t)F.G * NTHR) q[i] = (v4u){0u, 0u, 0u, 0u};
}

DI void build_rope(Frame& F) {
    float* rope = (float*)(F.ws + WS_ROPE);
    for (int i = F.bid * NTHR + F.tid; i < 4096 * 128; i += F.G * NTHR) { const int pos = i >> 7, d = i & 127;
        double inv = 1.0; { double r = 0.930572040929699; int e = d; while (e) { if (e & 1) inv *= r; r *= r; e >>= 1; } }
        const float ang = (float)pos * (float)inv;
        double s, c; sincos_d((double)ang, s, c);
        *(f32x2v*)(rope + 2 * (size_t)i) = (f32x2v){(float)c, (float)s}; }
}
DI void rms_rows_to_bf16(Frame& F, const float* src, const float* w, bf16* dst) {
    const int NGW = F.G * NWAVES;
    f32x4 wv[4];
#pragma unroll
    for (int j = 0; j < 4; ++j) wv[j] = ((const f32x4*)w)[F.lane + 64 * j];
    for (int m = gwave(F); m < M; m += NGW) { const f32x4* xr = (const f32x4*)(src + (size_t)m * D) + F.lane;
        f32x4 v[4]; float s = 0.f;
#pragma unroll
        for (int j = 0; j < 4; ++j) { v[j] = xr[64 * j]; s += (v[j].x * v[j].x + v[j].y * v[j].y) + (v[j].z * v[j].z + v[j].w * v[j].w); }
        const float rs = rsqrtf(wave_sum(s) * (1.f / D) + EPS);
        v2u* o8 = (v2u*)(dst + (size_t)m * D) + F.lane;
#pragma unroll
        for (int j = 0; j < 4; ++j) { const f32x4 y = v[j] * rs * wv[j]; o8[64 * j] = (v2u){pk2(y.x, y.y), pk2(y.z, y.w)}; } }
}
DI void row_phase(Frame& F, const float* mbuf, const float* hbase, float* hout, const float* w_post, const float* w_pre, bf16* hn) {
    const int NGW = F.G * NWAVES;
    f32x4 wp[4], wq[4];
#pragma unroll
    for (int j = 0; j < 4; ++j) { wp[j] = ((const f32x4*)w_post)[F.lane + 64 * j]; wq[j] = w_pre ? ((const f32x4*)w_pre)[F.lane + 64 * j] : (f32x4){0.f, 0.f, 0.f, 0.f}; }
    for (int m = gwave(F); m < M; m += NGW) {
        const f32x4* mr = (const f32x4*)(mbuf + (size_t)m * D) + F.lane; const f32x4* hr = (const f32x4*)(hbase + (size_t)m * D) + F.lane;
        f32x4 v[4], h[4]; float s = 0.f;
#pragma unroll
        for (int j = 0; j < 4; ++j) { v[j] = mr[64 * j]; h[j] = hr[64 * j]; s += (v[j].x * v[j].x + v[j].y * v[j].y) + (v[j].z * v[j].z + v[j].w * v[j].w); }
        const float rs = rsqrtf(wave_sum(s) * (1.f / D) + EPS); float s2 = 0.f;
        f32x4* ho = (f32x4*)(hout + (size_t)m * D) + F.lane;
#pragma unroll
        for (int j = 0; j < 4; ++j) { h[j] = h[j] + v[j] * rs * wp[j]; ho[64 * j] = h[j]; s2 += (h[j].x * h[j].x + h[j].y * h[j].y) + (h[j].z * h[j].z + h[j].w * h[j].w); }
        if (hn) { const float rs2 = rsqrtf(wave_sum(s2) * (1.f / D) + EPS);
            v2u* o8 = (v2u*)(hn + (size_t)m * D) + F.lane;
#pragma unroll
            for (int j = 0; j < 4; ++j) { const f32x4 y = h[j] * rs2 * wq[j]; o8[64 * j] = (v2u){pk2(y.x, y.y), pk2(y.z, y.w)}; } }
    }
}

DI float head_lg2(int h) { return __log2f(1.0f - exp2f(-5.0f - (float)h)); }

DI void ret_passA_unit(Frame& F, int unit) {
    const bf16* QKV = (const bf16*)(F.ws + WS_QKV); bf16* RST = (bf16*)(F.ws + WS_SLOT16);
    const int eh = unit & 1, sc = (unit >> 1) & 7, h = (unit >> 4) & 3, b = unit >> 6;
    const int lane = F.lane, w = F.wave, we = w >> 2, wd = w & 3;
    const float lg2 = head_lg2(h), g128 = exp2f(128.f * lg2), g127 = exp2f(127.f * lg2);
    LAS unsigned char* Kt = F.lds;
    LAS unsigned char* Vt = F.lds + 128 * 544;
    f32x4 acc[4][4];
#pragma unroll
    for (int a = 0; a < 4; ++a)
#pragma unroll
        for (int c = 0; c < 4; ++c) acc[a][c] = (f32x4){0.f, 0.f, 0.f, 0.f};
    for (int j = 0; j < 4; ++j) {
        if (j) {
#pragma unroll
            for (int a = 0; a < 4; ++a)
#pragma unroll
                for (int c = 0; c < 4; ++c) acc[a][c] *= g128; }
        const size_t row0 = (size_t)b * SEQ + sc * 512 + j * 128;
        __syncthreads();
        load_tile(Kt, 544, QKV + row0 * 3072 + 1024 + h * 256, 3072, 128, 256, F.tid);
        load_tile(Vt, 288, QKV + row0 * 3072 + 2048 + h * 256 + eh * 128, 3072, 128, 128, F.tid);
        __syncthreads();
#pragma unroll
        for (int ks = 0; ks < 4; ++ks) {
            bf16x8 vf[4], kf[4];
#pragma unroll
            for (int t = 0; t < 4; ++t) { vf[t] = frag_tr(Vt, 288, we * 64 + t * 16, ks * 32, lane); kf[t] = frag_tr(Kt, 544, wd * 64 + t * 16, ks * 32, lane); }
#pragma unroll
            for (int et = 0; et < 4; ++et)
#pragma unroll
                for (int dt = 0; dt < 4; ++dt) acc[et][dt] = mma(kf[dt], vf[et], acc[et][dt]);
        }
    }
    bf16* dst = RST + ((size_t)((b * 4 + h) * 8 + sc) * 256) * 256;
#pragma unroll
    for (int et = 0; et < 4; ++et)
#pragma unroll
        for (int dt = 0; dt < 4; ++dt) { const int e = eh * 128 + we * 64 + et * 16 + (lane & 15), d = wd * 64 + dt * 16 + 4 * (lane >> 4);
            const f32x4 v = acc[et][dt] * g127;
            *(v2u*)(dst + (size_t)e * 256 + d) = (v2u){pk2(v[0], v[1]), pk2(v[2], v[3])}; }
}

DI void ret_scan_item(Frame& F, int item) {
    bf16* RST = (bf16*)(F.ws + WS_SLOT16);
    const int bh = item >> 13, off = (item & 8191) * 8, h = bh & 3;
    const float g512 = exp2f(512.f * head_lg2(h));
    float run[8]; float zf = 0.f; asm volatile("" : "+v"(zf));
#pragma unroll
    for (int k = 0; k < 8; ++k) run[k] = zf;
    v4u cur = *(const v4u*)(RST + (size_t)(bh * 8) * 65536 + off);
    for (int sc = 0; sc < 8; ++sc) {
        v4u* p = (v4u*)(RST + (size_t)(bh * 8 + sc) * 65536 + off);
        v4u nxt = cur; if (sc < 7) nxt = *(const v4u*)(RST + (size_t)(bh * 8 + sc + 1) * 65536 + off);
        v4u o; o.x = pk2(run[0], run[1]); o.y = pk2(run[2], run[3]); o.z = pk2(run[4], run[5]); o.w = pk2(run[6], run[7]);
        *p = o;
        const unsigned cw[4] = {cur.x, cur.y, cur.z, cur.w};
#pragma unroll
        for (int k = 0; k < 4; ++k) { run[2 * k] = g512 * run[2 * k] + bflo(cw[k]); run[2 * k + 1] = g512 * run[2 * k + 1] + bfhi(cw[k]); }
        cur = nxt;
    }
}

DI void ret_passC_unit(Frame& F, int unit) {
    const bf16* QKV = (const bf16*)(F.ws + WS_QKV); const bf16* RST = (const bf16*)(F.ws + WS_SLOT16); bf16* GZ = (bf16*)(F.ws + WS_GZ);
    const int qp = unit & 1, sc = (unit >> 1) & 7, h = (unit >> 4) & 3, b = unit >> 6;
    const int lane = F.lane, w = F.wave, wn = w >> 2, we = w & 3, wm = w & 3;
    const float lg2 = head_lg2(h), g1 = exp2f(lg2), g128 = exp2f(128.f * lg2);
    LAS unsigned char* Qt = F.lds;
    LAS unsigned char* KV = F.lds + 33792;
    LAS unsigned char* Pt = F.lds + 33792 + 69632;
    LAS float* red = (LAS float*)(F.lds + 33792 + 69632 + 17408);
    const size_t rowsc = (size_t)b * SEQ + sc * 512;
    const bf16* Rbase = RST + (size_t)((b * 4 + h) * 8 + sc) * 65536;
    for (int qi = 0; qi < 2; ++qi) {
        const int i = qp == 0 ? (qi == 0 ? 0 : 3) : (qi == 0 ? 1 : 2);
        for (int hh = 0; hh < 2; ++hh) {
            const size_t grow0 = rowsc + i * 128 + hh * 64;
            f32x4 Y[2][4];
#pragma unroll
            for (int a = 0; a < 2; ++a)
#pragma unroll
                for (int c = 0; c < 4; ++c) Y[a][c] = (f32x4){0.f, 0.f, 0.f, 0.f};
            __syncthreads();
            load_tile(Qt, 528, QKV + grow0 * 3072 + h * 256, 3072, 64, 256, F.tid);
            for (int ds = 0; ds < 4; ++ds) {
                __syncthreads();
                load_tile(KV, 144, Rbase + ds * 64, 256, 256, 64, F.tid);
                __syncthreads();
#pragma unroll
                for (int ks = 0; ks < 2; ++ks) {
                    bf16x8 qf[2], rf[4];
#pragma unroll
                    for (int t = 0; t < 2; ++t) qf[t] = frag_rm(Qt, 528, wn * 32 + t * 16, ds * 64 + ks * 32, lane);
#pragma unroll
                    for (int t = 0; t < 4; ++t) rf[t] = frag_rm(KV, 144, we * 64 + t * 16, ks * 32, lane);
#pragma unroll
                    for (int nt = 0; nt < 2; ++nt)
#pragma unroll
                        for (int et = 0; et < 4; ++et) Y[nt][et] = mma(rf[et], qf[nt], Y[nt][et]);
                }
            }
#pragma unroll
            for (int a = 0; a < 2; ++a)
#pragma unroll
                for (int c = 0; c < 4; ++c) Y[a][c] *= g1;
            for (int j = 0; j <= i; ++j) {
                if (j) {
#pragma unroll
                    for (int a = 0; a < 2; ++a)
#pragma unroll
                        for (int c = 0; c < 4; ++c) Y[a][c] *= g128; }
                const size_t rowj = rowsc + j * 128;
                __syncthreads();
                load_tile(KV, 528, QKV + rowj * 3072 + 1024 + h * 256, 3072, 128, 256, F.tid);
                __syncthreads();
                f32x4 sa[2][2];
#pragma unroll
                for (int a = 0; a < 2; ++a)
#pragma unroll
                    for (int c = 0; c < 2; ++c) sa[a][c] = (f32x4){0.f, 0.f, 0.f, 0.f};
#pragma unroll
                for (int ks = 0; ks < 8; ++ks) {
                    bf16x8 qf[2], kf[2];
#pragma unroll
                    for (int t = 0; t < 2; ++t) { qf[t] = frag_rm(Qt, 528, wn * 32 + t * 16, ks * 32, lane); kf[t] = frag_rm(KV, 528, wm * 32 + t * 16, ks * 32, lane); }
#pragma unroll
                    for (int nt = 0; nt < 2; ++nt)
#pragma unroll
                        for (int mt = 0; mt < 2; ++mt) sa[nt][mt] = mma(kf[mt], qf[nt], sa[nt][mt]);
                }
#pragma unroll
                for (int nt = 0; nt < 2; ++nt)
#pragma unroll
                    for (int mt = 0; mt < 2; ++mt) { const int n = wn * 32 + nt * 16 + (lane & 15), m = wm * 32 + mt * 16 + 4 * (lane >> 4);
                        f32x4 s = sa[nt][mt];
                        if (j == i) { const int nb = hh * 64 + n;
#pragma unroll
                            for (int jj = 0; jj < 4; ++jj) if (m + jj > nb) s[jj] = 0.f; }
                        *(LAS v2u*)(Pt + n * 272 + m * 2) = (v2u){pk2(s[0], s[1]), pk2(s[2], s[3])}; }
                __syncthreads();
                load_tile(KV, 544, QKV + rowj * 3072 + 2048 + h * 256, 3072, 128, 256, F.tid);
                __syncthreads();
#pragma unroll
                for (int ks = 0; ks < 4; ++ks) {
                    bf16x8 pf[2], vf[4];
#pragma unroll
                    for (int t = 0; t < 2; ++t) pf[t] = frag_rm(Pt, 272, wn * 32 + t * 16, ks * 32, lane);
#pragma unroll
                    for (int t = 0; t < 4; ++t) vf[t] = frag_tr(KV, 544, we * 64 + t * 16, ks * 32, lane);
#pragma unroll
                    for (int nt = 0; nt < 2; ++nt)
#pragma unroll
                        for (int et = 0; et < 4; ++et) Y[nt][et] = mma(vf[et], pf[nt], Y[nt][et]);
                }
            }
            float mean[2], rstd[2];
#pragma unroll
            for (int nt = 0; nt < 2; ++nt) { float s = 0.f;
#pragma unroll
                for (int et = 0; et < 4; ++et) s += (Y[nt][et][0] + Y[nt][et][1]) + (Y[nt][et][2] + Y[nt][et][3]);
                s += __shfl_xor(s, 16); s += __shfl_xor(s, 32);
                if ((lane >> 4) == 0) red[(wn * 32 + nt * 16 + lane) * 4 + we] = s; }
            __syncthreads();
#pragma unroll
            for (int nt = 0; nt < 2; ++nt) { const LAS float* r = red + (wn * 32 + nt * 16 + (lane & 15)) * 4; mean[nt] = ((r[0] + r[1]) + (r[2] + r[3])) * (1.f / 256.f); }
            __syncthreads();
#pragma unroll
            for (int nt = 0; nt < 2; ++nt) { float s = 0.f;
#pragma unroll
                for (int et = 0; et < 4; ++et) { const f32x4 dv = Y[nt][et] - mean[nt]; s += (dv[0] * dv[0] + dv[1] * dv[1]) + (dv[2] * dv[2] + dv[3] * dv[3]); }
                s += __shfl_xor(s, 16); s += __shfl_xor(s, 32);
                if ((lane >> 4) == 0) red[(wn * 32 + nt * 16 + lane) * 4 + we] = s; }
            __syncthreads();
#pragma unroll
            for (int nt = 0; nt < 2; ++nt) { const LAS float* r = red + (wn * 32 + nt * 16 + (lane & 15)) * 4; rstd[nt] = rsqrtf(((r[0] + r[1]) + (r[2] + r[3])) * (1.f / 256.f) + EPS); }
#pragma unroll
            for (int nt = 0; nt < 2; ++nt)
#pragma unroll
                for (int et = 0; et < 4; ++et) { const int n = wn * 32 + nt * 16 + (lane & 15), e = we * 64 + et * 16 + 4 * (lane >> 4);
                    bf16* gp = GZ + (grow0 + n) * 2048 + h * 256 + e;
                    const v2u gv = *(const v2u*)gp;
                    const f32x4 y = (Y[nt][et] - mean[nt]) * rstd[nt];
                    const float o0 = y[0] * silu_f(bflo(gv.x)), o1 = y[1] * silu_f(bfhi(gv.x)), o2 = y[2] * silu_f(bflo(gv.y)), o3 = y[3] * silu_f(bfhi(gv.y));
                    *(v2u*)gp = (v2u){pk2(o0, o1), pk2(o2, o3)}; }
        }
    }
}

struct SsdPar { const float* conv_w; const float* conv_b; const float* a_log; const float* d_ssd; const float* ssd_norm; };

DI void conv8(const bf16* XBC, const float* cw, const float* cb, size_t row, int col, float (&o)[8]) {
    const int tin = (int)(row & 4095);
    { const f32x4 b0 = *(const f32x4*)(cb + col), b1 = *(const f32x4*)(cb + col + 4);
      o[0] = b0[0]; o[1] = b0[1]; o[2] = b0[2]; o[3] = b0[3]; o[4] = b1[0]; o[5] = b1[1]; o[6] = b1[2]; o[7] = b1[3]; }
#pragma unroll
    for (int k = 0; k < 4; ++k) {
        if (tin - 3 + k >= 0) {
            const v4u x = *(const v4u*)(XBC + (row - 3 + k) * 1536 + col);
            const f32x4 w0 = *(const f32x4*)(cw + k * 1536 + col), w1 = *(const f32x4*)(cw + k * 1536 + col + 4);
            o[0] += w0[0] * bflo(x.x); o[1] += w0[1] * bfhi(x.x); o[2] += w0[2] * bflo(x.y); o[3] += w0[3] * bfhi(x.y);
            o[4] += w1[0] * bflo(x.z); o[5] += w1[1] * bfhi(x.z); o[6] += w1[2] * bflo(x.w); o[7] += w1[3] * bfhi(x.w);
        }
    }
#pragma unroll
    for (int k = 0; k < 8; ++k) o[k] = silu_f(o[k]);
}
DI v4u pack8(const float (&o)[8], float s) { v4u r; r.x = pk2(o[0] * s, o[1] * s); r.y = pk2(o[2] * s, o[3] * s); r.z = pk2(o[4] * s, o[5] * s); r.w = pk2(o[6] * s, o[7] * s); return r; }

DI float ssd_cumsum(const float* DT, const float* a_log, size_t t0, int grp, int w, int lane, LAS float* cs) {
    const int head = grp * 8 + w; const float A = -__expf(a_log[head]);
    const float v0 = DT[(t0 + 2 * lane) * 16 + head] * A, v1 = DT[(t0 + 2 * lane + 1) * 16 + head] * A;
    float x = v0 + v1;
#pragma unroll
    for (int o = 1; o < 64; o <<= 1) { const float t = __shfl_up(x, o); if (lane >= o) x += t; }
    cs[w * 128 + 2 * lane] = x - v1; cs[w * 128 + 2 * lane + 1] = x;
    return __shfl(x, 63);
}

DI void ssd_passA_unit(Frame& F, const SsdPar& P, int unit) {
    const bf16* XBC = (const bf16*)(F.ws + WS_XBC); const float* DT = (const float*)(F.ws + WS_DT);
    bf16* ST = (bf16*)(F.ws + WS_SLOT32); float* CDEC = (float*)(F.ws + WS_MISC);
    const int grp = unit & 1, c = (unit >> 1) & 31, b = unit >> 6;
    const int lane = F.lane, w = F.wave;
    const size_t t0 = (size_t)b * SEQ + c * 128;
    LAS float* cs = (LAS float*)F.lds;
    LAS float* csend = (LAS float*)(F.lds + 4096);
    LAS unsigned char* Bt = F.lds + 4352;
    LAS unsigned char* Xw = F.lds + 4352 + 36864;
    __syncthreads();
    { const float tot = ssd_cumsum(DT, P.a_log, t0, grp, w, lane, cs);
      if (lane == 0) { csend[w] = tot; CDEC[(b * 32 + c) * 16 + grp * 8 + w] = __expf(tot); } }
#pragma unroll 1
    for (int it = 0; it < 4; ++it) { const int idx = F.tid + it * NTHR, r = idx >> 4, cc = idx & 15; float o[8];
        conv8(XBC, P.conv_w, P.conv_b, t0 + r, 1024 + grp * 128 + cc * 8, o);
        *(LAS v4u*)(Bt + r * 288 + cc * 16) = pack8(o, 1.0f); }
    for (int hg = 0; hg < 2; ++hg) {
        __syncthreads();
#pragma unroll 1
        for (int it = 0; it < 8; ++it) { const int idx = F.tid + it * NTHR, r = idx >> 5, cc = idx & 31, hd = hg * 4 + (cc >> 3); float o[8];
            conv8(XBC, P.conv_w, P.conv_b, t0 + r, grp * 512 + hg * 256 + cc * 8, o);
            const float sc = DT[(t0 + r) * 16 + grp * 8 + hd] * __expf(csend[hd] - cs[hd * 128 + r]);
            *(LAS v4u*)(Xw + r * 544 + cc * 16) = pack8(o, sc); }
        __syncthreads();
        const int hl = w >> 1, nh = w & 1;
        f32x4 acc[4][4];
#pragma unroll
        for (int a = 0; a < 4; ++a)
#pragma unroll
            for (int q = 0; q < 4; ++q) acc[a][q] = (f32x4){0.f, 0.f, 0.f, 0.f};
#pragma unroll
        for (int ks = 0; ks < 4; ++ks) {
            bf16x8 xf[4], bfr[4];
#pragma unroll
            for (int t = 0; t < 4; ++t) { xf[t] = frag_tr(Xw, 544, hl * 64 + t * 16, ks * 32, lane); bfr[t] = frag_tr(Bt, 288, nh * 64 + t * 16, ks * 32, lane); }
#pragma unroll
            for (int pt = 0; pt < 4; ++pt)
#pragma unroll
                for (int nt = 0; nt < 4; ++nt) acc[pt][nt] = mma(bfr[nt], xf[pt], acc[pt][nt]);
        }
        const int head = grp * 8 + hg * 4 + hl;
        bf16* dst = ST + (size_t)((b * 32 + c) * 16 + head) * 8192;
#pragma unroll
        for (int pt = 0; pt < 4; ++pt)
#pragma unroll
            for (int nt = 0; nt < 4; ++nt) { const int p = pt * 16 + (lane & 15), n = nh * 64 + nt * 16 + 4 * (lane >> 4); const f32x4 v = acc[pt][nt];
                *(v2u*)(dst + p * 128 + n) = (v2u){pk2(v[0], v[1]), pk2(v[2], v[3])}; }
    }
}

DI void ssd_scan_item(Frame& F, int item) {
    bf16* ST = (bf16*)(F.ws + WS_SLOT32); const float* CDEC = (const float*)(F.ws + WS_MISC);
    const int bh = item >> 10, b = bh >> 4, head = bh & 15, off = (item & 1023) * 8;
    float run[8]; float zf = 0.f; asm volatile("" : "+v"(zf));
#pragma unroll
    for (int k = 0; k < 8; ++k) run[k] = zf;
    v4u cur = *(const v4u*)(ST + (size_t)((b * 32) * 16 + head) * 8192 + off);
    for (int c = 0; c < 32; ++c) {
        v4u* p = (v4u*)(ST + (size_t)((b * 32 + c) * 16 + head) * 8192 + off);
        v4u nxt = cur; if (c < 31) nxt = *(const v4u*)(ST + (size_t)((b * 32 + c + 1) * 16 + head) * 8192 + off);
        const float dec = CDEC[(b * 32 + c) * 16 + head];
        v4u o; o.x = pk2(run[0], run[1]); o.y = pk2(run[2], run[3]); o.z = pk2(run[4], run[5]); o.w = pk2(run[6], run[7]);
        *p = o;
        const unsigned cw[4] = {cur.x, cur.y, cur.z, cur.w};
#pragma unroll
        for (int k = 0; k < 4; ++k) { run[2 * k] = dec * run[2 * k] + bflo(cw[k]); run[2 * k + 1] = dec * run[2 * k + 1] + bfhi(cw[k]); }
        cur = nxt;
    }
}

DI void ssd_passC_unit(Frame& F, const SsdPar& P, int unit) {
    const bf16* XBC = (const bf16*)(F.ws + WS_XBC); const float* DT = (const float*)(F.ws + WS_DT);
    const bf16* ST = (const bf16*)(F.ws + WS_SLOT32); bf16* GZ = (bf16*)(F.ws + WS_GZ);
    const int grp = unit & 1, c = (unit >> 1) & 31, b = unit >> 6;
    const int lane = F.lane, w = F.wave;
    const size_t t0 = (size_t)b * SEQ + c * 128;
    LAS float* cs = (LAS float*)F.lds;
    LAS float* rowss = (LAS float*)(F.lds + 132608);
    LAS unsigned char* Ct = F.lds + 4608;
    LAS unsigned char* BM = F.lds + 4608 + 34816;
    LAS unsigned char* Xd = F.lds + 74240;
    LAS unsigned char* Xr = F.lds + 94720;
    LAS unsigned char* Pv = F.lds + 115200;
    __syncthreads();
    (void)ssd_cumsum(DT, P.a_log, t0, grp, w, lane, cs);
#pragma unroll 1
    for (int it = 0; it < 8; ++it) { const int idx = F.tid + it * NTHR, which = idx >> 11, r = (idx >> 4) & 127, cc = idx & 15; float o[8];
        conv8(XBC, P.conv_w, P.conv_b, t0 + r, 1024 + which * 256 + grp * 128 + cc * 8, o);
        *(LAS v4u*)((which ? Ct : BM) + r * 272 + cc * 16) = pack8(o, 1.0f); }
    __syncthreads();
    const int wl = w >> 1, ws = w & 1, wp = w & 1;
    f32x4 cb[2][4];
#pragma unroll
    for (int a = 0; a < 2; ++a)
#pragma unroll
        for (int q = 0; q < 4; ++q) cb[a][q] = (f32x4){0.f, 0.f, 0.f, 0.f};
#pragma unroll
    for (int ks = 0; ks < 4; ++ks) {
        bf16x8 cf[2], bfr[4];
#pragma unroll
        for (int t = 0; t < 2; ++t) cf[t] = frag_rm(Ct, 272, wl * 32 + t * 16, ks * 32, lane);
#pragma unroll
        for (int t = 0; t < 4; ++t) bfr[t] = frag_rm(BM, 272, ws * 64 + t * 16, ks * 32, lane);
#pragma unroll
        for (int lt = 0; lt < 2; ++lt)
#pragma unroll
            for (int st = 0; st < 4; ++st) cb[lt][st] = mma(bfr[st], cf[lt], cb[lt][st]);
    }
#pragma unroll 1
    for (int pass = 0; pass < 2; ++pass) {
#pragma unroll 1
        for (int hd = 0; hd < 8; ++hd) {
            const int head = grp * 8 + hd;
            __syncthreads();
#pragma unroll
            for (int lt = 0; lt < 2; ++lt) { const int l = wl * 32 + lt * 16 + (lane & 15); const float csl = cs[hd * 128 + l];
#pragma unroll
                for (int st = 0; st < 4; ++st) { const int s = ws * 64 + st * 16 + 4 * (lane >> 4); f32x4 m;
#pragma unroll
                    for (int jj = 0; jj < 4; ++jj) m[jj] = (s + jj <= l) ? cb[lt][st][jj] * __expf(csl - cs[hd * 128 + s + jj]) : 0.f;
                    *(LAS v2u*)(BM + l * 272 + s * 2) = (v2u){pk2(m[0], m[1]), pk2(m[2], m[3])}; } }
#pragma unroll 1
            for (int it = 0; it < 2; ++it) { const int idx = F.tid + it * NTHR, r = idx >> 3, cc = idx & 7; float o[8];
                conv8(XBC, P.conv_w, P.conv_b, t0 + r, grp * 512 + hd * 64 + cc * 8, o);
                *(LAS v4u*)(Xr + r * 160 + cc * 16) = pack8(o, 1.0f);
                *(LAS v4u*)(Xd + r * 160 + cc * 16) = pack8(o, DT[(t0 + r) * 16 + head]); }
            load_tile(Pv, 272, ST + (size_t)((b * 32 + c) * 16 + head) * 8192, 128, 64, 128, F.tid);
            __syncthreads();
            f32x4 yd[2][2], yo[2][2];
#pragma unroll
            for (int a = 0; a < 2; ++a)
#pragma unroll
                for (int q = 0; q < 2; ++q) { yd[a][q] = (f32x4){0.f, 0.f, 0.f, 0.f}; yo[a][q] = (f32x4){0.f, 0.f, 0.f, 0.f}; }
#pragma unroll
            for (int ks = 0; ks < 4; ++ks) {
                bf16x8 mf[2], xf[2], cf[2], pf[2];
#pragma unroll
                for (int t = 0; t < 2; ++t) { mf[t] = frag_rm(BM, 272, wl * 32 + t * 16, ks * 32, lane); xf[t] = frag_tr(Xd, 160, wp * 32 + t * 16, ks * 32, lane);
                                              cf[t] = frag_rm(Ct, 272, wl * 32 + t * 16, ks * 32, lane); pf[t] = frag_rm(Pv, 272, wp * 32 + t * 16, ks * 32, lane); }
#pragma unroll
                for (int lt = 0; lt < 2; ++lt)
#pragma unroll
                    for (int pt = 0; pt < 2; ++pt) { yd[lt][pt] = mma(xf[pt], mf[lt], yd[lt][pt]); yo[lt][pt] = mma(pf[pt], cf[lt], yo[lt][pt]); }
            }
            const float dsk = P.d_ssd[head];
#pragma unroll
            for (int lt = 0; lt < 2; ++lt) { const int l = wl * 32 + lt * 16 + (lane & 15); const float ecs = __expf(cs[hd * 128 + l]); float ss = 0.f;
                float rs = 0.f;
                if (pass) { float t = 0.f;
#pragma unroll
                    for (int q = 0; q < 16; ++q) t += rowss[q * 128 + l];
                    rs = rsqrtf(t * (1.f / 512.f) + EPS); }
#pragma unroll
                for (int pt = 0; pt < 2; ++pt) { const int p = wp * 32 + pt * 16 + 4 * (lane >> 4);
                    const v2u xr = *(const LAS v2u*)(Xr + l * 160 + p * 2);
                    bf16* zp = GZ + (t0 + l) * 2048 + 1024 + head * 64 + p;
                    const v2u zv = *(const v2u*)zp;
                    f32x4 y = yd[lt][pt] + ecs * yo[lt][pt];
                    y[0] = (y[0] + dsk * bflo(xr.x)) * silu_f(bflo(zv.x)); y[1] = (y[1] + dsk * bfhi(xr.x)) * silu_f(bfhi(zv.x));
                    y[2] = (y[2] + dsk * bflo(xr.y)) * silu_f(bflo(zv.y)); y[3] = (y[3] + dsk * bfhi(xr.y)) * silu_f(bfhi(zv.y));
                    if (pass == 0) ss += (y[0] * y[0] + y[1] * y[1]) + (y[2] * y[2] + y[3] * y[3]);
                    else { const f32x4 nw = *(const f32x4*)(P.ssd_norm + head * 64 + p); y = y * rs * nw;
                        *(v2u*)zp = (v2u){pk2(y[0], y[1]), pk2(y[2], y[3])}; } }
                if (pass == 0) { ss += __shfl_xor(ss, 16); ss += __shfl_xor(ss, 32);
                    if ((lane >> 4) == 0) rowss[(hd * 2 + wp) * 128 + l] = ss; } }
        }
    }
}

struct S5Par { const float* lam_re; const float* lam_im; const float* log_step; const float* b_re; const float* b_im; const float* c_re; const float* c_im; const float* d_s5; };

DI void s5_build_unit(Frame& F, const S5Par& P, int g) {
    bf16* AB = (bf16*)(F.ws + WS_S5MAT + (size_t)g * 262144); bf16* E = AB + 256 * 384;
    f32x2v* AT16 = (f32x2v*)(F.ws + WS_MISC + 65536);
    LAS f32x2v* pw = (LAS f32x2v*)F.lds;
    LAS f32x2v* Bb = (LAS f32x2v*)(F.lds + 8704);
    LAS f32x2v* Cc = (LAS f32x2v*)(F.lds + 16896);
    LAS float* Km = (LAS float*)(F.lds + 25088);
    __syncthreads();
    if (F.tid < 64) { const int p = F.tid;
        const double lr = fmin((double)P.lam_re[g * 64 + p], -1e-4), li = (double)P.lam_im[g * 64 + p], dl = (double)expf(P.log_step[g]);
        double a1r = 0, a1i = 0;
        for (int t = 0; t <= 16; ++t) { const double mag = (double)expf((float)(t * lr * dl)); double s, c; sincos_d(t * li * dl, s, c);
            pw[t * 64 + p] = (f32x2v){(float)(mag * c), (float)(mag * s)}; if (t == 1) { a1r = mag * c; a1i = mag * s; } }
        AT16[g * 64 + p] = pw[16 * 64 + p];
        const double den = lr * lr + li * li, nr = a1r - 1.0, ni = a1i, cr = (nr * lr + ni * li) / den, ci = (ni * lr - nr * li) / den;
        for (int c2 = 0; c2 < 16; ++c2) { const double br = P.b_re[(g * 64 + p) * 16 + c2], bi = P.b_im[(g * 64 + p) * 16 + c2];
            Bb[p * 16 + c2] = (f32x2v){(float)(cr * br - ci * bi), (float)(cr * bi + ci * br)}; } }
    for (int i = F.tid; i < 1024; i += NTHR) Cc[i] = (f32x2v){P.c_re[g * 1024 + i], P.c_im[g * 1024 + i]};
    __syncthreads();
    for (int i = F.tid; i < 4096; i += NTHR) { const int t = i >> 8, c = (i >> 4) & 15, c2 = i & 15; float acc = 0.f;
        for (int p = 0; p < 64; ++p) { const f32x2v cc = Cc[c * 64 + p], a = pw[t * 64 + p], bb = Bb[p * 16 + c2];
            const float tr = cc.x * a.x - cc.y * a.y, ti = cc.x * a.y + cc.y * a.x; acc += tr * bb.x - ti * bb.y; }
        Km[i] = acc; }
    __syncthreads();
    for (int i = F.tid; i < 256 * 48; i += NTHR) { const int row = i / 48, c8 = (i % 48) * 8, l = row >> 4, c = row & 15; float v[8];
        if (c8 < 256) { const int s = c8 >> 4, c2 = c8 & 15;
#pragma unroll
            for (int k = 0; k < 8; ++k) v[k] = s <= l ? Km[((l - s) * 16 + c) * 16 + c2 + k] : 0.f;
        } else { const bool im = c8 >= 320; const int p0 = c8 - (im ? 320 : 256);
#pragma unroll
            for (int k = 0; k < 8; ++k) { const f32x2v cc = Cc[c * 64 + p0 + k], a = pw[(l + 1) * 64 + p0 + k];
                v[k] = im ? -(cc.x * a.y + cc.y * a.x) : (cc.x * a.x - cc.y * a.y); } }
        *(v4u*)(AB + (size_t)row * 384 + c8) = (v4u){pk2(v[0], v[1]), pk2(v[2], v[3]), pk2(v[4], v[5]), pk2(v[6], v[7])}; }
    for (int i = F.tid; i < 128 * 32; i += NTHR) { const int row = i >> 5, c8 = (i & 31) * 8, p = row & 63, s = c8 >> 4, c2 = c8 & 15; const bool im = row >= 64; float v[8];
        const f32x2v a = pw[(15 - s) * 64 + p];
#pragma unroll
        for (int k = 0; k < 8; ++k) { const f32x2v bb = Bb[p * 16 + c2 + k]; v[k] = im ? (a.x * bb.y + a.y * bb.x) : (a.x * bb.x - a.y * bb.y); }
        *(v4u*)(E + (size_t)row * 256 + c8) = (v4u){pk2(v[0], v[1]), pk2(v[2], v[3]), pk2(v[4], v[5]), pk2(v[6], v[7])}; }
}

DI void s5_gemmA_unit(Frame& F, int unit) {
    const bf16* HN = (const bf16*)(F.ws + WS_SLOT32); float* EO = (float*)(F.ws + WS_S5E);
    const int g8 = unit & 7, tb = (unit >> 3) & 15, b = unit >> 7, lane = F.lane, w = F.wave, g = g8 * 8 + w, i = lane & 15, gq = lane >> 4;
    const bf16* E = (const bf16*)(F.ws + WS_S5MAT + (size_t)g * 262144) + 256 * 384;
    LAS unsigned char* T = F.lds;
    __syncthreads();
    load_tile(T, 272, HN + ((size_t)b * SEQ + tb * 256) * D + g8 * 128, D, 256, 128, F.tid);
    __syncthreads();
    f32x4 acc[8];
#pragma unroll
    for (int m = 0; m < 8; ++m) acc[m] = (f32x4){0.f, 0.f, 0.f, 0.f};
#pragma unroll 2
    for (int ks = 0; ks < 8; ++ks) {
        const bf16x8 uf = *(const LAS bf16x8*)(T + (16 * i + 2 * ks + (gq >> 1)) * 272 + (16 * w + 8 * (gq & 1)) * 2);
#pragma unroll
        for (int mt = 0; mt < 8; ++mt) { const bf16x8 ef = *(const bf16x8*)(E + (mt * 16 + i) * 256 + 32 * ks + 8 * gq);
            acc[mt] = mma(ef, uf, acc[mt]); }
    }
    float* dst = EO + ((size_t)((b * 256 + tb * 16 + i) * 64 + g)) * 128 + 4 * gq;
#pragma unroll
    for (int mt = 0; mt < 8; ++mt) *(f32x4*)(dst + mt * 16) = acc[mt];
}

DI void s5_scan_task(Frame& F, const float* lam_re, const float* lam_im, const float* log_step, int task, int dbg) {
    const float* EO = (const float*)(F.ws + WS_S5E); bf16* XO = (bf16*)(F.ws + WS_S5X);
    const int b = task >> 6, g = task & 63, p = F.lane;
    f32x2v a;
    { const double lr = fmin((double)lam_re[g * 64 + p], -1e-4), li = (double)lam_im[g * 64 + p], dl = (double)expf(log_step[g]);
      const double mag = (double)expf((float)(16.0 * lr * dl)); double s, c; sincos_d(16.0 * li * dl, s, c); a = (f32x2v){(float)(mag * c), (float)(mag * s)}; }
    if (dbg == 6) a = (f32x2v){0.f, 0.f};
    float rr = 0.f, ri = 0.f;
#pragma unroll 8
    for (int k = 0; k < 256; ++k) { const size_t o = ((size_t)((b * 256 + k) * 64 + g)) * 128;
        const float er = EO[o + p], ei = EO[o + 64 + p];
        XO[o + p] = (bf16)f2bf(rr); XO[o + 64 + p] = (bf16)f2bf(ri);
        const float nr = a.x * rr - a.y * ri + er, ni = a.x * ri + a.y * rr + ei; rr = nr; ri = ni; }
}

DI float gelu_tanh(float v) { const float u = 0.7978845608028654f * (v + 0.044715f * v * v * v); const float t = 1.0f - 2.0f / (__expf(2.0f * u) + 1.0f); return 0.5f * v * (1.0f + t); }

DI void s5_gemmB_unit(Frame& F, const float* d_s5, int unit, int dbg) {
    const bf16* HN = (const bf16*)(F.ws + WS_SLOT32); const bf16* XO = (const bf16*)(F.ws + WS_S5X); bf16* Y = (bf16*)(F.ws + WS_Y);
    const int g8 = unit & 7, tb = (unit >> 3) & 15, b = unit >> 7, lane = F.lane, w = F.wave, g = g8 * 8 + w, i = lane & 15, gq = lane >> 4;
    const bf16* AB = (const bf16*)(F.ws + WS_S5MAT + (size_t)g * 262144);
    LAS unsigned char* T = F.lds;
    __syncthreads();
    load_tile(T, 272, HN + ((size_t)b * SEQ + tb * 256) * D + g8 * 128, D, 256, 128, F.tid);
    __syncthreads();
    f32x4 acc[16];
#pragma unroll
    for (int m = 0; m < 16; ++m) acc[m] = (f32x4){0.f, 0.f, 0.f, 0.f};
    const bf16* xrow = XO + ((size_t)((b * 256 + tb * 16 + i) * 64 + g)) * 128 + 8 * gq;
#pragma unroll 2
    for (int ks = 0; ks < 12; ++ks) {
        bf16x8 uf;
        if (ks < 8) uf = *(const LAS bf16x8*)(T + (16 * i + 2 * ks + (gq >> 1)) * 272 + (16 * w + 8 * (gq & 1)) * 2);
        else { uf = *(const bf16x8*)(xrow + (ks - 8) * 32); if (dbg == 5) uf = (bf16x8){0, 0, 0, 0, 0, 0, 0, 0}; }
#pragma unroll
        for (int mt = 0; mt < 16; ++mt) { const bf16x8 af = *(const bf16x8*)(AB + (mt * 16 + i) * 384 + 32 * ks + 8 * gq);
            acc[mt] = mma(af, uf, acc[mt]); }
    }
    const int colg = g8 * 128 + 16 * w + 4 * gq;
    const f32x4 dv = *(const f32x4*)(d_s5 + colg);
#pragma unroll
    for (int mt = 0; mt < 16; ++mt) { const int tl = 16 * i + mt;
        const v2u hv = *(const LAS v2u*)(T + tl * 272 + (16 * w + 4 * gq) * 2);
        const float y0 = gelu_tanh(acc[mt][0] + dv[0] * bflo(hv.x)), y1 = gelu_tanh(acc[mt][1] + dv[1] * bfhi(hv.x));
        const float y2 = gelu_tanh(acc[mt][2] + dv[2] * bflo(hv.y)), y3 = gelu_tanh(acc[mt][3] + dv[3] * bfhi(hv.y));
        *(v2u*)(Y + ((size_t)b * SEQ + tb * 256 + tl) * D + colg) = (v2u){pk2(y0, y1), pk2(y2, y3)}; }
}

#ifndef SKIP_EVEN
#define SKIP_EVEN 0
#endif
#ifndef SKIP_ODD
#define SKIP_ODD 0
#endif
DI int opq(int v) { asm volatile("" : "+s"(v)); return v; }
struct Args { const float* in[N_IN]; float* out; unsigned char* ws; };
constexpr int CW_BAR = 1024;

__global__ void __launch_bounds__(NTHR, 2) trunk_fwd(Args args) {
    extern __shared__ __attribute__((aligned(16))) unsigned char lds[];
    Frame F;
    F.lds = (LAS unsigned char*)lds;
    F.G = gridDim.x; F.bid = blockIdx.x;
    { const int t = threadIdx.x;
      for (int u = t; u < (LDS_BYTES - MISC_OFF) / 4; u += NTHR) ((LAS unsigned*)(F.lds + MISC_OFF))[u] = 0u;
      __syncthreads();
      if (t < N_IN + 2) ((LAS unsigned long long*)(F.lds + MISC_OFF + 256))[t] = t < N_IN ? (unsigned long long)args.in[t] : (t == N_IN ? (unsigned long long)args.out : (unsigned long long)args.ws);
      __syncthreads(); }
    const int wave0 = __builtin_amdgcn_readfirstlane(threadIdx.x >> 6);
#define PHASE() do { unsigned z_ = 0u; asm volatile("" : "+s"(z_)); int l_ = __builtin_amdgcn_mbcnt_hi(~0u, __builtin_amdgcn_mbcnt_lo(~0u, z_)); int w_ = wave0; asm volatile("" : "+s"(w_)); \
        int g_ = gridDim.x, b_ = blockIdx.x; asm volatile("" : "+s"(g_), "+s"(b_)); F.G = g_; F.bid = b_; F.lane = l_; F.wave = w_; F.tid = w_ * 64 + l_; F.out = (float*)(GAS float*)lds_ptr(F, N_IN); F.ws = (unsigned char*)(GAS unsigned char*)lds_ptr(F, N_IN + 1); } while (0)
#define WSP(T, off) ((T*)(F.ws + (off)))
#define GRID_BAR() do { XcdBarrier xb_; xb_.bar = (unsigned*)(F.ws + WS_CTL) + CW_BAR; xb_.x = xb_xcc_id(); xb_.tid = F.tid; xb_.st = (volatile LAS unsigned*)(F.lds + MISC_OFF) + 8; xcd_barrier(xb_); PHASE(); } while (0)
    PHASE();
    (void)xcd_barrier_post((unsigned*)(F.ws + WS_CTL) + CW_BAR, (volatile LAS unsigned*)(F.lds + MISC_OFF) + 8);

    build_rope(F);
    convert_weight(F, INP(I_W_IN), D, INP, WSP(bf16, WS_SLOT16), 0);
    zero_fill(F, WSP(bf16, WS_SLOT16) + (size_t)6688 * D, (size_t)(INP_PAD - 6688) * D * 2);
    convert_weight(F, INP(I_W_OUT), 2048, D, WSP(bf16, WS_W4), 0);
    rms_rows_to_bf16(F, INP(I_X), INP(I_PRE_MIX), WSP(bf16, WS_SLOT32));
    GRID_BAR();

#pragma unroll 1
    for (int layer = 0; layer < DEPTH; ++layer) {
        const int j = layer >> 1;
        if ((layer & 1) == 0) {
            if (!opq(SKIP_EVEN)) {
            { pg8::Gemm g{WSP(bf16, WS_SLOT32), WSP(bf16, WS_SLOT16), M, INP_PAD, D}; pg8::StaticOrder S; S.init(M, INP_PAD, F.G, F.bid);
              pg8::EpiInProj E{WSP(bf16, WS_QKV), WSP(bf16, WS_GZ), WSP(bf16, WS_XBC), WSP(float, WS_DT), (const float*)(F.ws + WS_ROPE), INP(I_DT_BIAS) + j * 16};
              pg8::gemm_phase<pg8::EpiInProj, pg8::StaticOrder, true, true>(F.lds, g, S, E, F.tid); }
            GRID_BAR();
            for (int u = F.bid; u < 256; u += F.G) ret_passA_unit(F, u);
            { const SsdPar SP{INP(I_CONV_W) + (size_t)j * 4 * 1536, INP(I_CONV_B) + j * 1536, INP(I_A_LOG) + j * 16, INP(I_D_SSD) + j * 16, INP(I_SSD_NORM) + j * 1024};
              for (int u = F.bid; u < 256; u += F.G) ssd_passA_unit(F, SP, u); }
            GRID_BAR();
            for (int it = (F.bid * NTHR + F.tid); it < 131072; it += (F.G * NTHR)) ret_scan_item(F, it);
            for (int it = (F.bid * NTHR + F.tid); it < 65536; it += (F.G * NTHR)) ssd_scan_item(F, it);
            GRID_BAR();
            for (int u = F.bid; u < 256; u += F.G) ret_passC_unit(F, u);
            { const SsdPar SP{INP(I_CONV_W) + (size_t)j * 4 * 1536, INP(I_CONV_B) + j * 1536, INP(I_A_LOG) + j * 16, INP(I_D_SSD) + j * 16, INP(I_SSD_NORM) + j * 1024};
              for (int u = F.bid; u < 256; u += F.G) ssd_passC_unit(F, SP, u); }
            GRID_BAR();
            }
            __syncthreads();
            convert_weight(F, INP(I_W_UP) + (size_t)layer * D * FF, D, FF, WSP(bf16, WS_SLOT16), 0);
            convert_weight(F, INP(I_W_DOWN) + (size_t)layer * FF * D, FF, D, WSP(bf16, WS_SLOT16) + (size_t)FF * D, 0);
            __syncthreads();
            if (!opq(SKIP_EVEN)) {
            { pg8::Gemm g{WSP(bf16, WS_GZ), WSP(bf16, WS_W4), M, D, 2048}; pg8::StaticOrder S; S.init(M, D, F.G, F.bid);
              pg8::EpiF32 E{WSP(float, WS_M32A), D};
              pg8::gemm_phase<pg8::EpiF32, pg8::StaticOrder, true, true>(F.lds, g, S, E, F.tid); }
            } else zero_fill(F, WSP(float, WS_M32A), (size_t)M * D * 4);
            GRID_BAR();
            row_phase(F, WSP(float, WS_M32A), (layer == 0 ? INP(I_X) : (const float*)F.out), F.out, INP(I_POST_MIX) + layer * D, INP(I_PRE_MLP) + layer * D, WSP(bf16, WS_SLOT32));
            GRID_BAR();
        } else {
            if (opq(SKIP_ODD) == 2) {
                const v4u* s_ = (const v4u*)WSP(bf16, WS_SLOT32); v4u* d_ = (v4u*)WSP(bf16, WS_Y);
                for (size_t i_ = (size_t)F.bid * NTHR + F.tid; i_ < (size_t)M * D / 8; i_ += (size_t)F.G * NTHR) d_[i_] = s_[i_];
                GRID_BAR();
            }
            if (opq(SKIP_ODD) == 0 || opq(SKIP_ODD) >= 3) {
            for (int u = F.bid; u < 512; u += F.G) s5_gemmA_unit(F, u);
            GRID_BAR();
            if (opq(SKIP_ODD) == 3) zero_fill(F, WSP(bf16, WS_S5X), (size_t)16 * MiB);
            else if (F.wave == 0) for (int t = F.bid; t < 256; t += F.G) s5_scan_task(F, INP(I_LAM_RE) + j * 4096, INP(I_LAM_IM) + j * 4096, INP(I_LOG_STEP) + j * 64, t, opq(SKIP_ODD));
            GRID_BAR();
            for (int u = F.bid; u < 512; u += F.G) s5_gemmB_unit(F, INP(I_D_S5) + j * 1024, u, opq(SKIP_ODD));
            GRID_BAR();
            }
            __syncthreads();
            convert_weight(F, INP(I_W_UP) + (size_t)layer * D * FF, D, FF, WSP(bf16, WS_SLOT16), 0);
            convert_weight(F, INP(I_W_DOWN) + (size_t)layer * FF * D, FF, D, WSP(bf16, WS_SLOT16) + (size_t)FF * D, 0);
            __syncthreads();
            if (opq(SKIP_ODD) != 1) {
            { pg8::Gemm g{WSP(bf16, WS_Y), WSP(bf16, WS_W4), M, 2048, D}; pg8::StaticOrder S; S.init(M, 2048, F.G, F.bid);
              pg8::EpiGlu E{WSP(float, WS_M32B), D};
              pg8::gemm_phase<pg8::EpiGlu, pg8::StaticOrder, true, true>(F.lds, g, S, E, F.tid); }
            } else zero_fill(F, WSP(float, WS_M32B), (size_t)M * D * 4);
            GRID_BAR();
            row_phase(F, WSP(float, WS_M32B), (layer == 0 ? INP(I_X) : (const float*)F.out), F.out, INP(I_POST_MIX) + layer * D, INP(I_PRE_MLP) + layer * D, WSP(bf16, WS_SLOT32));
            GRID_BAR();
        }
        { pg8::Gemm g{WSP(bf16, WS_SLOT32), WSP(bf16, WS_SLOT16), M, FF, D}; pg8::StaticOrder S; S.init(M, FF, F.G, F.bid);
          pg8::EpiRelu2 E{WSP(bf16, WS_U), FF};
          pg8::gemm_phase<pg8::EpiRelu2, pg8::StaticOrder, true, true>(F.lds, g, S, E, F.tid); }
        GRID_BAR();
        __syncthreads();
        if ((layer & 1) == 0) { convert_weight(F, INP(I_W_GLU_A) + (size_t)j * D * D, D, D, WSP(bf16, WS_W4), 1); convert_weight(F, INP(I_W_GLU_B) + (size_t)j * D * D, D, D, WSP(bf16, WS_W4), 2); }
        __syncthreads();
        { pg8::Gemm g{WSP(bf16, WS_U), WSP(bf16, WS_SLOT16) + (size_t)FF * D, M, D, FF}; pg8::StaticOrder S; S.init(M, D, F.G, F.bid);
          pg8::EpiF32 E{WSP(float, WS_M32B), D};
          pg8::gemm_phase<pg8::EpiF32, pg8::StaticOrder, true, true>(F.lds, g, S, E, F.tid); }
        GRID_BAR();
        row_phase(F, WSP(float, WS_M32B), F.out, F.out, INP(I_POST_MLP) + layer * D, layer < DEPTH - 1 ? INP(I_PRE_MIX) + (layer + 1) * D : nullptr, layer < DEPTH - 1 ? WSP(bf16, WS_SLOT32) : nullptr);
        if (layer == 0 || layer == 2) {
            const S5Par P5{INP(I_LAM_RE) + j * 4096, INP(I_LAM_IM) + j * 4096, INP(I_LOG_STEP) + j * 64, INP(I_B_RE) + (size_t)j * 65536, INP(I_B_IM) + (size_t)j * 65536,
                           INP(I_C_RE) + (size_t)j * 65536, INP(I_C_IM) + (size_t)j * 65536, INP(I_D_S5) + j * 1024};
            for (int g = F.bid; g < 64; g += F.G) s5_build_unit(F, P5, g);
        } else if (layer == 1) {
            __syncthreads();
            convert_weight(F, INP(I_W_IN) + (size_t)D * INP, D, INP, WSP(bf16, WS_SLOT16), 0);
            zero_fill(F, WSP(bf16, WS_SLOT16) + (size_t)6688 * D, (size_t)(INP_PAD - 6688) * D * 2);
            convert_weight(F, INP(I_W_OUT) + (size_t)2048 * D, 2048, D, WSP(bf16, WS_W4), 0);
        }
        if (layer < DEPTH - 1) GRID_BAR();
    }
}

extern "C" void kernel_launch(void* const* d_in, const int* in_sizes, int n_in, void* d_out, int out_size, void* d_ws, size_t ws_size, hipStream_t stream) {
    static int grid = 0;
    if (grid == 0) {
        if (n_in != N_IN || out_size != M * D || ws_size < WS_END) { fprintf(stderr, "kernel_launch: unexpected shapes (n_in %d, out %d, ws %zu)\n", n_in, out_size, ws_size); grid = -1; return; }
        int dev = 0, cus = 0, per_cu = 0;
        if (hipGetDevice(&dev) != hipSuccess || hipDeviceGetAttribute(&cus, hipDeviceAttributeMultiprocessorCount, dev) != hipSuccess) { grid = -1; return; }
        if (hipFuncSetAttribute((const void*)trunk_fwd, hipFuncAttributeMaxDynamicSharedMemorySize, LDS_BYTES) != hipSuccess) { fprintf(stderr, "kernel_launch: hipFuncSetAttribute failed\n"); grid = -1; return; }
        if (hipOccupancyMaxActiveBlocksPerMultiprocessor(&per_cu, (const void*)trunk_fwd, NTHR, LDS_BYTES) != hipSuccess || per_cu < 1)
            fprintf(stderr, "kernel_launch: note: occupancy query reports %d workgroups per CU\n", per_cu);
        (void)hipGetLastError();
        grid = cus;
    }
    if (grid < 0) return;
    if (hipMemsetAsync((char*)d_ws + WS_CTL, 0, CTL_ZERO_BYTES, stream) != hipSuccess) return;
#ifdef DBG_ZERO_MISC
    if (hipMemsetAsync((char*)d_ws + WS_MISC, 0, 512 * 1024, stream) != hipSuccess) return;
#endif
    Args a{};
    for (int i = 0; i < N_IN; ++i) a.in[i] = (const float*)d_in[i];
    a.out = (float*)d_out; a.ws = (unsigned char*)d_ws;
    hipLaunchKernelGGL(trunk_fwd, dim3(grid), dim3(NTHR), LDS_BYTES, stream, a);
}
```

```cpp
#include <hip/hip_runtime.h>
#include <cstdio>
#include <cstdint>
namespace pg8 {
#define PG8_LAS __attribute__((address_space(3)))
typedef unsigned short bf16_t;
typedef short bf16x8 __attribute__((ext_vector_type(8)));
typedef float f32x4 __attribute__((ext_vector_type(4)));
typedef unsigned u32x4 __attribute__((ext_vector_type(4)));
constexpr int BM = 256, BK = 64, HALF = 128, HTB = HALF * BK * 2  , STAGE_BYTES = 8 * HTB, NXCD = 8, WGM = 8;

__host__ __device__ __forceinline__ int lds_byte(int r, int c) { const int st = (r >> 4) * 2 + (c >> 5), rr = r & 15, cc = c & 31, ob = rr * 64 + cc * 2; return st * 1024 + (ob ^ (((ob >> 9) & 1) << 5)); }
__host__ __device__ __forceinline__ void stage_rc(int b, int& R, int& C) { const int st = b / 1024, sb = b % 1024, swz = sb ^ (((sb >> 9) & 1) << 5); R = (st >> 1) * 16 + swz / 64; C = (st & 1) * 32 + (swz % 64) / 2; }
__host__ __device__ __forceinline__ int perm32(int rho) { const int n = rho >> 4, i = rho & 15; return 8 * (i >> 2) + 4 * n + (i & 3); }

struct Unit { int pm, pn; };
struct Gemm { const bf16_t* A; const bf16_t* Bt; int M, N, K; };

struct StaticOrder {
    int nM, nN, nwg, G, c;
    __host__ __device__ void init(int M, int N, int G_, int c_) { nM = M / BM; nN = N / BM; nwg = nM * nN; G = G_; c = c_; }
    __host__ __device__ bool next(int i, Unit& u) const {
        const long L = (long)i * G + c; if (L >= nwg) return false;
        int wgid = (int)L; { const int q = nwg / NXCD, r = nwg % NXCD, xcd = wgid % NXCD, off = wgid / NXCD; wgid = (xcd < r ? xcd * (q + 1) : r * (q + 1) + (xcd - r) * q) + off; }
        const int nig = WGM * nN, gid = wgid / nig, fm = gid * WGM, gsz = (nM - fm) < WGM ? (nM - fm) : WGM;
        u.pm = fm + ((wgid % nig) % gsz); u.pn = (wgid % nig) / gsz; return true;
    }
    __device__ __forceinline__ void a_ready(const Unit&) const {}
    __device__ __forceinline__ void done(const Unit&) const {}
};

__device__ __forceinline__ unsigned cvt_pk_bf16(float lo, float hi) { unsigned r; asm volatile("v_cvt_pk_bf16_f32 %0, %1, %2" : "=v"(r) : "v"(lo), "v"(hi)); return r; }
typedef float f32x2 __attribute__((ext_vector_type(2)));
struct EpiF32 {
    static constexpr bool PERM = false, AFTER_DRAIN = false;
    float* C; int ldc;
    __device__ __forceinline__ void operator()(const f32x4 (&acc)[2][2][4][2], const Unit& u, int wr, int wc, int fr_in, int fq_in) const {
        int fr = fr_in, fq = fq_in; asm volatile("" : "+v"(fr), "+v"(fq));
        const int row0 = u.pm * BM + wr * 64 + fr, col0 = u.pn * BM + wc * 32 + 4 * fq;
#pragma unroll
        for (int ai = 0; ai < 2; ++ai)
#pragma unroll
            for (int m = 0; m < 4; ++m) { float* rowp = C + (size_t)(row0 + ai * HALF + m * 16) * ldc + col0;
#pragma unroll
                for (int bj = 0; bj < 2; ++bj)
#pragma unroll
                    for (int n = 0; n < 2; ++n) *(f32x4*)(rowp + bj * HALF + n * 16) = acc[ai][bj][m][n]; }
    }
};
struct EpiGlu {
    static constexpr bool PERM = false, AFTER_DRAIN = false;
    float* C; int ldc;
    __device__ __forceinline__ void operator()(const f32x4 (&acc)[2][2][4][2], const Unit& u, int wr, int wc, int fr_in, int fq_in) const {
        int fr = fr_in, fq = fq_in; asm volatile("" : "+v"(fr), "+v"(fq));
        const int row0 = u.pm * BM + wr * 64 + fr, col0 = u.pn * HALF + wc * 32 + 4 * fq;
#pragma unroll
        for (int ai = 0; ai < 2; ++ai)
#pragma unroll
            for (int m = 0; m < 4; ++m) { float* rowp = C + (size_t)(row0 + ai * HALF + m * 16) * ldc + col0;
#pragma unroll
                for (int n = 0; n < 2; ++n) { const f32x4 a = acc[ai][0][m][n], b = acc[ai][1][m][n]; f32x4 o;
#pragma unroll
                    for (int j = 0; j < 4; ++j) o[j] = a[j] / (1.0f + __expf(-b[j]));
                    *(f32x4*)(rowp + n * 16) = o; } }
    }
};
struct EpiRelu2 {
    static constexpr bool PERM = true, AFTER_DRAIN = false;
    bf16_t* O; int ldc;
    __device__ __forceinline__ void operator()(const f32x4 (&acc)[2][2][4][2], const Unit& u, int wr, int wc, int fr_in, int fq_in) const {
        int fr = fr_in, fq = fq_in; asm volatile("" : "+v"(fr), "+v"(fq));
        const int row0 = u.pm * BM + wr * 64 + fr, col0 = u.pn * BM + wc * 32 + 8 * fq;
#pragma unroll
        for (int ai = 0; ai < 2; ++ai)
#pragma unroll
            for (int m = 0; m < 4; ++m) { bf16_t* rowp = O + (size_t)(row0 + ai * HALF + m * 16) * ldc + col0;
#pragma unroll
                for (int bj = 0; bj < 2; ++bj) { f32x4 v0 = acc[ai][bj][m][0], v1 = acc[ai][bj][m][1];
#pragma unroll
                    for (int j = 0; j < 4; ++j) { const float a = fmaxf(v0[j], 0.f), b = fmaxf(v1[j], 0.f); v0[j] = a * a; v1[j] = b * b; }
                    u32x4 w; w.x = cvt_pk_bf16(v0[0], v0[1]); w.y = cvt_pk_bf16(v0[2], v0[3]); w.z = cvt_pk_bf16(v1[0], v1[1]); w.w = cvt_pk_bf16(v1[2], v1[3]);
                    *(u32x4*)(rowp + bj * HALF) = w; } }
    }
};
struct EpiInProj {
    static constexpr bool PERM = true, AFTER_DRAIN = false;
    bf16_t* QKV; bf16_t* GZ; bf16_t* XBC; float* DT; const float* rope; const float* dt_bias;
    __device__ __forceinline__ void operator()(const f32x4 (&acc)[2][2][4][2], const Unit& u, int wr, int wc, int fr_in, int fq_in) const {
        int fr = fr_in, fq = fq_in; asm volatile("" : "+v"(fr), "+v"(fq));
        const int pn = u.pn, row0 = u.pm * BM + wr * 64 + fr, cin = wc * 32 + 8 * fq;
        if (pn < 8) {
            const int hd = pn & 3; const bool isk = pn >= 4;
            const float lg2 = __log2f(1.0f - exp2f(-5.0f - (float)hd));
#pragma unroll
            for (int ai = 0; ai < 2; ++ai)
#pragma unroll
                for (int m = 0; m < 4; ++m) { const int row = row0 + ai * HALF + m * 16, pos = row & 4095, r = pos & 127;
                    const float sc = isk ? exp2f(-(float)r * lg2) * 0.0625f : exp2f((float)r * lg2);
                    const f32x4* rp = (const f32x4*)(rope + ((size_t)pos * 128 + cin) * 2);
                    f32x4 o1[2], o2[2];
#pragma unroll
                    for (int n = 0; n < 2; ++n) { const f32x4 cs0 = rp[2 * n], cs1 = rp[2 * n + 1];
                        const f32x4 x1 = acc[ai][0][m][n], x2 = acc[ai][1][m][n];
                        const float c[4] = {cs0[0], cs0[2], cs1[0], cs1[2]}, s[4] = {cs0[1], cs0[3], cs1[1], cs1[3]};
#pragma unroll
                        for (int j = 0; j < 4; ++j) { o1[n][j] = (x1[j] * c[j] - x2[j] * s[j]) * sc; o2[n][j] = (x2[j] * c[j] + x1[j] * s[j]) * sc; } }
                    bf16_t* rowp = QKV + (size_t)row * 3072 + pn * 256 + cin;
                    u32x4 w; w.x = cvt_pk_bf16(o1[0][0], o1[0][1]); w.y = cvt_pk_bf16(o1[0][2], o1[0][3]); w.z = cvt_pk_bf16(o1[1][0], o1[1][1]); w.w = cvt_pk_bf16(o1[1][2], o1[1][3]);
                    *(u32x4*)rowp = w;
                    w.x = cvt_pk_bf16(o2[0][0], o2[0][1]); w.y = cvt_pk_bf16(o2[0][2], o2[0][3]); w.z = cvt_pk_bf16(o2[1][0], o2[1][1]); w.w = cvt_pk_bf16(o2[1][2], o2[1][3]);
                    *(u32x4*)(rowp + HALF) = w; }
        } else if (pn < 26) {
            bf16_t* base; int ldc, colt;
            if (pn < 12) { base = QKV; ldc = 3072; colt = pn * 256; } else if (pn < 20) { base = GZ; ldc = 2048; colt = (pn - 12) * 256; } else { base = XBC; ldc = 1536; colt = (pn - 20) * 256; }
#pragma unroll
            for (int ai = 0; ai < 2; ++ai)
#pragma unroll
                for (int m = 0; m < 4; ++m) { bf16_t* rowp = base + (size_t)(row0 + ai * HALF + m * 16) * ldc + colt + cin;
#pragma unroll
                    for (int bj = 0; bj < 2; ++bj) { const f32x4 v0 = acc[ai][bj][m][0], v1 = acc[ai][bj][m][1];
                        u32x4 w; w.x = cvt_pk_bf16(v0[0], v0[1]); w.y = cvt_pk_bf16(v0[2], v0[3]); w.z = cvt_pk_bf16(v1[0], v1[1]); w.w = cvt_pk_bf16(v1[2], v1[3]);
                        *(u32x4*)(rowp + bj * HALF) = w; } }
        } else {
            if (cin < 16) {
#pragma unroll
                for (int ai = 0; ai < 2; ++ai)
#pragma unroll
                    for (int m = 0; m < 4; ++m) { float* rowp = DT + (size_t)(row0 + ai * HALF + m * 16) * 16 + cin;
#pragma unroll
                        for (int n = 0; n < 2; ++n) { f32x4 o;
#pragma unroll
                            for (int j = 0; j < 4; ++j) { const float x = acc[ai][0][m][n][j] + dt_bias[cin + 4 * n + j]; o[j] = x > 20.f ? x : log1pf(__expf(x)); }
                            *(f32x4*)(rowp + 4 * n) = o; } }
            }
        }
    }
};
template <class Epi, class Sched, bool ALIGN_EPI = false, bool SP2 = false>
__device__ __forceinline__ void gemm_phase(PG8_LAS unsigned char* lds, const Gemm g, const Sched& S, const Epi& E, const int tid) {
    const int wid = __builtin_amdgcn_readfirstlane(tid >> 6), lane = tid & 63, wr = wid >> 2, wc = wid & 3, fr = lane & 15, fq = lane >> 4;
    const int K = g.K, nt = K / BK;
    unsigned voffA[2], voffB[2];
#pragma unroll
    for (int i = 0; i < 2; ++i) { int R, C; stage_rc(tid * 16 + i * 8192, R, C); const int Rb = Epi::PERM ? ((R & ~31) + perm32(R & 31)) : R;
        voffA[i] = (unsigned)(R * K + C) * 2u; voffB[i] = (unsigned)(Rb * K + C) * 2u; }
    const size_t kstep = (size_t)(BK * 2);
    const size_t hstep = (size_t)HALF * K * 2;
    const size_t tstep = 2 * hstep;
    const unsigned ldsw = (unsigned)wid * 1024u;
    const int aoff = lds_byte(wr * 64 + fr, fq * 8), boff = lds_byte(wc * 32 + fr, fq * 8);
#define PG8_SA(b, h) (((b) * 2 + (h)) * HTB)
#define PG8_SB(b, h) ((4 + (b) * 2 + (h)) * HTB)
#define PG8_STAGE(bufoff, gbase, voff) do { _Pragma("unroll") for (int _i = 0; _i < 2; ++_i) \
        __builtin_amdgcn_global_load_lds((const unsigned*)((const char*)(gbase) + (voff)[_i]), (PG8_LAS unsigned*)(lds + (bufoff) + ldsw + _i * 8192), 16, 0, 0); } while (0)
#define PG8_LDA(dst, b, h) do { _Pragma("unroll") for (int m = 0; m < 4; ++m) _Pragma("unroll") for (int k = 0; k < 2; ++k) dst[m][k] = *(const PG8_LAS bf16x8*)(lds + PG8_SA(b, h) + aoff + m * 2048 + k * 1024); } while (0)
#define PG8_LDB(dst, b, h) do { _Pragma("unroll") for (int n = 0; n < 2; ++n) _Pragma("unroll") for (int k = 0; k < 2; ++k) dst[n][k] = *(const PG8_LAS bf16x8*)(lds + PG8_SB(b, h) + boff + n * 2048 + k * 1024); } while (0)
#define PG8_MMA(ai, bj, At, Bt) do { __builtin_amdgcn_s_setprio(1); _Pragma("unroll") for (int m = 0; m < 4; ++m) _Pragma("unroll") for (int n = 0; n < 2; ++n) _Pragma("unroll") for (int k = 0; k < 2; ++k) \
        acc[ai][bj][m][n] = __builtin_amdgcn_mfma_f32_16x16x32_bf16(Bt[n][k], At[m][k], acc[ai][bj][m][n], 0, 0, 0); __builtin_amdgcn_s_setprio(0); } while (0)
#define PG8_WAIT_V(n) asm volatile("s_waitcnt vmcnt(" #n ")" ::: "memory")
#define PG8_WAIT_L(n) asm volatile("s_waitcnt lgkmcnt(" #n ")" ::: "memory")
#define PG8_BAR __builtin_amdgcn_s_barrier()
#define PG8_SCHED __builtin_amdgcn_sched_barrier(0)
    Unit cur, nxt; int ui = 0;
    if (!S.next(0, cur)) return;
    f32x4 acc[2][2][4][2];
#pragma unroll
    for (int a = 0; a < 2; ++a)
#pragma unroll
        for (int b = 0; b < 2; ++b)
#pragma unroll
            for (int m = 0; m < 4; ++m)
#pragma unroll
                for (int n = 0; n < 2; ++n) acc[a][b][m][n] = (f32x4){0.f, 0.f, 0.f, 0.f};
    bf16x8 At[4][2], B0[2][2], B1[2][2];
    const char* cA = (const char*)g.A + (size_t)cur.pm * tstep; const char* cB = (const char*)g.Bt + (size_t)cur.pn * tstep;
    S.a_ready(cur);
    if constexpr (SP2) {
        PG8_STAGE(PG8_SB(0, 0), cB, voffB); PG8_STAGE(PG8_SB(0, 1), cB + hstep, voffB); PG8_STAGE(PG8_SA(0, 0), cA, voffA); PG8_STAGE(PG8_SA(0, 1), cA + hstep, voffA);
        if (wr == 1) PG8_BAR;
        PG8_WAIT_V(2); PG8_BAR;
        PG8_STAGE(PG8_SB(1, 0), cB + kstep, voffB); PG8_STAGE(PG8_SA(1, 0), cA + kstep, voffA); PG8_STAGE(PG8_SB(1, 1), cB + hstep + kstep, voffB);
        PG8_WAIT_V(6); PG8_BAR;
    } else {
        PG8_STAGE(PG8_SB(0, 0), cB, voffB); PG8_STAGE(PG8_SA(0, 0), cA, voffA); PG8_STAGE(PG8_SB(0, 1), cB + hstep, voffB); PG8_STAGE(PG8_SA(0, 1), cA + hstep, voffA);
        if (wr == 1) PG8_BAR;
        PG8_WAIT_V(4); PG8_BAR;
        PG8_STAGE(PG8_SB(1, 0), cB + kstep, voffB); PG8_STAGE(PG8_SA(1, 0), cA + kstep, voffA); PG8_STAGE(PG8_SB(1, 1), cB + hstep + kstep, voffB);
        PG8_WAIT_V(6); PG8_BAR;
    }
    for (;;) {
        const bool has_next = S.next(ui + 1, nxt);
        const char* nA = has_next ? (const char*)g.A + (size_t)nxt.pm * tstep : cA; const char* nB = has_next ? (const char*)g.Bt + (size_t)nxt.pn * tstep : cB;
        for (int t = 0; t < nt; t += 2) {
            const bool last = (t == nt - 2);
            const char* a1 = cA + (size_t)(t + 1) * kstep;
            const char* a2 = last ? nA : cA + (size_t)(t + 2) * kstep; const char* b2 = last ? nB : cB + (size_t)(t + 2) * kstep;
            const char* a3 = a2 + kstep; const char* b3 = b2 + kstep;
            if (last && has_next) S.a_ready(nxt);
            if constexpr (SP2) {
            PG8_LDB(B0, 0, 0); PG8_LDB(B1, 0, 1); PG8_SCHED; PG8_LDA(At, 0, 0); PG8_STAGE(PG8_SA(1, 1), a1 + hstep, voffA);
            PG8_WAIT_V(8); PG8_WAIT_L(0); PG8_BAR; PG8_MMA(0, 0, At, B0); PG8_MMA(0, 1, At, B1); PG8_BAR; PG8_SCHED;
            PG8_LDA(At, 0, 1); PG8_STAGE(PG8_SB(0, 0), b2, voffB); PG8_STAGE(PG8_SB(0, 1), b2 + hstep, voffB); PG8_STAGE(PG8_SA(0, 0), a2, voffA);
            PG8_WAIT_V(8); PG8_WAIT_L(0); PG8_BAR; PG8_MMA(1, 0, At, B0); PG8_MMA(1, 1, At, B1); PG8_BAR; PG8_SCHED;
            PG8_LDB(B0, 1, 0); PG8_LDB(B1, 1, 1); PG8_SCHED; PG8_LDA(At, 1, 0); PG8_STAGE(PG8_SA(0, 1), a2 + hstep, voffA);
            PG8_WAIT_V(8); PG8_WAIT_L(0); PG8_BAR; PG8_MMA(0, 0, At, B0); PG8_MMA(0, 1, At, B1); PG8_BAR; PG8_SCHED;
            PG8_LDA(At, 1, 1); PG8_STAGE(PG8_SB(1, 0), b3, voffB); PG8_STAGE(PG8_SB(1, 1), b3 + hstep, voffB); PG8_STAGE(PG8_SA(1, 0), a3, voffA);
            PG8_WAIT_V(8); PG8_WAIT_L(0); PG8_BAR; PG8_MMA(1, 0, At, B0); PG8_MMA(1, 1, At, B1); PG8_BAR; PG8_SCHED;
            } else {
            PG8_LDB(B0, 0, 0); PG8_SCHED; PG8_LDA(At, 0, 0); PG8_STAGE(PG8_SA(1, 1), a1 + hstep, voffA);
            PG8_WAIT_L(8); PG8_BAR; PG8_WAIT_L(0); PG8_MMA(0, 0, At, B0); PG8_BAR; PG8_SCHED;
            PG8_LDB(B1, 0, 1); PG8_STAGE(PG8_SB(0, 0), b2, voffB);
            PG8_BAR; PG8_WAIT_L(0); PG8_MMA(0, 1, At, B1); PG8_BAR;
            PG8_LDA(At, 0, 1); PG8_STAGE(PG8_SA(0, 0), a2, voffA);
            PG8_BAR; PG8_WAIT_L(0); PG8_MMA(1, 0, At, B0); PG8_BAR; PG8_SCHED;
            PG8_STAGE(PG8_SB(0, 1), b2 + hstep, voffB);
            PG8_WAIT_V(6); PG8_BAR; PG8_MMA(1, 1, At, B1); PG8_BAR;
            PG8_LDB(B0, 1, 0); PG8_SCHED; PG8_LDA(At, 1, 0); PG8_STAGE(PG8_SA(0, 1), a2 + hstep, voffA);
            PG8_WAIT_L(8); PG8_BAR; PG8_WAIT_L(0); PG8_MMA(0, 0, At, B0); PG8_BAR; PG8_SCHED;
            PG8_LDB(B1, 1, 1); PG8_STAGE(PG8_SB(1, 0), b3, voffB);
            PG8_BAR; PG8_WAIT_L(0); PG8_MMA(0, 1, At, B1); PG8_BAR;
            PG8_LDA(At, 1, 1); PG8_STAGE(PG8_SA(1, 0), a3, voffA);
            PG8_BAR; PG8_WAIT_L(0); PG8_MMA(1, 0, At, B0); PG8_BAR; PG8_SCHED;
            PG8_STAGE(PG8_SB(1, 1), b3 + hstep, voffB);
            PG8_WAIT_V(6); PG8_BAR; PG8_MMA(1, 1, At, B1); PG8_BAR;
            }
        }
        if constexpr (ALIGN_EPI) { if (wr == 0) PG8_BAR; }
        if constexpr (!Epi::AFTER_DRAIN) { E(acc, cur, wr, wc, fr, fq); S.done(cur); }
        if (!has_next) break;
#pragma unroll
        for (int a = 0; a < 2; ++a)
#pragma unroll
            for (int b = 0; b < 2; ++b)
#pragma unroll
                for (int m = 0; m < 4; ++m)
#pragma unroll
                    for (int n = 0; n < 2; ++n) acc[a][b][m][n] = (f32x4){0.f, 0.f, 0.f, 0.f};
        cur = nxt; cA = nA; cB = nB; ++ui;
        if constexpr (ALIGN_EPI) { if (wr == 1) PG8_BAR; }
    }
    PG8_WAIT_V(0);
    if constexpr (!ALIGN_EPI) { if (wr == 0) PG8_BAR; }
    PG8_BAR;
    if constexpr (Epi::AFTER_DRAIN) { E.fused(acc, cur, wr, wc, fr, fq, lds, wid, lane); S.done(cur); }
#undef PG8_SA
#undef PG8_SB
#undef PG8_STAGE
#undef PG8_LDA
#undef PG8_LDB
#undef PG8_MMA
#undef PG8_WAIT_V
#undef PG8_WAIT_L
#undef PG8_BAR
#undef PG8_SCHED
}
}
constexpr int NWAVES = 8, NTHR = 512;
constexpr int BATCH = 4, SEQ = 4096, D = 1024, M = BATCH * SEQ, FF = 4096, DEPTH = 4;
constexpr int INP = 6672, INP_PAD = 6912;
constexpr float EPS = 1e-6f;
enum { I_X = 0, I_PRE_MIX, I_POST_MIX, I_PRE_MLP, I_POST_MLP, I_W_IN, I_CONV_W, I_CONV_B, I_DT_BIAS, I_A_LOG, I_D_SSD, I_SSD_NORM, I_W_OUT,
       I_LAM_RE, I_LAM_IM, I_LOG_STEP, I_B_RE, I_B_IM, I_C_RE, I_C_IM, I_D_S5, I_W_GLU_A, I_W_GLU_B, I_W_UP, I_W_DOWN, N_IN };
constexpr size_t MiB = 1u << 20;
constexpr size_t WS_CTL = 0, CTL_ZERO_BYTES = 64 * 1024;
constexpr size_t WS_MISC = 512 * 1024;
constexpr size_t WS_ROPE = 1 * MiB;
constexpr size_t WS_W4 = 5 * MiB;
constexpr size_t WS_SLOT16 = 9 * MiB;
constexpr size_t WS_SLOT32 = 25 * MiB;
constexpr size_t WS_QKV = 57 * MiB;
constexpr size_t WS_GZ = 153 * MiB;
constexpr size_t WS_XBC = 217 * MiB;
constexpr size_t WS_DT = 265 * MiB;
constexpr size_t WS_END = 266 * MiB;
constexpr size_t WS_M32A = 57 * MiB;
constexpr size_t WS_M32B = 185 * MiB;
constexpr size_t WS_U = 57 * MiB;
constexpr size_t WS_S5MAT = 57 * MiB;
constexpr size_t WS_S5E = 73 * MiB;
constexpr size_t WS_S5X = 105 * MiB;
constexpr size_t WS_Y = 121 * MiB;
constexpr int SCR_BYTES = 143360;
constexpr int MISC_OFF = SCR_BYTES;
constexpr int LDS_BYTES = 147456;

#define GAS __attribute__((address_space(1)))
#define LAS __attribute__((address_space(3)))
#define DI __device__ __forceinline__
typedef unsigned short bf16;
typedef unsigned v4u __attribute__((ext_vector_type(4)));
typedef unsigned v2u __attribute__((ext_vector_type(2)));
typedef float f32x4 __attribute__((ext_vector_type(4)));
typedef float f32x2v __attribute__((ext_vector_type(2)));
typedef short bf16x8 __attribute__((ext_vector_type(8)));
typedef short v4i16_t __attribute__((ext_vector_type(4)));
typedef GAS unsigned gu32;
#define RLX_AGENT __ATOMIC_RELAXED, __HIP_MEMORY_SCOPE_AGENT
#define LDS_WAIT() asm volatile("s_waitcnt lgkmcnt(0)" ::: "memory")
#define VM_WAIT() asm volatile("s_waitcnt vmcnt(0)" ::: "memory")
DI unsigned f2bf(float f) { unsigned u = __builtin_bit_cast(unsigned, f); return (u + 0x7fffu + ((u >> 16) & 1u)) >> 16; }
DI unsigned pk2(float lo, float hi) { return f2bf(lo) | (f2bf(hi) << 16); }
DI float bf2f(unsigned short b) { return __builtin_bit_cast(float, ((unsigned)b) << 16); }
DI float bflo(unsigned w) { return __builtin_bit_cast(float, w << 16); }
DI float bfhi(unsigned w) { return __builtin_bit_cast(float, w & 0xffff0000u); }
DI float wave_sum(float v) {
#pragma unroll
    for (int o = 1; o < 64; o <<= 1) v += __shfl_xor(v, o);
    return v;
}
DI float silu_f(float x) { return x / (1.0f + __expf(-x)); }
DI void sincos_d(double x, double& s, double& c) {
    const double k = rint(x * 0.15915494309189533576888376337251);
    const double r = fma(-k, 6.283185307179586476925286766559, x), r2 = r * r;
    double ps = 1.0 / 1.0888869450418352e28, pc = 1.0 / 3.0488834461171384e29;
    const double fs[13] = {1.0 / 1.5511210043330986e25, 1.0 / 2.5852016738884978e22, 1.0 / 5.109094217170944e19, 1.0 / 1.21645100408832e17, 1.0 / 355687428096000.0, 1.0 / 1307674368000.0,
                           1.0 / 6227020800.0, 1.0 / 39916800.0, 1.0 / 362880.0, 1.0 / 5040.0, 1.0 / 120.0, 1.0 / 6.0, 1.0};
    const double fc[14] = {1.0 / 4.0329146112660565e26, 1.0 / 6.204484017332394e23, 1.0 / 1.1240007277776077e21, 1.0 / 2.43290200817664e18, 1.0 / 6402373705728000.0, 1.0 / 20922789888000.0,
                           1.0 / 87178291200.0, 1.0 / 479001600.0, 1.0 / 3628800.0, 1.0 / 40320.0, 1.0 / 720.0, 1.0 / 24.0, 1.0 / 2.0, 1.0};
#pragma unroll
    for (int i = 0; i < 13; ++i) ps = fs[i] - ps * r2;
#pragma unroll
    for (int i = 0; i < 14; ++i) pc = fc[i] - pc * r2;
    s = ps * r; c = pc;
}
#define XB_TMO      128
#define XB_XCNT(j)  (256  + 64 * (j))
#define XB_XSUB(j)  (1280 + 64 * (j))
#define XB_XGEN(j)  (2304 + 64 * (j))
#define XB_TOP      3328
#define XB_TOPGEN   3392
#define XCD_BAR_WORDS 3456
#define XB_SPIN_CAP (1u << 18)

__device__ __forceinline__ unsigned xb_ld(unsigned* p)              { return __hip_atomic_load(p, __ATOMIC_RELAXED, __HIP_MEMORY_SCOPE_AGENT); }
__device__ __forceinline__ unsigned xb_add(unsigned* p, unsigned v) { return __hip_atomic_fetch_add(p, v, __ATOMIC_RELAXED, __HIP_MEMORY_SCOPE_AGENT); }
__device__ __forceinline__ unsigned xb_xcc_id() { return (unsigned)__builtin_amdgcn_s_getreg((3 << 11) | 20) & 0xFu; }
#define XB_SPIN(cond, bar) do { unsigned _sp = 0; while (cond) { __builtin_amdgcn_s_sleep(1); \
    if ((++_sp & 255u) == 0u) { if (xb_ld(&(bar)[XB_TMO])) break; if (_sp > XB_SPIN_CAP) { atomicAdd(&(bar)[XB_TMO], 1u); break; } } } } while (0)

struct XcdBarrier {
    unsigned* bar; unsigned x; int tid;
    volatile LAS unsigned* st;
};

__device__ __forceinline__ XcdBarrier xcd_barrier_post(unsigned* bar, volatile LAS unsigned* st) {
    XcdBarrier b; b.bar = bar; b.x = xb_xcc_id(); b.st = st;
    if (threadIdx.x == 0) (void)xb_add(&bar[XB_XCNT(b.x)], 1u);
    return b;
}
__device__ __forceinline__ void xcd_barrier_complete(unsigned* bar, unsigned x, unsigned& nloc, unsigned& nx) {
    const unsigned G = gridDim.x * gridDim.y * gridDim.z;
    unsigned sum, cnt, mine, sp = 0u;
    for (;;) {
        sum = 0u; cnt = 0u; mine = 0u;
#pragma unroll
        for (unsigned j = 0; j < 16; ++j) { const unsigned c = xb_ld(&bar[XB_XCNT(j)]); sum += c; cnt += (c > 0u) ? 1u : 0u; mine = (j == x) ? c : mine; }
        if (sum == G) break;
        __builtin_amdgcn_s_sleep(1);
        if ((++sp & 255u) == 0u) { if (xb_ld(&bar[XB_TMO])) break; if (sp > XB_SPIN_CAP) { atomicAdd(&bar[XB_TMO], 1u); break; } }
    }
    nloc = mine > 0u ? mine : 1u; nx = cnt > 0u ? cnt : 1u;
}

__device__ __forceinline__ void xcd_barrier(const XcdBarrier& b) {
    asm volatile("s_waitcnt vmcnt(0)" ::: "memory");
    __syncthreads();
    if (b.tid == 0) {
        unsigned* bar = b.bar;
        __builtin_amdgcn_s_waitcnt(0);
        unsigned nloc = b.st[0], nx = b.st[1];
        if (nloc == 0u) { xcd_barrier_complete(bar, b.x, nloc, nx); b.st[0] = nloc; b.st[1] = nx; }
        const unsigned old = xb_add(&bar[XB_XSUB(b.x)], 1u);
        const unsigned gen = old / nloc;
        if (old + 1u == (gen + 1u) * nloc) {
            __builtin_amdgcn_fence(__ATOMIC_RELEASE, "agent");
            asm volatile("s_waitcnt vmcnt(0)" ::: "memory");
            const unsigned og = xb_add(&bar[XB_TOP], 1u);
            const unsigned tg = og / nx;
            if (og + 1u == (tg + 1u) * nx) xb_add(&bar[XB_TOPGEN], 1u);
            else XB_SPIN(xb_ld(&bar[XB_TOPGEN]) == tg, bar);
            __builtin_amdgcn_fence(__ATOMIC_ACQUIRE, "agent");
            xb_add(&bar[XB_XGEN(b.x)], 1u);
            asm volatile("s_waitcnt vmcnt(0)" ::: "memory");
        } else {
            XB_SPIN(xb_ld(&bar[XB_XGEN(b.x)]) == gen, bar);
            __builtin_amdgcn_fence(__ATOMIC_ACQUIRE, "agent");
            asm volatile("s_waitcnt vmcnt(0)" ::: "memory");
        }
    }
    __syncthreads();
}

struct Frame {
    LAS unsigned char* lds;
    int tid, lane, wave, G, bid, vcu;
    float* out; unsigned char* ws;
};
DI unsigned long long lds_ptr(const Frame& F, int i) {
    unsigned a_ = (unsigned)(size_t)(F.lds + MISC_OFF + 256) + 8u * (unsigned)i; asm volatile("" : "+v"(a_));
    const unsigned long long v = *(const volatile LAS unsigned long long*)a_;
    const unsigned lo = __builtin_amdgcn_readfirstlane((unsigned)v), hi = __builtin_amdgcn_readfirstlane((unsigned)(v >> 32));
    return ((unsigned long long)hi << 32) | lo;
}
#define INP(i) ((const float*)(const GAS float*)lds_ptr(F, (i)))
DI int gwave(const Frame& F) { return F.bid * NWAVES + F.wave; }

DI bf16x8 frag_rm(const LAS unsigned char* t, int S, int r0, int k0, int lane) { return *(const LAS bf16x8*)(t + (r0 + (lane & 15)) * S + (k0 + 8 * (lane >> 4)) * 2); }
DI bf16x8 frag_tr(const LAS unsigned char* t, int S, int r0, int k0, int lane) {
    const int g = lane >> 4, q = (lane & 15) >> 2, p = lane & 3;
    const LAS unsigned char* a = t + (k0 + 8 * g + q) * S + (r0 + 4 * p) * 2;
    const v4i16_t lo = __builtin_amdgcn_ds_read_tr16_b64_v4i16((LAS v4i16_t*)a);
    const v4i16_t hi = __builtin_amdgcn_ds_read_tr16_b64_v4i16((LAS v4i16_t*)(a + 4 * S));
    return __builtin_shufflevector(lo, hi, 0, 1, 2, 3, 4, 5, 6, 7);
}
DI f32x4 mma(bf16x8 a, bf16x8 b, f32x4 c) { return __builtin_amdgcn_mfma_f32_16x16x32_bf16(a, b, c, 0, 0, 0); }

DI void load_tile(LAS unsigned char* dst, int S, const bf16* src, size_t ld, int rows, int cols, int tid) {
    const int cpr = cols >> 3, n = rows * cpr;
    for (int i = tid; i < n; i += NTHR) { const int r = i / cpr, c = i - r * cpr;
        *(LAS v4u*)(dst + r * S + c * 16) = *(const v4u*)(src + (size_t)r * ld + c * 8); }
}

DI void transpose_item(const float* W, int K, int N, bf16* WT, int mode, LAS float* scr, int item, int lane) {
    const int nblk = (N + 31) / 32, kb = item / nblk, nb = item % nblk, k0 = 64 * kb, n0 = 32 * nb;
    const int nl = n0 + (lane & 31);
#pragma unroll 8
    for (int i = 0; i < 32; ++i) { const int kk = 2 * i + (lane >> 5); scr[kk * 33 + (lane & 31)] = nl < N ? W[(size_t)(k0 + kk) * N + nl] : 0.f; }
    LDS_WAIT(); asm volatile("" ::: "memory");
    const int c = lane & 7;
#pragma unroll
    for (int j = 0; j < 4; ++j) { const int n = (lane >> 3) + 8 * j; const LAS float* s = scr + (8 * c) * 33 + n;
        v4u o; o.x = pk2(s[0 * 33], s[1 * 33]); o.y = pk2(s[2 * 33], s[3 * 33]); o.z = pk2(s[4 * 33], s[5 * 33]); o.w = pk2(s[6 * 33], s[7 * 33]);
        const int ng = n0 + n; const int row = mode == 0 ? ng : (256 * (ng >> 7) + (ng & 127) + (mode == 2 ? 128 : 0));
        *(v4u*)(WT + (size_t)row * K + k0 + 8 * c) = o; }
    LDS_WAIT(); asm volatile("" ::: "memory");
}
DI void convert_weight(Frame& F, const float* W, int K, int N, bf16* WT, int mode) {
    LAS float* scr = (LAS float*)(F.lds + F.wave * 16384);
    const int nitems = (K / 64) * ((N + 31) / 32), NGW = F.G * NWAVES;
    for (int it = gwave(F); it < nitems; it += NGW) transpose_item(W, K, N, WT, mode, scr, it, F.lane);
}
DI void zero_fill(Frame& F, void* p, size_t bytes) {
    v4u* q = (v4u*)p; const size_t n = bytes / 16;
    for (size_t i = (size_t)F.bid * NTHR + F.tid; i < n; i += (size_t)F.G * NTHR) q[i] = (v4u){0u, 0u, 0u, 0u};
}

DI void build_rope(Frame& F) {
    float* rope = (float*)(F.ws + WS_ROPE);
    for (int i = F.bid * NTHR + F.tid; i < 4096 * 128; i += F.G * NTHR) { const int pos = i >> 7, d = i & 127;
        double inv = 1.0; { double r = 0.930572040929699; int e = d; while (e) { if (e & 1) inv *= r; r *= r; e >>= 1; } }
        const float ang = (float)pos * (float)inv;
        double s, c; sincos_d((double)ang, s, c);
        *(f32x2v*)(rope + 2 * (size_t)i) = (f32x2v){(float)c, (float)s}; }
}
DI void rms_rows_to_bf16(Frame& F, const float* src, const float* w, bf16* dst) {
    const int NGW = F.G * NWAVES;
    f32x4 wv[4];
#pragma unroll
    for (int j = 0; j < 4; ++j) wv[j] = ((const f32x4*)w)[F.lane + 64 * j];
    for (int m = gwave(F); m < M; m += NGW) { const f32x4* xr = (const f32x4*)(src + (size_t)m * D) + F.lane;
        f32x4 v[4]; float s = 0.f;
#pragma unroll
        for (int j = 0; j < 4; ++j) { v[j] = xr[64 * j]; s += (v[j].x * v[j].x + v[j].y * v[j].y) + (v[j].z * v[j].z + v[j].w * v[j].w); }
        const float rs = rsqrtf(wave_sum(s) * (1.f / D) + EPS);
        v2u* o8 = (v2u*)(dst + (size_t)m * D) + F.lane;
#pragma unroll
        for (int j = 0; j < 4; ++j) { const f32x4 y = v[j] * rs * wv[j]; o8[64 * j] = (v2u){pk2(y.x, y.y), pk2(y.z, y.w)}; } }
}
DI void row_phase(Frame& F, const float* mbuf, const float* hbase, float* hout, const float* w_post, const float* w_pre, bf16* hn) {
    const int NGW = F.G * NWAVES;
    f32x4 wp[4], wq[4];
#pragma unroll
    for (int j = 0; j < 4; ++j) { wp[j] = ((const f32x4*)w_post)[F.lane + 64 * j]; wq[j] = w_pre ? ((const f32x4*)w_pre)[F.lane + 64 * j] : (f32x4){0.f, 0.f, 0.f, 0.f}; }
    for (int m = gwave(F); m < M; m += NGW) {
        const f32x4* mr = (const f32x4*)(mbuf + (size_t)m * D) + F.lane; const f32x4* hr = (const f32x4*)(hbase + (size_t)m * D) + F.lane;
        f32x4 v[4], h[4]; float s = 0.f;
#pragma unroll
        for (int j = 0; j < 4; ++j) { v[j] = mr[64 * j]; h[j] = hr[64 * j]; s += (v[j].x * v[j].x + v[j].y * v[j].y) + (v[j].z * v[j].z + v[j].w * v[j].w); }
        const float rs = rsqrtf(wave_sum(s) * (1.f / D) + EPS); float s2 = 0.f;
        f32x4* ho = (f32x4*)(hout + (size_t)m * D) + F.lane;
#pragma unroll
        for (int j = 0; j < 4; ++j) { h[j] = h[j] + v[j] * rs * wp[j]; ho[64 * j] = h[j]; s2 += (h[j].x * h[j].x + h[j].y * h[j].y) + (h[j].z * h[j].z + h[j].w * h[j].w); }
        if (hn) { const float rs2 = rsqrtf(wave_sum(s2) * (1.f / D) + EPS);
            v2u* o8 = (v2u*)(hn + (size_t)m * D) + F.lane;
#pragma unroll
            for (int j = 0; j < 4; ++j) { const f32x4 y = h[j] * rs2 * wq[j]; o8[64 * j] = (v2u){pk2(y.x, y.y), pk2(y.z, y.w)}; } }
    }
}

DI float head_lg2(int h) { return __log2f(1.0f - exp2f(-5.0f - (float)h)); }

DI void ret_passA_unit(Frame& F, int unit) {
    const bf16* QKV = (const bf16*)(F.ws + WS_QKV); bf16* RST = (bf16*)(F.ws + WS_SLOT16);
    const int eh = unit & 1, sc = (unit >> 1) & 7, h = (unit >> 4) & 3, b = unit >> 6;
    const int lane = F.lane, w = F.wave, we = w >> 2, wd = w & 3;
    const float lg2 = head_lg2(h), g128 = exp2f(128.f * lg2), g127 = exp2f(127.f * lg2);
    LAS unsigned char* Kt = F.lds;
    LAS unsigned char* Vt = F.lds + 128 * 544;
    f32x4 acc[4][4];
#pragma unroll
    for (int a = 0; a < 4; ++a)
#pragma unroll
        for (int c = 0; c < 4; ++c) acc[a][c] = (f32x4){0.f, 0.f, 0.f, 0.f};
    for (int j = 0; j < 4; ++j) {
        if (j) {
#pragma unroll
            for (int a = 0; a < 4; ++a)
#pragma unroll
                for (int c = 0; c < 4; ++c) acc[a][c] *= g128; }
        const size_t row0 = (size_t)b * SEQ + sc * 512 + j * 128;
        __syncthreads();
        load_tile(Kt, 544, QKV + row0 * 3072 + 1024 + h * 256, 3072, 128, 256, F.tid);
        load_tile(Vt, 288, QKV + row0 * 3072 + 2048 + h * 256 + eh * 128, 3072, 128, 128, F.tid);
        __syncthreads();
#pragma unroll
        for (int ks = 0; ks < 4; ++ks) {
            bf16x8 vf[4], kf[4];
#pragma unroll
            for (int t = 0; t < 4; ++t) { vf[t] = frag_tr(Vt, 288, we * 64 + t * 16, ks * 32, lane); kf[t] = frag_tr(Kt, 544, wd * 64 + t * 16, ks * 32, lane); }
#pragma unroll
            for (int et = 0; et < 4; ++et)
#pragma unroll
                for (int dt = 0; dt < 4; ++dt) acc[et][dt] = mma(kf[dt], vf[et], acc[et][dt]);
        }
    }
    bf16* dst = RST + ((size_t)((b * 4 + h) * 8 + sc) * 256) * 256;
#pragma unroll
    for (int et = 0; et < 4; ++et)
#pragma unroll
        for (int dt = 0; dt < 4; ++dt) { const int e = eh * 128 + we * 64 + et * 16 + (lane & 15), d = wd * 64 + dt * 16 + 4 * (lane >> 4);
            const f32x4 v = acc[et][dt] * g127;
            *(v2u*)(dst + (size_t)e * 256 + d) = (v2u){pk2(v[0], v[1]), pk2(v[2], v[3])}; }
}

DI void ret_scan_item(Frame& F, int item) {
    bf16* RST = (bf16*)(F.ws + WS_SLOT16);
    const int bh = item >> 13, off = (item & 8191) * 8, h = bh & 3;
    const float g512 = exp2f(512.f * head_lg2(h));
    float run[8]; float zf = 0.f; asm volatile("" : "+v"(zf));
#pragma unroll
    for (int k = 0; k < 8; ++k) run[k] = zf;
    v4u cur = *(const v4u*)(RST + (size_t)(bh * 8) * 65536 + off);
    for (int sc = 0; sc < 8; ++sc) {
        v4u* p = (v4u*)(RST + (size_t)(bh * 8 + sc) * 65536 + off);
        v4u nxt = cur; if (sc < 7) nxt = *(const v4u*)(RST + (size_t)(bh * 8 + sc + 1) * 65536 + off);
        v4u o; o.x = pk2(run[0], run[1]); o.y = pk2(run[2], run[3]); o.z = pk2(run[4], run[5]); o.w = pk2(run[6], run[7]);
        *p = o;
        const unsigned cw[4] = {cur.x, cur.y, cur.z, cur.w};
#pragma unroll
        for (int k = 0; k < 4; ++k) { run[2 * k] = g512 * run[2 * k] + bflo(cw[k]); run[2 * k + 1] = g512 * run[2 * k + 1] + bfhi(cw[k]); }
        cur = nxt;
    }
}

DI void ret_passC_unit(Frame& F, int unit) {
    const bf16* QKV = (const bf16*)(F.ws + WS_QKV); const bf16* RST = (const bf16*)(F.ws + WS_SLOT16); bf16* GZ = (bf16*)(F.ws + WS_GZ);
    const int qp = unit & 1, sc = (unit >> 1) & 7, h = (unit >> 4) & 3, b = unit >> 6;
    const int lane = F.lane, w = F.wave, wn = w >> 2, we = w & 3, wm = w & 3;
    const float lg2 = head_lg2(h), g1 = exp2f(lg2), g128 = exp2f(128.f * lg2);
    LAS unsigned char* Qt = F.lds;
    LAS unsigned char* KV = F.lds + 33792;
    LAS unsigned char* Pt = F.lds + 33792 + 69632;
    LAS float* red = (LAS float*)(F.lds + 33792 + 69632 + 17408);
    const size_t rowsc = (size_t)b * SEQ + sc * 512;
    const bf16* Rbase = RST + (size_t)((b * 4 + h) * 8 + sc) * 65536;
    for (int qi = 0; qi < 2; ++qi) {
        const int i = qp == 0 ? (qi == 0 ? 0 : 3) : (qi == 0 ? 1 : 2);
        for (int hh = 0; hh < 2; ++hh) {
            const size_t grow0 = rowsc + i * 128 + hh * 64;
            f32x4 Y[2][4];
#pragma unroll
            for (int a = 0; a < 2; ++a)
#pragma unroll
                for (int c = 0; c < 4; ++c) Y[a][c] = (f32x4){0.f, 0.f, 0.f, 0.f};
            __syncthreads();
            load_tile(Qt, 528, QKV + grow0 * 3072 + h * 256, 3072, 64, 256, F.tid);
            for (int ds = 0; ds < 4; ++ds) {
                __syncthreads();
                load_tile(KV, 144, Rbase + ds * 64, 256, 256, 64, F.tid);
                __syncthreads();
#pragma unroll
                for (int ks = 0; ks < 2; ++ks) {
                    bf16x8 qf[2], rf[4];
#pragma unroll
                    for (int t = 0; t < 2; ++t) qf[t] = frag_rm(Qt, 528, wn * 32 + t * 16, ds * 64 + ks * 32, lane);
#pragma unroll
                    for (int t = 0; t < 4; ++t) rf[t] = frag_rm(KV, 144, we * 64 + t * 16, ks * 32, lane);
#pragma unroll
                    for (int nt = 0; nt < 2; ++nt)
#pragma unroll
                        for (int et = 0; et < 4; ++et) Y[nt][et] = mma(rf[et], qf[nt], Y[nt][et]);
                }
            }
#pragma unroll
            for (int a = 0; a < 2; ++a)
#pragma unroll
                for (int c = 0; c < 4; ++c) Y[a][c] *= g1;
            for (int j = 0; j <= i; ++j) {
                if (j) {
#pragma unroll
                    for (int a = 0; a < 2; ++a)
#pragma unroll
                        for (int c = 0; c < 4; ++c) Y[a][c] *= g128; }
                const size_t rowj = rowsc + j * 128;
                __syncthreads();
                load_tile(KV, 528, QKV + rowj * 3072 + 1024 + h * 256, 3072, 128, 256, F.tid);
                __syncthreads();
                f32x4 sa[2][2];
#pragma unroll
                for (int a = 0; a < 2; ++a)
#pragma unroll
                    for (int c = 0; c < 2; ++c) sa[a][c] = (f32x4){0.f, 0.f, 0.f, 0.f};
#pragma unroll
                for (int ks = 0; ks < 8; ++ks) {
                    bf16x8 qf[2], kf[2];
#pragma unroll
                    for (int t = 0; t < 2; ++t) { qf[t] = frag_rm(Qt, 528, wn * 32 + t * 16, ks * 32, lane); kf[t] = frag_rm(KV, 528, wm * 32 + t * 16, ks * 32, lane); }
#pragma unroll
                    for (int nt = 0; nt < 2; ++nt)
#pragma unroll
                        for (int mt = 0; mt < 2; ++mt) sa[nt][mt] = mma(kf[mt], qf[nt], sa[nt][mt]);
                }
#pragma unroll
                for (int nt = 0; nt < 2; ++nt)
#pragma unroll
                    for (int mt = 0; mt < 2; ++mt) { const int n = wn * 32 + nt * 16 + (lane & 15), m = wm * 32 + mt * 16 + 4 * (lane >> 4);
                        f32x4 s = sa[nt][mt];
                        if (j == i) { const int nb = hh * 64 + n;
#pragma unroll
                            for (int jj = 0; jj < 4; ++jj) if (m + jj > nb) s[jj] = 0.f; }
                        *(LAS v2u*)(Pt + n * 272 + m * 2) = (v2u){pk2(s[0], s[1]), pk2(s[2], s[3])}; }
                __syncthreads();
                load_tile(KV, 544, QKV + rowj * 3072 + 2048 + h * 256, 3072, 128, 256, F.tid);
                __syncthreads();
#pragma unroll
                for (int ks = 0; ks < 4; ++ks) {
                    bf16x8 pf[2], vf[4];
#pragma unroll
                    for (int t = 0; t < 2; ++t) pf[t] = frag_rm(Pt, 272, wn * 32 + t * 16, ks * 32, lane);
#pragma unroll
                    for (int t = 0; t < 4; ++t) vf[t] = frag_tr(KV, 544, we * 64 + t * 16, ks * 32, lane);
#pragma unroll
                    for (int nt = 0; nt < 2; ++nt)
#pragma unroll
                        for (int et = 0; et < 4; ++et) Y[nt][et] = mma(vf[et], pf[nt], Y[nt][et]);
                }
            }
            float mean[2], rstd[2];
#pragma unroll
            for (int nt = 0; nt < 2; ++nt) { float s = 0.f;
#pragma unroll
                for (int et = 0; et < 4; ++et) s += (Y[nt][et][0] + Y[nt][et][1]) + (Y[nt][et][2] + Y[nt][et][3]);
                s += __shfl_xor(s, 16); s += __shfl_xor(s, 32);
                if ((lane >> 4) == 0) red[(wn * 32 + nt * 16 + lane) * 4 + we] = s; }
            __syncthreads();
#pragma unroll
            for (int nt = 0; nt < 2; ++nt) { const LAS float* r = red + (wn * 32 + nt * 16 + (lane & 15)) * 4; mean[nt] = ((r[0] + r[1]) + (r[2] + r[3])) * (1.f / 256.f); }
            __syncthreads();
#pragma unroll
            for (int nt = 0; nt < 2; ++nt) { float s = 0.f;
#pragma unroll
                for (int et = 0; et < 4; ++et) { const f32x4 dv = Y[nt][et] - mean[nt]; s += (dv[0] * dv[0] + dv[1] * dv[1]) + (dv[2] * dv[2] + dv[3] * dv[3]); }
                s += __shfl_xor(s, 16); s += __shfl_xor(s, 32);
                if ((lane >> 4) == 0) red[(wn * 32 + nt * 16 + lane) * 4 + we] = s; }
            __syncthreads();
#pragma unroll
            for (int nt = 0; nt < 2; ++nt) { const LAS float* r = red + (wn * 32 + nt * 16 + (lane & 15)) * 4; rstd[nt] = rsqrtf(((r[0] + r[1]) + (r[2] + r[3])) * (1.f / 256.f) + EPS); }
#pragma unroll
            for (int nt = 0; nt < 2; ++nt)
#pragma unroll
                for (int et = 0; et < 4; ++et) { const int n = wn * 32 + nt * 16 + (lane & 15), e = we * 64 + et * 16 + 4 * (lane >> 4);
                    bf16* gp = GZ + (grow0 + n) * 2048 + h * 256 + e;
                    const v2u gv = *(const v2u*)gp;
                    const f32x4 y = (Y[nt][et] - mean[nt]) * rstd[nt];
                    const float o0 = y[0] * silu_f(bflo(gv.x)), o1 = y[1] * silu_f(bfhi(gv.x)), o2 = y[2] * silu_f(bflo(gv.y)), o3 = y[3] * silu_f(bfhi(gv.y));
                    *(v2u*)gp = (v2u){pk2(o0, o1), pk2(o2, o3)}; }
        }
    }
}

struct SsdPar { const float* conv_w; const float* conv_b; const float* a_log; const float* d_ssd; const float* ssd_norm; };

struct ConvW { f32x4 w[4][2]; f32x4 b[2]; };
DI ConvW load_convw(const float* cw, const float* cb, int col) { ConvW W;
#pragma unroll
    for (int k = 0; k < 4; ++k) { W.w[k][0] = *(const f32x4*)(cw + k * 1536 + col); W.w[k][1] = *(const f32x4*)(cw + k * 1536 + col + 4); }
    W.b[0] = *(const f32x4*)(cb + col); W.b[1] = *(const f32x4*)(cb + col + 4); return W; }
DI void conv8(const bf16* XBC, const ConvW& W, size_t row, int col, float (&o)[8]) {
    const int tin = (int)(row & 4095);
    o[0] = W.b[0][0]; o[1] = W.b[0][1]; o[2] = W.b[0][2]; o[3] = W.b[0][3]; o[4] = W.b[1][0]; o[5] = W.b[1][1]; o[6] = W.b[1][2]; o[7] = W.b[1][3];
#pragma unroll
    for (int k = 0; k < 4; ++k) {
        if (tin - 3 + k >= 0) {
            const v4u x = *(const v4u*)(XBC + (row - 3 + k) * 1536 + col);
            const f32x4 w0 = W.w[k][0], w1 = W.w[k][1];
            o[0] += w0[0] * bflo(x.x); o[1] += w0[1] * bfhi(x.x); o[2] += w0[2] * bflo(x.y); o[3] += w0[3] * bfhi(x.y);
            o[4] += w1[0] * bflo(x.z); o[5] += w1[1] * bfhi(x.z); o[6] += w1[2] * bflo(x.w); o[7] += w1[3] * bfhi(x.w);
        }
    }
#pragma unroll
    for (int k = 0; k < 8; ++k) o[k] = silu_f(o[k]);
}
DI v4u pack8(const float (&o)[8], float s) { v4u r; r.x = pk2(o[0] * s, o[1] * s); r.y = pk2(o[2] * s, o[3] * s); r.z = pk2(o[4] * s, o[5] * s); r.w = pk2(o[6] * s, o[7] * s); return r; }

DI float ssd_cumsum(const float* DT, const float* a_log, size_t t0, int grp, int w, int lane, LAS float* cs) {
    const int head = grp * 8 + w; const float A = -__expf(a_log[head]);
    const float v0 = DT[(t0 + 2 * lane) * 16 + head] * A, v1 = DT[(t0 + 2 * lane + 1) * 16 + head] * A;
    float x = v0 + v1;
#pragma unroll
    for (int o = 1; o < 64; o <<= 1) { const float t = __shfl_up(x, o); if (lane >= o) x += t; }
    cs[w * 128 + 2 * lane] = x - v1; cs[w * 128 + 2 * lane + 1] = x;
    return __shfl(x, 63);
}

DI void ssd_passA_unit(Frame& F, const SsdPar& P, int unit) {
    const bf16* XBC = (const bf16*)(F.ws + WS_XBC); const float* DT = (const float*)(F.ws + WS_DT);
    bf16* ST = (bf16*)(F.ws + WS_SLOT32); float* CDEC = (float*)(F.ws + WS_MISC);
    const int grp = unit & 1, c = (unit >> 1) & 31, b = unit >> 6;
    const int lane = F.lane, w = F.wave;
    const size_t t0 = (size_t)b * SEQ + c * 128;
    LAS float* cs = (LAS float*)F.lds;
    LAS float* csend = (LAS float*)(F.lds + 4096);
    LAS unsigned char* Bt = F.lds + 4352;
    LAS unsigned char* Xw = F.lds + 4352 + 36864;
    __syncthreads();
    { const float tot = ssd_cumsum(DT, P.a_log, t0, grp, w, lane, cs);
      if (lane == 0) { csend[w] = tot; CDEC[(b * 32 + c) * 16 + grp * 8 + w] = __expf(tot); } }
    { const ConvW W = load_convw(P.conv_w, P.conv_b, 1024 + grp * 128 + (F.tid & 15) * 8);
#pragma unroll 1
    for (int it = 0; it < 4; ++it) { const int idx = F.tid + it * NTHR, r = idx >> 4, cc = idx & 15; float o[8];
        conv8(XBC, W, t0 + r, 1024 + grp * 128 + cc * 8, o);
        *(LAS v4u*)(Bt + r * 288 + cc * 16) = pack8(o, 1.0f); } }
    for (int hg = 0; hg < 2; ++hg) {
        __syncthreads();
        const ConvW W = load_convw(P.conv_w, P.conv_b, grp * 512 + hg * 256 + (F.tid & 31) * 8);
#pragma unroll 1
        for (int it = 0; it < 8; ++it) { const int idx = F.tid + it * NTHR, r = idx >> 5, cc = idx & 31, hd = hg * 4 + (cc >> 3); float o[8];
            conv8(XBC, W, t0 + r, grp * 512 + hg * 256 + cc * 8, o);
            const float sc = DT[(t0 + r) * 16 + grp * 8 + hd] * __expf(csend[hd] - cs[hd * 128 + r]);
            *(LAS v4u*)(Xw + r * 544 + cc * 16) = pack8(o, sc); }
        __syncthreads();
        const int hl = w >> 1, nh = w & 1;
        f32x4 acc[4][4];
#pragma unroll
        for (int a = 0; a < 4; ++a)
#pragma unroll
            for (int q = 0; q < 4; ++q) acc[a][q] = (f32x4){0.f, 0.f, 0.f, 0.f};
#pragma unroll
        for (int ks = 0; ks < 4; ++ks) {
            bf16x8 xf[4], bfr[4];
#pragma unroll
            for (int t = 0; t < 4; ++t) { xf[t] = frag_tr(Xw, 544, hl * 64 + t * 16, ks * 32, lane); bfr[t] = frag_tr(Bt, 288, nh * 64 + t * 16, ks * 32, lane); }
#pragma unroll
            for (int pt = 0; pt < 4; ++pt)
#pragma unroll
                for (int nt = 0; nt < 4; ++nt) acc[pt][nt] = mma(bfr[nt], xf[pt], acc[pt][nt]);
        }
        const int head = grp * 8 + hg * 4 + hl;
        bf16* dst = ST + (size_t)((b * 32 + c) * 16 + head) * 8192;
#pragma unroll
        for (int pt = 0; pt < 4; ++pt)
#pragma unroll
            for (int nt = 0; nt < 4; ++nt) { const int p = pt * 16 + (lane & 15), n = nh * 64 + nt * 16 + 4 * (lane >> 4); const f32x4 v = acc[pt][nt];
                *(v2u*)(dst + p * 128 + n) = (v2u){pk2(v[0], v[1]), pk2(v[2], v[3])}; }
    }
}

DI void ssd_scan_item(Frame& F, int item) {
    bf16* ST = (bf16*)(F.ws + WS_SLOT32); const float* CDEC = (const float*)(F.ws + WS_MISC);
    const int bh = item >> 10, b = bh >> 4, head = bh & 15, off = (item & 1023) * 8;
    float run[8]; float zf = 0.f; asm volatile("" : "+v"(zf));
#pragma unroll
    for (int k = 0; k < 8; ++k) run[k] = zf;
    v4u cur = *(const v4u*)(ST + (size_t)((b * 32) * 16 + head) * 8192 + off);
    for (int c = 0; c < 32; ++c) {
        v4u* p = (v4u*)(ST + (size_t)((b * 32 + c) * 16 + head) * 8192 + off);
        v4u nxt = cur; if (c < 31) nxt = *(const v4u*)(ST + (size_t)((b * 32 + c + 1) * 16 + head) * 8192 + off);
        const float dec = CDEC[(b * 32 + c) * 16 + head];
        v4u o; o.x = pk2(run[0], run[1]); o.y = pk2(run[2], run[3]); o.z = pk2(run[4], run[5]); o.w = pk2(run[6], run[7]);
        *p = o;
        const unsigned cw[4] = {cur.x, cur.y, cur.z, cur.w};
#pragma unroll
        for (int k = 0; k < 4; ++k) { run[2 * k] = dec * run[2 * k] + bflo(cw[k]); run[2 * k + 1] = dec * run[2 * k + 1] + bfhi(cw[k]); }
        cur = nxt;
    }
}

DI void ssd_passC_unit(Frame& F, const SsdPar& P, int unit) {
    const bf16* XBC = (const bf16*)(F.ws + WS_XBC); const float* DT = (const float*)(F.ws + WS_DT);
    const bf16* ST = (const bf16*)(F.ws + WS_SLOT32); bf16* GZ = (bf16*)(F.ws + WS_GZ);
    const int grp = unit & 1, c = (unit >> 1) & 31, b = unit >> 6;
    const int lane = F.lane, w = F.wave;
    const size_t t0 = (size_t)b * SEQ + c * 128;
    LAS float* cs = (LAS float*)F.lds;
    LAS float* rowss = (LAS float*)(F.lds + 132608);
    LAS unsigned char* Ct = F.lds + 4608;
    LAS unsigned char* BM = F.lds + 4608 + 34816;
    LAS unsigned char* Xd = F.lds + 74240;
    LAS unsigned char* Xr = F.lds + 94720;
    LAS unsigned char* Pv = F.lds + 115200;
    __syncthreads();
    (void)ssd_cumsum(DT, P.a_log, t0, grp, w, lane, cs);
#pragma unroll 1
    for (int which = 0; which < 2; ++which) {
        const ConvW W = load_convw(P.conv_w, P.conv_b, 1024 + which * 256 + grp * 128 + (F.tid & 15) * 8);
#pragma unroll 1
        for (int it = 0; it < 4; ++it) { const int idx = F.tid + it * NTHR, r = idx >> 4, cc = idx & 15; float o[8];
            conv8(XBC, W, t0 + r, 1024 + which * 256 + grp * 128 + cc * 8, o);
            *(LAS v4u*)((which ? Ct : BM) + r * 272 + cc * 16) = pack8(o, 1.0f); } }
    __syncthreads();
    const int wl = w >> 1, ws = w & 1, wp = w & 1;
    f32x4 cb[2][4];
#pragma unroll
    for (int a = 0; a < 2; ++a)
#pragma unroll
        for (int q = 0; q < 4; ++q) cb[a][q] = (f32x4){0.f, 0.f, 0.f, 0.f};
#pragma unroll
    for (int ks = 0; ks < 4; ++ks) {
        bf16x8 cf[2], bfr[4];
#pragma unroll
        for (int t = 0; t < 2; ++t) cf[t] = frag_rm(Ct, 272, wl * 32 + t * 16, ks * 32, lane);
#pragma unroll
        for (int t = 0; t < 4; ++t) bfr[t] = frag_rm(BM, 272, ws * 64 + t * 16, ks * 32, lane);
#pragma unroll
        for (int lt = 0; lt < 2; ++lt)
#pragma unroll
            for (int st = 0; st < 4; ++st) cb[lt][st] = mma(bfr[st], cf[lt], cb[lt][st]);
    }
#pragma unroll 1
    for (int hd = 0; hd < 8; ++hd) {
        const int head = grp * 8 + hd;
        __syncthreads();
#pragma unroll
        for (int lt = 0; lt < 2; ++lt) { const int l = wl * 32 + lt * 16 + (lane & 15); const float csl = cs[hd * 128 + l];
#pragma unroll
            for (int st = 0; st < 4; ++st) { const int s = ws * 64 + st * 16 + 4 * (lane >> 4); f32x4 m;
#pragma unroll
                for (int jj = 0; jj < 4; ++jj) m[jj] = (s + jj <= l) ? cb[lt][st][jj] * __expf(csl - cs[hd * 128 + s + jj]) : 0.f;
                *(LAS v2u*)(BM + l * 272 + s * 2) = (v2u){pk2(m[0], m[1]), pk2(m[2], m[3])}; } }
        { const ConvW W = load_convw(P.conv_w, P.conv_b, grp * 512 + hd * 64 + (F.tid & 7) * 8);
#pragma unroll 1
        for (int it = 0; it < 2; ++it) { const int idx = F.tid + it * NTHR, r = idx >> 3, cc = idx & 7; float o[8];
            conv8(XBC, W, t0 + r, grp * 512 + hd * 64 + cc * 8, o);
            *(LAS v4u*)(Xr + r * 160 + cc * 16) = pack8(o, 1.0f);
            *(LAS v4u*)(Xd + r * 160 + cc * 16) = pack8(o, DT[(t0 + r) * 16 + head]); } }
        load_tile(Pv, 272, ST + (size_t)((b * 32 + c) * 16 + head) * 8192, 128, 64, 128, F.tid);
        __syncthreads();
        f32x4 yd[2][2], yo[2][2];
#pragma unroll
        for (int a2 = 0; a2 < 2; ++a2)
#pragma unroll
            for (int q = 0; q < 2; ++q) { yd[a2][q] = (f32x4){0.f, 0.f, 0.f, 0.f}; yo[a2][q] = (f32x4){0.f, 0.f, 0.f, 0.f}; }
#pragma unroll
        for (int ks = 0; ks < 4; ++ks) {
            bf16x8 mf[2], xf[2], cf[2], pf[2];
#pragma unroll
            for (int t = 0; t < 2; ++t) { mf[t] = frag_rm(BM, 272, wl * 32 + t * 16, ks * 32, lane); xf[t] = frag_tr(Xd, 160, wp * 32 + t * 16, ks * 32, lane);
                                          cf[t] = frag_rm(Ct, 272, wl * 32 + t * 16, ks * 32, lane); pf[t] = frag_rm(Pv, 272, wp * 32 + t * 16, ks * 32, lane); }
#pragma unroll
            for (int lt = 0; lt < 2; ++lt)
#pragma unroll
                for (int pt = 0; pt < 2; ++pt) { yd[lt][pt] = mma(xf[pt], mf[lt], yd[lt][pt]); yo[lt][pt] = mma(pf[pt], cf[lt], yo[lt][pt]); }
        }
        const float dsk = P.d_ssd[head];
#pragma unroll
        for (int lt = 0; lt < 2; ++lt) { const int l = wl * 32 + lt * 16 + (lane & 15); const float ecs = __expf(cs[hd * 128 + l]); float ss = 0.f;
#pragma unroll
            for (int pt = 0; pt < 2; ++pt) { const int p = wp * 32 + pt * 16 + 4 * (lane >> 4);
                const v2u xr = *(const LAS v2u*)(Xr + l * 160 + p * 2);
                bf16* zp = GZ + (t0 + l) * 2048 + 1024 + head * 64 + p;
                const v2u zv = *(const v2u*)zp;
                f32x4 y = yd[lt][pt] + ecs * yo[lt][pt];
                y[0] = (y[0] + dsk * bflo(xr.x)) * silu_f(bflo(zv.x)); y[1] = (y[1] + dsk * bfhi(xr.x)) * silu_f(bfhi(zv.x));
                y[2] = (y[2] + dsk * bflo(xr.y)) * silu_f(bflo(zv.y)); y[3] = (y[3] + dsk * bfhi(xr.y)) * silu_f(bfhi(zv.y));
                ss += (y[0] * y[0] + y[1] * y[1]) + (y[2] * y[2] + y[3] * y[3]);
                *(v2u*)zp = (v2u){pk2(y[0], y[1]), pk2(y[2], y[3])}; }
            ss += __shfl_xor(ss, 16); ss += __shfl_xor(ss, 32);
            if ((lane >> 4) == 0) rowss[(hd * 2 + wp) * 128 + l] = ss; }
    }
    asm volatile("s_waitcnt vmcnt(0)" ::: "memory");
    __syncthreads();
    LAS float* rst = (LAS float*)F.lds;
    if (F.tid < 128) { float t = 0.f;
#pragma unroll
        for (int q = 0; q < 16; ++q) t += rowss[q * 128 + F.tid];
        rst[F.tid] = rsqrtf(t * (1.f / 512.f) + EPS); }
    __syncthreads();
    { const int cc = F.tid & 63; const f32x4 n0 = *(const f32x4*)(P.ssd_norm + grp * 512 + cc * 8), n1 = *(const f32x4*)(P.ssd_norm + grp * 512 + cc * 8 + 4);
#pragma unroll 4
      for (int it = 0; it < 16; ++it) { const int r = (F.tid >> 6) + it * 8; const float rs = rst[r];
          v4u* gp = (v4u*)(GZ + (t0 + r) * 2048 + 1024 + grp * 512 + cc * 8); const v4u v = *gp;
          v4u o; o.x = pk2(bflo(v.x) * rs * n0[0], bfhi(v.x) * rs * n0[1]); o.y = pk2(bflo(v.y) * rs * n0[2], bfhi(v.y) * rs * n0[3]);
          o.z = pk2(bflo(v.z) * rs * n1[0], bfhi(v.z) * rs * n1[1]); o.w = pk2(bflo(v.w) * rs * n1[2], bfhi(v.w) * rs * n1[3]);
          *gp = o; } }
}

struct S5Par { const float* lam_re; const float* lam_im; const float* log_step; const float* b_re; const float* b_im; const float* c_re; const float* c_im; const float* d_s5; };

DI void s5_build_unit(Frame& F, const S5Par& P, int unit) {
    const int g = unit >> 2, cq = unit & 3;
    bf16* AB = (bf16*)(F.ws + WS_S5MAT + (size_t)g * 262144); bf16* E = AB + 256 * 384;
    LAS f32x2v* pw = (LAS f32x2v*)F.lds;
    LAS f32x2v* Bb = (LAS f32x2v*)(F.lds + 8704);
    LAS f32x2v* Cc = (LAS f32x2v*)(F.lds + 16896);
    LAS float* Km = (LAS float*)(F.lds + 25088);
    __syncthreads();
    if (F.tid < 64) { const int p = F.tid;
        const double lr = fmin((double)P.lam_re[g * 64 + p], -1e-4), li = (double)P.lam_im[g * 64 + p], dl = (double)expf(P.log_step[g]);
        double a1r = 0, a1i = 0;
        for (int t = 0; t <= 16; ++t) { const double mag = (double)expf((float)(t * lr * dl)); double s, c; sincos_d(t * li * dl, s, c);
            pw[t * 64 + p] = (f32x2v){(float)(mag * c), (float)(mag * s)}; if (t == 1) { a1r = mag * c; a1i = mag * s; } }
        const double den = lr * lr + li * li, nr = a1r - 1.0, ni = a1i, cr = (nr * lr + ni * li) / den, ci = (ni * lr - nr * li) / den;
        for (int c2 = 0; c2 < 16; ++c2) { const double br = P.b_re[(g * 64 + p) * 16 + c2], bi = P.b_im[(g * 64 + p) * 16 + c2];
            Bb[p * 16 + c2] = (f32x2v){(float)(cr * br - ci * bi), (float)(cr * bi + ci * br)}; } }
    for (int i = F.tid; i < 1024; i += NTHR) Cc[i] = (f32x2v){P.c_re[g * 1024 + i], P.c_im[g * 1024 + i]};
    __syncthreads();
    for (int i = F.tid; i < 1024; i += NTHR) { const int t = i >> 6, cl = (i >> 4) & 3, c2 = i & 15, c = cq * 4 + cl; float acc = 0.f;
        for (int p = 0; p < 64; ++p) { const f32x2v cc = Cc[c * 64 + p], a = pw[t * 64 + p], bb = Bb[p * 16 + c2];
            const float tr = cc.x * a.x - cc.y * a.y, ti = cc.x * a.y + cc.y * a.x; acc += tr * bb.x - ti * bb.y; }
        Km[i] = acc; }
    __syncthreads();
    for (int i = F.tid; i < 64 * 48; i += NTHR) { const int rl = i / 48, c8 = (i % 48) * 8, l = rl >> 2, cl = rl & 3, c = cq * 4 + cl, row = l * 16 + c; float v[8];
        if (c8 < 256) { const int s = c8 >> 4, c2 = c8 & 15;
#pragma unroll
            for (int k = 0; k < 8; ++k) v[k] = s <= l ? Km[((l - s) * 4 + cl) * 16 + c2 + k] : 0.f;
        } else { const bool im = c8 >= 320; const int p0 = c8 - (im ? 320 : 256);
#pragma unroll
            for (int k = 0; k < 8; ++k) { const f32x2v cc = Cc[c * 64 + p0 + k], a = pw[(l + 1) * 64 + p0 + k];
                v[k] = im ? -(cc.x * a.y + cc.y * a.x) : (cc.x * a.x - cc.y * a.y); } }
        *(v4u*)(AB + (size_t)row * 384 + c8) = (v4u){pk2(v[0], v[1]), pk2(v[2], v[3]), pk2(v[4], v[5]), pk2(v[6], v[7])}; }
    for (int i = F.tid; i < 32 * 32; i += NTHR) { const int rl = i >> 5, c8 = (i & 31) * 8, p = cq * 16 + (rl & 15), s = c8 >> 4, c2 = c8 & 15; const bool im = rl >= 16; const int row = (im ? 64 : 0) + p; float v[8];
        const f32x2v a = pw[(15 - s) * 64 + p];
#pragma unroll
        for (int k = 0; k < 8; ++k) { const f32x2v bb = Bb[p * 16 + c2 + k]; v[k] = im ? (a.x * bb.y + a.y * bb.x) : (a.x * bb.x - a.y * bb.y); }
        *(v4u*)(E + (size_t)row * 256 + c8) = (v4u){pk2(v[0], v[1]), pk2(v[2], v[3]), pk2(v[4], v[5]), pk2(v[6], v[7])}; }
}

DI void s5_gemmA_unit(Frame& F, int unit) {
    const bf16* HN = (const bf16*)(F.ws + WS_SLOT32); float* EO = (float*)(F.ws + WS_S5E);
    const int g = unit >> 2, q = unit & 3, lane = F.lane, w = F.wave, i = lane & 15, gq = lane >> 4;
    const bf16* E = (const bf16*)(F.ws + WS_S5MAT + (size_t)g * 262144) + 256 * 384 + (q * 32) * 256;
    bf16x8 ef[2][8];
#pragma unroll
    for (int mt = 0; mt < 2; ++mt)
#pragma unroll
        for (int ks = 0; ks < 8; ++ks) ef[mt][ks] = *(const bf16x8*)(E + (mt * 16 + i) * 256 + 32 * ks + 8 * gq);
#pragma unroll 2
    for (int t = 0; t < 8; ++t) { const int nt = t * 8 + w, b = nt >> 4, k0 = (nt & 15) * 16;
        const bf16* hp = HN + ((size_t)b * SEQ + 16 * (k0 + i) + (gq >> 1)) * D + 16 * g + 8 * (gq & 1);
        bf16x8 uf[8];
#pragma unroll
        for (int ks = 0; ks < 8; ++ks) uf[ks] = *(const bf16x8*)(hp + (size_t)(2 * ks) * D);
        f32x4 acc[2] = {(f32x4){0.f, 0.f, 0.f, 0.f}, (f32x4){0.f, 0.f, 0.f, 0.f}};
#pragma unroll
        for (int ks = 0; ks < 8; ++ks)
#pragma unroll
            for (int mt = 0; mt < 2; ++mt) acc[mt] = mma(ef[mt][ks], uf[ks], acc[mt]);
        float* dst = EO + ((size_t)((b * 256 + k0 + i) * 64 + g)) * 128 + q * 32 + 4 * gq;
#pragma unroll
        for (int mt = 0; mt < 2; ++mt) *(f32x4*)(dst + mt * 16) = acc[mt]; }
}

DI void s5_scan_task(Frame& F, const float* lam_re, const float* lam_im, const float* log_step, int task, int dbg) {
    const float* EO = (const float*)(F.ws + WS_S5E); bf16* XO = (bf16*)(F.ws + WS_S5X);
    const int b = task >> 6, g = task & 63, p = F.lane;
    f32x2v a;
    { const double lr = fmin((double)lam_re[g * 64 + p], -1e-4), li = (double)lam_im[g * 64 + p], dl = (double)expf(log_step[g]);
      const double mag = (double)expf((float)(16.0 * lr * dl)); double s, c; sincos_d(16.0 * li * dl, s, c); a = (f32x2v){(float)(mag * c), (float)(mag * s)}; }
    if (dbg == 6) a = (f32x2v){0.f, 0.f};
    float rr = 0.f, ri = 0.f;
    const float* ep = EO + ((size_t)(b * 256) * 64 + g) * 128 + p; bf16* xp = XO + ((size_t)(b * 256) * 64 + g) * 128 + p;
    float er[16], ei[16], fr_[16], fi_[16];
#pragma unroll
    for (int s2 = 0; s2 < 16; ++s2) { er[s2] = ep[(size_t)s2 * 8192]; ei[s2] = ep[(size_t)s2 * 8192 + 64]; }
#pragma unroll 1
    for (int kb = 0; kb < 16; ++kb) {
        const int kn = kb < 15 ? kb + 1 : kb;
#pragma unroll
        for (int s2 = 0; s2 < 16; ++s2) { fr_[s2] = ep[(size_t)(kn * 16 + s2) * 8192]; fi_[s2] = ep[(size_t)(kn * 16 + s2) * 8192 + 64]; }
#pragma unroll
        for (int s2 = 0; s2 < 16; ++s2) { bf16* xo = xp + (size_t)(kb * 16 + s2) * 8192;
            xo[0] = (bf16)f2bf(rr); xo[64] = (bf16)f2bf(ri);
            const float nr = a.x * rr - a.y * ri + er[s2], ni = a.x * ri + a.y * rr + ei[s2]; rr = nr; ri = ni; }
#pragma unroll
        for (int s2 = 0; s2 < 16; ++s2) { er[s2] = fr_[s2]; ei[s2] = fi_[s2]; }
    }
}

DI float gelu_tanh(float v) { const float u = 0.7978845608028654f * (v + 0.044715f * v * v * v); const float t = 1.0f - 2.0f / (__expf(2.0f * u) + 1.0f); return 0.5f * v * (1.0f + t); }

DI void s5_gemmB_unit(Frame& F, const float* d_s5, int unit) {
    const bf16* HN = (const bf16*)(F.ws + WS_SLOT32); const bf16* XO = (const bf16*)(F.ws + WS_S5X); bf16* Y = (bf16*)(F.ws + WS_Y);
    const int g = unit >> 2, lq = unit & 3, lane = F.lane, w = F.wave, i = lane & 15, gq = lane >> 4;
    const bf16* AB = (const bf16*)(F.ws + WS_S5MAT + (size_t)g * 262144) + (size_t)(64 * lq) * 384;
    LAS unsigned char* A = F.lds;
    __syncthreads();
    load_tile(A, 784, AB, 384, 64, 384, F.tid);
    __syncthreads();
    const int colg = 16 * g + 4 * gq;
    const f32x4 dv = *(const f32x4*)(d_s5 + colg);
#pragma unroll 1
    for (int t = 0; t < 8; ++t) { const int nt = t * 8 + w, b = nt >> 4, k0 = (nt & 15) * 16;
        const bf16* hp = HN + ((size_t)b * SEQ + 16 * (k0 + i) + (gq >> 1)) * D + 16 * g + 8 * (gq & 1);
        const bf16* xp = XO + ((size_t)((b * 256 + k0 + i) * 64 + g)) * 128 + 8 * gq;
        bf16x8 uf[12];
#pragma unroll
        for (int ks = 0; ks < 8; ++ks) uf[ks] = *(const bf16x8*)(hp + (size_t)(2 * ks) * D);
#pragma unroll
        for (int ks = 0; ks < 4; ++ks) uf[8 + ks] = *(const bf16x8*)(xp + ks * 32);
        f32x4 acc[4];
#pragma unroll
        for (int mt = 0; mt < 4; ++mt) acc[mt] = (f32x4){0.f, 0.f, 0.f, 0.f};
#pragma unroll
        for (int ks = 0; ks < 12; ++ks) {
#pragma unroll
            for (int mt = 0; mt < 4; ++mt) acc[mt] = mma(frag_rm(A, 784, mt * 16, ks * 32, lane), uf[ks], acc[mt]);
            if (ks & 1) __builtin_amdgcn_sched_barrier(0); }
#pragma unroll
        for (int mt = 0; mt < 4; ++mt) { const size_t tok = (size_t)b * SEQ + 16 * (k0 + i) + 4 * lq + mt;
            const v2u hv = *(const v2u*)(HN + tok * D + colg);
            const float y0 = gelu_tanh(acc[mt][0] + dv[0] * bflo(hv.x)), y1 = gelu_tanh(acc[mt][1] + dv[1] * bfhi(hv.x));
            const float y2 = gelu_tanh(acc[mt][2] + dv[2] * bflo(hv.y)), y3 = gelu_tanh(acc[mt][3] + dv[3] * bfhi(hv.y));
            *(v2u*)(Y + tok * D + colg) = (v2u){pk2(y0, y1), pk2(y2, y3)}; } }
}

#ifndef REP_BAR
#define REP_BAR 1
#endif
#ifndef REP_CONV
#define REP_CONV 1
#endif
#ifndef REP_ROW
#define REP_ROW 1
#endif
#ifndef REP_GEMM
#define REP_GEMM 1
#endif
#ifndef REP_S5A
#define REP_S5A 1
#endif
#ifndef REP_S5S
#define REP_S5S 1
#endif
#ifndef REP_S5B
#define REP_S5B 1
#endif
#ifndef REP_RA
#define REP_RA 1
#endif
#ifndef REP_SA
#define REP_SA 1
#endif
#ifndef SKIP_EVEN
#define SKIP_EVEN 0
#endif
#ifndef SKIP_ODD
#define SKIP_ODD 0
#endif
DI int opq(int v) { asm volatile("" : "+s"(v)); return v; }
struct Args { const float* in[N_IN]; float* out; unsigned char* ws; };
constexpr int CW_BAR = 1024;

#define PHASE() do { unsigned z_ = 0u; asm volatile("" : "+s"(z_)); int l_ = __builtin_amdgcn_mbcnt_hi(~0u, __builtin_amdgcn_mbcnt_lo(~0u, z_)); int w_ = wave0; asm volatile("" : "+s"(w_)); \
        int g_ = gridDim.x, b_ = blockIdx.x; asm volatile("" : "+s"(g_), "+s"(b_)); F.G = g_; F.bid = b_; F.vcu = (g_ % 8 == 0) ? (b_ % 8) * (g_ / 8) + b_ / 8 : b_; F.lane = l_; F.wave = w_; F.tid = w_ * 64 + l_; F.out = (float*)(GAS float*)lds_ptr(F, N_IN); F.ws = (unsigned char*)(GAS unsigned char*)lds_ptr(F, N_IN + 1); } while (0)
#define WSP(T, off) ((T*)(F.ws + (off)))
#define GRID_BAR() do { PHASE(); XcdBarrier xb_; xb_.bar = (unsigned*)(F.ws + WS_CTL) + CW_BAR; xb_.x = xb_xcc_id(); xb_.tid = F.tid; xb_.st = (volatile LAS unsigned*)(F.lds + MISC_OFF) + 8; xcd_barrier(xb_); if (REP_BAR == 2) xcd_barrier(xb_); PHASE(); } while (0)
template <int layer> __device__ __forceinline__ void run_layer(Frame& F, const int wave0) {
        const int j = layer >> 1;
        if ((layer & 1) == 0) {
            if (!opq(SKIP_EVEN)) {
            { pg8::Gemm g{WSP(bf16, WS_SLOT32), WSP(bf16, WS_SLOT16), M, INP_PAD, D}; pg8::StaticOrder S; S.init(M, INP_PAD, F.G, F.bid);
              pg8::EpiInProj E{WSP(bf16, WS_QKV), WSP(bf16, WS_GZ), WSP(bf16, WS_XBC), WSP(float, WS_DT), (const float*)(F.ws + WS_ROPE), INP(I_DT_BIAS) + j * 16};
              pg8::gemm_phase<pg8::EpiInProj, pg8::StaticOrder, true, true>(F.lds, g, S, E, F.tid); }
#if REP_GEMM == 2
            { PHASE(); pg8::Gemm g{WSP(bf16, WS_SLOT32), WSP(bf16, WS_SLOT16), M, INP_PAD, D}; pg8::StaticOrder S; S.init(M, INP_PAD, F.G, F.bid);
              pg8::EpiInProj E{WSP(bf16, WS_QKV), WSP(bf16, WS_GZ), WSP(bf16, WS_XBC), WSP(float, WS_DT), (const float*)(F.ws + WS_ROPE), INP(I_DT_BIAS) + j * 16};
              pg8::gemm_phase<pg8::EpiInProj, pg8::StaticOrder, true, true>(F.lds, g, S, E, F.tid); }
#endif
            GRID_BAR();
            for (int rep_ = 0; rep_ < REP_RA; ++rep_) for (int u = F.vcu; u < 256; u += F.G) ret_passA_unit(F, u);
            { const SsdPar SP{INP(I_CONV_W) + (size_t)j * 4 * 1536, INP(I_CONV_B) + j * 1536, INP(I_A_LOG) + j * 16, INP(I_D_SSD) + j * 16, INP(I_SSD_NORM) + j * 1024};
              for (int rep_ = 0; rep_ < REP_SA; ++rep_) for (int u = F.vcu; u < 256; u += F.G) ssd_passA_unit(F, SP, u); }
            GRID_BAR();
            for (int it = (F.bid * NTHR + F.tid); it < 131072; it += (F.G * NTHR)) ret_scan_item(F, it);
            for (int it = (F.bid * NTHR + F.tid); it < 65536; it += (F.G * NTHR)) ssd_scan_item(F, it);
            GRID_BAR();
            for (int u = F.vcu; u < 256; u += F.G) ret_passC_unit(F, u);
            { const SsdPar SP{INP(I_CONV_W) + (size_t)j * 4 * 1536, INP(I_CONV_B) + j * 1536, INP(I_A_LOG) + j * 16, INP(I_D_SSD) + j * 16, INP(I_SSD_NORM) + j * 1024};
              for (int u = F.vcu; u < 256; u += F.G) ssd_passC_unit(F, SP, u); }
            GRID_BAR();
            }
            __syncthreads();
            convert_weight(F, INP(I_W_UP) + (size_t)layer * D * FF, D, FF, WSP(bf16, WS_SLOT16), 0);
#if REP_CONV == 2
            convert_weight(F, INP(I_W_UP) + (size_t)layer * D * FF, D, FF, WSP(bf16, WS_SLOT16), 0);
#endif
            convert_weight(F, INP(I_W_DOWN) + (size_t)layer * FF * D, FF, D, WSP(bf16, WS_SLOT16) + (size_t)FF * D, 0);
#if REP_CONV == 2
            convert_weight(F, INP(I_W_DOWN) + (size_t)layer * FF * D, FF, D, WSP(bf16, WS_SLOT16) + (size_t)FF * D, 0);
#endif
            __syncthreads();
            if (!opq(SKIP_EVEN)) {
            { pg8::Gemm g{WSP(bf16, WS_GZ), WSP(bf16, WS_W4), M, D, 2048}; pg8::StaticOrder S; S.init(M, D, F.G, F.bid);
              pg8::EpiF32 E{WSP(float, WS_M32A), D};
              pg8::gemm_phase<pg8::EpiF32, pg8::StaticOrder, true, true>(F.lds, g, S, E, F.tid); }
#if REP_GEMM == 2
            { PHASE(); pg8::Gemm g{WSP(bf16, WS_GZ), WSP(bf16, WS_W4), M, D, 2048}; pg8::StaticOrder S; S.init(M, D, F.G, F.bid);
              pg8::EpiF32 E{WSP(float, WS_M32A), D};
              pg8::gemm_phase<pg8::EpiF32, pg8::StaticOrder, true, true>(F.lds, g, S, E, F.tid); }
#endif
            } else zero_fill(F, WSP(float, WS_M32A), (size_t)M * D * 4);
            GRID_BAR();
#if REP_ROW == 2
            row_phase(F, WSP(float, WS_M32A), (layer == 0 ? INP(I_X) : (const float*)F.out), WSP(float, WS_GZ), INP(I_POST_MIX) + layer * D, INP(I_PRE_MLP) + layer * D, WSP(bf16, WS_XBC));
#endif
            row_phase(F, WSP(float, WS_M32A), (layer == 0 ? INP(I_X) : (const float*)F.out), F.out, INP(I_POST_MIX) + layer * D, INP(I_PRE_MLP) + layer * D, WSP(bf16, WS_SLOT32));
            GRID_BAR();
        } else {
            if (opq(SKIP_ODD) == 2) {
                const v4u* s_ = (const v4u*)WSP(bf16, WS_SLOT32); v4u* d_ = (v4u*)WSP(bf16, WS_Y);
                for (size_t i_ = (size_t)F.bid * NTHR + F.tid; i_ < (size_t)M * D / 8; i_ += (size_t)F.G * NTHR) d_[i_] = s_[i_];
                GRID_BAR();
            }
            if (opq(SKIP_ODD) == 0 || opq(SKIP_ODD) >= 3) {
            for (int rep_ = 0; rep_ < REP_S5A; ++rep_) for (int u = F.vcu; u < 256; u += F.G) s5_gemmA_unit(F, u);
            GRID_BAR();
            if (opq(SKIP_ODD) == 3) zero_fill(F, WSP(bf16, WS_S5X), (size_t)16 * MiB);
            else if (F.wave == 0) for (int rep_ = 0; rep_ < REP_S5S; ++rep_) for (int t = F.bid; t < 256; t += F.G) s5_scan_task(F, INP(I_LAM_RE) + j * 4096, INP(I_LAM_IM) + j * 4096, INP(I_LOG_STEP) + j * 64, t, opq(SKIP_ODD));
            GRID_BAR();
            for (int rep_ = 0; rep_ < REP_S5B; ++rep_) for (int u = F.vcu; u < 256; u += F.G) s5_gemmB_unit(F, INP(I_D_S5) + j * 1024, u);
            GRID_BAR();
            }
            __syncthreads();
            convert_weight(F, INP(I_W_UP) + (size_t)layer * D * FF, D, FF, WSP(bf16, WS_SLOT16), 0);
#if REP_CONV == 2
            convert_weight(F, INP(I_W_UP) + (size_t)layer * D * FF, D, FF, WSP(bf16, WS_SLOT16), 0);
#endif
            convert_weight(F, INP(I_W_DOWN) + (size_t)layer * FF * D, FF, D, WSP(bf16, WS_SLOT16) + (size_t)FF * D, 0);
#if REP_CONV == 2
            convert_weight(F, INP(I_W_DOWN) + (size_t)layer * FF * D, FF, D, WSP(bf16, WS_SLOT16) + (size_t)FF * D, 0);
#endif
            __syncthreads();
            if (opq(SKIP_ODD) != 1) {
            { pg8::Gemm g{WSP(bf16, WS_Y), WSP(bf16, WS_W4), M, 2048, D}; pg8::StaticOrder S; S.init(M, 2048, F.G, F.bid);
              pg8::EpiGlu E{WSP(float, WS_M32B), D};
              pg8::gemm_phase<pg8::EpiGlu, pg8::StaticOrder, true, true>(F.lds, g, S, E, F.tid); }
#if REP_GEMM == 2
            { PHASE(); pg8::Gemm g{WSP(bf16, WS_Y), WSP(bf16, WS_W4), M, 2048, D}; pg8::StaticOrder S; S.init(M, 2048, F.G, F.bid);
              pg8::EpiGlu E{WSP(float, WS_M32B), D};
              pg8::gemm_phase<pg8::EpiGlu, pg8::StaticOrder, true, true>(F.lds, g, S, E, F.tid); }
#endif
            } else zero_fill(F, WSP(float, WS_M32B), (size_t)M * D * 4);
            GRID_BAR();
#if REP_ROW == 2
            row_phase(F, WSP(float, WS_M32B), (layer == 0 ? INP(I_X) : (const float*)F.out), WSP(float, WS_QKV), INP(I_POST_MIX) + layer * D, INP(I_PRE_MLP) + layer * D, WSP(bf16, WS_Y));
#endif
            row_phase(F, WSP(float, WS_M32B), (layer == 0 ? INP(I_X) : (const float*)F.out), F.out, INP(I_POST_MIX) + layer * D, INP(I_PRE_MLP) + layer * D, WSP(bf16, WS_SLOT32));
            GRID_BAR();
        }
        { pg8::Gemm g{WSP(bf16, WS_SLOT32), WSP(bf16, WS_SLOT16), M, FF, D}; pg8::StaticOrder S; S.init(M, FF, F.G, F.bid);
          pg8::EpiRelu2 E{WSP(bf16, WS_U), FF};
          pg8::gemm_phase<pg8::EpiRelu2, pg8::StaticOrder, true, true>(F.lds, g, S, E, F.tid); }
#if REP_GEMM == 2
            { PHASE(); pg8::Gemm g{WSP(bf16, WS_SLOT32), WSP(bf16, WS_SLOT16), M, FF, D}; pg8::StaticOrder S; S.init(M, FF, F.G, F.bid);
          pg8::EpiRelu2 E{WSP(bf16, WS_U), FF};
          pg8::gemm_phase<pg8::EpiRelu2, pg8::StaticOrder, true, true>(F.lds, g, S, E, F.tid); }
#endif
        GRID_BAR();
        __syncthreads();
        if ((layer & 1) == 0) { convert_weight(F, INP(I_W_GLU_A) + (size_t)j * D * D, D, D, WSP(bf16, WS_W4), 1); convert_weight(F, INP(I_W_GLU_B) + (size_t)j * D * D, D, D, WSP(bf16, WS_W4), 2); }
#if REP_CONV == 2
        if ((layer & 1) == 0) { convert_weight(F, INP(I_W_GLU_A) + (size_t)j * D * D, D, D, WSP(bf16, WS_W4), 1); convert_weight(F, INP(I_W_GLU_B) + (size_t)j * D * D, D, D, WSP(bf16, WS_W4), 2); }
#endif
        __syncthreads();
        { pg8::Gemm g{WSP(bf16, WS_U), WSP(bf16, WS_SLOT16) + (size_t)FF * D, M, D, FF}; pg8::StaticOrder S; S.init(M, D, F.G, F.bid);
          pg8::EpiF32 E{WSP(float, WS_M32B), D};
          pg8::gemm_phase<pg8::EpiF32, pg8::StaticOrder, true, true>(F.lds, g, S, E, F.tid); }
#if REP_GEMM == 2
            { PHASE(); pg8::Gemm g{WSP(bf16, WS_U), WSP(bf16, WS_SLOT16) + (size_t)FF * D, M, D, FF}; pg8::StaticOrder S; S.init(M, D, F.G, F.bid);
          pg8::EpiF32 E{WSP(float, WS_M32B), D};
          pg8::gemm_phase<pg8::EpiF32, pg8::StaticOrder, true, true>(F.lds, g, S, E, F.tid); }
#endif
        GRID_BAR();
#if REP_ROW == 2
        row_phase(F, WSP(float, WS_M32B), F.out, WSP(float, WS_QKV), INP(I_POST_MLP) + layer * D, INP(I_PRE_MIX), WSP(bf16, WS_Y));
#endif
        row_phase(F, WSP(float, WS_M32B), F.out, F.out, INP(I_POST_MLP) + layer * D, layer < DEPTH - 1 ? INP(I_PRE_MIX) + (layer + 1) * D : nullptr, layer < DEPTH - 1 ? WSP(bf16, WS_SLOT32) : nullptr);
        if (layer == 0 || layer == 2) {
            const S5Par P5{INP(I_LAM_RE) + j * 4096, INP(I_LAM_IM) + j * 4096, INP(I_LOG_STEP) + j * 64, INP(I_B_RE) + (size_t)j * 65536, INP(I_B_IM) + (size_t)j * 65536,
                           INP(I_C_RE) + (size_t)j * 65536, INP(I_C_IM) + (size_t)j * 65536, INP(I_D_S5) + j * 1024};
            for (int u = F.bid; u < 256; u += F.G) s5_build_unit(F, P5, u);
        } else if (layer == 1) {
            __syncthreads();
            convert_weight(F, INP(I_W_IN) + (size_t)D * INP, D, INP, WSP(bf16, WS_SLOT16), 0);
#if REP_CONV == 2
            convert_weight(F, INP(I_W_IN) + (size_t)D * INP, D, INP, WSP(bf16, WS_SLOT16), 0);
#endif
            zero_fill(F, WSP(bf16, WS_SLOT16) + (size_t)6688 * D, (size_t)(INP_PAD - 6688) * D * 2);
            convert_weight(F, INP(I_W_OUT) + (size_t)2048 * D, 2048, D, WSP(bf16, WS_W4), 0);
#if REP_CONV == 2
            convert_weight(F, INP(I_W_OUT) + (size_t)2048 * D, 2048, D, WSP(bf16, WS_W4), 0);
#endif
        }
        if (layer < DEPTH - 1) GRID_BAR();

}

__global__ void __launch_bounds__(NTHR, 2) trunk_fwd(Args args) {
    extern __shared__ __attribute__((aligned(16))) unsigned char lds[];
    Frame F;
    F.lds = (LAS unsigned char*)lds;
    F.G = gridDim.x; F.bid = blockIdx.x;
    { const int t = threadIdx.x;
      for (int u = t; u < (LDS_BYTES - MISC_OFF) / 4; u += NTHR) ((LAS unsigned*)(F.lds + MISC_OFF))[u] = 0u;
      __syncthreads();
      if (t < N_IN + 2) ((LAS unsigned long long*)(F.lds + MISC_OFF + 256))[t] = t < N_IN ? (unsigned long long)args.in[t] : (t == N_IN ? (unsigned long long)args.out : (unsigned long long)args.ws);
      __syncthreads(); }
    const int wave0 = __builtin_amdgcn_readfirstlane(threadIdx.x >> 6);
    PHASE();
    (void)xcd_barrier_post((unsigned*)(F.ws + WS_CTL) + CW_BAR, (volatile LAS unsigned*)(F.lds + MISC_OFF) + 8);

    build_rope(F);
    convert_weight(F, INP(I_W_IN), D, INP, WSP(bf16, WS_SLOT16), 0);
#if REP_CONV == 2
    convert_weight(F, INP(I_W_IN), D, INP, WSP(bf16, WS_SLOT16), 0);
#endif
    zero_fill(F, WSP(bf16, WS_SLOT16) + (size_t)6688 * D, (size_t)(INP_PAD - 6688) * D * 2);
    convert_weight(F, INP(I_W_OUT), 2048, D, WSP(bf16, WS_W4), 0);
#if REP_CONV == 2
    convert_weight(F, INP(I_W_OUT), 2048, D, WSP(bf16, WS_W4), 0);
#endif
    rms_rows_to_bf16(F, INP(I_X), INP(I_PRE_MIX), WSP(bf16, WS_SLOT32));
    GRID_BAR();

    run_layer<0>(F, wave0); run_layer<1>(F, wave0); run_layer<2>(F, wave0); run_layer<3>(F, wave0);
}

extern "C" void kernel_launch(void* const* d_in, const int* in_sizes, int n_in, void* d_out, int out_size, void* d_ws, size_t ws_size, hipStream_t stream) {
    static int grid = 0;
    if (grid == 0) {
        if (n_in != N_IN || out_size != M * D || ws_size < WS_END) { fprintf(stderr, "kernel_launch: unexpected shapes (n_in %d, out %d, ws %zu)\n", n_in, out_size, ws_size); grid = -1; return; }
        int dev = 0, cus = 0, per_cu = 0;
        if (hipGetDevice(&dev) != hipSuccess || hipDeviceGetAttribute(&cus, hipDeviceAttributeMultiprocessorCount, dev) != hipSuccess) { grid = -1; return; }
        if (hipFuncSetAttribute((const void*)trunk_fwd, hipFuncAttributeMaxDynamicSharedMemorySize, LDS_BYTES) != hipSuccess) { fprintf(stderr, "kernel_launch: hipFuncSetAttribute failed\n"); grid = -1; return; }
        if (hipOccupancyMaxActiveBlocksPerMultiprocessor(&per_cu, (const void*)trunk_fwd, NTHR, LDS_BYTES) != hipSuccess || per_cu < 1)
            fprintf(stderr, "kernel_launch: note: occupancy query reports %d workgroups per CU\n", per_cu);
        (void)hipGetLastError();
        grid = cus;
    }
    if (grid < 0) return;
    if (hipMemsetAsync((char*)d_ws + WS_CTL, 0, CTL_ZERO_BYTES, stream) != hipSuccess) return;
#ifdef DBG_ZERO_MISC
    if (hipMemsetAsync((char*)d_ws + WS_MISC, 0, 512 * 1024, stream) != hipSuccess) return;
#endif
    Args a{};
    for (int i = 0; i < N_IN; ++i) a.in[i] = (const float*)d_in[i];
    a.out = (float*)d_out; a.ws = (unsigned char*)d_ws;
    hipLaunchKernelGGL(trunk_fwd, dim3(grid), dim3(NTHR), LDS_BYTES, stream, a);
}
```

```cpp
#include <hip/hip_runtime.h>
#include <cstdio>
#include <cstdint>
namespace pg8 {
#define PG8_LAS __attribute__((address_space(3)))
typedef unsigned short bf16_t;
typedef short bf16x8 __attribute__((ext_vector_type(8)));
typedef float f32x4 __attribute__((ext_vector_type(4)));
typedef unsigned u32x4 __attribute__((ext_vector_type(4)));
constexpr int BM = 256, BK = 64, HALF = 128, HTB = HALF * BK * 2  , STAGE_BYTES = 8 * HTB, NXCD = 8, WGM = 8;

__host__ __device__ __forceinline__ int lds_byte(int r, int c) { const int st = (r >> 4) * 2 + (c >> 5), rr = r & 15, cc = c & 31, ob = rr * 64 + cc * 2; return st * 1024 + (ob ^ (((ob >> 9) & 1) << 5)); }
__host__ __device__ __forceinline__ void stage_rc(int b, int& R, int& C) { const int st = b / 1024, sb = b % 1024, swz = sb ^ (((sb >> 9) & 1) << 5); R = (st >> 1) * 16 + swz / 64; C = (st & 1) * 32 + (swz % 64) / 2; }
__host__ __device__ __forceinline__ int perm32(int rho) { const int n = rho >> 4, i = rho & 15; return 8 * (i >> 2) + 4 * n + (i & 3); }

struct Unit { int pm, pn; };
struct Gemm { const bf16_t* A; const bf16_t* Bt; int M, N, K; };

struct StaticOrder {
    int nM, nN, nwg, G, c;
    __host__ __device__ void init(int M, int N, int G_, int c_) { nM = M / BM; nN = N / BM; nwg = nM * nN; G = G_; c = c_; }
    __host__ __device__ bool next(int i, Unit& u) const {
        const long L = (long)i * G + c; if (L >= nwg) return false;
        int wgid = (int)L; { const int q = nwg / NXCD, r = nwg % NXCD, xcd = wgid % NXCD, off = wgid / NXCD; wgid = (xcd < r ? xcd * (q + 1) : r * (q + 1) + (xcd - r) * q) + off; }
        const int nig = WGM * nN, gid = wgid / nig, fm = gid * WGM, gsz = (nM - fm) < WGM ? (nM - fm) : WGM;
        u.pm = fm + ((wgid % nig) % gsz); u.pn = (wgid % nig) / gsz; return true;
    }
    __device__ __forceinline__ void a_ready(const Unit&) const {}
    __device__ __forceinline__ void done(const Unit&) const {}
};

typedef __bf16 bf2_t __attribute__((ext_vector_type(2))); typedef float f32x2p __attribute__((ext_vector_type(2)));
__device__ __forceinline__ unsigned cvt_pk_bf16(float lo, float hi) { const f32x2p v = {lo, hi}; return __builtin_bit_cast(unsigned, __builtin_convertvector(v, bf2_t)); }
typedef float f32x2 __attribute__((ext_vector_type(2)));
struct EpiBf16 {
    static constexpr bool PERM = true, AFTER_DRAIN = false;
    bf16_t* O; int ldc;
    __device__ __forceinline__ void operator()(const f32x4 (&acc)[2][2][4][2], const Unit& u, int wr, int wc, int fr_in, int fq_in) const {
        int fr = fr_in, fq = fq_in; asm volatile("" : "+v"(fr), "+v"(fq));
        const int row0 = u.pm * BM + wr * 64 + fr, col0 = u.pn * BM + wc * 32 + 8 * fq;
#pragma unroll
        for (int ai = 0; ai < 2; ++ai)
#pragma unroll
            for (int m = 0; m < 4; ++m) { bf16_t* rowp = O + (size_t)(row0 + ai * HALF + m * 16) * ldc + col0;
#pragma unroll
                for (int bj = 0; bj < 2; ++bj) { const f32x4 v0 = acc[ai][bj][m][0], v1 = acc[ai][bj][m][1];
                    u32x4 w; w.x = cvt_pk_bf16(v0[0], v0[1]); w.y = cvt_pk_bf16(v0[2], v0[3]); w.z = cvt_pk_bf16(v1[0], v1[1]); w.w = cvt_pk_bf16(v1[2], v1[3]);
                    *(u32x4*)(rowp + bj * HALF) = w; } }
    }
};
struct EpiGlu {
    static constexpr bool PERM = true, AFTER_DRAIN = false;
    bf16_t* O; int ldc;
    __device__ __forceinline__ void operator()(const f32x4 (&acc)[2][2][4][2], const Unit& u, int wr, int wc, int fr_in, int fq_in) const {
        int fr = fr_in, fq = fq_in; asm volatile("" : "+v"(fr), "+v"(fq));
        const int row0 = u.pm * BM + wr * 64 + fr, col0 = u.pn * HALF + wc * 32 + 8 * fq;
#pragma unroll
        for (int ai = 0; ai < 2; ++ai)
#pragma unroll
            for (int m = 0; m < 4; ++m) { bf16_t* rowp = O + (size_t)(row0 + ai * HALF + m * 16) * ldc + col0;
                f32x4 o[2];
#pragma unroll
                for (int n = 0; n < 2; ++n) { const f32x4 a = acc[ai][0][m][n], b = acc[ai][1][m][n];
#pragma unroll
                    for (int j = 0; j < 4; ++j) o[n][j] = a[j] / (1.0f + __expf(-b[j])); }
                u32x4 w; w.x = cvt_pk_bf16(o[0][0], o[0][1]); w.y = cvt_pk_bf16(o[0][2], o[0][3]); w.z = cvt_pk_bf16(o[1][0], o[1][1]); w.w = cvt_pk_bf16(o[1][2], o[1][3]);
                *(u32x4*)rowp = w; }
    }
};
struct EpiRelu2 {
    static constexpr bool PERM = true, AFTER_DRAIN = false;
    bf16_t* O; int ldc;
    __device__ __forceinline__ void operator()(const f32x4 (&acc)[2][2][4][2], const Unit& u, int wr, int wc, int fr_in, int fq_in) const {
        int fr = fr_in, fq = fq_in; asm volatile("" : "+v"(fr), "+v"(fq));
        const int row0 = u.pm * BM + wr * 64 + fr, col0 = u.pn * BM + wc * 32 + 8 * fq;
#pragma unroll
        for (int ai = 0; ai < 2; ++ai)
#pragma unroll
            for (int m = 0; m < 4; ++m) { bf16_t* rowp = O + (size_t)(row0 + ai * HALF + m * 16) * ldc + col0;
#pragma unroll
                for (int bj = 0; bj < 2; ++bj) { f32x4 v0 = acc[ai][bj][m][0], v1 = acc[ai][bj][m][1];
#pragma unroll
                    for (int j = 0; j < 4; ++j) { const float a = fmaxf(v0[j], 0.f), b = fmaxf(v1[j], 0.f); v0[j] = a * a; v1[j] = b * b; }
                    u32x4 w; w.x = cvt_pk_bf16(v0[0], v0[1]); w.y = cvt_pk_bf16(v0[2], v0[3]); w.z = cvt_pk_bf16(v1[0], v1[1]); w.w = cvt_pk_bf16(v1[2], v1[3]);
                    *(u32x4*)(rowp + bj * HALF) = w; } }
    }
};
struct EpiInProj {
    static constexpr bool PERM = true, AFTER_DRAIN = false;
    bf16_t* QKV; bf16_t* GZ; bf16_t* XBC; float* DT; const float* rope; const float* dt_bias;
    __device__ __forceinline__ void operator()(const f32x4 (&acc)[2][2][4][2], const Unit& u, int wr, int wc, int fr_in, int fq_in) const {
        int fr = fr_in, fq = fq_in; asm volatile("" : "+v"(fr), "+v"(fq));
        const int pn = u.pn, row0 = u.pm * BM + wr * 64 + fr, cin = wc * 32 + 8 * fq;
        if (pn < 8) {
            const int hd = pn & 3; const bool isk = pn >= 4;
            const float lg2 = __log2f(1.0f - exp2f(-5.0f - (float)hd));
#pragma unroll
            for (int ai = 0; ai < 2; ++ai)
#pragma unroll
                for (int m = 0; m < 4; ++m) { const int row = row0 + ai * HALF + m * 16, pos = row & 4095, r = pos & 127;
                    const float sc = isk ? exp2f(-(float)r * lg2) * 0.0625f : exp2f((float)r * lg2);
                    const f32x4* rp = (const f32x4*)(rope + ((size_t)pos * 128 + cin) * 2);
                    f32x4 o1[2], o2[2];
#pragma unroll
                    for (int n = 0; n < 2; ++n) { const f32x4 cs0 = rp[2 * n], cs1 = rp[2 * n + 1];
                        const f32x4 x1 = acc[ai][0][m][n], x2 = acc[ai][1][m][n];
                        const float c[4] = {cs0[0], cs0[2], cs1[0], cs1[2]}, s[4] = {cs0[1], cs0[3], cs1[1], cs1[3]};
#pragma unroll
                        for (int j = 0; j < 4; ++j) { o1[n][j] = (x1[j] * c[j] - x2[j] * s[j]) * sc; o2[n][j] = (x2[j] * c[j] + x1[j] * s[j]) * sc; } }
                    bf16_t* rowp = QKV + (size_t)row * 3072 + pn * 256 + cin;
                    u32x4 w; w.x = cvt_pk_bf16(o1[0][0], o1[0][1]); w.y = cvt_pk_bf16(o1[0][2], o1[0][3]); w.z = cvt_pk_bf16(o1[1][0], o1[1][1]); w.w = cvt_pk_bf16(o1[1][2], o1[1][3]);
                    *(u32x4*)rowp = w;
                    w.x = cvt_pk_bf16(o2[0][0], o2[0][1]); w.y = cvt_pk_bf16(o2[0][2], o2[0][3]); w.z = cvt_pk_bf16(o2[1][0], o2[1][1]); w.w = cvt_pk_bf16(o2[1][2], o2[1][3]);
                    *(u32x4*)(rowp + HALF) = w; }
        } else if (pn < 26) {
            bf16_t* base; int ldc, colt;
            if (pn < 12) { base = QKV; ldc = 3072; colt = pn * 256; } else if (pn < 20) { base = GZ; ldc = 2048; colt = (pn - 12) * 256; } else { base = XBC; ldc = 1536; colt = (pn - 20) * 256; }
#pragma unroll
            for (int ai = 0; ai < 2; ++ai)
#pragma unroll
                for (int m = 0; m < 4; ++m) { bf16_t* rowp = base + (size_t)(row0 + ai * HALF + m * 16) * ldc + colt + cin;
#pragma unroll
                    for (int bj = 0; bj < 2; ++bj) { const f32x4 v0 = acc[ai][bj][m][0], v1 = acc[ai][bj][m][1];
                        u32x4 w; w.x = cvt_pk_bf16(v0[0], v0[1]); w.y = cvt_pk_bf16(v0[2], v0[3]); w.z = cvt_pk_bf16(v1[0], v1[1]); w.w = cvt_pk_bf16(v1[2], v1[3]);
                        *(u32x4*)(rowp + bj * HALF) = w; } }
        } else {
            if (cin < 16) {
#pragma unroll
                for (int ai = 0; ai < 2; ++ai)
#pragma unroll
                    for (int m = 0; m < 4; ++m) { float* rowp = DT + (size_t)(row0 + ai * HALF + m * 16) * 16 + cin;
#pragma unroll
                        for (int n = 0; n < 2; ++n) { f32x4 o;
#pragma unroll
                            for (int j = 0; j < 4; ++j) { const float x = acc[ai][0][m][n][j] + dt_bias[cin + 4 * n + j]; o[j] = x > 20.f ? x : log1pf(__expf(x)); }
                            *(f32x4*)(rowp + 4 * n) = o; } }
            }
        }
    }
};
template <class Epi, class Sched, bool ALIGN_EPI = false, bool SP2 = false>
__device__ __forceinline__ void gemm_phase(PG8_LAS unsigned char* lds, const Gemm g, const Sched& S, const Epi& E, const int tid) {
    const int wid = __builtin_amdgcn_readfirstlane(tid >> 6), lane = tid & 63, wr = wid >> 2, wc = wid & 3, fr = lane & 15, fq = lane >> 4;
    const int K = g.K, nt = K / BK;
    unsigned voffA[2], voffB[2];
#pragma unroll
    for (int i = 0; i < 2; ++i) { int R, C; stage_rc(tid * 16 + i * 8192, R, C); const int Rb = Epi::PERM ? ((R & ~31) + perm32(R & 31)) : R;
        voffA[i] = (unsigned)(R * K + C) * 2u; voffB[i] = (unsigned)(Rb * K + C) * 2u; }
    const size_t kstep = (size_t)(BK * 2);
    const size_t hstep = (size_t)HALF * K * 2;
    const size_t tstep = 2 * hstep;
    const unsigned ldsw = (unsigned)wid * 1024u;
    const int aoff = lds_byte(wr * 64 + fr, fq * 8), boff = lds_byte(wc * 32 + fr, fq * 8);
#define PG8_SA(b, h) (((b) * 2 + (h)) * HTB)
#define PG8_SB(b, h) ((4 + (b) * 2 + (h)) * HTB)
#define PG8_STAGE(bufoff, gbase, voff) do { _Pragma("unroll") for (int _i = 0; _i < 2; ++_i) \
        __builtin_amdgcn_global_load_lds((const unsigned*)((const char*)(gbase) + (voff)[_i]), (PG8_LAS unsigned*)(lds + (bufoff) + ldsw + _i * 8192), 16, 0, 0); } while (0)
#define PG8_LDA(dst, b, h) do { _Pragma("unroll") for (int m = 0; m < 4; ++m) _Pragma("unroll") for (int k = 0; k < 2; ++k) dst[m][k] = *(const PG8_LAS bf16x8*)(lds + PG8_SA(b, h) + aoff + m * 2048 + k * 1024); } while (0)
#define PG8_LDB(dst, b, h) do { _Pragma("unroll") for (int n = 0; n < 2; ++n) _Pragma("unroll") for (int k = 0; k < 2; ++k) dst[n][k] = *(const PG8_LAS bf16x8*)(lds + PG8_SB(b, h) + boff + n * 2048 + k * 1024); } while (0)
#define PG8_MMA(ai, bj, At, Bt) do { __builtin_amdgcn_s_setprio(1); _Pragma("unroll") for (int m = 0; m < 4; ++m) _Pragma("unroll") for (int n = 0; n < 2; ++n) _Pragma("unroll") for (int k = 0; k < 2; ++k) \
        acc[ai][bj][m][n] = __builtin_amdgcn_mfma_f32_16x16x32_bf16(Bt[n][k], At[m][k], acc[ai][bj][m][n], 0, 0, 0); __builtin_amdgcn_s_setprio(0); } while (0)
#define PG8_WAIT_V(n) asm volatile("s_waitcnt vmcnt(" #n ")" ::: "memory")
#define PG8_WAIT_L(n) asm volatile("s_waitcnt lgkmcnt(" #n ")" ::: "memory")
#define PG8_BAR __builtin_amdgcn_s_barrier()
#define PG8_SCHED __builtin_amdgcn_sched_barrier(0)
    Unit cur, nxt; int ui = 0;
    if (!S.next(0, cur)) return;
    f32x4 acc[2][2][4][2];
#pragma unroll
    for (int a = 0; a < 2; ++a)
#pragma unroll
        for (int b = 0; b < 2; ++b)
#pragma unroll
            for (int m = 0; m < 4; ++m)
#pragma unroll
                for (int n = 0; n < 2; ++n) acc[a][b][m][n] = (f32x4){0.f, 0.f, 0.f, 0.f};
    bf16x8 At[4][2], B0[2][2], B1[2][2];
    const char* cA = (const char*)g.A + (size_t)cur.pm * tstep; const char* cB = (const char*)g.Bt + (size_t)cur.pn * tstep;
    S.a_ready(cur);
    if constexpr (SP2) {
        PG8_STAGE(PG8_SB(0, 0), cB, voffB); PG8_STAGE(PG8_SB(0, 1), cB + hstep, voffB); PG8_STAGE(PG8_SA(0, 0), cA, voffA); PG8_STAGE(PG8_SA(0, 1), cA + hstep, voffA);
        if (wr == 1) PG8_BAR;
        PG8_WAIT_V(2); PG8_BAR;
        PG8_STAGE(PG8_SB(1, 0), cB + kstep, voffB); PG8_STAGE(PG8_SA(1, 0), cA + kstep, voffA); PG8_STAGE(PG8_SB(1, 1), cB + hstep + kstep, voffB);
        PG8_WAIT_V(6); PG8_BAR;
    } else {
        PG8_STAGE(PG8_SB(0, 0), cB, voffB); PG8_STAGE(PG8_SA(0, 0), cA, voffA); PG8_STAGE(PG8_SB(0, 1), cB + hstep, voffB); PG8_STAGE(PG8_SA(0, 1), cA + hstep, voffA);
        if (wr == 1) PG8_BAR;
        PG8_WAIT_V(4); PG8_BAR;
        PG8_STAGE(PG8_SB(1, 0), cB + kstep, voffB); PG8_STAGE(PG8_SA(1, 0), cA + kstep, voffA); PG8_STAGE(PG8_SB(1, 1), cB + hstep + kstep, voffB);
        PG8_WAIT_V(6); PG8_BAR;
    }
    for (;;) {
        const bool has_next = S.next(ui + 1, nxt);
        const char* nA = has_next ? (const char*)g.A + (size_t)nxt.pm * tstep : cA; const char* nB = has_next ? (const char*)g.Bt + (size_t)nxt.pn * tstep : cB;
        for (int t = 0; t < nt; t += 2) {
            const bool last = (t == nt - 2);
            const char* a1 = cA + (size_t)(t + 1) * kstep;
            const char* a2 = last ? nA : cA + (size_t)(t + 2) * kstep; const char* b2 = last ? nB : cB + (size_t)(t + 2) * kstep;
            const char* a3 = a2 + kstep; const char* b3 = b2 + kstep;
            if (last && has_next) S.a_ready(nxt);
            if constexpr (SP2) {
            PG8_LDB(B0, 0, 0); PG8_LDB(B1, 0, 1); PG8_SCHED; PG8_LDA(At, 0, 0); PG8_STAGE(PG8_SA(1, 1), a1 + hstep, voffA);
            PG8_WAIT_V(8); PG8_WAIT_L(0); PG8_BAR; PG8_MMA(0, 0, At, B0); PG8_MMA(0, 1, At, B1); PG8_BAR; PG8_SCHED;
            PG8_LDA(At, 0, 1); PG8_STAGE(PG8_SB(0, 0), b2, voffB); PG8_STAGE(PG8_SB(0, 1), b2 + hstep, voffB); PG8_STAGE(PG8_SA(0, 0), a2, voffA);
            PG8_WAIT_V(8); PG8_WAIT_L(0); PG8_BAR; PG8_MMA(1, 0, At, B0); PG8_MMA(1, 1, At, B1); PG8_BAR; PG8_SCHED;
            PG8_LDB(B0, 1, 0); PG8_LDB(B1, 1, 1); PG8_SCHED; PG8_LDA(At, 1, 0); PG8_STAGE(PG8_SA(0, 1), a2 + hstep, voffA);
            PG8_WAIT_V(8); PG8_WAIT_L(0); PG8_BAR; PG8_MMA(0, 0, At, B0); PG8_MMA(0, 1, At, B1); PG8_BAR; PG8_SCHED;
            PG8_LDA(At, 1, 1); PG8_STAGE(PG8_SB(1, 0), b3, voffB); PG8_STAGE(PG8_SB(1, 1), b3 + hstep, voffB); PG8_STAGE(PG8_SA(1, 0), a3, voffA);
            PG8_WAIT_V(8); PG8_WAIT_L(0); PG8_BAR; PG8_MMA(1, 0, At, B0); PG8_MMA(1, 1, At, B1); PG8_BAR; PG8_SCHED;
            } else {
            PG8_LDB(B0, 0, 0); PG8_SCHED; PG8_LDA(At, 0, 0); PG8_STAGE(PG8_SA(1, 1), a1 + hstep, voffA);
            PG8_WAIT_L(8); PG8_BAR; PG8_WAIT_L(0); PG8_MMA(0, 0, At, B0); PG8_BAR; PG8_SCHED;
            PG8_LDB(B1, 0, 1); PG8_STAGE(PG8_SB(0, 0), b2, voffB);
            PG8_BAR; PG8_WAIT_L(0); PG8_MMA(0, 1, At, B1); PG8_BAR;
            PG8_LDA(At, 0, 1); PG8_STAGE(PG8_SA(0, 0), a2, voffA);
            PG8_BAR; PG8_WAIT_L(0); PG8_MMA(1, 0, At, B0); PG8_BAR; PG8_SCHED;
            PG8_STAGE(PG8_SB(0, 1), b2 + hstep, voffB);
            PG8_WAIT_V(6); PG8_BAR; PG8_MMA(1, 1, At, B1); PG8_BAR;
            PG8_LDB(B0, 1, 0); PG8_SCHED; PG8_LDA(At, 1, 0); PG8_STAGE(PG8_SA(0, 1), a2 + hstep, voffA);
            PG8_WAIT_L(8); PG8_BAR; PG8_WAIT_L(0); PG8_MMA(0, 0, At, B0); PG8_BAR; PG8_SCHED;
            PG8_LDB(B1, 1, 1); PG8_STAGE(PG8_SB(1, 0), b3, voffB);
            PG8_BAR; PG8_WAIT_L(0); PG8_MMA(0, 1, At, B1); PG8_BAR;
            PG8_LDA(At, 1, 1); PG8_STAGE(PG8_SA(1, 0), a3, voffA);
            PG8_BAR; PG8_WAIT_L(0); PG8_MMA(1, 0, At, B0); PG8_BAR; PG8_SCHED;
            PG8_STAGE(PG8_SB(1, 1), b3 + hstep, voffB);
            PG8_WAIT_V(6); PG8_BAR; PG8_MMA(1, 1, At, B1); PG8_BAR;
            }
        }
        if constexpr (ALIGN_EPI) { if (wr == 0) PG8_BAR; }
        if constexpr (!Epi::AFTER_DRAIN) { E(acc, cur, wr, wc, fr, fq); S.done(cur); }
        if (!has_next) break;
#pragma unroll
        for (int a = 0; a < 2; ++a)
#pragma unroll
            for (int b = 0; b < 2; ++b)
#pragma unroll
                for (int m = 0; m < 4; ++m)
#pragma unroll
                    for (int n = 0; n < 2; ++n) acc[a][b][m][n] = (f32x4){0.f, 0.f, 0.f, 0.f};
        cur = nxt; cA = nA; cB = nB; ++ui;
        if constexpr (ALIGN_EPI) { if (wr == 1) PG8_BAR; }
    }
    PG8_WAIT_V(0);
    if constexpr (!ALIGN_EPI) { if (wr == 0) PG8_BAR; }
    PG8_BAR;
    if constexpr (Epi::AFTER_DRAIN) { E.fused(acc, cur, wr, wc, fr, fq, lds, wid, lane); S.done(cur); }
#undef PG8_SA
#undef PG8_SB
#undef PG8_STAGE
#undef PG8_LDA
#undef PG8_LDB
#undef PG8_MMA
#undef PG8_WAIT_V
#undef PG8_WAIT_L
#undef PG8_BAR
#undef PG8_SCHED
}
}
constexpr int NWAVES = 8, NTHR = 512;
constexpr int BATCH = 4, SEQ = 4096, D = 1024, M = BATCH * SEQ, FF = 4096, DEPTH = 4;
constexpr int INP = 6672, INP_PAD = 6912;
constexpr float EPS = 1e-6f;
enum { I_X = 0, I_PRE_MIX, I_POST_MIX, I_PRE_MLP, I_POST_MLP, I_W_IN, I_CONV_W, I_CONV_B, I_DT_BIAS, I_A_LOG, I_D_SSD, I_SSD_NORM, I_W_OUT,
       I_LAM_RE, I_LAM_IM, I_LOG_STEP, I_B_RE, I_B_IM, I_C_RE, I_C_IM, I_D_S5, I_W_GLU_A, I_W_GLU_B, I_W_UP, I_W_DOWN, N_IN };
constexpr size_t MiB = 1u << 20;
constexpr size_t WS_CTL = 0, CTL_ZERO_BYTES = 64 * 1024;
constexpr size_t WS_MISC = 512 * 1024;
constexpr size_t WS_ROPE = 1 * MiB;
constexpr size_t WS_W4 = 5 * MiB;
constexpr size_t WS_SLOT16 = 9 * MiB;
constexpr size_t WS_SLOT32 = 25 * MiB;
constexpr size_t WS_QKV = 57 * MiB;
constexpr size_t WS_GZ = 153 * MiB;
constexpr size_t WS_XBC = 217 * MiB;
constexpr size_t WS_DT = 265 * MiB;
constexpr size_t WS_END = 266 * MiB;
constexpr size_t WS_M32A = 57 * MiB;
constexpr size_t WS_M32B = 185 * MiB;
constexpr size_t WS_U = 57 * MiB;
constexpr size_t WS_S5MAT = 57 * MiB;
constexpr size_t WS_S5E = 73 * MiB;
constexpr size_t WS_S5X = 105 * MiB;
constexpr size_t WS_Y = 121 * MiB;
constexpr int SCR_BYTES = 143360;
constexpr int MISC_OFF = SCR_BYTES;
constexpr int LDS_BYTES = 147456;

#define GAS __attribute__((address_space(1)))
#define LAS __attribute__((address_space(3)))
#define DI __device__ __forceinline__
typedef unsigned short bf16;
typedef unsigned v4u __attribute__((ext_vector_type(4)));
typedef unsigned v2u __attribute__((ext_vector_type(2)));
typedef float f32x4 __attribute__((ext_vector_type(4)));
typedef float f32x2v __attribute__((ext_vector_type(2)));
typedef short bf16x8 __attribute__((ext_vector_type(8)));
typedef short v4i16_t __attribute__((ext_vector_type(4)));
typedef GAS unsigned gu32;
#define RLX_AGENT __ATOMIC_RELAXED, __HIP_MEMORY_SCOPE_AGENT
#define LDS_WAIT() asm volatile("s_waitcnt lgkmcnt(0)" ::: "memory")
#define VM_WAIT() asm volatile("s_waitcnt vmcnt(0)" ::: "memory")
DI unsigned f2bf(float f) { unsigned u = __builtin_bit_cast(unsigned, f); return (u + 0x7fffu + ((u >> 16) & 1u)) >> 16; }
typedef __bf16 bf2_t __attribute__((ext_vector_type(2)));
DI unsigned pk2(float lo, float hi) { const f32x2v v = {lo, hi}; return __builtin_bit_cast(unsigned, __builtin_convertvector(v, bf2_t)); }
DI float bf2f(unsigned short b) { return __builtin_bit_cast(float, ((unsigned)b) << 16); }
DI float bflo(unsigned w) { return __builtin_bit_cast(float, w << 16); }
DI float bfhi(unsigned w) { return __builtin_bit_cast(float, w & 0xffff0000u); }
DI float wave_sum(float v) {
#pragma unroll
    for (int o = 1; o < 64; o <<= 1) v += __shfl_xor(v, o);
    return v;
}
DI float silu_f(float x) { return x / (1.0f + __expf(-x)); }
DI void sincos_d(double x, double& s, double& c) {
    const double k = rint(x * 0.15915494309189533576888376337251);
    const double r = fma(-k, 6.283185307179586476925286766559, x), r2 = r * r;
    double ps = 1.0 / 1.0888869450418352e28, pc = 1.0 / 3.0488834461171384e29;
    const double fs[13] = {1.0 / 1.5511210043330986e25, 1.0 / 2.5852016738884978e22, 1.0 / 5.109094217170944e19, 1.0 / 1.21645100408832e17, 1.0 / 355687428096000.0, 1.0 / 1307674368000.0,
                           1.0 / 6227020800.0, 1.0 / 39916800.0, 1.0 / 362880.0, 1.0 / 5040.0, 1.0 / 120.0, 1.0 / 6.0, 1.0};
    const double fc[14] = {1.0 / 4.0329146112660565e26, 1.0 / 6.204484017332394e23, 1.0 / 1.1240007277776077e21, 1.0 / 2.43290200817664e18, 1.0 / 6402373705728000.0, 1.0 / 20922789888000.0,
                           1.0 / 87178291200.0, 1.0 / 479001600.0, 1.0 / 3628800.0, 1.0 / 40320.0, 1.0 / 720.0, 1.0 / 24.0, 1.0 / 2.0, 1.0};
#pragma unroll
    for (int i = 0; i < 13; ++i) ps = fs[i] - ps * r2;
#pragma unroll
    for (int i = 0; i < 14; ++i) pc = fc[i] - pc * r2;
    s = ps * r; c = pc;
}
#define XB_TMO      128
#define XB_XCNT(j)  (256  + 64 * (j))
#define XB_XSUB(j)  (1280 + 64 * (j))
#define XB_XGEN(j)  (2304 + 64 * (j))
#define XB_TOP      3328
#define XB_TOPGEN   3392
#define XCD_BAR_WORDS 3456
#define XB_SPIN_CAP (1u << 18)

__device__ __forceinline__ unsigned xb_ld(unsigned* p)              { return __hip_atomic_load(p, __ATOMIC_RELAXED, __HIP_MEMORY_SCOPE_AGENT); }
__device__ __forceinline__ unsigned xb_add(unsigned* p, unsigned v) { return __hip_atomic_fetch_add(p, v, __ATOMIC_RELAXED, __HIP_MEMORY_SCOPE_AGENT); }
__device__ __forceinline__ unsigned xb_xcc_id() { return (unsigned)__builtin_amdgcn_s_getreg((3 << 11) | 20) & 0xFu; }
#define XB_SPIN(cond, bar) do { unsigned _sp = 0; while (cond) { __builtin_amdgcn_s_sleep(1); \
    if ((++_sp & 255u) == 0u) { if (xb_ld(&(bar)[XB_TMO])) break; if (_sp > XB_SPIN_CAP) { atomicAdd(&(bar)[XB_TMO], 1u); break; } } } } while (0)

struct XcdBarrier {
    unsigned* bar; unsigned x; int tid;
    volatile LAS unsigned* st;
};

__device__ __forceinline__ XcdBarrier xcd_barrier_post(unsigned* bar, volatile LAS unsigned* st) {
    XcdBarrier b; b.bar = bar; b.x = xb_xcc_id(); b.st = st;
    if (threadIdx.x == 0) (void)xb_add(&bar[XB_XCNT(b.x)], 1u);
    return b;
}
__device__ __forceinline__ void xcd_barrier_complete(unsigned* bar, unsigned x, unsigned& nloc, unsigned& nx) {
    const unsigned G = gridDim.x * gridDim.y * gridDim.z;
    unsigned sum, cnt, mine, sp = 0u;
    for (;;) {
        sum = 0u; cnt = 0u; mine = 0u;
#pragma unroll
        for (unsigned j = 0; j < 16; ++j) { const unsigned c = xb_ld(&bar[XB_XCNT(j)]); sum += c; cnt += (c > 0u) ? 1u : 0u; mine = (j == x) ? c : mine; }
        if (sum == G) break;
        __builtin_amdgcn_s_sleep(1);
        if ((++sp & 255u) == 0u) { if (xb_ld(&bar[XB_TMO])) break; if (sp > XB_SPIN_CAP) { atomicAdd(&bar[XB_TMO], 1u); break; } }
    }
    nloc = mine > 0u ? mine : 1u; nx = cnt > 0u ? cnt : 1u;
}

__device__ __forceinline__ void xcd_barrier(const XcdBarrier& b) {
    asm volatile("s_waitcnt vmcnt(0)" ::: "memory");
    __syncthreads();
    if (b.tid == 0) {
        unsigned* bar = b.bar;
        __builtin_amdgcn_s_waitcnt(0);
        unsigned nloc = b.st[0], nx = b.st[1];
        if (nloc == 0u) { xcd_barrier_complete(bar, b.x, nloc, nx); b.st[0] = nloc; b.st[1] = nx; }
        const unsigned old = xb_add(&bar[XB_XSUB(b.x)], 1u);
        const unsigned gen = old / nloc;
        if (old + 1u == (gen + 1u) * nloc) {
            __builtin_amdgcn_fence(__ATOMIC_RELEASE, "agent");
            asm volatile("s_waitcnt vmcnt(0)" ::: "memory");
            const unsigned og = xb_add(&bar[XB_TOP], 1u);
            const unsigned tg = og / nx;
            if (og + 1u == (tg + 1u) * nx) xb_add(&bar[XB_TOPGEN], 1u);
            else XB_SPIN(xb_ld(&bar[XB_TOPGEN]) == tg, bar);
            __builtin_amdgcn_fence(__ATOMIC_ACQUIRE, "agent");
            xb_add(&bar[XB_XGEN(b.x)], 1u);
            asm volatile("s_waitcnt vmcnt(0)" ::: "memory");
        } else {
            XB_SPIN(xb_ld(&bar[XB_XGEN(b.x)]) == gen, bar);
            __builtin_amdgcn_fence(__ATOMIC_ACQUIRE, "agent");
            asm volatile("s_waitcnt vmcnt(0)" ::: "memory");
        }
    }
    __syncthreads();
}

struct Frame {
    LAS unsigned char* lds;
    int tid, lane, wave, G, bid, vcu;
    float* out; unsigned char* ws;
};
DI unsigned long long lds_ptr(const Frame& F, int i) {
    unsigned a_ = (unsigned)(size_t)(F.lds + MISC_OFF + 256) + 8u * (unsigned)i; asm volatile("" : "+v"(a_));
    const unsigned long long v = *(const volatile LAS unsigned long long*)a_;
    const unsigned lo = __builtin_amdgcn_readfirstlane((unsigned)v), hi = __builtin_amdgcn_readfirstlane((unsigned)(v >> 32));
    return ((unsigned long long)hi << 32) | lo;
}
#define INP(i) ((const float*)(const GAS float*)lds_ptr(F, (i)))
DI int gwave(const Frame& F) { return F.bid * NWAVES + F.wave; }

DI bf16x8 frag_rm(const LAS unsigned char* t, int S, int r0, int k0, int lane) { return *(const LAS bf16x8*)(t + (r0 + (lane & 15)) * S + (k0 + 8 * (lane >> 4)) * 2); }
DI bf16x8 frag_tr(const LAS unsigned char* t, int S, int r0, int k0, int lane) {
    const int g = lane >> 4, q = (lane & 15) >> 2, p = lane & 3;
    const LAS unsigned char* a = t + (k0 + 8 * g + q) * S + (r0 + 4 * p) * 2;
    const v4i16_t lo = __builtin_amdgcn_ds_read_tr16_b64_v4i16((LAS v4i16_t*)a);
    const v4i16_t hi = __builtin_amdgcn_ds_read_tr16_b64_v4i16((LAS v4i16_t*)(a + 4 * S));
    return __builtin_shufflevector(lo, hi, 0, 1, 2, 3, 4, 5, 6, 7);
}
DI f32x4 mma(bf16x8 a, bf16x8 b, f32x4 c) { return __builtin_amdgcn_mfma_f32_16x16x32_bf16(a, b, c, 0, 0, 0); }

DI void load_tile(LAS unsigned char* dst, int S, const bf16* src, size_t ld, int rows, int cols, int tid) {
    const int cpr = cols >> 3, n = rows * cpr;
    for (int i = tid; i < n; i += NTHR) { const int r = i / cpr, c = i - r * cpr;
        *(LAS v4u*)(dst + r * S + c * 16) = *(const v4u*)(src + (size_t)r * ld + c * 8); }
}

template <int COLS> DI unsigned tile_loff(int tid, unsigned ld) { constexpr int CPR = COLS / 8; return (unsigned)(tid / CPR) * ld + (unsigned)(tid % CPR) * 8u; }
template <int ROWS, int COLS> DI void tile_issue(v4u* r, const bf16* src, unsigned ld, unsigned loff) {
    constexpr int CPR = COLS / 8, N = ROWS * COLS / 4096, RSTEP = NTHR / CPR;
#pragma unroll
    for (int i = 0; i < N; ++i) r[i] = *(const v4u*)((src + (size_t)i * RSTEP * ld) + loff);
}
template <int ROWS, int COLS> DI void tile_commit(const v4u* r, LAS unsigned char* dst, int S, int tid) {
    constexpr int CPR = COLS / 8, N = ROWS * COLS / 4096, RSTEP = NTHR / CPR;
    LAS unsigned char* p = dst + (tid / CPR) * S + (tid % CPR) * 16;
#pragma unroll
    for (int i = 0; i < N; ++i) *(LAS v4u*)(p + i * RSTEP * S) = r[i];
}

DI void transpose_item(const float* W, int K, int N, bf16* WT, int mode, LAS float* scr, int item, int lane) {
    const int nblk = (N + 31) / 32, kb = item / nblk, nb = item % nblk, k0 = 64 * kb, n0 = 32 * nb;
    const int n4 = 4 * (lane & 7), nl = n0 + n4;
    f32x4 v[8];
#pragma unroll
    for (int i = 0; i < 8; ++i) v[i] = nl < N ? *(const f32x4*)(W + (size_t)(k0 + 8 * i + (lane >> 3)) * N + nl) : (f32x4){0.f, 0.f, 0.f, 0.f};
#pragma unroll
    for (int i = 0; i < 8; ++i) { LAS float* d = scr + (8 * i + (lane >> 3)) * 33 + n4; d[0] = v[i][0]; d[1] = v[i][1]; d[2] = v[i][2]; d[3] = v[i][3]; }
    LDS_WAIT(); asm volatile("" ::: "memory");
    const int c = lane & 7;
#pragma unroll
    for (int j = 0; j < 4; ++j) { const int n = (lane >> 3) + 8 * j; const LAS float* s = scr + (8 * c) * 33 + n;
        v4u o; o.x = pk2(s[0 * 33], s[1 * 33]); o.y = pk2(s[2 * 33], s[3 * 33]); o.z = pk2(s[4 * 33], s[5 * 33]); o.w = pk2(s[6 * 33], s[7 * 33]);
        const int ng = n0 + n; const int row = mode == 0 ? ng : (256 * (ng >> 7) + (ng & 127) + (mode == 2 ? 128 : 0));
        *(v4u*)(WT + (size_t)row * K + k0 + 8 * c) = o; }
    LDS_WAIT(); asm volatile("" ::: "memory");
}
DI void convert_weight(Frame& F, const float* W, int K, int N, bf16* WT, int mode, int w0 = 0) {
    if (F.wave < w0) return;
    LAS float* scr = (LAS float*)(F.lds + F.wave * 16384);
    const int nw = NWAVES - w0, nitems = (K / 64) * ((N + 31) / 32), NGW = F.G * nw;
    for (int it = F.bid * nw + (F.wave - w0); it < nitems; it += NGW) transpose_item(W, K, N, WT, mode, scr, it, F.lane);
}
DI void zero_fill(Frame& F, void* p, size_t bytes) {
    v4u* q = (v4u*)p; const size_t n = bytes / 16;
    for (size_t i = (size_t)F.bid * NTHR + F.tid; i < n; i += (size_t)F.G * NTHR) q[i] = (v4u){0u, 0u, 0u, 0u};
}

DI void build_rope(Frame& F) {
    float* rope = (float*)(F.ws + WS_ROPE);
    for (int i = F.bid * NTHR + F.tid; i < 4096 * 128; i += F.G * NTHR) { const int pos = i >> 7, d = i & 127;
        double inv = 1.0; { double r = 0.930572040929699; int e = d; while (e) { if (e & 1) inv *= r; r *= r; e >>= 1; } }
        const float ang = (float)pos * (float)inv;
        double s, c; sincos_d((double)ang, s, c);
        *(f32x2v*)(rope + 2 * (size_t)i) = (f32x2v){(float)c, (float)s}; }
}
DI void rms_rows_to_bf16(Frame& F, const float* src, const float* w, bf16* dst) {
    const int NGW = F.G * NWAVES;
    f32x4 wv[4];
#pragma unroll
    for (int j = 0; j < 4; ++j) wv[j] = ((const f32x4*)w)[F.lane + 64 * j];
    for (int m = gwave(F); m < M; m += NGW) { const f32x4* xr = (const f32x4*)(src + (size_t)m * D) + F.lane;
        f32x4 v[4]; float s = 0.f;
#pragma unroll
        for (int j = 0; j < 4; ++j) { v[j] = xr[64 * j]; s += (v[j].x * v[j].x + v[j].y * v[j].y) + (v[j].z * v[j].z + v[j].w * v[j].w); }
        const float rs = rsqrtf(wave_sum(s) * (1.f / D) + EPS);
        v2u* o8 = (v2u*)(dst + (size_t)m * D) + F.lane;
#pragma unroll
        for (int j = 0; j < 4; ++j) { const f32x4 y = v[j] * rs * wv[j]; o8[64 * j] = (v2u){pk2(y.x, y.y), pk2(y.z, y.w)}; } }
}
template <bool IN_F32, bool OUT_F32>
DI void row_phase(Frame& F, const bf16* mbuf, const void* hbase, void* hout, const float* w_post, const float* w_pre, bf16* hn) {
    const int NGW = F.G * NWAVES;
    f32x4 wp[4], wq[4];
#pragma unroll
    for (int j = 0; j < 4; ++j) { wp[j] = ((const f32x4*)w_post)[F.lane + 64 * j]; wq[j] = w_pre ? ((const f32x4*)w_pre)[F.lane + 64 * j] : (f32x4){0.f, 0.f, 0.f, 0.f}; }
    for (int m = gwave(F); m < M; m += NGW) {
        const v2u* mr = (const v2u*)(mbuf + (size_t)m * D) + F.lane;
        f32x4 v[4], h[4]; float s = 0.f;
#pragma unroll
        for (int j = 0; j < 4; ++j) { const v2u mv = mr[64 * j]; v[j] = (f32x4){bflo(mv.x), bfhi(mv.x), bflo(mv.y), bfhi(mv.y)};
            if (IN_F32) h[j] = ((const f32x4*)((const float*)hbase + (size_t)m * D) + F.lane)[64 * j];
            else { const v2u hv = ((const v2u*)((const bf16*)hbase + (size_t)m * 2048) + F.lane)[64 * j]; h[j] = (f32x4){bflo(hv.x), bfhi(hv.x), bflo(hv.y), bfhi(hv.y)}; }
            s += (v[j].x * v[j].x + v[j].y * v[j].y) + (v[j].z * v[j].z + v[j].w * v[j].w); }
        const float rs = rsqrtf(wave_sum(s) * (1.f / D) + EPS); float s2 = 0.f;
#pragma unroll
        for (int j = 0; j < 4; ++j) { h[j] = h[j] + v[j] * rs * wp[j]; s2 += (h[j].x * h[j].x + h[j].y * h[j].y) + (h[j].z * h[j].z + h[j].w * h[j].w); }
        if (OUT_F32) { f32x4* ho = (f32x4*)((float*)hout + (size_t)m * D) + F.lane;
#pragma unroll
            for (int j = 0; j < 4; ++j) ho[64 * j] = h[j]; }
        else { v2u* ho = (v2u*)((bf16*)hout + (size_t)m * 2048) + F.lane;
#pragma unroll
            for (int j = 0; j < 4; ++j) ho[64 * j] = (v2u){pk2(h[j].x, h[j].y), pk2(h[j].z, h[j].w)}; }
        if (hn) { const float rs2 = rsqrtf(wave_sum(s2) * (1.f / D) + EPS);
            v2u* o8 = (v2u*)(hn + (size_t)m * D) + F.lane;
#pragma unroll
            for (int j = 0; j < 4; ++j) { const f32x4 y = h[j] * rs2 * wq[j]; o8[64 * j] = (v2u){pk2(y.x, y.y), pk2(y.z, y.w)}; } }
    }
}

DI float head_lg2(int h) { return __log2f(1.0f - exp2f(-5.0f - (float)h)); }

DI void ret_passA_unit(Frame& F, int unit) {
    const bf16* QKV = (const bf16*)(F.ws + WS_QKV); bf16* RST = (bf16*)(F.ws + WS_SLOT16);
    const int eh = unit & 1, sc = (unit >> 1) & 7, h = (unit >> 4) & 3, b = unit >> 6;
    const int lane = F.lane, w = F.wave, we = w >> 2, wd = w & 3;
    const float lg2 = head_lg2(h), g128 = exp2f(128.f * lg2), g127 = exp2f(127.f * lg2);
    LAS unsigned char* Kt = F.lds;
    LAS unsigned char* Vt = F.lds + 128 * 544;
    f32x4 acc[4][4];
#pragma unroll
    for (int a = 0; a < 4; ++a)
#pragma unroll
        for (int c = 0; c < 4; ++c) acc[a][c] = (f32x4){0.f, 0.f, 0.f, 0.f};
    v4u TK[8], TV[4];
    const unsigned lo_k = tile_loff<256>(F.tid, 3072), lo_v = tile_loff<128>(F.tid, 3072);
    const bf16* kbase = QKV + ((size_t)b * SEQ + sc * 512) * 3072 + 1024 + h * 256; const bf16* vbase = kbase + 1024 + eh * 128;
    tile_issue<128, 256>(TK, kbase, 3072, lo_k); tile_issue<128, 128>(TV, vbase, 3072, lo_v);
#pragma unroll 1
    for (int j = 0; j < 4; ++j) {
        if (j) {
#pragma unroll
            for (int a = 0; a < 4; ++a)
#pragma unroll
                for (int c = 0; c < 4; ++c) acc[a][c] *= g128; }
        __syncthreads();
        tile_commit<128, 256>(TK, Kt, 544, F.tid); tile_commit<128, 128>(TV, Vt, 288, F.tid);
        if (j < 3) { tile_issue<128, 256>(TK, kbase + (size_t)(j + 1) * 128 * 3072, 3072, lo_k); tile_issue<128, 128>(TV, vbase + (size_t)(j + 1) * 128 * 3072, 3072, lo_v); }
        __syncthreads();
#pragma unroll
        for (int ks = 0; ks < 4; ++ks) {
            bf16x8 vf[4], kf[4];
#pragma unroll
            for (int t = 0; t < 4; ++t) { vf[t] = frag_tr(Vt, 288, we * 64 + t * 16, ks * 32, lane); kf[t] = frag_tr(Kt, 544, wd * 64 + t * 16, ks * 32, lane); }
#pragma unroll
            for (int et = 0; et < 4; ++et)
#pragma unroll
                for (int dt = 0; dt < 4; ++dt) acc[et][dt] = mma(kf[dt], vf[et], acc[et][dt]);
        }
    }
    bf16* dst = RST + ((size_t)((b * 4 + h) * 8 + sc) * 256) * 256;
#pragma unroll
    for (int et = 0; et < 4; ++et)
#pragma unroll
        for (int dt = 0; dt < 4; ++dt) { const int e = eh * 128 + we * 64 + et * 16 + (lane & 15), d = wd * 64 + dt * 16 + 4 * (lane >> 4);
            const f32x4 v = acc[et][dt] * g127;
            *(v2u*)(dst + (size_t)e * 256 + d) = (v2u){pk2(v[0], v[1]), pk2(v[2], v[3])}; }
}

DI void ret_scan_item(Frame& F, int item) {
    bf16* RST = (bf16*)(F.ws + WS_SLOT16);
    const int bh = item >> 13, off = (item & 8191) * 8, h = bh & 3;
    const float g512 = exp2f(512.f * head_lg2(h));
    float run[8]; float zf = 0.f; asm volatile("" : "+v"(zf));
#pragma unroll
    for (int k = 0; k < 8; ++k) run[k] = zf;
    v4u cur = *(const v4u*)(RST + (size_t)(bh * 8) * 65536 + off);
    for (int sc = 0; sc < 8; ++sc) {
        v4u* p = (v4u*)(RST + (size_t)(bh * 8 + sc) * 65536 + off);
        v4u nxt = cur; if (sc < 7) nxt = *(const v4u*)(RST + (size_t)(bh * 8 + sc + 1) * 65536 + off);
        v4u o; o.x = pk2(run[0], run[1]); o.y = pk2(run[2], run[3]); o.z = pk2(run[4], run[5]); o.w = pk2(run[6], run[7]);
        *p = o;
        const unsigned cw[4] = {cur.x, cur.y, cur.z, cur.w};
#pragma unroll
        for (int k = 0; k < 4; ++k) { run[2 * k] = g512 * run[2 * k] + bflo(cw[k]); run[2 * k + 1] = g512 * run[2 * k + 1] + bfhi(cw[k]); }
        cur = nxt;
    }
}

DI void ret_passC_unit(Frame& F, int unit, bf16* YO) {
    const bf16* QKV = (const bf16*)(F.ws + WS_QKV); const bf16* RST = (const bf16*)(F.ws + WS_SLOT16); const bf16* GZ = (const bf16*)(F.ws + WS_GZ);
    const int qp = unit & 1, sc = (unit >> 1) & 7, h = (unit >> 4) & 3, b = unit >> 6;
    const int lane = F.lane, w = F.wave, wn = w >> 2, we = w & 3, wm = w & 3;
    const float lg2 = head_lg2(h), g1 = exp2f(lg2), g128 = exp2f(128.f * lg2);
    LAS unsigned char* Qt = F.lds;
    LAS unsigned char* KV = F.lds + 33792;
    LAS unsigned char* Pt = F.lds + 33792 + 69632;
    LAS float* red = (LAS float*)(F.lds + 33792 + 69632 + 17408);
    const size_t rowsc = (size_t)b * SEQ + sc * 512;
    const bf16* Rbase = RST + (size_t)((b * 4 + h) * 8 + sc) * 65536;
    v4u T[8], TQ[4];
    const unsigned lo_kv = tile_loff<256>(F.tid, 3072), lo_r = tile_loff<64>(F.tid, 256);
    tile_issue<64, 256>(TQ, QKV + (rowsc + (qp == 0 ? 0 : 1) * 128) * 3072 + h * 256, 3072, lo_kv);
    tile_issue<256, 64>(T, Rbase, 256, lo_r);
#pragma unroll 1
    for (int qi = 0; qi < 2; ++qi) {
        const int i = qp == 0 ? (qi == 0 ? 0 : 3) : (qi == 0 ? 1 : 2);
#pragma unroll 1
        for (int hh = 0; hh < 2; ++hh) {
            const size_t grow0 = rowsc + i * 128 + hh * 64;
            f32x4 Y[2][4];
#pragma unroll
            for (int a = 0; a < 2; ++a)
#pragma unroll
                for (int c = 0; c < 4; ++c) Y[a][c] = (f32x4){0.f, 0.f, 0.f, 0.f};
            __syncthreads();
            tile_commit<64, 256>(TQ, Qt, 528, F.tid);
#pragma unroll 1
            for (int ds = 0; ds < 4; ++ds) {
                if (ds) __syncthreads();
                tile_commit<256, 64>(T, KV, 144, F.tid);
                if (ds < 3) tile_issue<256, 64>(T, Rbase + (ds + 1) * 64, 256, lo_r);
                else tile_issue<128, 256>(T, QKV + rowsc * 3072 + 1024 + h * 256, 3072, lo_kv);
                __syncthreads();
#pragma unroll
                for (int ks = 0; ks < 2; ++ks) {
                    bf16x8 qf[2], rf[4];
#pragma unroll
                    for (int t = 0; t < 2; ++t) qf[t] = frag_rm(Qt, 528, wn * 32 + t * 16, ds * 64 + ks * 32, lane);
#pragma unroll
                    for (int t = 0; t < 4; ++t) rf[t] = frag_rm(KV, 144, we * 64 + t * 16, ks * 32, lane);
#pragma unroll
                    for (int nt = 0; nt < 2; ++nt)
#pragma unroll
                        for (int et = 0; et < 4; ++et) Y[nt][et] = mma(rf[et], qf[nt], Y[nt][et]);
                }
            }
#pragma unroll
            for (int a = 0; a < 2; ++a)
#pragma unroll
                for (int c = 0; c < 4; ++c) Y[a][c] *= g1;
#pragma unroll 1
            for (int j = 0; j <= i; ++j) {
                if (j) {
#pragma unroll
                    for (int a = 0; a < 2; ++a)
#pragma unroll
                        for (int c = 0; c < 4; ++c) Y[a][c] *= g128; }
                const size_t rowj = rowsc + j * 128;
                __syncthreads();
                tile_commit<128, 256>(T, KV, 528, F.tid);
                tile_issue<128, 256>(T, QKV + rowj * 3072 + 2048 + h * 256, 3072, lo_kv);
                __syncthreads();
                f32x4 sa[2][2];
#pragma unroll
                for (int a = 0; a < 2; ++a)
#pragma unroll
                    for (int c = 0; c < 2; ++c) sa[a][c] = (f32x4){0.f, 0.f, 0.f, 0.f};
#pragma unroll
                for (int ks = 0; ks < 8; ++ks) {
                    bf16x8 qf[2], kf[2];
#pragma unroll
                    for (int t = 0; t < 2; ++t) { qf[t] = frag_rm(Qt, 528, wn * 32 + t * 16, ks * 32, lane); kf[t] = frag_rm(KV, 528, wm * 32 + t * 16, ks * 32, lane); }
#pragma unroll
                    for (int nt = 0; nt < 2; ++nt)
#pragma unroll
                        for (int mt = 0; mt < 2; ++mt) sa[nt][mt] = mma(kf[mt], qf[nt], sa[nt][mt]);
                }
#pragma unroll
                for (int nt = 0; nt < 2; ++nt)
#pragma unroll
                    for (int mt = 0; mt < 2; ++mt) { const int n = wn * 32 + nt * 16 + (lane & 15), m = wm * 32 + mt * 16 + 4 * (lane >> 4);
                        f32x4 s = sa[nt][mt];
                        if (j == i) { const int nb = hh * 64 + n;
#pragma unroll
                            for (int jj = 0; jj < 4; ++jj) if (m + jj > nb) s[jj] = 0.f; }
                        *(LAS v2u*)(Pt + n * 272 + m * 2) = (v2u){pk2(s[0], s[1]), pk2(s[2], s[3])}; }
                __syncthreads();
                tile_commit<128, 256>(T, KV, 544, F.tid);
                if (j < i) tile_issue<128, 256>(T, QKV + (rowj + 128) * 3072 + 1024 + h * 256, 3072, lo_kv);
                else { const bool more = !(qi == 1 && hh == 1);
                    const int i2 = hh == 0 ? i : (qp == 0 ? 3 : 2), hh2 = hh ^ 1;
                    if (more) { tile_issue<64, 256>(TQ, QKV + (rowsc + i2 * 128 + hh2 * 64) * 3072 + h * 256, 3072, lo_kv); tile_issue<256, 64>(T, Rbase, 256, lo_r); } }
                __syncthreads();
#pragma unroll
                for (int ks = 0; ks < 4; ++ks) {
                    bf16x8 pf[2], vf[4];
#pragma unroll
                    for (int t = 0; t < 2; ++t) pf[t] = frag_rm(Pt, 272, wn * 32 + t * 16, ks * 32, lane);
#pragma unroll
                    for (int t = 0; t < 4; ++t) vf[t] = frag_tr(KV, 544, we * 64 + t * 16, ks * 32, lane);
#pragma unroll
                    for (int nt = 0; nt < 2; ++nt)
#pragma unroll
                        for (int et = 0; et < 4; ++et) Y[nt][et] = mma(vf[et], pf[nt], Y[nt][et]);
                }
            }
            float mean[2], rstd[2];
#pragma unroll
            for (int nt = 0; nt < 2; ++nt) { float s = 0.f;
#pragma unroll
                for (int et = 0; et < 4; ++et) s += (Y[nt][et][0] + Y[nt][et][1]) + (Y[nt][et][2] + Y[nt][et][3]);
                s += __shfl_xor(s, 16); s += __shfl_xor(s, 32);
                if ((lane >> 4) == 0) red[(wn * 32 + nt * 16 + lane) * 4 + we] = s; }
            __syncthreads();
#pragma unroll
            for (int nt = 0; nt < 2; ++nt) { const LAS float* r = red + (wn * 32 + nt * 16 + (lane & 15)) * 4; mean[nt] = ((r[0] + r[1]) + (r[2] + r[3])) * (1.f / 256.f); }
            __syncthreads();
#pragma unroll
            for (int nt = 0; nt < 2; ++nt) { float s = 0.f;
#pragma unroll
                for (int et = 0; et < 4; ++et) { const f32x4 dv = Y[nt][et] - mean[nt]; s += (dv[0] * dv[0] + dv[1] * dv[1]) + (dv[2] * dv[2] + dv[3] * dv[3]); }
                s += __shfl_xor(s, 16); s += __shfl_xor(s, 32);
                if ((lane >> 4) == 0) red[(wn * 32 + nt * 16 + lane) * 4 + we] = s; }
            __syncthreads();
#pragma unroll
            for (int nt = 0; nt < 2; ++nt) { const LAS float* r = red + (wn * 32 + nt * 16 + (lane & 15)) * 4; rstd[nt] = rsqrtf(((r[0] + r[1]) + (r[2] + r[3])) * (1.f / 256.f) + EPS); }
#pragma unroll
            for (int nt = 0; nt < 2; ++nt)
#pragma unroll
                for (int et = 0; et < 4; ++et) { const int n = wn * 32 + nt * 16 + (lane & 15), e = we * 64 + et * 16 + 4 * (lane >> 4);
                    const bf16* gp = GZ + (grow0 + n) * 2048 + h * 256 + e;
                    const v2u gv = *(const v2u*)gp;
                    const f32x4 y = (Y[nt][et] - mean[nt]) * rstd[nt];
                    const float o0 = y[0] * silu_f(bflo(gv.x)), o1 = y[1] * silu_f(bfhi(gv.x)), o2 = y[2] * silu_f(bflo(gv.y)), o3 = y[3] * silu_f(bfhi(gv.y));
                    *(v2u*)(YO + (gp - GZ)) = (v2u){pk2(o0, o1), pk2(o2, o3)}; }
        }
    }
}

struct SsdPar { const float* conv_w; const float* conv_b; const float* a_log; const float* d_ssd; const float* ssd_norm; };

struct ConvW { f32x4 w[4][2]; f32x4 b[2]; };
DI ConvW load_convw(const float* cw, const float* cb, int col) { ConvW W;
#pragma unroll
    for (int k = 0; k < 4; ++k) { W.w[k][0] = *(const f32x4*)(cw + k * 1536 + col); W.w[k][1] = *(const f32x4*)(cw + k * 1536 + col + 4); }
    W.b[0] = *(const f32x4*)(cb + col); W.b[1] = *(const f32x4*)(cb + col + 4); return W; }
DI void conv8(const bf16* XBC, const ConvW& W, size_t row, int col, float (&o)[8]) {
    const int tin = (int)(row & 4095);
    o[0] = W.b[0][0]; o[1] = W.b[0][1]; o[2] = W.b[0][2]; o[3] = W.b[0][3]; o[4] = W.b[1][0]; o[5] = W.b[1][1]; o[6] = W.b[1][2]; o[7] = W.b[1][3];
#pragma unroll
    for (int k = 0; k < 4; ++k) {
        if (tin - 3 + k >= 0) {
            const v4u x = *(const v4u*)(XBC + (row - 3 + k) * 1536 + col);
            const f32x4 w0 = W.w[k][0], w1 = W.w[k][1];
            o[0] += w0[0] * bflo(x.x); o[1] += w0[1] * bfhi(x.x); o[2] += w0[2] * bflo(x.y); o[3] += w0[3] * bfhi(x.y);
            o[4] += w1[0] * bflo(x.z); o[5] += w1[1] * bfhi(x.z); o[6] += w1[2] * bflo(x.w); o[7] += w1[3] * bfhi(x.w);
        }
    }
#pragma unroll
    for (int k = 0; k < 8; ++k) o[k] = silu_f(o[k]);
}
DI void conv8r(const v4u (&x)[4], const ConvW& W, int tin, float (&o)[8]) {
    o[0] = W.b[0][0]; o[1] = W.b[0][1]; o[2] = W.b[0][2]; o[3] = W.b[0][3]; o[4] = W.b[1][0]; o[5] = W.b[1][1]; o[6] = W.b[1][2]; o[7] = W.b[1][3];
#pragma unroll
    for (int k = 0; k < 4; ++k) {
        if (tin - 3 + k >= 0) { const f32x4 w0 = W.w[k][0], w1 = W.w[k][1];
            o[0] += w0[0] * bflo(x[k].x); o[1] += w0[1] * bfhi(x[k].x); o[2] += w0[2] * bflo(x[k].y); o[3] += w0[3] * bfhi(x[k].y);
            o[4] += w1[0] * bflo(x[k].z); o[5] += w1[1] * bfhi(x[k].z); o[6] += w1[2] * bflo(x[k].w); o[7] += w1[3] * bfhi(x[k].w); }
    }
#pragma unroll
    for (int k = 0; k < 8; ++k) o[k] = silu_f(o[k]);
}
DI v4u pack8(const float (&o)[8], float s) { v4u r; r.x = pk2(o[0] * s, o[1] * s); r.y = pk2(o[2] * s, o[3] * s); r.z = pk2(o[4] * s, o[5] * s); r.w = pk2(o[6] * s, o[7] * s); return r; }

DI float ssd_cumsum(const float* DT, const float* a_log, size_t t0, int grp, int w, int lane, LAS float* cs, LAS float* dtl = nullptr) {
    const int head = grp * 8 + w; const float A = -__expf(a_log[head]);
    const float d0 = DT[(t0 + 2 * lane) * 16 + head], d1 = DT[(t0 + 2 * lane + 1) * 16 + head], v0 = d0 * A, v1 = d1 * A;
    if (dtl) { dtl[w * 128 + 2 * lane] = d0; dtl[w * 128 + 2 * lane + 1] = d1; }
    float x = v0 + v1;
#pragma unroll
    for (int o = 1; o < 64; o <<= 1) { const float t = __shfl_up(x, o); if (lane >= o) x += t; }
    cs[w * 128 + 2 * lane] = x - v1; cs[w * 128 + 2 * lane + 1] = x;
    return __shfl(x, 63);
}

DI void ssd_passA_unit(Frame& F, const SsdPar& P, int unit) {
    const bf16* XBC = (const bf16*)(F.ws + WS_XBC); const float* DT = (const float*)(F.ws + WS_DT);
    bf16* ST = (bf16*)(F.ws + WS_SLOT32); float* CDEC = (float*)(F.ws + WS_MISC);
    const int grp = unit & 1, c = (unit >> 1) & 31, b = unit >> 6;
    const int lane = F.lane, w = F.wave;
    const size_t t0 = (size_t)b * SEQ + c * 128;
    LAS float* cs = (LAS float*)F.lds;
    LAS float* csend = (LAS float*)(F.lds + 4096);
    LAS unsigned char* Bt = F.lds + 4352;
    LAS unsigned char* Xw = F.lds + 4352 + 36864;
    __syncthreads();
    { const float tot = ssd_cumsum(DT, P.a_log, t0, grp, w, lane, cs);
      if (lane == 0) { csend[w] = tot; CDEC[(b * 32 + c) * 16 + grp * 8 + w] = __expf(tot); } }
    { const ConvW W = load_convw(P.conv_w, P.conv_b, 1024 + grp * 128 + (F.tid & 15) * 8);
#pragma unroll 1
    for (int it = 0; it < 4; ++it) { const int idx = F.tid + it * NTHR, r = idx >> 4, cc = idx & 15; float o[8];
        conv8(XBC, W, t0 + r, 1024 + grp * 128 + cc * 8, o);
        *(LAS v4u*)(Bt + r * 288 + cc * 16) = pack8(o, 1.0f); } }
    for (int hg = 0; hg < 2; ++hg) {
        __syncthreads();
        const ConvW W = load_convw(P.conv_w, P.conv_b, grp * 512 + hg * 256 + (F.tid & 31) * 8);
#pragma unroll 1
        for (int it = 0; it < 8; ++it) { const int idx = F.tid + it * NTHR, r = idx >> 5, cc = idx & 31, hd = hg * 4 + (cc >> 3); float o[8];
            conv8(XBC, W, t0 + r, grp * 512 + hg * 256 + cc * 8, o);
            const float sc = DT[(t0 + r) * 16 + grp * 8 + hd] * __expf(csend[hd] - cs[hd * 128 + r]);
            *(LAS v4u*)(Xw + r * 544 + cc * 16) = pack8(o, sc); }
        __syncthreads();
        const int hl = w >> 1, nh = w & 1;
        f32x4 acc[4][4];
#pragma unroll
        for (int a = 0; a < 4; ++a)
#pragma unroll
            for (int q = 0; q < 4; ++q) acc[a][q] = (f32x4){0.f, 0.f, 0.f, 0.f};
#pragma unroll
        for (int ks = 0; ks < 4; ++ks) {
            bf16x8 xf[4], bfr[4];
#pragma unroll
            for (int t = 0; t < 4; ++t) { xf[t] = frag_tr(Xw, 544, hl * 64 + t * 16, ks * 32, lane); bfr[t] = frag_tr(Bt, 288, nh * 64 + t * 16, ks * 32, lane); }
#pragma unroll
            for (int pt = 0; pt < 4; ++pt)
#pragma unroll
                for (int nt = 0; nt < 4; ++nt) acc[pt][nt] = mma(bfr[nt], xf[pt], acc[pt][nt]);
        }
        const int head = grp * 8 + hg * 4 + hl;
        bf16* dst = ST + (size_t)((b * 32 + c) * 16 + head) * 8192;
#pragma unroll
        for (int pt = 0; pt < 4; ++pt)
#pragma unroll
            for (int nt = 0; nt < 4; ++nt) { const int p = pt * 16 + (lane & 15), n = nh * 64 + nt * 16 + 4 * (lane >> 4); const f32x4 v = acc[pt][nt];
                *(v2u*)(dst + p * 128 + n) = (v2u){pk2(v[0], v[1]), pk2(v[2], v[3])}; }
    }
}

DI void ssd_scan_item(Frame& F, int item) {
    bf16* ST = (bf16*)(F.ws + WS_SLOT32); const float* CDEC = (const float*)(F.ws + WS_MISC);
    const int bh = item >> 10, b = bh >> 4, head = bh & 15, off = (item & 1023) * 8;
    float run[8]; float zf = 0.f; asm volatile("" : "+v"(zf));
#pragma unroll
    for (int k = 0; k < 8; ++k) run[k] = zf;
    v4u cur = *(const v4u*)(ST + (size_t)((b * 32) * 16 + head) * 8192 + off);
    for (int c = 0; c < 32; ++c) {
        v4u* p = (v4u*)(ST + (size_t)((b * 32 + c) * 16 + head) * 8192 + off);
        v4u nxt = cur; if (c < 31) nxt = *(const v4u*)(ST + (size_t)((b * 32 + c + 1) * 16 + head) * 8192 + off);
        const float dec = CDEC[(b * 32 + c) * 16 + head];
        v4u o; o.x = pk2(run[0], run[1]); o.y = pk2(run[2], run[3]); o.z = pk2(run[4], run[5]); o.w = pk2(run[6], run[7]);
        *p = o;
        const unsigned cw[4] = {cur.x, cur.y, cur.z, cur.w};
#pragma unroll
        for (int k = 0; k < 4; ++k) { run[2 * k] = dec * run[2 * k] + bflo(cw[k]); run[2 * k + 1] = dec * run[2 * k + 1] + bfhi(cw[k]); }
        cur = nxt;
    }
}

DI void ssd_passC_unit(Frame& F, const SsdPar& P, int unit, bf16* YO) {
    const bf16* XBC = (const bf16*)(F.ws + WS_XBC); const float* DT = (const float*)(F.ws + WS_DT);
    const bf16* ST = (const bf16*)(F.ws + WS_SLOT32); const bf16* GZ = (const bf16*)(F.ws + WS_GZ);
    const int grp = unit & 1, c = (unit >> 1) & 31, b = unit >> 6;
    const int lane = F.lane, w = F.wave;
    const size_t t0 = (size_t)b * SEQ + c * 128;
    LAS float* cs = (LAS float*)F.lds;
    LAS float* dtl = (LAS float*)(F.lds + 4096);
    LAS unsigned char* Ct = F.lds + 8192;
    LAS unsigned char* BM = F.lds + 43008;
    LAS unsigned char* Xd = F.lds + 77824;
    LAS unsigned char* Pv = F.lds + 98304;
    LAS float* rowss = (LAS float*)(F.lds + 115712);
    __syncthreads();
    (void)ssd_cumsum(DT, P.a_log, t0, grp, w, lane, cs, dtl);
#pragma unroll 1
    for (int which = 0; which < 2; ++which) {
        const ConvW W = load_convw(P.conv_w, P.conv_b, 1024 + which * 256 + grp * 128 + (F.tid & 15) * 8);
#pragma unroll 1
        for (int it = 0; it < 4; ++it) { const int idx = F.tid + it * NTHR, r = idx >> 4, cc = idx & 15; float o[8];
            conv8(XBC, W, t0 + r, 1024 + which * 256 + grp * 128 + cc * 8, o);
            *(LAS v4u*)((which ? Ct : BM) + r * 272 + cc * 16) = pack8(o, 1.0f); } }
    const int r0 = F.tid >> 3, cc8 = (F.tid & 7) * 8, tin0 = (int)((t0 + r0) & 4095);
    const int wl = w >> 1, ws = w & 1, wp = w & 1;
    v4u XR[2][4], PVr[2]; v2u ZN[2][2], ZC[2][2];
    const unsigned lo_p = tile_loff<128>(F.tid, 128);
#define SSD_ISSUE(hd_) do { const int hcol_ = grp * 512 + (hd_) * 64 + cc8; \
        _Pragma("unroll") for (int it_ = 0; it_ < 2; ++it_) _Pragma("unroll") for (int k_ = 0; k_ < 4; ++k_) \
            if (tin0 + 64 * it_ - 3 + k_ >= 0) XR[it_][k_] = *(const v4u*)(XBC + (t0 + r0 + 64 * it_ - 3 + k_) * 1536 + hcol_); \
        tile_issue<64, 128>(PVr, ST + (size_t)((b * 32 + c) * 16 + grp * 8 + (hd_)) * 8192, 128, lo_p); \
        _Pragma("unroll") for (int lt_ = 0; lt_ < 2; ++lt_) _Pragma("unroll") for (int pt_ = 0; pt_ < 2; ++pt_) \
            ZN[lt_][pt_] = *(const v2u*)(GZ + (t0 + wl * 32 + lt_ * 16 + (lane & 15)) * 2048 + 1024 + (grp * 8 + (hd_)) * 64 + wp * 32 + pt_ * 16 + 4 * (lane >> 4)); } while (0)
    SSD_ISSUE(0);
    __syncthreads();
    f32x4 cb[2][4];
#pragma unroll
    for (int a = 0; a < 2; ++a)
#pragma unroll
        for (int q = 0; q < 4; ++q) cb[a][q] = (f32x4){0.f, 0.f, 0.f, 0.f};
#pragma unroll
    for (int ks = 0; ks < 4; ++ks) {
        bf16x8 cf[2], bfr[4];
#pragma unroll
        for (int t = 0; t < 2; ++t) cf[t] = frag_rm(Ct, 272, wl * 32 + t * 16, ks * 32, lane);
#pragma unroll
        for (int t = 0; t < 4; ++t) bfr[t] = frag_rm(BM, 272, ws * 64 + t * 16, ks * 32, lane);
#pragma unroll
        for (int lt = 0; lt < 2; ++lt)
#pragma unroll
            for (int st = 0; st < 4; ++st) cb[lt][st] = mma(bfr[st], cf[lt], cb[lt][st]);
    }
#pragma unroll 1
    for (int hd = 0; hd < 8; ++hd) {
        const int head = grp * 8 + hd;
        const ConvW W = load_convw(P.conv_w, P.conv_b, grp * 512 + hd * 64 + cc8);
        const float dsk = P.d_ssd[head];
        __syncthreads();
#pragma unroll
        for (int lt = 0; lt < 2; ++lt) { const int l = wl * 32 + lt * 16 + (lane & 15); const float csl = cs[hd * 128 + l], dgl = dsk / dtl[hd * 128 + l];
#pragma unroll
            for (int st = 0; st < 4; ++st) { const int s = ws * 64 + st * 16 + 4 * (lane >> 4); f32x4 m;
#pragma unroll
                for (int jj = 0; jj < 4; ++jj) { m[jj] = (s + jj <= l) ? cb[lt][st][jj] * __expf(csl - cs[hd * 128 + s + jj]) : 0.f; if (s + jj == l) m[jj] += dgl; }
                *(LAS v2u*)(BM + l * 272 + s * 2) = (v2u){pk2(m[0], m[1]), pk2(m[2], m[3])}; } }
#pragma unroll
        for (int it = 0; it < 2; ++it) { float o[8]; conv8r(XR[it], W, tin0 + 64 * it, o);
            *(LAS v4u*)(Xd + (r0 + 64 * it) * 160 + cc8 * 2) = pack8(o, dtl[hd * 128 + r0 + 64 * it]); }
        tile_commit<64, 128>(PVr, Pv, 272, F.tid);
#pragma unroll
        for (int lt = 0; lt < 2; ++lt)
#pragma unroll
            for (int pt = 0; pt < 2; ++pt) ZC[lt][pt] = ZN[lt][pt];
        if (hd < 7) SSD_ISSUE(hd + 1);
        __syncthreads();
        f32x4 yd[2][2], yo[2][2];
#pragma unroll
        for (int a2 = 0; a2 < 2; ++a2)
#pragma unroll
            for (int q = 0; q < 2; ++q) { yd[a2][q] = (f32x4){0.f, 0.f, 0.f, 0.f}; yo[a2][q] = (f32x4){0.f, 0.f, 0.f, 0.f}; }
#pragma unroll
        for (int ks = 0; ks < 4; ++ks) {
            bf16x8 mf[2], xf[2], cf[2], pf[2];
#pragma unroll
            for (int t = 0; t < 2; ++t) { mf[t] = frag_rm(BM, 272, wl * 32 + t * 16, ks * 32, lane); xf[t] = frag_tr(Xd, 160, wp * 32 + t * 16, ks * 32, lane);
                                          cf[t] = frag_rm(Ct, 272, wl * 32 + t * 16, ks * 32, lane); pf[t] = frag_rm(Pv, 272, wp * 32 + t * 16, ks * 32, lane); }
#pragma unroll
            for (int lt = 0; lt < 2; ++lt)
#pragma unroll
                for (int pt = 0; pt < 2; ++pt) { yd[lt][pt] = mma(xf[pt], mf[lt], yd[lt][pt]); yo[lt][pt] = mma(pf[pt], cf[lt], yo[lt][pt]); }
        }
#pragma unroll
        for (int lt = 0; lt < 2; ++lt) { const int l = wl * 32 + lt * 16 + (lane & 15); const float ecs = __expf(cs[hd * 128 + l]); float ss = 0.f;
#pragma unroll
            for (int pt = 0; pt < 2; ++pt) { const int p = wp * 32 + pt * 16 + 4 * (lane >> 4);
                const v2u zv = ZC[lt][pt];
                f32x4 y = yd[lt][pt] + ecs * yo[lt][pt];
                y[0] *= silu_f(bflo(zv.x)); y[1] *= silu_f(bfhi(zv.x)); y[2] *= silu_f(bflo(zv.y)); y[3] *= silu_f(bfhi(zv.y));
                ss += (y[0] * y[0] + y[1] * y[1]) + (y[2] * y[2] + y[3] * y[3]);
                *(v2u*)(YO + (t0 + l) * 2048 + 1024 + head * 64 + p) = (v2u){pk2(y[0], y[1]), pk2(y[2], y[3])}; }
            ss += __shfl_xor(ss, 16); ss += __shfl_xor(ss, 32);
            if ((lane >> 4) == 0) rowss[(hd * 2 + wp) * 128 + l] = ss; }
    }
#undef SSD_ISSUE
    asm volatile("s_waitcnt vmcnt(0)" ::: "memory");
    __syncthreads();
    LAS float* rst = (LAS float*)F.lds;
    if (F.tid < 128) { float t = 0.f;
#pragma unroll
        for (int q = 0; q < 16; ++q) t += rowss[q * 128 + F.tid];
        rst[F.tid] = rsqrtf(t * (1.f / 512.f) + EPS); }
    __syncthreads();
    { const int cc = F.tid & 63; const f32x4 n0 = *(const f32x4*)(P.ssd_norm + grp * 512 + cc * 8), n1 = *(const f32x4*)(P.ssd_norm + grp * 512 + cc * 8 + 4);
#pragma unroll 4
      for (int it = 0; it < 16; ++it) { const int r = (F.tid >> 6) + it * 8; const float rs = rst[r];
          v4u* gp = (v4u*)(YO + (t0 + r) * 2048 + 1024 + grp * 512 + cc * 8); const v4u v = *gp;
          v4u o; o.x = pk2(bflo(v.x) * rs * n0[0], bfhi(v.x) * rs * n0[1]); o.y = pk2(bflo(v.y) * rs * n0[2], bfhi(v.y) * rs * n0[3]);
          o.z = pk2(bflo(v.z) * rs * n1[0], bfhi(v.z) * rs * n1[1]); o.w = pk2(bflo(v.w) * rs * n1[2], bfhi(v.w) * rs * n1[3]);
          *gp = o; } }
}

struct S5Par { const float* lam_re; const float* lam_im; const float* log_step; const float* b_re; const float* b_im; const float* c_re; const float* c_im; const float* d_s5; };

DI void s5_build_unit(Frame& F, const S5Par& P, int unit) {
    const int g = unit >> 2, cq = unit & 3;
    bf16* AB = (bf16*)(F.ws + WS_S5MAT + (size_t)g * 262144); bf16* E = AB + 256 * 384;
    LAS f32x2v* pw = (LAS f32x2v*)F.lds;
    LAS f32x2v* Bb = (LAS f32x2v*)(F.lds + 8704);
    LAS f32x2v* Cc = (LAS f32x2v*)(F.lds + 16896);
    LAS float* Km = (LAS float*)(F.lds + 25088);
    __syncthreads();
    if (F.tid < 64) { const int p = F.tid;
        const double lr = fmin((double)P.lam_re[g * 64 + p], -1e-4), li = (double)P.lam_im[g * 64 + p], dl = (double)expf(P.log_step[g]);
        double a1r = 0, a1i = 0;
        for (int t = 0; t <= 16; ++t) { const double mag = (double)expf((float)(t * lr * dl)); double s, c; sincos_d(t * li * dl, s, c);
            pw[t * 64 + p] = (f32x2v){(float)(mag * c), (float)(mag * s)}; if (t == 1) { a1r = mag * c; a1i = mag * s; } }
        const double den = lr * lr + li * li, nr = a1r - 1.0, ni = a1i, cr = (nr * lr + ni * li) / den, ci = (ni * lr - nr * li) / den;
        for (int c2 = 0; c2 < 16; ++c2) { const double br = P.b_re[(g * 64 + p) * 16 + c2], bi = P.b_im[(g * 64 + p) * 16 + c2];
            Bb[p * 16 + c2] = (f32x2v){(float)(cr * br - ci * bi), (float)(cr * bi + ci * br)}; } }
    for (int i = F.tid; i < 1024; i += NTHR) Cc[i] = (f32x2v){P.c_re[g * 1024 + i], P.c_im[g * 1024 + i]};
    __syncthreads();
    for (int i = F.tid; i < 1024; i += NTHR) { const int t = i >> 6, cl = (i >> 4) & 3, c2 = i & 15, c = cq * 4 + cl; float acc = 0.f;
        for (int p = 0; p < 64; ++p) { const f32x2v cc = Cc[c * 64 + p], a = pw[t * 64 + p], bb = Bb[p * 16 + c2];
            const float tr = cc.x * a.x - cc.y * a.y, ti = cc.x * a.y + cc.y * a.x; acc += tr * bb.x - ti * bb.y; }
        Km[i] = acc; }
    __syncthreads();
    for (int i = F.tid; i < 64 * 48; i += NTHR) { const int rl = i / 48, c8 = (i % 48) * 8, l = rl >> 2, cl = rl & 3, c = cq * 4 + cl, row = l * 16 + c; float v[8];
        if (c8 < 256) { const int s = c8 >> 4, c2 = c8 & 15;
#pragma unroll
            for (int k = 0; k < 8; ++k) v[k] = s <= l ? Km[((l - s) * 4 + cl) * 16 + c2 + k] : 0.f;
        } else { const bool im = c8 >= 320; const int p0 = c8 - (im ? 320 : 256);
#pragma unroll
            for (int k = 0; k < 8; ++k) { const f32x2v cc = Cc[c * 64 + p0 + k], a = pw[(l + 1) * 64 + p0 + k];
                v[k] = im ? -(cc.x * a.y + cc.y * a.x) : (cc.x * a.x - cc.y * a.y); } }
        *(v4u*)(AB + (size_t)row * 384 + c8) = (v4u){pk2(v[0], v[1]), pk2(v[2], v[3]), pk2(v[4], v[5]), pk2(v[6], v[7])}; }
    for (int i = F.tid; i < 32 * 32; i += NTHR) { const int rl = i >> 5, c8 = (i & 31) * 8, p = cq * 16 + (rl & 15), s = c8 >> 4, c2 = c8 & 15; const bool im = rl >= 16; const int row = (im ? 64 : 0) + p; float v[8];
        const f32x2v a = pw[(15 - s) * 64 + p];
#pragma unroll
        for (int k = 0; k < 8; ++k) { const f32x2v bb = Bb[p * 16 + c2 + k]; v[k] = im ? (a.x * bb.y + a.y * bb.x) : (a.x * bb.x - a.y * bb.y); }
        *(v4u*)(E + (size_t)row * 256 + c8) = (v4u){pk2(v[0], v[1]), pk2(v[2], v[3]), pk2(v[4], v[5]), pk2(v[6], v[7])}; }
}

DI void s5_gemmA_unit(Frame& F, int unit) {
    const bf16* HN = (const bf16*)(F.ws + WS_SLOT32); float* EO = (float*)(F.ws + WS_S5E);
    const int g = unit >> 2, q = unit & 3, lane = F.lane, w = F.wave, i = lane & 15, gq = lane >> 4;
    const bf16* E = (const bf16*)(F.ws + WS_S5MAT + (size_t)g * 262144) + 256 * 384 + (q * 32) * 256;
    bf16x8 ef[2][8];
#pragma unroll
    for (int mt = 0; mt < 2; ++mt)
#pragma unroll
        for (int ks = 0; ks < 8; ++ks) ef[mt][ks] = *(const bf16x8*)(E + (mt * 16 + i) * 256 + 32 * ks + 8 * gq);
#pragma unroll 2
    for (int t = 0; t < 8; ++t) { const int nt = t * 8 + w, b = nt >> 4, k0 = (nt & 15) * 16;
        const bf16* hp = HN + ((size_t)b * SEQ + 16 * (k0 + i) + (gq >> 1)) * D + 16 * g + 8 * (gq & 1);
        bf16x8 uf[8];
#pragma unroll
        for (int ks = 0; ks < 8; ++ks) uf[ks] = *(const bf16x8*)(hp + (size_t)(2 * ks) * D);
        f32x4 acc[2] = {(f32x4){0.f, 0.f, 0.f, 0.f}, (f32x4){0.f, 0.f, 0.f, 0.f}};
#pragma unroll
        for (int ks = 0; ks < 8; ++ks)
#pragma unroll
            for (int mt = 0; mt < 2; ++mt) acc[mt] = mma(ef[mt][ks], uf[ks], acc[mt]);
        float* dst = EO + ((size_t)((b * 256 + k0 + i) * 64 + g)) * 128 + q * 32 + 4 * gq;
#pragma unroll
        for (int mt = 0; mt < 2; ++mt) *(f32x4*)(dst + mt * 16) = acc[mt]; }
}

DI void s5_scan_task(Frame& F, const float* lam_re, const float* lam_im, const float* log_step, int task, int dbg) {
    const float* EO = (const float*)(F.ws + WS_S5E); bf16* XO = (bf16*)(F.ws + WS_S5X);
    const int b = task >> 6, g = task & 63, p = F.lane;
    f32x2v a;
    { const double lr = fmin((double)lam_re[g * 64 + p], -1e-4), li = (double)lam_im[g * 64 + p], dl = (double)expf(log_step[g]);
      const double mag = (double)expf((float)(16.0 * lr * dl)); double s, c; sincos_d(16.0 * li * dl, s, c); a = (f32x2v){(float)(mag * c), (float)(mag * s)}; }
    if (dbg == 6) a = (f32x2v){0.f, 0.f};
    float rr = 0.f, ri = 0.f;
    const float* ep = EO + ((size_t)(b * 256) * 64 + g) * 128 + p; bf16* xp = XO + ((size_t)(b * 256) * 64 + g) * 128 + p;
    float er[16], ei[16], fr_[16], fi_[16];
#pragma unroll
    for (int s2 = 0; s2 < 16; ++s2) { er[s2] = ep[(size_t)s2 * 8192]; ei[s2] = ep[(size_t)s2 * 8192 + 64]; }
#pragma unroll 1
    for (int kb = 0; kb < 16; ++kb) {
        const int kn = kb < 15 ? kb + 1 : kb;
#pragma unroll
        for (int s2 = 0; s2 < 16; ++s2) { fr_[s2] = ep[(size_t)(kn * 16 + s2) * 8192]; fi_[s2] = ep[(size_t)(kn * 16 + s2) * 8192 + 64]; }
#pragma unroll
        for (int s2 = 0; s2 < 16; ++s2) { bf16* xo = xp + (size_t)(kb * 16 + s2) * 8192;
            xo[0] = (bf16)f2bf(rr); xo[64] = (bf16)f2bf(ri);
            const float nr = a.x * rr - a.y * ri + er[s2], ni = a.x * ri + a.y * rr + ei[s2]; rr = nr; ri = ni; }
#pragma unroll
        for (int s2 = 0; s2 < 16; ++s2) { er[s2] = fr_[s2]; ei[s2] = fi_[s2]; }
    }
}

DI float gelu_tanh(float v) { const float u = 0.7978845608028654f * (v + 0.044715f * v * v * v); const float t = 1.0f - 2.0f / (__expf(2.0f * u) + 1.0f); return 0.5f * v * (1.0f + t); }

DI void s5_gemmB_unit(Frame& F, const float* d_s5, int unit) {
    const bf16* HN = (const bf16*)(F.ws + WS_SLOT32); const bf16* XO = (const bf16*)(F.ws + WS_S5X); bf16* Y = (bf16*)(F.ws + WS_Y);
    const int g = unit >> 2, lq = unit & 3, lane = F.lane, w = F.wave, i = lane & 15, gq = lane >> 4;
    const bf16* AB = (const bf16*)(F.ws + WS_S5MAT + (size_t)g * 262144) + (size_t)(64 * lq) * 384;
    LAS unsigned char* A = F.lds;
    __syncthreads();
    load_tile(A, 784, AB, 384, 64, 384, F.tid);
    __syncthreads();
    const int colg = 16 * g + 4 * gq;
    const f32x4 dv = *(const f32x4*)(d_s5 + colg);
#pragma unroll 1
    for (int t = 0; t < 8; ++t) { const int nt = t * 8 + w, b = nt >> 4, k0 = (nt & 15) * 16;
        const bf16* hp = HN + ((size_t)b * SEQ + 16 * (k0 + i) + (gq >> 1)) * D + 16 * g + 8 * (gq & 1);
        const bf16* xp = XO + ((size_t)((b * 256 + k0 + i) * 64 + g)) * 128 + 8 * gq;
        bf16x8 uf[12];
#pragma unroll
        for (int ks = 0; ks < 8; ++ks) uf[ks] = *(const bf16x8*)(hp + (size_t)(2 * ks) * D);
#pragma unroll
        for (int ks = 0; ks < 4; ++ks) uf[8 + ks] = *(const bf16x8*)(xp + ks * 32);
        f32x4 acc[4];
#pragma unroll
        for (int mt = 0; mt < 4; ++mt) acc[mt] = (f32x4){0.f, 0.f, 0.f, 0.f};
#pragma unroll
        for (int ks = 0; ks < 12; ++ks) {
#pragma unroll
            for (int mt = 0; mt < 4; ++mt) acc[mt] = mma(frag_rm(A, 784, mt * 16, ks * 32, lane), uf[ks], acc[mt]);
            if (ks & 1) __builtin_amdgcn_sched_barrier(0); }
#pragma unroll
        for (int mt = 0; mt < 4; ++mt) { const size_t tok = (size_t)b * SEQ + 16 * (k0 + i) + 4 * lq + mt;
            const v2u hv = *(const v2u*)(HN + tok * D + colg);
            const float y0 = gelu_tanh(acc[mt][0] + dv[0] * bflo(hv.x)), y1 = gelu_tanh(acc[mt][1] + dv[1] * bfhi(hv.x));
            const float y2 = gelu_tanh(acc[mt][2] + dv[2] * bflo(hv.y)), y3 = gelu_tanh(acc[mt][3] + dv[3] * bfhi(hv.y));
            *(v2u*)(Y + tok * D + colg) = (v2u){pk2(y0, y1), pk2(y2, y3)}; } }
}

#ifndef REP_BAR
#define REP_BAR 1
#endif
#ifndef REP_CONV
#define REP_CONV 1
#endif
#ifndef REP_ROW
#define REP_ROW 1
#endif
#ifndef REP_RC
#define REP_RC 1
#endif
#ifndef REP_SC
#define REP_SC 1
#endif
#ifndef REP_GEMM
#define REP_GEMM 1
#endif
#ifndef REP_S5A
#define REP_S5A 1
#endif
#ifndef REP_S5S
#define REP_S5S 1
#endif
#ifndef REP_S5B
#define REP_S5B 1
#endif
#ifndef REP_RA
#define REP_RA 1
#endif
#ifndef REP_SA
#define REP_SA 1
#endif
#ifndef SKIP_EVEN
#define SKIP_EVEN 0
#endif
#ifndef SKIP_ODD
#define SKIP_ODD 0
#endif
DI int opq(int v) { asm volatile("" : "+s"(v)); return v; }
struct Args { const float* in[N_IN]; float* out; unsigned char* ws; };
constexpr int CW_BAR = 1024;

#define PHASE() do { unsigned z_ = 0u; asm volatile("" : "+s"(z_)); int l_ = __builtin_amdgcn_mbcnt_hi(~0u, __builtin_amdgcn_mbcnt_lo(~0u, z_)); int w_ = wave0; asm volatile("" : "+s"(w_)); \
        int g_ = gridDim.x, b_ = blockIdx.x; asm volatile("" : "+s"(g_), "+s"(b_)); F.G = g_; F.bid = b_; F.vcu = (g_ % 8 == 0) ? (b_ % 8) * (g_ / 8) + b_ / 8 : b_; F.lane = l_; F.wave = w_; F.tid = w_ * 64 + l_; F.out = (float*)(GAS float*)lds_ptr(F, N_IN); F.ws = (unsigned char*)(GAS unsigned char*)lds_ptr(F, N_IN + 1); } while (0)
#define WSP(T, off) ((T*)(F.ws + (off)))
#define GRID_BAR() do { PHASE(); XcdBarrier xb_; xb_.bar = (unsigned*)(F.ws + WS_CTL) + CW_BAR; xb_.x = xb_xcc_id(); xb_.tid = F.tid; xb_.st = (volatile LAS unsigned*)(F.lds + MISC_OFF) + 8; xcd_barrier(xb_); if (REP_BAR == 2) xcd_barrier(xb_); PHASE(); } while (0)
template <int layer> __device__ __forceinline__ void run_layer(Frame& F, const int wave0) {
        const int j = layer >> 1;
        if ((layer & 1) == 0) {
            if (!opq(SKIP_EVEN)) {
            { pg8::Gemm g{WSP(bf16, WS_SLOT32), WSP(bf16, WS_SLOT16), M, INP_PAD, D}; pg8::StaticOrder S; S.init(M, INP_PAD, F.G, F.bid);
              pg8::EpiInProj E{WSP(bf16, WS_QKV), WSP(bf16, WS_GZ), WSP(bf16, WS_XBC), WSP(float, WS_DT), (const float*)(F.ws + WS_ROPE), INP(I_DT_BIAS) + j * 16};
              pg8::gemm_phase<pg8::EpiInProj, pg8::StaticOrder, true, true>(F.lds, g, S, E, F.tid); }
#if REP_GEMM == 2
            { PHASE(); pg8::Gemm g{WSP(bf16, WS_SLOT32), WSP(bf16, WS_SLOT16), M, INP_PAD, D}; pg8::StaticOrder S; S.init(M, INP_PAD, F.G, F.bid);
              pg8::EpiInProj E{WSP(bf16, WS_QKV), WSP(bf16, WS_GZ), WSP(bf16, WS_XBC), WSP(float, WS_DT), (const float*)(F.ws + WS_ROPE), INP(I_DT_BIAS) + j * 16};
              pg8::gemm_phase<pg8::EpiInProj, pg8::StaticOrder, true, true>(F.lds, g, S, E, F.tid); }
#endif
            GRID_BAR();
            for (int rep_ = 0; rep_ < REP_RA; ++rep_) for (int u = F.vcu; u < 256; u += F.G) ret_passA_unit(F, u);
            { const SsdPar SP{INP(I_CONV_W) + (size_t)j * 4 * 1536, INP(I_CONV_B) + j * 1536, INP(I_A_LOG) + j * 16, INP(I_D_SSD) + j * 16, INP(I_SSD_NORM) + j * 1024};
              for (int rep_ = 0; rep_ < REP_SA; ++rep_) for (int u = F.vcu; u < 256; u += F.G) ssd_passA_unit(F, SP, u); }
            GRID_BAR();
            for (int it = (F.bid * NTHR + F.tid); it < 131072; it += (F.G * NTHR)) ret_scan_item(F, it);
            for (int it = (F.bid * NTHR + F.tid); it < 65536; it += (F.G * NTHR)) ssd_scan_item(F, it);
            GRID_BAR();
#if REP_RC == 2
            if (layer == 0) for (int u = F.vcu; u < 256; u += F.G) ret_passC_unit(F, u, (bf16*)F.out);
#endif
            for (int u = F.vcu; u < 256; u += F.G) ret_passC_unit(F, u, WSP(bf16, WS_GZ));
            { const SsdPar SP{INP(I_CONV_W) + (size_t)j * 4 * 1536, INP(I_CONV_B) + j * 1536, INP(I_A_LOG) + j * 16, INP(I_D_SSD) + j * 16, INP(I_SSD_NORM) + j * 1024};
#if REP_SC == 2
              if (layer == 0) for (int u = F.vcu; u < 256; u += F.G) ssd_passC_unit(F, SP, u, (bf16*)F.out);
#endif
              for (int u = F.vcu; u < 256; u += F.G) ssd_passC_unit(F, SP, u, WSP(bf16, WS_GZ)); }
            GRID_BAR();
            }
            __syncthreads();
            convert_weight(F, INP(I_W_UP) + (size_t)layer * D * FF, D, FF, WSP(bf16, WS_SLOT16), 0);
#if REP_CONV == 2
            convert_weight(F, INP(I_W_UP) + (size_t)layer * D * FF, D, FF, WSP(bf16, WS_SLOT16), 0);
#endif
            convert_weight(F, INP(I_W_DOWN) + (size_t)layer * FF * D, FF, D, WSP(bf16, WS_SLOT16) + (size_t)FF * D, 0);
#if REP_CONV == 2
            convert_weight(F, INP(I_W_DOWN) + (size_t)layer * FF * D, FF, D, WSP(bf16, WS_SLOT16) + (size_t)FF * D, 0);
#endif
            __syncthreads();
            if (!opq(SKIP_EVEN)) {
            { pg8::Gemm g{WSP(bf16, WS_GZ), WSP(bf16, WS_W4), M, D, 2048}; pg8::StaticOrder S; S.init(M, D, F.G, F.bid);
              pg8::EpiBf16 E{WSP(bf16, WS_M32A), D};
              pg8::gemm_phase<pg8::EpiBf16, pg8::StaticOrder, true, true>(F.lds, g, S, E, F.tid); }
#if REP_GEMM == 2
            { PHASE(); pg8::Gemm g{WSP(bf16, WS_GZ), WSP(bf16, WS_W4), M, D, 2048}; pg8::StaticOrder S; S.init(M, D, F.G, F.bid);
              pg8::EpiBf16 E{WSP(bf16, WS_M32A), D};
              pg8::gemm_phase<pg8::EpiBf16, pg8::StaticOrder, true, true>(F.lds, g, S, E, F.tid); }
#endif
            } else zero_fill(F, WSP(bf16, WS_M32A), (size_t)M * D * 2);
            GRID_BAR();
            if (layer == 0) row_phase<true, false>(F, WSP(bf16, WS_M32A), INP(I_X), F.out, INP(I_POST_MIX) + layer * D, INP(I_PRE_MLP) + layer * D, WSP(bf16, WS_SLOT32));
            else row_phase<false, false>(F, WSP(bf16, WS_M32A), F.out, F.out, INP(I_POST_MIX) + layer * D, INP(I_PRE_MLP) + layer * D, WSP(bf16, WS_SLOT32));
            GRID_BAR();
        } else {
            if (opq(SKIP_ODD) == 2) {
                const v4u* s_ = (const v4u*)WSP(bf16, WS_SLOT32); v4u* d_ = (v4u*)WSP(bf16, WS_Y);
                for (size_t i_ = (size_t)F.bid * NTHR + F.tid; i_ < (size_t)M * D / 8; i_ += (size_t)F.G * NTHR) d_[i_] = s_[i_];
                GRID_BAR();
            }
            if (opq(SKIP_ODD) == 0 || opq(SKIP_ODD) >= 3) {
            for (int rep_ = 0; rep_ < REP_S5A; ++rep_) for (int u = F.vcu; u < 256; u += F.G) s5_gemmA_unit(F, u);
            GRID_BAR();
            if (opq(SKIP_ODD) == 3) zero_fill(F, WSP(bf16, WS_S5X), (size_t)16 * MiB);
            else if (F.wave == 0) for (int rep_ = 0; rep_ < REP_S5S; ++rep_) for (int t = F.bid; t < 256; t += F.G) s5_scan_task(F, INP(I_LAM_RE) + j * 4096, INP(I_LAM_IM) + j * 4096, INP(I_LOG_STEP) + j * 64, t, opq(SKIP_ODD));
            GRID_BAR();
            for (int rep_ = 0; rep_ < REP_S5B; ++rep_) for (int u = F.vcu; u < 256; u += F.G) s5_gemmB_unit(F, INP(I_D_S5) + j * 1024, u);
            GRID_BAR();
            }
            __syncthreads();
            convert_weight(F, INP(I_W_UP) + (size_t)layer * D * FF, D, FF, WSP(bf16, WS_SLOT16), 0);
            convert_weight(F, INP(I_W_DOWN) + (size_t)layer * FF * D, FF, D, WSP(bf16, WS_SLOT16) + (size_t)FF * D, 0);
            __syncthreads();
            if (opq(SKIP_ODD) != 1) {
            { pg8::Gemm g{WSP(bf16, WS_Y), WSP(bf16, WS_W4), M, 2048, D}; pg8::StaticOrder S; S.init(M, 2048, F.G, F.bid);
              pg8::EpiGlu E{WSP(bf16, WS_M32B), D};
              pg8::gemm_phase<pg8::EpiGlu, pg8::StaticOrder, true, true>(F.lds, g, S, E, F.tid); }
#if REP_GEMM == 2
            { PHASE(); pg8::Gemm g{WSP(bf16, WS_Y), WSP(bf16, WS_W4), M, 2048, D}; pg8::StaticOrder S; S.init(M, 2048, F.G, F.bid);
              pg8::EpiGlu E{WSP(bf16, WS_M32B), D};
              pg8::gemm_phase<pg8::EpiGlu, pg8::StaticOrder, true, true>(F.lds, g, S, E, F.tid); }
#endif
            } else zero_fill(F, WSP(bf16, WS_M32B), (size_t)M * D * 2);
            GRID_BAR();
            row_phase<false, false>(F, WSP(bf16, WS_M32B), F.out, F.out, INP(I_POST_MIX) + layer * D, INP(I_PRE_MLP) + layer * D, WSP(bf16, WS_SLOT32));
            GRID_BAR();
        }
        { pg8::Gemm g{WSP(bf16, WS_SLOT32), WSP(bf16, WS_SLOT16), M, FF, D}; pg8::StaticOrder S; S.init(M, FF, F.G, F.bid);
          pg8::EpiRelu2 E{WSP(bf16, WS_U), FF};
          pg8::gemm_phase<pg8::EpiRelu2, pg8::StaticOrder, true, true>(F.lds, g, S, E, F.tid); }
#if REP_GEMM == 2
            { PHASE(); pg8::Gemm g{WSP(bf16, WS_SLOT32), WSP(bf16, WS_SLOT16), M, FF, D}; pg8::StaticOrder S; S.init(M, FF, F.G, F.bid);
          pg8::EpiRelu2 E{WSP(bf16, WS_U), FF};
          pg8::gemm_phase<pg8::EpiRelu2, pg8::StaticOrder, true, true>(F.lds, g, S, E, F.tid); }
#endif
        GRID_BAR();
        __syncthreads();
        if ((layer & 1) == 0) { convert_weight(F, INP(I_W_GLU_A) + (size_t)j * D * D, D, D, WSP(bf16, WS_W4), 1); convert_weight(F, INP(I_W_GLU_B) + (size_t)j * D * D, D, D, WSP(bf16, WS_W4), 2); }
#if REP_CONV == 2
        if ((layer & 1) == 0) { convert_weight(F, INP(I_W_GLU_A) + (size_t)j * D * D, D, D, WSP(bf16, WS_W4), 1); convert_weight(F, INP(I_W_GLU_B) + (size_t)j * D * D, D, D, WSP(bf16, WS_W4), 2); }
#endif
        __syncthreads();
        { pg8::Gemm g{WSP(bf16, WS_U), WSP(bf16, WS_SLOT16) + (size_t)FF * D, M, D, FF}; pg8::StaticOrder S; S.init(M, D, F.G, F.bid);
          pg8::EpiBf16 E{WSP(bf16, WS_M32B), D};
          pg8::gemm_phase<pg8::EpiBf16, pg8::StaticOrder, true, true>(F.lds, g, S, E, F.tid); }
#if REP_GEMM == 2
            { PHASE(); pg8::Gemm g{WSP(bf16, WS_U), WSP(bf16, WS_SLOT16) + (size_t)FF * D, M, D, FF}; pg8::StaticOrder S; S.init(M, D, F.G, F.bid);
          pg8::EpiBf16 E{WSP(bf16, WS_M32B), D};
          pg8::gemm_phase<pg8::EpiBf16, pg8::StaticOrder, true, true>(F.lds, g, S, E, F.tid); }
#endif
        GRID_BAR();
        if (layer < DEPTH - 1) row_phase<false, false>(F, WSP(bf16, WS_M32B), F.out, F.out, INP(I_POST_MLP) + layer * D, INP(I_PRE_MIX) + (layer + 1) * D, WSP(bf16, WS_SLOT32));
        else row_phase<false, true>(F, WSP(bf16, WS_M32B), F.out, F.out, INP(I_POST_MLP) + layer * D, nullptr, nullptr);
        if (layer == 0 || layer == 2) {
            const S5Par P5{INP(I_LAM_RE) + j * 4096, INP(I_LAM_IM) + j * 4096, INP(I_LOG_STEP) + j * 64, INP(I_B_RE) + (size_t)j * 65536, INP(I_B_IM) + (size_t)j * 65536,
                           INP(I_C_RE) + (size_t)j * 65536, INP(I_C_IM) + (size_t)j * 65536, INP(I_D_S5) + j * 1024};
            for (int u = F.bid; u < 256; u += F.G) s5_build_unit(F, P5, u);
        } else if (layer == 1) {
            __syncthreads();
            convert_weight(F, INP(I_W_IN) + (size_t)D * INP, D, INP, WSP(bf16, WS_SLOT16), 0);
#if REP_CONV == 2
            convert_weight(F, INP(I_W_IN) + (size_t)D * INP, D, INP, WSP(bf16, WS_SLOT16), 0);
#endif
            zero_fill(F, WSP(bf16, WS_SLOT16) + (size_t)6688 * D, (size_t)(INP_PAD - 6688) * D * 2);
            convert_weight(F, INP(I_W_OUT) + (size_t)2048 * D, 2048, D, WSP(bf16, WS_W4), 0);
#if REP_CONV == 2
            convert_weight(F, INP(I_W_OUT) + (size_t)2048 * D, 2048, D, WSP(bf16, WS_W4), 0);
#endif
        }
        if (layer < DEPTH - 1) GRID_BAR();

}

__global__ void __launch_bounds__(NTHR, 2) trunk_fwd(Args args) {
    extern __shared__ __attribute__((aligned(16))) unsigned char lds[];
    Frame F;
    F.lds = (LAS unsigned char*)lds;
    F.G = gridDim.x; F.bid = blockIdx.x;
    { const int t = threadIdx.x;
      for (int u = t; u < (LDS_BYTES - MISC_OFF) / 4; u += NTHR) ((LAS unsigned*)(F.lds + MISC_OFF))[u] = 0u;
      __syncthreads();
      if (t < N_IN + 2) ((LAS unsigned long long*)(F.lds + MISC_OFF + 256))[t] = t < N_IN ? (unsigned long long)args.in[t] : (t == N_IN ? (unsigned long long)args.out : (unsigned long long)args.ws);
      __syncthreads(); }
    const int wave0 = __builtin_amdgcn_readfirstlane(threadIdx.x >> 6);
    PHASE();
    (void)xcd_barrier_post((unsigned*)(F.ws + WS_CTL) + CW_BAR, (volatile LAS unsigned*)(F.lds + MISC_OFF) + 8);

    build_rope(F);
    convert_weight(F, INP(I_W_IN), D, INP, WSP(bf16, WS_SLOT16), 0);
#if REP_CONV == 2
    convert_weight(F, INP(I_W_IN), D, INP, WSP(bf16, WS_SLOT16), 0);
#endif
    zero_fill(F, WSP(bf16, WS_SLOT16) + (size_t)6688 * D, (size_t)(INP_PAD - 6688) * D * 2);
    convert_weight(F, INP(I_W_OUT), 2048, D, WSP(bf16, WS_W4), 0);
#if REP_CONV == 2
    convert_weight(F, INP(I_W_OUT), 2048, D, WSP(bf16, WS_W4), 0);
#endif
    rms_rows_to_bf16(F, INP(I_X), INP(I_PRE_MIX), WSP(bf16, WS_SLOT32));
    GRID_BAR();

    run_layer<0>(F, wave0); run_layer<1>(F, wave0); run_layer<2>(F, wave0); run_layer<3>(F, wave0);
}

extern "C" void kernel_launch(void* const* d_in, const int* in_sizes, int n_in, void* d_out, int out_size, void* d_ws, size_t ws_size, hipStream_t stream) {
    static int grid = 0;
    if (grid == 0) {
        if (n_in != N_IN || out_size != M * D || ws_size < WS_END) { fprintf(stderr, "kernel_launch: unexpected shapes (n_in %d, out %d, ws %zu)\n", n_in, out_size, ws_size); grid = -1; return; }
        int dev = 0, cus = 0, per_cu = 0;
        if (hipGetDevice(&dev) != hipSuccess || hipDeviceGetAttribute(&cus, hipDeviceAttributeMultiprocessorCount, dev) != hipSuccess) { grid = -1; return; }
        if (hipFuncSetAttribute((const void*)trunk_fwd, hipFuncAttributeMaxDynamicSharedMemorySize, LDS_BYTES) != hipSuccess) { fprintf(stderr, "kernel_launch: hipFuncSetAttribute failed\n"); grid = -1; return; }
        if (hipOccupancyMaxActiveBlocksPerMultiprocessor(&per_cu, (const void*)trunk_fwd, NTHR, LDS_BYTES) != hipSuccess || per_cu < 1)
            fprintf(stderr, "kernel_launch: note: occupancy query reports %d workgroups per CU\n", per_cu);
        (void)hipGetLastError();
        grid = cus;
    }
    if (grid < 0) return;
    if (hipMemsetAsync((char*)d_ws + WS_CTL, 0, CTL_ZERO_BYTES, stream) != hipSuccess) return;
#ifdef DBG_ZERO_MISC
    if (hipMemsetAsync((char*)d_ws + WS_MISC, 0, 512 * 1024, stream) != hipSuccess) return;
#endif
    Args a{};
    for (int i = 0; i < N_IN; ++i) a.in[i] = (const float*)d_in[i];
    a.out = (float*)d_out; a.ws = (unsigned char*)d_ws;
    hipLaunchKernelGGL(trunk_fwd, dim3(grid), dim3(NTHR), LDS_BYTES, stream, a);
}
```

```cpp
#include <hip/hip_runtime.h>
#include <cstdio>
#include <cstdint>
namespace pg8 {
#define PG8_LAS __attribute__((address_space(3)))
typedef unsigned short bf16_t;
typedef short bf16x8 __attribute__((ext_vector_type(8)));
typedef float f32x4 __attribute__((ext_vector_type(4)));
typedef unsigned u32x4 __attribute__((ext_vector_type(4)));
constexpr int BM = 256, BK = 64, HALF = 128, HTB = HALF * BK * 2  , STAGE_BYTES = 8 * HTB, NXCD = 8, WGM = 8;

__host__ __device__ __forceinline__ int lds_byte(int r, int c) { const int st = (r >> 4) * 2 + (c >> 5), rr = r & 15, cc = c & 31, ob = rr * 64 + cc * 2; return st * 1024 + (ob ^ (((ob >> 9) & 1) << 5)); }
__host__ __device__ __forceinline__ void stage_rc(int b, int& R, int& C) { const int st = b / 1024, sb = b % 1024, swz = sb ^ (((sb >> 9) & 1) << 5); R = (st >> 1) * 16 + swz / 64; C = (st & 1) * 32 + (swz % 64) / 2; }
__host__ __device__ __forceinline__ int perm32(int rho) { const int n = rho >> 4, i = rho & 15; return 8 * (i >> 2) + 4 * n + (i & 3); }

struct Unit { int pm, pn; };
struct Gemm { const bf16_t* A; const bf16_t* Bt; int M, N, K; };

struct StaticOrder {
    int nM, nN, nwg, G, c;
    __host__ __device__ void init(int M, int N, int G_, int c_) { nM = M / BM; nN = N / BM; nwg = nM * nN; G = G_; c = c_; }
    __host__ __device__ bool next(int i, Unit& u) const {
        const long L = (long)i * G + c; if (L >= nwg) return false;
        int wgid = (int)L; { const int q = nwg / NXCD, r = nwg % NXCD, xcd = wgid % NXCD, off = wgid / NXCD; wgid = (xcd < r ? xcd * (q + 1) : r * (q + 1) + (xcd - r) * q) + off; }
        const int nig = WGM * nN, gid = wgid / nig, fm = gid * WGM, gsz = (nM - fm) < WGM ? (nM - fm) : WGM;
        u.pm = fm + ((wgid % nig) % gsz); u.pn = (wgid % nig) / gsz; return true;
    }
    __device__ __forceinline__ void a_ready(const Unit&) const {}
    __device__ __forceinline__ void done(const Unit&) const {}
};

typedef __bf16 bf2_t __attribute__((ext_vector_type(2))); typedef float f32x2p __attribute__((ext_vector_type(2)));
__device__ __forceinline__ unsigned cvt_pk_bf16(float lo, float hi) { const f32x2p v = {lo, hi}; return __builtin_bit_cast(unsigned, __builtin_convertvector(v, bf2_t)); }
typedef float f32x2 __attribute__((ext_vector_type(2)));
struct EpiBf16 {
    static constexpr bool PERM = true, AFTER_DRAIN = false;
    bf16_t* O; int ldc;
    __device__ __forceinline__ void operator()(const f32x4 (&acc)[2][2][4][2], const Unit& u, int wr, int wc, int fr_in, int fq_in) const {
        int fr = fr_in, fq = fq_in; asm volatile("" : "+v"(fr), "+v"(fq));
        const int row0 = u.pm * BM + wr * 64 + fr, col0 = u.pn * BM + wc * 32 + 8 * fq;
#pragma unroll
        for (int ai = 0; ai < 2; ++ai)
#pragma unroll
            for (int m = 0; m < 4; ++m) { bf16_t* rowp = O + (size_t)(row0 + ai * HALF + m * 16) * ldc + col0;
#pragma unroll
                for (int bj = 0; bj < 2; ++bj) { const f32x4 v0 = acc[ai][bj][m][0], v1 = acc[ai][bj][m][1];
                    u32x4 w; w.x = cvt_pk_bf16(v0[0], v0[1]); w.y = cvt_pk_bf16(v0[2], v0[3]); w.z = cvt_pk_bf16(v1[0], v1[1]); w.w = cvt_pk_bf16(v1[2], v1[3]);
                    *(u32x4*)(rowp + bj * HALF) = w; } }
    }
};
struct EpiGlu {
    static constexpr bool PERM = true, AFTER_DRAIN = false;
    bf16_t* O; int ldc;
    __device__ __forceinline__ void operator()(const f32x4 (&acc)[2][2][4][2], const Unit& u, int wr, int wc, int fr_in, int fq_in) const {
        int fr = fr_in, fq = fq_in; asm volatile("" : "+v"(fr), "+v"(fq));
        const int row0 = u.pm * BM + wr * 64 + fr, col0 = u.pn * HALF + wc * 32 + 8 * fq;
#pragma unroll
        for (int ai = 0; ai < 2; ++ai)
#pragma unroll
            for (int m = 0; m < 4; ++m) { bf16_t* rowp = O + (size_t)(row0 + ai * HALF + m * 16) * ldc + col0;
                f32x4 o[2];
#pragma unroll
                for (int n = 0; n < 2; ++n) { const f32x4 a = acc[ai][0][m][n], b = acc[ai][1][m][n];
#pragma unroll
                    for (int j = 0; j < 4; ++j) o[n][j] = a[j] * __builtin_amdgcn_rcpf(1.0f + __expf(-b[j])); }
                u32x4 w; w.x = cvt_pk_bf16(o[0][0], o[0][1]); w.y = cvt_pk_bf16(o[0][2], o[0][3]); w.z = cvt_pk_bf16(o[1][0], o[1][1]); w.w = cvt_pk_bf16(o[1][2], o[1][3]);
                *(u32x4*)rowp = w; }
    }
};
struct EpiRelu2 {
    static constexpr bool PERM = true, AFTER_DRAIN = false;
    bf16_t* O; int ldc;
    __device__ __forceinline__ void operator()(const f32x4 (&acc)[2][2][4][2], const Unit& u, int wr, int wc, int fr_in, int fq_in) const {
        int fr = fr_in, fq = fq_in; asm volatile("" : "+v"(fr), "+v"(fq));
        const int row0 = u.pm * BM + wr * 64 + fr, col0 = u.pn * BM + wc * 32 + 8 * fq;
#pragma unroll
        for (int ai = 0; ai < 2; ++ai)
#pragma unroll
            for (int m = 0; m < 4; ++m) { bf16_t* rowp = O + (size_t)(row0 + ai * HALF + m * 16) * ldc + col0;
#pragma unroll
                for (int bj = 0; bj < 2; ++bj) { f32x4 v0 = acc[ai][bj][m][0], v1 = acc[ai][bj][m][1];
#pragma unroll
                    for (int j = 0; j < 4; ++j) { const float a = fmaxf(v0[j], 0.f), b = fmaxf(v1[j], 0.f); v0[j] = a * a; v1[j] = b * b; }
                    u32x4 w; w.x = cvt_pk_bf16(v0[0], v0[1]); w.y = cvt_pk_bf16(v0[2], v0[3]); w.z = cvt_pk_bf16(v1[0], v1[1]); w.w = cvt_pk_bf16(v1[2], v1[3]);
                    *(u32x4*)(rowp + bj * HALF) = w; } }
    }
};
struct EpiInProj {
    static constexpr bool PERM = true, AFTER_DRAIN = false;
    bf16_t* QKV; bf16_t* GZ; bf16_t* XBC; float* DT; const float* rope; const float* dt_bias;
    __device__ __forceinline__ void operator()(const f32x4 (&acc)[2][2][4][2], const Unit& u, int wr, int wc, int fr_in, int fq_in) const {
        int fr = fr_in, fq = fq_in; asm volatile("" : "+v"(fr), "+v"(fq));
        const int pn = u.pn, row0 = u.pm * BM + wr * 64 + fr, cin = wc * 32 + 8 * fq;
        if (pn < 8) {
            const int hd = pn & 3; const bool isk = pn >= 4;
            const float lg2 = __log2f(1.0f - exp2f(-5.0f - (float)hd));
#pragma unroll
            for (int ai = 0; ai < 2; ++ai)
#pragma unroll
                for (int m = 0; m < 4; ++m) { const int row = row0 + ai * HALF + m * 16, pos = row & 4095, r = pos & 127;
                    const float sc = isk ? exp2f(-(float)r * lg2) * 0.0625f : exp2f((float)r * lg2);
                    const f32x4* rp = (const f32x4*)(rope + ((size_t)pos * 128 + cin) * 2);
                    f32x4 o1[2], o2[2];
#pragma unroll
                    for (int n = 0; n < 2; ++n) { const f32x4 cs0 = rp[2 * n], cs1 = rp[2 * n + 1];
                        const f32x4 x1 = acc[ai][0][m][n], x2 = acc[ai][1][m][n];
                        const float c[4] = {cs0[0], cs0[2], cs1[0], cs1[2]}, s[4] = {cs0[1], cs0[3], cs1[1], cs1[3]};
#pragma unroll
                        for (int j = 0; j < 4; ++j) { o1[n][j] = (x1[j] * c[j] - x2[j] * s[j]) * sc; o2[n][j] = (x2[j] * c[j] + x1[j] * s[j]) * sc; } }
                    bf16_t* rowp = QKV + (size_t)row * 3072 + pn * 256 + cin;
                    u32x4 w; w.x = cvt_pk_bf16(o1[0][0], o1[0][1]); w.y = cvt_pk_bf16(o1[0][2], o1[0][3]); w.z = cvt_pk_bf16(o1[1][0], o1[1][1]); w.w = cvt_pk_bf16(o1[1][2], o1[1][3]);
                    *(u32x4*)rowp = w;
                    w.x = cvt_pk_bf16(o2[0][0], o2[0][1]); w.y = cvt_pk_bf16(o2[0][2], o2[0][3]); w.z = cvt_pk_bf16(o2[1][0], o2[1][1]); w.w = cvt_pk_bf16(o2[1][2], o2[1][3]);
                    *(u32x4*)(rowp + HALF) = w; }
        } else if (pn < 26) {
            bf16_t* base; int ldc, colt;
            if (pn < 12) { base = QKV; ldc = 3072; colt = pn * 256; } else if (pn < 20) { base = GZ; ldc = 2048; colt = (pn - 12) * 256; } else { base = XBC; ldc = 1536; colt = (pn - 20) * 256; }
#pragma unroll
            for (int ai = 0; ai < 2; ++ai)
#pragma unroll
                for (int m = 0; m < 4; ++m) { bf16_t* rowp = base + (size_t)(row0 + ai * HALF + m * 16) * ldc + colt + cin;
#pragma unroll
                    for (int bj = 0; bj < 2; ++bj) { const f32x4 v0 = acc[ai][bj][m][0], v1 = acc[ai][bj][m][1];
                        u32x4 w; w.x = cvt_pk_bf16(v0[0], v0[1]); w.y = cvt_pk_bf16(v0[2], v0[3]); w.z = cvt_pk_bf16(v1[0], v1[1]); w.w = cvt_pk_bf16(v1[2], v1[3]);
                        *(u32x4*)(rowp + bj * HALF) = w; } }
        } else {
            if (cin < 16) {
#pragma unroll
                for (int ai = 0; ai < 2; ++ai)
#pragma unroll
                    for (int m = 0; m < 4; ++m) { float* rowp = DT + (size_t)(row0 + ai * HALF + m * 16) * 16 + cin;
#pragma unroll
                        for (int n = 0; n < 2; ++n) { f32x4 o;
#pragma unroll
                            for (int j = 0; j < 4; ++j) { const float x = acc[ai][0][m][n][j] + dt_bias[cin + 4 * n + j]; o[j] = x > 20.f ? x : log1pf(__expf(x)); }
                            *(f32x4*)(rowp + 4 * n) = o; } }
            }
        }
    }
};
template <class Epi, class Sched, bool ALIGN_EPI = false, bool SP2 = false>
__device__ __forceinline__ void gemm_phase(PG8_LAS unsigned char* lds, const Gemm g, const Sched& S, const Epi& E, const int tid) {
    const int wid = __builtin_amdgcn_readfirstlane(tid >> 6), lane = tid & 63, wr = wid >> 2, wc = wid & 3, fr = lane & 15, fq = lane >> 4;
    const int K = g.K, nt = K / BK;
    unsigned voffA[2], voffB[2];
#pragma unroll
    for (int i = 0; i < 2; ++i) { int R, C; stage_rc(tid * 16 + i * 8192, R, C); const int Rb = Epi::PERM ? ((R & ~31) + perm32(R & 31)) : R;
        voffA[i] = (unsigned)(R * K + C) * 2u; voffB[i] = (unsigned)(Rb * K + C) * 2u; }
    const size_t kstep = (size_t)(BK * 2);
    const size_t hstep = (size_t)HALF * K * 2;
    const size_t tstep = 2 * hstep;
    const unsigned ldsw = (unsigned)wid * 1024u;
    const int aoff = lds_byte(wr * 64 + fr, fq * 8), boff = lds_byte(wc * 32 + fr, fq * 8);
#define PG8_SA(b, h) (((b) * 2 + (h)) * HTB)
#define PG8_SB(b, h) ((4 + (b) * 2 + (h)) * HTB)
#define PG8_STAGE(bufoff, gbase, voff) do { _Pragma("unroll") for (int _i = 0; _i < 2; ++_i) \
        __builtin_amdgcn_global_load_lds((const unsigned*)((const char*)(gbase) + (voff)[_i]), (PG8_LAS unsigned*)(lds + (bufoff) + ldsw + _i * 8192), 16, 0, 0); } while (0)
#define PG8_LDA(dst, b, h) do { _Pragma("unroll") for (int m = 0; m < 4; ++m) _Pragma("unroll") for (int k = 0; k < 2; ++k) dst[m][k] = *(const PG8_LAS bf16x8*)(lds + PG8_SA(b, h) + aoff + m * 2048 + k * 1024); } while (0)
#define PG8_LDB(dst, b, h) do { _Pragma("unroll") for (int n = 0; n < 2; ++n) _Pragma("unroll") for (int k = 0; k < 2; ++k) dst[n][k] = *(const PG8_LAS bf16x8*)(lds + PG8_SB(b, h) + boff + n * 2048 + k * 1024); } while (0)
#define PG8_MMA(ai, bj, At, Bt) do { __builtin_amdgcn_s_setprio(1); _Pragma("unroll") for (int m = 0; m < 4; ++m) _Pragma("unroll") for (int n = 0; n < 2; ++n) _Pragma("unroll") for (int k = 0; k < 2; ++k) \
        acc[ai][bj][m][n] = __builtin_amdgcn_mfma_f32_16x16x32_bf16(Bt[n][k], At[m][k], acc[ai][bj][m][n], 0, 0, 0); __builtin_amdgcn_s_setprio(0); } while (0)
#define PG8_WAIT_V(n) asm volatile("s_waitcnt vmcnt(" #n ")" ::: "memory")
#define PG8_WAIT_L(n) asm volatile("s_waitcnt lgkmcnt(" #n ")" ::: "memory")
#define PG8_BAR __builtin_amdgcn_s_barrier()
#define PG8_SCHED __builtin_amdgcn_sched_barrier(0)
    Unit cur, nxt; int ui = 0;
    if (!S.next(0, cur)) return;
    f32x4 acc[2][2][4][2];
#pragma unroll
    for (int a = 0; a < 2; ++a)
#pragma unroll
        for (int b = 0; b < 2; ++b)
#pragma unroll
            for (int m = 0; m < 4; ++m)
#pragma unroll
                for (int n = 0; n < 2; ++n) acc[a][b][m][n] = (f32x4){0.f, 0.f, 0.f, 0.f};
    bf16x8 At[4][2], B0[2][2], B1[2][2];
    const char* cA = (const char*)g.A + (size_t)cur.pm * tstep; const char* cB = (const char*)g.Bt + (size_t)cur.pn * tstep;
    S.a_ready(cur);
    if constexpr (SP2) {
        PG8_STAGE(PG8_SB(0, 0), cB, voffB); PG8_STAGE(PG8_SB(0, 1), cB + hstep, voffB); PG8_STAGE(PG8_SA(0, 0), cA, voffA); PG8_STAGE(PG8_SA(0, 1), cA + hstep, voffA);
        if (wr == 1) PG8_BAR;
        PG8_WAIT_V(2); PG8_BAR;
        PG8_STAGE(PG8_SB(1, 0), cB + kstep, voffB); PG8_STAGE(PG8_SA(1, 0), cA + kstep, voffA); PG8_STAGE(PG8_SB(1, 1), cB + hstep + kstep, voffB);
        PG8_WAIT_V(6); PG8_BAR;
    } else {
        PG8_STAGE(PG8_SB(0, 0), cB, voffB); PG8_STAGE(PG8_SA(0, 0), cA, voffA); PG8_STAGE(PG8_SB(0, 1), cB + hstep, voffB); PG8_STAGE(PG8_SA(0, 1), cA + hstep, voffA);
        if (wr == 1) PG8_BAR;
        PG8_WAIT_V(4); PG8_BAR;
        PG8_STAGE(PG8_SB(1, 0), cB + kstep, voffB); PG8_STAGE(PG8_SA(1, 0), cA + kstep, voffA); PG8_STAGE(PG8_SB(1, 1), cB + hstep + kstep, voffB);
        PG8_WAIT_V(6); PG8_BAR;
    }
    for (;;) {
        const bool has_next = S.next(ui + 1, nxt);
        const char* nA = has_next ? (const char*)g.A + (size_t)nxt.pm * tstep : cA; const char* nB = has_next ? (const char*)g.Bt + (size_t)nxt.pn * tstep : cB;
        for (int t = 0; t < nt; t += 2) {
            const bool last = (t == nt - 2);
            const char* a1 = cA + (size_t)(t + 1) * kstep;
            const char* a2 = last ? nA : cA + (size_t)(t + 2) * kstep; const char* b2 = last ? nB : cB + (size_t)(t + 2) * kstep;
            const char* a3 = a2 + kstep; const char* b3 = b2 + kstep;
            if (last && has_next) S.a_ready(nxt);
            if constexpr (SP2) {
            PG8_LDB(B0, 0, 0); PG8_LDB(B1, 0, 1); PG8_SCHED; PG8_LDA(At, 0, 0); PG8_STAGE(PG8_SA(1, 1), a1 + hstep, voffA);
            PG8_WAIT_V(8); PG8_WAIT_L(0); PG8_BAR; PG8_MMA(0, 0, At, B0); PG8_MMA(0, 1, At, B1); PG8_BAR; PG8_SCHED;
            PG8_LDA(At, 0, 1); PG8_STAGE(PG8_SB(0, 0), b2, voffB); PG8_STAGE(PG8_SB(0, 1), b2 + hstep, voffB); PG8_STAGE(PG8_SA(0, 0), a2, voffA);
            PG8_WAIT_V(8); PG8_WAIT_L(0); PG8_BAR; PG8_MMA(1, 0, At, B0); PG8_MMA(1, 1, At, B1); PG8_BAR; PG8_SCHED;
            PG8_LDB(B0, 1, 0); PG8_LDB(B1, 1, 1); PG8_SCHED; PG8_LDA(At, 1, 0); PG8_STAGE(PG8_SA(0, 1), a2 + hstep, voffA);
            PG8_WAIT_V(8); PG8_WAIT_L(0); PG8_BAR; PG8_MMA(0, 0, At, B0); PG8_MMA(0, 1, At, B1); PG8_BAR; PG8_SCHED;
            PG8_LDA(At, 1, 1); PG8_STAGE(PG8_SB(1, 0), b3, voffB); PG8_STAGE(PG8_SB(1, 1), b3 + hstep, voffB); PG8_STAGE(PG8_SA(1, 0), a3, voffA);
            PG8_WAIT_V(8); PG8_WAIT_L(0); PG8_BAR; PG8_MMA(1, 0, At, B0); PG8_MMA(1, 1, At, B1); PG8_BAR; PG8_SCHED;
            } else {
            PG8_LDB(B0, 0, 0); PG8_SCHED; PG8_LDA(At, 0, 0); PG8_STAGE(PG8_SA(1, 1), a1 + hstep, voffA);
            PG8_WAIT_L(8); PG8_BAR; PG8_WAIT_L(0); PG8_MMA(0, 0, At, B0); PG8_BAR; PG8_SCHED;
            PG8_LDB(B1, 0, 1); PG8_STAGE(PG8_SB(0, 0), b2, voffB);
            PG8_BAR; PG8_WAIT_L(0); PG8_MMA(0, 1, At, B1); PG8_BAR;
            PG8_LDA(At, 0, 1); PG8_STAGE(PG8_SA(0, 0), a2, voffA);
            PG8_BAR; PG8_WAIT_L(0); PG8_MMA(1, 0, At, B0); PG8_BAR; PG8_SCHED;
            PG8_STAGE(PG8_SB(0, 1), b2 + hstep, voffB);
            PG8_WAIT_V(6); PG8_BAR; PG8_MMA(1, 1, At, B1); PG8_BAR;
            PG8_LDB(B0, 1, 0); PG8_SCHED; PG8_LDA(At, 1, 0); PG8_STAGE(PG8_SA(0, 1), a2 + hstep, voffA);
            PG8_WAIT_L(8); PG8_BAR; PG8_WAIT_L(0); PG8_MMA(0, 0, At, B0); PG8_BAR; PG8_SCHED;
            PG8_LDB(B1, 1, 1); PG8_STAGE(PG8_SB(1, 0), b3, voffB);
            PG8_BAR; PG8_WAIT_L(0); PG8_MMA(0, 1, At, B1); PG8_BAR;
            PG8_LDA(At, 1, 1); PG8_STAGE(PG8_SA(1, 0), a3, voffA);
            PG8_BAR; PG8_WAIT_L(0); PG8_MMA(1, 0, At, B0); PG8_BAR; PG8_SCHED;
            PG8_STAGE(PG8_SB(1, 1), b3 + hstep, voffB);
            PG8_WAIT_V(6); PG8_BAR; PG8_MMA(1, 1, At, B1); PG8_BAR;
            }
        }
        if constexpr (ALIGN_EPI) { if (wr == 0) PG8_BAR; }
        if constexpr (!Epi::AFTER_DRAIN) { E(acc, cur, wr, wc, fr, fq);
#if defined(REP_EPI) && REP_EPI == 2
            E(acc, cur, wr, wc, fr, fq);
#endif
            S.done(cur); }
        if (!has_next) break;
#pragma unroll
        for (int a = 0; a < 2; ++a)
#pragma unroll
            for (int b = 0; b < 2; ++b)
#pragma unroll
                for (int m = 0; m < 4; ++m)
#pragma unroll
                    for (int n = 0; n < 2; ++n) acc[a][b][m][n] = (f32x4){0.f, 0.f, 0.f, 0.f};
        cur = nxt; cA = nA; cB = nB; ++ui;
        if constexpr (ALIGN_EPI) { if (wr == 1) PG8_BAR; }
    }
    PG8_WAIT_V(0);
    if constexpr (!ALIGN_EPI) { if (wr == 0) PG8_BAR; }
    PG8_BAR;
    if constexpr (Epi::AFTER_DRAIN) { E.fused(acc, cur, wr, wc, fr, fq, lds, wid, lane); S.done(cur); }
#undef PG8_SA
#undef PG8_SB
#undef PG8_STAGE
#undef PG8_LDA
#undef PG8_LDB
#undef PG8_MMA
#undef PG8_WAIT_V
#undef PG8_WAIT_L
#undef PG8_BAR
#undef PG8_SCHED
}
}
constexpr int NWAVES = 8, NTHR = 512;
constexpr int BATCH = 4, SEQ = 4096, D = 1024, M = BATCH * SEQ, FF = 4096, DEPTH = 4;
constexpr int INP = 6672, INP_PAD = 6912;
constexpr float EPS = 1e-6f;
enum { I_X = 0, I_PRE_MIX, I_POST_MIX, I_PRE_MLP, I_POST_MLP, I_W_IN, I_CONV_W, I_CONV_B, I_DT_BIAS, I_A_LOG, I_D_SSD, I_SSD_NORM, I_W_OUT,
       I_LAM_RE, I_LAM_IM, I_LOG_STEP, I_B_RE, I_B_IM, I_C_RE, I_C_IM, I_D_S5, I_W_GLU_A, I_W_GLU_B, I_W_UP, I_W_DOWN, N_IN };
constexpr size_t MiB = 1u << 20;
constexpr size_t WS_CTL = 0, CTL_ZERO_BYTES = 64 * 1024;
constexpr size_t WS_MISC = 512 * 1024;
constexpr size_t WS_ROPE = 1 * MiB;
constexpr size_t WS_W4 = 5 * MiB;
constexpr size_t WS_SLOT16 = 9 * MiB;
constexpr size_t WS_SLOT32 = 25 * MiB;
constexpr size_t WS_QKV = 57 * MiB;
constexpr size_t WS_GZ = 153 * MiB;
constexpr size_t WS_XBC = 217 * MiB;
constexpr size_t WS_DT = 265 * MiB;
constexpr size_t WS_END = 266 * MiB;
constexpr size_t WS_M32A = 57 * MiB;
constexpr size_t WS_M32B = 185 * MiB;
constexpr size_t WS_U = 57 * MiB;
constexpr size_t WS_S5MAT = 57 * MiB;
constexpr size_t WS_S5E = 73 * MiB;
constexpr size_t WS_S5X = 105 * MiB;
constexpr size_t WS_Y = 121 * MiB;
constexpr int SCR_BYTES = 143360;
constexpr int MISC_OFF = SCR_BYTES;
constexpr int LDS_BYTES = 147456;

#define GAS __attribute__((address_space(1)))
#define LAS __attribute__((address_space(3)))
#define DI __device__ __forceinline__
typedef unsigned short bf16;
typedef unsigned v4u __attribute__((ext_vector_type(4)));
typedef unsigned v2u __attribute__((ext_vector_type(2)));
typedef float f32x4 __attribute__((ext_vector_type(4)));
typedef float f32x2v __attribute__((ext_vector_type(2)));
typedef short bf16x8 __attribute__((ext_vector_type(8)));
typedef short v4i16_t __attribute__((ext_vector_type(4)));
typedef GAS unsigned gu32;
#define RLX_AGENT __ATOMIC_RELAXED, __HIP_MEMORY_SCOPE_AGENT
#define LDS_WAIT() asm volatile("s_waitcnt lgkmcnt(0)" ::: "memory")
#define VM_WAIT() asm volatile("s_waitcnt vmcnt(0)" ::: "memory")
DI unsigned f2bf(float f) { unsigned u = __builtin_bit_cast(unsigned, f); return (u + 0x7fffu + ((u >> 16) & 1u)) >> 16; }
typedef __bf16 bf2_t __attribute__((ext_vector_type(2)));
DI unsigned pk2(float lo, float hi) { const f32x2v v = {lo, hi}; return __builtin_bit_cast(unsigned, __builtin_convertvector(v, bf2_t)); }
DI float bf2f(unsigned short b) { return __builtin_bit_cast(float, ((unsigned)b) << 16); }
DI float bflo(unsigned w) { return __builtin_bit_cast(float, w << 16); }
DI float bfhi(unsigned w) { return __builtin_bit_cast(float, w & 0xffff0000u); }
DI float wave_sum(float v) {
#pragma unroll
    for (int o = 1; o < 64; o <<= 1) v += __shfl_xor(v, o);
    return v;
}
DI float silu_f(float x) { return x * __builtin_amdgcn_rcpf(1.0f + __expf(-x)); }
DI void sincos_d(double x, double& s, double& c) {
    const double k = rint(x * 0.15915494309189533576888376337251);
    const double r = fma(-k, 6.283185307179586476925286766559, x), r2 = r * r;
    double ps = 1.0 / 1.0888869450418352e28, pc = 1.0 / 3.0488834461171384e29;
    const double fs[13] = {1.0 / 1.5511210043330986e25, 1.0 / 2.5852016738884978e22, 1.0 / 5.109094217170944e19, 1.0 / 1.21645100408832e17, 1.0 / 355687428096000.0, 1.0 / 1307674368000.0,
                           1.0 / 6227020800.0, 1.0 / 39916800.0, 1.0 / 362880.0, 1.0 / 5040.0, 1.0 / 120.0, 1.0 / 6.0, 1.0};
    const double fc[14] = {1.0 / 4.0329146112660565e26, 1.0 / 6.204484017332394e23, 1.0 / 1.1240007277776077e21, 1.0 / 2.43290200817664e18, 1.0 / 6402373705728000.0, 1.0 / 20922789888000.0,
                           1.0 / 87178291200.0, 1.0 / 479001600.0, 1.0 / 3628800.0, 1.0 / 40320.0, 1.0 / 720.0, 1.0 / 24.0, 1.0 / 2.0, 1.0};
#pragma unroll
    for (int i = 0; i < 13; ++i) ps = fs[i] - ps * r2;
#pragma unroll
    for (int i = 0; i < 14; ++i) pc = fc[i] - pc * r2;
    s = ps * r; c = pc;
}
#define XB_TMO      128
#define XB_XCNT(j)  (256  + 64 * (j))
#define XB_XSUB(j)  (1280 + 64 * (j))
#define XB_XGEN(j)  (2304 + 64 * (j))
#define XB_TOP      3328
#define XB_TOPGEN   3392
#define XCD_BAR_WORDS 3456
#define XB_SPIN_CAP (1u << 18)

__device__ __forceinline__ unsigned xb_ld(unsigned* p)              { return __hip_atomic_load(p, __ATOMIC_RELAXED, __HIP_MEMORY_SCOPE_AGENT); }
__device__ __forceinline__ unsigned xb_add(unsigned* p, unsigned v) { return __hip_atomic_fetch_add(p, v, __ATOMIC_RELAXED, __HIP_MEMORY_SCOPE_AGENT); }
__device__ __forceinline__ unsigned xb_xcc_id() { return (unsigned)__builtin_amdgcn_s_getreg((3 << 11) | 20) & 0xFu; }
#define XB_SPIN(cond, bar) do { unsigned _sp = 0; while (cond) { __builtin_amdgcn_s_sleep(1); \
    if ((++_sp & 255u) == 0u) { if (xb_ld(&(bar)[XB_TMO])) break; if (_sp > XB_SPIN_CAP) { atomicAdd(&(bar)[XB_TMO], 1u); break; } } } } while (0)

struct XcdBarrier {
    unsigned* bar; unsigned x; int tid;
    volatile LAS unsigned* st;
};

__device__ __forceinline__ XcdBarrier xcd_barrier_post(unsigned* bar, volatile LAS unsigned* st) {
    XcdBarrier b; b.bar = bar; b.x = xb_xcc_id(); b.st = st;
    if (threadIdx.x == 0) (void)xb_add(&bar[XB_XCNT(b.x)], 1u);
    return b;
}
__device__ __forceinline__ void xcd_barrier_complete(unsigned* bar, unsigned x, unsigned& nloc, unsigned& nx) {
    const unsigned G = gridDim.x * gridDim.y * gridDim.z;
    unsigned sum, cnt, mine, sp = 0u;
    for (;;) {
        sum = 0u; cnt = 0u; mine = 0u;
#pragma unroll
        for (unsigned j = 0; j < 16; ++j) { const unsigned c = xb_ld(&bar[XB_XCNT(j)]); sum += c; cnt += (c > 0u) ? 1u : 0u; mine = (j == x) ? c : mine; }
        if (sum == G) break;
        __builtin_amdgcn_s_sleep(1);
        if ((++sp & 255u) == 0u) { if (xb_ld(&bar[XB_TMO])) break; if (sp > XB_SPIN_CAP) { atomicAdd(&bar[XB_TMO], 1u); break; } }
    }
    nloc = mine > 0u ? mine : 1u; nx = cnt > 0u ? cnt : 1u;
}

__device__ __forceinline__ void xcd_barrier(const XcdBarrier& b) {
    asm volatile("s_waitcnt vmcnt(0)" ::: "memory");
    __syncthreads();
    if (b.tid == 0) {
        unsigned* bar = b.bar;
        __builtin_amdgcn_s_waitcnt(0);
        unsigned nloc = b.st[0], nx = b.st[1];
        if (nloc == 0u) { xcd_barrier_complete(bar, b.x, nloc, nx); b.st[0] = nloc; b.st[1] = nx; }
        const unsigned old = xb_add(&bar[XB_XSUB(b.x)], 1u);
        const unsigned gen = old / nloc;
        if (old + 1u == (gen + 1u) * nloc) {
            __builtin_amdgcn_fence(__ATOMIC_RELEASE, "agent");
            asm volatile("s_waitcnt vmcnt(0)" ::: "memory");
            const unsigned og = xb_add(&bar[XB_TOP], 1u);
            const unsigned tg = og / nx;
            if (og + 1u == (tg + 1u) * nx) xb_add(&bar[XB_TOPGEN], 1u);
            else XB_SPIN(xb_ld(&bar[XB_TOPGEN]) == tg, bar);
            __builtin_amdgcn_fence(__ATOMIC_ACQUIRE, "agent");
            xb_add(&bar[XB_XGEN(b.x)], 1u);
            asm volatile("s_waitcnt vmcnt(0)" ::: "memory");
        } else {
            XB_SPIN(xb_ld(&bar[XB_XGEN(b.x)]) == gen, bar);
            __builtin_amdgcn_fence(__ATOMIC_ACQUIRE, "agent");
            asm volatile("s_waitcnt vmcnt(0)" ::: "memory");
        }
    }
    __syncthreads();
}

struct Frame {
    LAS unsigned char* lds;
    int tid, lane, wave, G, bid, vcu;
    float* out; unsigned char* ws;
};
DI unsigned long long lds_ptr(const Frame& F, int i) {
    unsigned a_ = (unsigned)(size_t)(F.lds + MISC_OFF + 256) + 8u * (unsigned)i; asm volatile("" : "+v"(a_));
    const unsigned long long v = *(const volatile LAS unsigned long long*)a_;
    const unsigned lo = __builtin_amdgcn_readfirstlane((unsigned)v), hi = __builtin_amdgcn_readfirstlane((unsigned)(v >> 32));
    return ((unsigned long long)hi << 32) | lo;
}
#define INP(i) ((const float*)(const GAS float*)lds_ptr(F, (i)))
DI int gwave(const Frame& F) { return F.bid * NWAVES + F.wave; }

DI bf16x8 frag_rm(const LAS unsigned char* t, int S, int r0, int k0, int lane) { return *(const LAS bf16x8*)(t + (r0 + (lane & 15)) * S + (k0 + 8 * (lane >> 4)) * 2); }
DI bf16x8 frag_tr(const LAS unsigned char* t, int S, int r0, int k0, int lane) {
    const int g = lane >> 4, q = (lane & 15) >> 2, p = lane & 3;
    const LAS unsigned char* a = t + (k0 + 8 * g + q) * S + (r0 + 4 * p) * 2;
    const v4i16_t lo = __builtin_amdgcn_ds_read_tr16_b64_v4i16((LAS v4i16_t*)a);
    const v4i16_t hi = __builtin_amdgcn_ds_read_tr16_b64_v4i16((LAS v4i16_t*)(a + 4 * S));
    return __builtin_shufflevector(lo, hi, 0, 1, 2, 3, 4, 5, 6, 7);
}
DI f32x4 mma(bf16x8 a, bf16x8 b, f32x4 c) { return __builtin_amdgcn_mfma_f32_16x16x32_bf16(a, b, c, 0, 0, 0); }

DI void load_tile(LAS unsigned char* dst, int S, const bf16* src, size_t ld, int rows, int cols, int tid) {
    const int cpr = cols >> 3, n = rows * cpr;
    for (int i = tid; i < n; i += NTHR) { const int r = i / cpr, c = i - r * cpr;
        *(LAS v4u*)(dst + r * S + c * 16) = *(const v4u*)(src + (size_t)r * ld + c * 8); }
}

template <int COLS> DI unsigned tile_loff(int tid, unsigned ld) { constexpr int CPR = COLS / 8; return (unsigned)(tid / CPR) * ld + (unsigned)(tid % CPR) * 8u; }
template <int ROWS, int COLS> DI void tile_issue(v4u* r, const bf16* src, unsigned ld, unsigned loff) {
    constexpr int CPR = COLS / 8, N = ROWS * COLS / 4096, RSTEP = NTHR / CPR;
#pragma unroll
    for (int i = 0; i < N; ++i) r[i] = *(const v4u*)((src + (size_t)i * RSTEP * ld) + loff);
}
template <int ROWS, int COLS> DI void tile_commit(const v4u* r, LAS unsigned char* dst, int S, int tid) {
    constexpr int CPR = COLS / 8, N = ROWS * COLS / 4096, RSTEP = NTHR / CPR;
    LAS unsigned char* p = dst + (tid / CPR) * S + (tid % CPR) * 16;
#pragma unroll
    for (int i = 0; i < N; ++i) *(LAS v4u*)(p + i * RSTEP * S) = r[i];
}

DI void transpose_item(const float* W, int K, int N, bf16* WT, int mode, LAS float* scr, int item, int lane) {
    const int nblk = (N + 31) / 32, kb = item / nblk, nb = item % nblk, k0 = 64 * kb, n0 = 32 * nb;
    const int n4 = 4 * (lane & 7), nl = n0 + n4;
    f32x4 v[8];
#pragma unroll
    for (int i = 0; i < 8; ++i) v[i] = nl < N ? *(const f32x4*)(W + (size_t)(k0 + 8 * i + (lane >> 3)) * N + nl) : (f32x4){0.f, 0.f, 0.f, 0.f};
#pragma unroll
    for (int i = 0; i < 8; ++i) { LAS float* d = scr + (8 * i + (lane >> 3)) * 33 + n4; d[0] = v[i][0]; d[1] = v[i][1]; d[2] = v[i][2]; d[3] = v[i][3]; }
    LDS_WAIT(); asm volatile("" ::: "memory");
    const int c = lane & 7;
#pragma unroll
    for (int j = 0; j < 4; ++j) { const int n = (lane >> 3) + 8 * j; const LAS float* s = scr + (8 * c) * 33 + n;
        v4u o; o.x = pk2(s[0 * 33], s[1 * 33]); o.y = pk2(s[2 * 33], s[3 * 33]); o.z = pk2(s[4 * 33], s[5 * 33]); o.w = pk2(s[6 * 33], s[7 * 33]);
        const int ng = n0 + n; const int row = mode == 0 ? ng : (256 * (ng >> 7) + (ng & 127) + (mode == 2 ? 128 : 0));
        *(v4u*)(WT + (size_t)row * K + k0 + 8 * c) = o; }
    LDS_WAIT(); asm volatile("" ::: "memory");
}
DI void convert_weight(Frame& F, const float* W, int K, int N, bf16* WT, int mode, int w0 = 0) {
    if (F.wave < w0) return;
    LAS float* scr = (LAS float*)(F.lds + F.wave * 16384);
    const int nw = NWAVES - w0, nitems = (K / 64) * ((N + 31) / 32), NGW = F.G * nw;
    for (int it = F.bid * nw + (F.wave - w0); it < nitems; it += NGW) transpose_item(W, K, N, WT, mode, scr, it, F.lane);
}
DI void zero_fill(Frame& F, void* p, size_t bytes) {
    v4u* q = (v4u*)p; const size_t n = bytes / 16;
    for (size_t i = (size_t)F.bid * NTHR + F.tid; i < n; i += (size_t)F.G * NTHR) q[i] = (v4u){0u, 0u, 0u, 0u};
}

DI void build_rope(Frame& F) {
    float* rope = (float*)(F.ws + WS_ROPE);
    for (int i = F.bid * NTHR + F.tid; i < 4096 * 128; i += F.G * NTHR) { const int pos = i >> 7, d = i & 127;
        double inv = 1.0; { double r = 0.930572040929699; int e = d; while (e) { if (e & 1) inv *= r; r *= r; e >>= 1; } }
        const float ang = (float)pos * (float)inv;
        double s, c; sincos_d((double)ang, s, c);
        *(f32x2v*)(rope + 2 * (size_t)i) = (f32x2v){(float)c, (float)s}; }
}
DI void rms_rows_to_bf16(Frame& F, const float* src, const float* w, bf16* dst) {
    const int NGW = F.G * NWAVES;
    f32x4 wv[4];
#pragma unroll
    for (int j = 0; j < 4; ++j) wv[j] = ((const f32x4*)w)[F.lane + 64 * j];
    for (int m = gwave(F); m < M; m += NGW) { const f32x4* xr = (const f32x4*)(src + (size_t)m * D) + F.lane;
        f32x4 v[4]; float s = 0.f;
#pragma unroll
        for (int j = 0; j < 4; ++j) { v[j] = xr[64 * j]; s += (v[j].x * v[j].x + v[j].y * v[j].y) + (v[j].z * v[j].z + v[j].w * v[j].w); }
        const float rs = rsqrtf(wave_sum(s) * (1.f / D) + EPS);
        v2u* o8 = (v2u*)(dst + (size_t)m * D) + F.lane;
#pragma unroll
        for (int j = 0; j < 4; ++j) { const f32x4 y = v[j] * rs * wv[j]; o8[64 * j] = (v2u){pk2(y.x, y.y), pk2(y.z, y.w)}; } }
}
template <bool IN_F32, bool OUT_F32>
DI void row_phase(Frame& F, const bf16* mbuf, const void* hbase, void* hout, const float* w_post, const float* w_pre, bf16* hn) {
    const int NGW = F.G * NWAVES;
    f32x4 wp[4], wq[4];
#pragma unroll
    for (int j = 0; j < 4; ++j) { wp[j] = ((const f32x4*)w_post)[F.lane + 64 * j]; wq[j] = w_pre ? ((const f32x4*)w_pre)[F.lane + 64 * j] : (f32x4){0.f, 0.f, 0.f, 0.f}; }
    for (int m = gwave(F); m < M; m += NGW) {
        const v2u* mr = (const v2u*)(mbuf + (size_t)m * D) + F.lane;
        f32x4 v[4], h[4]; float s = 0.f;
#pragma unroll
        for (int j = 0; j < 4; ++j) { const v2u mv = mr[64 * j]; v[j] = (f32x4){bflo(mv.x), bfhi(mv.x), bflo(mv.y), bfhi(mv.y)};
            if (IN_F32) h[j] = ((const f32x4*)((const float*)hbase + (size_t)m * D) + F.lane)[64 * j];
            else { const v2u hv = ((const v2u*)((const bf16*)hbase + (size_t)m * 2048) + F.lane)[64 * j]; h[j] = (f32x4){bflo(hv.x), bfhi(hv.x), bflo(hv.y), bfhi(hv.y)}; }
            s += (v[j].x * v[j].x + v[j].y * v[j].y) + (v[j].z * v[j].z + v[j].w * v[j].w); }
        const float rs = rsqrtf(wave_sum(s) * (1.f / D) + EPS); float s2 = 0.f;
#pragma unroll
        for (int j = 0; j < 4; ++j) { h[j] = h[j] + v[j] * rs * wp[j]; s2 += (h[j].x * h[j].x + h[j].y * h[j].y) + (h[j].z * h[j].z + h[j].w * h[j].w); }
        if (OUT_F32) { f32x4* ho = (f32x4*)((float*)hout + (size_t)m * D) + F.lane;
#pragma unroll
            for (int j = 0; j < 4; ++j) ho[64 * j] = h[j]; }
        else { v2u* ho = (v2u*)((bf16*)hout + (size_t)m * 2048) + F.lane;
#pragma unroll
            for (int j = 0; j < 4; ++j) ho[64 * j] = (v2u){pk2(h[j].x, h[j].y), pk2(h[j].z, h[j].w)}; }
        if (hn) { const float rs2 = rsqrtf(wave_sum(s2) * (1.f / D) + EPS);
            v2u* o8 = (v2u*)(hn + (size_t)m * D) + F.lane;
#pragma unroll
            for (int j = 0; j < 4; ++j) { const f32x4 y = h[j] * rs2 * wq[j]; o8[64 * j] = (v2u){pk2(y.x, y.y), pk2(y.z, y.w)}; } }
    }
}

DI float head_lg2(int h) { return __log2f(1.0f - exp2f(-5.0f - (float)h)); }

DI void ret_passA_unit(Frame& F, int unit) {
    const bf16* QKV = (const bf16*)(F.ws + WS_QKV); bf16* RST = (bf16*)(F.ws + WS_SLOT16);
    const int eh = unit & 1, sc = (unit >> 1) & 7, h = (unit >> 4) & 3, b = unit >> 6;
    const int lane = F.lane, w = F.wave, we = w >> 2, wd = w & 3;
    const float lg2 = head_lg2(h), g128 = exp2f(128.f * lg2), g127 = exp2f(127.f * lg2);
    LAS unsigned char* Kt = F.lds;
    LAS unsigned char* Vt = F.lds + 128 * 544;
    f32x4 acc[4][4];
#pragma unroll
    for (int a = 0; a < 4; ++a)
#pragma unroll
        for (int c = 0; c < 4; ++c) acc[a][c] = (f32x4){0.f, 0.f, 0.f, 0.f};
    v4u TK[8], TV[4];
    const unsigned lo_k = tile_loff<256>(F.tid, 3072), lo_v = tile_loff<128>(F.tid, 3072);
    const bf16* kbase = QKV + ((size_t)b * SEQ + sc * 512) * 3072 + 1024 + h * 256; const bf16* vbase = kbase + 1024 + eh * 128;
    tile_issue<128, 256>(TK, kbase, 3072, lo_k); tile_issue<128, 128>(TV, vbase, 3072, lo_v);
#pragma unroll 1
    for (int j = 0; j < 4; ++j) {
        if (j) {
#pragma unroll
            for (int a = 0; a < 4; ++a)
#pragma unroll
                for (int c = 0; c < 4; ++c) acc[a][c] *= g128; }
        __syncthreads();
        tile_commit<128, 256>(TK, Kt, 544, F.tid); tile_commit<128, 128>(TV, Vt, 288, F.tid);
        if (j < 3) { tile_issue<128, 256>(TK, kbase + (size_t)(j + 1) * 128 * 3072, 3072, lo_k); tile_issue<128, 128>(TV, vbase + (size_t)(j + 1) * 128 * 3072, 3072, lo_v); }
        __syncthreads();
#pragma unroll
        for (int ks = 0; ks < 4; ++ks) {
            bf16x8 vf[4], kf[4];
#pragma unroll
            for (int t = 0; t < 4; ++t) { vf[t] = frag_tr(Vt, 288, we * 64 + t * 16, ks * 32, lane); kf[t] = frag_tr(Kt, 544, wd * 64 + t * 16, ks * 32, lane); }
#pragma unroll
            for (int et = 0; et < 4; ++et)
#pragma unroll
                for (int dt = 0; dt < 4; ++dt) acc[et][dt] = mma(kf[dt], vf[et], acc[et][dt]);
        }
    }
    bf16* dst = RST + ((size_t)((b * 4 + h) * 8 + sc) * 256) * 256;
#pragma unroll
    for (int et = 0; et < 4; ++et)
#pragma unroll
        for (int dt = 0; dt < 4; ++dt) { const int e = eh * 128 + we * 64 + et * 16 + (lane & 15), d = wd * 64 + dt * 16 + 4 * (lane >> 4);
            const f32x4 v = acc[et][dt] * g127;
            *(v2u*)(dst + (size_t)e * 256 + d) = (v2u){pk2(v[0], v[1]), pk2(v[2], v[3])}; }
}

DI void ret_scan_item(Frame& F, int item) {
    bf16* RST = (bf16*)(F.ws + WS_SLOT16);
    const int bh = item >> 13, off = (item & 8191) * 8, h = bh & 3;
    const float g512 = exp2f(512.f * head_lg2(h));
    float run[8]; float zf = 0.f; asm volatile("" : "+v"(zf));
#pragma unroll
    for (int k = 0; k < 8; ++k) run[k] = zf;
    v4u* base = (v4u*)(RST + (size_t)(bh * 8) * 65536 + off);
    v4u in[8];
#pragma unroll
    for (int sc = 0; sc < 8; ++sc) in[sc] = base[(size_t)sc * 8192];
#pragma unroll
    for (int sc = 0; sc < 8; ++sc) {
        v4u o; o.x = pk2(run[0], run[1]); o.y = pk2(run[2], run[3]); o.z = pk2(run[4], run[5]); o.w = pk2(run[6], run[7]);
        base[(size_t)sc * 8192] = o;
        const unsigned cw[4] = {in[sc].x, in[sc].y, in[sc].z, in[sc].w};
#pragma unroll
        for (int k = 0; k < 4; ++k) { run[2 * k] = g512 * run[2 * k] + bflo(cw[k]); run[2 * k + 1] = g512 * run[2 * k + 1] + bfhi(cw[k]); }
    }
}

DI void ret_passC_unit(Frame& F, int unit, bf16* YO) {
    const bf16* QKV = (const bf16*)(F.ws + WS_QKV); const bf16* RST = (const bf16*)(F.ws + WS_SLOT16); const bf16* GZ = (const bf16*)(F.ws + WS_GZ);
    const int qp = unit & 1, sc = (unit >> 1) & 7, h = (unit >> 4) & 3, b = unit >> 6;
    const int lane = F.lane, w = F.wave, wn = w >> 2, we = w & 3, wm = w & 3;
    const float lg2 = head_lg2(h), g1 = exp2f(lg2), g128 = exp2f(128.f * lg2);
    LAS unsigned char* Qt = F.lds;
    LAS unsigned char* KV = F.lds + 33792;
    LAS unsigned char* Pt = F.lds + 33792 + 69632;
    LAS float* red = (LAS float*)(F.lds + 33792 + 69632 + 17408);
    const size_t rowsc = (size_t)b * SEQ + sc * 512;
    const bf16* Rbase = RST + (size_t)((b * 4 + h) * 8 + sc) * 65536;
    v4u T[8], TQ[4];
    const unsigned lo_kv = tile_loff<256>(F.tid, 3072), lo_r = tile_loff<64>(F.tid, 256);
    tile_issue<64, 256>(TQ, QKV + (rowsc + (qp == 0 ? 0 : 1) * 128) * 3072 + h * 256, 3072, lo_kv);
    tile_issue<256, 64>(T, Rbase, 256, lo_r);
#pragma unroll 1
    for (int qi = 0; qi < 2; ++qi) {
        const int i = qp == 0 ? (qi == 0 ? 0 : 3) : (qi == 0 ? 1 : 2);
#pragma unroll 1
        for (int hh = 0; hh < 2; ++hh) {
            const size_t grow0 = rowsc + i * 128 + hh * 64;
            f32x4 Y[2][4];
#pragma unroll
            for (int a = 0; a < 2; ++a)
#pragma unroll
                for (int c = 0; c < 4; ++c) Y[a][c] = (f32x4){0.f, 0.f, 0.f, 0.f};
            __syncthreads();
            tile_commit<64, 256>(TQ, Qt, 528, F.tid);
#pragma unroll 1
            for (int ds = 0; ds < 4; ++ds) {
                if (ds) __syncthreads();
                tile_commit<256, 64>(T, KV, 144, F.tid);
                if (ds < 3) tile_issue<256, 64>(T, Rbase + (ds + 1) * 64, 256, lo_r);
                else tile_issue<128, 256>(T, QKV + rowsc * 3072 + 1024 + h * 256, 3072, lo_kv);
                __syncthreads();
#pragma unroll
                for (int ks = 0; ks < 2; ++ks) {
                    bf16x8 qf[2], rf[4];
#pragma unroll
                    for (int t = 0; t < 2; ++t) qf[t] = frag_rm(Qt, 528, wn * 32 + t * 16, ds * 64 + ks * 32, lane);
#pragma unroll
                    for (int t = 0; t < 4; ++t) rf[t] = frag_rm(KV, 144, we * 64 + t * 16, ks * 32, lane);
#pragma unroll
                    for (int nt = 0; nt < 2; ++nt)
#pragma unroll
                        for (int et = 0; et < 4; ++et) Y[nt][et] = mma(rf[et], qf[nt], Y[nt][et]);
                }
            }
#pragma unroll
            for (int a = 0; a < 2; ++a)
#pragma unroll
                for (int c = 0; c < 4; ++c) Y[a][c] *= g1;
#pragma unroll 1
            for (int j = 0; j <= i; ++j) {
                if (j) {
#pragma unroll
                    for (int a = 0; a < 2; ++a)
#pragma unroll
                        for (int c = 0; c < 4; ++c) Y[a][c] *= g128; }
                const size_t rowj = rowsc + j * 128;
                __syncthreads();
                tile_commit<128, 256>(T, KV, 528, F.tid);
                tile_issue<128, 256>(T, QKV + rowj * 3072 + 2048 + h * 256, 3072, lo_kv);
                __syncthreads();
                f32x4 sa[2][2];
#pragma unroll
                for (int a = 0; a < 2; ++a)
#pragma unroll
                    for (int c = 0; c < 2; ++c) sa[a][c] = (f32x4){0.f, 0.f, 0.f, 0.f};
#pragma unroll
                for (int ks = 0; ks < 8; ++ks) {
                    bf16x8 qf[2], kf[2];
#pragma unroll
                    for (int t = 0; t < 2; ++t) { qf[t] = frag_rm(Qt, 528, wn * 32 + t * 16, ks * 32, lane); kf[t] = frag_rm(KV, 528, wm * 32 + t * 16, ks * 32, lane); }
#pragma unroll
                    for (int nt = 0; nt < 2; ++nt)
#pragma unroll
                        for (int mt = 0; mt < 2; ++mt) sa[nt][mt] = mma(kf[mt], qf[nt], sa[nt][mt]);
                }
#pragma unroll
                for (int nt = 0; nt < 2; ++nt)
#pragma unroll
                    for (int mt = 0; mt < 2; ++mt) { const int n = wn * 32 + nt * 16 + (lane & 15), m = wm * 32 + mt * 16 + 4 * (lane >> 4);
                        f32x4 s = sa[nt][mt];
                        if (j == i) { const int nb = hh * 64 + n;
#pragma unroll
                            for (int jj = 0; jj < 4; ++jj) if (m + jj > nb) s[jj] = 0.f; }
                        *(LAS v2u*)(Pt + n * 272 + m * 2) = (v2u){pk2(s[0], s[1]), pk2(s[2], s[3])}; }
                __syncthreads();
                tile_commit<128, 256>(T, KV, 544, F.tid);
                if (j < i) tile_issue<128, 256>(T, QKV + (rowj + 128) * 3072 + 1024 + h * 256, 3072, lo_kv);
                else { const bool more = !(qi == 1 && hh == 1);
                    const int i2 = hh == 0 ? i : (qp == 0 ? 3 : 2), hh2 = hh ^ 1;
                    if (more) { tile_issue<64, 256>(TQ, QKV + (rowsc + i2 * 128 + hh2 * 64) * 3072 + h * 256, 3072, lo_kv); tile_issue<256, 64>(T, Rbase, 256, lo_r); } }
                __syncthreads();
#pragma unroll
                for (int ks = 0; ks < 4; ++ks) {
                    bf16x8 pf[2], vf[4];
#pragma unroll
                    for (int t = 0; t < 2; ++t) pf[t] = frag_rm(Pt, 272, wn * 32 + t * 16, ks * 32, lane);
#pragma unroll
                    for (int t = 0; t < 4; ++t) vf[t] = frag_tr(KV, 544, we * 64 + t * 16, ks * 32, lane);
#pragma unroll
                    for (int nt = 0; nt < 2; ++nt)
#pragma unroll
                        for (int et = 0; et < 4; ++et) Y[nt][et] = mma(vf[et], pf[nt], Y[nt][et]);
                }
            }
            float mean[2], rstd[2];
#pragma unroll
            for (int nt = 0; nt < 2; ++nt) { float s = 0.f;
#pragma unroll
                for (int et = 0; et < 4; ++et) s += (Y[nt][et][0] + Y[nt][et][1]) + (Y[nt][et][2] + Y[nt][et][3]);
                s += __shfl_xor(s, 16); s += __shfl_xor(s, 32);
                if ((lane >> 4) == 0) red[(wn * 32 + nt * 16 + lane) * 4 + we] = s; }
            __syncthreads();
#pragma unroll
            for (int nt = 0; nt < 2; ++nt) { const LAS float* r = red + (wn * 32 + nt * 16 + (lane & 15)) * 4; mean[nt] = ((r[0] + r[1]) + (r[2] + r[3])) * (1.f / 256.f); }
            __syncthreads();
#pragma unroll
            for (int nt = 0; nt < 2; ++nt) { float s = 0.f;
#pragma unroll
                for (int et = 0; et < 4; ++et) { const f32x4 dv = Y[nt][et] - mean[nt]; s += (dv[0] * dv[0] + dv[1] * dv[1]) + (dv[2] * dv[2] + dv[3] * dv[3]); }
                s += __shfl_xor(s, 16); s += __shfl_xor(s, 32);
                if ((lane >> 4) == 0) red[(wn * 32 + nt * 16 + lane) * 4 + we] = s; }
            __syncthreads();
#pragma unroll
            for (int nt = 0; nt < 2; ++nt) { const LAS float* r = red + (wn * 32 + nt * 16 + (lane & 15)) * 4; rstd[nt] = rsqrtf(((r[0] + r[1]) + (r[2] + r[3])) * (1.f / 256.f) + EPS); }
#pragma unroll
            for (int nt = 0; nt < 2; ++nt)
#pragma unroll
                for (int et = 0; et < 4; ++et) { const int n = wn * 32 + nt * 16 + (lane & 15), e = we * 64 + et * 16 + 4 * (lane >> 4);
                    const bf16* gp = GZ + (grow0 + n) * 2048 + h * 256 + e;
                    const v2u gv = *(const v2u*)gp;
                    const f32x4 y = (Y[nt][et] - mean[nt]) * rstd[nt];
                    const float o0 = y[0] * silu_f(bflo(gv.x)), o1 = y[1] * silu_f(bfhi(gv.x)), o2 = y[2] * silu_f(bflo(gv.y)), o3 = y[3] * silu_f(bfhi(gv.y));
                    *(v2u*)(YO + (gp - GZ)) = (v2u){pk2(o0, o1), pk2(o2, o3)}; }
        }
    }
}

struct SsdPar { const float* conv_w; const float* conv_b; const float* a_log; const float* d_ssd; const float* ssd_norm; };

struct ConvW { f32x4 w[4][2]; f32x4 b[2]; };
DI ConvW load_convw(const float* cw, const float* cb, int col) { ConvW W;
#pragma unroll
    for (int k = 0; k < 4; ++k) { W.w[k][0] = *(const f32x4*)(cw + k * 1536 + col); W.w[k][1] = *(const f32x4*)(cw + k * 1536 + col + 4); }
    W.b[0] = *(const f32x4*)(cb + col); W.b[1] = *(const f32x4*)(cb + col + 4); return W; }
DI void conv8(const bf16* XBC, const ConvW& W, size_t row, int col, float (&o)[8]) {
    const int tin = (int)(row & 4095);
    o[0] = W.b[0][0]; o[1] = W.b[0][1]; o[2] = W.b[0][2]; o[3] = W.b[0][3]; o[4] = W.b[1][0]; o[5] = W.b[1][1]; o[6] = W.b[1][2]; o[7] = W.b[1][3];
#pragma unroll
    for (int k = 0; k < 4; ++k) {
        if (tin - 3 + k >= 0) {
            const v4u x = *(const v4u*)(XBC + (row - 3 + k) * 1536 + col);
            const f32x4 w0 = W.w[k][0], w1 = W.w[k][1];
            o[0] += w0[0] * bflo(x.x); o[1] += w0[1] * bfhi(x.x); o[2] += w0[2] * bflo(x.y); o[3] += w0[3] * bfhi(x.y);
            o[4] += w1[0] * bflo(x.z); o[5] += w1[1] * bfhi(x.z); o[6] += w1[2] * bflo(x.w); o[7] += w1[3] * bfhi(x.w);
        }
    }
#pragma unroll
    for (int k = 0; k < 8; ++k) o[k] = silu_f(o[k]);
}
DI void conv8r(const v4u (&x)[4], const ConvW& W, int tin, float (&o)[8]) {
    o[0] = W.b[0][0]; o[1] = W.b[0][1]; o[2] = W.b[0][2]; o[3] = W.b[0][3]; o[4] = W.b[1][0]; o[5] = W.b[1][1]; o[6] = W.b[1][2]; o[7] = W.b[1][3];
#pragma unroll
    for (int k = 0; k < 4; ++k) {
        if (tin - 3 + k >= 0) { const f32x4 w0 = W.w[k][0], w1 = W.w[k][1];
            o[0] += w0[0] * bflo(x[k].x); o[1] += w0[1] * bfhi(x[k].x); o[2] += w0[2] * bflo(x[k].y); o[3] += w0[3] * bfhi(x[k].y);
            o[4] += w1[0] * bflo(x[k].z); o[5] += w1[1] * bfhi(x[k].z); o[6] += w1[2] * bflo(x[k].w); o[7] += w1[3] * bfhi(x[k].w); }
    }
#pragma unroll
    for (int k = 0; k < 8; ++k) o[k] = silu_f(o[k]);
}
template <int NR, class Fn> DI void conv_rows(const bf16* XBC, const ConvW& W, size_t row0, int col, Fn&& emit) {
    const int tin0 = (int)(row0 & 4095);
    v4u x[NR + 3];
#pragma unroll
    for (int i = 0; i < NR + 3; ++i) x[i] = (tin0 + i - 3 >= 0) ? *(const v4u*)(XBC + (row0 + i - 3) * 1536 + col) : (v4u){0u, 0u, 0u, 0u};
#pragma unroll
    for (int r = 0; r < NR; ++r) { float o[8];
        o[0] = W.b[0][0]; o[1] = W.b[0][1]; o[2] = W.b[0][2]; o[3] = W.b[0][3]; o[4] = W.b[1][0]; o[5] = W.b[1][1]; o[6] = W.b[1][2]; o[7] = W.b[1][3];
#pragma unroll
        for (int k = 0; k < 4; ++k) { const v4u xv = x[r + k]; const f32x4 w0 = W.w[k][0], w1 = W.w[k][1];
            o[0] += w0[0] * bflo(xv.x); o[1] += w0[1] * bfhi(xv.x); o[2] += w0[2] * bflo(xv.y); o[3] += w0[3] * bfhi(xv.y);
            o[4] += w1[0] * bflo(xv.z); o[5] += w1[1] * bfhi(xv.z); o[6] += w1[2] * bflo(xv.w); o[7] += w1[3] * bfhi(xv.w); }
#pragma unroll
        for (int k = 0; k < 8; ++k) o[k] = silu_f(o[k]);
        emit(r, o); }
}
DI v4u pack8(const float (&o)[8], float s) { v4u r; r.x = pk2(o[0] * s, o[1] * s); r.y = pk2(o[2] * s, o[3] * s); r.z = pk2(o[4] * s, o[5] * s); r.w = pk2(o[6] * s, o[7] * s); return r; }

DI float ssd_cumsum(const float* DT, const float* a_log, size_t t0, int grp, int w, int lane, LAS float* cs, LAS float* dtl = nullptr) {
    const int head = grp * 8 + w; const float A = -__expf(a_log[head]);
    const float d0 = DT[(t0 + 2 * lane) * 16 + head], d1 = DT[(t0 + 2 * lane + 1) * 16 + head], v0 = d0 * A, v1 = d1 * A;
    if (dtl) { dtl[w * 128 + 2 * lane] = d0; dtl[w * 128 + 2 * lane + 1] = d1; }
    float x = v0 + v1;
#pragma unroll
    for (int o = 1; o < 64; o <<= 1) { const float t = __shfl_up(x, o); if (lane >= o) x += t; }
    cs[w * 128 + 2 * lane] = x - v1; cs[w * 128 + 2 * lane + 1] = x;
    return __shfl(x, 63);
}

DI void ssd_passA_unit(Frame& F, const SsdPar& P, int unit) {
    const bf16* XBC = (const bf16*)(F.ws + WS_XBC); const float* DT = (const float*)(F.ws + WS_DT);
    bf16* ST = (bf16*)(F.ws + WS_SLOT32); float* CDEC = (float*)(F.ws + WS_MISC);
    const int grp = unit & 1, c = (unit >> 1) & 31, b = unit >> 6;
    const int lane = F.lane, w = F.wave;
    const size_t t0 = (size_t)b * SEQ + c * 128;
    LAS float* cs = (LAS float*)F.lds;
    LAS float* csend = (LAS float*)(F.lds + 4096);
    LAS unsigned char* Bt = F.lds + 4352;
    LAS unsigned char* Xw = F.lds + 4352 + 36864;
    __syncthreads();
    { const float tot = ssd_cumsum(DT, P.a_log, t0, grp, w, lane, cs);
      if (lane == 0) { csend[w] = tot; CDEC[(b * 32 + c) * 16 + grp * 8 + w] = __expf(tot); } }
    { const int cc = F.tid & 15, rb = F.tid >> 4; const ConvW W = load_convw(P.conv_w, P.conv_b, 1024 + grp * 128 + cc * 8);
      conv_rows<4>(XBC, W, t0 + 4 * rb, 1024 + grp * 128 + cc * 8, [&](int r, const float (&o)[8]) { *(LAS v4u*)(Bt + (4 * rb + r) * 288 + cc * 16) = pack8(o, 1.0f); }); }
    for (int hg = 0; hg < 2; ++hg) {
        __syncthreads();
        { const int cc = F.tid & 31, rb = F.tid >> 5, hd = hg * 4 + (cc >> 3); const ConvW W = load_convw(P.conv_w, P.conv_b, grp * 512 + hg * 256 + cc * 8);
          conv_rows<8>(XBC, W, t0 + 8 * rb, grp * 512 + hg * 256 + cc * 8, [&](int r, const float (&o)[8]) { const int rr = 8 * rb + r;
              const float sc = DT[(t0 + rr) * 16 + grp * 8 + hd] * __expf(csend[hd] - cs[hd * 128 + rr]);
              *(LAS v4u*)(Xw + rr * 544 + cc * 16) = pack8(o, sc); }); }
        __syncthreads();
        const int hl = w >> 1, nh = w & 1;
        f32x4 acc[4][4];
#pragma unroll
        for (int a = 0; a < 4; ++a)
#pragma unroll
            for (int q = 0; q < 4; ++q) acc[a][q] = (f32x4){0.f, 0.f, 0.f, 0.f};
#pragma unroll
        for (int ks = 0; ks < 4; ++ks) {
            bf16x8 xf[4], bfr[4];
#pragma unroll
            for (int t = 0; t < 4; ++t) { xf[t] = frag_tr(Xw, 544, hl * 64 + t * 16, ks * 32, lane); bfr[t] = frag_tr(Bt, 288, nh * 64 + t * 16, ks * 32, lane); }
#pragma unroll
            for (int pt = 0; pt < 4; ++pt)
#pragma unroll
                for (int nt = 0; nt < 4; ++nt) acc[pt][nt] = mma(bfr[nt], xf[pt], acc[pt][nt]);
        }
        const int head = grp * 8 + hg * 4 + hl;
        bf16* dst = ST + (size_t)((b * 32 + c) * 16 + head) * 8192;
#pragma unroll
        for (int pt = 0; pt < 4; ++pt)
#pragma unroll
            for (int nt = 0; nt < 4; ++nt) { const int p = pt * 16 + (lane & 15), n = nh * 64 + nt * 16 + 4 * (lane >> 4); const f32x4 v = acc[pt][nt];
                *(v2u*)(dst + p * 128 + n) = (v2u){pk2(v[0], v[1]), pk2(v[2], v[3])}; }
    }
}

DI void ssd_scan_item(Frame& F, int item) {
    bf16* ST = (bf16*)(F.ws + WS_SLOT32); const float* CDEC = (const float*)(F.ws + WS_MISC);
    const int bh = item >> 11, b = bh >> 4, head = bh & 15, off = (item & 2047) * 4;
    float run[4]; float zf = 0.f; asm volatile("" : "+v"(zf));
#pragma unroll
    for (int k = 0; k < 4; ++k) run[k] = zf;
    v2u* base = (v2u*)(ST + (size_t)((b * 32) * 16 + head) * 8192 + off);
    const float* dbase = CDEC + (b * 32) * 16 + head;
    v2u cur[8], nxt[8]; float dc[8], dn[8];
#pragma unroll
    for (int q = 0; q < 8; ++q) { cur[q] = base[(size_t)q * 32768]; dc[q] = dbase[q * 16]; }
#pragma unroll 1
    for (int cb = 0; cb < 4; ++cb) {
        const int cn = cb < 3 ? cb + 1 : cb;
#pragma unroll
        for (int q = 0; q < 8; ++q) { nxt[q] = base[(size_t)(cn * 8 + q) * 32768]; dn[q] = dbase[(cn * 8 + q) * 16]; }
#pragma unroll
        for (int q = 0; q < 8; ++q) {
            base[(size_t)(cb * 8 + q) * 32768] = (v2u){pk2(run[0], run[1]), pk2(run[2], run[3])};
            run[0] = dc[q] * run[0] + bflo(cur[q].x); run[1] = dc[q] * run[1] + bfhi(cur[q].x); run[2] = dc[q] * run[2] + bflo(cur[q].y); run[3] = dc[q] * run[3] + bfhi(cur[q].y); }
#pragma unroll
        for (int q = 0; q < 8; ++q) { cur[q] = nxt[q]; dc[q] = dn[q]; }
    }
}

DI void ssd_passC_unit(Frame& F, const SsdPar& P, int unit, bf16* YO) {
    const bf16* XBC = (const bf16*)(F.ws + WS_XBC); const float* DT = (const float*)(F.ws + WS_DT);
    const bf16* ST = (const bf16*)(F.ws + WS_SLOT32); const bf16* GZ = (const bf16*)(F.ws + WS_GZ);
    const int grp = unit & 1, c = (unit >> 1) & 31, b = unit >> 6;
    const int lane = F.lane, w = F.wave;
    const size_t t0 = (size_t)b * SEQ + c * 128;
    LAS float* cs = (LAS float*)F.lds;
    LAS float* dtl = (LAS float*)(F.lds + 4096);
    LAS unsigned char* Ct = F.lds + 8192;
    LAS unsigned char* BM = F.lds + 43008;
    LAS unsigned char* Xd = F.lds + 77824;
    LAS unsigned char* Pv = F.lds + 98304;
    LAS float* rowss = (LAS float*)(F.lds + 115712);
    LAS float* wtab = (LAS float*)(F.lds + 123904);
    __syncthreads();
    (void)ssd_cumsum(DT, P.a_log, t0, grp, w, lane, cs, dtl);
    for (int i = F.tid; i < 5 * 128; i += NTHR) { const int k = i >> 7, c4 = (i & 127) * 4;
        *(LAS f32x4*)(wtab + k * 512 + c4) = *(const f32x4*)((k < 4 ? P.conv_w + k * 1536 : P.conv_b) + grp * 512 + c4); }
#pragma unroll 1
    for (int which = 0; which < 2; ++which) {
        const int cc = F.tid & 15, rb = F.tid >> 4; const ConvW W = load_convw(P.conv_w, P.conv_b, 1024 + which * 256 + grp * 128 + cc * 8);
        LAS unsigned char* dstt = which ? Ct : BM;
        conv_rows<4>(XBC, W, t0 + 4 * rb, 1024 + which * 256 + grp * 128 + cc * 8, [&](int r, const float (&o)[8]) { *(LAS v4u*)(dstt + (4 * rb + r) * 272 + cc * 16) = pack8(o, 1.0f); }); }
    const int r0 = F.tid >> 3, cc8 = (F.tid & 7) * 8, tin0 = (int)((t0 + r0) & 4095);
    const int wl = w >> 1, ws = w & 1, wp = w & 1;
    v4u XR[2][4], PVr[2]; v2u ZN[2][2], ZC[2][2];
    const unsigned lo_p = tile_loff<128>(F.tid, 128);
#define SSD_ISSUE(hd_) do { const int hcol_ = grp * 512 + (hd_) * 64 + cc8; \
        _Pragma("unroll") for (int it_ = 0; it_ < 2; ++it_) _Pragma("unroll") for (int k_ = 0; k_ < 4; ++k_) \
            if (tin0 + 64 * it_ - 3 + k_ >= 0) XR[it_][k_] = *(const v4u*)(XBC + (t0 + r0 + 64 * it_ - 3 + k_) * 1536 + hcol_); \
        tile_issue<64, 128>(PVr, ST + (size_t)((b * 32 + c) * 16 + grp * 8 + (hd_)) * 8192, 128, lo_p); \
        _Pragma("unroll") for (int lt_ = 0; lt_ < 2; ++lt_) _Pragma("unroll") for (int pt_ = 0; pt_ < 2; ++pt_) \
            ZN[lt_][pt_] = *(const v2u*)(GZ + (t0 + wl * 32 + lt_ * 16 + (lane & 15)) * 2048 + 1024 + (grp * 8 + (hd_)) * 64 + wp * 32 + pt_ * 16 + 4 * (lane >> 4)); } while (0)
    SSD_ISSUE(0);
    __syncthreads();
    f32x4 cb[2][4];
#pragma unroll
    for (int a = 0; a < 2; ++a)
#pragma unroll
        for (int q = 0; q < 4; ++q) cb[a][q] = (f32x4){0.f, 0.f, 0.f, 0.f};
#pragma unroll
    for (int ks = 0; ks < 4; ++ks) {
        bf16x8 cf[2], bfr[4];
#pragma unroll
        for (int t = 0; t < 2; ++t) cf[t] = frag_rm(Ct, 272, wl * 32 + t * 16, ks * 32, lane);
#pragma unroll
        for (int t = 0; t < 4; ++t) bfr[t] = frag_rm(BM, 272, ws * 64 + t * 16, ks * 32, lane);
#pragma unroll
        for (int lt = 0; lt < 2; ++lt)
#pragma unroll
            for (int st = 0; st < 4; ++st) cb[lt][st] = mma(bfr[st], cf[lt], cb[lt][st]);
    }
#pragma unroll 1
    for (int hd = 0; hd < 8; ++hd) {
        const int head = grp * 8 + hd;
        ConvW W;
#pragma unroll
        for (int k = 0; k < 4; ++k) { W.w[k][0] = *(const LAS f32x4*)(wtab + k * 512 + hd * 64 + cc8); W.w[k][1] = *(const LAS f32x4*)(wtab + k * 512 + hd * 64 + cc8 + 4); }
        W.b[0] = *(const LAS f32x4*)(wtab + 4 * 512 + hd * 64 + cc8); W.b[1] = *(const LAS f32x4*)(wtab + 4 * 512 + hd * 64 + cc8 + 4);
        const float dsk = P.d_ssd[head];
        __syncthreads();
#pragma unroll
        for (int lt = 0; lt < 2; ++lt) { const int l = wl * 32 + lt * 16 + (lane & 15); const float csl = cs[hd * 128 + l], dgl = dsk * __builtin_amdgcn_rcpf(dtl[hd * 128 + l]);
#pragma unroll
            for (int st = 0; st < 4; ++st) { const int s = ws * 64 + st * 16 + 4 * (lane >> 4); f32x4 m;
#pragma unroll
                for (int jj = 0; jj < 4; ++jj) { m[jj] = (s + jj <= l) ? cb[lt][st][jj] * __expf(csl - cs[hd * 128 + s + jj]) : 0.f; if (s + jj == l) m[jj] += dgl; }
                *(LAS v2u*)(BM + l * 272 + s * 2) = (v2u){pk2(m[0], m[1]), pk2(m[2], m[3])}; } }
#pragma unroll
        for (int it = 0; it < 2; ++it) { float o[8]; conv8r(XR[it], W, tin0 + 64 * it, o);
            *(LAS v4u*)(Xd + (r0 + 64 * it) * 160 + cc8 * 2) = pack8(o, dtl[hd * 128 + r0 + 64 * it]); }
        tile_commit<64, 128>(PVr, Pv, 272, F.tid);
#pragma unroll
        for (int lt = 0; lt < 2; ++lt)
#pragma unroll
            for (int pt = 0; pt < 2; ++pt) ZC[lt][pt] = ZN[lt][pt];
        if (hd < 7) SSD_ISSUE(hd + 1);
        __syncthreads();
        f32x4 yd[2][2], yo[2][2];
#pragma unroll
        for (int a2 = 0; a2 < 2; ++a2)
#pragma unroll
            for (int q = 0; q < 2; ++q) { yd[a2][q] = (f32x4){0.f, 0.f, 0.f, 0.f}; yo[a2][q] = (f32x4){0.f, 0.f, 0.f, 0.f}; }
#pragma unroll
        for (int ks = 0; ks < 4; ++ks) {
            bf16x8 mf[2], xf[2], cf[2], pf[2];
#pragma unroll
            for (int t = 0; t < 2; ++t) { mf[t] = frag_rm(BM, 272, wl * 32 + t * 16, ks * 32, lane); xf[t] = frag_tr(Xd, 160, wp * 32 + t * 16, ks * 32, lane);
                                          cf[t] = frag_rm(Ct, 272, wl * 32 + t * 16, ks * 32, lane); pf[t] = frag_rm(Pv, 272, wp * 32 + t * 16, ks * 32, lane); }
#pragma unroll
            for (int lt = 0; lt < 2; ++lt)
#pragma unroll
                for (int pt = 0; pt < 2; ++pt) { yd[lt][pt] = mma(xf[pt], mf[lt], yd[lt][pt]); yo[lt][pt] = mma(pf[pt], cf[lt], yo[lt][pt]); }
        }
#pragma unroll
        for (int lt = 0; lt < 2; ++lt) { const int l = wl * 32 + lt * 16 + (lane & 15); const float ecs = __expf(cs[hd * 128 + l]); float ss = 0.f;
#pragma unroll
            for (int pt = 0; pt < 2; ++pt) { const int p = wp * 32 + pt * 16 + 4 * (lane >> 4);
                const v2u zv = ZC[lt][pt];
                f32x4 y = yd[lt][pt] + ecs * yo[lt][pt];
                y[0] *= silu_f(bflo(zv.x)); y[1] *= silu_f(bfhi(zv.x)); y[2] *= silu_f(bflo(zv.y)); y[3] *= silu_f(bfhi(zv.y));
                ss += (y[0] * y[0] + y[1] * y[1]) + (y[2] * y[2] + y[3] * y[3]);
                if (YO) *(v2u*)(YO + (t0 + l) * 2048 + 1024 + head * 64 + p) = (v2u){pk2(y[0], y[1]), pk2(y[2], y[3])}; }
            ss += __shfl_xor(ss, 16); ss += __shfl_xor(ss, 32);
            if ((lane >> 4) == 0) rowss[(hd * 2 + wp) * 128 + l] = ss; }
    }
#undef SSD_ISSUE
    if (!YO) return;
    asm volatile("s_waitcnt vmcnt(0)" ::: "memory");
    __syncthreads();
    LAS float* rst = (LAS float*)F.lds;
    if (F.tid < 128) { float t = 0.f;
#pragma unroll
        for (int q = 0; q < 16; ++q) t += rowss[q * 128 + F.tid];
        rst[F.tid] = rsqrtf(t * (1.f / 512.f) + EPS); }
    __syncthreads();
    { const int cc = F.tid & 63; const f32x4 n0 = *(const f32x4*)(P.ssd_norm + grp * 512 + cc * 8), n1 = *(const f32x4*)(P.ssd_norm + grp * 512 + cc * 8 + 4);
#pragma unroll 4
      for (int it = 0; it < 16; ++it) { const int r = (F.tid >> 6) + it * 8; const float rs = rst[r];
          v4u* gp = (v4u*)(YO + (t0 + r) * 2048 + 1024 + grp * 512 + cc * 8); const v4u v = *gp;
          v4u o; o.x = pk2(bflo(v.x) * rs * n0[0], bfhi(v.x) * rs * n0[1]); o.y = pk2(bflo(v.y) * rs * n0[2], bfhi(v.y) * rs * n0[3]);
          o.z = pk2(bflo(v.z) * rs * n1[0], bfhi(v.z) * rs * n1[1]); o.w = pk2(bflo(v.w) * rs * n1[2], bfhi(v.w) * rs * n1[3]);
          *gp = o; } }
}

struct S5Par { const float* lam_re; const float* lam_im; const float* log_step; const float* b_re; const float* b_im; const float* c_re; const float* c_im; const float* d_s5; };

DI void s5_build_unit(Frame& F, const S5Par& P, int unit) {
    const int g = unit >> 2, cq = unit & 3;
    bf16* AB = (bf16*)(F.ws + WS_S5MAT + (size_t)g * 262144); bf16* E = AB + 256 * 384;
    LAS f32x2v* pw = (LAS f32x2v*)F.lds;
    LAS f32x2v* Bb = (LAS f32x2v*)(F.lds + 8704);
    LAS f32x2v* Cc = (LAS f32x2v*)(F.lds + 16896);
    LAS float* Km = (LAS float*)(F.lds + 25088);
    LAS f32x2v* cf = (LAS f32x2v*)(F.lds + 29184);
    __syncthreads();
    for (int i = F.tid; i < 17 * 64; i += NTHR) { const int t = i >> 6, p = i & 63;
        const double lr = fmin((double)P.lam_re[g * 64 + p], -1e-4), li = (double)P.lam_im[g * 64 + p], dl = (double)expf(P.log_step[g]);
        const double mag = (double)expf((float)(t * lr * dl)); double sn, cs_; sincos_d(t * li * dl, sn, cs_);
        pw[i] = (f32x2v){(float)(mag * cs_), (float)(mag * sn)};
        if (t == 1) { const double den = lr * lr + li * li, nr = mag * cs_ - 1.0, ni = mag * sn; cf[p] = (f32x2v){(float)((nr * lr + ni * li) / den), (float)((ni * lr - nr * li) / den)}; } }
    __syncthreads();
    for (int i = F.tid; i < 1024; i += NTHR) { const int p = i >> 4; const f32x2v c = cf[p]; const float br = P.b_re[g * 1024 + i], bi = P.b_im[g * 1024 + i];
        Bb[i] = (f32x2v){c.x * br - c.y * bi, c.x * bi + c.y * br}; }
    for (int i = F.tid; i < 1024; i += NTHR) Cc[i] = (f32x2v){P.c_re[g * 1024 + i], P.c_im[g * 1024 + i]};
    __syncthreads();
    for (int i = F.tid; i < 1024; i += NTHR) { const int t = i >> 6, cl = (i >> 4) & 3, c2 = i & 15, c = cq * 4 + cl; float acc = 0.f;
        for (int p = 0; p < 64; ++p) { const f32x2v cc = Cc[c * 64 + p], a = pw[t * 64 + p], bb = Bb[p * 16 + c2];
            const float tr = cc.x * a.x - cc.y * a.y, ti = cc.x * a.y + cc.y * a.x; acc += tr * bb.x - ti * bb.y; }
        Km[i] = acc; }
    __syncthreads();
    for (int i = F.tid; i < 64 * 48; i += NTHR) { const int rl = i / 48, c8 = (i % 48) * 8, l = rl >> 2, cl = rl & 3, c = cq * 4 + cl, row = l * 16 + c; float v[8];
        if (c8 < 256) { const int s = c8 >> 4, c2 = c8 & 15;
#pragma unroll
            for (int k = 0; k < 8; ++k) v[k] = s <= l ? Km[((l - s) * 4 + cl) * 16 + c2 + k] : 0.f;
        } else { const bool im = c8 >= 320; const int p0 = c8 - (im ? 320 : 256);
#pragma unroll
            for (int k = 0; k < 8; ++k) { const f32x2v cc = Cc[c * 64 + p0 + k], a = pw[(l + 1) * 64 + p0 + k];
                v[k] = im ? -(cc.x * a.y + cc.y * a.x) : (cc.x * a.x - cc.y * a.y); } }
        *(v4u*)(AB + (size_t)row * 384 + c8) = (v4u){pk2(v[0], v[1]), pk2(v[2], v[3]), pk2(v[4], v[5]), pk2(v[6], v[7])}; }
    for (int i = F.tid; i < 32 * 32; i += NTHR) { const int rl = i >> 5, c8 = (i & 31) * 8, p = cq * 16 + (rl & 15), s = c8 >> 4, c2 = c8 & 15; const bool im = rl >= 16; const int row = (im ? 64 : 0) + p; float v[8];
        const f32x2v a = pw[(15 - s) * 64 + p];
#pragma unroll
        for (int k = 0; k < 8; ++k) { const f32x2v bb = Bb[p * 16 + c2 + k]; v[k] = im ? (a.x * bb.y + a.y * bb.x) : (a.x * bb.x - a.y * bb.y); }
        *(v4u*)(E + (size_t)row * 256 + c8) = (v4u){pk2(v[0], v[1]), pk2(v[2], v[3]), pk2(v[4], v[5]), pk2(v[6], v[7])}; }
}

DI void s5_gemmA_unit(Frame& F, int unit) {
    const bf16* HN = (const bf16*)(F.ws + WS_SLOT32); float* EO = (float*)(F.ws + WS_S5E);
    const int g = unit >> 2, q = unit & 3, lane = F.lane, w = F.wave, i = lane & 15, gq = lane >> 4;
    const bf16* E = (const bf16*)(F.ws + WS_S5MAT + (size_t)g * 262144) + 256 * 384 + (q * 32) * 256;
    bf16x8 ef[2][8];
#pragma unroll
    for (int mt = 0; mt < 2; ++mt)
#pragma unroll
        for (int ks = 0; ks < 8; ++ks) ef[mt][ks] = *(const bf16x8*)(E + (mt * 16 + i) * 256 + 32 * ks + 8 * gq);
#pragma unroll 2
    for (int t = 0; t < 8; ++t) { const int nt = t * 8 + w, b = nt >> 4, k0 = (nt & 15) * 16;
        const bf16* hp = HN + ((size_t)b * SEQ + 16 * (k0 + i) + (gq >> 1)) * D + 16 * g + 8 * (gq & 1);
        bf16x8 uf[8];
#pragma unroll
        for (int ks = 0; ks < 8; ++ks) uf[ks] = *(const bf16x8*)(hp + (size_t)(2 * ks) * D);
        f32x4 acc[2] = {(f32x4){0.f, 0.f, 0.f, 0.f}, (f32x4){0.f, 0.f, 0.f, 0.f}};
#pragma unroll
        for (int ks = 0; ks < 8; ++ks)
#pragma unroll
            for (int mt = 0; mt < 2; ++mt) acc[mt] = mma(ef[mt][ks], uf[ks], acc[mt]);
        float* dst = EO + ((size_t)((b * 256 + k0 + i) * 64 + g)) * 128 + q * 32 + 4 * gq;
#pragma unroll
        for (int mt = 0; mt < 2; ++mt) *(f32x4*)(dst + mt * 16) = acc[mt]; }
}

DI void s5_scan_task(Frame& F, const float* lam_re, const float* lam_im, const float* log_step, int task, int dbg) {
    const float* EO = (const float*)(F.ws + WS_S5E); bf16* XO = (bf16*)(F.ws + WS_S5X);
    const int b = task >> 6, g = task & 63, p = F.lane;
    f32x2v a;
    { const double lr = fmin((double)lam_re[g * 64 + p], -1e-4), li = (double)lam_im[g * 64 + p], dl = (double)expf(log_step[g]);
      const double mag = (double)expf((float)(16.0 * lr * dl)); double s, c; sincos_d(16.0 * li * dl, s, c); a = (f32x2v){(float)(mag * c), (float)(mag * s)}; }
    if (dbg == 6) a = (f32x2v){0.f, 0.f};
    float rr = 0.f, ri = 0.f;
    const float* ep = EO + ((size_t)(b * 256) * 64 + g) * 128 + p; bf16* xp = XO + ((size_t)(b * 256) * 64 + g) * 128 + p;
    float er[16], ei[16], fr_[16], fi_[16];
#pragma unroll
    for (int s2 = 0; s2 < 16; ++s2) { er[s2] = ep[(size_t)s2 * 8192]; ei[s2] = ep[(size_t)s2 * 8192 + 64]; }
#pragma unroll 1
    for (int kb = 0; kb < 16; ++kb) {
        const int kn = kb < 15 ? kb + 1 : kb;
#pragma unroll
        for (int s2 = 0; s2 < 16; ++s2) { fr_[s2] = ep[(size_t)(kn * 16 + s2) * 8192]; fi_[s2] = ep[(size_t)(kn * 16 + s2) * 8192 + 64]; }
#pragma unroll
        for (int s2 = 0; s2 < 16; ++s2) { bf16* xo = xp + (size_t)(kb * 16 + s2) * 8192;
            xo[0] = (bf16)f2bf(rr); xo[64] = (bf16)f2bf(ri);
            const float nr = a.x * rr - a.y * ri + er[s2], ni = a.x * ri + a.y * rr + ei[s2]; rr = nr; ri = ni; }
#pragma unroll
        for (int s2 = 0; s2 < 16; ++s2) { er[s2] = fr_[s2]; ei[s2] = fi_[s2]; }
    }
}

DI float gelu_tanh(float v) { const float u = 0.7978845608028654f * (v + 0.044715f * v * v * v); const float t = 1.0f - 2.0f * __builtin_amdgcn_rcpf(__expf(2.0f * u) + 1.0f); return 0.5f * v * (1.0f + t); }

DI void s5_gemmB_unit(Frame& F, const float* d_s5, int unit) {
    const bf16* HN = (const bf16*)(F.ws + WS_SLOT32); const bf16* XO = (const bf16*)(F.ws + WS_S5X); bf16* Y = (bf16*)(F.ws + WS_Y);
    const int g = unit >> 2, lq = unit & 3, lane = F.lane, w = F.wave, i = lane & 15, gq = lane >> 4;
    const bf16* AB = (const bf16*)(F.ws + WS_S5MAT + (size_t)g * 262144) + (size_t)(64 * lq) * 384;
    LAS unsigned char* A = F.lds;
    __syncthreads();
    load_tile(A, 784, AB, 384, 64, 384, F.tid);
    __syncthreads();
    const int colg = 16 * g + 4 * gq;
    const f32x4 dv = *(const f32x4*)(d_s5 + colg);
#pragma unroll 1
    for (int t = 0; t < 8; ++t) { const int nt = t * 8 + w, b = nt >> 4, k0 = (nt & 15) * 16;
        const bf16* hp = HN + ((size_t)b * SEQ + 16 * (k0 + i) + (gq >> 1)) * D + 16 * g + 8 * (gq & 1);
        const bf16* xp = XO + ((size_t)((b * 256 + k0 + i) * 64 + g)) * 128 + 8 * gq;
        bf16x8 uf[12];
#pragma unroll
        for (int ks = 0; ks < 8; ++ks) uf[ks] = *(const bf16x8*)(hp + (size_t)(2 * ks) * D);
#pragma unroll
        for (int ks = 0; ks < 4; ++ks) uf[8 + ks] = *(const bf16x8*)(xp + ks * 32);
        f32x4 acc[4];
#pragma unroll
        for (int mt = 0; mt < 4; ++mt) acc[mt] = (f32x4){0.f, 0.f, 0.f, 0.f};
#pragma unroll
        for (int ks = 0; ks < 12; ++ks) {
#pragma unroll
            for (int mt = 0; mt < 4; ++mt) acc[mt] = mma(frag_rm(A, 784, mt * 16, ks * 32, lane), uf[ks], acc[mt]);
            if (ks & 1) __builtin_amdgcn_sched_barrier(0); }
#pragma unroll
        for (int mt = 0; mt < 4; ++mt) { const size_t tok = (size_t)b * SEQ + 16 * (k0 + i) + 4 * lq + mt;
            const v2u hv = *(const v2u*)(HN + tok * D + colg);
            const float y0 = gelu_tanh(acc[mt][0] + dv[0] * bflo(hv.x)), y1 = gelu_tanh(acc[mt][1] + dv[1] * bfhi(hv.x));
            const float y2 = gelu_tanh(acc[mt][2] + dv[2] * bflo(hv.y)), y3 = gelu_tanh(acc[mt][3] + dv[3] * bfhi(hv.y));
            *(v2u*)(Y + tok * D + colg) = (v2u){pk2(y0, y1), pk2(y2, y3)}; } }
}

#ifndef REP_BAR
#define REP_BAR 1
#endif
#ifndef REP_CONV
#define REP_CONV 1
#endif
#ifndef REP_ROW
#define REP_ROW 1
#endif
#ifndef REP_RC
#define REP_RC 1
#endif
#ifndef REP_SC
#define REP_SC 1
#endif
#ifndef REP_GEMM
#define REP_GEMM 1
#endif
#ifndef REP_S5A
#define REP_S5A 1
#endif
#ifndef REP_S5S
#define REP_S5S 1
#endif
#ifndef REP_S5B
#define REP_S5B 1
#endif
#ifndef REP_RA
#define REP_RA 1
#endif
#ifndef REP_SA
#define REP_SA 1
#endif
#ifndef SKIP_EVEN
#define SKIP_EVEN 0
#endif
#ifndef SKIP_ODD
#define SKIP_ODD 0
#endif
DI int opq(int v) { asm volatile("" : "+s"(v)); return v; }
struct Args { const float* in[N_IN]; float* out; unsigned char* ws; };
constexpr int CW_BAR = 1024;

#define PHASE() do { unsigned z_ = 0u; asm volatile("" : "+s"(z_)); int l_ = __builtin_amdgcn_mbcnt_hi(~0u, __builtin_amdgcn_mbcnt_lo(~0u, z_)); int w_ = wave0; asm volatile("" : "+s"(w_)); \
        int g_ = gridDim.x, b_ = blockIdx.x; asm volatile("" : "+s"(g_), "+s"(b_)); F.G = g_; F.bid = b_; F.vcu = (g_ % 8 == 0) ? (b_ % 8) * (g_ / 8) + b_ / 8 : b_; F.lane = l_; F.wave = w_; F.tid = w_ * 64 + l_; F.out = (float*)(GAS float*)lds_ptr(F, N_IN); F.ws = (unsigned char*)(GAS unsigned char*)lds_ptr(F, N_IN + 1); } while (0)
#define WSP(T, off) ((T*)(F.ws + (off)))
#define GRID_BAR() do { PHASE(); XcdBarrier xb_; xb_.bar = (unsigned*)(F.ws + WS_CTL) + CW_BAR; xb_.x = xb_xcc_id(); xb_.tid = F.tid; xb_.st = (volatile LAS unsigned*)(F.lds + MISC_OFF) + 8; xcd_barrier(xb_); if (REP_BAR == 2) xcd_barrier(xb_); PHASE(); } while (0)
template <int layer> __device__ __forceinline__ void run_layer(Frame& F, const int wave0) {
        const int j = layer >> 1;
        if ((layer & 1) == 0) {
            if (!opq(SKIP_EVEN)) {
            { pg8::Gemm g{WSP(bf16, WS_SLOT32), WSP(bf16, WS_SLOT16), M, INP_PAD, D}; pg8::StaticOrder S; S.init(M, INP_PAD, F.G, F.bid);
              pg8::EpiInProj E{WSP(bf16, WS_QKV), WSP(bf16, WS_GZ), WSP(bf16, WS_XBC), WSP(float, WS_DT), (const float*)(F.ws + WS_ROPE), INP(I_DT_BIAS) + j * 16};
              pg8::gemm_phase<pg8::EpiInProj, pg8::StaticOrder, true, true>(F.lds, g, S, E, F.tid); }
#if REP_GEMM == 2
            { PHASE(); pg8::Gemm g{WSP(bf16, WS_SLOT32), WSP(bf16, WS_SLOT16), M, INP_PAD, D}; pg8::StaticOrder S; S.init(M, INP_PAD, F.G, F.bid);
              pg8::EpiInProj E{WSP(bf16, WS_QKV), WSP(bf16, WS_GZ), WSP(bf16, WS_XBC), WSP(float, WS_DT), (const float*)(F.ws + WS_ROPE), INP(I_DT_BIAS) + j * 16};
              pg8::gemm_phase<pg8::EpiInProj, pg8::StaticOrder, true, true>(F.lds, g, S, E, F.tid); }
#endif
            GRID_BAR();
            for (int rep_ = 0; rep_ < REP_RA; ++rep_) for (int u = F.vcu; u < 256; u += F.G) ret_passA_unit(F, u);
            { const SsdPar SP{INP(I_CONV_W) + (size_t)j * 4 * 1536, INP(I_CONV_B) + j * 1536, INP(I_A_LOG) + j * 16, INP(I_D_SSD) + j * 16, INP(I_SSD_NORM) + j * 1024};
              for (int rep_ = 0; rep_ < REP_SA; ++rep_) for (int u = F.vcu; u < 256; u += F.G) ssd_passA_unit(F, SP, u); }
            GRID_BAR();
            for (int it = (F.bid * NTHR + F.tid); it < 131072; it += (F.G * NTHR)) ret_scan_item(F, it);
            for (int it = (F.bid * NTHR + F.tid); it < 131072; it += (F.G * NTHR)) ssd_scan_item(F, it);
            GRID_BAR();
#if REP_RC == 2
            if (layer == 0) for (int u = F.vcu; u < 256; u += F.G) ret_passC_unit(F, u, (bf16*)F.out);
#endif
            for (int u = F.vcu; u < 256; u += F.G) ret_passC_unit(F, u, WSP(bf16, WS_GZ));
            { const SsdPar SP{INP(I_CONV_W) + (size_t)j * 4 * 1536, INP(I_CONV_B) + j * 1536, INP(I_A_LOG) + j * 16, INP(I_D_SSD) + j * 16, INP(I_SSD_NORM) + j * 1024};
#if REP_SC >= 2
              if (layer == 0) for (int u = F.vcu; u < 256; u += F.G) ssd_passC_unit(F, SP, u, REP_SC == 2 ? (bf16*)F.out : (bf16*)nullptr);
#endif
              for (int u = F.vcu; u < 256; u += F.G) ssd_passC_unit(F, SP, u, WSP(bf16, WS_GZ)); }
            GRID_BAR();
            }
            __syncthreads();
            convert_weight(F, INP(I_W_UP) + (size_t)layer * D * FF, D, FF, WSP(bf16, WS_SLOT16), 0);
#if REP_CONV == 2
            convert_weight(F, INP(I_W_UP) + (size_t)layer * D * FF, D, FF, WSP(bf16, WS_SLOT16), 0);
#endif
            convert_weight(F, INP(I_W_DOWN) + (size_t)layer * FF * D, FF, D, WSP(bf16, WS_SLOT16) + (size_t)FF * D, 0);
#if REP_CONV == 2
            convert_weight(F, INP(I_W_DOWN) + (size_t)layer * FF * D, FF, D, WSP(bf16, WS_SLOT16) + (size_t)FF * D, 0);
#endif
            __syncthreads();
            if (!opq(SKIP_EVEN)) {
            { pg8::Gemm g{WSP(bf16, WS_GZ), WSP(bf16, WS_W4), M, D, 2048}; pg8::StaticOrder S; S.init(M, D, F.G, F.bid);
              pg8::EpiBf16 E{WSP(bf16, WS_M32A), D};
              pg8::gemm_phase<pg8::EpiBf16, pg8::StaticOrder, true, true>(F.lds, g, S, E, F.tid); }
#if REP_GEMM == 2
            { PHASE(); pg8::Gemm g{WSP(bf16, WS_GZ), WSP(bf16, WS_W4), M, D, 2048}; pg8::StaticOrder S; S.init(M, D, F.G, F.bid);
              pg8::EpiBf16 E{WSP(bf16, WS_M32A), D};
              pg8::gemm_phase<pg8::EpiBf16, pg8::StaticOrder, true, true>(F.lds, g, S, E, F.tid); }
#endif
            } else zero_fill(F, WSP(bf16, WS_M32A), (size_t)M * D * 2);
            GRID_BAR();
            if (layer == 0) row_phase<true, false>(F, WSP(bf16, WS_M32A), INP(I_X), F.out, INP(I_POST_MIX) + layer * D, INP(I_PRE_MLP) + layer * D, WSP(bf16, WS_SLOT32));
            else row_phase<false, false>(F, WSP(bf16, WS_M32A), F.out, F.out, INP(I_POST_MIX) + layer * D, INP(I_PRE_MLP) + layer * D, WSP(bf16, WS_SLOT32));
            GRID_BAR();
        } else {
            if (opq(SKIP_ODD) == 2) {
                const v4u* s_ = (const v4u*)WSP(bf16, WS_SLOT32); v4u* d_ = (v4u*)WSP(bf16, WS_Y);
                for (size_t i_ = (size_t)F.bid * NTHR + F.tid; i_ < (size_t)M * D / 8; i_ += (size_t)F.G * NTHR) d_[i_] = s_[i_];
                GRID_BAR();
            }
            if (opq(SKIP_ODD) == 0 || opq(SKIP_ODD) >= 3) {
            for (int rep_ = 0; rep_ < REP_S5A; ++rep_) for (int u = F.vcu; u < 256; u += F.G) s5_gemmA_unit(F, u);
            GRID_BAR();
            if (opq(SKIP_ODD) == 3) zero_fill(F, WSP(bf16, WS_S5X), (size_t)16 * MiB);
            else if (F.wave == 0) for (int rep_ = 0; rep_ < REP_S5S; ++rep_) for (int t = F.bid; t < 256; t += F.G) s5_scan_task(F, INP(I_LAM_RE) + j * 4096, INP(I_LAM_IM) + j * 4096, INP(I_LOG_STEP) + j * 64, t, opq(SKIP_ODD));
            GRID_BAR();
            for (int rep_ = 0; rep_ < REP_S5B; ++rep_) for (int u = F.vcu; u < 256; u += F.G) s5_gemmB_unit(F, INP(I_D_S5) + j * 1024, u);
            GRID_BAR();
            }
            __syncthreads();
            convert_weight(F, INP(I_W_UP) + (size_t)layer * D * FF, D, FF, WSP(bf16, WS_SLOT16), 0);
            convert_weight(F, INP(I_W_DOWN) + (size_t)layer * FF * D, FF, D, WSP(bf16, WS_SLOT16) + (size_t)FF * D, 0);
            __syncthreads();
            if (opq(SKIP_ODD) != 1) {
            { pg8::Gemm g{WSP(bf16, WS_Y), WSP(bf16, WS_W4), M, 2048, D}; pg8::StaticOrder S; S.init(M, 2048, F.G, F.bid);
              pg8::EpiGlu E{WSP(bf16, WS_M32B), D};
              pg8::gemm_phase<pg8::EpiGlu, pg8::StaticOrder, true, true>(F.lds, g, S, E, F.tid); }
#if REP_GEMM == 2
            { PHASE(); pg8::Gemm g{WSP(bf16, WS_Y), WSP(bf16, WS_W4), M, 2048, D}; pg8::StaticOrder S; S.init(M, 2048, F.G, F.bid);
              pg8::EpiGlu E{WSP(bf16, WS_M32B), D};
              pg8::gemm_phase<pg8::EpiGlu, pg8::StaticOrder, true, true>(F.lds, g, S, E, F.tid); }
#endif
            } else zero_fill(F, WSP(bf16, WS_M32B), (size_t)M * D * 2);
            GRID_BAR();
            row_phase<false, false>(F, WSP(bf16, WS_M32B), F.out, F.out, INP(I_POST_MIX) + layer * D, INP(I_PRE_MLP) + layer * D, WSP(bf16, WS_SLOT32));
            GRID_BAR();
        }
        { pg8::Gemm g{WSP(bf16, WS_SLOT32), WSP(bf16, WS_SLOT16), M, FF, D}; pg8::StaticOrder S; S.init(M, FF, F.G, F.bid);
          pg8::EpiRelu2 E{WSP(bf16, WS_U), FF};
          pg8::gemm_phase<pg8::EpiRelu2, pg8::StaticOrder, true, true>(F.lds, g, S, E, F.tid); }
#if REP_GEMM == 2
            { PHASE(); pg8::Gemm g{WSP(bf16, WS_SLOT32), WSP(bf16, WS_SLOT16), M, FF, D}; pg8::StaticOrder S; S.init(M, FF, F.G, F.bid);
          pg8::EpiRelu2 E{WSP(bf16, WS_U), FF};
          pg8::gemm_phase<pg8::EpiRelu2, pg8::StaticOrder, true, true>(F.lds, g, S, E, F.tid); }
#endif
        GRID_BAR();
        __syncthreads();
        if ((layer & 1) == 0) { convert_weight(F, INP(I_W_GLU_A) + (size_t)j * D * D, D, D, WSP(bf16, WS_W4), 1); convert_weight(F, INP(I_W_GLU_B) + (size_t)j * D * D, D, D, WSP(bf16, WS_W4), 2); }
#if REP_CONV == 2
        if ((layer & 1) == 0) { convert_weight(F, INP(I_W_GLU_A) + (size_t)j * D * D, D, D, WSP(bf16, WS_W4), 1); convert_weight(F, INP(I_W_GLU_B) + (size_t)j * D * D, D, D, WSP(bf16, WS_W4), 2); }
#endif
        __syncthreads();
        { pg8::Gemm g{WSP(bf16, WS_U), WSP(bf16, WS_SLOT16) + (size_t)FF * D, M, D, FF}; pg8::StaticOrder S; S.init(M, D, F.G, F.bid);
          pg8::EpiBf16 E{WSP(bf16, WS_M32B), D};
          pg8::gemm_phase<pg8::EpiBf16, pg8::StaticOrder, true, true>(F.lds, g, S, E, F.tid); }
#if REP_GEMM == 2
            { PHASE(); pg8::Gemm g{WSP(bf16, WS_U), WSP(bf16, WS_SLOT16) + (size_t)FF * D, M, D, FF}; pg8::StaticOrder S; S.init(M, D, F.G, F.bid);
          pg8::EpiBf16 E{WSP(bf16, WS_M32B), D};
          pg8::gemm_phase<pg8::EpiBf16, pg8::StaticOrder, true, true>(F.lds, g, S, E, F.tid); }
#endif
        GRID_BAR();
        if (layer < DEPTH - 1) row_phase<false, false>(F, WSP(bf16, WS_M32B), F.out, F.out, INP(I_POST_MLP) + layer * D, INP(I_PRE_MIX) + (layer + 1) * D, WSP(bf16, WS_SLOT32));
        else row_phase<false, true>(F, WSP(bf16, WS_M32B), F.out, F.out, INP(I_POST_MLP) + layer * D, nullptr, nullptr);
        if (layer == 0 || layer == 2) {
            const S5Par P5{INP(I_LAM_RE) + j * 4096, INP(I_LAM_IM) + j * 4096, INP(I_LOG_STEP) + j * 64, INP(I_B_RE) + (size_t)j * 65536, INP(I_B_IM) + (size_t)j * 65536,
                           INP(I_C_RE) + (size_t)j * 65536, INP(I_C_IM) + (size_t)j * 65536, INP(I_D_S5) + j * 1024};
            for (int u = F.bid; u < 256; u += F.G) s5_build_unit(F, P5, u);
        } else if (layer == 1) {
            __syncthreads();
            convert_weight(F, INP(I_W_IN) + (size_t)D * INP, D, INP, WSP(bf16, WS_SLOT16), 0);
#if REP_CONV == 2
            convert_weight(F, INP(I_W_IN) + (size_t)D * INP, D, INP, WSP(bf16, WS_SLOT16), 0);
#endif
            zero_fill(F, WSP(bf16, WS_SLOT16) + (size_t)6688 * D, (size_t)(INP_PAD - 6688) * D * 2);
            convert_weight(F, INP(I_W_OUT) + (size_t)2048 * D, 2048, D, WSP(bf16, WS_W4), 0);
#if REP_CONV == 2
            convert_weight(F, INP(I_W_OUT) + (size_t)2048 * D, 2048, D, WSP(bf16, WS_W4), 0);
#endif
        }
        if (layer < DEPTH - 1) GRID_BAR();

}

__global__ void __launch_bounds__(NTHR, 2) trunk_fwd(Args args) {
    extern __shared__ __attribute__((aligned(16))) unsigned char lds[];
    Frame F;
    F.lds = (LAS unsigned char*)lds;
    F.G = gridDim.x; F.bid = blockIdx.x;
    { const int t = threadIdx.x;
      for (int u = t; u < (LDS_BYTES - MISC_OFF) / 4; u += NTHR) ((LAS unsigned*)(F.lds + MISC_OFF))[u] = 0u;
      __syncthreads();
      if (t < N_IN + 2) ((LAS unsigned long long*)(F.lds + MISC_OFF + 256))[t] = t < N_IN ? (unsigned long long)args.in[t] : (t == N_IN ? (unsigned long long)args.out : (unsigned long long)args.ws);
      __syncthreads(); }
    const int wave0 = __builtin_amdgcn_readfirstlane(threadIdx.x >> 6);
    PHASE();
    (void)xcd_barrier_post((unsigned*)(F.ws + WS_CTL) + CW_BAR, (volatile LAS unsigned*)(F.lds + MISC_OFF) + 8);

    build_rope(F);
    convert_weight(F, INP(I_W_IN), D, INP, WSP(bf16, WS_SLOT16), 0);
#if REP_CONV == 2
    convert_weight(F, INP(I_W_IN), D, INP, WSP(bf16, WS_SLOT16), 0);
#endif
    zero_fill(F, WSP(bf16, WS_SLOT16) + (size_t)6688 * D, (size_t)(INP_PAD - 6688) * D * 2);
    convert_weight(F, INP(I_W_OUT), 2048, D, WSP(bf16, WS_W4), 0);
#if REP_CONV == 2
    convert_weight(F, INP(I_W_OUT), 2048, D, WSP(bf16, WS_W4), 0);
#endif
    rms_rows_to_bf16(F, INP(I_X), INP(I_PRE_MIX), WSP(bf16, WS_SLOT32));
    GRID_BAR();

    run_layer<0>(F, wave0); run_layer<1>(F, wave0); run_layer<2>(F, wave0); run_layer<3>(F, wave0);
}

extern "C" void kernel_launch(void* const* d_in, const int* in_sizes, int n_in, void* d_out, int out_size, void* d_ws, size_t ws_size, hipStream_t stream) {
    static int grid = 0;
    if (grid == 0) {
        if (n_in != N_IN || out_size != M * D || ws_size < WS_END) { fprintf(stderr, "kernel_launch: unexpected shapes (n_in %d, out %d, ws %zu)\n", n_in, out_size, ws_size); grid = -1; return; }
        int dev = 0, cus = 0, per_cu = 0;
        if (hipGetDevice(&dev) != hipSuccess || hipDeviceGetAttribute(&cus, hipDeviceAttributeMultiprocessorCount, dev) != hipSuccess) { grid = -1; return; }
        if (hipFuncSetAttribute((const void*)trunk_fwd, hipFuncAttributeMaxDynamicSharedMemorySize, LDS_BYTES) != hipSuccess) { fprintf(stderr, "kernel_launch: hipFuncSetAttribute failed\n"); grid = -1; return; }
        if (hipOccupancyMaxActiveBlocksPerMultiprocessor(&per_cu, (const void*)trunk_fwd, NTHR, LDS_BYTES) != hipSuccess || per_cu < 1)
            fprintf(stderr, "kernel_launch: note: occupancy query reports %d workgroups per CU\n", per_cu);
        (void)hipGetLastError();
        grid = cus;
    }
    if (grid < 0) return;
    if (hipMemsetAsync((char*)d_ws + WS_CTL, 0, CTL_ZERO_BYTES, stream) != hipSuccess) return;
#ifdef DBG_ZERO_MISC
    if (hipMemsetAsync((char*)d_ws + WS_MISC, 0, 512 * 1024, stream) != hipSuccess) return;
#endif
    Args a{};
    for (int i = 0; i < N_IN; ++i) a.in[i] = (const float*)d_in[i];
    a.out = (float*)d_out; a.ws = (unsigned char*)d_ws;
    hipLaunchKernelGGL(trunk_fwd, dim3(grid), dim3(NTHR), LDS_BYTES, stream, a);
}
```

```cpp
#include <hip/hip_runtime.h>
#include <cstdio>
#include <cstdint>
namespace pg8 {
#define PG8_LAS __attribute__((address_space(3)))
typedef unsigned short bf16_t;
typedef short bf16x8 __attribute__((ext_vector_type(8)));
typedef float f32x4 __attribute__((ext_vector_type(4)));
typedef unsigned u32x4 __attribute__((ext_vector_type(4)));
constexpr int BM = 256, BK = 64, HALF = 128, HTB = HALF * BK * 2  , STAGE_BYTES = 8 * HTB, NXCD = 8, WGM = 8;

__host__ __device__ __forceinline__ int lds_byte(int r, int c) { const int st = (r >> 4) * 2 + (c >> 5), rr = r & 15, cc = c & 31, ob = rr * 64 + cc * 2; return st * 1024 + (ob ^ (((ob >> 9) & 1) << 5)); }
__host__ __device__ __forceinline__ void stage_rc(int b, int& R, int& C) { const int st = b / 1024, sb = b % 1024, swz = sb ^ (((sb >> 9) & 1) << 5); R = (st >> 1) * 16 + swz / 64; C = (st & 1) * 32 + (swz % 64) / 2; }
__host__ __device__ __forceinline__ int perm32(int rho) { const int n = rho >> 4, i = rho & 15; return 8 * (i >> 2) + 4 * n + (i & 3); }

struct Unit { int pm, pn; };
struct Gemm { const bf16_t* A; const bf16_t* Bt; int M, N, K; };

struct StaticOrder {
    int nM, nN, nwg, G, c;
    __host__ __device__ void init(int M, int N, int G_, int c_) { nM = M / BM; nN = N / BM; nwg = nM * nN; G = G_; c = c_; }
    __host__ __device__ bool next(int i, Unit& u) const {
        const long L = (long)i * G + c; if (L >= nwg) return false;
        int wgid = (int)L; { const int q = nwg / NXCD, r = nwg % NXCD, xcd = wgid % NXCD, off = wgid / NXCD; wgid = (xcd < r ? xcd * (q + 1) : r * (q + 1) + (xcd - r) * q) + off; }
        const int nig = WGM * nN, gid = wgid / nig, fm = gid * WGM, gsz = (nM - fm) < WGM ? (nM - fm) : WGM;
        u.pm = fm + ((wgid % nig) % gsz); u.pn = (wgid % nig) / gsz; return true;
    }
    __device__ __forceinline__ void a_ready(const Unit&) const {}
    __device__ __forceinline__ void done(const Unit&) const {}
};

typedef __bf16 bf2_t __attribute__((ext_vector_type(2))); typedef float f32x2p __attribute__((ext_vector_type(2)));
__device__ __forceinline__ unsigned cvt_pk_bf16(float lo, float hi) { const f32x2p v = {lo, hi}; return __builtin_bit_cast(unsigned, __builtin_convertvector(v, bf2_t)); }
typedef float f32x2 __attribute__((ext_vector_type(2)));
struct EpiBf16 {
    static constexpr bool PERM = true, AFTER_DRAIN = false;
    bf16_t* O; int ldc;
    __device__ __forceinline__ void operator()(const f32x4 (&acc)[2][2][4][2], const Unit& u, int wr, int wc, int fr_in, int fq_in) const {
        int fr = fr_in, fq = fq_in; asm volatile("" : "+v"(fr), "+v"(fq));
        const int row0 = u.pm * BM + wr * 64 + fr, col0 = u.pn * BM + wc * 32 + 8 * fq;
#pragma unroll
        for (int ai = 0; ai < 2; ++ai)
#pragma unroll
            for (int m = 0; m < 4; ++m) { bf16_t* rowp = O + (size_t)(row0 + ai * HALF + m * 16) * ldc + col0;
#pragma unroll
                for (int bj = 0; bj < 2; ++bj) { const f32x4 v0 = acc[ai][bj][m][0], v1 = acc[ai][bj][m][1];
                    u32x4 w; w.x = cvt_pk_bf16(v0[0], v0[1]); w.y = cvt_pk_bf16(v0[2], v0[3]); w.z = cvt_pk_bf16(v1[0], v1[1]); w.w = cvt_pk_bf16(v1[2], v1[3]);
                    *(u32x4*)(rowp + bj * HALF) = w; } }
    }
};
struct EpiGlu {
    static constexpr bool PERM = true, AFTER_DRAIN = false;
    bf16_t* O; int ldc;
    __device__ __forceinline__ void operator()(const f32x4 (&acc)[2][2][4][2], const Unit& u, int wr, int wc, int fr_in, int fq_in) const {
        int fr = fr_in, fq = fq_in; asm volatile("" : "+v"(fr), "+v"(fq));
        const int row0 = u.pm * BM + wr * 64 + fr, col0 = u.pn * HALF + wc * 32 + 8 * fq;
#pragma unroll
        for (int ai = 0; ai < 2; ++ai)
#pragma unroll
            for (int m = 0; m < 4; ++m) { bf16_t* rowp = O + (size_t)(row0 + ai * HALF + m * 16) * ldc + col0;
                f32x4 o[2];
#pragma unroll
                for (int n = 0; n < 2; ++n) { const f32x4 a = acc[ai][0][m][n], b = acc[ai][1][m][n];
#pragma unroll
                    for (int j = 0; j < 4; ++j) o[n][j] = a[j] * __builtin_amdgcn_rcpf(1.0f + __expf(-b[j])); }
                u32x4 w; w.x = cvt_pk_bf16(o[0][0], o[0][1]); w.y = cvt_pk_bf16(o[0][2], o[0][3]); w.z = cvt_pk_bf16(o[1][0], o[1][1]); w.w = cvt_pk_bf16(o[1][2], o[1][3]);
                *(u32x4*)rowp = w; }
    }
};
struct EpiRelu2 {
    static constexpr bool PERM = true, AFTER_DRAIN = false;
    bf16_t* O; int ldc;
    __device__ __forceinline__ void operator()(const f32x4 (&acc)[2][2][4][2], const Unit& u, int wr, int wc, int fr_in, int fq_in) const {
        int fr = fr_in, fq = fq_in; asm volatile("" : "+v"(fr), "+v"(fq));
        const int row0 = u.pm * BM + wr * 64 + fr, col0 = u.pn * BM + wc * 32 + 8 * fq;
#pragma unroll
        for (int ai = 0; ai < 2; ++ai)
#pragma unroll
            for (int m = 0; m < 4; ++m) { bf16_t* rowp = O + (size_t)(row0 + ai * HALF + m * 16) * ldc + col0;
#pragma unroll
                for (int bj = 0; bj < 2; ++bj) { f32x4 v0 = acc[ai][bj][m][0], v1 = acc[ai][bj][m][1];
#pragma unroll
                    for (int j = 0; j < 4; ++j) { const float a = fmaxf(v0[j], 0.f), b = fmaxf(v1[j], 0.f); v0[j] = a * a; v1[j] = b * b; }
                    u32x4 w; w.x = cvt_pk_bf16(v0[0], v0[1]); w.y = cvt_pk_bf16(v0[2], v0[3]); w.z = cvt_pk_bf16(v1[0], v1[1]); w.w = cvt_pk_bf16(v1[2], v1[3]);
                    *(u32x4*)(rowp + bj * HALF) = w; } }
    }
};
struct EpiInProj {
    static constexpr bool PERM = true, AFTER_DRAIN = false;
    bf16_t* QKV; bf16_t* GZ; bf16_t* XBC; float* DT; const float* rope; const float* dt_bias;
    __device__ __forceinline__ void operator()(const f32x4 (&acc)[2][2][4][2], const Unit& u, int wr, int wc, int fr_in, int fq_in) const {
        int fr = fr_in, fq = fq_in; asm volatile("" : "+v"(fr), "+v"(fq));
        const int pn = u.pn, row0 = u.pm * BM + wr * 64 + fr, cin = wc * 32 + 8 * fq;
        if (pn < 8) {
            const int hd = pn & 3; const bool isk = pn >= 4;
            const float lg2 = __log2f(1.0f - exp2f(-5.0f - (float)hd));
#pragma unroll
            for (int ai = 0; ai < 2; ++ai)
#pragma unroll
                for (int m = 0; m < 4; ++m) { const int row = row0 + ai * HALF + m * 16, pos = row & 4095, r = pos & 127;
                    const float sc = isk ? exp2f(-(float)r * lg2) * 0.0625f : exp2f((float)r * lg2);
                    const f32x4* rp = (const f32x4*)(rope + ((size_t)pos * 128 + cin) * 2);
                    f32x4 o1[2], o2[2];
#pragma unroll
                    for (int n = 0; n < 2; ++n) { const f32x4 cs0 = rp[2 * n], cs1 = rp[2 * n + 1];
                        const f32x4 x1 = acc[ai][0][m][n], x2 = acc[ai][1][m][n];
                        const float c[4] = {cs0[0], cs0[2], cs1[0], cs1[2]}, s[4] = {cs0[1], cs0[3], cs1[1], cs1[3]};
#pragma unroll
                        for (int j = 0; j < 4; ++j) { o1[n][j] = (x1[j] * c[j] - x2[j] * s[j]) * sc; o2[n][j] = (x2[j] * c[j] + x1[j] * s[j]) * sc; } }
                    bf16_t* rowp = QKV + (size_t)row * 3072 + pn * 256 + cin;
                    u32x4 w; w.x = cvt_pk_bf16(o1[0][0], o1[0][1]); w.y = cvt_pk_bf16(o1[0][2], o1[0][3]); w.z = cvt_pk_bf16(o1[1][0], o1[1][1]); w.w = cvt_pk_bf16(o1[1][2], o1[1][3]);
                    *(u32x4*)rowp = w;
                    w.x = cvt_pk_bf16(o2[0][0], o2[0][1]); w.y = cvt_pk_bf16(o2[0][2], o2[0][3]); w.z = cvt_pk_bf16(o2[1][0], o2[1][1]); w.w = cvt_pk_bf16(o2[1][2], o2[1][3]);
                    *(u32x4*)(rowp + HALF) = w; }
        } else if (pn < 26) {
            bf16_t* base; int ldc, colt;
            if (pn < 12) { base = QKV; ldc = 3072; colt = pn * 256; } else if (pn < 20) { base = GZ; ldc = 2048; colt = (pn - 12) * 256; } else { base = XBC; ldc = 1536; colt = (pn - 20) * 256; }
#pragma unroll
            for (int ai = 0; ai < 2; ++ai)
#pragma unroll
                for (int m = 0; m < 4; ++m) { bf16_t* rowp = base + (size_t)(row0 + ai * HALF + m * 16) * ldc + colt + cin;
#pragma unroll
                    for (int bj = 0; bj < 2; ++bj) { const f32x4 v0 = acc[ai][bj][m][0], v1 = acc[ai][bj][m][1];
                        u32x4 w; w.x = cvt_pk_bf16(v0[0], v0[1]); w.y = cvt_pk_bf16(v0[2], v0[3]); w.z = cvt_pk_bf16(v1[0], v1[1]); w.w = cvt_pk_bf16(v1[2], v1[3]);
                        *(u32x4*)(rowp + bj * HALF) = w; } }
        } else {
            if (cin < 16) {
#pragma unroll
                for (int ai = 0; ai < 2; ++ai)
#pragma unroll
                    for (int m = 0; m < 4; ++m) { float* rowp = DT + (size_t)(row0 + ai * HALF + m * 16) * 16 + cin;
#pragma unroll
                        for (int n = 0; n < 2; ++n) { f32x4 o;
#pragma unroll
                            for (int j = 0; j < 4; ++j) { const float x = acc[ai][0][m][n][j] + dt_bias[cin + 4 * n + j]; o[j] = fmaxf(x > 20.f ? x : log1pf(__expf(x)), 1e-30f); }
                            *(f32x4*)(rowp + 4 * n) = o; } }
            }
        }
    }
};
template <class Epi, class Sched, bool ALIGN_EPI = false, bool SP2 = false>
__device__ __forceinline__ void gemm_phase(PG8_LAS unsigned char* lds, const Gemm g, const Sched& S, const Epi& E, const int tid) {
    const int wid = __builtin_amdgcn_readfirstlane(tid >> 6), lane = tid & 63, wr = wid >> 2, wc = wid & 3, fr = lane & 15, fq = lane >> 4;
    const int K = g.K, nt = K / BK;
    unsigned voffA[2], voffB[2];
#pragma unroll
    for (int i = 0; i < 2; ++i) { int R, C; stage_rc(tid * 16 + i * 8192, R, C); const int Rb = Epi::PERM ? ((R & ~31) + perm32(R & 31)) : R;
        voffA[i] = (unsigned)(R * K + C) * 2u; voffB[i] = (unsigned)(Rb * K + C) * 2u; }
    const size_t kstep = (size_t)(BK * 2);
    const size_t hstep = (size_t)HALF * K * 2;
    const size_t tstep = 2 * hstep;
    const unsigned ldsw = (unsigned)wid * 1024u;
    const int aoff = lds_byte(wr * 64 + fr, fq * 8), boff = lds_byte(wc * 32 + fr, fq * 8);
#define PG8_SA(b, h) (((b) * 2 + (h)) * HTB)
#define PG8_SB(b, h) ((4 + (b) * 2 + (h)) * HTB)
#define PG8_STAGE(bufoff, gbase, voff) do { _Pragma("unroll") for (int _i = 0; _i < 2; ++_i) \
        __builtin_amdgcn_global_load_lds((const unsigned*)((const char*)(gbase) + (voff)[_i]), (PG8_LAS unsigned*)(lds + (bufoff) + ldsw + _i * 8192), 16, 0, 0); } while (0)
#define PG8_LDA(dst, b, h) do { _Pragma("unroll") for (int m = 0; m < 4; ++m) _Pragma("unroll") for (int k = 0; k < 2; ++k) dst[m][k] = *(const PG8_LAS bf16x8*)(lds + PG8_SA(b, h) + aoff + m * 2048 + k * 1024); } while (0)
#define PG8_LDB(dst, b, h) do { _Pragma("unroll") for (int n = 0; n < 2; ++n) _Pragma("unroll") for (int k = 0; k < 2; ++k) dst[n][k] = *(const PG8_LAS bf16x8*)(lds + PG8_SB(b, h) + boff + n * 2048 + k * 1024); } while (0)
#define PG8_MMA(ai, bj, At, Bt) do { __builtin_amdgcn_s_setprio(1); _Pragma("unroll") for (int m = 0; m < 4; ++m) _Pragma("unroll") for (int n = 0; n < 2; ++n) _Pragma("unroll") for (int k = 0; k < 2; ++k) \
        acc[ai][bj][m][n] = __builtin_amdgcn_mfma_f32_16x16x32_bf16(Bt[n][k], At[m][k], acc[ai][bj][m][n], 0, 0, 0); __builtin_amdgcn_s_setprio(0); } while (0)
#define PG8_WAIT_V(n) asm volatile("s_waitcnt vmcnt(" #n ")" ::: "memory")
#define PG8_WAIT_L(n) asm volatile("s_waitcnt lgkmcnt(" #n ")" ::: "memory")
#define PG8_BAR __builtin_amdgcn_s_barrier()
#define PG8_SCHED __builtin_amdgcn_sched_barrier(0)
    Unit cur, nxt; int ui = 0;
    if (!S.next(0, cur)) return;
    f32x4 acc[2][2][4][2];
#pragma unroll
    for (int a = 0; a < 2; ++a)
#pragma unroll
        for (int b = 0; b < 2; ++b)
#pragma unroll
            for (int m = 0; m < 4; ++m)
#pragma unroll
                for (int n = 0; n < 2; ++n) acc[a][b][m][n] = (f32x4){0.f, 0.f, 0.f, 0.f};
    bf16x8 At[4][2], B0[2][2], B1[2][2];
    const char* cA = (const char*)g.A + (size_t)cur.pm * tstep; const char* cB = (const char*)g.Bt + (size_t)cur.pn * tstep;
    S.a_ready(cur);
    if constexpr (SP2) {
        PG8_STAGE(PG8_SB(0, 0), cB, voffB); PG8_STAGE(PG8_SB(0, 1), cB + hstep, voffB); PG8_STAGE(PG8_SA(0, 0), cA, voffA); PG8_STAGE(PG8_SA(0, 1), cA + hstep, voffA);
        if (wr == 1) PG8_BAR;
        PG8_WAIT_V(2); PG8_BAR;
        PG8_STAGE(PG8_SB(1, 0), cB + kstep, voffB); PG8_STAGE(PG8_SA(1, 0), cA + kstep, voffA); PG8_STAGE(PG8_SB(1, 1), cB + hstep + kstep, voffB);
        PG8_WAIT_V(6); PG8_BAR;
    } else {
        PG8_STAGE(PG8_SB(0, 0), cB, voffB); PG8_STAGE(PG8_SA(0, 0), cA, voffA); PG8_STAGE(PG8_SB(0, 1), cB + hstep, voffB); PG8_STAGE(PG8_SA(0, 1), cA + hstep, voffA);
        if (wr == 1) PG8_BAR;
        PG8_WAIT_V(4); PG8_BAR;
        PG8_STAGE(PG8_SB(1, 0), cB + kstep, voffB); PG8_STAGE(PG8_SA(1, 0), cA + kstep, voffA); PG8_STAGE(PG8_SB(1, 1), cB + hstep + kstep, voffB);
        PG8_WAIT_V(6); PG8_BAR;
    }
    for (;;) {
        const bool has_next = S.next(ui + 1, nxt);
        const char* nA = has_next ? (const char*)g.A + (size_t)nxt.pm * tstep : cA; const char* nB = has_next ? (const char*)g.Bt + (size_t)nxt.pn * tstep : cB;
        for (int t = 0; t < nt; t += 2) {
            const bool last = (t == nt - 2);
            const char* a1 = cA + (size_t)(t + 1) * kstep;
            const char* a2 = last ? nA : cA + (size_t)(t + 2) * kstep; const char* b2 = last ? nB : cB + (size_t)(t + 2) * kstep;
            const char* a3 = a2 + kstep; const char* b3 = b2 + kstep;
            if (last && has_next) S.a_ready(nxt);
            if constexpr (SP2) {
            PG8_LDB(B0, 0, 0); PG8_LDB(B1, 0, 1); PG8_SCHED; PG8_LDA(At, 0, 0); PG8_STAGE(PG8_SA(1, 1), a1 + hstep, voffA);
            PG8_WAIT_V(8); PG8_WAIT_L(0); PG8_BAR; PG8_MMA(0, 0, At, B0); PG8_MMA(0, 1, At, B1); PG8_BAR; PG8_SCHED;
            PG8_LDA(At, 0, 1); PG8_STAGE(PG8_SB(0, 0), b2, voffB); PG8_STAGE(PG8_SB(0, 1), b2 + hstep, voffB); PG8_STAGE(PG8_SA(0, 0), a2, voffA);
            PG8_WAIT_V(8); PG8_WAIT_L(0); PG8_BAR; PG8_MMA(1, 0, At, B0); PG8_MMA(1, 1, At, B1); PG8_BAR; PG8_SCHED;
            PG8_LDB(B0, 1, 0); PG8_LDB(B1, 1, 1); PG8_SCHED; PG8_LDA(At, 1, 0); PG8_STAGE(PG8_SA(0, 1), a2 + hstep, voffA);
            PG8_WAIT_V(8); PG8_WAIT_L(0); PG8_BAR; PG8_MMA(0, 0, At, B0); PG8_MMA(0, 1, At, B1); PG8_BAR; PG8_SCHED;
            PG8_LDA(At, 1, 1); PG8_STAGE(PG8_SB(1, 0), b3, voffB); PG8_STAGE(PG8_SB(1, 1), b3 + hstep, voffB); PG8_STAGE(PG8_SA(1, 0), a3, voffA);
            PG8_WAIT_V(8); PG8_WAIT_L(0); PG8_BAR; PG8_MMA(1, 0, At, B0); PG8_MMA(1, 1, At, B1); PG8_BAR; PG8_SCHED;
            } else {
            PG8_LDB(B0, 0, 0); PG8_SCHED; PG8_LDA(At, 0, 0); PG8_STAGE(PG8_SA(1, 1), a1 + hstep, voffA);
            PG8_WAIT_L(8); PG8_BAR; PG8_WAIT_L(0); PG8_MMA(0, 0, At, B0); PG8_BAR; PG8_SCHED;
            PG8_LDB(B1, 0, 1); PG8_STAGE(PG8_SB(0, 0), b2, voffB);
            PG8_BAR; PG8_WAIT_L(0); PG8_MMA(0, 1, At, B1); PG8_BAR;
            PG8_LDA(At, 0, 1); PG8_STAGE(PG8_SA(0, 0), a2, voffA);
            PG8_BAR; PG8_WAIT_L(0); PG8_MMA(1, 0, At, B0); PG8_BAR; PG8_SCHED;
            PG8_STAGE(PG8_SB(0, 1), b2 + hstep, voffB);
            PG8_WAIT_V(6); PG8_BAR; PG8_MMA(1, 1, At, B1); PG8_BAR;
            PG8_LDB(B0, 1, 0); PG8_SCHED; PG8_LDA(At, 1, 0); PG8_STAGE(PG8_SA(0, 1), a2 + hstep, voffA);
            PG8_WAIT_L(8); PG8_BAR; PG8_WAIT_L(0); PG8_MMA(0, 0, At, B0); PG8_BAR; PG8_SCHED;
            PG8_LDB(B1, 1, 1); PG8_STAGE(PG8_SB(1, 0), b3, voffB);
            PG8_BAR; PG8_WAIT_L(0); PG8_MMA(0, 1, At, B1); PG8_BAR;
            PG8_LDA(At, 1, 1); PG8_STAGE(PG8_SA(1, 0), a3, voffA);
            PG8_BAR; PG8_WAIT_L(0); PG8_MMA(1, 0, At, B0); PG8_BAR; PG8_SCHED;
            PG8_STAGE(PG8_SB(1, 1), b3 + hstep, voffB);
            PG8_WAIT_V(6); PG8_BAR; PG8_MMA(1, 1, At, B1); PG8_BAR;
            }
        }
        if constexpr (ALIGN_EPI) { if (wr == 0) PG8_BAR; }
        if constexpr (!Epi::AFTER_DRAIN) { E(acc, cur, wr, wc, fr, fq);
#if defined(REP_EPI) && REP_EPI == 2
            E(acc, cur, wr, wc, fr, fq);
#endif
            S.done(cur); }
        if (!has_next) break;
#pragma unroll
        for (int a = 0; a < 2; ++a)
#pragma unroll
            for (int b = 0; b < 2; ++b)
#pragma unroll
                for (int m = 0; m < 4; ++m)
#pragma unroll
                    for (int n = 0; n < 2; ++n) acc[a][b][m][n] = (f32x4){0.f, 0.f, 0.f, 0.f};
        cur = nxt; cA = nA; cB = nB; ++ui;
        if constexpr (ALIGN_EPI) { if (wr == 1) PG8_BAR; }
    }
    PG8_WAIT_V(0);
    if constexpr (!ALIGN_EPI) { if (wr == 0) PG8_BAR; }
    PG8_BAR;
    if constexpr (Epi::AFTER_DRAIN) { E.fused(acc, cur, wr, wc, fr, fq, lds, wid, lane); S.done(cur); }
#undef PG8_SA
#undef PG8_SB
#undef PG8_STAGE
#undef PG8_LDA
#undef PG8_LDB
#undef PG8_MMA
#undef PG8_WAIT_V
#undef PG8_WAIT_L
#undef PG8_BAR
#undef PG8_SCHED
}
}
constexpr int NWAVES = 8, NTHR = 512;
constexpr int BATCH = 4, SEQ = 4096, D = 1024, M = BATCH * SEQ, FF = 4096, DEPTH = 4;
constexpr int INP = 6672, INP_PAD = 6912;
constexpr float EPS = 1e-6f;
enum { I_X = 0, I_PRE_MIX, I_POST_MIX, I_PRE_MLP, I_POST_MLP, I_W_IN, I_CONV_W, I_CONV_B, I_DT_BIAS, I_A_LOG, I_D_SSD, I_SSD_NORM, I_W_OUT,
       I_LAM_RE, I_LAM_IM, I_LOG_STEP, I_B_RE, I_B_IM, I_C_RE, I_C_IM, I_D_S5, I_W_GLU_A, I_W_GLU_B, I_W_UP, I_W_DOWN, N_IN };
constexpr size_t MiB = 1u << 20;
constexpr size_t WS_CTL = 0, CTL_ZERO_BYTES = 64 * 1024;
constexpr size_t WS_MISC = 512 * 1024;
constexpr size_t WS_ROPE = 1 * MiB;
constexpr size_t WS_W4 = 5 * MiB;
constexpr size_t WS_SLOT16 = 9 * MiB;
constexpr size_t WS_SLOT32 = 25 * MiB;
constexpr size_t WS_QKV = 57 * MiB;
constexpr size_t WS_GZ = 153 * MiB;
constexpr size_t WS_XBC = 217 * MiB;
constexpr size_t WS_DT = 265 * MiB;
constexpr size_t WS_END = 266 * MiB;
constexpr size_t WS_M32A = 57 * MiB;
constexpr size_t WS_M32B = 185 * MiB;
constexpr size_t WS_U = 57 * MiB;
constexpr size_t WS_S5MAT = 57 * MiB;
constexpr size_t WS_S5E = 73 * MiB;
constexpr size_t WS_S5X = 105 * MiB;
constexpr size_t WS_Y = 121 * MiB;
constexpr int SCR_BYTES = 143360;
constexpr int MISC_OFF = SCR_BYTES;
constexpr int LDS_BYTES = 147456;

#define GAS __attribute__((address_space(1)))
#define LAS __attribute__((address_space(3)))
#define DI __device__ __forceinline__
typedef unsigned short bf16;
typedef unsigned v4u __attribute__((ext_vector_type(4)));
typedef unsigned v2u __attribute__((ext_vector_type(2)));
typedef float f32x4 __attribute__((ext_vector_type(4)));
typedef float f32x2v __attribute__((ext_vector_type(2)));
typedef short bf16x8 __attribute__((ext_vector_type(8)));
typedef short v4i16_t __attribute__((ext_vector_type(4)));
typedef GAS unsigned gu32;
#define RLX_AGENT __ATOMIC_RELAXED, __HIP_MEMORY_SCOPE_AGENT
#define LDS_WAIT() asm volatile("s_waitcnt lgkmcnt(0)" ::: "memory")
#define VM_WAIT() asm volatile("s_waitcnt vmcnt(0)" ::: "memory")
DI unsigned f2bf(float f) { unsigned u = __builtin_bit_cast(unsigned, f); return (u + 0x7fffu + ((u >> 16) & 1u)) >> 16; }
typedef __bf16 bf2_t __attribute__((ext_vector_type(2)));
DI unsigned pk2(float lo, float hi) { const f32x2v v = {lo, hi}; return __builtin_bit_cast(unsigned, __builtin_convertvector(v, bf2_t)); }
DI float bf2f(unsigned short b) { return __builtin_bit_cast(float, ((unsigned)b) << 16); }
DI float bflo(unsigned w) { return __builtin_bit_cast(float, w << 16); }
DI float bfhi(unsigned w) { return __builtin_bit_cast(float, w & 0xffff0000u); }
DI float wave_sum(float v) {
#pragma unroll
    for (int o = 1; o < 64; o <<= 1) v += __shfl_xor(v, o);
    return v;
}
DI float silu_f(float x) { return x * __builtin_amdgcn_rcpf(1.0f + __expf(-x)); }
DI void sincos_d(double x, double& s, double& c) {
    const double k = rint(x * 0.15915494309189533576888376337251);
    const double r = fma(-k, 6.283185307179586476925286766559, x), r2 = r * r;
    double ps = 1.0 / 1.0888869450418352e28, pc = 1.0 / 3.0488834461171384e29;
    const double fs[13] = {1.0 / 1.5511210043330986e25, 1.0 / 2.5852016738884978e22, 1.0 / 5.109094217170944e19, 1.0 / 1.21645100408832e17, 1.0 / 355687428096000.0, 1.0 / 1307674368000.0,
                           1.0 / 6227020800.0, 1.0 / 39916800.0, 1.0 / 362880.0, 1.0 / 5040.0, 1.0 / 120.0, 1.0 / 6.0, 1.0};
    const double fc[14] = {1.0 / 4.0329146112660565e26, 1.0 / 6.204484017332394e23, 1.0 / 1.1240007277776077e21, 1.0 / 2.43290200817664e18, 1.0 / 6402373705728000.0, 1.0 / 20922789888000.0,
                           1.0 / 87178291200.0, 1.0 / 479001600.0, 1.0 / 3628800.0, 1.0 / 40320.0, 1.0 / 720.0, 1.0 / 24.0, 1.0 / 2.0, 1.0};
#pragma unroll
    for (int i = 0; i < 13; ++i) ps = fs[i] - ps * r2;
#pragma unroll
    for (int i = 0; i < 14; ++i) pc = fc[i] - pc * r2;
    s = ps * r; c = pc;
}
#define XB_TMO      128
#define XB_XCNT(j)  (256  + 64 * (j))
#define XB_XSUB(j)  (1280 + 64 * (j))
#define XB_XGEN(j)  (2304 + 64 * (j))
#define XB_TOP      3328
#define XB_TOPGEN   3392
#define XCD_BAR_WORDS 3456
#define XB_SPIN_CAP (1u << 18)

__device__ __forceinline__ unsigned xb_ld(unsigned* p)              { return __hip_atomic_load(p, __ATOMIC_RELAXED, __HIP_MEMORY_SCOPE_AGENT); }
__device__ __forceinline__ unsigned xb_add(unsigned* p, unsigned v) { return __hip_atomic_fetch_add(p, v, __ATOMIC_RELAXED, __HIP_MEMORY_SCOPE_AGENT); }
__device__ __forceinline__ unsigned xb_xcc_id() { return (unsigned)__builtin_amdgcn_s_getreg((3 << 11) | 20) & 0xFu; }
#define XB_SPIN(cond, bar) do { unsigned _sp = 0; while (cond) { __builtin_amdgcn_s_sleep(1); \
    if ((++_sp & 255u) == 0u) { if (xb_ld(&(bar)[XB_TMO])) break; if (_sp > XB_SPIN_CAP) { atomicAdd(&(bar)[XB_TMO], 1u); break; } } } } while (0)

struct XcdBarrier {
    unsigned* bar; unsigned x; int tid;
    volatile LAS unsigned* st;
};

__device__ __forceinline__ XcdBarrier xcd_barrier_post(unsigned* bar, volatile LAS unsigned* st) {
    XcdBarrier b; b.bar = bar; b.x = xb_xcc_id(); b.st = st;
    if (threadIdx.x == 0) (void)xb_add(&bar[XB_XCNT(b.x)], 1u);
    return b;
}
__device__ __forceinline__ void xcd_barrier_complete(unsigned* bar, unsigned x, unsigned& nloc, unsigned& nx) {
    const unsigned G = gridDim.x * gridDim.y * gridDim.z;
    unsigned sum, cnt, mine, sp = 0u;
    for (;;) {
        sum = 0u; cnt = 0u; mine = 0u;
#pragma unroll
        for (unsigned j = 0; j < 16; ++j) { const unsigned c = xb_ld(&bar[XB_XCNT(j)]); sum += c; cnt += (c > 0u) ? 1u : 0u; mine = (j == x) ? c : mine; }
        if (sum == G) break;
        __builtin_amdgcn_s_sleep(1);
        if ((++sp & 255u) == 0u) { if (xb_ld(&bar[XB_TMO])) break; if (sp > XB_SPIN_CAP) { atomicAdd(&bar[XB_TMO], 1u); break; } }
    }
    nloc = mine > 0u ? mine : 1u; nx = cnt > 0u ? cnt : 1u;
}

__device__ __forceinline__ void xcd_barrier(const XcdBarrier& b) {
    asm volatile("s_waitcnt vmcnt(0)" ::: "memory");
    __syncthreads();
    if (b.tid == 0) {
        unsigned* bar = b.bar;
        __builtin_amdgcn_s_waitcnt(0);
        unsigned nloc = b.st[0], nx = b.st[1];
        if (nloc == 0u) { xcd_barrier_complete(bar, b.x, nloc, nx); b.st[0] = nloc; b.st[1] = nx; }
        const unsigned old = xb_add(&bar[XB_XSUB(b.x)], 1u);
        const unsigned gen = old / nloc;
        if (old + 1u == (gen + 1u) * nloc) {
            __builtin_amdgcn_fence(__ATOMIC_RELEASE, "agent");
            asm volatile("s_waitcnt vmcnt(0)" ::: "memory");
            const unsigned og = xb_add(&bar[XB_TOP], 1u);
            const unsigned tg = og / nx;
            if (og + 1u == (tg + 1u) * nx) xb_add(&bar[XB_TOPGEN], 1u);
            else XB_SPIN(xb_ld(&bar[XB_TOPGEN]) == tg, bar);
            __builtin_amdgcn_fence(__ATOMIC_ACQUIRE, "agent");
            xb_add(&bar[XB_XGEN(b.x)], 1u);
            asm volatile("s_waitcnt vmcnt(0)" ::: "memory");
        } else {
            XB_SPIN(xb_ld(&bar[XB_XGEN(b.x)]) == gen, bar);
            __builtin_amdgcn_fence(__ATOMIC_ACQUIRE, "agent");
            asm volatile("s_waitcnt vmcnt(0)" ::: "memory");
        }
    }
    __syncthreads();
}

struct Frame {
    LAS unsigned char* lds;
    int tid, lane, wave, G, bid, vcu;
    float* out; unsigned char* ws;
};
DI unsigned long long lds_ptr(const Frame& F, int i) {
    unsigned a_ = (unsigned)(size_t)(F.lds + MISC_OFF + 256) + 8u * (unsigned)i; asm volatile("" : "+v"(a_));
    const unsigned long long v = *(const volatile LAS unsigned long long*)a_;
    const unsigned lo = __builtin_amdgcn_readfirstlane((unsigned)v), hi = __builtin_amdgcn_readfirstlane((unsigned)(v >> 32));
    return ((unsigned long long)hi << 32) | lo;
}
#define INP(i) ((const float*)(const GAS float*)lds_ptr(F, (i)))
DI int gwave(const Frame& F) { return F.bid * NWAVES + F.wave; }

DI bf16x8 frag_rm(const LAS unsigned char* t, int S, int r0, int k0, int lane) { return *(const LAS bf16x8*)(t + (r0 + (lane & 15)) * S + (k0 + 8 * (lane >> 4)) * 2); }
DI bf16x8 frag_tr(const LAS unsigned char* t, int S, int r0, int k0, int lane) {
    const int g = lane >> 4, q = (lane & 15) >> 2, p = lane & 3;
    const LAS unsigned char* a = t + (k0 + 8 * g + q) * S + (r0 + 4 * p) * 2;
    const v4i16_t lo = __builtin_amdgcn_ds_read_tr16_b64_v4i16((LAS v4i16_t*)a);
    const v4i16_t hi = __builtin_amdgcn_ds_read_tr16_b64_v4i16((LAS v4i16_t*)(a + 4 * S));
    return __builtin_shufflevector(lo, hi, 0, 1, 2, 3, 4, 5, 6, 7);
}
DI f32x4 mma(bf16x8 a, bf16x8 b, f32x4 c) { return __builtin_amdgcn_mfma_f32_16x16x32_bf16(a, b, c, 0, 0, 0); }

DI void load_tile(LAS unsigned char* dst, int S, const bf16* src, size_t ld, int rows, int cols, int tid) {
    const int cpr = cols >> 3, n = rows * cpr;
    for (int i = tid; i < n; i += NTHR) { const int r = i / cpr, c = i - r * cpr;
        *(LAS v4u*)(dst + r * S + c * 16) = *(const v4u*)(src + (size_t)r * ld + c * 8); }
}

template <int COLS> DI unsigned tile_loff(int tid, unsigned ld) { constexpr int CPR = COLS / 8; return (unsigned)(tid / CPR) * ld + (unsigned)(tid % CPR) * 8u; }
template <int ROWS, int COLS> DI void tile_issue(v4u* r, const bf16* src, unsigned ld, unsigned loff) {
    constexpr int CPR = COLS / 8, N = ROWS * COLS / 4096, RSTEP = NTHR / CPR;
#pragma unroll
    for (int i = 0; i < N; ++i) r[i] = *(const v4u*)((src + (size_t)i * RSTEP * ld) + loff);
}
template <int ROWS, int COLS> DI void tile_commit(const v4u* r, LAS unsigned char* dst, int S, int tid) {
    constexpr int CPR = COLS / 8, N = ROWS * COLS / 4096, RSTEP = NTHR / CPR;
    LAS unsigned char* p = dst + (tid / CPR) * S + (tid % CPR) * 16;
#pragma unroll
    for (int i = 0; i < N; ++i) *(LAS v4u*)(p + i * RSTEP * S) = r[i];
}

DI void transpose_item(const float* W, int K, int N, bf16* WT, int mode, LAS float* scr, int item, int lane) {
    const int nblk = (N + 31) / 32, kb = item / nblk, nb = item % nblk, k0 = 64 * kb, n0 = 32 * nb;
    const int n4 = 4 * (lane & 7), nl = n0 + n4;
    f32x4 v[8];
#pragma unroll
    for (int i = 0; i < 8; ++i) v[i] = nl < N ? *(const f32x4*)(W + (size_t)(k0 + 8 * i + (lane >> 3)) * N + nl) : (f32x4){0.f, 0.f, 0.f, 0.f};
#pragma unroll
    for (int i = 0; i < 8; ++i) { LAS float* d = scr + (8 * i + (lane >> 3)) * 33 + n4; d[0] = v[i][0]; d[1] = v[i][1]; d[2] = v[i][2]; d[3] = v[i][3]; }
    LDS_WAIT(); asm volatile("" ::: "memory");
    const int c = lane & 7;
#pragma unroll
    for (int j = 0; j < 4; ++j) { const int n = (lane >> 3) + 8 * j; const LAS float* s = scr + (8 * c) * 33 + n;
        v4u o; o.x = pk2(s[0 * 33], s[1 * 33]); o.y = pk2(s[2 * 33], s[3 * 33]); o.z = pk2(s[4 * 33], s[5 * 33]); o.w = pk2(s[6 * 33], s[7 * 33]);
        const int ng = n0 + n; const int row = mode == 0 ? ng : (256 * (ng >> 7) + (ng & 127) + (mode == 2 ? 128 : 0));
        *(v4u*)(WT + (size_t)row * K + k0 + 8 * c) = o; }
    LDS_WAIT(); asm volatile("" ::: "memory");
}
DI void convert_weight(Frame& F, const float* W, int K, int N, bf16* WT, int mode, int w0 = 0) {
    if (F.wave < w0) return;
    LAS float* scr = (LAS float*)(F.lds + F.wave * 16384);
    const int nw = NWAVES - w0, nitems = (K / 64) * ((N + 31) / 32), NGW = F.G * nw;
    for (int it = F.bid * nw + (F.wave - w0); it < nitems; it += NGW) transpose_item(W, K, N, WT, mode, scr, it, F.lane);
}
DI void zero_fill(Frame& F, void* p, size_t bytes) {
    v4u* q = (v4u*)p; const size_t n = bytes / 16;
    for (size_t i = (size_t)F.bid * NTHR + F.tid; i < n; i += (size_t)F.G * NTHR) q[i] = (v4u){0u, 0u, 0u, 0u};
}

DI void build_rope(Frame& F) {
    float* rope = (float*)(F.ws + WS_ROPE);
    for (int i = F.bid * NTHR + F.tid; i < 4096 * 128; i += F.G * NTHR) { const int pos = i >> 7, d = i & 127;
        double inv = 1.0; { double r = 0.930572040929699; int e = d; while (e) { if (e & 1) inv *= r; r *= r; e >>= 1; } }
        const float ang = (float)pos * (float)inv;
        double s, c; sincos_d((double)ang, s, c);
        *(f32x2v*)(rope + 2 * (size_t)i) = (f32x2v){(float)c, (float)s}; }
}
DI void rms_rows_to_bf16(Frame& F, const float* src, const float* w, bf16* dst) {
    const int NGW = F.G * NWAVES;
    f32x4 wv[4];
#pragma unroll
    for (int j = 0; j < 4; ++j) wv[j] = ((const f32x4*)w)[F.lane + 64 * j];
    for (int m = gwave(F); m < M; m += NGW) { const f32x4* xr = (const f32x4*)(src + (size_t)m * D) + F.lane;
        f32x4 v[4]; float s = 0.f;
#pragma unroll
        for (int j = 0; j < 4; ++j) { v[j] = xr[64 * j]; s += (v[j].x * v[j].x + v[j].y * v[j].y) + (v[j].z * v[j].z + v[j].w * v[j].w); }
        const float rs = rsqrtf(wave_sum(s) * (1.f / D) + EPS);
        v2u* o8 = (v2u*)(dst + (size_t)m * D) + F.lane;
#pragma unroll
        for (int j = 0; j < 4; ++j) { const f32x4 y = v[j] * rs * wv[j]; o8[64 * j] = (v2u){pk2(y.x, y.y), pk2(y.z, y.w)}; } }
}
template <bool IN_F32, bool OUT_F32>
DI void row_phase(Frame& F, const bf16* mbuf, const void* hbase, void* hout, const float* w_post, const float* w_pre, bf16* hn) {
    const int NGW = F.G * NWAVES;
    f32x4 wp[4], wq[4];
#pragma unroll
    for (int j = 0; j < 4; ++j) { wp[j] = ((const f32x4*)w_post)[F.lane + 64 * j]; wq[j] = w_pre ? ((const f32x4*)w_pre)[F.lane + 64 * j] : (f32x4){0.f, 0.f, 0.f, 0.f}; }
    for (int m = gwave(F); m < M; m += NGW) {
        const v2u* mr = (const v2u*)(mbuf + (size_t)m * D) + F.lane;
        f32x4 v[4], h[4]; float s = 0.f;
#pragma unroll
        for (int j = 0; j < 4; ++j) { const v2u mv = mr[64 * j]; v[j] = (f32x4){bflo(mv.x), bfhi(mv.x), bflo(mv.y), bfhi(mv.y)};
            if (IN_F32) h[j] = ((const f32x4*)((const float*)hbase + (size_t)m * D) + F.lane)[64 * j];
            else { const v2u hv = ((const v2u*)((const bf16*)hbase + (size_t)m * 2048) + F.lane)[64 * j]; h[j] = (f32x4){bflo(hv.x), bfhi(hv.x), bflo(hv.y), bfhi(hv.y)}; }
            s += (v[j].x * v[j].x + v[j].y * v[j].y) + (v[j].z * v[j].z + v[j].w * v[j].w); }
        const float rs = rsqrtf(wave_sum(s) * (1.f / D) + EPS); float s2 = 0.f;
#pragma unroll
        for (int j = 0; j < 4; ++j) { h[j] = h[j] + v[j] * rs * wp[j]; s2 += (h[j].x * h[j].x + h[j].y * h[j].y) + (h[j].z * h[j].z + h[j].w * h[j].w); }
        if (OUT_F32) { f32x4* ho = (f32x4*)((float*)hout + (size_t)m * D) + F.lane;
#pragma unroll
            for (int j = 0; j < 4; ++j) ho[64 * j] = h[j]; }
        else { v2u* ho = (v2u*)((bf16*)hout + (size_t)m * 2048) + F.lane;
#pragma unroll
            for (int j = 0; j < 4; ++j) ho[64 * j] = (v2u){pk2(h[j].x, h[j].y), pk2(h[j].z, h[j].w)}; }
        if (hn) { const float rs2 = rsqrtf(wave_sum(s2) * (1.f / D) + EPS);
            v2u* o8 = (v2u*)(hn + (size_t)m * D) + F.lane;
#pragma unroll
            for (int j = 0; j < 4; ++j) { const f32x4 y = h[j] * rs2 * wq[j]; o8[64 * j] = (v2u){pk2(y.x, y.y), pk2(y.z, y.w)}; } }
    }
}

DI float head_lg2(int h) { return __log2f(1.0f - exp2f(-5.0f - (float)h)); }

DI void ret_passA_unit(Frame& F, int unit) {
    const bf16* QKV = (const bf16*)(F.ws + WS_QKV); bf16* RST = (bf16*)(F.ws + WS_SLOT16);
    const int eh = unit & 1, sc = (unit >> 1) & 7, h = (unit >> 4) & 3, b = unit >> 6;
    const int lane = F.lane, w = F.wave, we = w >> 2, wd = w & 3;
    const float lg2 = head_lg2(h), g128 = exp2f(128.f * lg2), g127 = exp2f(127.f * lg2);
    LAS unsigned char* Kt = F.lds;
    LAS unsigned char* Vt = F.lds + 128 * 544;
    f32x4 acc[4][4];
#pragma unroll
    for (int a = 0; a < 4; ++a)
#pragma unroll
        for (int c = 0; c < 4; ++c) acc[a][c] = (f32x4){0.f, 0.f, 0.f, 0.f};
    v4u TK[8], TV[4];
    const unsigned lo_k = tile_loff<256>(F.tid, 3072), lo_v = tile_loff<128>(F.tid, 3072);
    const bf16* kbase = QKV + ((size_t)b * SEQ + sc * 512) * 3072 + 1024 + h * 256; const bf16* vbase = kbase + 1024 + eh * 128;
    tile_issue<128, 256>(TK, kbase, 3072, lo_k); tile_issue<128, 128>(TV, vbase, 3072, lo_v);
#pragma unroll 1
    for (int j = 0; j < 4; ++j) {
        if (j) {
#pragma unroll
            for (int a = 0; a < 4; ++a)
#pragma unroll
                for (int c = 0; c < 4; ++c) acc[a][c] *= g128; }
        __syncthreads();
        tile_commit<128, 256>(TK, Kt, 544, F.tid); tile_commit<128, 128>(TV, Vt, 288, F.tid);
        if (j < 3) { tile_issue<128, 256>(TK, kbase + (size_t)(j + 1) * 128 * 3072, 3072, lo_k); tile_issue<128, 128>(TV, vbase + (size_t)(j + 1) * 128 * 3072, 3072, lo_v); }
        __syncthreads();
#pragma unroll
        for (int ks = 0; ks < 4; ++ks) {
            bf16x8 vf[4], kf[4];
#pragma unroll
            for (int t = 0; t < 4; ++t) { vf[t] = frag_tr(Vt, 288, we * 64 + t * 16, ks * 32, lane); kf[t] = frag_tr(Kt, 544, wd * 64 + t * 16, ks * 32, lane); }
#pragma unroll
            for (int et = 0; et < 4; ++et)
#pragma unroll
                for (int dt = 0; dt < 4; ++dt) acc[et][dt] = mma(kf[dt], vf[et], acc[et][dt]);
        }
    }
    bf16* dst = RST + ((size_t)((b * 4 + h) * 8 + sc) * 256) * 256;
#pragma unroll
    for (int et = 0; et < 4; ++et)
#pragma unroll
        for (int dt = 0; dt < 4; ++dt) { const int e = eh * 128 + we * 64 + et * 16 + (lane & 15), d = wd * 64 + dt * 16 + 4 * (lane >> 4);
            const f32x4 v = acc[et][dt] * g127;
            *(v2u*)(dst + (size_t)e * 256 + d) = (v2u){pk2(v[0], v[1]), pk2(v[2], v[3])}; }
}

DI void ret_scan_item(Frame& F, int item) {
    bf16* RST = (bf16*)(F.ws + WS_SLOT16);
    const int bh = item >> 13, off = (item & 8191) * 8, h = bh & 3;
    const float g512 = exp2f(512.f * head_lg2(h));
    float run[8]; float zf = 0.f; asm volatile("" : "+v"(zf));
#pragma unroll
    for (int k = 0; k < 8; ++k) run[k] = zf;
    v4u* base = (v4u*)(RST + (size_t)(bh * 8) * 65536 + off);
    v4u in[8];
#pragma unroll
    for (int sc = 0; sc < 8; ++sc) in[sc] = base[(size_t)sc * 8192];
#pragma unroll
    for (int sc = 0; sc < 8; ++sc) {
        v4u o; o.x = pk2(run[0], run[1]); o.y = pk2(run[2], run[3]); o.z = pk2(run[4], run[5]); o.w = pk2(run[6], run[7]);
        base[(size_t)sc * 8192] = o;
        const unsigned cw[4] = {in[sc].x, in[sc].y, in[sc].z, in[sc].w};
#pragma unroll
        for (int k = 0; k < 4; ++k) { run[2 * k] = g512 * run[2 * k] + bflo(cw[k]); run[2 * k + 1] = g512 * run[2 * k + 1] + bfhi(cw[k]); }
    }
}

DI void ret_passC_unit(Frame& F, int unit, bf16* YO) {
    const bf16* QKV = (const bf16*)(F.ws + WS_QKV); const bf16* RST = (const bf16*)(F.ws + WS_SLOT16); const bf16* GZ = (const bf16*)(F.ws + WS_GZ);
    const int qp = unit & 1, sc = (unit >> 1) & 7, h = (unit >> 4) & 3, b = unit >> 6;
    const int lane = F.lane, w = F.wave, wn = w >> 2, we = w & 3, wm = w & 3;
    const float lg2 = head_lg2(h), g1 = exp2f(lg2), g128 = exp2f(128.f * lg2);
    LAS unsigned char* Qt = F.lds;
    LAS unsigned char* KV = F.lds + 33792;
    LAS unsigned char* Pt = F.lds + 33792 + 69632;
    LAS float* red = (LAS float*)(F.lds + 33792 + 69632 + 17408);
    const size_t rowsc = (size_t)b * SEQ + sc * 512;
    const bf16* Rbase = RST + (size_t)((b * 4 + h) * 8 + sc) * 65536;
    v4u T[8], TQ[4];
    const unsigned lo_kv = tile_loff<256>(F.tid, 3072), lo_r = tile_loff<64>(F.tid, 256);
    tile_issue<64, 256>(TQ, QKV + (rowsc + (qp == 0 ? 0 : 1) * 128) * 3072 + h * 256, 3072, lo_kv);
    tile_issue<256, 64>(T, Rbase, 256, lo_r);
#pragma unroll 1
    for (int qi = 0; qi < 2; ++qi) {
        const int i = qp == 0 ? (qi == 0 ? 0 : 3) : (qi == 0 ? 1 : 2);
#pragma unroll 1
        for (int hh = 0; hh < 2; ++hh) {
            const size_t grow0 = rowsc + i * 128 + hh * 64;
            f32x4 Y[2][4];
#pragma unroll
            for (int a = 0; a < 2; ++a)
#pragma unroll
                for (int c = 0; c < 4; ++c) Y[a][c] = (f32x4){0.f, 0.f, 0.f, 0.f};
            __syncthreads();
            tile_commit<64, 256>(TQ, Qt, 528, F.tid);
#pragma unroll 1
            for (int ds = 0; ds < 4; ++ds) {
                if (ds) __syncthreads();
                tile_commit<256, 64>(T, KV, 144, F.tid);
                if (ds < 3) tile_issue<256, 64>(T, Rbase + (ds + 1) * 64, 256, lo_r);
                else tile_issue<128, 256>(T, QKV + rowsc * 3072 + 1024 + h * 256, 3072, lo_kv);
                __syncthreads();
#pragma unroll
                for (int ks = 0; ks < 2; ++ks) {
                    bf16x8 qf[2], rf[4];
#pragma unroll
                    for (int t = 0; t < 2; ++t) qf[t] = frag_rm(Qt, 528, wn * 32 + t * 16, ds * 64 + ks * 32, lane);
#pragma unroll
                    for (int t = 0; t < 4; ++t) rf[t] = frag_rm(KV, 144, we * 64 + t * 16, ks * 32, lane);
#pragma unroll
                    for (int nt = 0; nt < 2; ++nt)
#pragma unroll
                        for (int et = 0; et < 4; ++et) Y[nt][et] = mma(rf[et], qf[nt], Y[nt][et]);
                }
            }
#pragma unroll
            for (int a = 0; a < 2; ++a)
#pragma unroll
                for (int c = 0; c < 4; ++c) Y[a][c] *= g1;
#pragma unroll 1
            for (int j = 0; j <= i; ++j) {
                if (j) {
#pragma unroll
                    for (int a = 0; a < 2; ++a)
#pragma unroll
                        for (int c = 0; c < 4; ++c) Y[a][c] *= g128; }
                const size_t rowj = rowsc + j * 128;
                __syncthreads();
                tile_commit<128, 256>(T, KV, 528, F.tid);
                tile_issue<128, 256>(T, QKV + rowj * 3072 + 2048 + h * 256, 3072, lo_kv);
                __syncthreads();
                f32x4 sa[2][2];
#pragma unroll
                for (int a = 0; a < 2; ++a)
#pragma unroll
                    for (int c = 0; c < 2; ++c) sa[a][c] = (f32x4){0.f, 0.f, 0.f, 0.f};
#pragma unroll
                for (int ks = 0; ks < 8; ++ks) {
                    bf16x8 qf[2], kf[2];
#pragma unroll
                    for (int t = 0; t < 2; ++t) { qf[t] = frag_rm(Qt, 528, wn * 32 + t * 16, ks * 32, lane); kf[t] = frag_rm(KV, 528, wm * 32 + t * 16, ks * 32, lane); }
#pragma unroll
                    for (int nt = 0; nt < 2; ++nt)
#pragma unroll
                        for (int mt = 0; mt < 2; ++mt) sa[nt][mt] = mma(kf[mt], qf[nt], sa[nt][mt]);
                }
#pragma unroll
                for (int nt = 0; nt < 2; ++nt)
#pragma unroll
                    for (int mt = 0; mt < 2; ++mt) { const int n = wn * 32 + nt * 16 + (lane & 15), m = wm * 32 + mt * 16 + 4 * (lane >> 4);
                        f32x4 s = sa[nt][mt];
                        if (j == i) { const int nb = hh * 64 + n;
#pragma unroll
                            for (int jj = 0; jj < 4; ++jj) if (m + jj > nb) s[jj] = 0.f; }
                        *(LAS v2u*)(Pt + n * 272 + m * 2) = (v2u){pk2(s[0], s[1]), pk2(s[2], s[3])}; }
                __syncthreads();
                tile_commit<128, 256>(T, KV, 544, F.tid);
                if (j < i) tile_issue<128, 256>(T, QKV + (rowj + 128) * 3072 + 1024 + h * 256, 3072, lo_kv);
                else { const bool more = !(qi == 1 && hh == 1);
                    const int i2 = hh == 0 ? i : (qp == 0 ? 3 : 2), hh2 = hh ^ 1;
                    if (more) { tile_issue<64, 256>(TQ, QKV + (rowsc + i2 * 128 + hh2 * 64) * 3072 + h * 256, 3072, lo_kv); tile_issue<256, 64>(T, Rbase, 256, lo_r); } }
                __syncthreads();
#pragma unroll
                for (int ks = 0; ks < 4; ++ks) {
                    bf16x8 pf[2], vf[4];
#pragma unroll
                    for (int t = 0; t < 2; ++t) pf[t] = frag_rm(Pt, 272, wn * 32 + t * 16, ks * 32, lane);
#pragma unroll
                    for (int t = 0; t < 4; ++t) vf[t] = frag_tr(KV, 544, we * 64 + t * 16, ks * 32, lane);
#pragma unroll
                    for (int nt = 0; nt < 2; ++nt)
#pragma unroll
                        for (int et = 0; et < 4; ++et) Y[nt][et] = mma(vf[et], pf[nt], Y[nt][et]);
                }
            }
            float mean[2], rstd[2];
#pragma unroll
            for (int nt = 0; nt < 2; ++nt) { float s = 0.f;
#pragma unroll
                for (int et = 0; et < 4; ++et) s += (Y[nt][et][0] + Y[nt][et][1]) + (Y[nt][et][2] + Y[nt][et][3]);
                s += __shfl_xor(s, 16); s += __shfl_xor(s, 32);
                if ((lane >> 4) == 0) red[(wn * 32 + nt * 16 + lane) * 4 + we] = s; }
            __syncthreads();
#pragma unroll
            for (int nt = 0; nt < 2; ++nt) { const LAS float* r = red + (wn * 32 + nt * 16 + (lane & 15)) * 4; mean[nt] = ((r[0] + r[1]) + (r[2] + r[3])) * (1.f / 256.f); }
            __syncthreads();
#pragma unroll
            for (int nt = 0; nt < 2; ++nt) { float s = 0.f;
#pragma unroll
                for (int et = 0; et < 4; ++et) { const f32x4 dv = Y[nt][et] - mean[nt]; s += (dv[0] * dv[0] + dv[1] * dv[1]) + (dv[2] * dv[2] + dv[3] * dv[3]); }
                s += __shfl_xor(s, 16); s += __shfl_xor(s, 32);
                if ((lane >> 4) == 0) red[(wn * 32 + nt * 16 + lane) * 4 + we] = s; }
            __syncthreads();
#pragma unroll
            for (int nt = 0; nt < 2; ++nt) { const LAS float* r = red + (wn * 32 + nt * 16 + (lane & 15)) * 4; rstd[nt] = rsqrtf(((r[0] + r[1]) + (r[2] + r[3])) * (1.f / 256.f) + EPS); }
#pragma unroll
            for (int nt = 0; nt < 2; ++nt)
#pragma unroll
                for (int et = 0; et < 4; ++et) { const int n = wn * 32 + nt * 16 + (lane & 15), e = we * 64 + et * 16 + 4 * (lane >> 4);
                    const bf16* gp = GZ + (grow0 + n) * 2048 + h * 256 + e;
                    const v2u gv = *(const v2u*)gp;
                    const f32x4 y = (Y[nt][et] - mean[nt]) * rstd[nt];
                    const float o0 = y[0] * silu_f(bflo(gv.x)), o1 = y[1] * silu_f(bfhi(gv.x)), o2 = y[2] * silu_f(bflo(gv.y)), o3 = y[3] * silu_f(bfhi(gv.y));
                    *(v2u*)(YO + (gp - GZ)) = (v2u){pk2(o0, o1), pk2(o2, o3)}; }
        }
    }
}

struct SsdPar { const float* conv_w; const float* conv_b; const float* a_log; const float* d_ssd; const float* ssd_norm; };

struct ConvW { f32x4 w[4][2]; f32x4 b[2]; };
DI ConvW load_convw(const float* cw, const float* cb, int col) { ConvW W;
#pragma unroll
    for (int k = 0; k < 4; ++k) { W.w[k][0] = *(const f32x4*)(cw + k * 1536 + col); W.w[k][1] = *(const f32x4*)(cw + k * 1536 + col + 4); }
    W.b[0] = *(const f32x4*)(cb + col); W.b[1] = *(const f32x4*)(cb + col + 4); return W; }
DI void conv8(const bf16* XBC, const ConvW& W, size_t row, int col, float (&o)[8]) {
    const int tin = (int)(row & 4095);
    o[0] = W.b[0][0]; o[1] = W.b[0][1]; o[2] = W.b[0][2]; o[3] = W.b[0][3]; o[4] = W.b[1][0]; o[5] = W.b[1][1]; o[6] = W.b[1][2]; o[7] = W.b[1][3];
#pragma unroll
    for (int k = 0; k < 4; ++k) {
        if (tin - 3 + k >= 0) {
            const v4u x = *(const v4u*)(XBC + (row - 3 + k) * 1536 + col);
            const f32x4 w0 = W.w[k][0], w1 = W.w[k][1];
            o[0] += w0[0] * bflo(x.x); o[1] += w0[1] * bfhi(x.x); o[2] += w0[2] * bflo(x.y); o[3] += w0[3] * bfhi(x.y);
            o[4] += w1[0] * bflo(x.z); o[5] += w1[1] * bfhi(x.z); o[6] += w1[2] * bflo(x.w); o[7] += w1[3] * bfhi(x.w);
        }
    }
#pragma unroll
    for (int k = 0; k < 8; ++k) o[k] = silu_f(o[k]);
}
DI void conv8r(const v4u (&x)[4], const ConvW& W, int tin, float (&o)[8]) {
    o[0] = W.b[0][0]; o[1] = W.b[0][1]; o[2] = W.b[0][2]; o[3] = W.b[0][3]; o[4] = W.b[1][0]; o[5] = W.b[1][1]; o[6] = W.b[1][2]; o[7] = W.b[1][3];
#pragma unroll
    for (int k = 0; k < 4; ++k) {
        if (tin - 3 + k >= 0) { const f32x4 w0 = W.w[k][0], w1 = W.w[k][1];
            o[0] += w0[0] * bflo(x[k].x); o[1] += w0[1] * bfhi(x[k].x); o[2] += w0[2] * bflo(x[k].y); o[3] += w0[3] * bfhi(x[k].y);
            o[4] += w1[0] * bflo(x[k].z); o[5] += w1[1] * bfhi(x[k].z); o[6] += w1[2] * bflo(x[k].w); o[7] += w1[3] * bfhi(x[k].w); }
    }
#pragma unroll
    for (int k = 0; k < 8; ++k) o[k] = silu_f(o[k]);
}
template <int NR, class Fn> DI void conv_rows(const bf16* XBC, const ConvW& W, size_t row0, int col, Fn&& emit) {
    const int tin0 = (int)(row0 & 4095);
    v4u x[NR + 3];
#pragma unroll
    for (int i = 0; i < NR + 3; ++i) x[i] = (tin0 + i - 3 >= 0) ? *(const v4u*)(XBC + (row0 + i - 3) * 1536 + col) : (v4u){0u, 0u, 0u, 0u};
#pragma unroll
    for (int r = 0; r < NR; ++r) { float o[8];
        o[0] = W.b[0][0]; o[1] = W.b[0][1]; o[2] = W.b[0][2]; o[3] = W.b[0][3]; o[4] = W.b[1][0]; o[5] = W.b[1][1]; o[6] = W.b[1][2]; o[7] = W.b[1][3];
#pragma unroll
        for (int k = 0; k < 4; ++k) { const v4u xv = x[r + k]; const f32x4 w0 = W.w[k][0], w1 = W.w[k][1];
            o[0] += w0[0] * bflo(xv.x); o[1] += w0[1] * bfhi(xv.x); o[2] += w0[2] * bflo(xv.y); o[3] += w0[3] * bfhi(xv.y);
            o[4] += w1[0] * bflo(xv.z); o[5] += w1[1] * bfhi(xv.z); o[6] += w1[2] * bflo(xv.w); o[7] += w1[3] * bfhi(xv.w); }
#pragma unroll
        for (int k = 0; k < 8; ++k) o[k] = silu_f(o[k]);
        emit(r, o); }
}
DI v4u pack8(const float (&o)[8], float s) { v4u r; r.x = pk2(o[0] * s, o[1] * s); r.y = pk2(o[2] * s, o[3] * s); r.z = pk2(o[4] * s, o[5] * s); r.w = pk2(o[6] * s, o[7] * s); return r; }

DI float ssd_cumsum(const float* DT, const float* a_log, size_t t0, int grp, int w, int lane, LAS float* cs, LAS float* dtl = nullptr) {
    const int head = grp * 8 + w; const float A = -__expf(a_log[head]);
    const float d0 = DT[(t0 + 2 * lane) * 16 + head], d1 = DT[(t0 + 2 * lane + 1) * 16 + head], v0 = d0 * A, v1 = d1 * A;
    if (dtl) { dtl[w * 128 + 2 * lane] = d0; dtl[w * 128 + 2 * lane + 1] = d1; }
    float x = v0 + v1;
#pragma unroll
    for (int o = 1; o < 64; o <<= 1) { const float t = __shfl_up(x, o); if (lane >= o) x += t; }
    cs[w * 128 + 2 * lane] = x - v1; cs[w * 128 + 2 * lane + 1] = x;
    return __shfl(x, 63);
}

DI void ssd_passA_unit(Frame& F, const SsdPar& P, int unit) {
    const bf16* XBC = (const bf16*)(F.ws + WS_XBC); const float* DT = (const float*)(F.ws + WS_DT);
    bf16* ST = (bf16*)(F.ws + WS_SLOT32); float* CDEC = (float*)(F.ws + WS_MISC);
    const int grp = unit & 1, c = (unit >> 1) & 31, b = unit >> 6;
    const int lane = F.lane, w = F.wave;
    const size_t t0 = (size_t)b * SEQ + c * 128;
    LAS float* cs = (LAS float*)F.lds;
    LAS float* csend = (LAS float*)(F.lds + 4096);
    LAS unsigned char* Bt = F.lds + 4352;
    LAS unsigned char* Xw = F.lds + 4352 + 36864;
    __syncthreads();
    { const float tot = ssd_cumsum(DT, P.a_log, t0, grp, w, lane, cs);
      if (lane == 0) { csend[w] = tot; CDEC[(b * 32 + c) * 16 + grp * 8 + w] = __expf(tot); } }
    { const int cc = F.tid & 15, rb = F.tid >> 4; const ConvW W = load_convw(P.conv_w, P.conv_b, 1024 + grp * 128 + cc * 8);
      conv_rows<4>(XBC, W, t0 + 4 * rb, 1024 + grp * 128 + cc * 8, [&](int r, const float (&o)[8]) { *(LAS v4u*)(Bt + (4 * rb + r) * 288 + cc * 16) = pack8(o, 1.0f); }); }
    for (int hg = 0; hg < 2; ++hg) {
        __syncthreads();
        { const int cc = F.tid & 31, rb = F.tid >> 5, hd = hg * 4 + (cc >> 3); const ConvW W = load_convw(P.conv_w, P.conv_b, grp * 512 + hg * 256 + cc * 8);
          conv_rows<8>(XBC, W, t0 + 8 * rb, grp * 512 + hg * 256 + cc * 8, [&](int r, const float (&o)[8]) { const int rr = 8 * rb + r;
              const float sc = DT[(t0 + rr) * 16 + grp * 8 + hd] * __expf(csend[hd] - cs[hd * 128 + rr]);
              *(LAS v4u*)(Xw + rr * 544 + cc * 16) = pack8(o, sc); }); }
        __syncthreads();
        const int hl = w >> 1, nh = w & 1;
        f32x4 acc[4][4];
#pragma unroll
        for (int a = 0; a < 4; ++a)
#pragma unroll
            for (int q = 0; q < 4; ++q) acc[a][q] = (f32x4){0.f, 0.f, 0.f, 0.f};
#pragma unroll
        for (int ks = 0; ks < 4; ++ks) {
            bf16x8 xf[4], bfr[4];
#pragma unroll
            for (int t = 0; t < 4; ++t) { xf[t] = frag_tr(Xw, 544, hl * 64 + t * 16, ks * 32, lane); bfr[t] = frag_tr(Bt, 288, nh * 64 + t * 16, ks * 32, lane); }
#pragma unroll
            for (int pt = 0; pt < 4; ++pt)
#pragma unroll
                for (int nt = 0; nt < 4; ++nt) acc[pt][nt] = mma(bfr[nt], xf[pt], acc[pt][nt]);
        }
        const int head = grp * 8 + hg * 4 + hl;
        bf16* dst = ST + (size_t)((b * 32 + c) * 16 + head) * 8192;
#pragma unroll
        for (int pt = 0; pt < 4; ++pt)
#pragma unroll
            for (int nt = 0; nt < 4; ++nt) { const int p = pt * 16 + (lane & 15), n = nh * 64 + nt * 16 + 4 * (lane >> 4); const f32x4 v = acc[pt][nt];
                *(v2u*)(dst + p * 128 + n) = (v2u){pk2(v[0], v[1]), pk2(v[2], v[3])}; }
    }
}

DI void ssd_scan_item(Frame& F, int item) {
    bf16* ST = (bf16*)(F.ws + WS_SLOT32); const float* CDEC = (const float*)(F.ws + WS_MISC);
    const int bh = item >> 11, b = bh >> 4, head = bh & 15, off = (item & 2047) * 4;
    float run[4]; float zf = 0.f; asm volatile("" : "+v"(zf));
#pragma unroll
    for (int k = 0; k < 4; ++k) run[k] = zf;
    v2u* base = (v2u*)(ST + (size_t)((b * 32) * 16 + head) * 8192 + off);
    const float* dbase = CDEC + (b * 32) * 16 + head;
    v2u cur[8], nxt[8]; float dc[8], dn[8];
#pragma unroll
    for (int q = 0; q < 8; ++q) { cur[q] = base[(size_t)q * 32768]; dc[q] = dbase[q * 16]; }
#pragma unroll 1
    for (int cb = 0; cb < 4; ++cb) {
        const int cn = cb < 3 ? cb + 1 : cb;
#pragma unroll
        for (int q = 0; q < 8; ++q) { nxt[q] = base[(size_t)(cn * 8 + q) * 32768]; dn[q] = dbase[(cn * 8 + q) * 16]; }
#pragma unroll
        for (int q = 0; q < 8; ++q) {
            base[(size_t)(cb * 8 + q) * 32768] = (v2u){pk2(run[0], run[1]), pk2(run[2], run[3])};
            run[0] = dc[q] * run[0] + bflo(cur[q].x); run[1] = dc[q] * run[1] + bfhi(cur[q].x); run[2] = dc[q] * run[2] + bflo(cur[q].y); run[3] = dc[q] * run[3] + bfhi(cur[q].y); }
#pragma unroll
        for (int q = 0; q < 8; ++q) { cur[q] = nxt[q]; dc[q] = dn[q]; }
    }
}

template <int DBG = 0> DI void ssd_passC_unit(Frame& F, const SsdPar& P, int unit, bf16* YO) {
    const bf16* XBC = (const bf16*)(F.ws + WS_XBC); const float* DT = (const float*)(F.ws + WS_DT);
    const bf16* ST = (const bf16*)(F.ws + WS_SLOT32); const bf16* GZ = (const bf16*)(F.ws + WS_GZ);
    const int grp = unit & 1, c = (unit >> 1) & 31, b = unit >> 6;
    const int lane = F.lane, w = F.wave;
    const size_t t0 = (size_t)b * SEQ + c * 128;
    LAS float* cs = (LAS float*)F.lds;
    LAS float* dtl = (LAS float*)(F.lds + 4096);
    LAS unsigned char* Ct = F.lds + 8192;
    LAS unsigned char* BM = F.lds + 43008;
    LAS unsigned char* Xd = F.lds + 77824;
    LAS unsigned char* Pv = F.lds + 98304;
    LAS float* rowss = (LAS float*)(F.lds + 115712);
    LAS float* wtab = (LAS float*)(F.lds + 123904);
    __syncthreads();
    (void)ssd_cumsum(DT, P.a_log, t0, grp, w, lane, cs, dtl);
    for (int i = F.tid; i < 5 * 128; i += NTHR) { const int k = i >> 7, c4 = (i & 127) * 4;
        *(LAS f32x4*)(wtab + k * 512 + c4) = *(const f32x4*)((k < 4 ? P.conv_w + k * 1536 : P.conv_b) + grp * 512 + c4); }
#pragma unroll 1
    for (int which = 0; which < 2; ++which) {
        const int cc = F.tid & 15, rb = F.tid >> 4; const ConvW W = load_convw(P.conv_w, P.conv_b, 1024 + which * 256 + grp * 128 + cc * 8);
        LAS unsigned char* dstt = which ? Ct : BM;
        conv_rows<4>(XBC, W, t0 + 4 * rb, 1024 + which * 256 + grp * 128 + cc * 8, [&](int r, const float (&o)[8]) { *(LAS v4u*)(dstt + (4 * rb + r) * 272 + cc * 16) = pack8(o, 1.0f); }); }
    const int r0 = F.tid >> 3, cc8 = (F.tid & 7) * 8, tin0 = (int)((t0 + r0) & 4095);
    const int wl = w >> 1, ws = w & 1, wp = w & 1;
    v4u XR[2][4], PVr[2]; v2u ZN[2][2], ZC[2][2];
    const unsigned lo_p = tile_loff<128>(F.tid, 128);
#define SSD_ISSUE(hd_) do { const int hcol_ = grp * 512 + (hd_) * 64 + cc8; \
        _Pragma("unroll") for (int it_ = 0; it_ < 2; ++it_) _Pragma("unroll") for (int k_ = 0; k_ < 4; ++k_) \
            if (tin0 + 64 * it_ - 3 + k_ >= 0) XR[it_][k_] = *(const v4u*)(XBC + (t0 + r0 + 64 * it_ - 3 + k_) * 1536 + hcol_); \
        tile_issue<64, 128>(PVr, ST + (size_t)((b * 32 + c) * 16 + grp * 8 + (hd_)) * 8192, 128, lo_p); \
        _Pragma("unroll") for (int lt_ = 0; lt_ < 2; ++lt_) _Pragma("unroll") for (int pt_ = 0; pt_ < 2; ++pt_) \
            ZN[lt_][pt_] = *(const v2u*)(GZ + (t0 + wl * 32 + lt_ * 16 + (lane & 15)) * 2048 + 1024 + (grp * 8 + (hd_)) * 64 + wp * 32 + pt_ * 16 + 4 * (lane >> 4)); } while (0)
    SSD_ISSUE(0);
    __syncthreads();
    f32x4 cb[2][4];
#pragma unroll
    for (int a = 0; a < 2; ++a)
#pragma unroll
        for (int q = 0; q < 4; ++q) cb[a][q] = (f32x4){0.f, 0.f, 0.f, 0.f};
#pragma unroll
    for (int ks = 0; ks < 4; ++ks) {
        bf16x8 cf[2], bfr[4];
#pragma unroll
        for (int t = 0; t < 2; ++t) cf[t] = frag_rm(Ct, 272, wl * 32 + t * 16, ks * 32, lane);
#pragma unroll
        for (int t = 0; t < 4; ++t) bfr[t] = frag_rm(BM, 272, ws * 64 + t * 16, ks * 32, lane);
#pragma unroll
        for (int lt = 0; lt < 2; ++lt)
#pragma unroll
            for (int st = 0; st < 4; ++st) cb[lt][st] = mma(bfr[st], cf[lt], cb[lt][st]);
    }
#pragma unroll 1
    for (int hd = 0; hd < 8; ++hd) {
        const int head = grp * 8 + hd;
        ConvW W;
#pragma unroll
        for (int k = 0; k < 4; ++k) { W.w[k][0] = *(const LAS f32x4*)(wtab + k * 512 + hd * 64 + cc8); W.w[k][1] = *(const LAS f32x4*)(wtab + k * 512 + hd * 64 + cc8 + 4); }
        W.b[0] = *(const LAS f32x4*)(wtab + 4 * 512 + hd * 64 + cc8); W.b[1] = *(const LAS f32x4*)(wtab + 4 * 512 + hd * 64 + cc8 + 4);
        const float dsk = P.d_ssd[head];
        __syncthreads();
        if (!(DBG & 1))
#pragma unroll
        for (int lt = 0; lt < 2; ++lt) { const int l = wl * 32 + lt * 16 + (lane & 15); const float csl = cs[hd * 128 + l], dgl = dsk * __builtin_amdgcn_rcpf(dtl[hd * 128 + l]);
#pragma unroll
            for (int st = 0; st < 4; ++st) { const int s = ws * 64 + st * 16 + 4 * (lane >> 4); f32x4 m;
                const f32x4 cs4 = *(const LAS f32x4*)(cs + hd * 128 + s);
#pragma unroll
                for (int jj = 0; jj < 4; ++jj) { const float e = __expf(fminf(csl - cs4[jj], 0.f)); m[jj] = (s + jj <= l) ? cb[lt][st][jj] * e : 0.f; m[jj] += (s + jj == l) ? dgl : 0.f; }
                *(LAS v2u*)(BM + l * 272 + s * 2) = (v2u){pk2(m[0], m[1]), pk2(m[2], m[3])}; } }
        if (!(DBG & 2))
#pragma unroll
        for (int it = 0; it < 2; ++it) { float o[8]; conv8r(XR[it], W, tin0 + 64 * it, o);
            *(LAS v4u*)(Xd + (r0 + 64 * it) * 160 + cc8 * 2) = pack8(o, dtl[hd * 128 + r0 + 64 * it]); }
        tile_commit<64, 128>(PVr, Pv, 272, F.tid);
#pragma unroll
        for (int lt = 0; lt < 2; ++lt)
#pragma unroll
            for (int pt = 0; pt < 2; ++pt) ZC[lt][pt] = ZN[lt][pt];
        if (hd < 7) SSD_ISSUE(hd + 1);
        __syncthreads();
        f32x4 yd[2][2], yo[2][2];
#pragma unroll
        for (int a2 = 0; a2 < 2; ++a2)
#pragma unroll
            for (int q = 0; q < 2; ++q) { yd[a2][q] = (f32x4){0.f, 0.f, 0.f, 0.f}; yo[a2][q] = (f32x4){0.f, 0.f, 0.f, 0.f}; }
        if (!(DBG & 4))
#pragma unroll
        for (int ks = 0; ks < 4; ++ks) {
            bf16x8 mf[2], xf[2], cf[2], pf[2];
#pragma unroll
            for (int t = 0; t < 2; ++t) { mf[t] = frag_rm(BM, 272, wl * 32 + t * 16, ks * 32, lane); xf[t] = frag_tr(Xd, 160, wp * 32 + t * 16, ks * 32, lane);
                                          cf[t] = frag_rm(Ct, 272, wl * 32 + t * 16, ks * 32, lane); pf[t] = frag_rm(Pv, 272, wp * 32 + t * 16, ks * 32, lane); }
#pragma unroll
            for (int lt = 0; lt < 2; ++lt)
#pragma unroll
                for (int pt = 0; pt < 2; ++pt) { yd[lt][pt] = mma(xf[pt], mf[lt], yd[lt][pt]); yo[lt][pt] = mma(pf[pt], cf[lt], yo[lt][pt]); }
        }
#pragma unroll
        for (int lt = 0; lt < 2; ++lt) { const int l = wl * 32 + lt * 16 + (lane & 15); const float ecs = __expf(cs[hd * 128 + l]); float ss = 0.f;
#pragma unroll
            for (int pt = 0; pt < 2; ++pt) { const int p = wp * 32 + pt * 16 + 4 * (lane >> 4);
                const v2u zv = ZC[lt][pt];
                f32x4 y = yd[lt][pt] + ecs * yo[lt][pt];
                y[0] *= silu_f(bflo(zv.x)); y[1] *= silu_f(bfhi(zv.x)); y[2] *= silu_f(bflo(zv.y)); y[3] *= silu_f(bfhi(zv.y));
                ss += (y[0] * y[0] + y[1] * y[1]) + (y[2] * y[2] + y[3] * y[3]);
                if (YO) *(v2u*)(YO + (t0 + l) * 2048 + 1024 + head * 64 + p) = (v2u){pk2(y[0], y[1]), pk2(y[2], y[3])}; }
            ss += __shfl_xor(ss, 16); ss += __shfl_xor(ss, 32);
            if ((lane >> 4) == 0) rowss[(hd * 2 + wp) * 128 + l] = ss; }
    }
#undef SSD_ISSUE
    if (!YO) return;
    asm volatile("s_waitcnt vmcnt(0)" ::: "memory");
    __syncthreads();
    LAS float* rst = (LAS float*)F.lds;
    if (F.tid < 128) { float t = 0.f;
#pragma unroll
        for (int q = 0; q < 16; ++q) t += rowss[q * 128 + F.tid];
        rst[F.tid] = rsqrtf(t * (1.f / 512.f) + EPS); }
    __syncthreads();
    { const int cc = F.tid & 63; const f32x4 n0 = *(const f32x4*)(P.ssd_norm + grp * 512 + cc * 8), n1 = *(const f32x4*)(P.ssd_norm + grp * 512 + cc * 8 + 4);
#pragma unroll 4
      for (int it = 0; it < 16; ++it) { const int r = (F.tid >> 6) + it * 8; const float rs = rst[r];
          v4u* gp = (v4u*)(YO + (t0 + r) * 2048 + 1024 + grp * 512 + cc * 8); const v4u v = *gp;
          v4u o; o.x = pk2(bflo(v.x) * rs * n0[0], bfhi(v.x) * rs * n0[1]); o.y = pk2(bflo(v.y) * rs * n0[2], bfhi(v.y) * rs * n0[3]);
          o.z = pk2(bflo(v.z) * rs * n1[0], bfhi(v.z) * rs * n1[1]); o.w = pk2(bflo(v.w) * rs * n1[2], bfhi(v.w) * rs * n1[3]);
          *gp = o; } }
}

struct S5Par { const float* lam_re; const float* lam_im; const float* log_step; const float* b_re; const float* b_im; const float* c_re; const float* c_im; const float* d_s5; };

DI void s5_build_unit(Frame& F, const S5Par& P, int unit) {
    const int g = unit >> 2, cq = unit & 3;
    bf16* AB = (bf16*)(F.ws + WS_S5MAT + (size_t)g * 262144); bf16* E = AB + 256 * 384;
    LAS f32x2v* pw = (LAS f32x2v*)F.lds;
    LAS f32x2v* Bb = (LAS f32x2v*)(F.lds + 8704);
    LAS f32x2v* Cc = (LAS f32x2v*)(F.lds + 16896);
    LAS float* Km = (LAS float*)(F.lds + 25088);
    LAS f32x2v* cf = (LAS f32x2v*)(F.lds + 29184);
    __syncthreads();
    for (int i = F.tid; i < 17 * 64; i += NTHR) { const int t = i >> 6, p = i & 63;
        const double lr = fmin((double)P.lam_re[g * 64 + p], -1e-4), li = (double)P.lam_im[g * 64 + p], dl = (double)expf(P.log_step[g]);
        const double mag = (double)expf((float)(t * lr * dl)); double sn, cs_; sincos_d(t * li * dl, sn, cs_);
        pw[i] = (f32x2v){(float)(mag * cs_), (float)(mag * sn)};
        if (t == 1) { const double den = lr * lr + li * li, nr = mag * cs_ - 1.0, ni = mag * sn; cf[p] = (f32x2v){(float)((nr * lr + ni * li) / den), (float)((ni * lr - nr * li) / den)}; } }
    __syncthreads();
    for (int i = F.tid; i < 1024; i += NTHR) { const int p = i >> 4; const f32x2v c = cf[p]; const float br = P.b_re[g * 1024 + i], bi = P.b_im[g * 1024 + i];
        Bb[i] = (f32x2v){c.x * br - c.y * bi, c.x * bi + c.y * br}; }
    for (int i = F.tid; i < 1024; i += NTHR) Cc[i] = (f32x2v){P.c_re[g * 1024 + i], P.c_im[g * 1024 + i]};
    __syncthreads();
    for (int i = F.tid; i < 1024; i += NTHR) { const int t = i >> 6, cl = (i >> 4) & 3, c2 = i & 15, c = cq * 4 + cl; float acc = 0.f;
        for (int p = 0; p < 64; ++p) { const f32x2v cc = Cc[c * 64 + p], a = pw[t * 64 + p], bb = Bb[p * 16 + c2];
            const float tr = cc.x * a.x - cc.y * a.y, ti = cc.x * a.y + cc.y * a.x; acc += tr * bb.x - ti * bb.y; }
        Km[i] = acc; }
    __syncthreads();
    for (int i = F.tid; i < 64 * 48; i += NTHR) { const int rl = i / 48, c8 = (i % 48) * 8, l = rl >> 2, cl = rl & 3, c = cq * 4 + cl, row = l * 16 + c; float v[8];
        if (c8 < 256) { const int s = c8 >> 4, c2 = c8 & 15;
#pragma unroll
            for (int k = 0; k < 8; ++k) v[k] = s <= l ? Km[((l - s) * 4 + cl) * 16 + c2 + k] : 0.f;
        } else { const bool im = c8 >= 320; const int p0 = c8 - (im ? 320 : 256);
#pragma unroll
            for (int k = 0; k < 8; ++k) { const f32x2v cc = Cc[c * 64 + p0 + k], a = pw[(l + 1) * 64 + p0 + k];
                v[k] = im ? -(cc.x * a.y + cc.y * a.x) : (cc.x * a.x - cc.y * a.y); } }
        *(v4u*)(AB + (size_t)row * 384 + c8) = (v4u){pk2(v[0], v[1]), pk2(v[2], v[3]), pk2(v[4], v[5]), pk2(v[6], v[7])}; }
    for (int i = F.tid; i < 32 * 32; i += NTHR) { const int rl = i >> 5, c8 = (i & 31) * 8, p = cq * 16 + (rl & 15), s = c8 >> 4, c2 = c8 & 15; const bool im = rl >= 16; const int row = (im ? 64 : 0) + p; float v[8];
        const f32x2v a = pw[(15 - s) * 64 + p];
#pragma unroll
        for (int k = 0; k < 8; ++k) { const f32x2v bb = Bb[p * 16 + c2 + k]; v[k] = im ? (a.x * bb.y + a.y * bb.x) : (a.x * bb.x - a.y * bb.y); }
        *(v4u*)(E + (size_t)row * 256 + c8) = (v4u){pk2(v[0], v[1]), pk2(v[2], v[3]), pk2(v[4], v[5]), pk2(v[6], v[7])}; }
}

DI void s5_gemmA_unit(Frame& F, int unit) {
    const bf16* HN = (const bf16*)(F.ws + WS_SLOT32); float* EO = (float*)(F.ws + WS_S5E);
    const int g = unit >> 2, q = unit & 3, lane = F.lane, w = F.wave, i = lane & 15, gq = lane >> 4;
    const bf16* E = (const bf16*)(F.ws + WS_S5MAT + (size_t)g * 262144) + 256 * 384 + (q * 32) * 256;
    bf16x8 ef[2][8];
#pragma unroll
    for (int mt = 0; mt < 2; ++mt)
#pragma unroll
        for (int ks = 0; ks < 8; ++ks) ef[mt][ks] = *(const bf16x8*)(E + (mt * 16 + i) * 256 + 32 * ks + 8 * gq);
#pragma unroll 2
    for (int t = 0; t < 8; ++t) { const int nt = t * 8 + w, b = nt >> 4, k0 = (nt & 15) * 16;
        const bf16* hp = HN + ((size_t)b * SEQ + 16 * (k0 + i) + (gq >> 1)) * D + 16 * g + 8 * (gq & 1);
        bf16x8 uf[8];
#pragma unroll
        for (int ks = 0; ks < 8; ++ks) uf[ks] = *(const bf16x8*)(hp + (size_t)(2 * ks) * D);
        f32x4 acc[2] = {(f32x4){0.f, 0.f, 0.f, 0.f}, (f32x4){0.f, 0.f, 0.f, 0.f}};
#pragma unroll
        for (int ks = 0; ks < 8; ++ks)
#pragma unroll
            for (int mt = 0; mt < 2; ++mt) acc[mt] = mma(ef[mt][ks], uf[ks], acc[mt]);
        float* dst = EO + ((size_t)((b * 256 + k0 + i) * 64 + g)) * 128 + q * 32 + 4 * gq;
#pragma unroll
        for (int mt = 0; mt < 2; ++mt) *(f32x4*)(dst + mt * 16) = acc[mt]; }
}

DI void s5_scan_task(Frame& F, const float* lam_re, const float* lam_im, const float* log_step, int task, int dbg) {
    const float* EO = (const float*)(F.ws + WS_S5E); bf16* XO = (bf16*)(F.ws + WS_S5X);
    const int b = task >> 6, g = task & 63, p = F.lane;
    f32x2v a;
    { const double lr = fmin((double)lam_re[g * 64 + p], -1e-4), li = (double)lam_im[g * 64 + p], dl = (double)expf(log_step[g]);
      const double mag = (double)expf((float)(16.0 * lr * dl)); double s, c; sincos_d(16.0 * li * dl, s, c); a = (f32x2v){(float)(mag * c), (float)(mag * s)}; }
    if (dbg == 6) a = (f32x2v){0.f, 0.f};
    float rr = 0.f, ri = 0.f;
    const float* ep = EO + ((size_t)(b * 256) * 64 + g) * 128 + p; bf16* xp = XO + ((size_t)(b * 256) * 64 + g) * 128 + p;
    float er[16], ei[16], fr_[16], fi_[16];
#pragma unroll
    for (int s2 = 0; s2 < 16; ++s2) { er[s2] = ep[(size_t)s2 * 8192]; ei[s2] = ep[(size_t)s2 * 8192 + 64]; }
#pragma unroll 1
    for (int kb = 0; kb < 16; ++kb) {
        const int kn = kb < 15 ? kb + 1 : kb;
#pragma unroll
        for (int s2 = 0; s2 < 16; ++s2) { fr_[s2] = ep[(size_t)(kn * 16 + s2) * 8192]; fi_[s2] = ep[(size_t)(kn * 16 + s2) * 8192 + 64]; }
#pragma unroll
        for (int s2 = 0; s2 < 16; ++s2) { bf16* xo = xp + (size_t)(kb * 16 + s2) * 8192;
            xo[0] = (bf16)f2bf(rr); xo[64] = (bf16)f2bf(ri);
            const float nr = a.x * rr - a.y * ri + er[s2], ni = a.x * ri + a.y * rr + ei[s2]; rr = nr; ri = ni; }
#pragma unroll
        for (int s2 = 0; s2 < 16; ++s2) { er[s2] = fr_[s2]; ei[s2] = fi_[s2]; }
    }
}

DI float gelu_tanh(float v) { const float u = 0.7978845608028654f * (v + 0.044715f * v * v * v); const float t = 1.0f - 2.0f * __builtin_amdgcn_rcpf(__expf(2.0f * u) + 1.0f); return 0.5f * v * (1.0f + t); }

DI void s5_gemmB_unit(Frame& F, const float* d_s5, int unit) {
    const bf16* HN = (const bf16*)(F.ws + WS_SLOT32); const bf16* XO = (const bf16*)(F.ws + WS_S5X); bf16* Y = (bf16*)(F.ws + WS_Y);
    const int g = unit >> 2, lq = unit & 3, lane = F.lane, w = F.wave, i = lane & 15, gq = lane >> 4;
    const bf16* AB = (const bf16*)(F.ws + WS_S5MAT + (size_t)g * 262144) + (size_t)(64 * lq) * 384;
    LAS unsigned char* A = F.lds;
    __syncthreads();
    load_tile(A, 784, AB, 384, 64, 384, F.tid);
    __syncthreads();
    const int colg = 16 * g + 4 * gq;
    const f32x4 dv = *(const f32x4*)(d_s5 + colg);
#pragma unroll 1
    for (int t = 0; t < 8; ++t) { const int nt = t * 8 + w, b = nt >> 4, k0 = (nt & 15) * 16;
        const bf16* hp = HN + ((size_t)b * SEQ + 16 * (k0 + i) + (gq >> 1)) * D + 16 * g + 8 * (gq & 1);
        const bf16* xp = XO + ((size_t)((b * 256 + k0 + i) * 64 + g)) * 128 + 8 * gq;
        bf16x8 uf[12];
#pragma unroll
        for (int ks = 0; ks < 8; ++ks) uf[ks] = *(const bf16x8*)(hp + (size_t)(2 * ks) * D);
#pragma unroll
        for (int ks = 0; ks < 4; ++ks) uf[8 + ks] = *(const bf16x8*)(xp + ks * 32);
        f32x4 acc[4];
#pragma unroll
        for (int mt = 0; mt < 4; ++mt) acc[mt] = (f32x4){0.f, 0.f, 0.f, 0.f};
#pragma unroll
        for (int ks = 0; ks < 12; ++ks) {
#pragma unroll
            for (int mt = 0; mt < 4; ++mt) acc[mt] = mma(frag_rm(A, 784, mt * 16, ks * 32, lane), uf[ks], acc[mt]);
            if (ks & 1) __builtin_amdgcn_sched_barrier(0); }
#pragma unroll
        for (int mt = 0; mt < 4; ++mt) { const size_t tok = (size_t)b * SEQ + 16 * (k0 + i) + 4 * lq + mt;
            const v2u hv = *(const v2u*)(HN + tok * D + colg);
            const float y0 = gelu_tanh(acc[mt][0] + dv[0] * bflo(hv.x)), y1 = gelu_tanh(acc[mt][1] + dv[1] * bfhi(hv.x));
            const float y2 = gelu_tanh(acc[mt][2] + dv[2] * bflo(hv.y)), y3 = gelu_tanh(acc[mt][3] + dv[3] * bfhi(hv.y));
            *(v2u*)(Y + tok * D + colg) = (v2u){pk2(y0, y1), pk2(y2, y3)}; } }
}

#ifndef REP_BAR
#define REP_BAR 1
#endif
#ifndef REP_CONV
#define REP_CONV 1
#endif
#ifndef REP_ROW
#define REP_ROW 1
#endif
#ifndef REP_RC
#define REP_RC 1
#endif
#ifndef REP_SC
#define REP_SC 1
#endif
#ifndef SC_DBG
#define SC_DBG 0
#endif
#ifndef REP_GEMM
#define REP_GEMM 1
#endif
#ifndef REP_S5A
#define REP_S5A 1
#endif
#ifndef REP_S5S
#define REP_S5S 1
#endif
#ifndef REP_S5B
#define REP_S5B 1
#endif
#ifndef REP_RA
#define REP_RA 1
#endif
#ifndef REP_SA
#define REP_SA 1
#endif
#ifndef SKIP_EVEN
#define SKIP_EVEN 0
#endif
#ifndef SKIP_ODD
#define SKIP_ODD 0
#endif
DI int opq(int v) { asm volatile("" : "+s"(v)); return v; }
struct Args { const float* in[N_IN]; float* out; unsigned char* ws; };
constexpr int CW_BAR = 1024;

#define PHASE() do { unsigned z_ = 0u; asm volatile("" : "+s"(z_)); int l_ = __builtin_amdgcn_mbcnt_hi(~0u, __builtin_amdgcn_mbcnt_lo(~0u, z_)); int w_ = wave0; asm volatile("" : "+s"(w_)); \
        int g_ = gridDim.x, b_ = blockIdx.x; asm volatile("" : "+s"(g_), "+s"(b_)); F.G = g_; F.bid = b_; F.vcu = (g_ % 8 == 0) ? (b_ % 8) * (g_ / 8) + b_ / 8 : b_; F.lane = l_; F.wave = w_; F.tid = w_ * 64 + l_; F.out = (float*)(GAS float*)lds_ptr(F, N_IN); F.ws = (unsigned char*)(GAS unsigned char*)lds_ptr(F, N_IN + 1); } while (0)
#define WSP(T, off) ((T*)(F.ws + (off)))
#define GRID_BAR() do { PHASE(); XcdBarrier xb_; xb_.bar = (unsigned*)(F.ws + WS_CTL) + CW_BAR; xb_.x = xb_xcc_id(); xb_.tid = F.tid; xb_.st = (volatile LAS unsigned*)(F.lds + MISC_OFF) + 8; xcd_barrier(xb_); if (REP_BAR == 2) xcd_barrier(xb_); PHASE(); } while (0)
template <int layer> __device__ __forceinline__ void run_layer(Frame& F, const int wave0) {
        const int j = layer >> 1;
        if ((layer & 1) == 0) {
            if (!opq(SKIP_EVEN)) {
            { pg8::Gemm g{WSP(bf16, WS_SLOT32), WSP(bf16, WS_SLOT16), M, INP_PAD, D}; pg8::StaticOrder S; S.init(M, INP_PAD, F.G, F.bid);
              pg8::EpiInProj E{WSP(bf16, WS_QKV), WSP(bf16, WS_GZ), WSP(bf16, WS_XBC), WSP(float, WS_DT), (const float*)(F.ws + WS_ROPE), INP(I_DT_BIAS) + j * 16};
              pg8::gemm_phase<pg8::EpiInProj, pg8::StaticOrder, true, true>(F.lds, g, S, E, F.tid); }
#if REP_GEMM == 2 || defined(REP_G_INP)
            { PHASE(); pg8::Gemm g{WSP(bf16, WS_SLOT32), WSP(bf16, WS_SLOT16), M, INP_PAD, D}; pg8::StaticOrder S; S.init(M, INP_PAD, F.G, F.bid);
              pg8::EpiInProj E{WSP(bf16, WS_QKV), WSP(bf16, WS_GZ), WSP(bf16, WS_XBC), WSP(float, WS_DT), (const float*)(F.ws + WS_ROPE), INP(I_DT_BIAS) + j * 16};
              pg8::gemm_phase<pg8::EpiInProj, pg8::StaticOrder, true, true>(F.lds, g, S, E, F.tid); }
#endif
            GRID_BAR();
            for (int rep_ = 0; rep_ < REP_RA; ++rep_) for (int u = F.vcu; u < 256; u += F.G) ret_passA_unit(F, u);
            { const SsdPar SP{INP(I_CONV_W) + (size_t)j * 4 * 1536, INP(I_CONV_B) + j * 1536, INP(I_A_LOG) + j * 16, INP(I_D_SSD) + j * 16, INP(I_SSD_NORM) + j * 1024};
              for (int rep_ = 0; rep_ < REP_SA; ++rep_) for (int u = F.vcu; u < 256; u += F.G) ssd_passA_unit(F, SP, u); }
            GRID_BAR();
            for (int it = (F.bid * NTHR + F.tid); it < 131072; it += (F.G * NTHR)) ret_scan_item(F, it);
            for (int it = (F.bid * NTHR + F.tid); it < 131072; it += (F.G * NTHR)) ssd_scan_item(F, it);
            GRID_BAR();
#if REP_RC == 2
            if (layer == 0) for (int u = F.vcu; u < 256; u += F.G) ret_passC_unit(F, u, (bf16*)F.out);
#endif
            for (int u = F.vcu; u < 256; u += F.G) ret_passC_unit(F, u, WSP(bf16, WS_GZ));
            { const SsdPar SP{INP(I_CONV_W) + (size_t)j * 4 * 1536, INP(I_CONV_B) + j * 1536, INP(I_A_LOG) + j * 16, INP(I_D_SSD) + j * 16, INP(I_SSD_NORM) + j * 1024};
#if REP_SC >= 2
              if (layer == 0) for (int u = F.vcu; u < 256; u += F.G) ssd_passC_unit<SC_DBG>(F, SP, u, REP_SC == 2 ? (bf16*)F.out : (bf16*)nullptr);
#endif
              for (int u = F.vcu; u < 256; u += F.G) ssd_passC_unit(F, SP, u, WSP(bf16, WS_GZ)); }
            GRID_BAR();
            }
            __syncthreads();
            convert_weight(F, INP(I_W_UP) + (size_t)layer * D * FF, D, FF, WSP(bf16, WS_SLOT16), 0);
#if REP_CONV == 2
            convert_weight(F, INP(I_W_UP) + (size_t)layer * D * FF, D, FF, WSP(bf16, WS_SLOT16), 0);
#endif
            convert_weight(F, INP(I_W_DOWN) + (size_t)layer * FF * D, FF, D, WSP(bf16, WS_SLOT16) + (size_t)FF * D, 0);
#if REP_CONV == 2
            convert_weight(F, INP(I_W_DOWN) + (size_t)layer * FF * D, FF, D, WSP(bf16, WS_SLOT16) + (size_t)FF * D, 0);
#endif
            __syncthreads();
            if (!opq(SKIP_EVEN)) {
            { pg8::Gemm g{WSP(bf16, WS_GZ), WSP(bf16, WS_W4), M, D, 2048}; pg8::StaticOrder S; S.init(M, D, F.G, F.bid);
              pg8::EpiBf16 E{WSP(bf16, WS_M32A), D};
              pg8::gemm_phase<pg8::EpiBf16, pg8::StaticOrder, true, true>(F.lds, g, S, E, F.tid); }
#if REP_GEMM == 2 || defined(REP_G_OUT)
            { PHASE(); pg8::Gemm g{WSP(bf16, WS_GZ), WSP(bf16, WS_W4), M, D, 2048}; pg8::StaticOrder S; S.init(M, D, F.G, F.bid);
              pg8::EpiBf16 E{WSP(bf16, WS_M32A), D};
              pg8::gemm_phase<pg8::EpiBf16, pg8::StaticOrder, true, true>(F.lds, g, S, E, F.tid); }
#endif
            } else zero_fill(F, WSP(bf16, WS_M32A), (size_t)M * D * 2);
            GRID_BAR();
            if (layer == 0) row_phase<true, false>(F, WSP(bf16, WS_M32A), INP(I_X), F.out, INP(I_POST_MIX) + layer * D, INP(I_PRE_MLP) + layer * D, WSP(bf16, WS_SLOT32));
            else row_phase<false, false>(F, WSP(bf16, WS_M32A), F.out, F.out, INP(I_POST_MIX) + layer * D, INP(I_PRE_MLP) + layer * D, WSP(bf16, WS_SLOT32));
            GRID_BAR();
        } else {
            if (opq(SKIP_ODD) == 2) {
                const v4u* s_ = (const v4u*)WSP(bf16, WS_SLOT32); v4u* d_ = (v4u*)WSP(bf16, WS_Y);
                for (size_t i_ = (size_t)F.bid * NTHR + F.tid; i_ < (size_t)M * D / 8; i_ += (size_t)F.G * NTHR) d_[i_] = s_[i_];
                GRID_BAR();
            }
            if (opq(SKIP_ODD) == 0 || opq(SKIP_ODD) >= 3) {
            for (int rep_ = 0; rep_ < REP_S5A; ++rep_) for (int u = F.vcu; u < 256; u += F.G) s5_gemmA_unit(F, u);
            GRID_BAR();
            for (int rep_ = 0; rep_ < REP_S5B; ++rep_) for (int u = F.vcu; u < 256; u += F.G) {
                __syncthreads();
                if (F.wave < 4) s5_scan_task(F, INP(I_LAM_RE) + j * 4096, INP(I_LAM_IM) + j * 4096, INP(I_LOG_STEP) + j * 64, F.wave * 64 + (u >> 2), 0);
                asm volatile("s_waitcnt vmcnt(0)" ::: "memory");
                s5_gemmB_unit(F, INP(I_D_S5) + j * 1024, u); }
            GRID_BAR();
            }
            __syncthreads();
            convert_weight(F, INP(I_W_UP) + (size_t)layer * D * FF, D, FF, WSP(bf16, WS_SLOT16), 0);
            convert_weight(F, INP(I_W_DOWN) + (size_t)layer * FF * D, FF, D, WSP(bf16, WS_SLOT16) + (size_t)FF * D, 0);
            __syncthreads();
            if (opq(SKIP_ODD) != 1) {
            { pg8::Gemm g{WSP(bf16, WS_Y), WSP(bf16, WS_W4), M, 2048, D}; pg8::StaticOrder S; S.init(M, 2048, F.G, F.bid);
              pg8::EpiGlu E{WSP(bf16, WS_M32B), D};
              pg8::gemm_phase<pg8::EpiGlu, pg8::StaticOrder, true, true>(F.lds, g, S, E, F.tid); }
#if REP_GEMM == 2 || defined(REP_G_GLU)
            { PHASE(); pg8::Gemm g{WSP(bf16, WS_Y), WSP(bf16, WS_W4), M, 2048, D}; pg8::StaticOrder S; S.init(M, 2048, F.G, F.bid);
              pg8::EpiGlu E{WSP(bf16, WS_M32B), D};
              pg8::gemm_phase<pg8::EpiGlu, pg8::StaticOrder, true, true>(F.lds, g, S, E, F.tid); }
#endif
            } else zero_fill(F, WSP(bf16, WS_M32B), (size_t)M * D * 2);
            GRID_BAR();
            row_phase<false, false>(F, WSP(bf16, WS_M32B), F.out, F.out, INP(I_POST_MIX) + layer * D, INP(I_PRE_MLP) + layer * D, WSP(bf16, WS_SLOT32));
            GRID_BAR();
        }
        { pg8::Gemm g{WSP(bf16, WS_SLOT32), WSP(bf16, WS_SLOT16), M, FF, D}; pg8::StaticOrder S; S.init(M, FF, F.G, F.bid);
          pg8::EpiRelu2 E{WSP(bf16, WS_U), FF};
          pg8::gemm_phase<pg8::EpiRelu2, pg8::StaticOrder, true, true>(F.lds, g, S, E, F.tid); }
#if REP_GEMM == 2 || defined(REP_G_UP)
            { PHASE(); pg8::Gemm g{WSP(bf16, WS_SLOT32), WSP(bf16, WS_SLOT16), M, FF, D}; pg8::StaticOrder S; S.init(M, FF, F.G, F.bid);
          pg8::EpiRelu2 E{WSP(bf16, WS_U), FF};
          pg8::gemm_phase<pg8::EpiRelu2, pg8::StaticOrder, true, true>(F.lds, g, S, E, F.tid); }
#endif
        GRID_BAR();
        __syncthreads();
        if ((layer & 1) == 0) { convert_weight(F, INP(I_W_GLU_A) + (size_t)j * D * D, D, D, WSP(bf16, WS_W4), 1); convert_weight(F, INP(I_W_GLU_B) + (size_t)j * D * D, D, D, WSP(bf16, WS_W4), 2); }
#if REP_CONV == 2
        if ((layer & 1) == 0) { convert_weight(F, INP(I_W_GLU_A) + (size_t)j * D * D, D, D, WSP(bf16, WS_W4), 1); convert_weight(F, INP(I_W_GLU_B) + (size_t)j * D * D, D, D, WSP(bf16, WS_W4), 2); }
#endif
        __syncthreads();
        { pg8::Gemm g{WSP(bf16, WS_U), WSP(bf16, WS_SLOT16) + (size_t)FF * D, M, D, FF}; pg8::StaticOrder S; S.init(M, D, F.G, F.bid);
          pg8::EpiBf16 E{WSP(bf16, WS_M32B), D};
          pg8::gemm_phase<pg8::EpiBf16, pg8::StaticOrder, true, true>(F.lds, g, S, E, F.tid); }
#if REP_GEMM == 2 || defined(REP_G_DOWN)
            { PHASE(); pg8::Gemm g{WSP(bf16, WS_U), WSP(bf16, WS_SLOT16) + (size_t)FF * D, M, D, FF}; pg8::StaticOrder S; S.init(M, D, F.G, F.bid);
          pg8::EpiBf16 E{WSP(bf16, WS_M32B), D};
          pg8::gemm_phase<pg8::EpiBf16, pg8::StaticOrder, true, true>(F.lds, g, S, E, F.tid); }
#endif
        GRID_BAR();
        if (layer < DEPTH - 1) row_phase<false, false>(F, WSP(bf16, WS_M32B), F.out, F.out, INP(I_POST_MLP) + layer * D, INP(I_PRE_MIX) + (layer + 1) * D, WSP(bf16, WS_SLOT32));
        else row_phase<false, true>(F, WSP(bf16, WS_M32B), F.out, F.out, INP(I_POST_MLP) + layer * D, nullptr, nullptr);
        if (layer == 0 || layer == 2) {
            const S5Par P5{INP(I_LAM_RE) + j * 4096, INP(I_LAM_IM) + j * 4096, INP(I_LOG_STEP) + j * 64, INP(I_B_RE) + (size_t)j * 65536, INP(I_B_IM) + (size_t)j * 65536,
                           INP(I_C_RE) + (size_t)j * 65536, INP(I_C_IM) + (size_t)j * 65536, INP(I_D_S5) + j * 1024};
            for (int u = F.bid; u < 256; u += F.G) s5_build_unit(F, P5, u);
        } else if (layer == 1) {
            __syncthreads();
            convert_weight(F, INP(I_W_IN) + (size_t)D * INP, D, INP, WSP(bf16, WS_SLOT16), 0);
#if REP_CONV == 2
            convert_weight(F, INP(I_W_IN) + (size_t)D * INP, D, INP, WSP(bf16, WS_SLOT16), 0);
#endif
            zero_fill(F, WSP(bf16, WS_SLOT16) + (size_t)6688 * D, (size_t)(INP_PAD - 6688) * D * 2);
            convert_weight(F, INP(I_W_OUT) + (size_t)2048 * D, 2048, D, WSP(bf16, WS_W4), 0);
#if REP_CONV == 2
            convert_weight(F, INP(I_W_OUT) + (size_t)2048 * D, 2048, D, WSP(bf16, WS_W4), 0);
#endif
        }
        if (layer < DEPTH - 1) GRID_BAR();

}

__global__ void __launch_bounds__(NTHR, 2) trunk_fwd(Args args) {
    extern __shared__ __attribute__((aligned(16))) unsigned char lds[];
    Frame F;
    F.lds = (LAS unsigned char*)lds;
    F.G = gridDim.x; F.bid = blockIdx.x;
    { const int t = threadIdx.x;
      for (int u = t; u < (LDS_BYTES - MISC_OFF) / 4; u += NTHR) ((LAS unsigned*)(F.lds + MISC_OFF))[u] = 0u;
      __syncthreads();
      if (t < N_IN + 2) ((LAS unsigned long long*)(F.lds + MISC_OFF + 256))[t] = t < N_IN ? (unsigned long long)args.in[t] : (t == N_IN ? (unsigned long long)args.out : (unsigned long long)args.ws);
      __syncthreads(); }
    const int wave0 = __builtin_amdgcn_readfirstlane(threadIdx.x >> 6);
    PHASE();
    (void)xcd_barrier_post((unsigned*)(F.ws + WS_CTL) + CW_BAR, (volatile LAS unsigned*)(F.lds + MISC_OFF) + 8);

    build_rope(F);
    convert_weight(F, INP(I_W_IN), D, INP, WSP(bf16, WS_SLOT16), 0);
#if REP_CONV == 2
    convert_weight(F, INP(I_W_IN), D, INP, WSP(bf16, WS_SLOT16), 0);
#endif
    zero_fill(F, WSP(bf16, WS_SLOT16) + (size_t)6688 * D, (size_t)(INP_PAD - 6688) * D * 2);
    convert_weight(F, INP(I_W_OUT), 2048, D, WSP(bf16, WS_W4), 0);
#if REP_CONV == 2
    convert_weight(F, INP(I_W_OUT), 2048, D, WSP(bf16, WS_W4), 0);
#endif
    rms_rows_to_bf16(F, INP(I_X), INP(I_PRE_MIX), WSP(bf16, WS_SLOT32));
    GRID_BAR();

    run_layer<0>(F, wave0); run_layer<1>(F, wave0); run_layer<2>(F, wave0); run_layer<3>(F, wave0);
}

extern "C" void kernel_launch(void* const* d_in, const int* in_sizes, int n_in, void* d_out, int out_size, void* d_ws, size_t ws_size, hipStream_t stream) {
    static int grid = 0;
    if (grid == 0) {
        if (n_in != N_IN || out_size != M * D || ws_size < WS_END) { fprintf(stderr, "kernel_launch: unexpected shapes (n_in %d, out %d, ws %zu)\n", n_in, out_size, ws_size); grid = -1; return; }
        int dev = 0, cus = 0, per_cu = 0;
        if (hipGetDevice(&dev) != hipSuccess || hipDeviceGetAttribute(&cus, hipDeviceAttributeMultiprocessorCount, dev) != hipSuccess) { grid = -1; return; }
        if (hipFuncSetAttribute((const void*)trunk_fwd, hipFuncAttributeMaxDynamicSharedMemorySize, LDS_BYTES) != hipSuccess) { fprintf(stderr, "kernel_launch: hipFuncSetAttribute failed\n"); grid = -1; return; }
        if (hipOccupancyMaxActiveBlocksPerMultiprocessor(&per_cu, (const void*)trunk_fwd, NTHR, LDS_BYTES) != hipSuccess || per_cu < 1)
            fprintf(stderr, "kernel_launch: note: occupancy query reports %d workgroups per CU\n", per_cu);
        (void)hipGetLastError();
        grid = cus;
    }
    if (grid < 0) return;
    if (hipMemsetAsync((char*)d_ws + WS_CTL, 0, CTL_ZERO_BYTES, stream) != hipSuccess) return;
#ifdef DBG_ZERO_MISC
    if (hipMemsetAsync((char*)d_ws + WS_MISC, 0, 512 * 1024, stream) != hipSuccess) return;
#endif
    Args a{};
    for (int i = 0; i < N_IN; ++i) a.in[i] = (const float*)d_in[i];
    a.out = (float*)d_out; a.ws = (unsigned char*)d_ws;
    hipLaunchKernelGGL(trunk_fwd, dim3(grid), dim3(NTHR), LDS_BYTES, stream, a);
}
```

```cpp
#include <hip/hip_runtime.h>
#include <cstdio>
#include <cstdint>
namespace pg8 {
#define PG8_LAS __attribute__((address_space(3)))
typedef unsigned short bf16_t;
typedef short bf16x8 __attribute__((ext_vector_type(8)));
typedef float f32x4 __attribute__((ext_vector_type(4)));
typedef unsigned u32x4 __attribute__((ext_vector_type(4)));
constexpr int BM = 256, BK = 64, HALF = 128, HTB = HALF * BK * 2  , STAGE_BYTES = 8 * HTB, NXCD = 8, WGM = 8;

__host__ __device__ __forceinline__ int lds_byte(int r, int c) { const int st = (r >> 4) * 2 + (c >> 5), rr = r & 15, cc = c & 31, ob = rr * 64 + cc * 2; return st * 1024 + (ob ^ (((ob >> 9) & 1) << 5)); }
__host__ __device__ __forceinline__ void stage_rc(int b, int& R, int& C) { const int st = b / 1024, sb = b % 1024, swz = sb ^ (((sb >> 9) & 1) << 5); R = (st >> 1) * 16 + swz / 64; C = (st & 1) * 32 + (swz % 64) / 2; }
__host__ __device__ __forceinline__ int perm32(int rho) { const int n = rho >> 4, i = rho & 15; return 8 * (i >> 2) + 4 * n + (i & 3); }

struct Unit { int pm, pn; };
struct Gemm { const bf16_t* A; const bf16_t* Bt; int M, N, K; };

struct StaticOrder {
    int nM, nN, nwg, G, c;
    __host__ __device__ void init(int M, int N, int G_, int c_) { nM = M / BM; nN = N / BM; nwg = nM * nN; G = G_; c = c_; }
    __host__ __device__ bool next(int i, Unit& u) const {
        const long L = (long)i * G + c; if (L >= nwg) return false;
        int wgid = (int)L; { const int q = nwg / NXCD, r = nwg % NXCD, xcd = wgid % NXCD, off = wgid / NXCD; wgid = (xcd < r ? xcd * (q + 1) : r * (q + 1) + (xcd - r) * q) + off; }
        const int nig = WGM * nN, gid = wgid / nig, fm = gid * WGM, gsz = (nM - fm) < WGM ? (nM - fm) : WGM;
        u.pm = fm + ((wgid % nig) % gsz); u.pn = (wgid % nig) / gsz; return true;
    }
    __device__ __forceinline__ void a_ready(const Unit&) const {}
    __device__ __forceinline__ void done(const Unit&) const {}
};

typedef __bf16 bf2_t __attribute__((ext_vector_type(2))); typedef float f32x2p __attribute__((ext_vector_type(2)));
__device__ __forceinline__ unsigned cvt_pk_bf16(float lo, float hi) { const f32x2p v = {lo, hi}; return __builtin_bit_cast(unsigned, __builtin_convertvector(v, bf2_t)); }
typedef float f32x2 __attribute__((ext_vector_type(2)));
struct EpiBf16 {
    static constexpr bool PERM = true, AFTER_DRAIN = false;
    bf16_t* O; int ldc;
    __device__ __forceinline__ void operator()(const f32x4 (&acc)[2][2][4][2], const Unit& u, int wr, int wc, int fr_in, int fq_in) const {
        int fr = fr_in, fq = fq_in; asm volatile("" : "+v"(fr), "+v"(fq));
        const int row0 = u.pm * BM + wr * 64 + fr, col0 = u.pn * BM + wc * 32 + 8 * fq;
#pragma unroll
        for (int ai = 0; ai < 2; ++ai)
#pragma unroll
            for (int m = 0; m < 4; ++m) { bf16_t* rowp = O + (size_t)(row0 + ai * HALF + m * 16) * ldc + col0;
#pragma unroll
                for (int bj = 0; bj < 2; ++bj) { const f32x4 v0 = acc[ai][bj][m][0], v1 = acc[ai][bj][m][1];
                    u32x4 w; w.x = cvt_pk_bf16(v0[0], v0[1]); w.y = cvt_pk_bf16(v0[2], v0[3]); w.z = cvt_pk_bf16(v1[0], v1[1]); w.w = cvt_pk_bf16(v1[2], v1[3]);
                    *(u32x4*)(rowp + bj * HALF) = w; } }
    }
};
struct EpiGlu {
    static constexpr bool PERM = true, AFTER_DRAIN = false;
    bf16_t* O; int ldc;
    __device__ __forceinline__ void operator()(const f32x4 (&acc)[2][2][4][2], const Unit& u, int wr, int wc, int fr_in, int fq_in) const {
        int fr = fr_in, fq = fq_in; asm volatile("" : "+v"(fr), "+v"(fq));
        const int row0 = u.pm * BM + wr * 64 + fr, col0 = u.pn * HALF + wc * 32 + 8 * fq;
#pragma unroll
        for (int ai = 0; ai < 2; ++ai)
#pragma unroll
            for (int m = 0; m < 4; ++m) { bf16_t* rowp = O + (size_t)(row0 + ai * HALF + m * 16) * ldc + col0;
                f32x4 o[2];
#pragma unroll
                for (int n = 0; n < 2; ++n) { const f32x4 a = acc[ai][0][m][n], b = acc[ai][1][m][n];
#pragma unroll
                    for (int j = 0; j < 4; ++j) o[n][j] = a[j] * __builtin_amdgcn_rcpf(1.0f + __expf(-b[j])); }
                u32x4 w; w.x = cvt_pk_bf16(o[0][0], o[0][1]); w.y = cvt_pk_bf16(o[0][2], o[0][3]); w.z = cvt_pk_bf16(o[1][0], o[1][1]); w.w = cvt_pk_bf16(o[1][2], o[1][3]);
                *(u32x4*)rowp = w; }
    }
};
struct EpiRelu2 {
    static constexpr bool PERM = true, AFTER_DRAIN = false;
    bf16_t* O; int ldc;
    __device__ __forceinline__ void operator()(const f32x4 (&acc)[2][2][4][2], const Unit& u, int wr, int wc, int fr_in, int fq_in) const {
        int fr = fr_in, fq = fq_in; asm volatile("" : "+v"(fr), "+v"(fq));
        const int row0 = u.pm * BM + wr * 64 + fr, col0 = u.pn * BM + wc * 32 + 8 * fq;
#pragma unroll
        for (int ai = 0; ai < 2; ++ai)
#pragma unroll
            for (int m = 0; m < 4; ++m) { bf16_t* rowp = O + (size_t)(row0 + ai * HALF + m * 16) * ldc + col0;
#pragma unroll
                for (int bj = 0; bj < 2; ++bj) { f32x4 v0 = acc[ai][bj][m][0], v1 = acc[ai][bj][m][1];
#pragma unroll
                    for (int j = 0; j < 4; ++j) { const float a = fmaxf(v0[j], 0.f), b = fmaxf(v1[j], 0.f); v0[j] = a * a; v1[j] = b * b; }
                    u32x4 w; w.x = cvt_pk_bf16(v0[0], v0[1]); w.y = cvt_pk_bf16(v0[2], v0[3]); w.z = cvt_pk_bf16(v1[0], v1[1]); w.w = cvt_pk_bf16(v1[2], v1[3]);
                    *(u32x4*)(rowp + bj * HALF) = w; } }
    }
};
struct EpiInProj {
    static constexpr bool PERM = true, AFTER_DRAIN = false;
    bf16_t* QKV; bf16_t* GZ; bf16_t* XBC; float* DT; const float* rope; const float* dt_bias;
    __device__ __forceinline__ void operator()(const f32x4 (&acc)[2][2][4][2], const Unit& u, int wr, int wc, int fr_in, int fq_in) const {
        int fr = fr_in, fq = fq_in; asm volatile("" : "+v"(fr), "+v"(fq));
        const int pn = u.pn, row0 = u.pm * BM + wr * 64 + fr, cin = wc * 32 + 8 * fq;
        if (pn < 8) {
            const int hd = pn & 3; const bool isk = pn >= 4;
            const float lg2 = __log2f(1.0f - exp2f(-5.0f - (float)hd));
#pragma unroll
            for (int ai = 0; ai < 2; ++ai)
#pragma unroll
                for (int m = 0; m < 4; ++m) { const int row = row0 + ai * HALF + m * 16, pos = row & 4095, r = pos & 127;
                    const float sc = isk ? exp2f(-(float)r * lg2) * 0.0625f : exp2f((float)r * lg2);
                    const f32x4* rp = (const f32x4*)(rope + ((size_t)pos * 128 + cin) * 2);
                    f32x4 o1[2], o2[2];
#pragma unroll
                    for (int n = 0; n < 2; ++n) { const f32x4 cs0 = rp[2 * n], cs1 = rp[2 * n + 1];
                        const f32x4 x1 = acc[ai][0][m][n], x2 = acc[ai][1][m][n];
                        const float c[4] = {cs0[0], cs0[2], cs1[0], cs1[2]}, s[4] = {cs0[1], cs0[3], cs1[1], cs1[3]};
#pragma unroll
                        for (int j = 0; j < 4; ++j) { o1[n][j] = (x1[j] * c[j] - x2[j] * s[j]) * sc; o2[n][j] = (x2[j] * c[j] + x1[j] * s[j]) * sc; } }
                    bf16_t* rowp = QKV + (size_t)row * 3072 + pn * 256 + cin;
                    u32x4 w; w.x = cvt_pk_bf16(o1[0][0], o1[0][1]); w.y = cvt_pk_bf16(o1[0][2], o1[0][3]); w.z = cvt_pk_bf16(o1[1][0], o1[1][1]); w.w = cvt_pk_bf16(o1[1][2], o1[1][3]);
                    *(u32x4*)rowp = w;
                    w.x = cvt_pk_bf16(o2[0][0], o2[0][1]); w.y = cvt_pk_bf16(o2[0][2], o2[0][3]); w.z = cvt_pk_bf16(o2[1][0], o2[1][1]); w.w = cvt_pk_bf16(o2[1][2], o2[1][3]);
                    *(u32x4*)(rowp + HALF) = w; }
        } else if (pn < 26) {
            bf16_t* base; int ldc, colt;
            if (pn < 12) { base = QKV; ldc = 3072; colt = pn * 256; } else if (pn < 20) { base = GZ; ldc = 2048; colt = (pn - 12) * 256; } else { base = XBC; ldc = 1536; colt = (pn - 20) * 256; }
#pragma unroll
            for (int ai = 0; ai < 2; ++ai)
#pragma unroll
                for (int m = 0; m < 4; ++m) { bf16_t* rowp = base + (size_t)(row0 + ai * HALF + m * 16) * ldc + colt + cin;
#pragma unroll
                    for (int bj = 0; bj < 2; ++bj) { const f32x4 v0 = acc[ai][bj][m][0], v1 = acc[ai][bj][m][1];
                        u32x4 w; w.x = cvt_pk_bf16(v0[0], v0[1]); w.y = cvt_pk_bf16(v0[2], v0[3]); w.z = cvt_pk_bf16(v1[0], v1[1]); w.w = cvt_pk_bf16(v1[2], v1[3]);
                        *(u32x4*)(rowp + bj * HALF) = w; } }
        } else {
            if (cin < 16) {
#pragma unroll
                for (int ai = 0; ai < 2; ++ai)
#pragma unroll
                    for (int m = 0; m < 4; ++m) { float* rowp = DT + (size_t)(row0 + ai * HALF + m * 16) * 16 + cin;
#pragma unroll
                        for (int n = 0; n < 2; ++n) { f32x4 o;
#pragma unroll
                            for (int j = 0; j < 4; ++j) { const float x = acc[ai][0][m][n][j] + dt_bias[cin + 4 * n + j]; o[j] = fmaxf(x > 20.f ? x : log1pf(__expf(x)), 1e-30f); }
                            *(f32x4*)(rowp + 4 * n) = o; } }
            }
        }
    }
};
template <class Epi, class Sched, bool ALIGN_EPI = false, bool SP2 = false>
__device__ __forceinline__ void gemm_phase(PG8_LAS unsigned char* lds, const Gemm g, const Sched& S, const Epi& E, const int tid) {
    const int wid = __builtin_amdgcn_readfirstlane(tid >> 6), lane = tid & 63, wr = wid >> 2, wc = wid & 3, fr = lane & 15, fq = lane >> 4;
    const int K = g.K, nt = K / BK;
    unsigned voffA[2], voffB[2];
#pragma unroll
    for (int i = 0; i < 2; ++i) { int R, C; stage_rc(tid * 16 + i * 8192, R, C); const int Rb = Epi::PERM ? ((R & ~31) + perm32(R & 31)) : R;
        voffA[i] = (unsigned)(R * K + C) * 2u; voffB[i] = (unsigned)(Rb * K + C) * 2u; }
    const size_t kstep = (size_t)(BK * 2);
    const size_t hstep = (size_t)HALF * K * 2;
    const size_t tstep = 2 * hstep;
    const unsigned ldsw = (unsigned)wid * 1024u;
    const int aoff = lds_byte(wr * 64 + fr, fq * 8), boff = lds_byte(wc * 32 + fr, fq * 8);
#define PG8_SA(b, h) (((b) * 2 + (h)) * HTB)
#define PG8_SB(b, h) ((4 + (b) * 2 + (h)) * HTB)
#define PG8_STAGE(bufoff, gbase, voff) do { _Pragma("unroll") for (int _i = 0; _i < 2; ++_i) \
        __builtin_amdgcn_global_load_lds((const unsigned*)((const char*)(gbase) + (voff)[_i]), (PG8_LAS unsigned*)(lds + (bufoff) + ldsw + _i * 8192), 16, 0, 0); } while (0)
#define PG8_LDA(dst, b, h) do { _Pragma("unroll") for (int m = 0; m < 4; ++m) _Pragma("unroll") for (int k = 0; k < 2; ++k) dst[m][k] = *(const PG8_LAS bf16x8*)(lds + PG8_SA(b, h) + aoff + m * 2048 + k * 1024); } while (0)
#define PG8_LDB(dst, b, h) do { _Pragma("unroll") for (int n = 0; n < 2; ++n) _Pragma("unroll") for (int k = 0; k < 2; ++k) dst[n][k] = *(const PG8_LAS bf16x8*)(lds + PG8_SB(b, h) + boff + n * 2048 + k * 1024); } while (0)
#define PG8_MMA(ai, bj, At, Bt) do { __builtin_amdgcn_s_setprio(1); _Pragma("unroll") for (int m = 0; m < 4; ++m) _Pragma("unroll") for (int n = 0; n < 2; ++n) _Pragma("unroll") for (int k = 0; k < 2; ++k) \
        acc[ai][bj][m][n] = __builtin_amdgcn_mfma_f32_16x16x32_bf16(Bt[n][k], At[m][k], acc[ai][bj][m][n], 0, 0, 0); __builtin_amdgcn_s_setprio(0); } while (0)
#define PG8_WAIT_V(n) asm volatile("s_waitcnt vmcnt(" #n ")" ::: "memory")
#define PG8_WAIT_L(n) asm volatile("s_waitcnt lgkmcnt(" #n ")" ::: "memory")
#define PG8_BAR __builtin_amdgcn_s_barrier()
#define PG8_SCHED __builtin_amdgcn_sched_barrier(0)
    Unit cur, nxt; int ui = 0;
    if (!S.next(0, cur)) return;
    f32x4 acc[2][2][4][2];
#pragma unroll
    for (int a = 0; a < 2; ++a)
#pragma unroll
        for (int b = 0; b < 2; ++b)
#pragma unroll
            for (int m = 0; m < 4; ++m)
#pragma unroll
                for (int n = 0; n < 2; ++n) acc[a][b][m][n] = (f32x4){0.f, 0.f, 0.f, 0.f};
    bf16x8 At[4][2], B0[2][2], B1[2][2];
    const char* cA = (const char*)g.A + (size_t)cur.pm * tstep; const char* cB = (const char*)g.Bt + (size_t)cur.pn * tstep;
    S.a_ready(cur);
    if constexpr (SP2) {
        PG8_STAGE(PG8_SB(0, 0), cB, voffB); PG8_STAGE(PG8_SB(0, 1), cB + hstep, voffB); PG8_STAGE(PG8_SA(0, 0), cA, voffA); PG8_STAGE(PG8_SA(0, 1), cA + hstep, voffA);
        if (wr == 1) PG8_BAR;
        PG8_WAIT_V(2); PG8_BAR;
        PG8_STAGE(PG8_SB(1, 0), cB + kstep, voffB); PG8_STAGE(PG8_SA(1, 0), cA + kstep, voffA); PG8_STAGE(PG8_SB(1, 1), cB + hstep + kstep, voffB);
        PG8_WAIT_V(6); PG8_BAR;
    } else {
        PG8_STAGE(PG8_SB(0, 0), cB, voffB); PG8_STAGE(PG8_SA(0, 0), cA, voffA); PG8_STAGE(PG8_SB(0, 1), cB + hstep, voffB); PG8_STAGE(PG8_SA(0, 1), cA + hstep, voffA);
        if (wr == 1) PG8_BAR;
        PG8_WAIT_V(4); PG8_BAR;
        PG8_STAGE(PG8_SB(1, 0), cB + kstep, voffB); PG8_STAGE(PG8_SA(1, 0), cA + kstep, voffA); PG8_STAGE(PG8_SB(1, 1), cB + hstep + kstep, voffB);
        PG8_WAIT_V(6); PG8_BAR;
    }
    for (;;) {
        const bool has_next = S.next(ui + 1, nxt);
        const char* nA = has_next ? (const char*)g.A + (size_t)nxt.pm * tstep : cA; const char* nB = has_next ? (const char*)g.Bt + (size_t)nxt.pn * tstep : cB;
        for (int t = 0; t < nt; t += 2) {
            const bool last = (t == nt - 2);
            const char* a1 = cA + (size_t)(t + 1) * kstep;
            const char* a2 = last ? nA : cA + (size_t)(t + 2) * kstep; const char* b2 = last ? nB : cB + (size_t)(t + 2) * kstep;
            const char* a3 = a2 + kstep; const char* b3 = b2 + kstep;
            if (last && has_next) S.a_ready(nxt);
            if constexpr (SP2) {
            PG8_LDB(B0, 0, 0); PG8_LDB(B1, 0, 1); PG8_SCHED; PG8_LDA(At, 0, 0); PG8_STAGE(PG8_SA(1, 1), a1 + hstep, voffA);
            PG8_WAIT_V(8); PG8_WAIT_L(0); PG8_BAR; PG8_MMA(0, 0, At, B0); PG8_MMA(0, 1, At, B1); PG8_BAR; PG8_SCHED;
            PG8_LDA(At, 0, 1); PG8_STAGE(PG8_SB(0, 0), b2, voffB); PG8_STAGE(PG8_SB(0, 1), b2 + hstep, voffB); PG8_STAGE(PG8_SA(0, 0), a2, voffA);
            PG8_WAIT_V(8); PG8_WAIT_L(0); PG8_BAR; PG8_MMA(1, 0, At, B0); PG8_MMA(1, 1, At, B1); PG8_BAR; PG8_SCHED;
            PG8_LDB(B0, 1, 0); PG8_LDB(B1, 1, 1); PG8_SCHED; PG8_LDA(At, 1, 0); PG8_STAGE(PG8_SA(0, 1), a2 + hstep, voffA);
            PG8_WAIT_V(8); PG8_WAIT_L(0); PG8_BAR; PG8_MMA(0, 0, At, B0); PG8_MMA(0, 1, At, B1); PG8_BAR; PG8_SCHED;
            PG8_LDA(At, 1, 1); PG8_STAGE(PG8_SB(1, 0), b3, voffB); PG8_STAGE(PG8_SB(1, 1), b3 + hstep, voffB); PG8_STAGE(PG8_SA(1, 0), a3, voffA);
            PG8_WAIT_V(8); PG8_WAIT_L(0); PG8_BAR; PG8_MMA(1, 0, At, B0); PG8_MMA(1, 1, At, B1); PG8_BAR; PG8_SCHED;
            } else {
            PG8_LDB(B0, 0, 0); PG8_SCHED; PG8_LDA(At, 0, 0); PG8_STAGE(PG8_SA(1, 1), a1 + hstep, voffA);
            PG8_WAIT_L(8); PG8_BAR; PG8_WAIT_L(0); PG8_MMA(0, 0, At, B0); PG8_BAR; PG8_SCHED;
            PG8_LDB(B1, 0, 1); PG8_STAGE(PG8_SB(0, 0), b2, voffB);
            PG8_BAR; PG8_WAIT_L(0); PG8_MMA(0, 1, At, B1); PG8_BAR;
            PG8_LDA(At, 0, 1); PG8_STAGE(PG8_SA(0, 0), a2, voffA);
            PG8_BAR; PG8_WAIT_L(0); PG8_MMA(1, 0, At, B0); PG8_BAR; PG8_SCHED;
            PG8_STAGE(PG8_SB(0, 1), b2 + hstep, voffB);
            PG8_WAIT_V(6); PG8_BAR; PG8_MMA(1, 1, At, B1); PG8_BAR;
            PG8_LDB(B0, 1, 0); PG8_SCHED; PG8_LDA(At, 1, 0); PG8_STAGE(PG8_SA(0, 1), a2 + hstep, voffA);
            PG8_WAIT_L(8); PG8_BAR; PG8_WAIT_L(0); PG8_MMA(0, 0, At, B0); PG8_BAR; PG8_SCHED;
            PG8_LDB(B1, 1, 1); PG8_STAGE(PG8_SB(1, 0), b3, voffB);
            PG8_BAR; PG8_WAIT_L(0); PG8_MMA(0, 1, At, B1); PG8_BAR;
            PG8_LDA(At, 1, 1); PG8_STAGE(PG8_SA(1, 0), a3, voffA);
            PG8_BAR; PG8_WAIT_L(0); PG8_MMA(1, 0, At, B0); PG8_BAR; PG8_SCHED;
            PG8_STAGE(PG8_SB(1, 1), b3 + hstep, voffB);
            PG8_WAIT_V(6); PG8_BAR; PG8_MMA(1, 1, At, B1); PG8_BAR;
            }
        }
        if constexpr (ALIGN_EPI) { if (wr == 0) PG8_BAR; }
        if constexpr (!Epi::AFTER_DRAIN) { E(acc, cur, wr, wc, fr, fq);
#if defined(REP_EPI) && REP_EPI == 2
            E(acc, cur, wr, wc, fr, fq);
#endif
            S.done(cur); }
        if (!has_next) break;
#pragma unroll
        for (int a = 0; a < 2; ++a)
#pragma unroll
            for (int b = 0; b < 2; ++b)
#pragma unroll
                for (int m = 0; m < 4; ++m)
#pragma unroll
                    for (int n = 0; n < 2; ++n) acc[a][b][m][n] = (f32x4){0.f, 0.f, 0.f, 0.f};
        cur = nxt; cA = nA; cB = nB; ++ui;
        if constexpr (ALIGN_EPI) { if (wr == 1) PG8_BAR; }
    }
    PG8_WAIT_V(0);
    if constexpr (!ALIGN_EPI) { if (wr == 0) PG8_BAR; }
    PG8_BAR;
    if constexpr (Epi::AFTER_DRAIN) { E.fused(acc, cur, wr, wc, fr, fq, lds, wid, lane); S.done(cur); }
#undef PG8_SA
#undef PG8_SB
#undef PG8_STAGE
#undef PG8_LDA
#undef PG8_LDB
#undef PG8_MMA
#undef PG8_WAIT_V
#undef PG8_WAIT_L
#undef PG8_BAR
#undef PG8_SCHED
}
}
constexpr int NWAVES = 8, NTHR = 512;
constexpr int BATCH = 4, SEQ = 4096, D = 1024, M = BATCH * SEQ, FF = 4096, DEPTH = 4;
constexpr int INP = 6672, INP_PAD = 6912;
constexpr float EPS = 1e-6f;
enum { I_X = 0, I_PRE_MIX, I_POST_MIX, I_PRE_MLP, I_POST_MLP, I_W_IN, I_CONV_W, I_CONV_B, I_DT_BIAS, I_A_LOG, I_D_SSD, I_SSD_NORM, I_W_OUT,
       I_LAM_RE, I_LAM_IM, I_LOG_STEP, I_B_RE, I_B_IM, I_C_RE, I_C_IM, I_D_S5, I_W_GLU_A, I_W_GLU_B, I_W_UP, I_W_DOWN, N_IN };
constexpr size_t MiB = 1u << 20;
constexpr size_t WS_CTL = 0, CTL_ZERO_BYTES = 64 * 1024;
constexpr size_t WS_MISC = 512 * 1024;
constexpr size_t WS_ROPE = 1 * MiB;
constexpr size_t WS_W4 = 5 * MiB;
constexpr size_t WS_SLOT16 = 9 * MiB;
constexpr size_t WS_SLOT32 = 25 * MiB;
constexpr size_t WS_QKV = 57 * MiB;
constexpr size_t WS_GZ = 153 * MiB;
constexpr size_t WS_XBC = 217 * MiB;
constexpr size_t WS_DT = 265 * MiB;
constexpr size_t WS_END = 266 * MiB;
constexpr size_t WS_M32A = 57 * MiB;
constexpr size_t WS_M32B = 185 * MiB;
constexpr size_t WS_U = 57 * MiB;
constexpr size_t WS_S5MAT = 57 * MiB;
constexpr size_t WS_S5E = 73 * MiB;
constexpr size_t WS_S5X = 105 * MiB;
constexpr size_t WS_Y = 121 * MiB;
constexpr int SCR_BYTES = 143360;
constexpr int MISC_OFF = SCR_BYTES;
constexpr int LDS_BYTES = 147456;

#define GAS __attribute__((address_space(1)))
#define LAS __attribute__((address_space(3)))
#define DI __device__ __forceinline__
typedef unsigned short bf16;
typedef unsigned v4u __attribute__((ext_vector_type(4)));
typedef unsigned v2u __attribute__((ext_vector_type(2)));
typedef float f32x4 __attribute__((ext_vector_type(4)));
typedef float f32x2v __attribute__((ext_vector_type(2)));
typedef short bf16x8 __attribute__((ext_vector_type(8)));
typedef short v4i16_t __attribute__((ext_vector_type(4)));
typedef GAS unsigned gu32;
#define RLX_AGENT __ATOMIC_RELAXED, __HIP_MEMORY_SCOPE_AGENT
#define LDS_WAIT() asm volatile("s_waitcnt lgkmcnt(0)" ::: "memory")
#define VM_WAIT() asm volatile("s_waitcnt vmcnt(0)" ::: "memory")
DI unsigned f2bf(float f) { unsigned u = __builtin_bit_cast(unsigned, f); return (u + 0x7fffu + ((u >> 16) & 1u)) >> 16; }
typedef __bf16 bf2_t __attribute__((ext_vector_type(2)));
DI unsigned pk2(float lo, float hi) { const f32x2v v = {lo, hi}; return __builtin_bit_cast(unsigned, __builtin_convertvector(v, bf2_t)); }
DI float bf2f(unsigned short b) { return __builtin_bit_cast(float, ((unsigned)b) << 16); }
DI float bflo(unsigned w) { return __builtin_bit_cast(float, w << 16); }
DI float bfhi(unsigned w) { return __builtin_bit_cast(float, w & 0xffff0000u); }
DI float wave_sum(float v) {
#pragma unroll
    for (int o = 1; o < 64; o <<= 1) v += __shfl_xor(v, o);
    return v;
}
DI float silu_f(float x) { return x * __builtin_amdgcn_rcpf(1.0f + __expf(-x)); }
DI void sincos_d(double x, double& s, double& c) {
    const double k = rint(x * 0.15915494309189533576888376337251);
    const double r = fma(-k, 6.283185307179586476925286766559, x), r2 = r * r;
    double ps = 1.0 / 1.0888869450418352e28, pc = 1.0 / 3.0488834461171384e29;
    const double fs[13] = {1.0 / 1.5511210043330986e25, 1.0 / 2.5852016738884978e22, 1.0 / 5.109094217170944e19, 1.0 / 1.21645100408832e17, 1.0 / 355687428096000.0, 1.0 / 1307674368000.0,
                           1.0 / 6227020800.0, 1.0 / 39916800.0, 1.0 / 362880.0, 1.0 / 5040.0, 1.0 / 120.0, 1.0 / 6.0, 1.0};
    const double fc[14] = {1.0 / 4.0329146112660565e26, 1.0 / 6.204484017332394e23, 1.0 / 1.1240007277776077e21, 1.0 / 2.43290200817664e18, 1.0 / 6402373705728000.0, 1.0 / 20922789888000.0,
                           1.0 / 87178291200.0, 1.0 / 479001600.0, 1.0 / 3628800.0, 1.0 / 40320.0, 1.0 / 720.0, 1.0 / 24.0, 1.0 / 2.0, 1.0};
#pragma unroll
    for (int i = 0; i < 13; ++i) ps = fs[i] - ps * r2;
#pragma unroll
    for (int i = 0; i < 14; ++i) pc = fc[i] - pc * r2;
    s = ps * r; c = pc;
}
#define XB_TMO      128
#define XB_XCNT(j)  (256  + 64 * (j))
#define XB_XSUB(j)  (1280 + 64 * (j))
#define XB_XGEN(j)  (2304 + 64 * (j))
#define XB_TOP      3328
#define XB_TOPGEN   3392
#define XCD_BAR_WORDS 3456
#define XB_SPIN_CAP (1u << 18)

__device__ __forceinline__ unsigned xb_ld(unsigned* p)              { return __hip_atomic_load(p, __ATOMIC_RELAXED, __HIP_MEMORY_SCOPE_AGENT); }
__device__ __forceinline__ unsigned xb_add(unsigned* p, unsigned v) { return __hip_atomic_fetch_add(p, v, __ATOMIC_RELAXED, __HIP_MEMORY_SCOPE_AGENT); }
__device__ __forceinline__ unsigned xb_xcc_id() { return (unsigned)__builtin_amdgcn_s_getreg((3 << 11) | 20) & 0xFu; }
#define XB_SPIN(cond, bar) do { unsigned _sp = 0; while (cond) { __builtin_amdgcn_s_sleep(1); \
    if ((++_sp & 255u) == 0u) { if (xb_ld(&(bar)[XB_TMO])) break; if (_sp > XB_SPIN_CAP) { atomicAdd(&(bar)[XB_TMO], 1u); break; } } } } while (0)

struct XcdBarrier {
    unsigned* bar; unsigned x; int tid;
    volatile LAS unsigned* st;
};

__device__ __forceinline__ XcdBarrier xcd_barrier_post(unsigned* bar, volatile LAS unsigned* st) {
    XcdBarrier b; b.bar = bar; b.x = xb_xcc_id(); b.st = st;
    if (threadIdx.x == 0) (void)xb_add(&bar[XB_XCNT(b.x)], 1u);
    return b;
}
__device__ __forceinline__ void xcd_barrier_complete(unsigned* bar, unsigned x, unsigned& nloc, unsigned& nx) {
    const unsigned G = gridDim.x * gridDim.y * gridDim.z;
    unsigned sum, cnt, mine, sp = 0u;
    for (;;) {
        sum = 0u; cnt = 0u; mine = 0u;
#pragma unroll
        for (unsigned j = 0; j < 16; ++j) { const unsigned c = xb_ld(&bar[XB_XCNT(j)]); sum += c; cnt += (c > 0u) ? 1u : 0u; mine = (j == x) ? c : mine; }
        if (sum == G) break;
        __builtin_amdgcn_s_sleep(1);
        if ((++sp & 255u) == 0u) { if (xb_ld(&bar[XB_TMO])) break; if (sp > XB_SPIN_CAP) { atomicAdd(&bar[XB_TMO], 1u); break; } }
    }
    nloc = mine > 0u ? mine : 1u; nx = cnt > 0u ? cnt : 1u;
}

__device__ __forceinline__ void xcd_barrier(const XcdBarrier& b) {
    asm volatile("s_waitcnt vmcnt(0)" ::: "memory");
    __syncthreads();
    if (b.tid == 0) {
        unsigned* bar = b.bar;
        __builtin_amdgcn_s_waitcnt(0);
        unsigned nloc = b.st[0], nx = b.st[1];
        if (nloc == 0u) { xcd_barrier_complete(bar, b.x, nloc, nx); b.st[0] = nloc; b.st[1] = nx; }
        const unsigned old = xb_add(&bar[XB_XSUB(b.x)], 1u);
        const unsigned gen = old / nloc;
        if (old + 1u == (gen + 1u) * nloc) {
            __builtin_amdgcn_fence(__ATOMIC_RELEASE, "agent");
            asm volatile("s_waitcnt vmcnt(0)" ::: "memory");
            const unsigned og = xb_add(&bar[XB_TOP], 1u);
            const unsigned tg = og / nx;
            if (og + 1u == (tg + 1u) * nx) xb_add(&bar[XB_TOPGEN], 1u);
            else XB_SPIN(xb_ld(&bar[XB_TOPGEN]) == tg, bar);
            __builtin_amdgcn_fence(__ATOMIC_ACQUIRE, "agent");
            xb_add(&bar[XB_XGEN(b.x)], 1u);
            asm volatile("s_waitcnt vmcnt(0)" ::: "memory");
        } else {
            XB_SPIN(xb_ld(&bar[XB_XGEN(b.x)]) == gen, bar);
            __builtin_amdgcn_fence(__ATOMIC_ACQUIRE, "agent");
            asm volatile("s_waitcnt vmcnt(0)" ::: "memory");
        }
    }
    __syncthreads();
}

struct Frame {
    LAS unsigned char* lds;
    int tid, lane, wave, G, bid, vcu;
    float* out; unsigned char* ws;
};
DI unsigned long long lds_ptr(const Frame& F, int i) {
    unsigned a_ = (unsigned)(size_t)(F.lds + MISC_OFF + 256) + 8u * (unsigned)i; asm volatile("" : "+v"(a_));
    const unsigned long long v = *(const volatile LAS unsigned long long*)a_;
    const unsigned lo = __builtin_amdgcn_readfirstlane((unsigned)v), hi = __builtin_amdgcn_readfirstlane((unsigned)(v >> 32));
    return ((unsigned long long)hi << 32) | lo;
}
#define INP(i) ((const float*)(const GAS float*)lds_ptr(F, (i)))
DI int gwave(const Frame& F) { return F.bid * NWAVES + F.wave; }

DI bf16x8 frag_rm(const LAS unsigned char* t, int S, int r0, int k0, int lane) { return *(const LAS bf16x8*)(t + (r0 + (lane & 15)) * S + (k0 + 8 * (lane >> 4)) * 2); }
DI bf16x8 frag_tr(const LAS unsigned char* t, int S, int r0, int k0, int lane) {
    const int g = lane >> 4, q = (lane & 15) >> 2, p = lane & 3;
    const LAS unsigned char* a = t + (k0 + 8 * g + q) * S + (r0 + 4 * p) * 2;
    const v4i16_t lo = __builtin_amdgcn_ds_read_tr16_b64_v4i16((LAS v4i16_t*)a);
    const v4i16_t hi = __builtin_amdgcn_ds_read_tr16_b64_v4i16((LAS v4i16_t*)(a + 4 * S));
    return __builtin_shufflevector(lo, hi, 0, 1, 2, 3, 4, 5, 6, 7);
}
DI f32x4 mma(bf16x8 a, bf16x8 b, f32x4 c) { return __builtin_amdgcn_mfma_f32_16x16x32_bf16(a, b, c, 0, 0, 0); }

DI void load_tile(LAS unsigned char* dst, int S, const bf16* src, size_t ld, int rows, int cols, int tid) {
    const int cpr = cols >> 3, n = rows * cpr;
    for (int i = tid; i < n; i += NTHR) { const int r = i / cpr, c = i - r * cpr;
        *(LAS v4u*)(dst + r * S + c * 16) = *(const v4u*)(src + (size_t)r * ld + c * 8); }
}

template <int COLS> DI unsigned tile_loff(int tid, unsigned ld) { constexpr int CPR = COLS / 8; return (unsigned)(tid / CPR) * ld + (unsigned)(tid % CPR) * 8u; }
template <int ROWS, int COLS> DI void tile_issue(v4u* r, const bf16* src, unsigned ld, unsigned loff) {
    constexpr int CPR = COLS / 8, N = ROWS * COLS / 4096, RSTEP = NTHR / CPR;
#pragma unroll
    for (int i = 0; i < N; ++i) r[i] = *(const v4u*)((src + (size_t)i * RSTEP * ld) + loff);
}
template <int ROWS, int COLS> DI void tile_commit(const v4u* r, LAS unsigned char* dst, int S, int tid) {
    constexpr int CPR = COLS / 8, N = ROWS * COLS / 4096, RSTEP = NTHR / CPR;
    LAS unsigned char* p = dst + (tid / CPR) * S + (tid % CPR) * 16;
#pragma unroll
    for (int i = 0; i < N; ++i) *(LAS v4u*)(p + i * RSTEP * S) = r[i];
}

DI void transpose_item(const float* W, int K, int N, bf16* WT, int mode, LAS float* scr, int item, int lane) {
    const int nblk = (N + 31) / 32, kb = item / nblk, nb = item % nblk, k0 = 64 * kb, n0 = 32 * nb;
    const int n4 = 4 * (lane & 7), nl = n0 + n4;
    f32x4 v[8];
#pragma unroll
    for (int i = 0; i < 8; ++i) v[i] = nl < N ? *(const f32x4*)(W + (size_t)(k0 + 8 * i + (lane >> 3)) * N + nl) : (f32x4){0.f, 0.f, 0.f, 0.f};
#pragma unroll
    for (int i = 0; i < 8; ++i) { LAS float* d = scr + (8 * i + (lane >> 3)) * 33 + n4; d[0] = v[i][0]; d[1] = v[i][1]; d[2] = v[i][2]; d[3] = v[i][3]; }
    LDS_WAIT(); asm volatile("" ::: "memory");
    const int c = lane & 7;
#pragma unroll
    for (int j = 0; j < 4; ++j) { const int n = (lane >> 3) + 8 * j; const LAS float* s = scr + (8 * c) * 33 + n;
        v4u o; o.x = pk2(s[0 * 33], s[1 * 33]); o.y = pk2(s[2 * 33], s[3 * 33]); o.z = pk2(s[4 * 33], s[5 * 33]); o.w = pk2(s[6 * 33], s[7 * 33]);
        const int ng = n0 + n; const int row = mode == 0 ? ng : (256 * (ng >> 7) + (ng & 127) + (mode == 2 ? 128 : 0));
        *(v4u*)(WT + (size_t)row * K + k0 + 8 * c) = o; }
    LDS_WAIT(); asm volatile("" ::: "memory");
}
DI void convert_weight(Frame& F, const float* W, int K, int N, bf16* WT, int mode, int w0 = 0) {
    if (F.wave < w0) return;
    LAS float* scr = (LAS float*)(F.lds + F.wave * 16384);
    const int nw = NWAVES - w0, nitems = (K / 64) * ((N + 31) / 32), NGW = F.G * nw;
    for (int it = F.bid * nw + (F.wave - w0); it < nitems; it += NGW) transpose_item(W, K, N, WT, mode, scr, it, F.lane);
}
DI void zero_fill(Frame& F, void* p, size_t bytes) {
    v4u* q = (v4u*)p; const size_t n = bytes / 16;
    for (size_t i = (size_t)F.bid * NTHR + F.tid; i < n; i += (size_t)F.G * NTHR) q[i] = (v4u){0u, 0u, 0u, 0u};
}

DI void build_rope(Frame& F) {
    float* rope = (float*)(F.ws + WS_ROPE);
    for (int i = F.bid * NTHR + F.tid; i < 4096 * 128; i += F.G * NTHR) { const int pos = i >> 7, d = i & 127;
        double inv = 1.0; { double r = 0.930572040929699; int e = d; while (e) { if (e & 1) inv *= r; r *= r; e >>= 1; } }
        const float ang = (float)pos * (float)inv;
        double s, c; sincos_d((double)ang, s, c);
        *(f32x2v*)(rope + 2 * (size_t)i) = (f32x2v){(float)c, (float)s}; }
}
DI void rms_rows_to_bf16(Frame& F, const float* src, const float* w, bf16* dst) {
    const int NGW = F.G * NWAVES;
    f32x4 wv[4];
#pragma unroll
    for (int j = 0; j < 4; ++j) wv[j] = ((const f32x4*)w)[F.lane + 64 * j];
    for (int m = gwave(F); m < M; m += NGW) { const f32x4* xr = (const f32x4*)(src + (size_t)m * D) + F.lane;
        f32x4 v[4]; float s = 0.f;
#pragma unroll
        for (int j = 0; j < 4; ++j) { v[j] = xr[64 * j]; s += (v[j].x * v[j].x + v[j].y * v[j].y) + (v[j].z * v[j].z + v[j].w * v[j].w); }
        const float rs = rsqrtf(wave_sum(s) * (1.f / D) + EPS);
        v2u* o8 = (v2u*)(dst + (size_t)m * D) + F.lane;
#pragma unroll
        for (int j = 0; j < 4; ++j) { const f32x4 y = v[j] * rs * wv[j]; o8[64 * j] = (v2u){pk2(y.x, y.y), pk2(y.z, y.w)}; } }
}
template <bool IN_F32, bool OUT_F32>
DI void row_phase(Frame& F, const bf16* mbuf, const void* hbase, void* hout, const float* w_post, const float* w_pre, bf16* hn) {
    const int NGW = F.G * NWAVES;
    f32x4 wp[4], wq[4];
#pragma unroll
    for (int j = 0; j < 4; ++j) { wp[j] = ((const f32x4*)w_post)[F.lane + 64 * j]; wq[j] = w_pre ? ((const f32x4*)w_pre)[F.lane + 64 * j] : (f32x4){0.f, 0.f, 0.f, 0.f}; }
    for (int m = gwave(F); m < M; m += NGW) {
        const v2u* mr = (const v2u*)(mbuf + (size_t)m * D) + F.lane;
        f32x4 v[4], h[4]; float s = 0.f;
#pragma unroll
        for (int j = 0; j < 4; ++j) { const v2u mv = mr[64 * j]; v[j] = (f32x4){bflo(mv.x), bfhi(mv.x), bflo(mv.y), bfhi(mv.y)};
            if (IN_F32) h[j] = ((const f32x4*)((const float*)hbase + (size_t)m * D) + F.lane)[64 * j];
            else { const v2u hv = ((const v2u*)((const bf16*)hbase + (size_t)m * 2048) + F.lane)[64 * j]; h[j] = (f32x4){bflo(hv.x), bfhi(hv.x), bflo(hv.y), bfhi(hv.y)}; }
            s += (v[j].x * v[j].x + v[j].y * v[j].y) + (v[j].z * v[j].z + v[j].w * v[j].w); }
        const float rs = rsqrtf(wave_sum(s) * (1.f / D) + EPS); float s2 = 0.f;
#pragma unroll
        for (int j = 0; j < 4; ++j) { h[j] = h[j] + v[j] * rs * wp[j]; s2 += (h[j].x * h[j].x + h[j].y * h[j].y) + (h[j].z * h[j].z + h[j].w * h[j].w); }
        if (OUT_F32) { f32x4* ho = (f32x4*)((float*)hout + (size_t)m * D) + F.lane;
#pragma unroll
            for (int j = 0; j < 4; ++j) ho[64 * j] = h[j]; }
        else { v2u* ho = (v2u*)((bf16*)hout + (size_t)m * 2048) + F.lane;
#pragma unroll
            for (int j = 0; j < 4; ++j) ho[64 * j] = (v2u){pk2(h[j].x, h[j].y), pk2(h[j].z, h[j].w)}; }
        if (hn) { const float rs2 = rsqrtf(wave_sum(s2) * (1.f / D) + EPS);
            v2u* o8 = (v2u*)(hn + (size_t)m * D) + F.lane;
#pragma unroll
            for (int j = 0; j < 4; ++j) { const f32x4 y = h[j] * rs2 * wq[j]; o8[64 * j] = (v2u){pk2(y.x, y.y), pk2(y.z, y.w)}; } }
    }
}

DI float head_lg2(int h) { return __log2f(1.0f - exp2f(-5.0f - (float)h)); }

DI void ret_passA_unit(Frame& F, int unit) {
    const bf16* QKV = (const bf16*)(F.ws + WS_QKV); bf16* RST = (bf16*)(F.ws + WS_SLOT16);
    const int eh = unit & 1, sc = (unit >> 1) & 7, h = (unit >> 4) & 3, b = unit >> 6;
    const int lane = F.lane, w = F.wave, we = w >> 2, wd = w & 3;
    const float lg2 = head_lg2(h), g128 = exp2f(128.f * lg2), g127 = exp2f(127.f * lg2);
    LAS unsigned char* Kt = F.lds;
    LAS unsigned char* Vt = F.lds + 128 * 544;
    f32x4 acc[4][4];
#pragma unroll
    for (int a = 0; a < 4; ++a)
#pragma unroll
        for (int c = 0; c < 4; ++c) acc[a][c] = (f32x4){0.f, 0.f, 0.f, 0.f};
    v4u TK[8], TV[4];
    const unsigned lo_k = tile_loff<256>(F.tid, 3072), lo_v = tile_loff<128>(F.tid, 3072);
    const bf16* kbase = QKV + ((size_t)b * SEQ + sc * 512) * 3072 + 1024 + h * 256; const bf16* vbase = kbase + 1024 + eh * 128;
    tile_issue<128, 256>(TK, kbase, 3072, lo_k); tile_issue<128, 128>(TV, vbase, 3072, lo_v);
#pragma unroll 1
    for (int j = 0; j < 4; ++j) {
        if (j) {
#pragma unroll
            for (int a = 0; a < 4; ++a)
#pragma unroll
                for (int c = 0; c < 4; ++c) acc[a][c] *= g128; }
        __syncthreads();
        tile_commit<128, 256>(TK, Kt, 544, F.tid); tile_commit<128, 128>(TV, Vt, 288, F.tid);
        if (j < 3) { tile_issue<128, 256>(TK, kbase + (size_t)(j + 1) * 128 * 3072, 3072, lo_k); tile_issue<128, 128>(TV, vbase + (size_t)(j + 1) * 128 * 3072, 3072, lo_v); }
        __syncthreads();
#pragma unroll
        for (int ks = 0; ks < 4; ++ks) {
            bf16x8 vf[4], kf[4];
#pragma unroll
            for (int t = 0; t < 4; ++t) { vf[t] = frag_tr(Vt, 288, we * 64 + t * 16, ks * 32, lane); kf[t] = frag_tr(Kt, 544, wd * 64 + t * 16, ks * 32, lane); }
#pragma unroll
            for (int et = 0; et < 4; ++et)
#pragma unroll
                for (int dt = 0; dt < 4; ++dt) acc[et][dt] = mma(kf[dt], vf[et], acc[et][dt]);
        }
    }
    bf16* dst = RST + ((size_t)((b * 4 + h) * 8 + sc) * 256) * 256;
#pragma unroll
    for (int et = 0; et < 4; ++et)
#pragma unroll
        for (int dt = 0; dt < 4; ++dt) { const int e = eh * 128 + we * 64 + et * 16 + (lane & 15), d = wd * 64 + dt * 16 + 4 * (lane >> 4);
            const f32x4 v = acc[et][dt] * g127;
            *(v2u*)(dst + (size_t)e * 256 + d) = (v2u){pk2(v[0], v[1]), pk2(v[2], v[3])}; }
}

DI void ret_scan_item(Frame& F, int item) {
    bf16* RST = (bf16*)(F.ws + WS_SLOT16);
    const int bh = item >> 13, off = (item & 8191) * 8, h = bh & 3;
    const float g512 = exp2f(512.f * head_lg2(h));
    float run[8]; float zf = 0.f; asm volatile("" : "+v"(zf));
#pragma unroll
    for (int k = 0; k < 8; ++k) run[k] = zf;
    v4u* base = (v4u*)(RST + (size_t)(bh * 8) * 65536 + off);
    v4u in[8];
#pragma unroll
    for (int sc = 0; sc < 8; ++sc) in[sc] = base[(size_t)sc * 8192];
#pragma unroll
    for (int sc = 0; sc < 8; ++sc) {
        v4u o; o.x = pk2(run[0], run[1]); o.y = pk2(run[2], run[3]); o.z = pk2(run[4], run[5]); o.w = pk2(run[6], run[7]);
        base[(size_t)sc * 8192] = o;
        const unsigned cw[4] = {in[sc].x, in[sc].y, in[sc].z, in[sc].w};
#pragma unroll
        for (int k = 0; k < 4; ++k) { run[2 * k] = g512 * run[2 * k] + bflo(cw[k]); run[2 * k + 1] = g512 * run[2 * k + 1] + bfhi(cw[k]); }
    }
}

DI void ret_passC_unit(Frame& F, int unit, bf16* YO) {
    const bf16* QKV = (const bf16*)(F.ws + WS_QKV); const bf16* RST = (const bf16*)(F.ws + WS_SLOT16); const bf16* GZ = (const bf16*)(F.ws + WS_GZ);
    const int qp = unit & 1, sc = (unit >> 1) & 7, h = (unit >> 4) & 3, b = unit >> 6;
    const int lane = F.lane, w = F.wave, wn = w >> 2, we = w & 3, wm = w & 3;
    const float lg2 = head_lg2(h), g1 = exp2f(lg2), g128 = exp2f(128.f * lg2);
    LAS unsigned char* Qt = F.lds;
    LAS unsigned char* KV = F.lds + 33792;
    LAS unsigned char* Pt = F.lds + 33792 + 69632;
    LAS float* red = (LAS float*)(F.lds + 33792 + 69632 + 17408);
    const size_t rowsc = (size_t)b * SEQ + sc * 512;
    const bf16* Rbase = RST + (size_t)((b * 4 + h) * 8 + sc) * 65536;
    v4u T[8], TQ[4];
    const unsigned lo_kv = tile_loff<256>(F.tid, 3072), lo_r = tile_loff<64>(F.tid, 256);
    tile_issue<64, 256>(TQ, QKV + (rowsc + (qp == 0 ? 0 : 1) * 128) * 3072 + h * 256, 3072, lo_kv);
    tile_issue<256, 64>(T, Rbase, 256, lo_r);
#pragma unroll 1
    for (int qi = 0; qi < 2; ++qi) {
        const int i = qp == 0 ? (qi == 0 ? 0 : 3) : (qi == 0 ? 1 : 2);
#pragma unroll 1
        for (int hh = 0; hh < 2; ++hh) {
            const size_t grow0 = rowsc + i * 128 + hh * 64;
            f32x4 Y[2][4];
#pragma unroll
            for (int a = 0; a < 2; ++a)
#pragma unroll
                for (int c = 0; c < 4; ++c) Y[a][c] = (f32x4){0.f, 0.f, 0.f, 0.f};
            __syncthreads();
            tile_commit<64, 256>(TQ, Qt, 528, F.tid);
#pragma unroll 1
            for (int ds = 0; ds < 4; ++ds) {
                if (ds) __syncthreads();
                tile_commit<256, 64>(T, KV, 144, F.tid);
                if (ds < 3) tile_issue<256, 64>(T, Rbase + (ds + 1) * 64, 256, lo_r);
                else tile_issue<128, 256>(T, QKV + rowsc * 3072 + 1024 + h * 256, 3072, lo_kv);
                __syncthreads();
#pragma unroll
                for (int ks = 0; ks < 2; ++ks) {
                    bf16x8 qf[2], rf[4];
#pragma unroll
                    for (int t = 0; t < 2; ++t) qf[t] = frag_rm(Qt, 528, wn * 32 + t * 16, ds * 64 + ks * 32, lane);
#pragma unroll
                    for (int t = 0; t < 4; ++t) rf[t] = frag_rm(KV, 144, we * 64 + t * 16, ks * 32, lane);
#pragma unroll
                    for (int nt = 0; nt < 2; ++nt)
#pragma unroll
                        for (int et = 0; et < 4; ++et) Y[nt][et] = mma(rf[et], qf[nt], Y[nt][et]);
                }
            }
#pragma unroll
            for (int a = 0; a < 2; ++a)
#pragma unroll
                for (int c = 0; c < 4; ++c) Y[a][c] *= g1;
#pragma unroll 1
            for (int j = 0; j <= i; ++j) {
                if (j) {
#pragma unroll
                    for (int a = 0; a < 2; ++a)
#pragma unroll
                        for (int c = 0; c < 4; ++c) Y[a][c] *= g128; }
                const size_t rowj = rowsc + j * 128;
                __syncthreads();
                tile_commit<128, 256>(T, KV, 528, F.tid);
                tile_issue<128, 256>(T, QKV + rowj * 3072 + 2048 + h * 256, 3072, lo_kv);
                __syncthreads();
                f32x4 sa[2][2];
#pragma unroll
                for (int a = 0; a < 2; ++a)
#pragma unroll
                    for (int c = 0; c < 2; ++c) sa[a][c] = (f32x4){0.f, 0.f, 0.f, 0.f};
#pragma unroll
                for (int ks = 0; ks < 8; ++ks) {
                    bf16x8 qf[2], kf[2];
#pragma unroll
                    for (int t = 0; t < 2; ++t) { qf[t] = frag_rm(Qt, 528, wn * 32 + t * 16, ks * 32, lane); kf[t] = frag_rm(KV, 528, wm * 32 + t * 16, ks * 32, lane); }
#pragma unroll
                    for (int nt = 0; nt < 2; ++nt)
#pragma unroll
                        for (int mt = 0; mt < 2; ++mt) sa[nt][mt] = mma(kf[mt], qf[nt], sa[nt][mt]);
                }
#pragma unroll
                for (int nt = 0; nt < 2; ++nt)
#pragma unroll
                    for (int mt = 0; mt < 2; ++mt) { const int n = wn * 32 + nt * 16 + (lane & 15), m = wm * 32 + mt * 16 + 4 * (lane >> 4);
                        f32x4 s = sa[nt][mt];
                        if (j == i) { const int nb = hh * 64 + n;
#pragma unroll
                            for (int jj = 0; jj < 4; ++jj) if (m + jj > nb) s[jj] = 0.f; }
                        *(LAS v2u*)(Pt + n * 272 + m * 2) = (v2u){pk2(s[0], s[1]), pk2(s[2], s[3])}; }
                __syncthreads();
                tile_commit<128, 256>(T, KV, 544, F.tid);
                if (j < i) tile_issue<128, 256>(T, QKV + (rowj + 128) * 3072 + 1024 + h * 256, 3072, lo_kv);
                else { const bool more = !(qi == 1 && hh == 1);
                    const int i2 = hh == 0 ? i : (qp == 0 ? 3 : 2), hh2 = hh ^ 1;
                    if (more) { tile_issue<64, 256>(TQ, QKV + (rowsc + i2 * 128 + hh2 * 64) * 3072 + h * 256, 3072, lo_kv); tile_issue<256, 64>(T, Rbase, 256, lo_r); } }
                __syncthreads();
#pragma unroll
                for (int ks = 0; ks < 4; ++ks) {
                    bf16x8 pf[2], vf[4];
#pragma unroll
                    for (int t = 0; t < 2; ++t) pf[t] = frag_rm(Pt, 272, wn * 32 + t * 16, ks * 32, lane);
#pragma unroll
                    for (int t = 0; t < 4; ++t) vf[t] = frag_tr(KV, 544, we * 64 + t * 16, ks * 32, lane);
#pragma unroll
                    for (int nt = 0; nt < 2; ++nt)
#pragma unroll
                        for (int et = 0; et < 4; ++et) Y[nt][et] = mma(vf[et], pf[nt], Y[nt][et]);
                }
            }
            float mean[2], rstd[2];
#pragma unroll
            for (int nt = 0; nt < 2; ++nt) { float s = 0.f;
#pragma unroll
                for (int et = 0; et < 4; ++et) s += (Y[nt][et][0] + Y[nt][et][1]) + (Y[nt][et][2] + Y[nt][et][3]);
                s += __shfl_xor(s, 16); s += __shfl_xor(s, 32);
                if ((lane >> 4) == 0) red[(wn * 32 + nt * 16 + lane) * 4 + we] = s; }
            __syncthreads();
#pragma unroll
            for (int nt = 0; nt < 2; ++nt) { const LAS float* r = red + (wn * 32 + nt * 16 + (lane & 15)) * 4; mean[nt] = ((r[0] + r[1]) + (r[2] + r[3])) * (1.f / 256.f); }
            __syncthreads();
#pragma unroll
            for (int nt = 0; nt < 2; ++nt) { float s = 0.f;
#pragma unroll
                for (int et = 0; et < 4; ++et) { const f32x4 dv = Y[nt][et] - mean[nt]; s += (dv[0] * dv[0] + dv[1] * dv[1]) + (dv[2] * dv[2] + dv[3] * dv[3]); }
                s += __shfl_xor(s, 16); s += __shfl_xor(s, 32);
                if ((lane >> 4) == 0) red[(wn * 32 + nt * 16 + lane) * 4 + we] = s; }
            __syncthreads();
#pragma unroll
            for (int nt = 0; nt < 2; ++nt) { const LAS float* r = red + (wn * 32 + nt * 16 + (lane & 15)) * 4; rstd[nt] = rsqrtf(((r[0] + r[1]) + (r[2] + r[3])) * (1.f / 256.f) + EPS); }
#pragma unroll
            for (int nt = 0; nt < 2; ++nt)
#pragma unroll
                for (int et = 0; et < 4; ++et) { const int n = wn * 32 + nt * 16 + (lane & 15), e = we * 64 + et * 16 + 4 * (lane >> 4);
                    const bf16* gp = GZ + (grow0 + n) * 2048 + h * 256 + e;
                    const v2u gv = *(const v2u*)gp;
                    const f32x4 y = (Y[nt][et] - mean[nt]) * rstd[nt];
                    const float o0 = y[0] * silu_f(bflo(gv.x)), o1 = y[1] * silu_f(bfhi(gv.x)), o2 = y[2] * silu_f(bflo(gv.y)), o3 = y[3] * silu_f(bfhi(gv.y));
                    *(v2u*)(YO + (gp - GZ)) = (v2u){pk2(o0, o1), pk2(o2, o3)}; }
        }
    }
}

struct SsdPar { const float* conv_w; const float* conv_b; const float* a_log; const float* d_ssd; const float* ssd_norm; };

struct ConvW { f32x4 w[4][2]; f32x4 b[2]; };
DI ConvW load_convw(const float* cw, const float* cb, int col) { ConvW W;
#pragma unroll
    for (int k = 0; k < 4; ++k) { W.w[k][0] = *(const f32x4*)(cw + k * 1536 + col); W.w[k][1] = *(const f32x4*)(cw + k * 1536 + col + 4); }
    W.b[0] = *(const f32x4*)(cb + col); W.b[1] = *(const f32x4*)(cb + col + 4); return W; }
DI void conv8(const bf16* XBC, const ConvW& W, size_t row, int col, float (&o)[8]) {
    const int tin = (int)(row & 4095);
    o[0] = W.b[0][0]; o[1] = W.b[0][1]; o[2] = W.b[0][2]; o[3] = W.b[0][3]; o[4] = W.b[1][0]; o[5] = W.b[1][1]; o[6] = W.b[1][2]; o[7] = W.b[1][3];
#pragma unroll
    for (int k = 0; k < 4; ++k) {
        if (tin - 3 + k >= 0) {
            const v4u x = *(const v4u*)(XBC + (row - 3 + k) * 1536 + col);
            const f32x4 w0 = W.w[k][0], w1 = W.w[k][1];
            o[0] += w0[0] * bflo(x.x); o[1] += w0[1] * bfhi(x.x); o[2] += w0[2] * bflo(x.y); o[3] += w0[3] * bfhi(x.y);
            o[4] += w1[0] * bflo(x.z); o[5] += w1[1] * bfhi(x.z); o[6] += w1[2] * bflo(x.w); o[7] += w1[3] * bfhi(x.w);
        }
    }
#pragma unroll
    for (int k = 0; k < 8; ++k) o[k] = silu_f(o[k]);
}
DI void conv8r(const v4u (&x)[4], const ConvW& W, int tin, float (&o)[8]) {
    o[0] = W.b[0][0]; o[1] = W.b[0][1]; o[2] = W.b[0][2]; o[3] = W.b[0][3]; o[4] = W.b[1][0]; o[5] = W.b[1][1]; o[6] = W.b[1][2]; o[7] = W.b[1][3];
#pragma unroll
    for (int k = 0; k < 4; ++k) {
        if (tin - 3 + k >= 0) { const f32x4 w0 = W.w[k][0], w1 = W.w[k][1];
            o[0] += w0[0] * bflo(x[k].x); o[1] += w0[1] * bfhi(x[k].x); o[2] += w0[2] * bflo(x[k].y); o[3] += w0[3] * bfhi(x[k].y);
            o[4] += w1[0] * bflo(x[k].z); o[5] += w1[1] * bfhi(x[k].z); o[6] += w1[2] * bflo(x[k].w); o[7] += w1[3] * bfhi(x[k].w); }
    }
#pragma unroll
    for (int k = 0; k < 8; ++k) o[k] = silu_f(o[k]);
}
template <int NR, class Fn> DI void conv_rows(const bf16* XBC, const ConvW& W, size_t row0, int col, Fn&& emit) {
    const int tin0 = (int)(row0 & 4095);
    v4u x[NR + 3];
#pragma unroll
    for (int i = 0; i < NR + 3; ++i) x[i] = (tin0 + i - 3 >= 0) ? *(const v4u*)(XBC + (row0 + i - 3) * 1536 + col) : (v4u){0u, 0u, 0u, 0u};
#pragma unroll
    for (int r = 0; r < NR; ++r) { float o[8];
        o[0] = W.b[0][0]; o[1] = W.b[0][1]; o[2] = W.b[0][2]; o[3] = W.b[0][3]; o[4] = W.b[1][0]; o[5] = W.b[1][1]; o[6] = W.b[1][2]; o[7] = W.b[1][3];
#pragma unroll
        for (int k = 0; k < 4; ++k) { const v4u xv = x[r + k]; const f32x4 w0 = W.w[k][0], w1 = W.w[k][1];
            o[0] += w0[0] * bflo(xv.x); o[1] += w0[1] * bfhi(xv.x); o[2] += w0[2] * bflo(xv.y); o[3] += w0[3] * bfhi(xv.y);
            o[4] += w1[0] * bflo(xv.z); o[5] += w1[1] * bfhi(xv.z); o[6] += w1[2] * bflo(xv.w); o[7] += w1[3] * bfhi(xv.w); }
#pragma unroll
        for (int k = 0; k < 8; ++k) o[k] = silu_f(o[k]);
        emit(r, o); }
}
DI v4u pack8(const float (&o)[8], float s) { v4u r; r.x = pk2(o[0] * s, o[1] * s); r.y = pk2(o[2] * s, o[3] * s); r.z = pk2(o[4] * s, o[5] * s); r.w = pk2(o[6] * s, o[7] * s); return r; }

DI float ssd_cumsum(const float* DT, const float* a_log, size_t t0, int grp, int w, int lane, LAS float* cs, LAS float* dtl = nullptr) {
    const int head = grp * 8 + w; const float A = -__expf(a_log[head]);
    const float d0 = DT[(t0 + 2 * lane) * 16 + head], d1 = DT[(t0 + 2 * lane + 1) * 16 + head], v0 = d0 * A, v1 = d1 * A;
    if (dtl) { dtl[w * 128 + 2 * lane] = d0; dtl[w * 128 + 2 * lane + 1] = d1; }
    float x = v0 + v1;
#pragma unroll
    for (int o = 1; o < 64; o <<= 1) { const float t = __shfl_up(x, o); if (lane >= o) x += t; }
    cs[w * 128 + 2 * lane] = x - v1; cs[w * 128 + 2 * lane + 1] = x;
    return __shfl(x, 63);
}

DI void ssd_passA_unit(Frame& F, const SsdPar& P, int unit) {
    const bf16* XBC = (const bf16*)(F.ws + WS_XBC); const float* DT = (const float*)(F.ws + WS_DT);
    bf16* ST = (bf16*)(F.ws + WS_SLOT32); float* CDEC = (float*)(F.ws + WS_MISC);
    const int grp = unit & 1, c = (unit >> 1) & 31, b = unit >> 6;
    const int lane = F.lane, w = F.wave;
    const size_t t0 = (size_t)b * SEQ + c * 128;
    LAS float* cs = (LAS float*)F.lds;
    LAS float* csend = (LAS float*)(F.lds + 4096);
    LAS unsigned char* Bt = F.lds + 4352;
    LAS unsigned char* Xw = F.lds + 4352 + 36864;
    __syncthreads();
    { const float tot = ssd_cumsum(DT, P.a_log, t0, grp, w, lane, cs);
      if (lane == 0) { csend[w] = tot; CDEC[(b * 32 + c) * 16 + grp * 8 + w] = __expf(tot); } }
    { const int cc = F.tid & 15, rb = F.tid >> 4; const ConvW W = load_convw(P.conv_w, P.conv_b, 1024 + grp * 128 + cc * 8);
      conv_rows<4>(XBC, W, t0 + 4 * rb, 1024 + grp * 128 + cc * 8, [&](int r, const float (&o)[8]) { *(LAS v4u*)(Bt + (4 * rb + r) * 288 + cc * 16) = pack8(o, 1.0f); }); }
    for (int hg = 0; hg < 2; ++hg) {
        __syncthreads();
        { const int cc = F.tid & 31, rb = F.tid >> 5, hd = hg * 4 + (cc >> 3); const ConvW W = load_convw(P.conv_w, P.conv_b, grp * 512 + hg * 256 + cc * 8);
          conv_rows<8>(XBC, W, t0 + 8 * rb, grp * 512 + hg * 256 + cc * 8, [&](int r, const float (&o)[8]) { const int rr = 8 * rb + r;
              const float sc = DT[(t0 + rr) * 16 + grp * 8 + hd] * __expf(csend[hd] - cs[hd * 128 + rr]);
              *(LAS v4u*)(Xw + rr * 544 + cc * 16) = pack8(o, sc); }); }
        __syncthreads();
        const int hl = w >> 1, nh = w & 1;
        f32x4 acc[4][4];
#pragma unroll
        for (int a = 0; a < 4; ++a)
#pragma unroll
            for (int q = 0; q < 4; ++q) acc[a][q] = (f32x4){0.f, 0.f, 0.f, 0.f};
#pragma unroll
        for (int ks = 0; ks < 4; ++ks) {
            bf16x8 xf[4], bfr[4];
#pragma unroll
            for (int t = 0; t < 4; ++t) { xf[t] = frag_tr(Xw, 544, hl * 64 + t * 16, ks * 32, lane); bfr[t] = frag_tr(Bt, 288, nh * 64 + t * 16, ks * 32, lane); }
#pragma unroll
            for (int pt = 0; pt < 4; ++pt)
#pragma unroll
                for (int nt = 0; nt < 4; ++nt) acc[pt][nt] = mma(bfr[nt], xf[pt], acc[pt][nt]);
        }
        const int head = grp * 8 + hg * 4 + hl;
        bf16* dst = ST + (size_t)((b * 32 + c) * 16 + head) * 8192;
#pragma unroll
        for (int pt = 0; pt < 4; ++pt)
#pragma unroll
            for (int nt = 0; nt < 4; ++nt) { const int p = pt * 16 + (lane & 15), n = nh * 64 + nt * 16 + 4 * (lane >> 4); const f32x4 v = acc[pt][nt];
                *(v2u*)(dst + p * 128 + n) = (v2u){pk2(v[0], v[1]), pk2(v[2], v[3])}; }
    }
}

DI void ssd_scan_item(Frame& F, int item) {
    bf16* ST = (bf16*)(F.ws + WS_SLOT32); const float* CDEC = (const float*)(F.ws + WS_MISC);
    const int bh = item >> 11, b = bh >> 4, head = bh & 15, off = (item & 2047) * 4;
    float run[4]; float zf = 0.f; asm volatile("" : "+v"(zf));
#pragma unroll
    for (int k = 0; k < 4; ++k) run[k] = zf;
    v2u* base = (v2u*)(ST + (size_t)((b * 32) * 16 + head) * 8192 + off);
    const float* dbase = CDEC + (b * 32) * 16 + head;
    v2u cur[8], nxt[8]; float dc[8], dn[8];
#pragma unroll
    for (int q = 0; q < 8; ++q) { cur[q] = base[(size_t)q * 32768]; dc[q] = dbase[q * 16]; }
#pragma unroll 1
    for (int cb = 0; cb < 4; ++cb) {
        const int cn = cb < 3 ? cb + 1 : cb;
#pragma unroll
        for (int q = 0; q < 8; ++q) { nxt[q] = base[(size_t)(cn * 8 + q) * 32768]; dn[q] = dbase[(cn * 8 + q) * 16]; }
#pragma unroll
        for (int q = 0; q < 8; ++q) {
            base[(size_t)(cb * 8 + q) * 32768] = (v2u){pk2(run[0], run[1]), pk2(run[2], run[3])};
            run[0] = dc[q] * run[0] + bflo(cur[q].x); run[1] = dc[q] * run[1] + bfhi(cur[q].x); run[2] = dc[q] * run[2] + bflo(cur[q].y); run[3] = dc[q] * run[3] + bfhi(cur[q].y); }
#pragma unroll
        for (int q = 0; q < 8; ++q) { cur[q] = nxt[q]; dc[q] = dn[q]; }
    }
}

template <int DBG = 0> DI void ssd_passC_unit(Frame& F, const SsdPar& P, int unit, bf16* YO) {
    const bf16* XBC = (const bf16*)(F.ws + WS_XBC); const float* DT = (const float*)(F.ws + WS_DT);
    const bf16* ST = (const bf16*)(F.ws + WS_SLOT32); const bf16* GZ = (const bf16*)(F.ws + WS_GZ);
    const int grp = unit & 1, c = (unit >> 1) & 31, b = unit >> 6;
    const int lane = F.lane, w = F.wave;
    const size_t t0 = (size_t)b * SEQ + c * 128;
    LAS float* cs = (LAS float*)F.lds;
    LAS float* dtl = (LAS float*)(F.lds + 4096);
    LAS unsigned char* Ct = F.lds + 8192;
    LAS unsigned char* BM = F.lds + 43008;
    LAS unsigned char* Xd = F.lds + 77824;
    LAS unsigned char* Pv = F.lds + 98304;
    LAS float* rowss = (LAS float*)(F.lds + 115712);
    LAS float* wtab = (LAS float*)(F.lds + 123904);
    __syncthreads();
    (void)ssd_cumsum(DT, P.a_log, t0, grp, w, lane, cs, dtl);
    for (int i = F.tid; i < 5 * 128; i += NTHR) { const int k = i >> 7, c4 = (i & 127) * 4;
        *(LAS f32x4*)(wtab + k * 512 + c4) = *(const f32x4*)((k < 4 ? P.conv_w + k * 1536 : P.conv_b) + grp * 512 + c4); }
#pragma unroll 1
    for (int which = 0; which < 2; ++which) {
        const int cc = F.tid & 15, rb = F.tid >> 4; const ConvW W = load_convw(P.conv_w, P.conv_b, 1024 + which * 256 + grp * 128 + cc * 8);
        LAS unsigned char* dstt = which ? Ct : BM;
        conv_rows<4>(XBC, W, t0 + 4 * rb, 1024 + which * 256 + grp * 128 + cc * 8, [&](int r, const float (&o)[8]) { *(LAS v4u*)(dstt + (4 * rb + r) * 272 + cc * 16) = pack8(o, 1.0f); }); }
    const int r0 = F.tid >> 3, cc8 = (F.tid & 7) * 8, tin0 = (int)((t0 + r0) & 4095);
    const int wl = w >> 1, ws = w & 1, wp = w & 1;
    v4u XR[2][4], PVr[2]; v2u ZN[2][2], ZC[2][2];
    const unsigned lo_p = tile_loff<128>(F.tid, 128);
#define SSD_ISSUE(hd_) do { const int hcol_ = grp * 512 + (hd_) * 64 + cc8; \
        _Pragma("unroll") for (int it_ = 0; it_ < 2; ++it_) _Pragma("unroll") for (int k_ = 0; k_ < 4; ++k_) \
            if (tin0 + 64 * it_ - 3 + k_ >= 0) XR[it_][k_] = *(const v4u*)(XBC + (t0 + r0 + 64 * it_ - 3 + k_) * 1536 + hcol_); \
        tile_issue<64, 128>(PVr, ST + (size_t)((b * 32 + c) * 16 + grp * 8 + (hd_)) * 8192, 128, lo_p); \
        _Pragma("unroll") for (int lt_ = 0; lt_ < 2; ++lt_) _Pragma("unroll") for (int pt_ = 0; pt_ < 2; ++pt_) \
            ZN[lt_][pt_] = *(const v2u*)(GZ + (t0 + wl * 32 + lt_ * 16 + (lane & 15)) * 2048 + 1024 + (grp * 8 + (hd_)) * 64 + wp * 32 + pt_ * 16 + 4 * (lane >> 4)); } while (0)
    SSD_ISSUE(0);
    __syncthreads();
    f32x4 cb[2][4];
#pragma unroll
    for (int a = 0; a < 2; ++a)
#pragma unroll
        for (int q = 0; q < 4; ++q) cb[a][q] = (f32x4){0.f, 0.f, 0.f, 0.f};
#pragma unroll
    for (int ks = 0; ks < 4; ++ks) {
        bf16x8 cf[2], bfr[4];
#pragma unroll
        for (int t = 0; t < 2; ++t) cf[t] = frag_rm(Ct, 272, wl * 32 + t * 16, ks * 32, lane);
#pragma unroll
        for (int t = 0; t < 4; ++t) bfr[t] = frag_rm(BM, 272, ws * 64 + t * 16, ks * 32, lane);
#pragma unroll
        for (int lt = 0; lt < 2; ++lt)
#pragma unroll
            for (int st = 0; st < 4; ++st) cb[lt][st] = mma(bfr[st], cf[lt], cb[lt][st]);
    }
#pragma unroll 1
    for (int hd = 0; hd < 8; ++hd) {
        const int head = grp * 8 + hd;
        ConvW W;
#pragma unroll
        for (int k = 0; k < 4; ++k) { W.w[k][0] = *(const LAS f32x4*)(wtab + k * 512 + hd * 64 + cc8); W.w[k][1] = *(const LAS f32x4*)(wtab + k * 512 + hd * 64 + cc8 + 4); }
        W.b[0] = *(const LAS f32x4*)(wtab + 4 * 512 + hd * 64 + cc8); W.b[1] = *(const LAS f32x4*)(wtab + 4 * 512 + hd * 64 + cc8 + 4);
        const float dsk = P.d_ssd[head];
        __syncthreads();
        if (!(DBG & 1))
#pragma unroll
        for (int lt = 0; lt < 2; ++lt) { const int l = wl * 32 + lt * 16 + (lane & 15); const float csl = cs[hd * 128 + l], dgl = dsk * __builtin_amdgcn_rcpf(dtl[hd * 128 + l]);
#pragma unroll
            for (int st = 0; st < 4; ++st) { const int s = ws * 64 + st * 16 + 4 * (lane >> 4); f32x4 m;
                const f32x4 cs4 = *(const LAS f32x4*)(cs + hd * 128 + s);
#pragma unroll
                for (int jj = 0; jj < 4; ++jj) { const float e = __expf(fminf(csl - cs4[jj], 0.f)); m[jj] = (s + jj <= l) ? cb[lt][st][jj] * e : 0.f; m[jj] += (s + jj == l) ? dgl : 0.f; }
                *(LAS v2u*)(BM + l * 272 + s * 2) = (v2u){pk2(m[0], m[1]), pk2(m[2], m[3])}; } }
        if (!(DBG & 2))
#pragma unroll
        for (int it = 0; it < 2; ++it) { float o[8]; conv8r(XR[it], W, tin0 + 64 * it, o);
            *(LAS v4u*)(Xd + (r0 + 64 * it) * 160 + cc8 * 2) = pack8(o, dtl[hd * 128 + r0 + 64 * it]); }
        tile_commit<64, 128>(PVr, Pv, 272, F.tid);
#pragma unroll
        for (int lt = 0; lt < 2; ++lt)
#pragma unroll
            for (int pt = 0; pt < 2; ++pt) ZC[lt][pt] = ZN[lt][pt];
        if (hd < 7) SSD_ISSUE(hd + 1);
        __syncthreads();
        f32x4 yd[2][2], yo[2][2];
#pragma unroll
        for (int a2 = 0; a2 < 2; ++a2)
#pragma unroll
            for (int q = 0; q < 2; ++q) { yd[a2][q] = (f32x4){0.f, 0.f, 0.f, 0.f}; yo[a2][q] = (f32x4){0.f, 0.f, 0.f, 0.f}; }
        if (!(DBG & 4))
#pragma unroll
        for (int ks = 0; ks < 4; ++ks) {
            bf16x8 mf[2], xf[2], cf[2], pf[2];
#pragma unroll
            for (int t = 0; t < 2; ++t) { mf[t] = frag_rm(BM, 272, wl * 32 + t * 16, ks * 32, lane); xf[t] = frag_tr(Xd, 160, wp * 32 + t * 16, ks * 32, lane);
                                          cf[t] = frag_rm(Ct, 272, wl * 32 + t * 16, ks * 32, lane); pf[t] = frag_rm(Pv, 272, wp * 32 + t * 16, ks * 32, lane); }
#pragma unroll
            for (int lt = 0; lt < 2; ++lt)
#pragma unroll
                for (int pt = 0; pt < 2; ++pt) { yd[lt][pt] = mma(xf[pt], mf[lt], yd[lt][pt]); yo[lt][pt] = mma(pf[pt], cf[lt], yo[lt][pt]); }
        }
#pragma unroll
        for (int lt = 0; lt < 2; ++lt) { const int l = wl * 32 + lt * 16 + (lane & 15); const float ecs = __expf(cs[hd * 128 + l]); float ss = 0.f;
#pragma unroll
            for (int pt = 0; pt < 2; ++pt) { const int p = wp * 32 + pt * 16 + 4 * (lane >> 4);
                const v2u zv = ZC[lt][pt];
                f32x4 y = yd[lt][pt] + ecs * yo[lt][pt];
                y[0] *= silu_f(bflo(zv.x)); y[1] *= silu_f(bfhi(zv.x)); y[2] *= silu_f(bflo(zv.y)); y[3] *= silu_f(bfhi(zv.y));
                ss += (y[0] * y[0] + y[1] * y[1]) + (y[2] * y[2] + y[3] * y[3]);
                if (YO) *(v2u*)(YO + (t0 + l) * 2048 + 1024 + head * 64 + p) = (v2u){pk2(y[0], y[1]), pk2(y[2], y[3])}; }
            ss += __shfl_xor(ss, 16); ss += __shfl_xor(ss, 32);
            if ((lane >> 4) == 0) rowss[(hd * 2 + wp) * 128 + l] = ss; }
    }
#undef SSD_ISSUE
    if (!YO) return;
    asm volatile("s_waitcnt vmcnt(0)" ::: "memory");
    __syncthreads();
    LAS float* rst = (LAS float*)F.lds;
    if (F.tid < 128) { float t = 0.f;
#pragma unroll
        for (int q = 0; q < 16; ++q) t += rowss[q * 128 + F.tid];
        rst[F.tid] = rsqrtf(t * (1.f / 512.f) + EPS); }
    __syncthreads();
    { const int cc = F.tid & 63; const f32x4 n0 = *(const f32x4*)(P.ssd_norm + grp * 512 + cc * 8), n1 = *(const f32x4*)(P.ssd_norm + grp * 512 + cc * 8 + 4);
#pragma unroll 4
      for (int it = 0; it < 16; ++it) { const int r = (F.tid >> 6) + it * 8; const float rs = rst[r];
          v4u* gp = (v4u*)(YO + (t0 + r) * 2048 + 1024 + grp * 512 + cc * 8); const v4u v = *gp;
          v4u o; o.x = pk2(bflo(v.x) * rs * n0[0], bfhi(v.x) * rs * n0[1]); o.y = pk2(bflo(v.y) * rs * n0[2], bfhi(v.y) * rs * n0[3]);
          o.z = pk2(bflo(v.z) * rs * n1[0], bfhi(v.z) * rs * n1[1]); o.w = pk2(bflo(v.w) * rs * n1[2], bfhi(v.w) * rs * n1[3]);
          *gp = o; } }
}

struct S5Par { const float* lam_re; const float* lam_im; const float* log_step; const float* b_re; const float* b_im; const float* c_re; const float* c_im; const float* d_s5; };

DI void s5_build_unit(Frame& F, const S5Par& P, int unit) {
    const int g = unit >> 2, cq = unit & 3;
    bf16* AB = (bf16*)(F.ws + WS_S5MAT + (size_t)g * 262144); bf16* E = AB + 256 * 384;
    LAS f32x2v* pw = (LAS f32x2v*)F.lds;
    LAS f32x2v* Bb = (LAS f32x2v*)(F.lds + 8704);
    LAS f32x2v* Cc = (LAS f32x2v*)(F.lds + 16896);
    LAS float* Km = (LAS float*)(F.lds + 25088);
    LAS f32x2v* cf = (LAS f32x2v*)(F.lds + 29184);
    __syncthreads();
    for (int i = F.tid; i < 17 * 64; i += NTHR) { const int t = i >> 6, p = i & 63;
        const double lr = fmin((double)P.lam_re[g * 64 + p], -1e-4), li = (double)P.lam_im[g * 64 + p], dl = (double)expf(P.log_step[g]);
        const double mag = (double)expf((float)(t * lr * dl)); double sn, cs_; sincos_d(t * li * dl, sn, cs_);
        pw[i] = (f32x2v){(float)(mag * cs_), (float)(mag * sn)};
        if (t == 1) { const double den = lr * lr + li * li, nr = mag * cs_ - 1.0, ni = mag * sn; cf[p] = (f32x2v){(float)((nr * lr + ni * li) / den), (float)((ni * lr - nr * li) / den)}; } }
    __syncthreads();
    for (int i = F.tid; i < 1024; i += NTHR) { const int p = i >> 4; const f32x2v c = cf[p]; const float br = P.b_re[g * 1024 + i], bi = P.b_im[g * 1024 + i];
        Bb[i] = (f32x2v){c.x * br - c.y * bi, c.x * bi + c.y * br}; }
    for (int i = F.tid; i < 1024; i += NTHR) Cc[i] = (f32x2v){P.c_re[g * 1024 + i], P.c_im[g * 1024 + i]};
    __syncthreads();
    for (int i = F.tid; i < 1024; i += NTHR) { const int t = i >> 6, cl = (i >> 4) & 3, c2 = i & 15, c = cq * 4 + cl; float acc = 0.f;
        for (int p = 0; p < 64; ++p) { const f32x2v cc = Cc[c * 64 + p], a = pw[t * 64 + p], bb = Bb[p * 16 + c2];
            const float tr = cc.x * a.x - cc.y * a.y, ti = cc.x * a.y + cc.y * a.x; acc += tr * bb.x - ti * bb.y; }
        Km[i] = acc; }
    __syncthreads();
    for (int i = F.tid; i < 64 * 48; i += NTHR) { const int rl = i / 48, c8 = (i % 48) * 8, l = rl >> 2, cl = rl & 3, c = cq * 4 + cl, row = l * 16 + c; float v[8];
        if (c8 < 256) { const int s = c8 >> 4, c2 = c8 & 15;
#pragma unroll
            for (int k = 0; k < 8; ++k) v[k] = s <= l ? Km[((l - s) * 4 + cl) * 16 + c2 + k] : 0.f;
        } else { const bool im = c8 >= 320; const int p0 = c8 - (im ? 320 : 256);
#pragma unroll
            for (int k = 0; k < 8; ++k) { const f32x2v cc = Cc[c * 64 + p0 + k], a = pw[(l + 1) * 64 + p0 + k];
                v[k] = im ? -(cc.x * a.y + cc.y * a.x) : (cc.x * a.x - cc.y * a.y); } }
        *(v4u*)(AB + (size_t)row * 384 + c8) = (v4u){pk2(v[0], v[1]), pk2(v[2], v[3]), pk2(v[4], v[5]), pk2(v[6], v[7])}; }
    for (int i = F.tid; i < 32 * 32; i += NTHR) { const int rl = i >> 5, c8 = (i & 31) * 8, p = cq * 16 + (rl & 15), s = c8 >> 4, c2 = c8 & 15; const bool im = rl >= 16; const int row = (im ? 64 : 0) + p; float v[8];
        const f32x2v a = pw[(15 - s) * 64 + p];
#pragma unroll
        for (int k = 0; k < 8; ++k) { const f32x2v bb = Bb[p * 16 + c2 + k]; v[k] = im ? (a.x * bb.y + a.y * bb.x) : (a.x * bb.x - a.y * bb.y); }
        *(v4u*)(E + (size_t)row * 256 + c8) = (v4u){pk2(v[0], v[1]), pk2(v[2], v[3]), pk2(v[4], v[5]), pk2(v[6], v[7])}; }
}

DI void s5_gemmA_unit(Frame& F, int unit) {
    const bf16* HN = (const bf16*)(F.ws + WS_SLOT32); float* EO = (float*)(F.ws + WS_S5E);
    const int gp = unit >> 3, te = unit & 7, b = te >> 1, lane = F.lane, w = F.wave, g = 2 * gp + (w & 1), i = lane & 15, gq = lane >> 4;
    LAS unsigned char* Et = F.lds + (w & 1) * 67584;
    __syncthreads();
    load_tile(F.lds, 528, (const bf16*)(F.ws + WS_S5MAT + (size_t)(2 * gp) * 262144) + 256 * 384, 256, 128, 256, F.tid);
    load_tile(F.lds + 67584, 528, (const bf16*)(F.ws + WS_S5MAT + (size_t)(2 * gp + 1) * 262144) + 256 * 384, 256, 128, 256, F.tid);
    __syncthreads();
#pragma unroll 1
    for (int t = 0; t < 2; ++t) { const int k0 = (te & 1) * 128 + ((w >> 1) * 2 + t) * 16;
        const bf16* hp = HN + ((size_t)b * SEQ + 16 * (k0 + i) + (gq >> 1)) * D + 16 * g + 8 * (gq & 1);
        bf16x8 uf[8];
#pragma unroll
        for (int ks = 0; ks < 8; ++ks) uf[ks] = *(const bf16x8*)(hp + (size_t)(2 * ks) * D);
        f32x4 acc[8];
#pragma unroll
        for (int mt = 0; mt < 8; ++mt) acc[mt] = (f32x4){0.f, 0.f, 0.f, 0.f};
#pragma unroll
        for (int ks = 0; ks < 8; ++ks) {
#pragma unroll
            for (int mt = 0; mt < 8; ++mt) acc[mt] = mma(frag_rm(Et, 528, mt * 16, ks * 32, lane), uf[ks], acc[mt]);
            if (ks & 1) __builtin_amdgcn_sched_barrier(0); }
        float* dst = EO + ((size_t)((b * 256 + k0 + i) * 64 + g)) * 128 + 4 * gq;
#pragma unroll
        for (int mt = 0; mt < 8; ++mt) *(f32x4*)(dst + mt * 16) = acc[mt]; }
}

DI void s5_scan_task(Frame& F, const float* lam_re, const float* lam_im, const float* log_step, int task, int dbg) {
    const float* EO = (const float*)(F.ws + WS_S5E); bf16* XO = (bf16*)(F.ws + WS_S5X);
    const int b = task >> 6, g = task & 63, p = F.lane;
    f32x2v a;
    { const double lr = fmin((double)lam_re[g * 64 + p], -1e-4), li = (double)lam_im[g * 64 + p], dl = (double)expf(log_step[g]);
      const double mag = (double)expf((float)(16.0 * lr * dl)); double s, c; sincos_d(16.0 * li * dl, s, c); a = (f32x2v){(float)(mag * c), (float)(mag * s)}; }
    if (dbg == 6) a = (f32x2v){0.f, 0.f};
    float rr = 0.f, ri = 0.f;
    const float* ep = EO + ((size_t)(b * 256) * 64 + g) * 128 + p; bf16* xp = XO + ((size_t)(b * 256) * 64 + g) * 128 + p;
    float er[16], ei[16], fr_[16], fi_[16];
#pragma unroll
    for (int s2 = 0; s2 < 16; ++s2) { er[s2] = ep[(size_t)s2 * 8192]; ei[s2] = ep[(size_t)s2 * 8192 + 64]; }
#pragma unroll 1
    for (int kb = 0; kb < 16; ++kb) {
        const int kn = kb < 15 ? kb + 1 : kb;
#pragma unroll
        for (int s2 = 0; s2 < 16; ++s2) { fr_[s2] = ep[(size_t)(kn * 16 + s2) * 8192]; fi_[s2] = ep[(size_t)(kn * 16 + s2) * 8192 + 64]; }
#pragma unroll
        for (int s2 = 0; s2 < 16; ++s2) { bf16* xo = xp + (size_t)(kb * 16 + s2) * 8192;
            xo[0] = (bf16)f2bf(rr); xo[64] = (bf16)f2bf(ri);
            const float nr = a.x * rr - a.y * ri + er[s2], ni = a.x * ri + a.y * rr + ei[s2]; rr = nr; ri = ni; }
#pragma unroll
        for (int s2 = 0; s2 < 16; ++s2) { er[s2] = fr_[s2]; ei[s2] = fi_[s2]; }
    }
}

DI float gelu_tanh(float v) { const float u = 0.7978845608028654f * (v + 0.044715f * v * v * v); const float t = 1.0f - 2.0f * __builtin_amdgcn_rcpf(__expf(2.0f * u) + 1.0f); return 0.5f * v * (1.0f + t); }

DI void s5_gemmB_unit(Frame& F, const float* d_s5, int unit) {
    const bf16* HN = (const bf16*)(F.ws + WS_SLOT32); const bf16* XO = (const bf16*)(F.ws + WS_S5X); bf16* Y = (bf16*)(F.ws + WS_Y);
    const int g = unit >> 2, lh = (unit >> 1) & 1, th = unit & 1, lane = F.lane, w = F.wave, i = lane & 15, gq = lane >> 4;
    const bf16* AB = (const bf16*)(F.ws + WS_S5MAT + (size_t)g * 262144) + (size_t)(128 * lh) * 384;
    LAS unsigned char* A = F.lds;
    __syncthreads();
    load_tile(A, 784, AB, 384, 128, 384, F.tid);
    __syncthreads();
    const int colg = 16 * g + 4 * gq;
    const f32x4 dv = *(const f32x4*)(d_s5 + colg);
#pragma unroll 1
    for (int t = 0; t < 4; ++t) { const int nt = w * 4 + t, b = 2 * th + (nt >> 4), k0 = (nt & 15) * 16;
        const bf16* hp = HN + ((size_t)b * SEQ + 16 * (k0 + i) + (gq >> 1)) * D + 16 * g + 8 * (gq & 1);
        const bf16* xp = XO + ((size_t)((b * 256 + k0 + i) * 64 + g)) * 128 + 8 * gq;
        bf16x8 uf[12];
#pragma unroll
        for (int ks = 0; ks < 8; ++ks) uf[ks] = *(const bf16x8*)(hp + (size_t)(2 * ks) * D);
#pragma unroll
        for (int ks = 0; ks < 4; ++ks) uf[8 + ks] = *(const bf16x8*)(xp + ks * 32);
        f32x4 acc[8];
#pragma unroll
        for (int mt = 0; mt < 8; ++mt) acc[mt] = (f32x4){0.f, 0.f, 0.f, 0.f};
#pragma unroll
        for (int ks = 0; ks < 12; ++ks) {
#pragma unroll
            for (int mt = 0; mt < 8; ++mt) acc[mt] = mma(frag_rm(A, 784, mt * 16, ks * 32, lane), uf[ks], acc[mt]);
            __builtin_amdgcn_sched_barrier(0); }
#pragma unroll
        for (int mt = 0; mt < 8; ++mt) { const size_t tok = (size_t)b * SEQ + 16 * (k0 + i) + 8 * lh + mt;
            const v2u hv = *(const v2u*)(HN + tok * D + colg);
            const float y0 = gelu_tanh(acc[mt][0] + dv[0] * bflo(hv.x)), y1 = gelu_tanh(acc[mt][1] + dv[1] * bfhi(hv.x));
            const float y2 = gelu_tanh(acc[mt][2] + dv[2] * bflo(hv.y)), y3 = gelu_tanh(acc[mt][3] + dv[3] * bfhi(hv.y));
            *(v2u*)(Y + tok * D + colg) = (v2u){pk2(y0, y1), pk2(y2, y3)}; } }
}

#ifndef REP_BAR
#define REP_BAR 1
#endif
#ifndef REP_CONV
#define REP_CONV 1
#endif
#ifndef REP_ROW
#define REP_ROW 1
#endif
#ifndef REP_RC
#define REP_RC 1
#endif
#ifndef REP_SC
#define REP_SC 1
#endif
#ifndef SC_DBG
#define SC_DBG 0
#endif
#ifndef REP_GEMM
#define REP_GEMM 1
#endif
#ifndef REP_S5A
#define REP_S5A 1
#endif
#ifndef REP_S5S
#define REP_S5S 1
#endif
#ifndef REP_S5B
#define REP_S5B 1
#endif
#ifndef REP_RA
#define REP_RA 1
#endif
#ifndef REP_SA
#define REP_SA 1
#endif
#ifndef SKIP_EVEN
#define SKIP_EVEN 0
#endif
#ifndef SKIP_ODD
#define SKIP_ODD 0
#endif
DI int opq(int v) { asm volatile("" : "+s"(v)); return v; }
struct Args { const float* in[N_IN]; float* out; unsigned char* ws; };
constexpr int CW_BAR = 1024;

#define PHASE() do { unsigned z_ = 0u; asm volatile("" : "+s"(z_)); int l_ = __builtin_amdgcn_mbcnt_hi(~0u, __builtin_amdgcn_mbcnt_lo(~0u, z_)); int w_ = wave0; asm volatile("" : "+s"(w_)); \
        int g_ = gridDim.x, b_ = blockIdx.x; asm volatile("" : "+s"(g_), "+s"(b_)); F.G = g_; F.bid = b_; F.vcu = (g_ % 8 == 0) ? (b_ % 8) * (g_ / 8) + b_ / 8 : b_; F.lane = l_; F.wave = w_; F.tid = w_ * 64 + l_; F.out = (float*)(GAS float*)lds_ptr(F, N_IN); F.ws = (unsigned char*)(GAS unsigned char*)lds_ptr(F, N_IN + 1); } while (0)
#define WSP(T, off) ((T*)(F.ws + (off)))
#define GRID_BAR() do { PHASE(); XcdBarrier xb_; xb_.bar = (unsigned*)(F.ws + WS_CTL) + CW_BAR; xb_.x = xb_xcc_id(); xb_.tid = F.tid; xb_.st = (volatile LAS unsigned*)(F.lds + MISC_OFF) + 8; xcd_barrier(xb_); if (REP_BAR == 2) xcd_barrier(xb_); PHASE(); } while (0)
template <int layer> __device__ __forceinline__ void run_layer(Frame& F, const int wave0) {
        const int j = layer >> 1;
        if ((layer & 1) == 0) {
            if (!opq(SKIP_EVEN)) {
            { pg8::Gemm g{WSP(bf16, WS_SLOT32), WSP(bf16, WS_SLOT16), M, INP_PAD, D}; pg8::StaticOrder S; S.init(M, INP_PAD, F.G, F.bid);
              pg8::EpiInProj E{WSP(bf16, WS_QKV), WSP(bf16, WS_GZ), WSP(bf16, WS_XBC), WSP(float, WS_DT), (const float*)(F.ws + WS_ROPE), INP(I_DT_BIAS) + j * 16};
              pg8::gemm_phase<pg8::EpiInProj, pg8::StaticOrder, true, true>(F.lds, g, S, E, F.tid); }
#if REP_GEMM == 2 || defined(REP_G_INP)
            { PHASE(); pg8::Gemm g{WSP(bf16, WS_SLOT32), WSP(bf16, WS_SLOT16), M, INP_PAD, D}; pg8::StaticOrder S; S.init(M, INP_PAD, F.G, F.bid);
              pg8::EpiInProj E{WSP(bf16, WS_QKV), WSP(bf16, WS_GZ), WSP(bf16, WS_XBC), WSP(float, WS_DT), (const float*)(F.ws + WS_ROPE), INP(I_DT_BIAS) + j * 16};
              pg8::gemm_phase<pg8::EpiInProj, pg8::StaticOrder, true, true>(F.lds, g, S, E, F.tid); }
#endif
            GRID_BAR();
            for (int rep_ = 0; rep_ < REP_RA; ++rep_) for (int u = F.vcu; u < 256; u += F.G) ret_passA_unit(F, u);
            { const SsdPar SP{INP(I_CONV_W) + (size_t)j * 4 * 1536, INP(I_CONV_B) + j * 1536, INP(I_A_LOG) + j * 16, INP(I_D_SSD) + j * 16, INP(I_SSD_NORM) + j * 1024};
              for (int rep_ = 0; rep_ < REP_SA; ++rep_) for (int u = F.vcu; u < 256; u += F.G) ssd_passA_unit(F, SP, u); }
            GRID_BAR();
            for (int it = (F.bid * NTHR + F.tid); it < 131072; it += (F.G * NTHR)) ret_scan_item(F, it);
            for (int it = (F.bid * NTHR + F.tid); it < 131072; it += (F.G * NTHR)) ssd_scan_item(F, it);
            GRID_BAR();
#if REP_RC == 2
            if (layer == 0) for (int u = F.vcu; u < 256; u += F.G) ret_passC_unit(F, u, (bf16*)F.out);
#endif
            for (int u = F.vcu; u < 256; u += F.G) ret_passC_unit(F, u, WSP(bf16, WS_GZ));
            { const SsdPar SP{INP(I_CONV_W) + (size_t)j * 4 * 1536, INP(I_CONV_B) + j * 1536, INP(I_A_LOG) + j * 16, INP(I_D_SSD) + j * 16, INP(I_SSD_NORM) + j * 1024};
#if REP_SC >= 2
              if (layer == 0) for (int u = F.vcu; u < 256; u += F.G) ssd_passC_unit<SC_DBG>(F, SP, u, REP_SC == 2 ? (bf16*)F.out : (bf16*)nullptr);
#endif
              for (int u = F.vcu; u < 256; u += F.G) ssd_passC_unit(F, SP, u, WSP(bf16, WS_GZ)); }
            GRID_BAR();
            }
            __syncthreads();
            convert_weight(F, INP(I_W_UP) + (size_t)layer * D * FF, D, FF, WSP(bf16, WS_SLOT16), 0);
#if REP_CONV == 2
            convert_weight(F, INP(I_W_UP) + (size_t)layer * D * FF, D, FF, WSP(bf16, WS_SLOT16), 0);
#endif
            convert_weight(F, INP(I_W_DOWN) + (size_t)layer * FF * D, FF, D, WSP(bf16, WS_SLOT16) + (size_t)FF * D, 0);
#if REP_CONV == 2
            convert_weight(F, INP(I_W_DOWN) + (size_t)layer * FF * D, FF, D, WSP(bf16, WS_SLOT16) + (size_t)FF * D, 0);
#endif
            __syncthreads();
            if (!opq(SKIP_EVEN)) {
            { pg8::Gemm g{WSP(bf16, WS_GZ), WSP(bf16, WS_W4), M, D, 2048}; pg8::StaticOrder S; S.init(M, D, F.G, F.bid);
              pg8::EpiBf16 E{WSP(bf16, WS_M32A), D};
              pg8::gemm_phase<pg8::EpiBf16, pg8::StaticOrder, true, true>(F.lds, g, S, E, F.tid); }
#if REP_GEMM == 2 || defined(REP_G_OUT)
            { PHASE(); pg8::Gemm g{WSP(bf16, WS_GZ), WSP(bf16, WS_W4), M, D, 2048}; pg8::StaticOrder S; S.init(M, D, F.G, F.bid);
              pg8::EpiBf16 E{WSP(bf16, WS_M32A), D};
              pg8::gemm_phase<pg8::EpiBf16, pg8::StaticOrder, true, true>(F.lds, g, S, E, F.tid); }
#endif
            } else zero_fill(F, WSP(bf16, WS_M32A), (size_t)M * D * 2);
            GRID_BAR();
            if (layer == 0) row_phase<true, false>(F, WSP(bf16, WS_M32A), INP(I_X), F.out, INP(I_POST_MIX) + layer * D, INP(I_PRE_MLP) + layer * D, WSP(bf16, WS_SLOT32));
            else row_phase<false, false>(F, WSP(bf16, WS_M32A), F.out, F.out, INP(I_POST_MIX) + layer * D, INP(I_PRE_MLP) + layer * D, WSP(bf16, WS_SLOT32));
            GRID_BAR();
        } else {
            if (opq(SKIP_ODD) == 2) {
                const v4u* s_ = (const v4u*)WSP(bf16, WS_SLOT32); v4u* d_ = (v4u*)WSP(bf16, WS_Y);
                for (size_t i_ = (size_t)F.bid * NTHR + F.tid; i_ < (size_t)M * D / 8; i_ += (size_t)F.G * NTHR) d_[i_] = s_[i_];
                GRID_BAR();
            }
            if (opq(SKIP_ODD) == 0 || opq(SKIP_ODD) >= 3) {
            for (int rep_ = 0; rep_ < REP_S5A; ++rep_) for (int u = F.vcu; u < 256; u += F.G) s5_gemmA_unit(F, u);
            GRID_BAR();
            for (int rep_ = 0; rep_ < REP_S5B; ++rep_) for (int u = F.vcu; u < 256; u += F.G) {
                __syncthreads();
                if (F.wave < 2) s5_scan_task(F, INP(I_LAM_RE) + j * 4096, INP(I_LAM_IM) + j * 4096, INP(I_LOG_STEP) + j * 64, (2 * (u & 1) + F.wave) * 64 + (u >> 2), 0);
                asm volatile("s_waitcnt vmcnt(0)" ::: "memory");
                s5_gemmB_unit(F, INP(I_D_S5) + j * 1024, u); }
            GRID_BAR();
            }
            __syncthreads();
            convert_weight(F, INP(I_W_UP) + (size_t)layer * D * FF, D, FF, WSP(bf16, WS_SLOT16), 0);
            convert_weight(F, INP(I_W_DOWN) + (size_t)layer * FF * D, FF, D, WSP(bf16, WS_SLOT16) + (size_t)FF * D, 0);
            __syncthreads();
            if (opq(SKIP_ODD) != 1) {
            { pg8::Gemm g{WSP(bf16, WS_Y), WSP(bf16, WS_W4), M, 2048, D}; pg8::StaticOrder S; S.init(M, 2048, F.G, F.bid);
              pg8::EpiGlu E{WSP(bf16, WS_M32B), D};
              pg8::gemm_phase<pg8::EpiGlu, pg8::StaticOrder, true, true>(F.lds, g, S, E, F.tid); }
#if REP_GEMM == 2 || defined(REP_G_GLU)
            { PHASE(); pg8::Gemm g{WSP(bf16, WS_Y), WSP(bf16, WS_W4), M, 2048, D}; pg8::StaticOrder S; S.init(M, 2048, F.G, F.bid);
              pg8::EpiGlu E{WSP(bf16, WS_M32B), D};
              pg8::gemm_phase<pg8::EpiGlu, pg8::StaticOrder, true, true>(F.lds, g, S, E, F.tid); }
#endif
            } else zero_fill(F, WSP(bf16, WS_M32B), (size_t)M * D * 2);
            GRID_BAR();
            row_phase<false, false>(F, WSP(bf16, WS_M32B), F.out, F.out, INP(I_POST_MIX) + layer * D, INP(I_PRE_MLP) + layer * D, WSP(bf16, WS_SLOT32));
            GRID_BAR();
        }
        { pg8::Gemm g{WSP(bf16, WS_SLOT32), WSP(bf16, WS_SLOT16), M, FF, D}; pg8::StaticOrder S; S.init(M, FF, F.G, F.bid);
          pg8::EpiRelu2 E{WSP(bf16, WS_U), FF};
          pg8::gemm_phase<pg8::EpiRelu2, pg8::StaticOrder, true, true>(F.lds, g, S, E, F.tid); }
#if REP_GEMM == 2 || defined(REP_G_UP)
            { PHASE(); pg8::Gemm g{WSP(bf16, WS_SLOT32), WSP(bf16, WS_SLOT16), M, FF, D}; pg8::StaticOrder S; S.init(M, FF, F.G, F.bid);
          pg8::EpiRelu2 E{WSP(bf16, WS_U), FF};
          pg8::gemm_phase<pg8::EpiRelu2, pg8::StaticOrder, true, true>(F.lds, g, S, E, F.tid); }
#endif
        GRID_BAR();
        __syncthreads();
        if ((layer & 1) == 0) { convert_weight(F, INP(I_W_GLU_A) + (size_t)j * D * D, D, D, WSP(bf16, WS_W4), 1); convert_weight(F, INP(I_W_GLU_B) + (size_t)j * D * D, D, D, WSP(bf16, WS_W4), 2); }
#if REP_CONV == 2
        if ((layer & 1) == 0) { convert_weight(F, INP(I_W_GLU_A) + (size_t)j * D * D, D, D, WSP(bf16, WS_W4), 1); convert_weight(F, INP(I_W_GLU_B) + (size_t)j * D * D, D, D, WSP(bf16, WS_W4), 2); }
#endif
        __syncthreads();
        { pg8::Gemm g{WSP(bf16, WS_U), WSP(bf16, WS_SLOT16) + (size_t)FF * D, M, D, FF}; pg8::StaticOrder S; S.init(M, D, F.G, F.bid);
          pg8::EpiBf16 E{WSP(bf16, WS_M32B), D};
          pg8::gemm_phase<pg8::EpiBf16, pg8::StaticOrder, true, true>(F.lds, g, S, E, F.tid); }
#if REP_GEMM == 2 || defined(REP_G_DOWN)
            { PHASE(); pg8::Gemm g{WSP(bf16, WS_U), WSP(bf16, WS_SLOT16) + (size_t)FF * D, M, D, FF}; pg8::StaticOrder S; S.init(M, D, F.G, F.bid);
          pg8::EpiBf16 E{WSP(bf16, WS_M32B), D};
          pg8::gemm_phase<pg8::EpiBf16, pg8::StaticOrder, true, true>(F.lds, g, S, E, F.tid); }
#endif
        GRID_BAR();
        if (layer < DEPTH - 1) row_phase<false, false>(F, WSP(bf16, WS_M32B), F.out, F.out, INP(I_POST_MLP) + layer * D, INP(I_PRE_MIX) + (layer + 1) * D, WSP(bf16, WS_SLOT32));
        else row_phase<false, true>(F, WSP(bf16, WS_M32B), F.out, F.out, INP(I_POST_MLP) + layer * D, nullptr, nullptr);
        if (layer == 0 || layer == 2) {
            const S5Par P5{INP(I_LAM_RE) + j * 4096, INP(I_LAM_IM) + j * 4096, INP(I_LOG_STEP) + j * 64, INP(I_B_RE) + (size_t)j * 65536, INP(I_B_IM) + (size_t)j * 65536,
                           INP(I_C_RE) + (size_t)j * 65536, INP(I_C_IM) + (size_t)j * 65536, INP(I_D_S5) + j * 1024};
            for (int u = F.bid; u < 256; u += F.G) s5_build_unit(F, P5, u);
        } else if (layer == 1) {
            __syncthreads();
            convert_weight(F, INP(I_W_IN) + (size_t)D * INP, D, INP, WSP(bf16, WS_SLOT16), 0);
#if REP_CONV == 2
            convert_weight(F, INP(I_W_IN) + (size_t)D * INP, D, INP, WSP(bf16, WS_SLOT16), 0);
#endif
            zero_fill(F, WSP(bf16, WS_SLOT16) + (size_t)6688 * D, (size_t)(INP_PAD - 6688) * D * 2);
            convert_weight(F, INP(I_W_OUT) + (size_t)2048 * D, 2048, D, WSP(bf16, WS_W4), 0);
#if REP_CONV == 2
            convert_weight(F, INP(I_W_OUT) + (size_t)2048 * D, 2048, D, WSP(bf16, WS_W4), 0);
#endif
        }
        if (layer < DEPTH - 1) GRID_BAR();

}

__global__ void __launch_bounds__(NTHR, 2) trunk_fwd(Args args) {
    extern __shared__ __attribute__((aligned(16))) unsigned char lds[];
    Frame F;
    F.lds = (LAS unsigned char*)lds;
    F.G = gridDim.x; F.bid = blockIdx.x;
    { const int t = threadIdx.x;
      for (int u = t; u < (LDS_BYTES - MISC_OFF) / 4; u += NTHR) ((LAS unsigned*)(F.lds + MISC_OFF))[u] = 0u;
      __syncthreads();
      if (t < N_IN + 2) ((LAS unsigned long long*)(F.lds + MISC_OFF + 256))[t] = t < N_IN ? (unsigned long long)args.in[t] : (t == N_IN ? (unsigned long long)args.out : (unsigned long long)args.ws);
      __syncthreads(); }
    const int wave0 = __builtin_amdgcn_readfirstlane(threadIdx.x >> 6);
    PHASE();
    (void)xcd_barrier_post((unsigned*)(F.ws + WS_CTL) + CW_BAR, (volatile LAS unsigned*)(F.lds + MISC_OFF) + 8);

    build_rope(F);
    convert_weight(F, INP(I_W_IN), D, INP, WSP(bf16, WS_SLOT16), 0);
#if REP_CONV == 2
    convert_weight(F, INP(I_W_IN), D, INP, WSP(bf16, WS_SLOT16), 0);
#endif
    zero_fill(F, WSP(bf16, WS_SLOT16) + (size_t)6688 * D, (size_t)(INP_PAD - 6688) * D * 2);
    convert_weight(F, INP(I_W_OUT), 2048, D, WSP(bf16, WS_W4), 0);
#if REP_CONV == 2
    convert_weight(F, INP(I_W_OUT), 2048, D, WSP(bf16, WS_W4), 0);
#endif
    rms_rows_to_bf16(F, INP(I_X), INP(I_PRE_MIX), WSP(bf16, WS_SLOT32));
    GRID_BAR();

    run_layer<0>(F, wave0); run_layer<1>(F, wave0); run_layer<2>(F, wave0); run_layer<3>(F, wave0);
}

extern "C" void kernel_launch(void* const* d_in, const int* in_sizes, int n_in, void* d_out, int out_size, void* d_ws, size_t ws_size, hipStream_t stream) {
    static int grid = 0;
    if (grid == 0) {
        if (n_in != N_IN || out_size != M * D || ws_size < WS_END) { fprintf(stderr, "kernel_launch: unexpected shapes (n_in %d, out %d, ws %zu)\n", n_in, out_size, ws_size); grid = -1; return; }
        int dev = 0, cus = 0, per_cu = 0;
        if (hipGetDevice(&dev) != hipSuccess || hipDeviceGetAttribute(&cus, hipDeviceAttributeMultiprocessorCount, dev) != hipSuccess) { grid = -1; return; }
        if (hipFuncSetAttribute((const void*)trunk_fwd, hipFuncAttributeMaxDynamicSharedMemorySize, LDS_BYTES) != hipSuccess) { fprintf(stderr, "kernel_launch: hipFuncSetAttribute failed\n"); grid = -1; return; }
        if (hipOccupancyMaxActiveBlocksPerMultiprocessor(&per_cu, (const void*)trunk_fwd, NTHR, LDS_BYTES) != hipSuccess || per_cu < 1)
            fprintf(stderr, "kernel_launch: note: occupancy query reports %d workgroups per CU\n", per_cu);
        (void)hipGetLastError();
        grid = cus;
    }
    if (grid < 0) return;
    if (hipMemsetAsync((char*)d_ws + WS_CTL, 0, CTL_ZERO_BYTES, stream) != hipSuccess) return;
#ifdef DBG_ZERO_MISC
    if (hipMemsetAsync((char*)d_ws + WS_MISC, 0, 512 * 1024, stream) != hipSuccess) return;
#endif
    Args a{};
    for (int i = 0; i < N_IN; ++i) a.in[i] = (const float*)d_in[i];
    a.out = (float*)d_out; a.ws = (unsigned char*)d_ws;
    hipLaunchKernelGGL(trunk_fwd, dim3(grid), dim3(NTHR), LDS_BYTES, stream, a);
}
```

```cpp
#include <hip/hip_runtime.h>
#include <cstdio>
#include <cstdint>
namespace pg8 {
#define PG8_LAS __attribute__((address_space(3)))
typedef unsigned short bf16_t;
typedef short bf16x8 __attribute__((ext_vector_type(8)));
typedef float f32x4 __attribute__((ext_vector_type(4)));
typedef unsigned u32x4 __attribute__((ext_vector_type(4)));
constexpr int BM = 256, BK = 64, HALF = 128, HTB = HALF * BK * 2  , STAGE_BYTES = 8 * HTB, NXCD = 8, WGM = 8;

__host__ __device__ __forceinline__ int lds_byte(int r, int c) { const int st = (r >> 4) * 2 + (c >> 5), rr = r & 15, cc = c & 31, ob = rr * 64 + cc * 2; return st * 1024 + (ob ^ (((ob >> 9) & 1) << 5)); }
__host__ __device__ __forceinline__ void stage_rc(int b, int& R, int& C) { const int st = b / 1024, sb = b % 1024, swz = sb ^ (((sb >> 9) & 1) << 5); R = (st >> 1) * 16 + swz / 64; C = (st & 1) * 32 + (swz % 64) / 2; }
__host__ __device__ __forceinline__ int perm32(int rho) { const int n = rho >> 4, i = rho & 15; return 8 * (i >> 2) + 4 * n + (i & 3); }

struct Unit { int pm, pn; };
struct Gemm { const bf16_t* A; const bf16_t* Bt; int M, N, K; };

struct StaticOrder {
    int nM, nN, nwg, G, c;
    __host__ __device__ void init(int M, int N, int G_, int c_) { nM = M / BM; nN = N / BM; nwg = nM * nN; G = G_; c = c_; }
    __host__ __device__ bool next(int i, Unit& u) const {
        const long L = (long)i * G + c; if (L >= nwg) return false;
        int wgid = (int)L; { const int q = nwg / NXCD, r = nwg % NXCD, xcd = wgid % NXCD, off = wgid / NXCD; wgid = (xcd < r ? xcd * (q + 1) : r * (q + 1) + (xcd - r) * q) + off; }
        const int nig = WGM * nN, gid = wgid / nig, fm = gid * WGM, gsz = (nM - fm) < WGM ? (nM - fm) : WGM;
        u.pm = fm + ((wgid % nig) % gsz); u.pn = (wgid % nig) / gsz; return true;
    }
    __device__ __forceinline__ void a_ready(const Unit&) const {}
    __device__ __forceinline__ void done(const Unit&) const {}
};

typedef __bf16 bf2_t __attribute__((ext_vector_type(2))); typedef float f32x2p __attribute__((ext_vector_type(2)));
__device__ __forceinline__ unsigned cvt_pk_bf16(float lo, float hi) { const f32x2p v = {lo, hi}; return __builtin_bit_cast(unsigned, __builtin_convertvector(v, bf2_t)); }
typedef float f32x2 __attribute__((ext_vector_type(2)));
struct EpiBf16 {
    static constexpr bool PERM = true, AFTER_DRAIN = false;
    bf16_t* O; int ldc;
    __device__ __forceinline__ void operator()(const f32x4 (&acc)[2][2][4][2], const Unit& u, int wr, int wc, int fr_in, int fq_in) const {
        int fr = fr_in, fq = fq_in; asm volatile("" : "+v"(fr), "+v"(fq));
        const int row0 = u.pm * BM + wr * 64 + fr, col0 = u.pn * BM + wc * 32 + 8 * fq;
#pragma unroll
        for (int ai = 0; ai < 2; ++ai)
#pragma unroll
            for (int m = 0; m < 4; ++m) { bf16_t* rowp = O + (size_t)(row0 + ai * HALF + m * 16) * ldc + col0;
#pragma unroll
                for (int bj = 0; bj < 2; ++bj) { const f32x4 v0 = acc[ai][bj][m][0], v1 = acc[ai][bj][m][1];
                    u32x4 w; w.x = cvt_pk_bf16(v0[0], v0[1]); w.y = cvt_pk_bf16(v0[2], v0[3]); w.z = cvt_pk_bf16(v1[0], v1[1]); w.w = cvt_pk_bf16(v1[2], v1[3]);
                    *(u32x4*)(rowp + bj * HALF) = w; } }
    }
};
struct EpiGlu {
    static constexpr bool PERM = true, AFTER_DRAIN = false;
    bf16_t* O; int ldc;
    __device__ __forceinline__ void operator()(const f32x4 (&acc)[2][2][4][2], const Unit& u, int wr, int wc, int fr_in, int fq_in) const {
        int fr = fr_in, fq = fq_in; asm volatile("" : "+v"(fr), "+v"(fq));
        const int row0 = u.pm * BM + wr * 64 + fr, col0 = u.pn * HALF + wc * 32 + 8 * fq;
#pragma unroll
        for (int ai = 0; ai < 2; ++ai)
#pragma unroll
            for (int m = 0; m < 4; ++m) { bf16_t* rowp = O + (size_t)(row0 + ai * HALF + m * 16) * ldc + col0;
                f32x4 o[2];
#pragma unroll
                for (int n = 0; n < 2; ++n) { const f32x4 a = acc[ai][0][m][n], b = acc[ai][1][m][n];
#pragma unroll
                    for (int j = 0; j < 4; ++j) o[n][j] = a[j] * __builtin_amdgcn_rcpf(1.0f + __expf(-b[j])); }
                u32x4 w; w.x = cvt_pk_bf16(o[0][0], o[0][1]); w.y = cvt_pk_bf16(o[0][2], o[0][3]); w.z = cvt_pk_bf16(o[1][0], o[1][1]); w.w = cvt_pk_bf16(o[1][2], o[1][3]);
                *(u32x4*)rowp = w; }
    }
};
struct EpiRelu2 {
    static constexpr bool PERM = true, AFTER_DRAIN = false;
    bf16_t* O; int ldc;
    __device__ __forceinline__ void operator()(const f32x4 (&acc)[2][2][4][2], const Unit& u, int wr, int wc, int fr_in, int fq_in) const {
        int fr = fr_in, fq = fq_in; asm volatile("" : "+v"(fr), "+v"(fq));
        const int row0 = u.pm * BM + wr * 64 + fr, col0 = u.pn * BM + wc * 32 + 8 * fq;
#pragma unroll
        for (int ai = 0; ai < 2; ++ai)
#pragma unroll
            for (int m = 0; m < 4; ++m) { bf16_t* rowp = O + (size_t)(row0 + ai * HALF + m * 16) * ldc + col0;
#pragma unroll
                for (int bj = 0; bj < 2; ++bj) { f32x4 v0 = acc[ai][bj][m][0], v1 = acc[ai][bj][m][1];
#pragma unroll
                    for (int j = 0; j < 4; ++j) { const float a = fmaxf(v0[j], 0.f), b = fmaxf(v1[j], 0.f); v0[j] = a * a; v1[j] = b * b; }
                    u32x4 w; w.x = cvt_pk_bf16(v0[0], v0[1]); w.y = cvt_pk_bf16(v0[2], v0[3]); w.z = cvt_pk_bf16(v1[0], v1[1]); w.w = cvt_pk_bf16(v1[2], v1[3]);
                    *(u32x4*)(rowp + bj * HALF) = w; } }
    }
};
struct EpiInProj {
    static constexpr bool PERM = true, AFTER_DRAIN = false;
    bf16_t* QKV; bf16_t* GZ; bf16_t* XBC; float* DT; const float* rope; const float* dt_bias;
    __device__ __forceinline__ void operator()(const f32x4 (&acc)[2][2][4][2], const Unit& u, int wr, int wc, int fr_in, int fq_in) const {
        int fr = fr_in, fq = fq_in; asm volatile("" : "+v"(fr), "+v"(fq));
        const int pn = u.pn, row0 = u.pm * BM + wr * 64 + fr, cin = wc * 32 + 8 * fq;
        if (pn < 8) {
            const int hd = pn & 3; const bool isk = pn >= 4;
            const float lg2 = __log2f(1.0f - exp2f(-5.0f - (float)hd));
#pragma unroll
            for (int ai = 0; ai < 2; ++ai)
#pragma unroll
                for (int m = 0; m < 4; ++m) { const int row = row0 + ai * HALF + m * 16, pos = row & 4095, r = pos & 127;
                    const float sc = isk ? exp2f(-(float)r * lg2) * 0.0625f : exp2f((float)r * lg2);
                    const f32x4* rp = (const f32x4*)(rope + ((size_t)pos * 128 + cin) * 2);
                    f32x4 o1[2], o2[2];
#pragma unroll
                    for (int n = 0; n < 2; ++n) { const f32x4 cs0 = rp[2 * n], cs1 = rp[2 * n + 1];
                        const f32x4 x1 = acc[ai][0][m][n], x2 = acc[ai][1][m][n];
                        const float c[4] = {cs0[0], cs0[2], cs1[0], cs1[2]}, s[4] = {cs0[1], cs0[3], cs1[1], cs1[3]};
#pragma unroll
                        for (int j = 0; j < 4; ++j) { o1[n][j] = (x1[j] * c[j] - x2[j] * s[j]) * sc; o2[n][j] = (x2[j] * c[j] + x1[j] * s[j]) * sc; } }
                    bf16_t* rowp = QKV + (size_t)row * 3072 + pn * 256 + cin;
                    u32x4 w; w.x = cvt_pk_bf16(o1[0][0], o1[0][1]); w.y = cvt_pk_bf16(o1[0][2], o1[0][3]); w.z = cvt_pk_bf16(o1[1][0], o1[1][1]); w.w = cvt_pk_bf16(o1[1][2], o1[1][3]);
                    *(u32x4*)rowp = w;
                    w.x = cvt_pk_bf16(o2[0][0], o2[0][1]); w.y = cvt_pk_bf16(o2[0][2], o2[0][3]); w.z = cvt_pk_bf16(o2[1][0], o2[1][1]); w.w = cvt_pk_bf16(o2[1][2], o2[1][3]);
                    *(u32x4*)(rowp + HALF) = w; }
        } else if (pn < 26) {
            bf16_t* base; int ldc, colt;
            if (pn < 12) { base = QKV; ldc = 3072; colt = pn * 256; } else if (pn < 20) { base = GZ; ldc = 2048; colt = (pn - 12) * 256; } else { base = XBC; ldc = 1536; colt = (pn - 20) * 256; }
#pragma unroll
            for (int ai = 0; ai < 2; ++ai)
#pragma unroll
                for (int m = 0; m < 4; ++m) { bf16_t* rowp = base + (size_t)(row0 + ai * HALF + m * 16) * ldc + colt + cin;
#pragma unroll
                    for (int bj = 0; bj < 2; ++bj) { const f32x4 v0 = acc[ai][bj][m][0], v1 = acc[ai][bj][m][1];
                        u32x4 w; w.x = cvt_pk_bf16(v0[0], v0[1]); w.y = cvt_pk_bf16(v0[2], v0[3]); w.z = cvt_pk_bf16(v1[0], v1[1]); w.w = cvt_pk_bf16(v1[2], v1[3]);
                        *(u32x4*)(rowp + bj * HALF) = w; } }
        } else {
            if (cin < 16) {
#pragma unroll
                for (int ai = 0; ai < 2; ++ai)
#pragma unroll
                    for (int m = 0; m < 4; ++m) { float* rowp = DT + (size_t)(row0 + ai * HALF + m * 16) * 16 + cin;
#pragma unroll
                        for (int n = 0; n < 2; ++n) { f32x4 o;
#pragma unroll
                            for (int j = 0; j < 4; ++j) { const float x = acc[ai][0][m][n][j] + dt_bias[cin + 4 * n + j]; o[j] = fmaxf(x > 20.f ? x : log1pf(__expf(x)), 1e-30f); }
                            *(f32x4*)(rowp + 4 * n) = o; } }
            }
        }
    }
};
template <bool IN_F32>
struct EpiResNorm {
    static constexpr bool PERM = true, AFTER_DRAIN = true;
    const void* hin; bf16_t* hout; bf16_t* hn; const float* w_post; const float* w_pre; unsigned long long* xbuf; unsigned* cnt; unsigned want; float eps;
    static __device__ __forceinline__ f32x4 up4(unsigned w0, unsigned w1) { return (f32x4){__builtin_bit_cast(float, w0 << 16), __builtin_bit_cast(float, w0 & 0xffff0000u), __builtin_bit_cast(float, w1 << 16), __builtin_bit_cast(float, w1 & 0xffff0000u)}; }
    __device__ __forceinline__ void fused(f32x4 (&acc)[2][2][4][2], const Unit& u, int wr, int wc, int fr_in, int fq_in, PG8_LAS unsigned char* lds, int wid, int lane_in) const {
        int fr = fr_in, fq = fq_in, lane = lane_in; asm volatile("" : "+v"(fr), "+v"(fq), "+v"(lane));
        typedef float f32x2v __attribute__((ext_vector_type(2)));
        PG8_LAS f32x4* P = (PG8_LAS f32x4*)lds;
        PG8_LAS f32x2v* S = (PG8_LAS f32x2v*)(lds + 16384);
        const int rowt = wr * 64 + fr, col0 = u.pn * BM + wc * 32 + 8 * fq;
        const size_t grow0 = (size_t)u.pm * BM + rowt;
        u32x4 wp[2][4][2];
        {   f32x4 wv[2][2];
#pragma unroll
            for (int bj = 0; bj < 2; ++bj)
#pragma unroll
                for (int n = 0; n < 2; ++n) wv[bj][n] = *(const f32x4*)(w_post + col0 + bj * HALF + 4 * n);
#pragma unroll
            for (int ai = 0; ai < 2; ++ai) {
                f32x4 hx[4][2][2];
                u32x4 hp[2][4][2];
                if (!IN_F32) {
#pragma unroll
                    for (int m = 0; m < 4; ++m)
#pragma unroll
                        for (int bj = 0; bj < 2; ++bj) hp[ai][m][bj] = *(const u32x4*)((const bf16_t*)hin + (grow0 + ai * HALF + m * 16) * 2048 + col0 + bj * HALF);
                }
#pragma unroll
                for (int m = 0; m < 4; ++m) {
                    if (IN_F32 && (m & 1) == 0) {
#pragma unroll
                        for (int mm = m; mm < m + 2; ++mm)
#pragma unroll
                            for (int bj = 0; bj < 2; ++bj)
#pragma unroll
                                for (int n = 0; n < 2; ++n) hx[mm][bj][n] = *(const f32x4*)((const float*)hin + (grow0 + ai * HALF + mm * 16) * 1024 + col0 + bj * HALF + 4 * n);
                    }
                    float s1 = 0.f, s2 = 0.f, s3 = 0.f, s4 = 0.f;
#pragma unroll
                    for (int bj = 0; bj < 2; ++bj) { f32x4 wm[2];
#pragma unroll
                        for (int n = 0; n < 2; ++n) {
                            const f32x4 hv = IN_F32 ? hx[m][bj][n] : up4(hp[ai][m][bj][2 * n], hp[ai][m][bj][2 * n + 1]);
                            const f32x4 a = acc[ai][bj][m][n]; wm[n] = a * wv[bj][n];
                            s1 += (a[0] * a[0] + a[1] * a[1]) + (a[2] * a[2] + a[3] * a[3]);
                            s2 += (hv[0] * hv[0] + hv[1] * hv[1]) + (hv[2] * hv[2] + hv[3] * hv[3]);
                            s3 += (hv[0] * wm[n][0] + hv[1] * wm[n][1]) + (hv[2] * wm[n][2] + hv[3] * wm[n][3]);
                            s4 += (wm[n][0] * wm[n][0] + wm[n][1] * wm[n][1]) + (wm[n][2] * wm[n][2] + wm[n][3] * wm[n][3]); }
                        u32x4 w; w.x = cvt_pk_bf16(wm[0][0], wm[0][1]); w.y = cvt_pk_bf16(wm[0][2], wm[0][3]); w.z = cvt_pk_bf16(wm[1][0], wm[1][1]); w.w = cvt_pk_bf16(wm[1][2], wm[1][3]);
                        asm volatile("" : "+v"(w));
                        wp[ai][m][bj] = w; }
                    s1 += __shfl_xor(s1, 16); s2 += __shfl_xor(s2, 16); s3 += __shfl_xor(s3, 16); s4 += __shfl_xor(s4, 16);
                    s1 += __shfl_xor(s1, 32); s2 += __shfl_xor(s2, 32); s3 += __shfl_xor(s3, 32); s4 += __shfl_xor(s4, 32);
                    if (fq == 0) P[(ai * HALF + rowt + m * 16) * 4 + wc] = (f32x4){s1, s2, s3, s4};
                    if (IN_F32 && (m & 1)) asm volatile("" ::: "memory");
                }
                asm volatile("" ::: "memory");
            }
        }
        asm volatile("s_waitcnt lgkmcnt(0)" ::: "memory"); __builtin_amdgcn_s_barrier(); asm volatile("" ::: "memory");
        const int row = wid * 32 + (lane & 31);
        if (lane < 32) {
            const f32x4 a = P[row * 4 + 0], b = P[row * 4 + 1], c = P[row * 4 + 2], d = P[row * 4 + 3];
            const f32x4 t = (a + b) + (c + d);
            const float t0 = t[0], t1 = t[1], t2 = t[2], t3 = t[3];
            unsigned long long* slot = xbuf + ((size_t)(u.pm * BM + row) * 4 + u.pn) * 2;
            __hip_atomic_store(slot, ((unsigned long long)__builtin_bit_cast(unsigned, t1) << 32) | __builtin_bit_cast(unsigned, t0), __ATOMIC_RELAXED, __HIP_MEMORY_SCOPE_AGENT);
            __hip_atomic_store(slot + 1, ((unsigned long long)__builtin_bit_cast(unsigned, t3) << 32) | __builtin_bit_cast(unsigned, t2), __ATOMIC_RELAXED, __HIP_MEMORY_SCOPE_AGENT);
        }
        asm volatile("s_waitcnt vmcnt(0)" ::: "memory");
        if (lane == 0) __hip_atomic_fetch_add(cnt + 64 * u.pm, 1u, __ATOMIC_RELAXED, __HIP_MEMORY_SCOPE_AGENT);
        if (wid == 0) {
            unsigned sp = 0u;
            for (;;) {
                if ((unsigned)__builtin_amdgcn_readfirstlane(__hip_atomic_load(cnt + 64 * u.pm, __ATOMIC_RELAXED, __HIP_MEMORY_SCOPE_AGENT)) >= want) break;
                if (++sp > (1u << 22)) break;
                __builtin_amdgcn_s_sleep(2);
            }
            __builtin_amdgcn_fence(__ATOMIC_ACQUIRE, "agent");
        }
        asm volatile("s_waitcnt vmcnt(0) lgkmcnt(0)" ::: "memory"); __builtin_amdgcn_s_barrier(); asm volatile("" ::: "memory");
        if (lane < 32) {
            const unsigned long long* slot = xbuf + (size_t)(u.pm * BM + row) * 8; float t1 = 0.f, t2 = 0.f, t3 = 0.f, t4 = 0.f;
#pragma unroll
            for (int t = 0; t < 4; ++t) { const unsigned long long w0 = __hip_atomic_load(slot + 2 * t, __ATOMIC_RELAXED, __HIP_MEMORY_SCOPE_AGENT), w1 = __hip_atomic_load(slot + 2 * t + 1, __ATOMIC_RELAXED, __HIP_MEMORY_SCOPE_AGENT);
                t1 += __builtin_bit_cast(float, (unsigned)w0); t2 += __builtin_bit_cast(float, (unsigned)(w0 >> 32)); t3 += __builtin_bit_cast(float, (unsigned)w1); t4 += __builtin_bit_cast(float, (unsigned)(w1 >> 32)); }
            const float r1 = rsqrtf(t1 * (1.0f / 1024.0f) + eps);
            const float q = fmaxf(t2 + r1 * (2.0f * t3 + r1 * t4), 0.f);
            S[row] = (f32x2v){r1, rsqrtf(q * (1.0f / 1024.0f) + eps)};
        }
        asm volatile("s_waitcnt lgkmcnt(0)" ::: "memory"); __builtin_amdgcn_s_barrier(); asm volatile("" ::: "memory");
        u32x4 hp[2][4][2];
        if (!IN_F32) {
#pragma unroll
            for (int ai = 0; ai < 2; ++ai)
#pragma unroll
                for (int m = 0; m < 4; ++m)
#pragma unroll
                    for (int bj = 0; bj < 2; ++bj) hp[ai][m][bj] = *(const u32x4*)((const bf16_t*)hin + (grow0 + ai * HALF + m * 16) * 2048 + col0 + bj * HALF);
        }
        f32x4 wq[2][2];
#pragma unroll
        for (int bj = 0; bj < 2; ++bj)
#pragma unroll
            for (int n = 0; n < 2; ++n) wq[bj][n] = *(const f32x4*)(w_pre + col0 + bj * HALF + 4 * n);
#pragma unroll
        for (int ai = 0; ai < 2; ++ai) {
            f32x4 hx[4][2][2];
            if (IN_F32) {
#pragma unroll
                for (int m = 0; m < 4; ++m)
#pragma unroll
                    for (int bj = 0; bj < 2; ++bj)
#pragma unroll
                        for (int n = 0; n < 2; ++n) hx[m][bj][n] = *(const f32x4*)((const float*)hin + (grow0 + ai * HALF + m * 16) * 1024 + col0 + bj * HALF + 4 * n);
            }
#pragma unroll
            for (int m = 0; m < 4; ++m) { const int r = ai * HALF + rowt + m * 16; const f32x2v sr = S[r]; const size_t grow = (size_t)u.pm * BM + r;
#pragma unroll
                for (int bj = 0; bj < 2; ++bj) { f32x4 o[2];
#pragma unroll
                    for (int n = 0; n < 2; ++n) { const f32x4 hv = IN_F32 ? hx[m][bj][n] : up4(hp[ai][m][bj][2 * n], hp[ai][m][bj][2 * n + 1]);
                        o[n] = hv + up4(wp[ai][m][bj][2 * n], wp[ai][m][bj][2 * n + 1]) * sr.x; }
                    u32x4 w; w.x = cvt_pk_bf16(o[0][0], o[0][1]); w.y = cvt_pk_bf16(o[0][2], o[0][3]); w.z = cvt_pk_bf16(o[1][0], o[1][1]); w.w = cvt_pk_bf16(o[1][2], o[1][3]);
                    *(u32x4*)(hout + grow * 2048 + col0 + bj * HALF) = w;
                    const f32x4 y0 = o[0] * sr.y * wq[bj][0], y1 = o[1] * sr.y * wq[bj][1];
                    w.x = cvt_pk_bf16(y0[0], y0[1]); w.y = cvt_pk_bf16(y0[2], y0[3]); w.z = cvt_pk_bf16(y1[0], y1[1]); w.w = cvt_pk_bf16(y1[2], y1[3]);
                    *(u32x4*)(hn + grow * 1024 + col0 + bj * HALF) = w; } }
            if (IN_F32) asm volatile("" ::: "memory");
        }
    }
};
template <class Epi, class Sched, bool ALIGN_EPI = false, bool SP2 = false>
__device__ __forceinline__ void gemm_phase(PG8_LAS unsigned char* lds, const Gemm g, const Sched& S, const Epi& E, const int tid) {
    const int wid = __builtin_amdgcn_readfirstlane(tid >> 6), lane = tid & 63, wr = wid >> 2, wc = wid & 3, fr = lane & 15, fq = lane >> 4;
    const int K = g.K, nt = K / BK;
    unsigned voffA[2], voffB[2];
#pragma unroll
    for (int i = 0; i < 2; ++i) { int R, C; stage_rc(tid * 16 + i * 8192, R, C); const int Rb = Epi::PERM ? ((R & ~31) + perm32(R & 31)) : R;
        voffA[i] = (unsigned)(R * K + C) * 2u; voffB[i] = (unsigned)(Rb * K + C) * 2u; }
    const size_t kstep = (size_t)(BK * 2);
    const size_t hstep = (size_t)HALF * K * 2;
    const size_t tstep = 2 * hstep;
    const unsigned ldsw = (unsigned)wid * 1024u;
    const int aoff = lds_byte(wr * 64 + fr, fq * 8), boff = lds_byte(wc * 32 + fr, fq * 8);
#define PG8_SA(b, h) (((b) * 2 + (h)) * HTB)
#define PG8_SB(b, h) ((4 + (b) * 2 + (h)) * HTB)
#define PG8_STAGE(bufoff, gbase, voff) do { _Pragma("unroll") for (int _i = 0; _i < 2; ++_i) \
        __builtin_amdgcn_global_load_lds((const unsigned*)((const char*)(gbase) + (voff)[_i]), (PG8_LAS unsigned*)(lds + (bufoff) + ldsw + _i * 8192), 16, 0, 0); } while (0)
#define PG8_LDA(dst, b, h) do { _Pragma("unroll") for (int m = 0; m < 4; ++m) _Pragma("unroll") for (int k = 0; k < 2; ++k) dst[m][k] = *(const PG8_LAS bf16x8*)(lds + PG8_SA(b, h) + aoff + m * 2048 + k * 1024); } while (0)
#define PG8_LDB(dst, b, h) do { _Pragma("unroll") for (int n = 0; n < 2; ++n) _Pragma("unroll") for (int k = 0; k < 2; ++k) dst[n][k] = *(const PG8_LAS bf16x8*)(lds + PG8_SB(b, h) + boff + n * 2048 + k * 1024); } while (0)
#define PG8_MMA(ai, bj, At, Bt) do { __builtin_amdgcn_s_setprio(1); _Pragma("unroll") for (int m = 0; m < 4; ++m) _Pragma("unroll") for (int n = 0; n < 2; ++n) _Pragma("unroll") for (int k = 0; k < 2; ++k) \
        acc[ai][bj][m][n] = __builtin_amdgcn_mfma_f32_16x16x32_bf16(Bt[n][k], At[m][k], acc[ai][bj][m][n], 0, 0, 0); __builtin_amdgcn_s_setprio(0); } while (0)
#define PG8_WAIT_V(n) asm volatile("s_waitcnt vmcnt(" #n ")" ::: "memory")
#define PG8_WAIT_L(n) asm volatile("s_waitcnt lgkmcnt(" #n ")" ::: "memory")
#define PG8_BAR __builtin_amdgcn_s_barrier()
#define PG8_SCHED __builtin_amdgcn_sched_barrier(0)
    Unit cur, nxt; int ui = 0;
    if (!S.next(0, cur)) return;
    f32x4 acc[2][2][4][2];
#pragma unroll
    for (int a = 0; a < 2; ++a)
#pragma unroll
        for (int b = 0; b < 2; ++b)
#pragma unroll
            for (int m = 0; m < 4; ++m)
#pragma unroll
                for (int n = 0; n < 2; ++n) acc[a][b][m][n] = (f32x4){0.f, 0.f, 0.f, 0.f};
    bf16x8 At[4][2], B0[2][2], B1[2][2];
    const char* cA = (const char*)g.A + (size_t)cur.pm * tstep; const char* cB = (const char*)g.Bt + (size_t)cur.pn * tstep;
    S.a_ready(cur);
    if constexpr (SP2) {
        PG8_STAGE(PG8_SB(0, 0), cB, voffB); PG8_STAGE(PG8_SB(0, 1), cB + hstep, voffB); PG8_STAGE(PG8_SA(0, 0), cA, voffA); PG8_STAGE(PG8_SA(0, 1), cA + hstep, voffA);
        if (wr == 1) PG8_BAR;
        PG8_WAIT_V(2); PG8_BAR;
        PG8_STAGE(PG8_SB(1, 0), cB + kstep, voffB); PG8_STAGE(PG8_SA(1, 0), cA + kstep, voffA); PG8_STAGE(PG8_SB(1, 1), cB + hstep + kstep, voffB);
        PG8_WAIT_V(6); PG8_BAR;
    } else {
        PG8_STAGE(PG8_SB(0, 0), cB, voffB); PG8_STAGE(PG8_SA(0, 0), cA, voffA); PG8_STAGE(PG8_SB(0, 1), cB + hstep, voffB); PG8_STAGE(PG8_SA(0, 1), cA + hstep, voffA);
        if (wr == 1) PG8_BAR;
        PG8_WAIT_V(4); PG8_BAR;
        PG8_STAGE(PG8_SB(1, 0), cB + kstep, voffB); PG8_STAGE(PG8_SA(1, 0), cA + kstep, voffA); PG8_STAGE(PG8_SB(1, 1), cB + hstep + kstep, voffB);
        PG8_WAIT_V(6); PG8_BAR;
    }
    for (;;) {
        const bool has_next = S.next(ui + 1, nxt);
        const char* nA = has_next ? (const char*)g.A + (size_t)nxt.pm * tstep : cA; const char* nB = has_next ? (const char*)g.Bt + (size_t)nxt.pn * tstep : cB;
        for (int t = 0; t < nt; t += 2) {
            const bool last = (t == nt - 2);
            const char* a1 = cA + (size_t)(t + 1) * kstep;
            const char* a2 = last ? nA : cA + (size_t)(t + 2) * kstep; const char* b2 = last ? nB : cB + (size_t)(t + 2) * kstep;
            const char* a3 = a2 + kstep; const char* b3 = b2 + kstep;
            if (last && has_next) S.a_ready(nxt);
            if constexpr (SP2) {
            PG8_LDB(B0, 0, 0); PG8_LDB(B1, 0, 1); PG8_SCHED; PG8_LDA(At, 0, 0); PG8_STAGE(PG8_SA(1, 1), a1 + hstep, voffA);
            PG8_WAIT_V(8); PG8_WAIT_L(0); PG8_BAR; PG8_MMA(0, 0, At, B0); PG8_MMA(0, 1, At, B1); PG8_BAR; PG8_SCHED;
            PG8_LDA(At, 0, 1); PG8_STAGE(PG8_SB(0, 0), b2, voffB); PG8_STAGE(PG8_SB(0, 1), b2 + hstep, voffB); PG8_STAGE(PG8_SA(0, 0), a2, voffA);
            PG8_WAIT_V(8); PG8_WAIT_L(0); PG8_BAR; PG8_MMA(1, 0, At, B0); PG8_MMA(1, 1, At, B1); PG8_BAR; PG8_SCHED;
            PG8_LDB(B0, 1, 0); PG8_LDB(B1, 1, 1); PG8_SCHED; PG8_LDA(At, 1, 0); PG8_STAGE(PG8_SA(0, 1), a2 + hstep, voffA);
            PG8_WAIT_V(8); PG8_WAIT_L(0); PG8_BAR; PG8_MMA(0, 0, At, B0); PG8_MMA(0, 1, At, B1); PG8_BAR; PG8_SCHED;
            PG8_LDA(At, 1, 1); PG8_STAGE(PG8_SB(1, 0), b3, voffB); PG8_STAGE(PG8_SB(1, 1), b3 + hstep, voffB); PG8_STAGE(PG8_SA(1, 0), a3, voffA);
            PG8_WAIT_V(8); PG8_WAIT_L(0); PG8_BAR; PG8_MMA(1, 0, At, B0); PG8_MMA(1, 1, At, B1); PG8_BAR; PG8_SCHED;
            } else {
            PG8_LDB(B0, 0, 0); PG8_SCHED; PG8_LDA(At, 0, 0); PG8_STAGE(PG8_SA(1, 1), a1 + hstep, voffA);
            PG8_WAIT_L(8); PG8_BAR; PG8_WAIT_L(0); PG8_MMA(0, 0, At, B0); PG8_BAR; PG8_SCHED;
            PG8_LDB(B1, 0, 1); PG8_STAGE(PG8_SB(0, 0), b2, voffB);
            PG8_BAR; PG8_WAIT_L(0); PG8_MMA(0, 1, At, B1); PG8_BAR;
            PG8_LDA(At, 0, 1); PG8_STAGE(PG8_SA(0, 0), a2, voffA);
            PG8_BAR; PG8_WAIT_L(0); PG8_MMA(1, 0, At, B0); PG8_BAR; PG8_SCHED;
            PG8_STAGE(PG8_SB(0, 1), b2 + hstep, voffB);
            PG8_WAIT_V(6); PG8_BAR; PG8_MMA(1, 1, At, B1); PG8_BAR;
            PG8_LDB(B0, 1, 0); PG8_SCHED; PG8_LDA(At, 1, 0); PG8_STAGE(PG8_SA(0, 1), a2 + hstep, voffA);
            PG8_WAIT_L(8); PG8_BAR; PG8_WAIT_L(0); PG8_MMA(0, 0, At, B0); PG8_BAR; PG8_SCHED;
            PG8_LDB(B1, 1, 1); PG8_STAGE(PG8_SB(1, 0), b3, voffB);
            PG8_BAR; PG8_WAIT_L(0); PG8_MMA(0, 1, At, B1); PG8_BAR;
            PG8_LDA(At, 1, 1); PG8_STAGE(PG8_SA(1, 0), a3, voffA);
            PG8_BAR; PG8_WAIT_L(0); PG8_MMA(1, 0, At, B0); PG8_BAR; PG8_SCHED;
            PG8_STAGE(PG8_SB(1, 1), b3 + hstep, voffB);
            PG8_WAIT_V(6); PG8_BAR; PG8_MMA(1, 1, At, B1); PG8_BAR;
            }
        }
        if constexpr (ALIGN_EPI) { if (wr == 0) PG8_BAR; }
        if constexpr (!Epi::AFTER_DRAIN) { E(acc, cur, wr, wc, fr, fq);
#if defined(REP_EPI) && REP_EPI == 2
            E(acc, cur, wr, wc, fr, fq);
#endif
            S.done(cur); }
        if (!has_next) break;
#pragma unroll
        for (int a = 0; a < 2; ++a)
#pragma unroll
            for (int b = 0; b < 2; ++b)
#pragma unroll
                for (int m = 0; m < 4; ++m)
#pragma unroll
                    for (int n = 0; n < 2; ++n) acc[a][b][m][n] = (f32x4){0.f, 0.f, 0.f, 0.f};
        cur = nxt; cA = nA; cB = nB; ++ui;
        if constexpr (ALIGN_EPI) { if (wr == 1) PG8_BAR; }
    }
    PG8_WAIT_V(0);
    if constexpr (!ALIGN_EPI) { if (wr == 0) PG8_BAR; }
    PG8_BAR;
    if constexpr (Epi::AFTER_DRAIN) { E.fused(acc, cur, wr, wc, fr, fq, lds, wid, lane); S.done(cur); }
#undef PG8_SA
#undef PG8_SB
#undef PG8_STAGE
#undef PG8_LDA
#undef PG8_LDB
#undef PG8_MMA
#undef PG8_WAIT_V
#undef PG8_WAIT_L
#undef PG8_BAR
#undef PG8_SCHED
}
}
constexpr int NWAVES = 8, NTHR = 512;
constexpr int BATCH = 4, SEQ = 4096, D = 1024, M = BATCH * SEQ, FF = 4096, DEPTH = 4;
constexpr int INP = 6672, INP_PAD = 6912;
constexpr float EPS = 1e-6f;
enum { I_X = 0, I_PRE_MIX, I_POST_MIX, I_PRE_MLP, I_POST_MLP, I_W_IN, I_CONV_W, I_CONV_B, I_DT_BIAS, I_A_LOG, I_D_SSD, I_SSD_NORM, I_W_OUT,
       I_LAM_RE, I_LAM_IM, I_LOG_STEP, I_B_RE, I_B_IM, I_C_RE, I_C_IM, I_D_S5, I_W_GLU_A, I_W_GLU_B, I_W_UP, I_W_DOWN, N_IN };
constexpr size_t MiB = 1u << 20;
constexpr size_t WS_CTL = 0, CTL_ZERO_BYTES = 64 * 1024;
constexpr size_t WS_MISC = 512 * 1024;
constexpr size_t WS_ROPE = 1 * MiB;
constexpr size_t WS_W4 = 5 * MiB;
constexpr size_t WS_SLOT16 = 9 * MiB;
constexpr size_t WS_SLOT32 = 25 * MiB;
constexpr size_t WS_QKV = 57 * MiB;
constexpr size_t WS_GZ = 153 * MiB;
constexpr size_t WS_XBC = 217 * MiB;
constexpr size_t WS_DT = 265 * MiB;
constexpr size_t WS_END = 268 * MiB;
constexpr size_t WS_M32A = 57 * MiB;
constexpr size_t WS_M32B = 185 * MiB;
constexpr size_t WS_U = 57 * MiB;
constexpr size_t WS_S5MAT = 217 * MiB;
constexpr size_t WS_S5E = 73 * MiB;
constexpr size_t WS_S5X = 105 * MiB;
constexpr size_t WS_Y = 121 * MiB;
constexpr size_t WS_DOWN1 = 233 * MiB;
constexpr size_t WS_XBUF_A = 266 * MiB, WS_XBUF_B = 267 * MiB;
constexpr int CW_PANEL = 8192;
constexpr int SCR_BYTES = 143360;
constexpr int MISC_OFF = SCR_BYTES;
constexpr int LDS_BYTES = 147456;

#define GAS __attribute__((address_space(1)))
#define LAS __attribute__((address_space(3)))
#define DI __device__ __forceinline__
typedef unsigned short bf16;
typedef unsigned v4u __attribute__((ext_vector_type(4)));
typedef unsigned v2u __attribute__((ext_vector_type(2)));
typedef float f32x4 __attribute__((ext_vector_type(4)));
typedef float f32x2v __attribute__((ext_vector_type(2)));
typedef short bf16x8 __attribute__((ext_vector_type(8)));
typedef short v4i16_t __attribute__((ext_vector_type(4)));
typedef GAS unsigned gu32;
#define RLX_AGENT __ATOMIC_RELAXED, __HIP_MEMORY_SCOPE_AGENT
#define LDS_WAIT() asm volatile("s_waitcnt lgkmcnt(0)" ::: "memory")
#define VM_WAIT() asm volatile("s_waitcnt vmcnt(0)" ::: "memory")
DI unsigned f2bf(float f) { unsigned u = __builtin_bit_cast(unsigned, f); return (u + 0x7fffu + ((u >> 16) & 1u)) >> 16; }
typedef __bf16 bf2_t __attribute__((ext_vector_type(2)));
DI unsigned pk2(float lo, float hi) { const f32x2v v = {lo, hi}; return __builtin_bit_cast(unsigned, __builtin_convertvector(v, bf2_t)); }
DI float bf2f(unsigned short b) { return __builtin_bit_cast(float, ((unsigned)b) << 16); }
DI float bflo(unsigned w) { return __builtin_bit_cast(float, w << 16); }
DI float bfhi(unsigned w) { return __builtin_bit_cast(float, w & 0xffff0000u); }
DI float wave_sum(float v) {
#pragma unroll
    for (int o = 1; o < 64; o <<= 1) v += __shfl_xor(v, o);
    return v;
}
DI float silu_f(float x) { return x * __builtin_amdgcn_rcpf(1.0f + __expf(-x)); }
DI void sincos_d(double x, double& s, double& c) {
    const double k = rint(x * 0.15915494309189533576888376337251);
    const double r = fma(-k, 6.283185307179586476925286766559, x), r2 = r * r;
    double ps = 1.0 / 1.0888869450418352e28, pc = 1.0 / 3.0488834461171384e29;
    const double fs[13] = {1.0 / 1.5511210043330986e25, 1.0 / 2.5852016738884978e22, 1.0 / 5.109094217170944e19, 1.0 / 1.21645100408832e17, 1.0 / 355687428096000.0, 1.0 / 1307674368000.0,
                           1.0 / 6227020800.0, 1.0 / 39916800.0, 1.0 / 362880.0, 1.0 / 5040.0, 1.0 / 120.0, 1.0 / 6.0, 1.0};
    const double fc[14] = {1.0 / 4.0329146112660565e26, 1.0 / 6.204484017332394e23, 1.0 / 1.1240007277776077e21, 1.0 / 2.43290200817664e18, 1.0 / 6402373705728000.0, 1.0 / 20922789888000.0,
                           1.0 / 87178291200.0, 1.0 / 479001600.0, 1.0 / 3628800.0, 1.0 / 40320.0, 1.0 / 720.0, 1.0 / 24.0, 1.0 / 2.0, 1.0};
#pragma unroll
    for (int i = 0; i < 13; ++i) ps = fs[i] - ps * r2;
#pragma unroll
    for (int i = 0; i < 14; ++i) pc = fc[i] - pc * r2;
    s = ps * r; c = pc;
}
#define XB_TMO      128
#define XB_XCNT(j)  (256  + 64 * (j))
#define XB_XSUB(j)  (1280 + 64 * (j))
#define XB_XGEN(j)  (2304 + 64 * (j))
#define XB_TOP      3328
#define XB_TOPGEN   3392
#define XCD_BAR_WORDS 3456
#define XB_SPIN_CAP (1u << 18)

__device__ __forceinline__ unsigned xb_ld(unsigned* p)              { return __hip_atomic_load(p, __ATOMIC_RELAXED, __HIP_MEMORY_SCOPE_AGENT); }
__device__ __forceinline__ unsigned xb_add(unsigned* p, unsigned v) { return __hip_atomic_fetch_add(p, v, __ATOMIC_RELAXED, __HIP_MEMORY_SCOPE_AGENT); }
__device__ __forceinline__ unsigned xb_xcc_id() { return (unsigned)__builtin_amdgcn_s_getreg((3 << 11) | 20) & 0xFu; }
#define XB_SPIN(cond, bar) do { unsigned _sp = 0; while (cond) { __builtin_amdgcn_s_sleep(1); \
    if ((++_sp & 255u) == 0u) { if (xb_ld(&(bar)[XB_TMO])) break; if (_sp > XB_SPIN_CAP) { atomicAdd(&(bar)[XB_TMO], 1u); break; } } } } while (0)

struct XcdBarrier {
    unsigned* bar; unsigned x; int tid;
    volatile LAS unsigned* st;
};

__device__ __forceinline__ XcdBarrier xcd_barrier_post(unsigned* bar, volatile LAS unsigned* st) {
    XcdBarrier b; b.bar = bar; b.x = xb_xcc_id(); b.st = st;
    if (threadIdx.x == 0) (void)xb_add(&bar[XB_XCNT(b.x)], 1u);
    return b;
}
__device__ __forceinline__ void xcd_barrier_complete(unsigned* bar, unsigned x, unsigned& nloc, unsigned& nx) {
    const unsigned G = gridDim.x * gridDim.y * gridDim.z;
    unsigned sum, cnt, mine, sp = 0u;
    for (;;) {
        sum = 0u; cnt = 0u; mine = 0u;
#pragma unroll
        for (unsigned j = 0; j < 16; ++j) { const unsigned c = xb_ld(&bar[XB_XCNT(j)]); sum += c; cnt += (c > 0u) ? 1u : 0u; mine = (j == x) ? c : mine; }
        if (sum == G) break;
        __builtin_amdgcn_s_sleep(1);
        if ((++sp & 255u) == 0u) { if (xb_ld(&bar[XB_TMO])) break; if (sp > XB_SPIN_CAP) { atomicAdd(&bar[XB_TMO], 1u); break; } }
    }
    nloc = mine > 0u ? mine : 1u; nx = cnt > 0u ? cnt : 1u;
}

__device__ __forceinline__ void xcd_barrier(const XcdBarrier& b) {
    asm volatile("s_waitcnt vmcnt(0)" ::: "memory");
    __syncthreads();
    if (b.tid == 0) {
        unsigned* bar = b.bar;
        __builtin_amdgcn_s_waitcnt(0);
        unsigned nloc = b.st[0], nx = b.st[1];
        if (nloc == 0u) { xcd_barrier_complete(bar, b.x, nloc, nx); b.st[0] = nloc; b.st[1] = nx; }
        const unsigned old = xb_add(&bar[XB_XSUB(b.x)], 1u);
        const unsigned gen = old / nloc;
        if (old + 1u == (gen + 1u) * nloc) {
            __builtin_amdgcn_fence(__ATOMIC_RELEASE, "agent");
            asm volatile("s_waitcnt vmcnt(0)" ::: "memory");
            const unsigned og = xb_add(&bar[XB_TOP], 1u);
            const unsigned tg = og / nx;
            if (og + 1u == (tg + 1u) * nx) xb_add(&bar[XB_TOPGEN], 1u);
            else XB_SPIN(xb_ld(&bar[XB_TOPGEN]) == tg, bar);
            __builtin_amdgcn_fence(__ATOMIC_ACQUIRE, "agent");
            xb_add(&bar[XB_XGEN(b.x)], 1u);
            asm volatile("s_waitcnt vmcnt(0)" ::: "memory");
        } else {
            XB_SPIN(xb_ld(&bar[XB_XGEN(b.x)]) == gen, bar);
            __builtin_amdgcn_fence(__ATOMIC_ACQUIRE, "agent");
            asm volatile("s_waitcnt vmcnt(0)" ::: "memory");
        }
    }
    __syncthreads();
}

struct Frame {
    LAS unsigned char* lds;
    int tid, lane, wave, G, bid, vcu;
    float* out; unsigned char* ws;
};
DI unsigned long long lds_ptr(const Frame& F, int i) {
    unsigned a_ = (unsigned)(size_t)(F.lds + MISC_OFF + 256) + 8u * (unsigned)i; asm volatile("" : "+v"(a_));
    const unsigned long long v = *(const volatile LAS unsigned long long*)a_;
    const unsigned lo = __builtin_amdgcn_readfirstlane((unsigned)v), hi = __builtin_amdgcn_readfirstlane((unsigned)(v >> 32));
    return ((unsigned long long)hi << 32) | lo;
}
#define INP(i) ((const float*)(const GAS float*)lds_ptr(F, (i)))
DI int gwave(const Frame& F) { return F.bid * NWAVES + F.wave; }

DI bf16x8 frag_rm(const LAS unsigned char* t, int S, int r0, int k0, int lane) { return *(const LAS bf16x8*)(t + (r0 + (lane & 15)) * S + (k0 + 8 * (lane >> 4)) * 2); }
DI bf16x8 frag_tr(const LAS unsigned char* t, int S, int r0, int k0, int lane) {
    const int g = lane >> 4, q = (lane & 15) >> 2, p = lane & 3;
    const LAS unsigned char* a = t + (k0 + 8 * g + q) * S + (r0 + 4 * p) * 2;
    const v4i16_t lo = __builtin_amdgcn_ds_read_tr16_b64_v4i16((LAS v4i16_t*)a);
    const v4i16_t hi = __builtin_amdgcn_ds_read_tr16_b64_v4i16((LAS v4i16_t*)(a + 4 * S));
    return __builtin_shufflevector(lo, hi, 0, 1, 2, 3, 4, 5, 6, 7);
}
DI f32x4 mma(bf16x8 a, bf16x8 b, f32x4 c) { return __builtin_amdgcn_mfma_f32_16x16x32_bf16(a, b, c, 0, 0, 0); }

DI void load_tile(LAS unsigned char* dst, int S, const bf16* src, size_t ld, int rows, int cols, int tid) {
    const int cpr = cols >> 3, n = rows * cpr;
    for (int i = tid; i < n; i += NTHR) { const int r = i / cpr, c = i - r * cpr;
        *(LAS v4u*)(dst + r * S + c * 16) = *(const v4u*)(src + (size_t)r * ld + c * 8); }
}

template <int COLS> DI unsigned tile_loff(int tid, unsigned ld) { constexpr int CPR = COLS / 8; return (unsigned)(tid / CPR) * ld + (unsigned)(tid % CPR) * 8u; }
template <int ROWS, int COLS> DI void tile_issue(v4u* r, const bf16* src, unsigned ld, unsigned loff) {
    constexpr int CPR = COLS / 8, N = ROWS * COLS / 4096, RSTEP = NTHR / CPR;
#pragma unroll
    for (int i = 0; i < N; ++i) r[i] = *(const v4u*)((src + (size_t)i * RSTEP * ld) + loff);
}
template <int ROWS, int COLS> DI void tile_commit(const v4u* r, LAS unsigned char* dst, int S, int tid) {
    constexpr int CPR = COLS / 8, N = ROWS * COLS / 4096, RSTEP = NTHR / CPR;
    LAS unsigned char* p = dst + (tid / CPR) * S + (tid % CPR) * 16;
#pragma unroll
    for (int i = 0; i < N; ++i) *(LAS v4u*)(p + i * RSTEP * S) = r[i];
}

DI void transpose_item(const float* W, int K, int N, bf16* WT, int mode, LAS float* scr, int item, int lane) {
    const int nblk = (N + 31) / 32, kb = item / nblk, nb = item % nblk, k0 = 64 * kb, n0 = 32 * nb;
    const int n4 = 4 * (lane & 7), nl = n0 + n4;
    f32x4 v[8];
#pragma unroll
    for (int i = 0; i < 8; ++i) v[i] = nl < N ? *(const f32x4*)(W + (size_t)(k0 + 8 * i + (lane >> 3)) * N + nl) : (f32x4){0.f, 0.f, 0.f, 0.f};
#pragma unroll
    for (int i = 0; i < 8; ++i) { LAS float* d = scr + (8 * i + (lane >> 3)) * 33 + n4; d[0] = v[i][0]; d[1] = v[i][1]; d[2] = v[i][2]; d[3] = v[i][3]; }
    LDS_WAIT(); asm volatile("" ::: "memory");
    const int c = lane & 7;
#pragma unroll
    for (int j = 0; j < 4; ++j) { const int n = (lane >> 3) + 8 * j; const LAS float* s = scr + (8 * c) * 33 + n;
        v4u o; o.x = pk2(s[0 * 33], s[1 * 33]); o.y = pk2(s[2 * 33], s[3 * 33]); o.z = pk2(s[4 * 33], s[5 * 33]); o.w = pk2(s[6 * 33], s[7 * 33]);
        const int ng = n0 + n; const int row = mode == 0 ? ng : (256 * (ng >> 7) + (ng & 127) + (mode == 2 ? 128 : 0));
        *(v4u*)(WT + (size_t)row * K + k0 + 8 * c) = o; }
    LDS_WAIT(); asm volatile("" ::: "memory");
}
DI void convert_weight(Frame& F, const float* W, int K, int N, bf16* WT, int mode, int w0 = 0) {
    if (F.wave < w0) return;
    LAS float* scr = (LAS float*)(F.lds + F.wave * 16384);
    const int nw = NWAVES - w0, nitems = (K / 64) * ((N + 31) / 32), NGW = F.G * nw;
    for (int it = F.bid * nw + (F.wave - w0); it < nitems; it += NGW) transpose_item(W, K, N, WT, mode, scr, it, F.lane);
}
DI void zero_fill(Frame& F, void* p, size_t bytes) {
    v4u* q = (v4u*)p; const size_t n = bytes / 16;
    for (size_t i = (size_t)F.bid * NTHR + F.tid; i < n; i += (size_t)F.G * NTHR) q[i] = (v4u){0u, 0u, 0u, 0u};
}

DI void build_rope(Frame& F) {
    float* rope = (float*)(F.ws + WS_ROPE);
    for (int i = F.bid * NTHR + F.tid; i < 4096 * 128; i += F.G * NTHR) { const int pos = i >> 7, d = i & 127;
        double inv = 1.0; { double r = 0.930572040929699; int e = d; while (e) { if (e & 1) inv *= r; r *= r; e >>= 1; } }
        const float ang = (float)pos * (float)inv;
        double s, c; sincos_d((double)ang, s, c);
        *(f32x2v*)(rope + 2 * (size_t)i) = (f32x2v){(float)c, (float)s}; }
}
DI void rms_rows_to_bf16(Frame& F, const float* src, const float* w, bf16* dst) {
    const int NGW = F.G * NWAVES;
    f32x4 wv[4];
#pragma unroll
    for (int j = 0; j < 4; ++j) wv[j] = ((const f32x4*)w)[F.lane + 64 * j];
    for (int m = gwave(F); m < M; m += NGW) { const f32x4* xr = (const f32x4*)(src + (size_t)m * D) + F.lane;
        f32x4 v[4]; float s = 0.f;
#pragma unroll
        for (int j = 0; j < 4; ++j) { v[j] = xr[64 * j]; s += (v[j].x * v[j].x + v[j].y * v[j].y) + (v[j].z * v[j].z + v[j].w * v[j].w); }
        const float rs = rsqrtf(wave_sum(s) * (1.f / D) + EPS);
        v2u* o8 = (v2u*)(dst + (size_t)m * D) + F.lane;
#pragma unroll
        for (int j = 0; j < 4; ++j) { const f32x4 y = v[j] * rs * wv[j]; o8[64 * j] = (v2u){pk2(y.x, y.y), pk2(y.z, y.w)}; } }
}
template <bool IN_F32, bool OUT_F32>
DI void row_phase(Frame& F, const bf16* mbuf, const void* hbase, void* hout, const float* w_post, const float* w_pre, bf16* hn) {
    const int NGW = F.G * NWAVES;
    f32x4 wp[4], wq[4];
#pragma unroll
    for (int j = 0; j < 4; ++j) { wp[j] = ((const f32x4*)w_post)[F.lane + 64 * j]; wq[j] = w_pre ? ((const f32x4*)w_pre)[F.lane + 64 * j] : (f32x4){0.f, 0.f, 0.f, 0.f}; }
    for (int m = gwave(F); m < M; m += NGW) {
        const v2u* mr = (const v2u*)(mbuf + (size_t)m * D) + F.lane;
        f32x4 v[4], h[4]; float s = 0.f;
#pragma unroll
        for (int j = 0; j < 4; ++j) { const v2u mv = mr[64 * j]; v[j] = (f32x4){bflo(mv.x), bfhi(mv.x), bflo(mv.y), bfhi(mv.y)};
            if (IN_F32) h[j] = ((const f32x4*)((const float*)hbase + (size_t)m * D) + F.lane)[64 * j];
            else { const v2u hv = ((const v2u*)((const bf16*)hbase + (size_t)m * 2048) + F.lane)[64 * j]; h[j] = (f32x4){bflo(hv.x), bfhi(hv.x), bflo(hv.y), bfhi(hv.y)}; }
            s += (v[j].x * v[j].x + v[j].y * v[j].y) + (v[j].z * v[j].z + v[j].w * v[j].w); }
#ifdef PERT_ROW
        const float rs = rsqrtf(wave_sum(s) * (1.f / D) + EPS) * PERT_ROW; float s2 = 0.f;
#else
        const float rs = rsqrtf(wave_sum(s) * (1.f / D) + EPS); float s2 = 0.f;
#endif
#ifdef ALG_Q
        float q2 = 0.f, q3 = 0.f, q4 = 0.f;
#pragma unroll
        for (int j = 0; j < 4; ++j) { const f32x4 wm = v[j] * wp[j]; q2 += (h[j].x * h[j].x + h[j].y * h[j].y) + (h[j].z * h[j].z + h[j].w * h[j].w);
            q3 += (h[j].x * wm.x + h[j].y * wm.y) + (h[j].z * wm.z + h[j].w * wm.w); q4 += (wm.x * wm.x + wm.y * wm.y) + (wm.z * wm.z + wm.w * wm.w); h[j] = h[j] + wm * rs; }
        q2 = wave_sum(q2); q3 = wave_sum(q3); q4 = wave_sum(q4);
        s2 = fmaxf(q2 + rs * (2.0f * q3 + rs * q4), 0.f) * (1.0f / 64.0f);
#else
#pragma unroll
        for (int j = 0; j < 4; ++j) { h[j] = h[j] + v[j] * rs * wp[j]; s2 += (h[j].x * h[j].x + h[j].y * h[j].y) + (h[j].z * h[j].z + h[j].w * h[j].w); }
#endif
        if (OUT_F32) { f32x4* ho = (f32x4*)((float*)hout + (size_t)m * D) + F.lane;
#pragma unroll
            for (int j = 0; j < 4; ++j) ho[64 * j] = h[j]; }
        else { v2u* ho = (v2u*)((bf16*)hout + (size_t)m * 2048) + F.lane;
#pragma unroll
            for (int j = 0; j < 4; ++j) ho[64 * j] = (v2u){pk2(h[j].x, h[j].y), pk2(h[j].z, h[j].w)}; }
        if (hn) { const float rs2 = rsqrtf(wave_sum(s2) * (1.f / D) + EPS);
            v2u* o8 = (v2u*)(hn + (size_t)m * D) + F.lane;
#pragma unroll
            for (int j = 0; j < 4; ++j) { const f32x4 y = h[j] * rs2 * wq[j]; o8[64 * j] = (v2u){pk2(y.x, y.y), pk2(y.z, y.w)}; } }
    }
}

DI void hn_from_h(Frame& F, const bf16* hbase, const float* w, bf16* hn) {
    const int NGW = F.G * NWAVES;
    f32x4 wq[4];
#pragma unroll
    for (int j = 0; j < 4; ++j) wq[j] = ((const f32x4*)w)[F.lane + 64 * j];
    for (int m = gwave(F); m < M; m += NGW) {
        f32x4 h[4]; float s2 = 0.f;
#pragma unroll
        for (int j = 0; j < 4; ++j) { const v2u hv = ((const v2u*)(hbase + (size_t)m * 2048) + F.lane)[64 * j]; h[j] = (f32x4){bflo(hv.x), bfhi(hv.x), bflo(hv.y), bfhi(hv.y)};
            s2 += (h[j].x * h[j].x + h[j].y * h[j].y) + (h[j].z * h[j].z + h[j].w * h[j].w); }
        const float rs2 = rsqrtf(wave_sum(s2) * (1.f / D) + EPS);
        v2u* o8 = (v2u*)(hn + (size_t)m * D) + F.lane;
#pragma unroll
        for (int j = 0; j < 4; ++j) { const f32x4 y = h[j] * rs2 * wq[j]; o8[64 * j] = (v2u){pk2(y.x, y.y), pk2(y.z, y.w)}; }
    }
}

DI float head_lg2(int h) { return __log2f(1.0f - exp2f(-5.0f - (float)h)); }

DI void ret_passA_unit(Frame& F, int unit) {
    const bf16* QKV = (const bf16*)(F.ws + WS_QKV); bf16* RST = (bf16*)(F.ws + WS_SLOT16);
    const int eh = unit & 1, sc = (unit >> 1) & 7, h = (unit >> 4) & 3, b = unit >> 6;
    const int lane = F.lane, w = F.wave, we = w >> 2, wd = w & 3;
    const float lg2 = head_lg2(h), g128 = exp2f(128.f * lg2), g127 = exp2f(127.f * lg2);
    LAS unsigned char* Kt = F.lds;
    LAS unsigned char* Vt = F.lds + 128 * 544;
    f32x4 acc[4][4];
#pragma unroll
    for (int a = 0; a < 4; ++a)
#pragma unroll
        for (int c = 0; c < 4; ++c) acc[a][c] = (f32x4){0.f, 0.f, 0.f, 0.f};
    v4u TK[8], TV[4];
    const unsigned lo_k = tile_loff<256>(F.tid, 3072), lo_v = tile_loff<128>(F.tid, 3072);
    const bf16* kbase = QKV + ((size_t)b * SEQ + sc * 512) * 3072 + 1024 + h * 256; const bf16* vbase = kbase + 1024 + eh * 128;
    tile_issue<128, 256>(TK, kbase, 3072, lo_k); tile_issue<128, 128>(TV, vbase, 3072, lo_v);
#pragma unroll 1
    for (int j = 0; j < 4; ++j) {
        if (j) {
#pragma unroll
            for (int a = 0; a < 4; ++a)
#pragma unroll
                for (int c = 0; c < 4; ++c) acc[a][c] *= g128; }
        __syncthreads();
        tile_commit<128, 256>(TK, Kt, 544, F.tid); tile_commit<128, 128>(TV, Vt, 288, F.tid);
        if (j < 3) { tile_issue<128, 256>(TK, kbase + (size_t)(j + 1) * 128 * 3072, 3072, lo_k); tile_issue<128, 128>(TV, vbase + (size_t)(j + 1) * 128 * 3072, 3072, lo_v); }
        __syncthreads();
#pragma unroll
        for (int ks = 0; ks < 4; ++ks) {
            bf16x8 vf[4], kf[4];
#pragma unroll
            for (int t = 0; t < 4; ++t) { vf[t] = frag_tr(Vt, 288, we * 64 + t * 16, ks * 32, lane); kf[t] = frag_tr(Kt, 544, wd * 64 + t * 16, ks * 32, lane); }
#pragma unroll
            for (int et = 0; et < 4; ++et)
#pragma unroll
                for (int dt = 0; dt < 4; ++dt) acc[et][dt] = mma(kf[dt], vf[et], acc[et][dt]);
        }
    }
    bf16* dst = RST + ((size_t)((b * 4 + h) * 8 + sc) * 256) * 256;
#pragma unroll
    for (int et = 0; et < 4; ++et)
#pragma unroll
        for (int dt = 0; dt < 4; ++dt) { const int e = eh * 128 + we * 64 + et * 16 + (lane & 15), d = wd * 64 + dt * 16 + 4 * (lane >> 4);
            const f32x4 v = acc[et][dt] * g127;
            *(v2u*)(dst + (size_t)e * 256 + d) = (v2u){pk2(v[0], v[1]), pk2(v[2], v[3])}; }
}

DI void ret_scan_item(Frame& F, int item) {
    bf16* RST = (bf16*)(F.ws + WS_SLOT16);
    const int bh = item >> 13, off = (item & 8191) * 8, h = bh & 3;
    const float g512 = exp2f(512.f * head_lg2(h));
    float run[8]; float zf = 0.f; asm volatile("" : "+v"(zf));
#pragma unroll
    for (int k = 0; k < 8; ++k) run[k] = zf;
    v4u* base = (v4u*)(RST + (size_t)(bh * 8) * 65536 + off);
    v4u in[8];
#pragma unroll
    for (int sc = 0; sc < 8; ++sc) in[sc] = base[(size_t)sc * 8192];
#pragma unroll
    for (int sc = 0; sc < 8; ++sc) {
        v4u o; o.x = pk2(run[0], run[1]); o.y = pk2(run[2], run[3]); o.z = pk2(run[4], run[5]); o.w = pk2(run[6], run[7]);
        base[(size_t)sc * 8192] = o;
        const unsigned cw[4] = {in[sc].x, in[sc].y, in[sc].z, in[sc].w};
#pragma unroll
        for (int k = 0; k < 4; ++k) { run[2 * k] = g512 * run[2 * k] + bflo(cw[k]); run[2 * k + 1] = g512 * run[2 * k + 1] + bfhi(cw[k]); }
    }
}

DI void ret_passC_unit(Frame& F, int unit, bf16* YO) {
    const bf16* QKV = (const bf16*)(F.ws + WS_QKV); const bf16* RST = (const bf16*)(F.ws + WS_SLOT16); const bf16* GZ = (const bf16*)(F.ws + WS_GZ);
    const int qp = unit & 1, sc = (unit >> 1) & 7, h = (unit >> 4) & 3, b = unit >> 6;
    const int lane = F.lane, w = F.wave, wn = w >> 1, wm = w & 1, wn2 = w >> 2, we = w & 3;
    const float lg2 = head_lg2(h), g1 = exp2f(lg2), g128 = exp2f(128.f * lg2);
    LAS unsigned char* Qt = F.lds;
    LAS unsigned char* KV = F.lds + 67584;
    LAS unsigned char* Pt = F.lds + 67584 + 36864;
    LAS float* red = (LAS float*)(F.lds + 67584 + 36864 + 18432);
    const size_t rowsc = (size_t)b * SEQ + sc * 512;
    const bf16* Rbase = RST + (size_t)((b * 4 + h) * 8 + sc) * 65536;
    const bf16* Kb = QKV + rowsc * 3072 + 1024 + h * 256; const bf16* Vb = Kb + 1024;
    v4u T[4];
    const unsigned lo_kv = tile_loff<256>(F.tid, 3072), lo_r = tile_loff<64>(F.tid, 256);
    tile_issue<256, 64>(T, Rbase, 256, lo_r);
#pragma unroll 1
    for (int qi = 0; qi < 2; ++qi) {
        const int i = qp == 0 ? (qi == 0 ? 0 : 3) : (qi == 0 ? 1 : 2);
        const size_t grow0 = rowsc + i * 128;
        f32x4 Y[4][4];
#pragma unroll
        for (int a = 0; a < 4; ++a)
#pragma unroll
            for (int c = 0; c < 4; ++c) Y[a][c] = (f32x4){0.f, 0.f, 0.f, 0.f};
        __syncthreads();
        load_tile(Qt, 528, QKV + grow0 * 3072 + h * 256, 3072, 128, 256, F.tid);
#pragma unroll 1
        for (int ds = 0; ds < 4; ++ds) {
            if (ds) __syncthreads();
            tile_commit<256, 64>(T, KV, 144, F.tid);
            if (ds < 3) tile_issue<256, 64>(T, Rbase + (ds + 1) * 64, 256, lo_r);
            else tile_issue<64, 256>(T, Kb, 3072, lo_kv);
            __syncthreads();
#pragma unroll
            for (int ks = 0; ks < 2; ++ks) {
                bf16x8 qf[4], rf[4];
#pragma unroll
                for (int t = 0; t < 4; ++t) { qf[t] = frag_rm(Qt, 528, wn2 * 64 + t * 16, ds * 64 + ks * 32, lane); rf[t] = frag_rm(KV, 144, we * 64 + t * 16, ks * 32, lane); }
#pragma unroll
                for (int nt = 0; nt < 4; ++nt)
#pragma unroll
                    for (int et = 0; et < 4; ++et) Y[nt][et] = mma(rf[et], qf[nt], Y[nt][et]);
            }
        }
#pragma unroll
        for (int a = 0; a < 4; ++a)
#pragma unroll
            for (int c = 0; c < 4; ++c) Y[a][c] *= g1;
#pragma unroll 1
        for (int kt = 0; kt < 2 * (i + 1); ++kt) {
            const int j = kt >> 1, kh = kt & 1;
            if (j && !kh) {
#pragma unroll
                for (int a = 0; a < 4; ++a)
#pragma unroll
                    for (int c = 0; c < 4; ++c) Y[a][c] *= g128; }
            const size_t krow = (size_t)kt * 64;
            __syncthreads();
            tile_commit<64, 256>(T, KV, 528, F.tid);
            tile_issue<64, 256>(T, Vb + krow * 3072, 3072, lo_kv);
            __syncthreads();
            f32x4 sa[2][2];
#pragma unroll
            for (int a = 0; a < 2; ++a)
#pragma unroll
                for (int c = 0; c < 2; ++c) sa[a][c] = (f32x4){0.f, 0.f, 0.f, 0.f};
#pragma unroll
            for (int ks = 0; ks < 8; ++ks) {
                bf16x8 qf[2], kf[2];
#pragma unroll
                for (int t = 0; t < 2; ++t) { qf[t] = frag_rm(Qt, 528, wn * 32 + t * 16, ks * 32, lane); kf[t] = frag_rm(KV, 528, wm * 32 + t * 16, ks * 32, lane); }
#pragma unroll
                for (int nt = 0; nt < 2; ++nt)
#pragma unroll
                    for (int mt = 0; mt < 2; ++mt) sa[nt][mt] = mma(kf[mt], qf[nt], sa[nt][mt]);
            }
#pragma unroll
            for (int nt = 0; nt < 2; ++nt)
#pragma unroll
                for (int mt = 0; mt < 2; ++mt) { const int n = wn * 32 + nt * 16 + (lane & 15), m = wm * 32 + mt * 16 + 4 * (lane >> 4);
                    f32x4 sv = sa[nt][mt];
                    if (j == i) { const int mk = kh * 64 + m;
#pragma unroll
                        for (int jj = 0; jj < 4; ++jj) sv[jj] = (mk + jj > n) ? 0.f : sv[jj]; }
                    *(LAS v2u*)(Pt + n * 144 + m * 2) = (v2u){pk2(sv[0], sv[1]), pk2(sv[2], sv[3])}; }
            __syncthreads();
            tile_commit<64, 256>(T, KV, 544, F.tid);
            if (kt + 1 < 2 * (i + 1)) tile_issue<64, 256>(T, Kb + (krow + 64) * 3072, 3072, lo_kv);
            else if (qi == 0) tile_issue<256, 64>(T, Rbase, 256, lo_r);
            __syncthreads();
#pragma unroll
            for (int ks = 0; ks < 2; ++ks) {
                bf16x8 pf[4], vf[4];
#pragma unroll
                for (int t = 0; t < 4; ++t) { pf[t] = frag_rm(Pt, 144, wn2 * 64 + t * 16, ks * 32, lane); vf[t] = frag_tr(KV, 544, we * 64 + t * 16, ks * 32, lane); }
#pragma unroll
                for (int nt = 0; nt < 4; ++nt)
#pragma unroll
                    for (int et = 0; et < 4; ++et) Y[nt][et] = mma(vf[et], pf[nt], Y[nt][et]);
            }
        }
        float mean[4], rstd[4];
#pragma unroll
        for (int nt = 0; nt < 4; ++nt) { float sm = 0.f;
#pragma unroll
            for (int et = 0; et < 4; ++et) sm += (Y[nt][et][0] + Y[nt][et][1]) + (Y[nt][et][2] + Y[nt][et][3]);
            sm += __shfl_xor(sm, 16); sm += __shfl_xor(sm, 32);
            if ((lane >> 4) == 0) red[(wn2 * 64 + nt * 16 + lane) * 4 + we] = sm; }
        __syncthreads();
#pragma unroll
        for (int nt = 0; nt < 4; ++nt) { const LAS float* r = red + (wn2 * 64 + nt * 16 + (lane & 15)) * 4; mean[nt] = ((r[0] + r[1]) + (r[2] + r[3])) * (1.f / 256.f); }
        __syncthreads();
#pragma unroll
        for (int nt = 0; nt < 4; ++nt) { float sm = 0.f;
#pragma unroll
            for (int et = 0; et < 4; ++et) { const f32x4 dv = Y[nt][et] - mean[nt]; sm += (dv[0] * dv[0] + dv[1] * dv[1]) + (dv[2] * dv[2] + dv[3] * dv[3]); }
            sm += __shfl_xor(sm, 16); sm += __shfl_xor(sm, 32);
            if ((lane >> 4) == 0) red[(wn2 * 64 + nt * 16 + lane) * 4 + we] = sm; }
        __syncthreads();
#pragma unroll
        for (int nt = 0; nt < 4; ++nt) { const LAS float* r = red + (wn2 * 64 + nt * 16 + (lane & 15)) * 4; rstd[nt] = rsqrtf(((r[0] + r[1]) + (r[2] + r[3])) * (1.f / 256.f) + EPS); }
#pragma unroll
        for (int nt = 0; nt < 4; ++nt)
#pragma unroll
            for (int et = 0; et < 4; ++et) { const int n = wn2 * 64 + nt * 16 + (lane & 15), e = we * 64 + et * 16 + 4 * (lane >> 4);
                const bf16* gp = GZ + (grow0 + n) * 2048 + h * 256 + e;
                const v2u gv = *(const v2u*)gp;
                const f32x4 y = (Y[nt][et] - mean[nt]) * rstd[nt];
                const float o0 = y[0] * silu_f(bflo(gv.x)), o1 = y[1] * silu_f(bfhi(gv.x)), o2 = y[2] * silu_f(bflo(gv.y)), o3 = y[3] * silu_f(bfhi(gv.y));
                *(v2u*)(YO + (gp - GZ)) = (v2u){pk2(o0, o1), pk2(o2, o3)}; }
    }
}

struct SsdPar { const float* conv_w; const float* conv_b; const float* a_log; const float* d_ssd; const float* ssd_norm; };

struct ConvW { f32x4 w[4][2]; f32x4 b[2]; };
DI ConvW load_convw(const float* cw, const float* cb, int col) { ConvW W;
#pragma unroll
    for (int k = 0; k < 4; ++k) { W.w[k][0] = *(const f32x4*)(cw + k * 1536 + col); W.w[k][1] = *(const f32x4*)(cw + k * 1536 + col + 4); }
    W.b[0] = *(const f32x4*)(cb + col); W.b[1] = *(const f32x4*)(cb + col + 4); return W; }
DI void conv8(const bf16* XBC, const ConvW& W, size_t row, int col, float (&o)[8]) {
    const int tin = (int)(row & 4095);
    o[0] = W.b[0][0]; o[1] = W.b[0][1]; o[2] = W.b[0][2]; o[3] = W.b[0][3]; o[4] = W.b[1][0]; o[5] = W.b[1][1]; o[6] = W.b[1][2]; o[7] = W.b[1][3];
#pragma unroll
    for (int k = 0; k < 4; ++k) {
        if (tin - 3 + k >= 0) {
            const v4u x = *(const v4u*)(XBC + (row - 3 + k) * 1536 + col);
            const f32x4 w0 = W.w[k][0], w1 = W.w[k][1];
            o[0] += w0[0] * bflo(x.x); o[1] += w0[1] * bfhi(x.x); o[2] += w0[2] * bflo(x.y); o[3] += w0[3] * bfhi(x.y);
            o[4] += w1[0] * bflo(x.z); o[5] += w1[1] * bfhi(x.z); o[6] += w1[2] * bflo(x.w); o[7] += w1[3] * bfhi(x.w);
        }
    }
#pragma unroll
    for (int k = 0; k < 8; ++k) o[k] = silu_f(o[k]);
}
DI void conv8r(const v4u (&x)[4], const ConvW& W, int tin, float (&o)[8]) {
    o[0] = W.b[0][0]; o[1] = W.b[0][1]; o[2] = W.b[0][2]; o[3] = W.b[0][3]; o[4] = W.b[1][0]; o[5] = W.b[1][1]; o[6] = W.b[1][2]; o[7] = W.b[1][3];
#pragma unroll
    for (int k = 0; k < 4; ++k) {
        if (tin - 3 + k >= 0) { const f32x4 w0 = W.w[k][0], w1 = W.w[k][1];
            o[0] += w0[0] * bflo(x[k].x); o[1] += w0[1] * bfhi(x[k].x); o[2] += w0[2] * bflo(x[k].y); o[3] += w0[3] * bfhi(x[k].y);
            o[4] += w1[0] * bflo(x[k].z); o[5] += w1[1] * bfhi(x[k].z); o[6] += w1[2] * bflo(x[k].w); o[7] += w1[3] * bfhi(x[k].w); }
    }
#pragma unroll
    for (int k = 0; k < 8; ++k) o[k] = silu_f(o[k]);
}
template <int NR, class Fn> DI void conv_rows(const bf16* XBC, const ConvW& W, size_t row0, int col, Fn&& emit) {
    const int tin0 = (int)(row0 & 4095);
    v4u x[NR + 3];
#pragma unroll
    for (int i = 0; i < NR + 3; ++i) x[i] = (tin0 + i - 3 >= 0) ? *(const v4u*)(XBC + (row0 + i - 3) * 1536 + col) : (v4u){0u, 0u, 0u, 0u};
#pragma unroll
    for (int r = 0; r < NR; ++r) { float o[8];
        o[0] = W.b[0][0]; o[1] = W.b[0][1]; o[2] = W.b[0][2]; o[3] = W.b[0][3]; o[4] = W.b[1][0]; o[5] = W.b[1][1]; o[6] = W.b[1][2]; o[7] = W.b[1][3];
#pragma unroll
        for (int k = 0; k < 4; ++k) { const v4u xv = x[r + k]; const f32x4 w0 = W.w[k][0], w1 = W.w[k][1];
            o[0] += w0[0] * bflo(xv.x); o[1] += w0[1] * bfhi(xv.x); o[2] += w0[2] * bflo(xv.y); o[3] += w0[3] * bfhi(xv.y);
            o[4] += w1[0] * bflo(xv.z); o[5] += w1[1] * bfhi(xv.z); o[6] += w1[2] * bflo(xv.w); o[7] += w1[3] * bfhi(xv.w); }
#pragma unroll
        for (int k = 0; k < 8; ++k) o[k] = silu_f(o[k]);
        emit(r, o); }
}
DI v4u pack8(const float (&o)[8], float s) { v4u r; r.x = pk2(o[0] * s, o[1] * s); r.y = pk2(o[2] * s, o[3] * s); r.z = pk2(o[4] * s, o[5] * s); r.w = pk2(o[6] * s, o[7] * s); return r; }

DI float ssd_cumsum(const float* DT, const float* a_log, size_t t0, int grp, int w, int lane, LAS float* cs, LAS float* dtl = nullptr) {
    const int head = grp * 8 + w; const float A = -__expf(a_log[head]);
    const float d0 = DT[(t0 + 2 * lane) * 16 + head], d1 = DT[(t0 + 2 * lane + 1) * 16 + head], v0 = d0 * A, v1 = d1 * A;
    if (dtl) { dtl[w * 128 + 2 * lane] = d0; dtl[w * 128 + 2 * lane + 1] = d1; }
    float x = v0 + v1;
#pragma unroll
    for (int o = 1; o < 64; o <<= 1) { const float t = __shfl_up(x, o); if (lane >= o) x += t; }
    cs[w * 128 + 2 * lane] = x - v1; cs[w * 128 + 2 * lane + 1] = x;
    return __shfl(x, 63);
}

DI void ssd_passA_unit(Frame& F, const SsdPar& P, int unit) {
    const bf16* XBC = (const bf16*)(F.ws + WS_XBC); const float* DT = (const float*)(F.ws + WS_DT);
    bf16* ST = (bf16*)(F.ws + WS_SLOT32); float* CDEC = (float*)(F.ws + WS_MISC);
    const int grp = unit & 1, c = (unit >> 1) & 31, b = unit >> 6;
    const int lane = F.lane, w = F.wave;
    const size_t t0 = (size_t)b * SEQ + c * 128;
    LAS float* cs = (LAS float*)F.lds;
    LAS float* csend = (LAS float*)(F.lds + 4096);
    LAS unsigned char* Bt = F.lds + 4352;
    LAS unsigned char* Xw = F.lds + 4352 + 36864;
    __syncthreads();
    { const float tot = ssd_cumsum(DT, P.a_log, t0, grp, w, lane, cs);
      if (lane == 0) { csend[w] = tot; CDEC[(b * 32 + c) * 16 + grp * 8 + w] = __expf(tot); } }
    { const int cc = F.tid & 15, rb = F.tid >> 4; const ConvW W = load_convw(P.conv_w, P.conv_b, 1024 + grp * 128 + cc * 8);
      conv_rows<4>(XBC, W, t0 + 4 * rb, 1024 + grp * 128 + cc * 8, [&](int r, const float (&o)[8]) { *(LAS v4u*)(Bt + (4 * rb + r) * 288 + cc * 16) = pack8(o, 1.0f); }); }
    for (int hg = 0; hg < 2; ++hg) {
        __syncthreads();
        { const int cc = F.tid & 31, rb = F.tid >> 5, hd = hg * 4 + (cc >> 3); const ConvW W = load_convw(P.conv_w, P.conv_b, grp * 512 + hg * 256 + cc * 8);
          conv_rows<8>(XBC, W, t0 + 8 * rb, grp * 512 + hg * 256 + cc * 8, [&](int r, const float (&o)[8]) { const int rr = 8 * rb + r;
              const float sc = DT[(t0 + rr) * 16 + grp * 8 + hd] * __expf(csend[hd] - cs[hd * 128 + rr]);
              *(LAS v4u*)(Xw + rr * 544 + cc * 16) = pack8(o, sc); }); }
        __syncthreads();
        const int hl = w >> 1, nh = w & 1;
        f32x4 acc[4][4];
#pragma unroll
        for (int a = 0; a < 4; ++a)
#pragma unroll
            for (int q = 0; q < 4; ++q) acc[a][q] = (f32x4){0.f, 0.f, 0.f, 0.f};
#pragma unroll
        for (int ks = 0; ks < 4; ++ks) {
            bf16x8 xf[4], bfr[4];
#pragma unroll
            for (int t = 0; t < 4; ++t) { xf[t] = frag_tr(Xw, 544, hl * 64 + t * 16, ks * 32, lane); bfr[t] = frag_tr(Bt, 288, nh * 64 + t * 16, ks * 32, lane); }
#pragma unroll
            for (int pt = 0; pt < 4; ++pt)
#pragma unroll
                for (int nt = 0; nt < 4; ++nt) acc[pt][nt] = mma(bfr[nt], xf[pt], acc[pt][nt]);
        }
        const int head = grp * 8 + hg * 4 + hl;
        bf16* dst = ST + (size_t)((b * 32 + c) * 16 + head) * 8192;
#pragma unroll
        for (int pt = 0; pt < 4; ++pt)
#pragma unroll
            for (int nt = 0; nt < 4; ++nt) { const int p = pt * 16 + (lane & 15), n = nh * 64 + nt * 16 + 4 * (lane >> 4); const f32x4 v = acc[pt][nt];
                *(v2u*)(dst + p * 128 + n) = (v2u){pk2(v[0], v[1]), pk2(v[2], v[3])}; }
    }
}

DI void ssd_scan_item(Frame& F, int item) {
    bf16* ST = (bf16*)(F.ws + WS_SLOT32); const float* CDEC = (const float*)(F.ws + WS_MISC);
    const int bh = item >> 11, b = bh >> 4, head = bh & 15, off = (item & 2047) * 4;
    float run[4]; float zf = 0.f; asm volatile("" : "+v"(zf));
#pragma unroll
    for (int k = 0; k < 4; ++k) run[k] = zf;
    v2u* base = (v2u*)(ST + (size_t)((b * 32) * 16 + head) * 8192 + off);
    const float* dbase = CDEC + (b * 32) * 16 + head;
    v2u cur[8], nxt[8]; float dc[8], dn[8];
#pragma unroll
    for (int q = 0; q < 8; ++q) { cur[q] = base[(size_t)q * 32768]; dc[q] = dbase[q * 16]; }
#pragma unroll 1
    for (int cb = 0; cb < 4; ++cb) {
        const int cn = cb < 3 ? cb + 1 : cb;
#pragma unroll
        for (int q = 0; q < 8; ++q) { nxt[q] = base[(size_t)(cn * 8 + q) * 32768]; dn[q] = dbase[(cn * 8 + q) * 16]; }
#pragma unroll
        for (int q = 0; q < 8; ++q) {
            base[(size_t)(cb * 8 + q) * 32768] = (v2u){pk2(run[0], run[1]), pk2(run[2], run[3])};
            run[0] = dc[q] * run[0] + bflo(cur[q].x); run[1] = dc[q] * run[1] + bfhi(cur[q].x); run[2] = dc[q] * run[2] + bflo(cur[q].y); run[3] = dc[q] * run[3] + bfhi(cur[q].y); }
#pragma unroll
        for (int q = 0; q < 8; ++q) { cur[q] = nxt[q]; dc[q] = dn[q]; }
    }
}

template <int DBG = 0> DI void ssd_passC_unit(Frame& F, const SsdPar& P, int unit, bf16* YO) {
    const bf16* XBC = (const bf16*)(F.ws + WS_XBC); const float* DT = (const float*)(F.ws + WS_DT);
    const bf16* ST = (const bf16*)(F.ws + WS_SLOT32); const bf16* GZ = (const bf16*)(F.ws + WS_GZ);
    const int grp = unit & 1, c = (unit >> 1) & 31, b = unit >> 6;
    const int lane = F.lane, w = F.wave;
    const size_t t0 = (size_t)b * SEQ + c * 128;
    LAS float* cs = (LAS float*)F.lds;
    LAS float* dtl = (LAS float*)(F.lds + 4096);
    LAS unsigned char* Ct = F.lds + 8192;
    LAS unsigned char* BM = F.lds + 43008;
    LAS unsigned char* Xd = F.lds + 77824;
    LAS unsigned char* Pv = F.lds + 98304;
    LAS float* rowss = (LAS float*)(F.lds + 115712);
    LAS float* wtab = (LAS float*)(F.lds + 123904);
    __syncthreads();
    (void)ssd_cumsum(DT, P.a_log, t0, grp, w, lane, cs, dtl);
    for (int i = F.tid; i < 5 * 128; i += NTHR) { const int k = i >> 7, c4 = (i & 127) * 4;
        *(LAS f32x4*)(wtab + k * 512 + c4) = *(const f32x4*)((k < 4 ? P.conv_w + k * 1536 : P.conv_b) + grp * 512 + c4); }
#pragma unroll 1
    for (int which = 0; which < 2; ++which) {
        const int cc = F.tid & 15, rb = F.tid >> 4; const ConvW W = load_convw(P.conv_w, P.conv_b, 1024 + which * 256 + grp * 128 + cc * 8);
        LAS unsigned char* dstt = which ? Ct : BM;
        conv_rows<4>(XBC, W, t0 + 4 * rb, 1024 + which * 256 + grp * 128 + cc * 8, [&](int r, const float (&o)[8]) { *(LAS v4u*)(dstt + (4 * rb + r) * 272 + cc * 16) = pack8(o, 1.0f); }); }
    const int r0 = F.tid >> 3, cc8 = (F.tid & 7) * 8, tin0 = (int)((t0 + r0) & 4095);
    const int wl = w >> 1, ws = w & 1, wp = w & 1;
    v4u XR[2][4], PVr[2]; v2u ZN[2][2], ZC[2][2];
    const unsigned lo_p = tile_loff<128>(F.tid, 128);
#define SSD_ISSUE(hd_) do { const int hcol_ = grp * 512 + (hd_) * 64 + cc8; \
        _Pragma("unroll") for (int it_ = 0; it_ < 2; ++it_) _Pragma("unroll") for (int k_ = 0; k_ < 4; ++k_) \
            if (tin0 + 64 * it_ - 3 + k_ >= 0) XR[it_][k_] = *(const v4u*)(XBC + (t0 + r0 + 64 * it_ - 3 + k_) * 1536 + hcol_); \
        tile_issue<64, 128>(PVr, ST + (size_t)((b * 32 + c) * 16 + grp * 8 + (hd_)) * 8192, 128, lo_p); \
        _Pragma("unroll") for (int lt_ = 0; lt_ < 2; ++lt_) _Pragma("unroll") for (int pt_ = 0; pt_ < 2; ++pt_) \
            ZN[lt_][pt_] = *(const v2u*)(GZ + (t0 + wl * 32 + lt_ * 16 + (lane & 15)) * 2048 + 1024 + (grp * 8 + (hd_)) * 64 + wp * 32 + pt_ * 16 + 4 * (lane >> 4)); } while (0)
    SSD_ISSUE(0);
    __syncthreads();
    f32x4 cb[2][4];
#pragma unroll
    for (int a = 0; a < 2; ++a)
#pragma unroll
        for (int q = 0; q < 4; ++q) cb[a][q] = (f32x4){0.f, 0.f, 0.f, 0.f};
#pragma unroll
    for (int ks = 0; ks < 4; ++ks) {
        bf16x8 cf[2], bfr[4];
#pragma unroll
        for (int t = 0; t < 2; ++t) cf[t] = frag_rm(Ct, 272, wl * 32 + t * 16, ks * 32, lane);
#pragma unroll
        for (int t = 0; t < 4; ++t) bfr[t] = frag_rm(BM, 272, ws * 64 + t * 16, ks * 32, lane);
#pragma unroll
        for (int lt = 0; lt < 2; ++lt)
#pragma unroll
            for (int st = 0; st < 4; ++st) cb[lt][st] = mma(bfr[st], cf[lt], cb[lt][st]);
    }
#pragma unroll 1
    for (int hd = 0; hd < 8; ++hd) {
        const int head = grp * 8 + hd;
        ConvW W;
#pragma unroll
        for (int k = 0; k < 4; ++k) { W.w[k][0] = *(const LAS f32x4*)(wtab + k * 512 + hd * 64 + cc8); W.w[k][1] = *(const LAS f32x4*)(wtab + k * 512 + hd * 64 + cc8 + 4); }
        W.b[0] = *(const LAS f32x4*)(wtab + 4 * 512 + hd * 64 + cc8); W.b[1] = *(const LAS f32x4*)(wtab + 4 * 512 + hd * 64 + cc8 + 4);
        const float dsk = P.d_ssd[head];
        __syncthreads();
        if (!(DBG & 1))
#pragma unroll
        for (int lt = 0; lt < 2; ++lt) { const int l = wl * 32 + lt * 16 + (lane & 15); const float csl = cs[hd * 128 + l], dgl = dsk * __builtin_amdgcn_rcpf(dtl[hd * 128 + l]);
#pragma unroll
            for (int st = 0; st < 4; ++st) { const int s = ws * 64 + st * 16 + 4 * (lane >> 4); f32x4 m;
                const f32x4 cs4 = *(const LAS f32x4*)(cs + hd * 128 + s);
#pragma unroll
                for (int jj = 0; jj < 4; ++jj) { const float e = __expf(fminf(csl - cs4[jj], 0.f)); m[jj] = (s + jj <= l) ? cb[lt][st][jj] * e : 0.f; m[jj] += (s + jj == l) ? dgl : 0.f; }
                *(LAS v2u*)(BM + l * 272 + s * 2) = (v2u){pk2(m[0], m[1]), pk2(m[2], m[3])}; } }
        if (!(DBG & 2))
#pragma unroll
        for (int it = 0; it < 2; ++it) { float o[8]; conv8r(XR[it], W, tin0 + 64 * it, o);
            *(LAS v4u*)(Xd + (r0 + 64 * it) * 160 + cc8 * 2) = pack8(o, dtl[hd * 128 + r0 + 64 * it]); }
        tile_commit<64, 128>(PVr, Pv, 272, F.tid);
#pragma unroll
        for (int lt = 0; lt < 2; ++lt)
#pragma unroll
            for (int pt = 0; pt < 2; ++pt) ZC[lt][pt] = ZN[lt][pt];
        if (hd < 7) SSD_ISSUE(hd + 1);
        __syncthreads();
        f32x4 yd[2][2], yo[2][2];
#pragma unroll
        for (int a2 = 0; a2 < 2; ++a2)
#pragma unroll
            for (int q = 0; q < 2; ++q) { yd[a2][q] = (f32x4){0.f, 0.f, 0.f, 0.f}; yo[a2][q] = (f32x4){0.f, 0.f, 0.f, 0.f}; }
        if (!(DBG & 4))
#pragma unroll
        for (int ks = 0; ks < 4; ++ks) {
            bf16x8 mf[2], xf[2], cf[2], pf[2];
#pragma unroll
            for (int t = 0; t < 2; ++t) { if (!(DBG & 8)) { mf[t] = frag_rm(BM, 272, wl * 32 + t * 16, ks * 32, lane); xf[t] = frag_tr(Xd, 160, wp * 32 + t * 16, ks * 32, lane); }
                                          if (!(DBG & 16)) { cf[t] = frag_rm(Ct, 272, wl * 32 + t * 16, ks * 32, lane); pf[t] = frag_rm(Pv, 272, wp * 32 + t * 16, ks * 32, lane); } }
#pragma unroll
            for (int lt = 0; lt < 2; ++lt)
#pragma unroll
                for (int pt = 0; pt < 2; ++pt) { if (!(DBG & 8)) yd[lt][pt] = mma(xf[pt], mf[lt], yd[lt][pt]); if (!(DBG & 16)) yo[lt][pt] = mma(pf[pt], cf[lt], yo[lt][pt]); }
        }
#pragma unroll
        for (int lt = 0; lt < 2; ++lt) { const int l = wl * 32 + lt * 16 + (lane & 15); const float ecs = __expf(cs[hd * 128 + l]); float ss = 0.f;
#pragma unroll
            for (int pt = 0; pt < 2; ++pt) { const int p = wp * 32 + pt * 16 + 4 * (lane >> 4);
                const v2u zv = ZC[lt][pt];
                f32x4 y = yd[lt][pt] + ecs * yo[lt][pt];
                y[0] *= silu_f(bflo(zv.x)); y[1] *= silu_f(bfhi(zv.x)); y[2] *= silu_f(bflo(zv.y)); y[3] *= silu_f(bfhi(zv.y));
                ss += (y[0] * y[0] + y[1] * y[1]) + (y[2] * y[2] + y[3] * y[3]);
                if (YO) *(v2u*)(YO + (t0 + l) * 2048 + 1024 + head * 64 + p) = (v2u){pk2(y[0], y[1]), pk2(y[2], y[3])}; }
            ss += __shfl_xor(ss, 16); ss += __shfl_xor(ss, 32);
            if ((lane >> 4) == 0) rowss[(hd * 2 + wp) * 128 + l] = ss; }
    }
#undef SSD_ISSUE
    if (!YO) return;
    asm volatile("s_waitcnt vmcnt(0)" ::: "memory");
    __syncthreads();
    LAS float* rst = (LAS float*)F.lds;
    if (F.tid < 128) { float t = 0.f;
#pragma unroll
        for (int q = 0; q < 16; ++q) t += rowss[q * 128 + F.tid];
        rst[F.tid] = rsqrtf(t * (1.f / 512.f) + EPS); }
    __syncthreads();
    { const int cc = F.tid & 63; const f32x4 n0 = *(const f32x4*)(P.ssd_norm + grp * 512 + cc * 8), n1 = *(const f32x4*)(P.ssd_norm + grp * 512 + cc * 8 + 4);
#pragma unroll 4
      for (int it = 0; it < 16; ++it) { const int r = (F.tid >> 6) + it * 8; const float rs = rst[r];
          v4u* gp = (v4u*)(YO + (t0 + r) * 2048 + 1024 + grp * 512 + cc * 8); const v4u v = *gp;
          v4u o; o.x = pk2(bflo(v.x) * rs * n0[0], bfhi(v.x) * rs * n0[1]); o.y = pk2(bflo(v.y) * rs * n0[2], bfhi(v.y) * rs * n0[3]);
          o.z = pk2(bflo(v.z) * rs * n1[0], bfhi(v.z) * rs * n1[1]); o.w = pk2(bflo(v.w) * rs * n1[2], bfhi(v.w) * rs * n1[3]);
          *gp = o; } }
}

struct S5Par { const float* lam_re; const float* lam_im; const float* log_step; const float* b_re; const float* b_im; const float* c_re; const float* c_im; const float* d_s5; };

DI void s5_build_unit(Frame& F, const S5Par& P, int unit) {
    const int g = unit >> 2, cq = unit & 3;
    bf16* AB = (bf16*)(F.ws + WS_S5MAT + (size_t)g * 262144); bf16* E = AB + 256 * 384;
    LAS f32x2v* pw = (LAS f32x2v*)F.lds;
    LAS f32x2v* Bb = (LAS f32x2v*)(F.lds + 8704);
    LAS f32x2v* Cc = (LAS f32x2v*)(F.lds + 16896);
    LAS float* Km = (LAS float*)(F.lds + 25088);
    LAS f32x2v* cf = (LAS f32x2v*)(F.lds + 29184);
    __syncthreads();
    for (int i = F.tid; i < 17 * 64; i += NTHR) { const int t = i >> 6, p = i & 63;
        const double lr = fmin((double)P.lam_re[g * 64 + p], -1e-4), li = (double)P.lam_im[g * 64 + p], dl = (double)expf(P.log_step[g]);
        const double mag = (double)expf((float)(t * lr * dl)); double sn, cs_; sincos_d(t * li * dl, sn, cs_);
        pw[i] = (f32x2v){(float)(mag * cs_), (float)(mag * sn)};
        if (t == 1) { const double den = lr * lr + li * li, nr = mag * cs_ - 1.0, ni = mag * sn; cf[p] = (f32x2v){(float)((nr * lr + ni * li) / den), (float)((ni * lr - nr * li) / den)}; } }
    __syncthreads();
    for (int i = F.tid; i < 1024; i += NTHR) { const int p = i >> 4; const f32x2v c = cf[p]; const float br = P.b_re[g * 1024 + i], bi = P.b_im[g * 1024 + i];
        Bb[i] = (f32x2v){c.x * br - c.y * bi, c.x * bi + c.y * br}; }
    for (int i = F.tid; i < 1024; i += NTHR) Cc[i] = (f32x2v){P.c_re[g * 1024 + i], P.c_im[g * 1024 + i]};
    __syncthreads();
    for (int i = F.tid; i < 1024; i += NTHR) { const int t = i >> 6, cl = (i >> 4) & 3, c2 = i & 15, c = cq * 4 + cl; float acc = 0.f;
        for (int p = 0; p < 64; ++p) { const f32x2v cc = Cc[c * 64 + p], a = pw[t * 64 + p], bb = Bb[p * 16 + c2];
            const float tr = cc.x * a.x - cc.y * a.y, ti = cc.x * a.y + cc.y * a.x; acc += tr * bb.x - ti * bb.y; }
        Km[i] = acc; }
    __syncthreads();
    for (int i = F.tid; i < 64 * 48; i += NTHR) { const int rl = i / 48, c8 = (i % 48) * 8, l = rl >> 2, cl = rl & 3, c = cq * 4 + cl, row = l * 16 + c; float v[8];
        if (c8 < 256) { const int s = c8 >> 4, c2 = c8 & 15;
#pragma unroll
            for (int k = 0; k < 8; ++k) v[k] = s <= l ? Km[((l - s) * 4 + cl) * 16 + c2 + k] : 0.f;
        } else { const bool im = c8 >= 320; const int p0 = c8 - (im ? 320 : 256);
#pragma unroll
            for (int k = 0; k < 8; ++k) { const f32x2v cc = Cc[c * 64 + p0 + k], a = pw[(l + 1) * 64 + p0 + k];
                v[k] = im ? -(cc.x * a.y + cc.y * a.x) : (cc.x * a.x - cc.y * a.y); } }
        *(v4u*)(AB + (size_t)row * 384 + c8) = (v4u){pk2(v[0], v[1]), pk2(v[2], v[3]), pk2(v[4], v[5]), pk2(v[6], v[7])}; }
    for (int i = F.tid; i < 32 * 32; i += NTHR) { const int rl = i >> 5, c8 = (i & 31) * 8, p = cq * 16 + (rl & 15), s = c8 >> 4, c2 = c8 & 15; const bool im = rl >= 16; const int row = (im ? 64 : 0) + p; float v[8];
        const f32x2v a = pw[(15 - s) * 64 + p];
#pragma unroll
        for (int k = 0; k < 8; ++k) { const f32x2v bb = Bb[p * 16 + c2 + k]; v[k] = im ? (a.x * bb.y + a.y * bb.x) : (a.x * bb.x - a.y * bb.y); }
        *(v4u*)(E + (size_t)row * 256 + c8) = (v4u){pk2(v[0], v[1]), pk2(v[2], v[3]), pk2(v[4], v[5]), pk2(v[6], v[7])}; }
}

DI void s5_gemmA_unit(Frame& F, int unit) {
    const bf16* HN = (const bf16*)(F.ws + WS_SLOT32); float* EO = (float*)(F.ws + WS_S5E);
    const int gp = unit >> 3, te = unit & 7, b = te >> 1, lane = F.lane, w = F.wave, g = 2 * gp + (w & 1), i = lane & 15, gq = lane >> 4;
    LAS unsigned char* Et = F.lds + (w & 1) * 67584;
    __syncthreads();
    load_tile(F.lds, 528, (const bf16*)(F.ws + WS_S5MAT + (size_t)(2 * gp) * 262144) + 256 * 384, 256, 128, 256, F.tid);
    load_tile(F.lds + 67584, 528, (const bf16*)(F.ws + WS_S5MAT + (size_t)(2 * gp + 1) * 262144) + 256 * 384, 256, 128, 256, F.tid);
    __syncthreads();
#pragma unroll 1
    for (int t = 0; t < 2; ++t) { const int k0 = (te & 1) * 128 + ((w >> 1) * 2 + t) * 16;
        const bf16* hp = HN + ((size_t)b * SEQ + 16 * (k0 + i) + (gq >> 1)) * D + 16 * g + 8 * (gq & 1);
        bf16x8 uf[8];
#pragma unroll
        for (int ks = 0; ks < 8; ++ks) uf[ks] = *(const bf16x8*)(hp + (size_t)(2 * ks) * D);
        f32x4 acc[8];
#pragma unroll
        for (int mt = 0; mt < 8; ++mt) acc[mt] = (f32x4){0.f, 0.f, 0.f, 0.f};
#pragma unroll
        for (int ks = 0; ks < 8; ++ks) {
#pragma unroll
            for (int mt = 0; mt < 8; ++mt) acc[mt] = mma(frag_rm(Et, 528, mt * 16, ks * 32, lane), uf[ks], acc[mt]);
            if (ks & 1) __builtin_amdgcn_sched_barrier(0); }
        float* dst = EO + ((size_t)((b * 256 + k0 + i) * 64 + g)) * 128 + 4 * gq;
#pragma unroll
        for (int mt = 0; mt < 8; ++mt) *(f32x4*)(dst + mt * 16) = acc[mt]; }
}

DI void s5_scan_task(Frame& F, const float* lam_re, const float* lam_im, const float* log_step, int task, int dbg) {
    const float* EO = (const float*)(F.ws + WS_S5E); bf16* XO = (bf16*)(F.ws + WS_S5X);
    const int b = task >> 6, g = task & 63, p = F.lane;
    f32x2v a;
    { const double lr = fmin((double)lam_re[g * 64 + p], -1e-4), li = (double)lam_im[g * 64 + p], dl = (double)expf(log_step[g]);
      const double mag = (double)expf((float)(16.0 * lr * dl)); double s, c; sincos_d(16.0 * li * dl, s, c); a = (f32x2v){(float)(mag * c), (float)(mag * s)}; }
    if (dbg == 6) a = (f32x2v){0.f, 0.f};
    float rr = 0.f, ri = 0.f;
    const float* ep = EO + ((size_t)(b * 256) * 64 + g) * 128 + p; bf16* xp = XO + ((size_t)(b * 256) * 64 + g) * 128 + p;
    float er[16], ei[16], fr_[16], fi_[16];
#pragma unroll
    for (int s2 = 0; s2 < 16; ++s2) { er[s2] = ep[(size_t)s2 * 8192]; ei[s2] = ep[(size_t)s2 * 8192 + 64]; }
#pragma unroll 1
    for (int kb = 0; kb < 16; ++kb) {
        const int kn = kb < 15 ? kb + 1 : kb;
#pragma unroll
        for (int s2 = 0; s2 < 16; ++s2) { fr_[s2] = ep[(size_t)(kn * 16 + s2) * 8192]; fi_[s2] = ep[(size_t)(kn * 16 + s2) * 8192 + 64]; }
#pragma unroll
        for (int s2 = 0; s2 < 16; ++s2) { bf16* xo = xp + (size_t)(kb * 16 + s2) * 8192;
            xo[0] = (bf16)f2bf(rr); xo[64] = (bf16)f2bf(ri);
            const float nr = a.x * rr - a.y * ri + er[s2], ni = a.x * ri + a.y * rr + ei[s2]; rr = nr; ri = ni; }
#pragma unroll
        for (int s2 = 0; s2 < 16; ++s2) { er[s2] = fr_[s2]; ei[s2] = fi_[s2]; }
    }
}

DI float gelu_tanh(float v) { const float u = 0.7978845608028654f * (v + 0.044715f * v * v * v); const float t = 1.0f - 2.0f * __builtin_amdgcn_rcpf(__expf(2.0f * u) + 1.0f); return 0.5f * v * (1.0f + t); }

DI void s5_gemmB_unit(Frame& F, const float* d_s5, int unit) {
    const bf16* HN = (const bf16*)(F.ws + WS_SLOT32); const bf16* XO = (const bf16*)(F.ws + WS_S5X); bf16* Y = (bf16*)(F.ws + WS_Y);
    const int g = unit >> 2, lh = (unit >> 1) & 1, th = unit & 1, lane = F.lane, w = F.wave, i = lane & 15, gq = lane >> 4;
    const bf16* AB = (const bf16*)(F.ws + WS_S5MAT + (size_t)g * 262144) + (size_t)(128 * lh) * 384;
    LAS unsigned char* A = F.lds;
    __syncthreads();
    load_tile(A, 784, AB, 384, 128, 384, F.tid);
    __syncthreads();
    const int colg = 16 * g + 4 * gq;
    const f32x4 dv = *(const f32x4*)(d_s5 + colg);
#pragma unroll 1
    for (int t = 0; t < 4; ++t) { const int nt = w * 4 + t, b = 2 * th + (nt >> 4), k0 = (nt & 15) * 16;
        const bf16* hp = HN + ((size_t)b * SEQ + 16 * (k0 + i) + (gq >> 1)) * D + 16 * g + 8 * (gq & 1);
        const bf16* xp = XO + ((size_t)((b * 256 + k0 + i) * 64 + g)) * 128 + 8 * gq;
        bf16x8 uf[12];
#pragma unroll
        for (int ks = 0; ks < 8; ++ks) uf[ks] = *(const bf16x8*)(hp + (size_t)(2 * ks) * D);
#pragma unroll
        for (int ks = 0; ks < 4; ++ks) uf[8 + ks] = *(const bf16x8*)(xp + ks * 32);
        f32x4 acc[8];
#pragma unroll
        for (int mt = 0; mt < 8; ++mt) acc[mt] = (f32x4){0.f, 0.f, 0.f, 0.f};
#pragma unroll
        for (int ks = 0; ks < 12; ++ks) {
#pragma unroll
            for (int mt = 0; mt < 8; ++mt) acc[mt] = mma(frag_rm(A, 784, mt * 16, ks * 32, lane), uf[ks], acc[mt]);
            __builtin_amdgcn_sched_barrier(0); }
#pragma unroll
        for (int mt = 0; mt < 8; ++mt) { const size_t tok = (size_t)b * SEQ + 16 * (k0 + i) + 8 * lh + mt;
            const v2u hv = *(const v2u*)(HN + tok * D + colg);
            const float y0 = gelu_tanh(acc[mt][0] + dv[0] * bflo(hv.x)), y1 = gelu_tanh(acc[mt][1] + dv[1] * bfhi(hv.x));
            const float y2 = gelu_tanh(acc[mt][2] + dv[2] * bflo(hv.y)), y3 = gelu_tanh(acc[mt][3] + dv[3] * bfhi(hv.y));
            *(v2u*)(Y + tok * D + colg) = (v2u){pk2(y0, y1), pk2(y2, y3)}; } }
}

#ifndef FUSE_E5
#define FUSE_E5 1
#endif
#ifndef FUSE_DOWN
#define FUSE_DOWN 7
#endif
#ifndef REP_BAR
#define REP_BAR 1
#endif
#ifndef REP_CONV
#define REP_CONV 1
#endif
#ifndef REP_ROW
#define REP_ROW 1
#endif
#ifndef REP_RC
#define REP_RC 1
#endif
#ifndef REP_SC
#define REP_SC 1
#endif
#ifndef SC_DBG
#define SC_DBG 0
#endif
#ifndef REP_GEMM
#define REP_GEMM 1
#endif
#ifndef REP_S5A
#define REP_S5A 1
#endif
#ifndef REP_S5S
#define REP_S5S 1
#endif
#ifndef REP_S5B
#define REP_S5B 1
#endif
#ifndef REP_RA
#define REP_RA 1
#endif
#ifndef REP_SA
#define REP_SA 1
#endif
#ifndef SKIP_EVEN
#define SKIP_EVEN 0
#endif
#ifndef SKIP_ODD
#define SKIP_ODD 0
#endif
DI int opq(int v) { asm volatile("" : "+s"(v)); return v; }
#define CS_STR2(x) #x
#define CS_STR(x) CS_STR2(x)
#ifdef CODE_SHIFT
#define CODE_SHIFT_STR CS_STR(CODE_SHIFT)
#endif
struct Args { const float* in[N_IN]; float* out; unsigned char* ws; };
constexpr int CW_BAR = 1024;

#define PHASE() do { unsigned z_ = 0u; asm volatile("" : "+s"(z_)); int l_ = __builtin_amdgcn_mbcnt_hi(~0u, __builtin_amdgcn_mbcnt_lo(~0u, z_)); int w_ = wave0; asm volatile("" : "+s"(w_)); \
        int g_ = gridDim.x, b_ = blockIdx.x; asm volatile("" : "+s"(g_), "+s"(b_)); F.G = g_; F.bid = b_; F.vcu = (g_ % 8 == 0) ? (b_ % 8) * (g_ / 8) + b_ / 8 : b_; F.lane = l_; F.wave = w_; F.tid = w_ * 64 + l_; F.out = (float*)(GAS float*)lds_ptr(F, N_IN); F.ws = (unsigned char*)(GAS unsigned char*)lds_ptr(F, N_IN + 1); } while (0)
#define WSP(T, off) ((T*)(F.ws + (off)))
#define GRID_BAR() do { PHASE(); XcdBarrier xb_; xb_.bar = (unsigned*)(F.ws + WS_CTL) + CW_BAR; xb_.x = xb_xcc_id(); xb_.tid = F.tid; xb_.st = (volatile LAS unsigned*)(F.lds + MISC_OFF) + 8; xcd_barrier(xb_); if (REP_BAR == 2) xcd_barrier(xb_); PHASE(); } while (0)
template <int layer> __device__ __forceinline__ void run_layer(Frame& F, const int wave0) {
        const int j = layer >> 1;
        if ((layer & 1) == 0) {
            if (!opq(SKIP_EVEN)) {
            { pg8::Gemm g{WSP(bf16, WS_SLOT32), WSP(bf16, WS_SLOT16), M, INP_PAD, D}; pg8::StaticOrder S; S.init(M, INP_PAD, F.G, F.bid);
              pg8::EpiInProj E{WSP(bf16, WS_QKV), WSP(bf16, WS_GZ), WSP(bf16, WS_XBC), WSP(float, WS_DT), (const float*)(F.ws + WS_ROPE), INP(I_DT_BIAS) + j * 16};
              pg8::gemm_phase<pg8::EpiInProj, pg8::StaticOrder, true, true>(F.lds, g, S, E, F.tid); }
#if REP_GEMM == 2 || defined(REP_G_INP)
            { PHASE(); pg8::Gemm g{WSP(bf16, WS_SLOT32), WSP(bf16, WS_SLOT16), M, INP_PAD, D}; pg8::StaticOrder S; S.init(M, INP_PAD, F.G, F.bid);
              pg8::EpiInProj E{WSP(bf16, WS_QKV), WSP(bf16, WS_GZ), WSP(bf16, WS_XBC), WSP(float, WS_DT), (const float*)(F.ws + WS_ROPE), INP(I_DT_BIAS) + j * 16};
              pg8::gemm_phase<pg8::EpiInProj, pg8::StaticOrder, true, true>(F.lds, g, S, E, F.tid); }
#endif
            GRID_BAR();
            for (int rep_ = 0; rep_ < REP_RA; ++rep_) for (int u = F.vcu; u < 256; u += F.G) ret_passA_unit(F, u);
            { const SsdPar SP{INP(I_CONV_W) + (size_t)j * 4 * 1536, INP(I_CONV_B) + j * 1536, INP(I_A_LOG) + j * 16, INP(I_D_SSD) + j * 16, INP(I_SSD_NORM) + j * 1024};
              for (int rep_ = 0; rep_ < REP_SA; ++rep_) for (int u = F.vcu; u < 256; u += F.G) ssd_passA_unit(F, SP, u); }
            GRID_BAR();
            for (int it = (F.bid * NTHR + F.tid); it < 131072; it += (F.G * NTHR)) ret_scan_item(F, it);
            for (int it = (F.bid * NTHR + F.tid); it < 131072; it += (F.G * NTHR)) ssd_scan_item(F, it);
            GRID_BAR();
#if REP_RC == 2
            if (layer == 0) for (int u = F.vcu; u < 256; u += F.G) ret_passC_unit(F, u, (bf16*)F.out);
#endif
            for (int u = F.vcu; u < 256; u += F.G) ret_passC_unit(F, u, WSP(bf16, WS_GZ));
            { const SsdPar SP{INP(I_CONV_W) + (size_t)j * 4 * 1536, INP(I_CONV_B) + j * 1536, INP(I_A_LOG) + j * 16, INP(I_D_SSD) + j * 16, INP(I_SSD_NORM) + j * 1024};
#if REP_SC >= 2
              if (layer == 0) for (int u = F.vcu; u < 256; u += F.G) ssd_passC_unit<SC_DBG>(F, SP, u, REP_SC == 2 ? (bf16*)F.out : (bf16*)nullptr);
#endif
              for (int u = F.vcu; u < 256; u += F.G) ssd_passC_unit(F, SP, u, WSP(bf16, WS_GZ)); }
            GRID_BAR();
            }
            __syncthreads();
            convert_weight(F, INP(I_W_UP) + (size_t)layer * D * FF, D, FF, WSP(bf16, WS_SLOT16), 0);
#if REP_CONV == 2
            convert_weight(F, INP(I_W_UP) + (size_t)layer * D * FF, D, FF, WSP(bf16, WS_SLOT16), 0);
#endif
            convert_weight(F, INP(I_W_DOWN) + (size_t)layer * FF * D, FF, D, WSP(bf16, WS_SLOT16) + (size_t)FF * D, 0);
#if REP_CONV == 2
            convert_weight(F, INP(I_W_DOWN) + (size_t)layer * FF * D, FF, D, WSP(bf16, WS_SLOT16) + (size_t)FF * D, 0);
#endif
            __syncthreads();
            if (FUSE_E5 && F.G == 256 && !opq(SKIP_EVEN)) {
            { pg8::Gemm g{WSP(bf16, WS_GZ), WSP(bf16, WS_W4), M, D, 2048}; pg8::StaticOrder S; S.init(M, D, F.G, F.bid);
              pg8::EpiResNorm<layer == 0> E{layer == 0 ? (const void*)INP(I_X) : (const void*)F.out, (bf16*)F.out, WSP(bf16, WS_SLOT32), INP(I_POST_MIX) + layer * D, INP(I_PRE_MLP) + layer * D,
                                            WSP(unsigned long long, WS_XBUF_A), (unsigned*)(F.ws + WS_CTL) + CW_PANEL, 32u * (unsigned)(layer / 2 + 1), EPS};
              pg8::gemm_phase<pg8::EpiResNorm<layer == 0>, pg8::StaticOrder, true, true>(F.lds, g, S, E, F.tid); }
            __syncthreads();
            GRID_BAR();
            } else {
            if (!opq(SKIP_EVEN)) {
            { pg8::Gemm g{WSP(bf16, WS_GZ), WSP(bf16, WS_W4), M, D, 2048}; pg8::StaticOrder S; S.init(M, D, F.G, F.bid);
              pg8::EpiBf16 E{WSP(bf16, WS_M32A), D};
              pg8::gemm_phase<pg8::EpiBf16, pg8::StaticOrder, true, true>(F.lds, g, S, E, F.tid); }
            } else zero_fill(F, WSP(bf16, WS_M32A), (size_t)M * D * 2);
            GRID_BAR();
            if (layer == 0) row_phase<true, false>(F, WSP(bf16, WS_M32A), INP(I_X), F.out, INP(I_POST_MIX) + layer * D, INP(I_PRE_MLP) + layer * D, WSP(bf16, WS_SLOT32));
            else row_phase<false, false>(F, WSP(bf16, WS_M32A), F.out, F.out, INP(I_POST_MIX) + layer * D, INP(I_PRE_MLP) + layer * D, WSP(bf16, WS_SLOT32));
            GRID_BAR();
            }
        } else {
            if (opq(SKIP_ODD) == 2) {
                const v4u* s_ = (const v4u*)WSP(bf16, WS_SLOT32); v4u* d_ = (v4u*)WSP(bf16, WS_Y);
                for (size_t i_ = (size_t)F.bid * NTHR + F.tid; i_ < (size_t)M * D / 8; i_ += (size_t)F.G * NTHR) d_[i_] = s_[i_];
                GRID_BAR();
            }
            if (opq(SKIP_ODD) == 0 || opq(SKIP_ODD) >= 3) {
            for (int rep_ = 0; rep_ < REP_S5A; ++rep_) for (int u = F.vcu; u < 256; u += F.G) s5_gemmA_unit(F, u);
            GRID_BAR();
            for (int rep_ = 0; rep_ < REP_S5B; ++rep_) for (int u = F.vcu; u < 256; u += F.G) {
                __syncthreads();
                if (F.wave < 2) s5_scan_task(F, INP(I_LAM_RE) + j * 4096, INP(I_LAM_IM) + j * 4096, INP(I_LOG_STEP) + j * 64, (2 * (u & 1) + F.wave) * 64 + (u >> 2), 0);
                asm volatile("s_waitcnt vmcnt(0)" ::: "memory");
                s5_gemmB_unit(F, INP(I_D_S5) + j * 1024, u); }
            GRID_BAR();
            }
            __syncthreads();
            convert_weight(F, INP(I_W_UP) + (size_t)layer * D * FF, D, FF, WSP(bf16, WS_SLOT16), 0);
            convert_weight(F, INP(I_W_DOWN) + (size_t)layer * FF * D, FF, D, layer == 1 ? WSP(bf16, WS_DOWN1) : WSP(bf16, WS_SLOT16) + (size_t)FF * D, 0);
            __syncthreads();
            if (opq(SKIP_ODD) != 1) {
            { pg8::Gemm g{WSP(bf16, WS_Y), WSP(bf16, WS_W4), M, 2048, D}; pg8::StaticOrder S; S.init(M, 2048, F.G, F.bid);
              pg8::EpiGlu E{WSP(bf16, WS_M32B), D};
              pg8::gemm_phase<pg8::EpiGlu, pg8::StaticOrder, true, true>(F.lds, g, S, E, F.tid); }
#if REP_GEMM == 2 || defined(REP_G_GLU)
            { PHASE(); pg8::Gemm g{WSP(bf16, WS_Y), WSP(bf16, WS_W4), M, 2048, D}; pg8::StaticOrder S; S.init(M, 2048, F.G, F.bid);
              pg8::EpiGlu E{WSP(bf16, WS_M32B), D};
              pg8::gemm_phase<pg8::EpiGlu, pg8::StaticOrder, true, true>(F.lds, g, S, E, F.tid); }
#endif
            } else zero_fill(F, WSP(bf16, WS_M32B), (size_t)M * D * 2);
            GRID_BAR();
            row_phase<false, false>(F, WSP(bf16, WS_M32B), F.out, F.out, INP(I_POST_MIX) + layer * D, INP(I_PRE_MLP) + layer * D, WSP(bf16, WS_SLOT32));
            GRID_BAR();
        }
        { pg8::Gemm g{WSP(bf16, WS_SLOT32), WSP(bf16, WS_SLOT16), M, FF, D}; pg8::StaticOrder S; S.init(M, FF, F.G, F.bid);
          pg8::EpiRelu2 E{WSP(bf16, WS_U), FF};
          pg8::gemm_phase<pg8::EpiRelu2, pg8::StaticOrder, true, true>(F.lds, g, S, E, F.tid); }
#if REP_GEMM == 2 || defined(REP_G_UP)
            { PHASE(); pg8::Gemm g{WSP(bf16, WS_SLOT32), WSP(bf16, WS_SLOT16), M, FF, D}; pg8::StaticOrder S; S.init(M, FF, F.G, F.bid);
          pg8::EpiRelu2 E{WSP(bf16, WS_U), FF};
          pg8::gemm_phase<pg8::EpiRelu2, pg8::StaticOrder, true, true>(F.lds, g, S, E, F.tid); }
#endif
        GRID_BAR();
        __syncthreads();
        if ((layer & 1) == 0) { convert_weight(F, INP(I_W_GLU_A) + (size_t)j * D * D, D, D, WSP(bf16, WS_W4), 1); convert_weight(F, INP(I_W_GLU_B) + (size_t)j * D * D, D, D, WSP(bf16, WS_W4), 2); }
#if REP_CONV == 2
        if ((layer & 1) == 0) { convert_weight(F, INP(I_W_GLU_A) + (size_t)j * D * D, D, D, WSP(bf16, WS_W4), 1); convert_weight(F, INP(I_W_GLU_B) + (size_t)j * D * D, D, D, WSP(bf16, WS_W4), 2); }
#endif
        if (layer == 1) {
            convert_weight(F, INP(I_W_IN) + (size_t)D * INP, D, INP, WSP(bf16, WS_SLOT16), 0);
#if REP_CONV == 2
            convert_weight(F, INP(I_W_IN) + (size_t)D * INP, D, INP, WSP(bf16, WS_SLOT16), 0);
#endif
            zero_fill(F, WSP(bf16, WS_SLOT16) + (size_t)6688 * D, (size_t)(INP_PAD - 6688) * D * 2);
            convert_weight(F, INP(I_W_OUT) + (size_t)2048 * D, 2048, D, WSP(bf16, WS_W4), 0);
#if REP_CONV == 2
            convert_weight(F, INP(I_W_OUT) + (size_t)2048 * D, 2048, D, WSP(bf16, WS_W4), 0);
#endif
        }
        __syncthreads();
        if (((FUSE_DOWN >> layer) & 1) && layer < DEPTH - 1 && F.G == 256) {
            { pg8::Gemm g{WSP(bf16, WS_U), layer == 1 ? WSP(bf16, WS_DOWN1) : WSP(bf16, WS_SLOT16) + (size_t)FF * D, M, D, FF}; pg8::StaticOrder S; S.init(M, D, F.G, F.bid);
              pg8::EpiResNorm<false> E{(const void*)F.out, (bf16*)F.out, WSP(bf16, WS_SLOT32), INP(I_POST_MLP) + layer * D, INP(I_PRE_MIX) + (layer + 1) * D,
                                       WSP(unsigned long long, WS_XBUF_B), (unsigned*)(F.ws + WS_CTL) + CW_PANEL + 4096, 32u * (unsigned)__builtin_popcount(FUSE_DOWN & ((2 << layer) - 1)), EPS};
              pg8::gemm_phase<pg8::EpiResNorm<false>, pg8::StaticOrder, true, true>(F.lds, g, S, E, F.tid); }
            __syncthreads();
#ifdef XTRA_BAR
            GRID_BAR();
#endif
#ifdef HN_SEP
            GRID_BAR();
            hn_from_h(F, (const bf16*)F.out, INP(I_PRE_MIX) + (layer + 1) * D, WSP(bf16, WS_SLOT32));
#endif
        } else {
        { pg8::Gemm g{WSP(bf16, WS_U), layer == 1 ? WSP(bf16, WS_DOWN1) : WSP(bf16, WS_SLOT16) + (size_t)FF * D, M, D, FF}; pg8::StaticOrder S; S.init(M, D, F.G, F.bid);
          pg8::EpiBf16 E{WSP(bf16, WS_M32B), D};
          pg8::gemm_phase<pg8::EpiBf16, pg8::StaticOrder, true, true>(F.lds, g, S, E, F.tid); }
#if REP_GEMM == 2 || defined(REP_G_DOWN)
            { PHASE(); pg8::Gemm g{WSP(bf16, WS_U), layer == 1 ? WSP(bf16, WS_DOWN1) : WSP(bf16, WS_SLOT16) + (size_t)FF * D, M, D, FF}; pg8::StaticOrder S; S.init(M, D, F.G, F.bid);
          pg8::EpiBf16 E{WSP(bf16, WS_M32B), D};
          pg8::gemm_phase<pg8::EpiBf16, pg8::StaticOrder, true, true>(F.lds, g, S, E, F.tid); }
#endif
        GRID_BAR();
        if (layer < DEPTH - 1) row_phase<false, false>(F, WSP(bf16, WS_M32B), F.out, F.out, INP(I_POST_MLP) + layer * D, INP(I_PRE_MIX) + (layer + 1) * D, WSP(bf16, WS_SLOT32));
        else row_phase<false, true>(F, WSP(bf16, WS_M32B), F.out, F.out, INP(I_POST_MLP) + layer * D, nullptr, nullptr);
        }
        if (layer == 0 || layer == 2) {
            const S5Par P5{INP(I_LAM_RE) + j * 4096, INP(I_LAM_IM) + j * 4096, INP(I_LOG_STEP) + j * 64, INP(I_B_RE) + (size_t)j * 65536, INP(I_B_IM) + (size_t)j * 65536,
                           INP(I_C_RE) + (size_t)j * 65536, INP(I_C_IM) + (size_t)j * 65536, INP(I_D_S5) + j * 1024};
            for (int u = F.bid; u < 256; u += F.G) s5_build_unit(F, P5, u);
        }
        if (layer < DEPTH - 1) GRID_BAR();

}

__global__ void __launch_bounds__(NTHR, 2) trunk_fwd(Args args) {
    extern __shared__ __attribute__((aligned(16))) unsigned char lds[];
#ifdef CODE_SHIFT
    asm volatile(".rept " CODE_SHIFT_STR "\n\ts_nop 0\n\t.endr" ::: "memory");
#endif
    Frame F;
    F.lds = (LAS unsigned char*)lds;
    F.G = gridDim.x; F.bid = blockIdx.x;
    { const int t = threadIdx.x;
      for (int u = t; u < (LDS_BYTES - MISC_OFF) / 4; u += NTHR) ((LAS unsigned*)(F.lds + MISC_OFF))[u] = 0u;
      __syncthreads();
      if (t < N_IN + 2) ((LAS unsigned long long*)(F.lds + MISC_OFF + 256))[t] = t < N_IN ? (unsigned long long)args.in[t] : (t == N_IN ? (unsigned long long)args.out : (unsigned long long)args.ws);
      __syncthreads(); }
    const int wave0 = __builtin_amdgcn_readfirstlane(threadIdx.x >> 6);
    PHASE();
    (void)xcd_barrier_post((unsigned*)(F.ws + WS_CTL) + CW_BAR, (volatile LAS unsigned*)(F.lds + MISC_OFF) + 8);

    build_rope(F);
    convert_weight(F, INP(I_W_IN), D, INP, WSP(bf16, WS_SLOT16), 0);
#if REP_CONV == 2
    convert_weight(F, INP(I_W_IN), D, INP, WSP(bf16, WS_SLOT16), 0);
#endif
    zero_fill(F, WSP(bf16, WS_SLOT16) + (size_t)6688 * D, (size_t)(INP_PAD - 6688) * D * 2);
    convert_weight(F, INP(I_W_OUT), 2048, D, WSP(bf16, WS_W4), 0);
#if REP_CONV == 2
    convert_weight(F, INP(I_W_OUT), 2048, D, WSP(bf16, WS_W4), 0);
#endif
    rms_rows_to_bf16(F, INP(I_X), INP(I_PRE_MIX), WSP(bf16, WS_SLOT32));
    GRID_BAR();

    run_layer<0>(F, wave0); run_layer<1>(F, wave0); run_layer<2>(F, wave0); run_layer<3>(F, wave0);
}

extern "C" void kernel_launch(void* const* d_in, const int* in_sizes, int n_in, void* d_out, int out_size, void* d_ws, size_t ws_size, hipStream_t stream) {
    static int grid = 0;
    if (grid == 0) {
        if (n_in != N_IN || out_size != M * D || ws_size < WS_END) { fprintf(stderr, "kernel_launch: unexpected shapes (n_in %d, out %d, ws %zu)\n", n_in, out_size, ws_size); grid = -1; return; }
        int dev = 0, cus = 0, per_cu = 0;
        if (hipGetDevice(&dev) != hipSuccess || hipDeviceGetAttribute(&cus, hipDeviceAttributeMultiprocessorCount, dev) != hipSuccess) { grid = -1; return; }
        if (hipFuncSetAttribute((const void*)trunk_fwd, hipFuncAttributeMaxDynamicSharedMemorySize, LDS_BYTES) != hipSuccess) { fprintf(stderr, "kernel_launch: hipFuncSetAttribute failed\n"); grid = -1; return; }
        if (hipOccupancyMaxActiveBlocksPerMultiprocessor(&per_cu, (const void*)trunk_fwd, NTHR, LDS_BYTES) != hipSuccess || per_cu < 1)
            fprintf(stderr, "kernel_launch: note: occupancy query reports %d workgroups per CU\n", per_cu);
        (void)hipGetLastError();
        grid = cus;
    }
    if (grid < 0) return;
    if (hipMemsetAsync((char*)d_ws + WS_CTL, 0, CTL_ZERO_BYTES, stream) != hipSuccess) return;
#ifdef DBG_ZERO_MISC
    if (hipMemsetAsync((char*)d_ws + WS_MISC, 0, 512 * 1024, stream) != hipSuccess) return;
#endif
    Args a{};
    for (int i = 0; i < N_IN; ++i) a.in[i] = (const float*)d_in[i];
    a.out = (float*)d_out; a.ws = (unsigned char*)d_ws;
    hipLaunchKernelGGL(trunk_fwd, dim3(grid), dim3(NTHR), LDS_BYTES, stream, a);
}
```

```cpp
#include <hip/hip_runtime.h>
#include <cstdio>
#include <cstdint>
namespace pg8 {
#define PG8_LAS __attribute__((address_space(3)))
typedef unsigned short bf16_t;
typedef short bf16x8 __attribute__((ext_vector_type(8)));
typedef float f32x4 __attribute__((ext_vector_type(4)));
typedef unsigned u32x4 __attribute__((ext_vector_type(4)));
constexpr int BM = 256, BK = 64, HALF = 128, HTB = HALF * BK * 2  , STAGE_BYTES = 8 * HTB, NXCD = 8, WGM = 8;

__host__ __device__ __forceinline__ int lds_byte(int r, int c) { const int st = (r >> 4) * 2 + (c >> 5), rr = r & 15, cc = c & 31, ob = rr * 64 + cc * 2; return st * 1024 + (ob ^ (((ob >> 9) & 1) << 5)); }
__host__ __device__ __forceinline__ void stage_rc(int b, int& R, int& C) { const int st = b / 1024, sb = b % 1024, swz = sb ^ (((sb >> 9) & 1) << 5); R = (st >> 1) * 16 + swz / 64; C = (st & 1) * 32 + (swz % 64) / 2; }
__host__ __device__ __forceinline__ int perm32(int rho) { const int n = rho >> 4, i = rho & 15; return 8 * (i >> 2) + 4 * n + (i & 3); }

struct Unit { int pm, pn; };
struct Gemm { const bf16_t* A; const bf16_t* Bt; int M, N, K; };

struct StaticOrder {
    int nM, nN, nwg, G, c;
    __host__ __device__ void init(int M, int N, int G_, int c_) { nM = M / BM; nN = N / BM; nwg = nM * nN; G = G_; c = c_; }
    __host__ __device__ bool next(int i, Unit& u) const {
        const long L = (long)i * G + c; if (L >= nwg) return false;
        int wgid = (int)L; { const int q = nwg / NXCD, r = nwg % NXCD, xcd = wgid % NXCD, off = wgid / NXCD; wgid = (xcd < r ? xcd * (q + 1) : r * (q + 1) + (xcd - r) * q) + off; }
        const int nig = WGM * nN, gid = wgid / nig, fm = gid * WGM, gsz = (nM - fm) < WGM ? (nM - fm) : WGM;
        u.pm = fm + ((wgid % nig) % gsz); u.pn = (wgid % nig) / gsz; return true;
    }
    __device__ __forceinline__ void a_ready(const Unit&) const {}
    __device__ __forceinline__ void done(const Unit&) const {}
};

typedef __bf16 bf2_t __attribute__((ext_vector_type(2))); typedef float f32x2p __attribute__((ext_vector_type(2)));
__device__ __forceinline__ unsigned cvt_pk_bf16(float lo, float hi) { const f32x2p v = {lo, hi}; return __builtin_bit_cast(unsigned, __builtin_convertvector(v, bf2_t)); }
typedef float f32x2 __attribute__((ext_vector_type(2)));
struct EpiBf16 {
    static constexpr bool PERM = true, AFTER_DRAIN = false;
    bf16_t* O; int ldc;
    __device__ __forceinline__ void operator()(const f32x4 (&acc)[2][2][4][2], const Unit& u, int wr, int wc, int fr_in, int fq_in) const {
        int fr = fr_in, fq = fq_in; asm volatile("" : "+v"(fr), "+v"(fq));
        const int row0 = u.pm * BM + wr * 64 + fr, col0 = u.pn * BM + wc * 32 + 8 * fq;
#pragma unroll
        for (int ai = 0; ai < 2; ++ai)
#pragma unroll
            for (int m = 0; m < 4; ++m) { bf16_t* rowp = O + (size_t)(row0 + ai * HALF + m * 16) * ldc + col0;
#pragma unroll
                for (int bj = 0; bj < 2; ++bj) { const f32x4 v0 = acc[ai][bj][m][0], v1 = acc[ai][bj][m][1];
                    u32x4 w; w.x = cvt_pk_bf16(v0[0], v0[1]); w.y = cvt_pk_bf16(v0[2], v0[3]); w.z = cvt_pk_bf16(v1[0], v1[1]); w.w = cvt_pk_bf16(v1[2], v1[3]);
                    *(u32x4*)(rowp + bj * HALF) = w; } }
    }
};
struct EpiGlu {
    static constexpr bool PERM = true, AFTER_DRAIN = false;
    bf16_t* O; int ldc;
    __device__ __forceinline__ void operator()(const f32x4 (&acc)[2][2][4][2], const Unit& u, int wr, int wc, int fr_in, int fq_in) const {
        int fr = fr_in, fq = fq_in; asm volatile("" : "+v"(fr), "+v"(fq));
        const int row0 = u.pm * BM + wr * 64 + fr, col0 = u.pn * HALF + wc * 32 + 8 * fq;
#pragma unroll
        for (int ai = 0; ai < 2; ++ai)
#pragma unroll
            for (int m = 0; m < 4; ++m) { bf16_t* rowp = O + (size_t)(row0 + ai * HALF + m * 16) * ldc + col0;
                f32x4 o[2];
#pragma unroll
                for (int n = 0; n < 2; ++n) { const f32x4 a = acc[ai][0][m][n], b = acc[ai][1][m][n];
#pragma unroll
                    for (int j = 0; j < 4; ++j) o[n][j] = a[j] * __builtin_amdgcn_rcpf(1.0f + __expf(-b[j])); }
                u32x4 w; w.x = cvt_pk_bf16(o[0][0], o[0][1]); w.y = cvt_pk_bf16(o[0][2], o[0][3]); w.z = cvt_pk_bf16(o[1][0], o[1][1]); w.w = cvt_pk_bf16(o[1][2], o[1][3]);
                *(u32x4*)rowp = w; }
    }
};
struct EpiRelu2 {
    static constexpr bool PERM = true, AFTER_DRAIN = false;
    bf16_t* O; int ldc;
    __device__ __forceinline__ void operator()(const f32x4 (&acc)[2][2][4][2], const Unit& u, int wr, int wc, int fr_in, int fq_in) const {
        int fr = fr_in, fq = fq_in; asm volatile("" : "+v"(fr), "+v"(fq));
        const int row0 = u.pm * BM + wr * 64 + fr, col0 = u.pn * BM + wc * 32 + 8 * fq;
#pragma unroll
        for (int ai = 0; ai < 2; ++ai)
#pragma unroll
            for (int m = 0; m < 4; ++m) { bf16_t* rowp = O + (size_t)(row0 + ai * HALF + m * 16) * ldc + col0;
#pragma unroll
                for (int bj = 0; bj < 2; ++bj) { f32x4 v0 = acc[ai][bj][m][0], v1 = acc[ai][bj][m][1];
#pragma unroll
                    for (int j = 0; j < 4; ++j) { const float a = fmaxf(v0[j], 0.f), b = fmaxf(v1[j], 0.f); v0[j] = a * a; v1[j] = b * b; }
                    u32x4 w; w.x = cvt_pk_bf16(v0[0], v0[1]); w.y = cvt_pk_bf16(v0[2], v0[3]); w.z = cvt_pk_bf16(v1[0], v1[1]); w.w = cvt_pk_bf16(v1[2], v1[3]);
                    *(u32x4*)(rowp + bj * HALF) = w; } }
    }
};
struct EpiInProj {
    static constexpr bool PERM = true, AFTER_DRAIN = false;
    bf16_t* QKV; bf16_t* GZ; bf16_t* XBC; float* DT; const float* rope; const float* dt_bias;
    __device__ __forceinline__ void operator()(const f32x4 (&acc)[2][2][4][2], const Unit& u, int wr, int wc, int fr_in, int fq_in) const {
        int fr = fr_in, fq = fq_in; asm volatile("" : "+v"(fr), "+v"(fq));
        const int pn = u.pn, row0 = u.pm * BM + wr * 64 + fr, cin = wc * 32 + 8 * fq;
        if (pn < 8) {
            const int hd = pn & 3; const bool isk = pn >= 4;
            const float lg2 = __log2f(1.0f - exp2f(-5.0f - (float)hd));
#pragma unroll
            for (int ai = 0; ai < 2; ++ai)
#pragma unroll
                for (int m = 0; m < 4; ++m) { const int row = row0 + ai * HALF + m * 16, pos = row & 4095, r = pos & 127;
                    const float sc = isk ? exp2f(-(float)r * lg2) * 0.0625f : exp2f((float)r * lg2);
                    const f32x4* rp = (const f32x4*)(rope + ((size_t)pos * 128 + cin) * 2);
                    f32x4 o1[2], o2[2];
#pragma unroll
                    for (int n = 0; n < 2; ++n) { const f32x4 cs0 = rp[2 * n], cs1 = rp[2 * n + 1];
                        const f32x4 x1 = acc[ai][0][m][n], x2 = acc[ai][1][m][n];
                        const float c[4] = {cs0[0], cs0[2], cs1[0], cs1[2]}, s[4] = {cs0[1], cs0[3], cs1[1], cs1[3]};
#pragma unroll
                        for (int j = 0; j < 4; ++j) { o1[n][j] = (x1[j] * c[j] - x2[j] * s[j]) * sc; o2[n][j] = (x2[j] * c[j] + x1[j] * s[j]) * sc; } }
                    bf16_t* rowp = QKV + (size_t)row * 3072 + pn * 256 + cin;
                    u32x4 w; w.x = cvt_pk_bf16(o1[0][0], o1[0][1]); w.y = cvt_pk_bf16(o1[0][2], o1[0][3]); w.z = cvt_pk_bf16(o1[1][0], o1[1][1]); w.w = cvt_pk_bf16(o1[1][2], o1[1][3]);
                    *(u32x4*)rowp = w;
                    w.x = cvt_pk_bf16(o2[0][0], o2[0][1]); w.y = cvt_pk_bf16(o2[0][2], o2[0][3]); w.z = cvt_pk_bf16(o2[1][0], o2[1][1]); w.w = cvt_pk_bf16(o2[1][2], o2[1][3]);
                    *(u32x4*)(rowp + HALF) = w; }
        } else if (pn < 26) {
            bf16_t* base; int ldc, colt;
            if (pn < 12) { base = QKV; ldc = 3072; colt = pn * 256; } else if (pn < 20) { base = GZ; ldc = 2048; colt = (pn - 12) * 256; } else { base = XBC; ldc = 1536; colt = (pn - 20) * 256; }
#pragma unroll
            for (int ai = 0; ai < 2; ++ai)
#pragma unroll
                for (int m = 0; m < 4; ++m) { bf16_t* rowp = base + (size_t)(row0 + ai * HALF + m * 16) * ldc + colt + cin;
#pragma unroll
                    for (int bj = 0; bj < 2; ++bj) { const f32x4 v0 = acc[ai][bj][m][0], v1 = acc[ai][bj][m][1];
                        u32x4 w; w.x = cvt_pk_bf16(v0[0], v0[1]); w.y = cvt_pk_bf16(v0[2], v0[3]); w.z = cvt_pk_bf16(v1[0], v1[1]); w.w = cvt_pk_bf16(v1[2], v1[3]);
                        *(u32x4*)(rowp + bj * HALF) = w; } }
        } else {
            if (cin < 16) {
#pragma unroll
                for (int ai = 0; ai < 2; ++ai)
#pragma unroll
                    for (int m = 0; m < 4; ++m) { float* rowp = DT + (size_t)(row0 + ai * HALF + m * 16) * 16 + cin;
#pragma unroll
                        for (int n = 0; n < 2; ++n) { f32x4 o;
#pragma unroll
                            for (int j = 0; j < 4; ++j) { const float x = acc[ai][0][m][n][j] + dt_bias[cin + 4 * n + j]; o[j] = fmaxf(x > 20.f ? x : log1pf(__expf(x)), 1e-30f); }
                            *(f32x4*)(rowp + 4 * n) = o; } }
            }
        }
    }
};
template <bool IN_F32>
struct EpiResNorm {
    static constexpr bool PERM = true, AFTER_DRAIN = true;
    const void* hin; bf16_t* hout; bf16_t* hn; const float* w_post; const float* w_pre; unsigned long long* xbuf; unsigned* cnt; unsigned want; float eps;
    static __device__ __forceinline__ f32x4 up4(unsigned w0, unsigned w1) { return (f32x4){__builtin_bit_cast(float, w0 << 16), __builtin_bit_cast(float, w0 & 0xffff0000u), __builtin_bit_cast(float, w1 << 16), __builtin_bit_cast(float, w1 & 0xffff0000u)}; }
    __device__ __forceinline__ void fused(f32x4 (&acc)[2][2][4][2], const Unit& u, int wr, int wc, int fr_in, int fq_in, PG8_LAS unsigned char* lds, int wid, int lane_in) const {
        int fr = fr_in, fq = fq_in, lane = lane_in; asm volatile("" : "+v"(fr), "+v"(fq), "+v"(lane));
        typedef float f32x2v __attribute__((ext_vector_type(2)));
#ifdef TPROBE
        unsigned long long tp_t0 = 0ull;
#define TP_B(id) do { if (TPROBE == (id) && blockIdx.x == TP_CU && threadIdx.x == 0) tp_t0 = __builtin_amdgcn_s_memrealtime(); } while (0)
#define TP_E(id) do { if (TPROBE == (id) && blockIdx.x == TP_CU && threadIdx.x == 0) *(PG8_LAS unsigned*)(lds + 146432) += (unsigned)(__builtin_amdgcn_s_memrealtime() - tp_t0); } while (0)
#else
#define TP_B(id) do {} while (0)
#define TP_E(id) do {} while (0)
#endif
        TP_B(1); TP_B(2);
        PG8_LAS f32x4* P = (PG8_LAS f32x4*)lds;
        PG8_LAS f32x2v* S = (PG8_LAS f32x2v*)(lds + 16384);
        const int rowt = wr * 64 + fr, col0 = u.pn * BM + wc * 32 + 8 * fq;
        const size_t grow0 = (size_t)u.pm * BM + rowt;
        u32x4 wp[2][4][2];
        {   f32x4 wv[2][2];
#pragma unroll
            for (int bj = 0; bj < 2; ++bj)
#pragma unroll
                for (int n = 0; n < 2; ++n) wv[bj][n] = *(const f32x4*)(w_post + col0 + bj * HALF + 4 * n);
#pragma unroll
            for (int ai = 0; ai < 2; ++ai) {
                f32x4 hx[4][2][2];
                u32x4 hp[2][4][2];
                if (!IN_F32) {
#pragma unroll
                    for (int m = 0; m < 4; ++m)
#pragma unroll
                        for (int bj = 0; bj < 2; ++bj) hp[ai][m][bj] = *(const u32x4*)((const bf16_t*)hin + (grow0 + ai * HALF + m * 16) * 2048 + col0 + bj * HALF);
                }
#pragma unroll
                for (int m = 0; m < 4; ++m) {
                    if (IN_F32 && (m & 1) == 0) {
#pragma unroll
                        for (int mm = m; mm < m + 2; ++mm)
#pragma unroll
                            for (int bj = 0; bj < 2; ++bj)
#pragma unroll
                                for (int n = 0; n < 2; ++n) hx[mm][bj][n] = *(const f32x4*)((const float*)hin + (grow0 + ai * HALF + mm * 16) * 1024 + col0 + bj * HALF + 4 * n);
                    }
                    float s1 = 0.f, s2 = 0.f, s3 = 0.f, s4 = 0.f;
#pragma unroll
                    for (int bj = 0; bj < 2; ++bj) { f32x4 wm[2];
#pragma unroll
                        for (int n = 0; n < 2; ++n) {
                            const f32x4 hv = IN_F32 ? hx[m][bj][n] : up4(hp[ai][m][bj][2 * n], hp[ai][m][bj][2 * n + 1]);
                            const f32x4 a = acc[ai][bj][m][n]; wm[n] = a * wv[bj][n];
                            s1 += (a[0] * a[0] + a[1] * a[1]) + (a[2] * a[2] + a[3] * a[3]);
                            s2 += (hv[0] * hv[0] + hv[1] * hv[1]) + (hv[2] * hv[2] + hv[3] * hv[3]);
                            s3 += (hv[0] * wm[n][0] + hv[1] * wm[n][1]) + (hv[2] * wm[n][2] + hv[3] * wm[n][3]);
                            s4 += (wm[n][0] * wm[n][0] + wm[n][1] * wm[n][1]) + (wm[n][2] * wm[n][2] + wm[n][3] * wm[n][3]); }
                        u32x4 w; w.x = cvt_pk_bf16(wm[0][0], wm[0][1]); w.y = cvt_pk_bf16(wm[0][2], wm[0][3]); w.z = cvt_pk_bf16(wm[1][0], wm[1][1]); w.w = cvt_pk_bf16(wm[1][2], wm[1][3]);
                        asm volatile("" : "+v"(w));
                        wp[ai][m][bj] = w; }
                    s1 += __shfl_xor(s1, 16); s2 += __shfl_xor(s2, 16); s3 += __shfl_xor(s3, 16); s4 += __shfl_xor(s4, 16);
                    s1 += __shfl_xor(s1, 32); s2 += __shfl_xor(s2, 32); s3 += __shfl_xor(s3, 32); s4 += __shfl_xor(s4, 32);
                    if (fq == 0) P[(ai * HALF + rowt + m * 16) * 4 + wc] = (f32x4){s1, s2, s3, s4};
                    if (IN_F32 && (m & 1)) asm volatile("" ::: "memory");
                }
                asm volatile("" ::: "memory");
            }
        }
        asm volatile("s_waitcnt lgkmcnt(0)" ::: "memory"); __builtin_amdgcn_s_barrier(); asm volatile("" ::: "memory");
        TP_E(2); TP_B(3);
        const int row = wid * 32 + (lane & 31);
        if (lane < 32) {
            const f32x4 a = P[row * 4 + 0], b = P[row * 4 + 1], c = P[row * 4 + 2], d = P[row * 4 + 3];
            const f32x4 t = (a + b) + (c + d);
            const float t0 = t[0], t1 = t[1], t2 = t[2], t3 = t[3];
            unsigned long long* slot = xbuf + ((size_t)(u.pm * BM + row) * 4 + u.pn) * 2;
            __hip_atomic_store(slot, ((unsigned long long)__builtin_bit_cast(unsigned, t1) << 32) | __builtin_bit_cast(unsigned, t0), __ATOMIC_RELAXED, __HIP_MEMORY_SCOPE_AGENT);
            __hip_atomic_store(slot + 1, ((unsigned long long)__builtin_bit_cast(unsigned, t3) << 32) | __builtin_bit_cast(unsigned, t2), __ATOMIC_RELAXED, __HIP_MEMORY_SCOPE_AGENT);
        }
        asm volatile("s_waitcnt vmcnt(0)" ::: "memory");
        if (lane == 0) __hip_atomic_fetch_add(cnt + 64 * u.pm, 1u, __ATOMIC_RELAXED, __HIP_MEMORY_SCOPE_AGENT);
        TP_E(3); TP_B(4);
        if (wid == 0) {
            unsigned sp = 0u;
            for (;;) {
                if ((unsigned)__builtin_amdgcn_readfirstlane(__hip_atomic_load(cnt + 64 * u.pm, __ATOMIC_RELAXED, __HIP_MEMORY_SCOPE_AGENT)) >= want) break;
                if (++sp > (1u << 22)) break;
                __builtin_amdgcn_s_sleep(2);
            }
#ifdef XCH_FENCE
            __builtin_amdgcn_fence(__ATOMIC_ACQUIRE, "agent");
#endif
        }
        asm volatile("s_waitcnt vmcnt(0) lgkmcnt(0)" ::: "memory"); __builtin_amdgcn_s_barrier(); asm volatile("" ::: "memory");
        TP_E(4); TP_B(5);
        if (lane < 32) {
            const unsigned long long* slot = xbuf + (size_t)(u.pm * BM + row) * 8; float t1 = 0.f, t2 = 0.f, t3 = 0.f, t4 = 0.f;
#pragma unroll
            for (int t = 0; t < 4; ++t) { const unsigned long long w0 = __hip_atomic_load(slot + 2 * t, __ATOMIC_RELAXED, __HIP_MEMORY_SCOPE_AGENT), w1 = __hip_atomic_load(slot + 2 * t + 1, __ATOMIC_RELAXED, __HIP_MEMORY_SCOPE_AGENT);
                t1 += __builtin_bit_cast(float, (unsigned)w0); t2 += __builtin_bit_cast(float, (unsigned)(w0 >> 32)); t3 += __builtin_bit_cast(float, (unsigned)w1); t4 += __builtin_bit_cast(float, (unsigned)(w1 >> 32)); }
            const float r1 = rsqrtf(t1 * (1.0f / 1024.0f) + eps);
            const float q = fmaxf(t2 + r1 * (2.0f * t3 + r1 * t4), 0.f);
            S[row] = (f32x2v){r1, rsqrtf(q * (1.0f / 1024.0f) + eps)};
        }
        asm volatile("s_waitcnt lgkmcnt(0)" ::: "memory"); __builtin_amdgcn_s_barrier(); asm volatile("" ::: "memory");
        TP_E(5); TP_B(6);
        u32x4 hp[2][4][2];
        if (!IN_F32) {
#pragma unroll
            for (int ai = 0; ai < 2; ++ai)
#pragma unroll
                for (int m = 0; m < 4; ++m)
#pragma unroll
                    for (int bj = 0; bj < 2; ++bj) hp[ai][m][bj] = *(const u32x4*)((const bf16_t*)hin + (grow0 + ai * HALF + m * 16) * 2048 + col0 + bj * HALF);
        }
        f32x4 wq[2][2];
#pragma unroll
        for (int bj = 0; bj < 2; ++bj)
#pragma unroll
            for (int n = 0; n < 2; ++n) wq[bj][n] = *(const f32x4*)(w_pre + col0 + bj * HALF + 4 * n);
#pragma unroll
        for (int ai = 0; ai < 2; ++ai) {
            f32x4 hx[4][2][2];
            if (IN_F32) {
#pragma unroll
                for (int m = 0; m < 4; ++m)
#pragma unroll
                    for (int bj = 0; bj < 2; ++bj)
#pragma unroll
                        for (int n = 0; n < 2; ++n) hx[m][bj][n] = *(const f32x4*)((const float*)hin + (grow0 + ai * HALF + m * 16) * 1024 + col0 + bj * HALF + 4 * n);
            }
#pragma unroll
            for (int m = 0; m < 4; ++m) { const int r = ai * HALF + rowt + m * 16; const f32x2v sr = S[r]; const size_t grow = (size_t)u.pm * BM + r;
#pragma unroll
                for (int bj = 0; bj < 2; ++bj) { f32x4 o[2];
#pragma unroll
                    for (int n = 0; n < 2; ++n) { const f32x4 hv = IN_F32 ? hx[m][bj][n] : up4(hp[ai][m][bj][2 * n], hp[ai][m][bj][2 * n + 1]);
                        o[n] = hv + up4(wp[ai][m][bj][2 * n], wp[ai][m][bj][2 * n + 1]) * sr.x; }
                    u32x4 w; w.x = cvt_pk_bf16(o[0][0], o[0][1]); w.y = cvt_pk_bf16(o[0][2], o[0][3]); w.z = cvt_pk_bf16(o[1][0], o[1][1]); w.w = cvt_pk_bf16(o[1][2], o[1][3]);
                    *(u32x4*)(hout + grow * 2048 + col0 + bj * HALF) = w;
                    const f32x4 y0 = o[0] * sr.y * wq[bj][0], y1 = o[1] * sr.y * wq[bj][1];
                    w.x = cvt_pk_bf16(y0[0], y0[1]); w.y = cvt_pk_bf16(y0[2], y0[3]); w.z = cvt_pk_bf16(y1[0], y1[1]); w.w = cvt_pk_bf16(y1[2], y1[3]);
                    *(u32x4*)(hn + grow * 1024 + col0 + bj * HALF) = w; } }
            if (IN_F32) asm volatile("" ::: "memory");
        }
        TP_E(6); TP_E(1);
    }
};
template <class Epi, class Sched, bool ALIGN_EPI = false, bool SP2 = false>
__device__ __forceinline__ void gemm_phase(PG8_LAS unsigned char* lds, const Gemm g, const Sched& S, const Epi& E, const int tid) {
    const int wid = __builtin_amdgcn_readfirstlane(tid >> 6), lane = tid & 63, wr = wid >> 2, wc = wid & 3, fr = lane & 15, fq = lane >> 4;
    const int K = g.K, nt = K / BK;
    unsigned voffA[2], voffB[2];
#pragma unroll
    for (int i = 0; i < 2; ++i) { int R, C; stage_rc(tid * 16 + i * 8192, R, C); const int Rb = Epi::PERM ? ((R & ~31) + perm32(R & 31)) : R;
        voffA[i] = (unsigned)(R * K + C) * 2u; voffB[i] = (unsigned)(Rb * K + C) * 2u; }
    const size_t kstep = (size_t)(BK * 2);
    const size_t hstep = (size_t)HALF * K * 2;
    const size_t tstep = 2 * hstep;
    const unsigned ldsw = (unsigned)wid * 1024u;
    const int aoff = lds_byte(wr * 64 + fr, fq * 8), boff = lds_byte(wc * 32 + fr, fq * 8);
#define PG8_SA(b, h) (((b) * 2 + (h)) * HTB)
#define PG8_SB(b, h) ((4 + (b) * 2 + (h)) * HTB)
#define PG8_STAGE(bufoff, gbase, voff) do { _Pragma("unroll") for (int _i = 0; _i < 2; ++_i) \
        __builtin_amdgcn_global_load_lds((const unsigned*)((const char*)(gbase) + (voff)[_i]), (PG8_LAS unsigned*)(lds + (bufoff) + ldsw + _i * 8192), 16, 0, 0); } while (0)
#define PG8_LDA(dst, b, h) do { _Pragma("unroll") for (int m = 0; m < 4; ++m) _Pragma("unroll") for (int k = 0; k < 2; ++k) dst[m][k] = *(const PG8_LAS bf16x8*)(lds + PG8_SA(b, h) + aoff + m * 2048 + k * 1024); } while (0)
#define PG8_LDB(dst, b, h) do { _Pragma("unroll") for (int n = 0; n < 2; ++n) _Pragma("unroll") for (int k = 0; k < 2; ++k) dst[n][k] = *(const PG8_LAS bf16x8*)(lds + PG8_SB(b, h) + boff + n * 2048 + k * 1024); } while (0)
#define PG8_MMA(ai, bj, At, Bt) do { __builtin_amdgcn_s_setprio(1); _Pragma("unroll") for (int m = 0; m < 4; ++m) _Pragma("unroll") for (int n = 0; n < 2; ++n) _Pragma("unroll") for (int k = 0; k < 2; ++k) \
        acc[ai][bj][m][n] = __builtin_amdgcn_mfma_f32_16x16x32_bf16(Bt[n][k], At[m][k], acc[ai][bj][m][n], 0, 0, 0); __builtin_amdgcn_s_setprio(0); } while (0)
#define PG8_WAIT_V(n) asm volatile("s_waitcnt vmcnt(" #n ")" ::: "memory")
#define PG8_WAIT_L(n) asm volatile("s_waitcnt lgkmcnt(" #n ")" ::: "memory")
#define PG8_BAR __builtin_amdgcn_s_barrier()
#define PG8_SCHED __builtin_amdgcn_sched_barrier(0)
    Unit cur, nxt; int ui = 0;
    if (!S.next(0, cur)) return;
    f32x4 acc[2][2][4][2];
#pragma unroll
    for (int a = 0; a < 2; ++a)
#pragma unroll
        for (int b = 0; b < 2; ++b)
#pragma unroll
            for (int m = 0; m < 4; ++m)
#pragma unroll
                for (int n = 0; n < 2; ++n) acc[a][b][m][n] = (f32x4){0.f, 0.f, 0.f, 0.f};
    bf16x8 At[4][2], B0[2][2], B1[2][2];
    const char* cA = (const char*)g.A + (size_t)cur.pm * tstep; const char* cB = (const char*)g.Bt + (size_t)cur.pn * tstep;
    S.a_ready(cur);
    if constexpr (SP2) {
        PG8_STAGE(PG8_SB(0, 0), cB, voffB); PG8_STAGE(PG8_SB(0, 1), cB + hstep, voffB); PG8_STAGE(PG8_SA(0, 0), cA, voffA); PG8_STAGE(PG8_SA(0, 1), cA + hstep, voffA);
        if (wr == 1) PG8_BAR;
        PG8_WAIT_V(2); PG8_BAR;
        PG8_STAGE(PG8_SB(1, 0), cB + kstep, voffB); PG8_STAGE(PG8_SA(1, 0), cA + kstep, voffA); PG8_STAGE(PG8_SB(1, 1), cB + hstep + kstep, voffB);
        PG8_WAIT_V(6); PG8_BAR;
    } else {
        PG8_STAGE(PG8_SB(0, 0), cB, voffB); PG8_STAGE(PG8_SA(0, 0), cA, voffA); PG8_STAGE(PG8_SB(0, 1), cB + hstep, voffB); PG8_STAGE(PG8_SA(0, 1), cA + hstep, voffA);
        if (wr == 1) PG8_BAR;
        PG8_WAIT_V(4); PG8_BAR;
        PG8_STAGE(PG8_SB(1, 0), cB + kstep, voffB); PG8_STAGE(PG8_SA(1, 0), cA + kstep, voffA); PG8_STAGE(PG8_SB(1, 1), cB + hstep + kstep, voffB);
        PG8_WAIT_V(6); PG8_BAR;
    }
    for (;;) {
        const bool has_next = S.next(ui + 1, nxt);
        const char* nA = has_next ? (const char*)g.A + (size_t)nxt.pm * tstep : cA; const char* nB = has_next ? (const char*)g.Bt + (size_t)nxt.pn * tstep : cB;
        for (int t = 0; t < nt; t += 2) {
            const bool last = (t == nt - 2);
            const char* a1 = cA + (size_t)(t + 1) * kstep;
            const char* a2 = last ? nA : cA + (size_t)(t + 2) * kstep; const char* b2 = last ? nB : cB + (size_t)(t + 2) * kstep;
            const char* a3 = a2 + kstep; const char* b3 = b2 + kstep;
            if (last && has_next) S.a_ready(nxt);
            if constexpr (SP2) {
            PG8_LDB(B0, 0, 0); PG8_LDB(B1, 0, 1); PG8_SCHED; PG8_LDA(At, 0, 0); PG8_STAGE(PG8_SA(1, 1), a1 + hstep, voffA);
            PG8_WAIT_V(8); PG8_WAIT_L(0); PG8_BAR; PG8_MMA(0, 0, At, B0); PG8_MMA(0, 1, At, B1); PG8_BAR; PG8_SCHED;
            PG8_LDA(At, 0, 1); PG8_STAGE(PG8_SB(0, 0), b2, voffB); PG8_STAGE(PG8_SB(0, 1), b2 + hstep, voffB); PG8_STAGE(PG8_SA(0, 0), a2, voffA);
            PG8_WAIT_V(8); PG8_WAIT_L(0); PG8_BAR; PG8_MMA(1, 0, At, B0); PG8_MMA(1, 1, At, B1); PG8_BAR; PG8_SCHED;
            PG8_LDB(B0, 1, 0); PG8_LDB(B1, 1, 1); PG8_SCHED; PG8_LDA(At, 1, 0); PG8_STAGE(PG8_SA(0, 1), a2 + hstep, voffA);
            PG8_WAIT_V(8); PG8_WAIT_L(0); PG8_BAR; PG8_MMA(0, 0, At, B0); PG8_MMA(0, 1, At, B1); PG8_BAR; PG8_SCHED;
            PG8_LDA(At, 1, 1); PG8_STAGE(PG8_SB(1, 0), b3, voffB); PG8_STAGE(PG8_SB(1, 1), b3 + hstep, voffB); PG8_STAGE(PG8_SA(1, 0), a3, voffA);
            PG8_WAIT_V(8); PG8_WAIT_L(0); PG8_BAR; PG8_MMA(1, 0, At, B0); PG8_MMA(1, 1, At, B1); PG8_BAR; PG8_SCHED;
            } else {
            PG8_LDB(B0, 0, 0); PG8_SCHED; PG8_LDA(At, 0, 0); PG8_STAGE(PG8_SA(1, 1), a1 + hstep, voffA);
            PG8_WAIT_L(8); PG8_BAR; PG8_WAIT_L(0); PG8_MMA(0, 0, At, B0); PG8_BAR; PG8_SCHED;
            PG8_LDB(B1, 0, 1); PG8_STAGE(PG8_SB(0, 0), b2, voffB);
            PG8_BAR; PG8_WAIT_L(0); PG8_MMA(0, 1, At, B1); PG8_BAR;
            PG8_LDA(At, 0, 1); PG8_STAGE(PG8_SA(0, 0), a2, voffA);
            PG8_BAR; PG8_WAIT_L(0); PG8_MMA(1, 0, At, B0); PG8_BAR; PG8_SCHED;
            PG8_STAGE(PG8_SB(0, 1), b2 + hstep, voffB);
            PG8_WAIT_V(6); PG8_BAR; PG8_MMA(1, 1, At, B1); PG8_BAR;
            PG8_LDB(B0, 1, 0); PG8_SCHED; PG8_LDA(At, 1, 0); PG8_STAGE(PG8_SA(0, 1), a2 + hstep, voffA);
            PG8_WAIT_L(8); PG8_BAR; PG8_WAIT_L(0); PG8_MMA(0, 0, At, B0); PG8_BAR; PG8_SCHED;
            PG8_LDB(B1, 1, 1); PG8_STAGE(PG8_SB(1, 0), b3, voffB);
            PG8_BAR; PG8_WAIT_L(0); PG8_MMA(0, 1, At, B1); PG8_BAR;
            PG8_LDA(At, 1, 1); PG8_STAGE(PG8_SA(1, 0), a3, voffA);
            PG8_BAR; PG8_WAIT_L(0); PG8_MMA(1, 0, At, B0); PG8_BAR; PG8_SCHED;
            PG8_STAGE(PG8_SB(1, 1), b3 + hstep, voffB);
            PG8_WAIT_V(6); PG8_BAR; PG8_MMA(1, 1, At, B1); PG8_BAR;
            }
        }
        if constexpr (ALIGN_EPI) { if (wr == 0) PG8_BAR; }
        if constexpr (!Epi::AFTER_DRAIN) { E(acc, cur, wr, wc, fr, fq);
#if defined(REP_EPI) && REP_EPI == 2
            E(acc, cur, wr, wc, fr, fq);
#endif
            S.done(cur); }
        if (!has_next) break;
#pragma unroll
        for (int a = 0; a < 2; ++a)
#pragma unroll
            for (int b = 0; b < 2; ++b)
#pragma unroll
                for (int m = 0; m < 4; ++m)
#pragma unroll
                    for (int n = 0; n < 2; ++n) acc[a][b][m][n] = (f32x4){0.f, 0.f, 0.f, 0.f};
        cur = nxt; cA = nA; cB = nB; ++ui;
        if constexpr (ALIGN_EPI) { if (wr == 1) PG8_BAR; }
    }
    PG8_WAIT_V(0);
    if constexpr (!ALIGN_EPI) { if (wr == 0) PG8_BAR; }
    PG8_BAR;
    if constexpr (Epi::AFTER_DRAIN) { E.fused(acc, cur, wr, wc, fr, fq, lds, wid, lane); S.done(cur); }
#undef PG8_SA
#undef PG8_SB
#undef PG8_STAGE
#undef PG8_LDA
#undef PG8_LDB
#undef PG8_MMA
#undef PG8_WAIT_V
#undef PG8_WAIT_L
#undef PG8_BAR
#undef PG8_SCHED
}
}
constexpr int NWAVES = 8, NTHR = 512;
constexpr int BATCH = 4, SEQ = 4096, D = 1024, M = BATCH * SEQ, FF = 4096, DEPTH = 4;
constexpr int INP = 6672, INP_PAD = 6912;
constexpr float EPS = 1e-6f;
enum { I_X = 0, I_PRE_MIX, I_POST_MIX, I_PRE_MLP, I_POST_MLP, I_W_IN, I_CONV_W, I_CONV_B, I_DT_BIAS, I_A_LOG, I_D_SSD, I_SSD_NORM, I_W_OUT,
       I_LAM_RE, I_LAM_IM, I_LOG_STEP, I_B_RE, I_B_IM, I_C_RE, I_C_IM, I_D_S5, I_W_GLU_A, I_W_GLU_B, I_W_UP, I_W_DOWN, N_IN };
#ifndef DOWN1_MIB
#define DOWN1_MIB 249
#endif
#ifndef S5MAT_MIB
#define S5MAT_MIB 185
#endif
constexpr size_t MiB = 1u << 20;
constexpr size_t WS_CTL = 0, CTL_ZERO_BYTES = 64 * 1024;
constexpr size_t WS_MISC = 512 * 1024;
constexpr size_t WS_ROPE = 1 * MiB;
constexpr size_t WS_W4 = 5 * MiB;
constexpr size_t WS_SLOT16 = 9 * MiB;
constexpr size_t WS_SLOT32 = 25 * MiB;
constexpr size_t WS_QKV = 57 * MiB;
constexpr size_t WS_GZ = 153 * MiB;
constexpr size_t WS_XBC = 217 * MiB;
constexpr size_t WS_DT = 265 * MiB;
constexpr size_t WS_END = 268 * MiB;
constexpr size_t WS_M32A = 57 * MiB;
constexpr size_t WS_M32B = 185 * MiB;
constexpr size_t WS_U = 57 * MiB;
constexpr size_t WS_S5MAT = (S5MAT_MIB) * MiB;
constexpr size_t WS_S5E = 73 * MiB;
constexpr size_t WS_S5X = 105 * MiB;
constexpr size_t WS_Y = 121 * MiB;
constexpr size_t WS_DOWN1 = (DOWN1_MIB) * MiB;
constexpr size_t WS_XBUF_A = 266 * MiB, WS_XBUF_B = 267 * MiB;
constexpr int CW_PANEL = 8192;
constexpr int SCR_BYTES = 143360;
constexpr int MISC_OFF = SCR_BYTES;
constexpr int LDS_BYTES = 147456;

#define GAS __attribute__((address_space(1)))
#define LAS __attribute__((address_space(3)))
#define DI __device__ __forceinline__
typedef unsigned short bf16;
typedef unsigned v4u __attribute__((ext_vector_type(4)));
typedef unsigned v2u __attribute__((ext_vector_type(2)));
typedef float f32x4 __attribute__((ext_vector_type(4)));
typedef float f32x2v __attribute__((ext_vector_type(2)));
typedef short bf16x8 __attribute__((ext_vector_type(8)));
typedef short v4i16_t __attribute__((ext_vector_type(4)));
typedef GAS unsigned gu32;
#define RLX_AGENT __ATOMIC_RELAXED, __HIP_MEMORY_SCOPE_AGENT
#define LDS_WAIT() asm volatile("s_waitcnt lgkmcnt(0)" ::: "memory")
#define VM_WAIT() asm volatile("s_waitcnt vmcnt(0)" ::: "memory")
DI unsigned f2bf(float f) { unsigned u = __builtin_bit_cast(unsigned, f); return (u + 0x7fffu + ((u >> 16) & 1u)) >> 16; }
typedef __bf16 bf2_t __attribute__((ext_vector_type(2)));
DI unsigned pk2(float lo, float hi) { const f32x2v v = {lo, hi}; return __builtin_bit_cast(unsigned, __builtin_convertvector(v, bf2_t)); }
DI float bf2f(unsigned short b) { return __builtin_bit_cast(float, ((unsigned)b) << 16); }
DI float bflo(unsigned w) { return __builtin_bit_cast(float, w << 16); }
DI float bfhi(unsigned w) { return __builtin_bit_cast(float, w & 0xffff0000u); }
DI float wave_sum(float v) {
#pragma unroll
    for (int o = 1; o < 64; o <<= 1) v += __shfl_xor(v, o);
    return v;
}
DI float silu_f(float x) { return x * __builtin_amdgcn_rcpf(1.0f + __expf(-x)); }
DI void sincos_d(double x, double& s, double& c) {
    const double k = rint(x * 0.15915494309189533576888376337251);
    const double r = fma(-k, 6.283185307179586476925286766559, x), r2 = r * r;
    double ps = 1.0 / 1.0888869450418352e28, pc = 1.0 / 3.0488834461171384e29;
    const double fs[13] = {1.0 / 1.5511210043330986e25, 1.0 / 2.5852016738884978e22, 1.0 / 5.109094217170944e19, 1.0 / 1.21645100408832e17, 1.0 / 355687428096000.0, 1.0 / 1307674368000.0,
                           1.0 / 6227020800.0, 1.0 / 39916800.0, 1.0 / 362880.0, 1.0 / 5040.0, 1.0 / 120.0, 1.0 / 6.0, 1.0};
    const double fc[14] = {1.0 / 4.0329146112660565e26, 1.0 / 6.204484017332394e23, 1.0 / 1.1240007277776077e21, 1.0 / 2.43290200817664e18, 1.0 / 6402373705728000.0, 1.0 / 20922789888000.0,
                           1.0 / 87178291200.0, 1.0 / 479001600.0, 1.0 / 3628800.0, 1.0 / 40320.0, 1.0 / 720.0, 1.0 / 24.0, 1.0 / 2.0, 1.0};
#pragma unroll
    for (int i = 0; i < 13; ++i) ps = fs[i] - ps * r2;
#pragma unroll
    for (int i = 0; i < 14; ++i) pc = fc[i] - pc * r2;
    s = ps * r; c = pc;
}
#define XB_TMO      128
#define XB_XCNT(j)  (256  + 64 * (j))
#define XB_XSUB(j)  (1280 + 64 * (j))
#define XB_XGEN(j)  (2304 + 64 * (j))
#define XB_TOP      3328
#define XB_TOPGEN   3392
#define XCD_BAR_WORDS 3456
#define XB_SPIN_CAP (1u << 18)

__device__ __forceinline__ unsigned xb_ld(unsigned* p)              { return __hip_atomic_load(p, __ATOMIC_RELAXED, __HIP_MEMORY_SCOPE_AGENT); }
__device__ __forceinline__ unsigned xb_add(unsigned* p, unsigned v) { return __hip_atomic_fetch_add(p, v, __ATOMIC_RELAXED, __HIP_MEMORY_SCOPE_AGENT); }
__device__ __forceinline__ unsigned xb_xcc_id() { return (unsigned)__builtin_amdgcn_s_getreg((3 << 11) | 20) & 0xFu; }
#define XB_SPIN(cond, bar) do { unsigned _sp = 0; while (cond) { __builtin_amdgcn_s_sleep(1); \
    if ((++_sp & 255u) == 0u) { if (xb_ld(&(bar)[XB_TMO])) break; if (_sp > XB_SPIN_CAP) { atomicAdd(&(bar)[XB_TMO], 1u); break; } } } } while (0)

struct XcdBarrier {
    unsigned* bar; unsigned x; int tid;
    volatile LAS unsigned* st;
};

__device__ __forceinline__ XcdBarrier xcd_barrier_post(unsigned* bar, volatile LAS unsigned* st) {
    XcdBarrier b; b.bar = bar; b.x = xb_xcc_id(); b.st = st;
    if (threadIdx.x == 0) (void)xb_add(&bar[XB_XCNT(b.x)], 1u);
    return b;
}
__device__ __forceinline__ void xcd_barrier_complete(unsigned* bar, unsigned x, unsigned& nloc, unsigned& nx) {
    const unsigned G = gridDim.x * gridDim.y * gridDim.z;
    unsigned sum, cnt, mine, sp = 0u;
    for (;;) {
        sum = 0u; cnt = 0u; mine = 0u;
#pragma unroll
        for (unsigned j = 0; j < 16; ++j) { const unsigned c = xb_ld(&bar[XB_XCNT(j)]); sum += c; cnt += (c > 0u) ? 1u : 0u; mine = (j == x) ? c : mine; }
        if (sum == G) break;
        __builtin_amdgcn_s_sleep(1);
        if ((++sp & 255u) == 0u) { if (xb_ld(&bar[XB_TMO])) break; if (sp > XB_SPIN_CAP) { atomicAdd(&bar[XB_TMO], 1u); break; } }
    }
    nloc = mine > 0u ? mine : 1u; nx = cnt > 0u ? cnt : 1u;
}

__device__ __forceinline__ void xcd_barrier(const XcdBarrier& b) {
    asm volatile("s_waitcnt vmcnt(0)" ::: "memory");
    __syncthreads();
    if (b.tid == 0) {
        unsigned* bar = b.bar;
        __builtin_amdgcn_s_waitcnt(0);
        unsigned nloc = b.st[0], nx = b.st[1];
        if (nloc == 0u) { xcd_barrier_complete(bar, b.x, nloc, nx); b.st[0] = nloc; b.st[1] = nx; }
        const unsigned old = xb_add(&bar[XB_XSUB(b.x)], 1u);
        const unsigned gen = old / nloc;
        if (old + 1u == (gen + 1u) * nloc) {
            __builtin_amdgcn_fence(__ATOMIC_RELEASE, "agent");
            asm volatile("s_waitcnt vmcnt(0)" ::: "memory");
            const unsigned og = xb_add(&bar[XB_TOP], 1u);
            const unsigned tg = og / nx;
            if (og + 1u == (tg + 1u) * nx) xb_add(&bar[XB_TOPGEN], 1u);
            else XB_SPIN(xb_ld(&bar[XB_TOPGEN]) == tg, bar);
            __builtin_amdgcn_fence(__ATOMIC_ACQUIRE, "agent");
            xb_add(&bar[XB_XGEN(b.x)], 1u);
            asm volatile("s_waitcnt vmcnt(0)" ::: "memory");
        } else {
            XB_SPIN(xb_ld(&bar[XB_XGEN(b.x)]) == gen, bar);
            __builtin_amdgcn_fence(__ATOMIC_ACQUIRE, "agent");
            asm volatile("s_waitcnt vmcnt(0)" ::: "memory");
        }
    }
    __syncthreads();
}

struct Frame {
    LAS unsigned char* lds;
    int tid, lane, wave, G, bid, vcu;
    float* out; unsigned char* ws;
};
DI unsigned long long lds_ptr(const Frame& F, int i) {
    unsigned a_ = (unsigned)(size_t)(F.lds + MISC_OFF + 256) + 8u * (unsigned)i; asm volatile("" : "+v"(a_));
    const unsigned long long v = *(const volatile LAS unsigned long long*)a_;
    const unsigned lo = __builtin_amdgcn_readfirstlane((unsigned)v), hi = __builtin_amdgcn_readfirstlane((unsigned)(v >> 32));
    return ((unsigned long long)hi << 32) | lo;
}
#define INP(i) ((const float*)(const GAS float*)lds_ptr(F, (i)))
DI int gwave(const Frame& F) { return F.bid * NWAVES + F.wave; }

DI bf16x8 frag_rm(const LAS unsigned char* t, int S, int r0, int k0, int lane) { return *(const LAS bf16x8*)(t + (r0 + (lane & 15)) * S + (k0 + 8 * (lane >> 4)) * 2); }
DI bf16x8 frag_tr(const LAS unsigned char* t, int S, int r0, int k0, int lane) {
    const int g = lane >> 4, q = (lane & 15) >> 2, p = lane & 3;
    const LAS unsigned char* a = t + (k0 + 8 * g + q) * S + (r0 + 4 * p) * 2;
    const v4i16_t lo = __builtin_amdgcn_ds_read_tr16_b64_v4i16((LAS v4i16_t*)a);
    const v4i16_t hi = __builtin_amdgcn_ds_read_tr16_b64_v4i16((LAS v4i16_t*)(a + 4 * S));
    return __builtin_shufflevector(lo, hi, 0, 1, 2, 3, 4, 5, 6, 7);
}
DI f32x4 mma(bf16x8 a, bf16x8 b, f32x4 c) { return __builtin_amdgcn_mfma_f32_16x16x32_bf16(a, b, c, 0, 0, 0); }

DI void load_tile(LAS unsigned char* dst, int S, const bf16* src, size_t ld, int rows, int cols, int tid) {
    const int cpr = cols >> 3, n = rows * cpr;
    for (int i = tid; i < n; i += NTHR) { const int r = i / cpr, c = i - r * cpr;
        *(LAS v4u*)(dst + r * S + c * 16) = *(const v4u*)(src + (size_t)r * ld + c * 8); }
}

template <int COLS> DI unsigned tile_loff(int tid, unsigned ld) { constexpr int CPR = COLS / 8; return (unsigned)(tid / CPR) * ld + (unsigned)(tid % CPR) * 8u; }
template <int ROWS, int COLS> DI void tile_issue(v4u* r, const bf16* src, unsigned ld, unsigned loff) {
    constexpr int CPR = COLS / 8, N = ROWS * COLS / 4096, RSTEP = NTHR / CPR;
#pragma unroll
    for (int i = 0; i < N; ++i) r[i] = *(const v4u*)((src + (size_t)i * RSTEP * ld) + loff);
}
template <int ROWS, int COLS> DI void tile_commit(const v4u* r, LAS unsigned char* dst, int S, int tid) {
    constexpr int CPR = COLS / 8, N = ROWS * COLS / 4096, RSTEP = NTHR / CPR;
    LAS unsigned char* p = dst + (tid / CPR) * S + (tid % CPR) * 16;
#pragma unroll
    for (int i = 0; i < N; ++i) *(LAS v4u*)(p + i * RSTEP * S) = r[i];
}

DI void transpose_item(const float* W, int K, int N, bf16* WT, int mode, LAS float* scr, int item, int lane) {
    const int nblk = (N + 31) / 32, kb = item / nblk, nb = item % nblk, k0 = 64 * kb, n0 = 32 * nb;
    const int n4 = 4 * (lane & 7), nl = n0 + n4;
    f32x4 v[8];
#pragma unroll
    for (int i = 0; i < 8; ++i) v[i] = nl < N ? *(const f32x4*)(W + (size_t)(k0 + 8 * i + (lane >> 3)) * N + nl) : (f32x4){0.f, 0.f, 0.f, 0.f};
#pragma unroll
    for (int i = 0; i < 8; ++i) { LAS float* d = scr + (8 * i + (lane >> 3)) * 33 + n4; d[0] = v[i][0]; d[1] = v[i][1]; d[2] = v[i][2]; d[3] = v[i][3]; }
    LDS_WAIT(); asm volatile("" ::: "memory");
    const int c = lane & 7;
#pragma unroll
    for (int j = 0; j < 4; ++j) { const int n = (lane >> 3) + 8 * j; const LAS float* s = scr + (8 * c) * 33 + n;
        v4u o; o.x = pk2(s[0 * 33], s[1 * 33]); o.y = pk2(s[2 * 33], s[3 * 33]); o.z = pk2(s[4 * 33], s[5 * 33]); o.w = pk2(s[6 * 33], s[7 * 33]);
        const int ng = n0 + n; const int row = mode == 0 ? ng : (256 * (ng >> 7) + (ng & 127) + (mode == 2 ? 128 : 0));
        *(v4u*)(WT + (size_t)row * K + k0 + 8 * c) = o; }
    LDS_WAIT(); asm volatile("" ::: "memory");
}
DI void convert_weight(Frame& F, const float* W, int K, int N, bf16* WT, int mode, int w0 = 0) {
    if (F.wave < w0) return;
    LAS float* scr = (LAS float*)(F.lds + F.wave * 16384);
    const int nw = NWAVES - w0, nitems = (K / 64) * ((N + 31) / 32), NGW = F.G * nw;
    for (int it = F.bid * nw + (F.wave - w0); it < nitems; it += NGW) transpose_item(W, K, N, WT, mode, scr, it, F.lane);
}
DI void zero_fill(Frame& F, void* p, size_t bytes) {
    v4u* q = (v4u*)p; const size_t n = bytes / 16;
    for (size_t i = (size_t)F.bid * NTHR + F.tid; i < n; i += (size_t)F.G * NTHR) q[i] = (v4u){0u, 0u, 0u, 0u};
}

DI void build_rope(Frame& F) {
    float* rope = (float*)(F.ws + WS_ROPE);
    for (int i = F.bid * NTHR + F.tid; i < 4096 * 128; i += F.G * NTHR) { const int pos = i >> 7, d = i & 127;
        double inv = 1.0; { double r = 0.930572040929699; int e = d; while (e) { if (e & 1) inv *= r; r *= r; e >>= 1; } }
        const float ang = (float)pos * (float)inv;
        double s, c; sincos_d((double)ang, s, c);
        *(f32x2v*)(rope + 2 * (size_t)i) = (f32x2v){(float)c, (float)s}; }
}
DI void rms_rows_to_bf16(Frame& F, const float* src, const float* w, bf16* dst) {
    const int NGW = F.G * NWAVES;
    f32x4 wv[4];
#pragma unroll
    for (int j = 0; j < 4; ++j) wv[j] = ((const f32x4*)w)[F.lane + 64 * j];
    for (int m = gwave(F); m < M; m += NGW) { const f32x4* xr = (const f32x4*)(src + (size_t)m * D) + F.lane;
        f32x4 v[4]; float s = 0.f;
#pragma unroll
        for (int j = 0; j < 4; ++j) { v[j] = xr[64 * j]; s += (v[j].x * v[j].x + v[j].y * v[j].y) + (v[j].z * v[j].z + v[j].w * v[j].w); }
        const float rs = rsqrtf(wave_sum(s) * (1.f / D) + EPS);
        v2u* o8 = (v2u*)(dst + (size_t)m * D) + F.lane;
#pragma unroll
        for (int j = 0; j < 4; ++j) { const f32x4 y = v[j] * rs * wv[j]; o8[64 * j] = (v2u){pk2(y.x, y.y), pk2(y.z, y.w)}; } }
}
template <bool IN_F32, bool OUT_F32>
DI void row_phase(Frame& F, const bf16* mbuf, const void* hbase, void* hout, const float* w_post, const float* w_pre, bf16* hn) {
    const int NGW = F.G * NWAVES;
    f32x4 wp[4], wq[4];
#pragma unroll
    for (int j = 0; j < 4; ++j) { wp[j] = ((const f32x4*)w_post)[F.lane + 64 * j]; wq[j] = w_pre ? ((const f32x4*)w_pre)[F.lane + 64 * j] : (f32x4){0.f, 0.f, 0.f, 0.f}; }
    for (int m = gwave(F); m < M; m += NGW) {
        const v2u* mr = (const v2u*)(mbuf + (size_t)m * D) + F.lane;
        f32x4 v[4], h[4]; float s = 0.f;
#pragma unroll
        for (int j = 0; j < 4; ++j) { const v2u mv = mr[64 * j]; v[j] = (f32x4){bflo(mv.x), bfhi(mv.x), bflo(mv.y), bfhi(mv.y)};
            if (IN_F32) h[j] = ((const f32x4*)((const float*)hbase + (size_t)m * D) + F.lane)[64 * j];
            else { const v2u hv = ((const v2u*)((const bf16*)hbase + (size_t)m * 2048) + F.lane)[64 * j]; h[j] = (f32x4){bflo(hv.x), bfhi(hv.x), bflo(hv.y), bfhi(hv.y)}; }
            s += (v[j].x * v[j].x + v[j].y * v[j].y) + (v[j].z * v[j].z + v[j].w * v[j].w); }
#ifdef PERT_ROW
        const float rs = rsqrtf(wave_sum(s) * (1.f / D) + EPS) * PERT_ROW; float s2 = 0.f;
#else
        const float rs = rsqrtf(wave_sum(s) * (1.f / D) + EPS); float s2 = 0.f;
#endif
#ifdef ALG_Q
        float q2 = 0.f, q3 = 0.f, q4 = 0.f;
#pragma unroll
        for (int j = 0; j < 4; ++j) { const f32x4 wm = v[j] * wp[j]; q2 += (h[j].x * h[j].x + h[j].y * h[j].y) + (h[j].z * h[j].z + h[j].w * h[j].w);
            q3 += (h[j].x * wm.x + h[j].y * wm.y) + (h[j].z * wm.z + h[j].w * wm.w); q4 += (wm.x * wm.x + wm.y * wm.y) + (wm.z * wm.z + wm.w * wm.w); h[j] = h[j] + wm * rs; }
        q2 = wave_sum(q2); q3 = wave_sum(q3); q4 = wave_sum(q4);
        s2 = fmaxf(q2 + rs * (2.0f * q3 + rs * q4), 0.f) * (1.0f / 64.0f);
#else
#pragma unroll
        for (int j = 0; j < 4; ++j) { h[j] = h[j] + v[j] * rs * wp[j]; s2 += (h[j].x * h[j].x + h[j].y * h[j].y) + (h[j].z * h[j].z + h[j].w * h[j].w); }
#endif
        if (OUT_F32) { f32x4* ho = (f32x4*)((float*)hout + (size_t)m * D) + F.lane;
#pragma unroll
            for (int j = 0; j < 4; ++j) ho[64 * j] = h[j]; }
        else { v2u* ho = (v2u*)((bf16*)hout + (size_t)m * 2048) + F.lane;
#pragma unroll
            for (int j = 0; j < 4; ++j) ho[64 * j] = (v2u){pk2(h[j].x, h[j].y), pk2(h[j].z, h[j].w)}; }
        if (hn) { const float rs2 = rsqrtf(wave_sum(s2) * (1.f / D) + EPS);
            v2u* o8 = (v2u*)(hn + (size_t)m * D) + F.lane;
#pragma unroll
            for (int j = 0; j < 4; ++j) { const f32x4 y = h[j] * rs2 * wq[j]; o8[64 * j] = (v2u){pk2(y.x, y.y), pk2(y.z, y.w)}; } }
    }
}

DI void hn_from_h(Frame& F, const bf16* hbase, const float* w, bf16* hn) {
    const int NGW = F.G * NWAVES;
    f32x4 wq[4];
#pragma unroll
    for (int j = 0; j < 4; ++j) wq[j] = ((const f32x4*)w)[F.lane + 64 * j];
    for (int m = gwave(F); m < M; m += NGW) {
        f32x4 h[4]; float s2 = 0.f;
#pragma unroll
        for (int j = 0; j < 4; ++j) { const v2u hv = ((const v2u*)(hbase + (size_t)m * 2048) + F.lane)[64 * j]; h[j] = (f32x4){bflo(hv.x), bfhi(hv.x), bflo(hv.y), bfhi(hv.y)};
            s2 += (h[j].x * h[j].x + h[j].y * h[j].y) + (h[j].z * h[j].z + h[j].w * h[j].w); }
        const float rs2 = rsqrtf(wave_sum(s2) * (1.f / D) + EPS);
        v2u* o8 = (v2u*)(hn + (size_t)m * D) + F.lane;
#pragma unroll
        for (int j = 0; j < 4; ++j) { const f32x4 y = h[j] * rs2 * wq[j]; o8[64 * j] = (v2u){pk2(y.x, y.y), pk2(y.z, y.w)}; }
    }
}

DI float head_lg2(int h) { return __log2f(1.0f - exp2f(-5.0f - (float)h)); }

DI void ret_passA_unit(Frame& F, int unit) {
    const bf16* QKV = (const bf16*)(F.ws + WS_QKV); bf16* RST = (bf16*)(F.ws + WS_SLOT16);
    const int eh = unit & 1, sc = (unit >> 1) & 7, h = (unit >> 4) & 3, b = unit >> 6;
    const int lane = F.lane, w = F.wave, we = w >> 2, wd = w & 3;
    const float lg2 = head_lg2(h), g128 = exp2f(128.f * lg2), g127 = exp2f(127.f * lg2);
    LAS unsigned char* Kt = F.lds;
    LAS unsigned char* Vt = F.lds + 128 * 544;
    f32x4 acc[4][4];
#pragma unroll
    for (int a = 0; a < 4; ++a)
#pragma unroll
        for (int c = 0; c < 4; ++c) acc[a][c] = (f32x4){0.f, 0.f, 0.f, 0.f};
    v4u TK[8], TV[4];
    const unsigned lo_k = tile_loff<256>(F.tid, 3072), lo_v = tile_loff<128>(F.tid, 3072);
    const bf16* kbase = QKV + ((size_t)b * SEQ + sc * 512) * 3072 + 1024 + h * 256; const bf16* vbase = kbase + 1024 + eh * 128;
    tile_issue<128, 256>(TK, kbase, 3072, lo_k); tile_issue<128, 128>(TV, vbase, 3072, lo_v);
#pragma unroll 1
    for (int j = 0; j < 4; ++j) {
        if (j) {
#pragma unroll
            for (int a = 0; a < 4; ++a)
#pragma unroll
                for (int c = 0; c < 4; ++c) acc[a][c] *= g128; }
        __syncthreads();
        tile_commit<128, 256>(TK, Kt, 544, F.tid); tile_commit<128, 128>(TV, Vt, 288, F.tid);
        if (j < 3) { tile_issue<128, 256>(TK, kbase + (size_t)(j + 1) * 128 * 3072, 3072, lo_k); tile_issue<128, 128>(TV, vbase + (size_t)(j + 1) * 128 * 3072, 3072, lo_v); }
        __syncthreads();
#pragma unroll
        for (int ks = 0; ks < 4; ++ks) {
            bf16x8 vf[4], kf[4];
#pragma unroll
            for (int t = 0; t < 4; ++t) { vf[t] = frag_tr(Vt, 288, we * 64 + t * 16, ks * 32, lane); kf[t] = frag_tr(Kt, 544, wd * 64 + t * 16, ks * 32, lane); }
#pragma unroll
            for (int et = 0; et < 4; ++et)
#pragma unroll
                for (int dt = 0; dt < 4; ++dt) acc[et][dt] = mma(kf[dt], vf[et], acc[et][dt]);
        }
    }
    bf16* dst = RST + ((size_t)((b * 4 + h) * 8 + sc) * 256) * 256;
#pragma unroll
    for (int et = 0; et < 4; ++et)
#pragma unroll
        for (int dt = 0; dt < 4; ++dt) { const int e = eh * 128 + we * 64 + et * 16 + (lane & 15), d = wd * 64 + dt * 16 + 4 * (lane >> 4);
            const f32x4 v = acc[et][dt] * g127;
            *(v2u*)(dst + (size_t)e * 256 + d) = (v2u){pk2(v[0], v[1]), pk2(v[2], v[3])}; }
}

DI void ret_scan_item(Frame& F, int item) {
    bf16* RST = (bf16*)(F.ws + WS_SLOT16);
    const int bh = item >> 13, off = (item & 8191) * 8, h = bh & 3;
    const float g512 = exp2f(512.f * head_lg2(h));
    float run[8]; float zf = 0.f; asm volatile("" : "+v"(zf));
#pragma unroll
    for (int k = 0; k < 8; ++k) run[k] = zf;
    v4u* base = (v4u*)(RST + (size_t)(bh * 8) * 65536 + off);
    v4u in[8];
#pragma unroll
    for (int sc = 0; sc < 8; ++sc) in[sc] = base[(size_t)sc * 8192];
#pragma unroll
    for (int sc = 0; sc < 8; ++sc) {
        v4u o; o.x = pk2(run[0], run[1]); o.y = pk2(run[2], run[3]); o.z = pk2(run[4], run[5]); o.w = pk2(run[6], run[7]);
        base[(size_t)sc * 8192] = o;
        const unsigned cw[4] = {in[sc].x, in[sc].y, in[sc].z, in[sc].w};
#pragma unroll
        for (int k = 0; k < 4; ++k) { run[2 * k] = g512 * run[2 * k] + bflo(cw[k]); run[2 * k + 1] = g512 * run[2 * k + 1] + bfhi(cw[k]); }
    }
}

DI void ret_passC_unit(Frame& F, int unit, bf16* YO) {
    const bf16* QKV = (const bf16*)(F.ws + WS_QKV); const bf16* RST = (const bf16*)(F.ws + WS_SLOT16); const bf16* GZ = (const bf16*)(F.ws + WS_GZ);
    const int qp = unit & 1, sc = (unit >> 1) & 7, h = (unit >> 4) & 3, b = unit >> 6;
    const int lane = F.lane, w = F.wave, wn = w >> 1, wm = w & 1, wn2 = w >> 2, we = w & 3;
    const float lg2 = head_lg2(h), g1 = exp2f(lg2), g128 = exp2f(128.f * lg2);
    LAS unsigned char* Qt = F.lds;
    LAS unsigned char* KV = F.lds + 67584;
    LAS unsigned char* Pt = F.lds + 67584 + 36864;
    LAS float* red = (LAS float*)(F.lds + 67584 + 36864 + 18432);
    const size_t rowsc = (size_t)b * SEQ + sc * 512;
    const bf16* Rbase = RST + (size_t)((b * 4 + h) * 8 + sc) * 65536;
    const bf16* Kb = QKV + rowsc * 3072 + 1024 + h * 256; const bf16* Vb = Kb + 1024;
    v4u T[4];
    const unsigned lo_kv = tile_loff<256>(F.tid, 3072), lo_r = tile_loff<64>(F.tid, 256);
    tile_issue<256, 64>(T, Rbase, 256, lo_r);
#pragma unroll 1
    for (int qi = 0; qi < 2; ++qi) {
        const int i = qp == 0 ? (qi == 0 ? 0 : 3) : (qi == 0 ? 1 : 2);
        const size_t grow0 = rowsc + i * 128;
        f32x4 Y[4][4];
#pragma unroll
        for (int a = 0; a < 4; ++a)
#pragma unroll
            for (int c = 0; c < 4; ++c) Y[a][c] = (f32x4){0.f, 0.f, 0.f, 0.f};
        __syncthreads();
        load_tile(Qt, 528, QKV + grow0 * 3072 + h * 256, 3072, 128, 256, F.tid);
#pragma unroll 1
        for (int ds = 0; ds < 4; ++ds) {
            if (ds) __syncthreads();
            tile_commit<256, 64>(T, KV, 144, F.tid);
            if (ds < 3) tile_issue<256, 64>(T, Rbase + (ds + 1) * 64, 256, lo_r);
            else tile_issue<64, 256>(T, Kb, 3072, lo_kv);
            __syncthreads();
#pragma unroll
            for (int ks = 0; ks < 2; ++ks) {
                bf16x8 qf[4], rf[4];
#pragma unroll
                for (int t = 0; t < 4; ++t) { qf[t] = frag_rm(Qt, 528, wn2 * 64 + t * 16, ds * 64 + ks * 32, lane); rf[t] = frag_rm(KV, 144, we * 64 + t * 16, ks * 32, lane); }
#pragma unroll
                for (int nt = 0; nt < 4; ++nt)
#pragma unroll
                    for (int et = 0; et < 4; ++et) Y[nt][et] = mma(rf[et], qf[nt], Y[nt][et]);
            }
        }
#pragma unroll
        for (int a = 0; a < 4; ++a)
#pragma unroll
            for (int c = 0; c < 4; ++c) Y[a][c] *= g1;
#pragma unroll 1
        for (int kt = 0; kt < 2 * (i + 1); ++kt) {
            const int j = kt >> 1, kh = kt & 1;
            if (j && !kh) {
#pragma unroll
                for (int a = 0; a < 4; ++a)
#pragma unroll
                    for (int c = 0; c < 4; ++c) Y[a][c] *= g128; }
            const size_t krow = (size_t)kt * 64;
            __syncthreads();
            tile_commit<64, 256>(T, KV, 528, F.tid);
            tile_issue<64, 256>(T, Vb + krow * 3072, 3072, lo_kv);
            __syncthreads();
            f32x4 sa[2][2];
#pragma unroll
            for (int a = 0; a < 2; ++a)
#pragma unroll
                for (int c = 0; c < 2; ++c) sa[a][c] = (f32x4){0.f, 0.f, 0.f, 0.f};
#pragma unroll
            for (int ks = 0; ks < 8; ++ks) {
                bf16x8 qf[2], kf[2];
#pragma unroll
                for (int t = 0; t < 2; ++t) { qf[t] = frag_rm(Qt, 528, wn * 32 + t * 16, ks * 32, lane); kf[t] = frag_rm(KV, 528, wm * 32 + t * 16, ks * 32, lane); }
#pragma unroll
                for (int nt = 0; nt < 2; ++nt)
#pragma unroll
                    for (int mt = 0; mt < 2; ++mt) sa[nt][mt] = mma(kf[mt], qf[nt], sa[nt][mt]);
            }
#pragma unroll
            for (int nt = 0; nt < 2; ++nt)
#pragma unroll
                for (int mt = 0; mt < 2; ++mt) { const int n = wn * 32 + nt * 16 + (lane & 15), m = wm * 32 + mt * 16 + 4 * (lane >> 4);
                    f32x4 sv = sa[nt][mt];
                    if (j == i) { const int mk = kh * 64 + m;
#pragma unroll
                        for (int jj = 0; jj < 4; ++jj) sv[jj] = (mk + jj > n) ? 0.f : sv[jj]; }
                    *(LAS v2u*)(Pt + n * 144 + m * 2) = (v2u){pk2(sv[0], sv[1]), pk2(sv[2], sv[3])}; }
            __syncthreads();
            tile_commit<64, 256>(T, KV, 544, F.tid);
            if (kt + 1 < 2 * (i + 1)) tile_issue<64, 256>(T, Kb + (krow + 64) * 3072, 3072, lo_kv);
            else if (qi == 0) tile_issue<256, 64>(T, Rbase, 256, lo_r);
            __syncthreads();
#pragma unroll
            for (int ks = 0; ks < 2; ++ks) {
                bf16x8 pf[4], vf[4];
#pragma unroll
                for (int t = 0; t < 4; ++t) { pf[t] = frag_rm(Pt, 144, wn2 * 64 + t * 16, ks * 32, lane); vf[t] = frag_tr(KV, 544, we * 64 + t * 16, ks * 32, lane); }
#pragma unroll
                for (int nt = 0; nt < 4; ++nt)
#pragma unroll
                    for (int et = 0; et < 4; ++et) Y[nt][et] = mma(vf[et], pf[nt], Y[nt][et]);
            }
        }
        float mean[4], rstd[4];
#pragma unroll
        for (int nt = 0; nt < 4; ++nt) { float sm = 0.f;
#pragma unroll
            for (int et = 0; et < 4; ++et) sm += (Y[nt][et][0] + Y[nt][et][1]) + (Y[nt][et][2] + Y[nt][et][3]);
            sm += __shfl_xor(sm, 16); sm += __shfl_xor(sm, 32);
            if ((lane >> 4) == 0) red[(wn2 * 64 + nt * 16 + lane) * 4 + we] = sm; }
        __syncthreads();
#pragma unroll
        for (int nt = 0; nt < 4; ++nt) { const LAS float* r = red + (wn2 * 64 + nt * 16 + (lane & 15)) * 4; mean[nt] = ((r[0] + r[1]) + (r[2] + r[3])) * (1.f / 256.f); }
        __syncthreads();
#pragma unroll
        for (int nt = 0; nt < 4; ++nt) { float sm = 0.f;
#pragma unroll
            for (int et = 0; et < 4; ++et) { const f32x4 dv = Y[nt][et] - mean[nt]; sm += (dv[0] * dv[0] + dv[1] * dv[1]) + (dv[2] * dv[2] + dv[3] * dv[3]); }
            sm += __shfl_xor(sm, 16); sm += __shfl_xor(sm, 32);
            if ((lane >> 4) == 0) red[(wn2 * 64 + nt * 16 + lane) * 4 + we] = sm; }
        __syncthreads();
#pragma unroll
        for (int nt = 0; nt < 4; ++nt) { const LAS float* r = red + (wn2 * 64 + nt * 16 + (lane & 15)) * 4; rstd[nt] = rsqrtf(((r[0] + r[1]) + (r[2] + r[3])) * (1.f / 256.f) + EPS); }
#pragma unroll
        for (int nt = 0; nt < 4; ++nt)
#pragma unroll
            for (int et = 0; et < 4; ++et) { const int n = wn2 * 64 + nt * 16 + (lane & 15), e = we * 64 + et * 16 + 4 * (lane >> 4);
                const bf16* gp = GZ + (grow0 + n) * 2048 + h * 256 + e;
                const v2u gv = *(const v2u*)gp;
                const f32x4 y = (Y[nt][et] - mean[nt]) * rstd[nt];
                const float o0 = y[0] * silu_f(bflo(gv.x)), o1 = y[1] * silu_f(bfhi(gv.x)), o2 = y[2] * silu_f(bflo(gv.y)), o3 = y[3] * silu_f(bfhi(gv.y));
                *(v2u*)(YO + (gp - GZ)) = (v2u){pk2(o0, o1), pk2(o2, o3)}; }
    }
}

struct SsdPar { const float* conv_w; const float* conv_b; const float* a_log; const float* d_ssd; const float* ssd_norm; };

struct ConvW { f32x4 w[4][2]; f32x4 b[2]; };
DI ConvW load_convw(const float* cw, const float* cb, int col) { ConvW W;
#pragma unroll
    for (int k = 0; k < 4; ++k) { W.w[k][0] = *(const f32x4*)(cw + k * 1536 + col); W.w[k][1] = *(const f32x4*)(cw + k * 1536 + col + 4); }
    W.b[0] = *(const f32x4*)(cb + col); W.b[1] = *(const f32x4*)(cb + col + 4); return W; }
DI void conv8(const bf16* XBC, const ConvW& W, size_t row, int col, float (&o)[8]) {
    const int tin = (int)(row & 4095);
    o[0] = W.b[0][0]; o[1] = W.b[0][1]; o[2] = W.b[0][2]; o[3] = W.b[0][3]; o[4] = W.b[1][0]; o[5] = W.b[1][1]; o[6] = W.b[1][2]; o[7] = W.b[1][3];
#pragma unroll
    for (int k = 0; k < 4; ++k) {
        if (tin - 3 + k >= 0) {
            const v4u x = *(const v4u*)(XBC + (row - 3 + k) * 1536 + col);
            const f32x4 w0 = W.w[k][0], w1 = W.w[k][1];
            o[0] += w0[0] * bflo(x.x); o[1] += w0[1] * bfhi(x.x); o[2] += w0[2] * bflo(x.y); o[3] += w0[3] * bfhi(x.y);
            o[4] += w1[0] * bflo(x.z); o[5] += w1[1] * bfhi(x.z); o[6] += w1[2] * bflo(x.w); o[7] += w1[3] * bfhi(x.w);
        }
    }
#pragma unroll
    for (int k = 0; k < 8; ++k) o[k] = silu_f(o[k]);
}
DI void conv8r(const v4u (&x)[4], const ConvW& W, int tin, float (&o)[8]) {
    o[0] = W.b[0][0]; o[1] = W.b[0][1]; o[2] = W.b[0][2]; o[3] = W.b[0][3]; o[4] = W.b[1][0]; o[5] = W.b[1][1]; o[6] = W.b[1][2]; o[7] = W.b[1][3];
#pragma unroll
    for (int k = 0; k < 4; ++k) {
        if (tin - 3 + k >= 0) { const f32x4 w0 = W.w[k][0], w1 = W.w[k][1];
            o[0] += w0[0] * bflo(x[k].x); o[1] += w0[1] * bfhi(x[k].x); o[2] += w0[2] * bflo(x[k].y); o[3] += w0[3] * bfhi(x[k].y);
            o[4] += w1[0] * bflo(x[k].z); o[5] += w1[1] * bfhi(x[k].z); o[6] += w1[2] * bflo(x[k].w); o[7] += w1[3] * bfhi(x[k].w); }
    }
#pragma unroll
    for (int k = 0; k < 8; ++k) o[k] = silu_f(o[k]);
}
template <int NR, class Fn> DI void conv_rows(const bf16* XBC, const ConvW& W, size_t row0, int col, Fn&& emit) {
    const int tin0 = (int)(row0 & 4095);
    v4u x[NR + 3];
#pragma unroll
    for (int i = 0; i < NR + 3; ++i) x[i] = (tin0 + i - 3 >= 0) ? *(const v4u*)(XBC + (row0 + i - 3) * 1536 + col) : (v4u){0u, 0u, 0u, 0u};
#pragma unroll
    for (int r = 0; r < NR; ++r) { float o[8];
        o[0] = W.b[0][0]; o[1] = W.b[0][1]; o[2] = W.b[0][2]; o[3] = W.b[0][3]; o[4] = W.b[1][0]; o[5] = W.b[1][1]; o[6] = W.b[1][2]; o[7] = W.b[1][3];
#pragma unroll
        for (int k = 0; k < 4; ++k) { const v4u xv = x[r + k]; const f32x4 w0 = W.w[k][0], w1 = W.w[k][1];
            o[0] += w0[0] * bflo(xv.x); o[1] += w0[1] * bfhi(xv.x); o[2] += w0[2] * bflo(xv.y); o[3] += w0[3] * bfhi(xv.y);
            o[4] += w1[0] * bflo(xv.z); o[5] += w1[1] * bfhi(xv.z); o[6] += w1[2] * bflo(xv.w); o[7] += w1[3] * bfhi(xv.w); }
#pragma unroll
        for (int k = 0; k < 8; ++k) o[k] = silu_f(o[k]);
        emit(r, o); }
}
DI v4u pack8(const float (&o)[8], float s) { v4u r; r.x = pk2(o[0] * s, o[1] * s); r.y = pk2(o[2] * s, o[3] * s); r.z = pk2(o[4] * s, o[5] * s); r.w = pk2(o[6] * s, o[7] * s); return r; }

DI float ssd_cumsum(const float* DT, const float* a_log, size_t t0, int grp, int w, int lane, LAS float* cs, LAS float* dtl = nullptr) {
    const int head = grp * 8 + w; const float A = -__expf(a_log[head]);
    const float d0 = DT[(t0 + 2 * lane) * 16 + head], d1 = DT[(t0 + 2 * lane + 1) * 16 + head], v0 = d0 * A, v1 = d1 * A;
    if (dtl) { dtl[w * 128 + 2 * lane] = d0; dtl[w * 128 + 2 * lane + 1] = d1; }
    float x = v0 + v1;
#pragma unroll
    for (int o = 1; o < 64; o <<= 1) { const float t = __shfl_up(x, o); if (lane >= o) x += t; }
    cs[w * 128 + 2 * lane] = x - v1; cs[w * 128 + 2 * lane + 1] = x;
    return __shfl(x, 63);
}

DI void ssd_passA_unit(Frame& F, const SsdPar& P, int unit) {
    const bf16* XBC = (const bf16*)(F.ws + WS_XBC); const float* DT = (const float*)(F.ws + WS_DT);
    bf16* ST = (bf16*)(F.ws + WS_SLOT32); float* CDEC = (float*)(F.ws + WS_MISC);
    const int grp = unit & 1, c = (unit >> 1) & 31, b = unit >> 6;
    const int lane = F.lane, w = F.wave;
    const size_t t0 = (size_t)b * SEQ + c * 128;
    LAS float* cs = (LAS float*)F.lds;
    LAS float* csend = (LAS float*)(F.lds + 4096);
    LAS unsigned char* Bt = F.lds + 4352;
    LAS unsigned char* Xw = F.lds + 4352 + 36864;
    __syncthreads();
    { const float tot = ssd_cumsum(DT, P.a_log, t0, grp, w, lane, cs);
      if (lane == 0) { csend[w] = tot; CDEC[(b * 32 + c) * 16 + grp * 8 + w] = __expf(tot); } }
    { const int cc = F.tid & 15, rb = F.tid >> 4; const ConvW W = load_convw(P.conv_w, P.conv_b, 1024 + grp * 128 + cc * 8);
      conv_rows<4>(XBC, W, t0 + 4 * rb, 1024 + grp * 128 + cc * 8, [&](int r, const float (&o)[8]) { *(LAS v4u*)(Bt + (4 * rb + r) * 288 + cc * 16) = pack8(o, 1.0f); }); }
    for (int hg = 0; hg < 2; ++hg) {
        __syncthreads();
        { const int cc = F.tid & 31, rb = F.tid >> 5, hd = hg * 4 + (cc >> 3); const ConvW W = load_convw(P.conv_w, P.conv_b, grp * 512 + hg * 256 + cc * 8);
          conv_rows<8>(XBC, W, t0 + 8 * rb, grp * 512 + hg * 256 + cc * 8, [&](int r, const float (&o)[8]) { const int rr = 8 * rb + r;
              const float sc = DT[(t0 + rr) * 16 + grp * 8 + hd] * __expf(csend[hd] - cs[hd * 128 + rr]);
              *(LAS v4u*)(Xw + rr * 544 + cc * 16) = pack8(o, sc); }); }
        __syncthreads();
        const int hl = w >> 1, nh = w & 1;
        f32x4 acc[4][4];
#pragma unroll
        for (int a = 0; a < 4; ++a)
#pragma unroll
            for (int q = 0; q < 4; ++q) acc[a][q] = (f32x4){0.f, 0.f, 0.f, 0.f};
#pragma unroll
        for (int ks = 0; ks < 4; ++ks) {
            bf16x8 xf[4], bfr[4];
#pragma unroll
            for (int t = 0; t < 4; ++t) { xf[t] = frag_tr(Xw, 544, hl * 64 + t * 16, ks * 32, lane); bfr[t] = frag_tr(Bt, 288, nh * 64 + t * 16, ks * 32, lane); }
#pragma unroll
            for (int pt = 0; pt < 4; ++pt)
#pragma unroll
                for (int nt = 0; nt < 4; ++nt) acc[pt][nt] = mma(bfr[nt], xf[pt], acc[pt][nt]);
        }
        const int head = grp * 8 + hg * 4 + hl;
        bf16* dst = ST + (size_t)((b * 32 + c) * 16 + head) * 8192;
#pragma unroll
        for (int pt = 0; pt < 4; ++pt)
#pragma unroll
            for (int nt = 0; nt < 4; ++nt) { const int p = pt * 16 + (lane & 15), n = nh * 64 + nt * 16 + 4 * (lane >> 4); const f32x4 v = acc[pt][nt];
                *(v2u*)(dst + p * 128 + n) = (v2u){pk2(v[0], v[1]), pk2(v[2], v[3])}; }
    }
}

DI void ssd_scan_item(Frame& F, int item) {
    bf16* ST = (bf16*)(F.ws + WS_SLOT32); const float* CDEC = (const float*)(F.ws + WS_MISC);
    const int bh = item >> 11, b = bh >> 4, head = bh & 15, off = (item & 2047) * 4;
    float run[4]; float zf = 0.f; asm volatile("" : "+v"(zf));
#pragma unroll
    for (int k = 0; k < 4; ++k) run[k] = zf;
    v2u* base = (v2u*)(ST + (size_t)((b * 32) * 16 + head) * 8192 + off);
    const float* dbase = CDEC + (b * 32) * 16 + head;
    v2u cur[8], nxt[8]; float dc[8], dn[8];
#pragma unroll
    for (int q = 0; q < 8; ++q) { cur[q] = base[(size_t)q * 32768]; dc[q] = dbase[q * 16]; }
#pragma unroll 1
    for (int cb = 0; cb < 4; ++cb) {
        const int cn = cb < 3 ? cb + 1 : cb;
#pragma unroll
        for (int q = 0; q < 8; ++q) { nxt[q] = base[(size_t)(cn * 8 + q) * 32768]; dn[q] = dbase[(cn * 8 + q) * 16]; }
#pragma unroll
        for (int q = 0; q < 8; ++q) {
            base[(size_t)(cb * 8 + q) * 32768] = (v2u){pk2(run[0], run[1]), pk2(run[2], run[3])};
            run[0] = dc[q] * run[0] + bflo(cur[q].x); run[1] = dc[q] * run[1] + bfhi(cur[q].x); run[2] = dc[q] * run[2] + bflo(cur[q].y); run[3] = dc[q] * run[3] + bfhi(cur[q].y); }
#pragma unroll
        for (int q = 0; q < 8; ++q) { cur[q] = nxt[q]; dc[q] = dn[q]; }
    }
}

template <int DBG = 0> DI void ssd_passC_unit(Frame& F, const SsdPar& P, int unit, bf16* YO) {
    const bf16* XBC = (const bf16*)(F.ws + WS_XBC); const float* DT = (const float*)(F.ws + WS_DT);
    const bf16* ST = (const bf16*)(F.ws + WS_SLOT32); const bf16* GZ = (const bf16*)(F.ws + WS_GZ);
    const int grp = unit & 1, c = (unit >> 1) & 31, b = unit >> 6;
    const int lane = F.lane, w = F.wave;
    const size_t t0 = (size_t)b * SEQ + c * 128;
    LAS float* cs = (LAS float*)F.lds;
    LAS float* dtl = (LAS float*)(F.lds + 4096);
    LAS unsigned char* Ct = F.lds + 8192;
    LAS unsigned char* BM = F.lds + 43008;
    LAS unsigned char* Xd = F.lds + 77824;
    LAS unsigned char* Pv = F.lds + 98304;
    LAS float* rowss = (LAS float*)(F.lds + 115712);
    LAS float* wtab = (LAS float*)(F.lds + 123904);
    __syncthreads();
    (void)ssd_cumsum(DT, P.a_log, t0, grp, w, lane, cs, dtl);
    for (int i = F.tid; i < 5 * 128; i += NTHR) { const int k = i >> 7, c4 = (i & 127) * 4;
        *(LAS f32x4*)(wtab + k * 512 + c4) = *(const f32x4*)((k < 4 ? P.conv_w + k * 1536 : P.conv_b) + grp * 512 + c4); }
#pragma unroll 1
    for (int which = 0; which < 2; ++which) {
        const int cc = F.tid & 15, rb = F.tid >> 4; const ConvW W = load_convw(P.conv_w, P.conv_b, 1024 + which * 256 + grp * 128 + cc * 8);
        LAS unsigned char* dstt = which ? Ct : BM;
        conv_rows<4>(XBC, W, t0 + 4 * rb, 1024 + which * 256 + grp * 128 + cc * 8, [&](int r, const float (&o)[8]) { *(LAS v4u*)(dstt + (4 * rb + r) * 272 + cc * 16) = pack8(o, 1.0f); }); }
    const int r0 = F.tid >> 3, cc8 = (F.tid & 7) * 8, tin0 = (int)((t0 + r0) & 4095);
    const int wl = w >> 1, ws = w & 1, wp = w & 1;
    v4u XR[2][4], PVr[2]; v2u ZN[2][2], ZC[2][2];
    const unsigned lo_p = tile_loff<128>(F.tid, 128);
#define SSD_ISSUE(hd_) do { const int hcol_ = grp * 512 + (hd_) * 64 + cc8; \
        _Pragma("unroll") for (int it_ = 0; it_ < 2; ++it_) _Pragma("unroll") for (int k_ = 0; k_ < 4; ++k_) \
            if (tin0 + 64 * it_ - 3 + k_ >= 0) XR[it_][k_] = *(const v4u*)(XBC + (t0 + r0 + 64 * it_ - 3 + k_) * 1536 + hcol_); \
        tile_issue<64, 128>(PVr, ST + (size_t)((b * 32 + c) * 16 + grp * 8 + (hd_)) * 8192, 128, lo_p); \
        _Pragma("unroll") for (int lt_ = 0; lt_ < 2; ++lt_) _Pragma("unroll") for (int pt_ = 0; pt_ < 2; ++pt_) \
            ZN[lt_][pt_] = *(const v2u*)(GZ + (t0 + wl * 32 + lt_ * 16 + (lane & 15)) * 2048 + 1024 + (grp * 8 + (hd_)) * 64 + wp * 32 + pt_ * 16 + 4 * (lane >> 4)); } while (0)
    SSD_ISSUE(0);
    __syncthreads();
    f32x4 cb[2][4];
#pragma unroll
    for (int a = 0; a < 2; ++a)
#pragma unroll
        for (int q = 0; q < 4; ++q) cb[a][q] = (f32x4){0.f, 0.f, 0.f, 0.f};
#pragma unroll
    for (int ks = 0; ks < 4; ++ks) {
        bf16x8 cf[2], bfr[4];
#pragma unroll
        for (int t = 0; t < 2; ++t) cf[t] = frag_rm(Ct, 272, wl * 32 + t * 16, ks * 32, lane);
#pragma unroll
        for (int t = 0; t < 4; ++t) bfr[t] = frag_rm(BM, 272, ws * 64 + t * 16, ks * 32, lane);
#pragma unroll
        for (int lt = 0; lt < 2; ++lt)
#pragma unroll
            for (int st = 0; st < 4; ++st) cb[lt][st] = mma(bfr[st], cf[lt], cb[lt][st]);
    }
#pragma unroll 1
    for (int hd = 0; hd < 8; ++hd) {
        const int head = grp * 8 + hd;
        ConvW W;
#pragma unroll
        for (int k = 0; k < 4; ++k) { W.w[k][0] = *(const LAS f32x4*)(wtab + k * 512 + hd * 64 + cc8); W.w[k][1] = *(const LAS f32x4*)(wtab + k * 512 + hd * 64 + cc8 + 4); }
        W.b[0] = *(const LAS f32x4*)(wtab + 4 * 512 + hd * 64 + cc8); W.b[1] = *(const LAS f32x4*)(wtab + 4 * 512 + hd * 64 + cc8 + 4);
        const float dsk = P.d_ssd[head];
        __syncthreads();
        if (!(DBG & 1))
#pragma unroll
        for (int lt = 0; lt < 2; ++lt) { const int l = wl * 32 + lt * 16 + (lane & 15); const float csl = cs[hd * 128 + l], dgl = dsk * __builtin_amdgcn_rcpf(dtl[hd * 128 + l]);
#pragma unroll
            for (int st = 0; st < 4; ++st) { const int s = ws * 64 + st * 16 + 4 * (lane >> 4); f32x4 m;
                const f32x4 cs4 = *(const LAS f32x4*)(cs + hd * 128 + s);
#pragma unroll
                for (int jj = 0; jj < 4; ++jj) { const float e = __expf(fminf(csl - cs4[jj], 0.f)); m[jj] = (s + jj <= l) ? cb[lt][st][jj] * e : 0.f; m[jj] += (s + jj == l) ? dgl : 0.f; }
                *(LAS v2u*)(BM + l * 272 + s * 2) = (v2u){pk2(m[0], m[1]), pk2(m[2], m[3])}; } }
        if (!(DBG & 2))
#pragma unroll
        for (int it = 0; it < 2; ++it) { float o[8]; conv8r(XR[it], W, tin0 + 64 * it, o);
            *(LAS v4u*)(Xd + (r0 + 64 * it) * 160 + cc8 * 2) = pack8(o, dtl[hd * 128 + r0 + 64 * it]); }
        tile_commit<64, 128>(PVr, Pv, 272, F.tid);
#pragma unroll
        for (int lt = 0; lt < 2; ++lt)
#pragma unroll
            for (int pt = 0; pt < 2; ++pt) ZC[lt][pt] = ZN[lt][pt];
        if (hd < 7) SSD_ISSUE(hd + 1);
        __syncthreads();
        f32x4 yd[2][2], yo[2][2];
#pragma unroll
        for (int a2 = 0; a2 < 2; ++a2)
#pragma unroll
            for (int q = 0; q < 2; ++q) { yd[a2][q] = (f32x4){0.f, 0.f, 0.f, 0.f}; yo[a2][q] = (f32x4){0.f, 0.f, 0.f, 0.f}; }
        if (!(DBG & 4))
#pragma unroll
        for (int ks = 0; ks < 4; ++ks) {
            bf16x8 mf[2], xf[2], cf[2], pf[2];
#pragma unroll
            for (int t = 0; t < 2; ++t) { if (!(DBG & 8)) { mf[t] = frag_rm(BM, 272, wl * 32 + t * 16, ks * 32, lane); xf[t] = frag_tr(Xd, 160, wp * 32 + t * 16, ks * 32, lane); }
                                          if (!(DBG & 16)) { cf[t] = frag_rm(Ct, 272, wl * 32 + t * 16, ks * 32, lane); pf[t] = frag_rm(Pv, 272, wp * 32 + t * 16, ks * 32, lane); } }
#pragma unroll
            for (int lt = 0; lt < 2; ++lt)
#pragma unroll
                for (int pt = 0; pt < 2; ++pt) { if (!(DBG & 8)) yd[lt][pt] = mma(xf[pt], mf[lt], yd[lt][pt]); if (!(DBG & 16)) yo[lt][pt] = mma(pf[pt], cf[lt], yo[lt][pt]); }
        }
#pragma unroll
        for (int lt = 0; lt < 2; ++lt) { const int l = wl * 32 + lt * 16 + (lane & 15); const float ecs = __expf(cs[hd * 128 + l]); float ss = 0.f;
#pragma unroll
            for (int pt = 0; pt < 2; ++pt) { const int p = wp * 32 + pt * 16 + 4 * (lane >> 4);
                const v2u zv = ZC[lt][pt];
                f32x4 y = yd[lt][pt] + ecs * yo[lt][pt];
                y[0] *= silu_f(bflo(zv.x)); y[1] *= silu_f(bfhi(zv.x)); y[2] *= silu_f(bflo(zv.y)); y[3] *= silu_f(bfhi(zv.y));
                ss += (y[0] * y[0] + y[1] * y[1]) + (y[2] * y[2] + y[3] * y[3]);
                if (YO) *(v2u*)(YO + (t0 + l) * 2048 + 1024 + head * 64 + p) = (v2u){pk2(y[0], y[1]), pk2(y[2], y[3])}; }
            ss += __shfl_xor(ss, 16); ss += __shfl_xor(ss, 32);
            if ((lane >> 4) == 0) rowss[(hd * 2 + wp) * 128 + l] = ss; }
    }
#undef SSD_ISSUE
    if (!YO) return;
    asm volatile("s_waitcnt vmcnt(0)" ::: "memory");
    __syncthreads();
    LAS float* rst = (LAS float*)F.lds;
    if (F.tid < 128) { float t = 0.f;
#pragma unroll
        for (int q = 0; q < 16; ++q) t += rowss[q * 128 + F.tid];
        rst[F.tid] = rsqrtf(t * (1.f / 512.f) + EPS); }
    __syncthreads();
    { const int cc = F.tid & 63; const f32x4 n0 = *(const f32x4*)(P.ssd_norm + grp * 512 + cc * 8), n1 = *(const f32x4*)(P.ssd_norm + grp * 512 + cc * 8 + 4);
#pragma unroll 4
      for (int it = 0; it < 16; ++it) { const int r = (F.tid >> 6) + it * 8; const float rs = rst[r];
          v4u* gp = (v4u*)(YO + (t0 + r) * 2048 + 1024 + grp * 512 + cc * 8); const v4u v = *gp;
          v4u o; o.x = pk2(bflo(v.x) * rs * n0[0], bfhi(v.x) * rs * n0[1]); o.y = pk2(bflo(v.y) * rs * n0[2], bfhi(v.y) * rs * n0[3]);
          o.z = pk2(bflo(v.z) * rs * n1[0], bfhi(v.z) * rs * n1[1]); o.w = pk2(bflo(v.w) * rs * n1[2], bfhi(v.w) * rs * n1[3]);
          *gp = o; } }
}

struct S5Par { const float* lam_re; const float* lam_im; const float* log_step; const float* b_re; const float* b_im; const float* c_re; const float* c_im; const float* d_s5; };

DI void s5_build_unit(Frame& F, const S5Par& P, int unit) {
    const int g = unit >> 2, cq = unit & 3;
    bf16* AB = (bf16*)(F.ws + WS_S5MAT + (size_t)g * 262144); bf16* E = AB + 256 * 384;
    LAS f32x2v* pw = (LAS f32x2v*)F.lds;
    LAS f32x2v* Bb = (LAS f32x2v*)(F.lds + 8704);
    LAS f32x2v* Cc = (LAS f32x2v*)(F.lds + 16896);
    LAS float* Km = (LAS float*)(F.lds + 25088);
    LAS f32x2v* cf = (LAS f32x2v*)(F.lds + 29184);
    __syncthreads();
    for (int i = F.tid; i < 17 * 64; i += NTHR) { const int t = i >> 6, p = i & 63;
        const double lr = fmin((double)P.lam_re[g * 64 + p], -1e-4), li = (double)P.lam_im[g * 64 + p], dl = (double)expf(P.log_step[g]);
        const double mag = (double)expf((float)(t * lr * dl)); double sn, cs_; sincos_d(t * li * dl, sn, cs_);
        pw[i] = (f32x2v){(float)(mag * cs_), (float)(mag * sn)};
        if (t == 1) { const double den = lr * lr + li * li, nr = mag * cs_ - 1.0, ni = mag * sn; cf[p] = (f32x2v){(float)((nr * lr + ni * li) / den), (float)((ni * lr - nr * li) / den)}; } }
    __syncthreads();
    for (int i = F.tid; i < 1024; i += NTHR) { const int p = i >> 4; const f32x2v c = cf[p]; const float br = P.b_re[g * 1024 + i], bi = P.b_im[g * 1024 + i];
        Bb[i] = (f32x2v){c.x * br - c.y * bi, c.x * bi + c.y * br}; }
    for (int i = F.tid; i < 1024; i += NTHR) Cc[i] = (f32x2v){P.c_re[g * 1024 + i], P.c_im[g * 1024 + i]};
    __syncthreads();
    for (int i = F.tid; i < 1024; i += NTHR) { const int t = i >> 6, cl = (i >> 4) & 3, c2 = i & 15, c = cq * 4 + cl; float acc = 0.f;
        for (int p = 0; p < 64; ++p) { const f32x2v cc = Cc[c * 64 + p], a = pw[t * 64 + p], bb = Bb[p * 16 + c2];
            const float tr = cc.x * a.x - cc.y * a.y, ti = cc.x * a.y + cc.y * a.x; acc += tr * bb.x - ti * bb.y; }
        Km[i] = acc; }
    __syncthreads();
    for (int i = F.tid; i < 64 * 48; i += NTHR) { const int rl = i / 48, c8 = (i % 48) * 8, l = rl >> 2, cl = rl & 3, c = cq * 4 + cl, row = l * 16 + c; float v[8];
        if (c8 < 256) { const int s = c8 >> 4, c2 = c8 & 15;
#pragma unroll
            for (int k = 0; k < 8; ++k) v[k] = s <= l ? Km[((l - s) * 4 + cl) * 16 + c2 + k] : 0.f;
        } else { const bool im = c8 >= 320; const int p0 = c8 - (im ? 320 : 256);
#pragma unroll
            for (int k = 0; k < 8; ++k) { const f32x2v cc = Cc[c * 64 + p0 + k], a = pw[(l + 1) * 64 + p0 + k];
                v[k] = im ? -(cc.x * a.y + cc.y * a.x) : (cc.x * a.x - cc.y * a.y); } }
        *(v4u*)(AB + (size_t)row * 384 + c8) = (v4u){pk2(v[0], v[1]), pk2(v[2], v[3]), pk2(v[4], v[5]), pk2(v[6], v[7])}; }
    for (int i = F.tid; i < 32 * 32; i += NTHR) { const int rl = i >> 5, c8 = (i & 31) * 8, p = cq * 16 + (rl & 15), s = c8 >> 4, c2 = c8 & 15; const bool im = rl >= 16; const int row = (im ? 64 : 0) + p; float v[8];
        const f32x2v a = pw[(15 - s) * 64 + p];
#pragma unroll
        for (int k = 0; k < 8; ++k) { const f32x2v bb = Bb[p * 16 + c2 + k]; v[k] = im ? (a.x * bb.y + a.y * bb.x) : (a.x * bb.x - a.y * bb.y); }
        *(v4u*)(E + (size_t)row * 256 + c8) = (v4u){pk2(v[0], v[1]), pk2(v[2], v[3]), pk2(v[4], v[5]), pk2(v[6], v[7])}; }
}

DI void s5_gemmA_unit(Frame& F, int unit) {
    const bf16* HN = (const bf16*)(F.ws + WS_SLOT32); float* EO = (float*)(F.ws + WS_S5E);
    const int gp = unit >> 3, te = unit & 7, b = te >> 1, lane = F.lane, w = F.wave, g = 2 * gp + (w & 1), i = lane & 15, gq = lane >> 4;
    LAS unsigned char* Et = F.lds + (w & 1) * 67584;
    __syncthreads();
    load_tile(F.lds, 528, (const bf16*)(F.ws + WS_S5MAT + (size_t)(2 * gp) * 262144) + 256 * 384, 256, 128, 256, F.tid);
    load_tile(F.lds + 67584, 528, (const bf16*)(F.ws + WS_S5MAT + (size_t)(2 * gp + 1) * 262144) + 256 * 384, 256, 128, 256, F.tid);
    __syncthreads();
#pragma unroll 1
    for (int t = 0; t < 2; ++t) { const int k0 = (te & 1) * 128 + ((w >> 1) * 2 + t) * 16;
        const bf16* hp = HN + ((size_t)b * SEQ + 16 * (k0 + i) + (gq >> 1)) * D + 16 * g + 8 * (gq & 1);
        bf16x8 uf[8];
#pragma unroll
        for (int ks = 0; ks < 8; ++ks) uf[ks] = *(const bf16x8*)(hp + (size_t)(2 * ks) * D);
        f32x4 acc[8];
#pragma unroll
        for (int mt = 0; mt < 8; ++mt) acc[mt] = (f32x4){0.f, 0.f, 0.f, 0.f};
#pragma unroll
        for (int ks = 0; ks < 8; ++ks) {
#pragma unroll
            for (int mt = 0; mt < 8; ++mt) acc[mt] = mma(frag_rm(Et, 528, mt * 16, ks * 32, lane), uf[ks], acc[mt]);
            if (ks & 1) __builtin_amdgcn_sched_barrier(0); }
        float* dst = EO + ((size_t)((b * 256 + k0 + i) * 64 + g)) * 128 + 4 * gq;
#pragma unroll
        for (int mt = 0; mt < 8; ++mt) *(f32x4*)(dst + mt * 16) = acc[mt]; }
}

DI void s5_scan_task(Frame& F, const float* lam_re, const float* lam_im, const float* log_step, int task, int dbg) {
    const float* EO = (const float*)(F.ws + WS_S5E); bf16* XO = (bf16*)(F.ws + WS_S5X);
    const int b = task >> 6, g = task & 63, p = F.lane;
    f32x2v a;
    { const double lr = fmin((double)lam_re[g * 64 + p], -1e-4), li = (double)lam_im[g * 64 + p], dl = (double)expf(log_step[g]);
      const double mag = (double)expf((float)(16.0 * lr * dl)); double s, c; sincos_d(16.0 * li * dl, s, c); a = (f32x2v){(float)(mag * c), (float)(mag * s)}; }
    if (dbg == 6) a = (f32x2v){0.f, 0.f};
    float rr = 0.f, ri = 0.f;
    const float* ep = EO + ((size_t)(b * 256) * 64 + g) * 128 + p; bf16* xp = XO + ((size_t)(b * 256) * 64 + g) * 128 + p;
    float er[16], ei[16], fr_[16], fi_[16];
#pragma unroll
    for (int s2 = 0; s2 < 16; ++s2) { er[s2] = ep[(size_t)s2 * 8192]; ei[s2] = ep[(size_t)s2 * 8192 + 64]; }
#pragma unroll 1
    for (int kb = 0; kb < 16; ++kb) {
        const int kn = kb < 15 ? kb + 1 : kb;
#pragma unroll
        for (int s2 = 0; s2 < 16; ++s2) { fr_[s2] = ep[(size_t)(kn * 16 + s2) * 8192]; fi_[s2] = ep[(size_t)(kn * 16 + s2) * 8192 + 64]; }
#pragma unroll
        for (int s2 = 0; s2 < 16; ++s2) { bf16* xo = xp + (size_t)(kb * 16 + s2) * 8192;
            xo[0] = (bf16)f2bf(rr); xo[64] = (bf16)f2bf(ri);
            const float nr = a.x * rr - a.y * ri + er[s2], ni = a.x * ri + a.y * rr + ei[s2]; rr = nr; ri = ni; }
#pragma unroll
        for (int s2 = 0; s2 < 16; ++s2) { er[s2] = fr_[s2]; ei[s2] = fi_[s2]; }
    }
}

DI float gelu_tanh(float v) { const float u = 0.7978845608028654f * (v + 0.044715f * v * v * v); const float t = 1.0f - 2.0f * __builtin_amdgcn_rcpf(__expf(2.0f * u) + 1.0f); return 0.5f * v * (1.0f + t); }

DI void s5_gemmB_unit(Frame& F, const float* d_s5, int unit) {
    const bf16* HN = (const bf16*)(F.ws + WS_SLOT32); const bf16* XO = (const bf16*)(F.ws + WS_S5X); bf16* Y = (bf16*)(F.ws + WS_Y);
    const int g = unit >> 2, lh = (unit >> 1) & 1, th = unit & 1, lane = F.lane, w = F.wave, i = lane & 15, gq = lane >> 4;
    const bf16* AB = (const bf16*)(F.ws + WS_S5MAT + (size_t)g * 262144) + (size_t)(128 * lh) * 384;
    LAS unsigned char* A = F.lds;
    __syncthreads();
    load_tile(A, 784, AB, 384, 128, 384, F.tid);
    __syncthreads();
    const int colg = 16 * g + 4 * gq;
    const f32x4 dv = *(const f32x4*)(d_s5 + colg);
#pragma unroll 1
    for (int t = 0; t < 4; ++t) { const int nt = w * 4 + t, b = 2 * th + (nt >> 4), k0 = (nt & 15) * 16;
        const bf16* hp = HN + ((size_t)b * SEQ + 16 * (k0 + i) + (gq >> 1)) * D + 16 * g + 8 * (gq & 1);
        const bf16* xp = XO + ((size_t)((b * 256 + k0 + i) * 64 + g)) * 128 + 8 * gq;
        bf16x8 uf[12];
#pragma unroll
        for (int ks = 0; ks < 8; ++ks) uf[ks] = *(const bf16x8*)(hp + (size_t)(2 * ks) * D);
#pragma unroll
        for (int ks = 0; ks < 4; ++ks) uf[8 + ks] = *(const bf16x8*)(xp + ks * 32);
        f32x4 acc[8];
#pragma unroll
        for (int mt = 0; mt < 8; ++mt) acc[mt] = (f32x4){0.f, 0.f, 0.f, 0.f};
#pragma unroll
        for (int ks = 0; ks < 12; ++ks) {
#pragma unroll
            for (int mt = 0; mt < 8; ++mt) acc[mt] = mma(frag_rm(A, 784, mt * 16, ks * 32, lane), uf[ks], acc[mt]);
            __builtin_amdgcn_sched_barrier(0); }
#pragma unroll
        for (int mt = 0; mt < 8; ++mt) { const size_t tok = (size_t)b * SEQ + 16 * (k0 + i) + 8 * lh + mt;
            const v2u hv = *(const v2u*)(HN + tok * D + colg);
            const float y0 = gelu_tanh(acc[mt][0] + dv[0] * bflo(hv.x)), y1 = gelu_tanh(acc[mt][1] + dv[1] * bfhi(hv.x));
            const float y2 = gelu_tanh(acc[mt][2] + dv[2] * bflo(hv.y)), y3 = gelu_tanh(acc[mt][3] + dv[3] * bfhi(hv.y));
            *(v2u*)(Y + tok * D + colg) = (v2u){pk2(y0, y1), pk2(y2, y3)}; } }
}

#ifndef CONV_OLD
#define CONV_OLD 0
#endif
#ifndef FUSE_E5
#define FUSE_E5 1
#endif
#ifndef FUSE_DOWN
#define FUSE_DOWN 7
#endif
#ifndef REP_BAR
#define REP_BAR 1
#endif
#ifndef REP_CONV
#define REP_CONV 1
#endif
#ifndef REP_ROW
#define REP_ROW 1
#endif
#ifndef REP_RC
#define REP_RC 1
#endif
#ifndef REP_SC
#define REP_SC 1
#endif
#ifndef SC_DBG
#define SC_DBG 0
#endif
#ifndef REP_GEMM
#define REP_GEMM 1
#endif
#ifndef REP_S5A
#define REP_S5A 1
#endif
#ifndef REP_S5S
#define REP_S5S 1
#endif
#ifndef REP_S5B
#define REP_S5B 1
#endif
#ifndef REP_RA
#define REP_RA 1
#endif
#ifndef REP_SA
#define REP_SA 1
#endif
#ifndef SKIP_EVEN
#define SKIP_EVEN 0
#endif
#ifndef SKIP_ODD
#define SKIP_ODD 0
#endif
#ifdef TPROBE
#ifndef TP_CU
#define TP_CU 0
#endif
#define TPK_B(id) do { if (TPROBE == (id) && blockIdx.x == TP_CU && threadIdx.x == 0) { const unsigned long long t_ = __builtin_amdgcn_s_memrealtime(); ((LAS unsigned*)(F.lds + 146432))[2] = (unsigned)t_; } } while (0)
#define TPK_E(id) do { if (TPROBE == (id) && blockIdx.x == TP_CU && threadIdx.x == 0) { const unsigned long long t_ = __builtin_amdgcn_s_memrealtime(); ((LAS unsigned*)(F.lds + 146432))[0] += (unsigned)t_ - ((LAS unsigned*)(F.lds + 146432))[2]; } } while (0)
#else
#define TPK_B(id) do {} while (0)
#define TPK_E(id) do {} while (0)
#endif
DI int opq(int v) { asm volatile("" : "+s"(v)); return v; }
#define CS_STR2(x) #x
#define CS_STR(x) CS_STR2(x)
#ifdef CODE_SHIFT
#define CODE_SHIFT_STR CS_STR(CODE_SHIFT)
#endif
struct Args { const float* in[N_IN]; float* out; unsigned char* ws; };
constexpr int CW_BAR = 1024;

#define PHASE() do { unsigned z_ = 0u; asm volatile("" : "+s"(z_)); int l_ = __builtin_amdgcn_mbcnt_hi(~0u, __builtin_amdgcn_mbcnt_lo(~0u, z_)); int w_ = wave0; asm volatile("" : "+s"(w_)); \
        int g_ = gridDim.x, b_ = blockIdx.x; asm volatile("" : "+s"(g_), "+s"(b_)); F.G = g_; F.bid = b_; F.vcu = (g_ % 8 == 0) ? (b_ % 8) * (g_ / 8) + b_ / 8 : b_; F.lane = l_; F.wave = w_; F.tid = w_ * 64 + l_; F.out = (float*)(GAS float*)lds_ptr(F, N_IN); F.ws = (unsigned char*)(GAS unsigned char*)lds_ptr(F, N_IN + 1); } while (0)
#define WSP(T, off) ((T*)(F.ws + (off)))
#define GRID_BAR() do { PHASE(); XcdBarrier xb_; xb_.bar = (unsigned*)(F.ws + WS_CTL) + CW_BAR; xb_.x = xb_xcc_id(); xb_.tid = F.tid; xb_.st = (volatile LAS unsigned*)(F.lds + MISC_OFF) + 8; xcd_barrier(xb_); if (REP_BAR == 2) xcd_barrier(xb_); PHASE(); } while (0)
template <int layer> __device__ __forceinline__ void run_layer(Frame& F, const int wave0) {
        const int j = layer >> 1;
        if ((layer & 1) == 0) {
            if (!opq(SKIP_EVEN)) {
            { pg8::Gemm g{WSP(bf16, WS_SLOT32), WSP(bf16, WS_SLOT16), M, INP_PAD, D}; pg8::StaticOrder S; S.init(M, INP_PAD, F.G, F.bid);
              pg8::EpiInProj E{WSP(bf16, WS_QKV), WSP(bf16, WS_GZ), WSP(bf16, WS_XBC), WSP(float, WS_DT), (const float*)(F.ws + WS_ROPE), INP(I_DT_BIAS) + j * 16};
              pg8::gemm_phase<pg8::EpiInProj, pg8::StaticOrder, true, true>(F.lds, g, S, E, F.tid); }
#if REP_GEMM == 2 || defined(REP_G_INP)
            { PHASE(); pg8::Gemm g{WSP(bf16, WS_SLOT32), WSP(bf16, WS_SLOT16), M, INP_PAD, D}; pg8::StaticOrder S; S.init(M, INP_PAD, F.G, F.bid);
              pg8::EpiInProj E{WSP(bf16, WS_QKV), WSP(bf16, WS_GZ), WSP(bf16, WS_XBC), WSP(float, WS_DT), (const float*)(F.ws + WS_ROPE), INP(I_DT_BIAS) + j * 16};
              pg8::gemm_phase<pg8::EpiInProj, pg8::StaticOrder, true, true>(F.lds, g, S, E, F.tid); }
#endif
            GRID_BAR();
            for (int rep_ = 0; rep_ < REP_RA; ++rep_) for (int u = F.vcu; u < 256; u += F.G) ret_passA_unit(F, u);
            { const SsdPar SP{INP(I_CONV_W) + (size_t)j * 4 * 1536, INP(I_CONV_B) + j * 1536, INP(I_A_LOG) + j * 16, INP(I_D_SSD) + j * 16, INP(I_SSD_NORM) + j * 1024};
              for (int rep_ = 0; rep_ < REP_SA; ++rep_) for (int u = F.vcu; u < 256; u += F.G) ssd_passA_unit(F, SP, u); }
            GRID_BAR();
            for (int it = (F.bid * NTHR + F.tid); it < 131072; it += (F.G * NTHR)) ret_scan_item(F, it);
            for (int it = (F.bid * NTHR + F.tid); it < 131072; it += (F.G * NTHR)) ssd_scan_item(F, it);
            GRID_BAR();
#if REP_RC == 2
            if (layer == 0) for (int u = F.vcu; u < 256; u += F.G) ret_passC_unit(F, u, (bf16*)F.out);
#endif
            for (int u = F.vcu; u < 256; u += F.G) ret_passC_unit(F, u, WSP(bf16, WS_GZ));
            { const SsdPar SP{INP(I_CONV_W) + (size_t)j * 4 * 1536, INP(I_CONV_B) + j * 1536, INP(I_A_LOG) + j * 16, INP(I_D_SSD) + j * 16, INP(I_SSD_NORM) + j * 1024};
#if REP_SC >= 2
              if (layer == 0) for (int u = F.vcu; u < 256; u += F.G) ssd_passC_unit<SC_DBG>(F, SP, u, REP_SC == 2 ? (bf16*)F.out : (bf16*)nullptr);
#endif
              for (int u = F.vcu; u < 256; u += F.G) ssd_passC_unit(F, SP, u, WSP(bf16, WS_GZ)); }
            GRID_BAR();
            }
            __syncthreads();
            convert_weight(F, INP(I_W_UP) + (size_t)layer * D * FF, D, FF, WSP(bf16, WS_SLOT16), 0);
#if REP_CONV == 2
            convert_weight(F, INP(I_W_UP) + (size_t)layer * D * FF, D, FF, WSP(bf16, WS_SLOT16), 0);
#endif
            convert_weight(F, INP(I_W_DOWN) + (size_t)layer * FF * D, FF, D, WSP(bf16, WS_SLOT16) + (size_t)FF * D, 0);
#if REP_CONV == 2
            convert_weight(F, INP(I_W_DOWN) + (size_t)layer * FF * D, FF, D, WSP(bf16, WS_SLOT16) + (size_t)FF * D, 0);
#endif
            __syncthreads();
            if (FUSE_E5 && F.G == 256 && !opq(SKIP_EVEN)) {
            { pg8::Gemm g{WSP(bf16, WS_GZ), WSP(bf16, WS_W4), M, D, 2048}; pg8::StaticOrder S; S.init(M, D, F.G, F.bid);
              pg8::EpiResNorm<layer == 0> E{layer == 0 ? (const void*)INP(I_X) : (const void*)F.out, (bf16*)F.out, WSP(bf16, WS_SLOT32), INP(I_POST_MIX) + layer * D, INP(I_PRE_MLP) + layer * D,
                                            WSP(unsigned long long, WS_XBUF_A), (unsigned*)(F.ws + WS_CTL) + CW_PANEL, 32u * (unsigned)(layer / 2 + 1), EPS};
              TPK_B(8); pg8::gemm_phase<pg8::EpiResNorm<layer == 0>, pg8::StaticOrder, true, true>(F.lds, g, S, E, F.tid); TPK_E(8); }
            __syncthreads();
            TPK_B(7); GRID_BAR(); TPK_E(7);
            } else {
            if (!opq(SKIP_EVEN)) {
            { pg8::Gemm g{WSP(bf16, WS_GZ), WSP(bf16, WS_W4), M, D, 2048}; pg8::StaticOrder S; S.init(M, D, F.G, F.bid);
              pg8::EpiBf16 E{WSP(bf16, WS_M32A), D};
              TPK_B(9); pg8::gemm_phase<pg8::EpiBf16, pg8::StaticOrder, true, true>(F.lds, g, S, E, F.tid); TPK_E(9); }
            } else zero_fill(F, WSP(bf16, WS_M32A), (size_t)M * D * 2);
            TPK_B(10); GRID_BAR(); TPK_E(10);
            TPK_B(11);
            if (layer == 0) row_phase<true, false>(F, WSP(bf16, WS_M32A), INP(I_X), F.out, INP(I_POST_MIX) + layer * D, INP(I_PRE_MLP) + layer * D, WSP(bf16, WS_SLOT32));
            else row_phase<false, false>(F, WSP(bf16, WS_M32A), F.out, F.out, INP(I_POST_MIX) + layer * D, INP(I_PRE_MLP) + layer * D, WSP(bf16, WS_SLOT32));
            TPK_E(11);
            TPK_B(12); GRID_BAR(); TPK_E(12);
            }
        } else {
            if (opq(SKIP_ODD) == 2) {
                const v4u* s_ = (const v4u*)WSP(bf16, WS_SLOT32); v4u* d_ = (v4u*)WSP(bf16, WS_Y);
                for (size_t i_ = (size_t)F.bid * NTHR + F.tid; i_ < (size_t)M * D / 8; i_ += (size_t)F.G * NTHR) d_[i_] = s_[i_];
                GRID_BAR();
            }
            if (opq(SKIP_ODD) == 0 || opq(SKIP_ODD) >= 3) {
            for (int rep_ = 0; rep_ < REP_S5A; ++rep_) for (int u = F.vcu; u < 256; u += F.G) s5_gemmA_unit(F, u);
            GRID_BAR();
            for (int rep_ = 0; rep_ < REP_S5B; ++rep_) for (int u = F.vcu; u < 256; u += F.G) {
                __syncthreads();
                if (F.wave < 2) s5_scan_task(F, INP(I_LAM_RE) + j * 4096, INP(I_LAM_IM) + j * 4096, INP(I_LOG_STEP) + j * 64, (2 * (u & 1) + F.wave) * 64 + (u >> 2), 0);
                asm volatile("s_waitcnt vmcnt(0)" ::: "memory");
                s5_gemmB_unit(F, INP(I_D_S5) + j * 1024, u); }
            GRID_BAR();
            }
            __syncthreads();
            convert_weight(F, INP(I_W_UP) + (size_t)layer * D * FF, D, FF, WSP(bf16, WS_SLOT16), 0);
            convert_weight(F, INP(I_W_DOWN) + (size_t)layer * FF * D, FF, D, layer == 1 ? WSP(bf16, WS_DOWN1) : WSP(bf16, WS_SLOT16) + (size_t)FF * D, 0);
            __syncthreads();
            if (opq(SKIP_ODD) != 1) {
            { pg8::Gemm g{WSP(bf16, WS_Y), WSP(bf16, WS_W4), M, 2048, D}; pg8::StaticOrder S; S.init(M, 2048, F.G, F.bid);
              pg8::EpiGlu E{WSP(bf16, WS_M32B), D};
              pg8::gemm_phase<pg8::EpiGlu, pg8::StaticOrder, true, true>(F.lds, g, S, E, F.tid); }
#if REP_GEMM == 2 || defined(REP_G_GLU)
            { PHASE(); pg8::Gemm g{WSP(bf16, WS_Y), WSP(bf16, WS_W4), M, 2048, D}; pg8::StaticOrder S; S.init(M, 2048, F.G, F.bid);
              pg8::EpiGlu E{WSP(bf16, WS_M32B), D};
              pg8::gemm_phase<pg8::EpiGlu, pg8::StaticOrder, true, true>(F.lds, g, S, E, F.tid); }
#endif
            } else zero_fill(F, WSP(bf16, WS_M32B), (size_t)M * D * 2);
            GRID_BAR();
            row_phase<false, false>(F, WSP(bf16, WS_M32B), F.out, F.out, INP(I_POST_MIX) + layer * D, INP(I_PRE_MLP) + layer * D, WSP(bf16, WS_SLOT32));
            GRID_BAR();
        }
        { pg8::Gemm g{WSP(bf16, WS_SLOT32), WSP(bf16, WS_SLOT16), M, FF, D}; pg8::StaticOrder S; S.init(M, FF, F.G, F.bid);
          pg8::EpiRelu2 E{WSP(bf16, WS_U), FF};
          pg8::gemm_phase<pg8::EpiRelu2, pg8::StaticOrder, true, true>(F.lds, g, S, E, F.tid); }
#if REP_GEMM == 2 || defined(REP_G_UP)
            { PHASE(); pg8::Gemm g{WSP(bf16, WS_SLOT32), WSP(bf16, WS_SLOT16), M, FF, D}; pg8::StaticOrder S; S.init(M, FF, F.G, F.bid);
          pg8::EpiRelu2 E{WSP(bf16, WS_U), FF};
          pg8::gemm_phase<pg8::EpiRelu2, pg8::StaticOrder, true, true>(F.lds, g, S, E, F.tid); }
#endif
        GRID_BAR();
        __syncthreads();
        if ((layer & 1) == 0) { convert_weight(F, INP(I_W_GLU_A) + (size_t)j * D * D, D, D, WSP(bf16, WS_W4), 1); convert_weight(F, INP(I_W_GLU_B) + (size_t)j * D * D, D, D, WSP(bf16, WS_W4), 2); }
#if REP_CONV == 2
        if ((layer & 1) == 0) { convert_weight(F, INP(I_W_GLU_A) + (size_t)j * D * D, D, D, WSP(bf16, WS_W4), 1); convert_weight(F, INP(I_W_GLU_B) + (size_t)j * D * D, D, D, WSP(bf16, WS_W4), 2); }
#endif
        if (layer == 1 && !CONV_OLD) {
            convert_weight(F, INP(I_W_IN) + (size_t)D * INP, D, INP, WSP(bf16, WS_SLOT16), 0);
#if REP_CONV == 2
            convert_weight(F, INP(I_W_IN) + (size_t)D * INP, D, INP, WSP(bf16, WS_SLOT16), 0);
#endif
            zero_fill(F, WSP(bf16, WS_SLOT16) + (size_t)6688 * D, (size_t)(INP_PAD - 6688) * D * 2);
            convert_weight(F, INP(I_W_OUT) + (size_t)2048 * D, 2048, D, WSP(bf16, WS_W4), 0);
#if REP_CONV == 2
            convert_weight(F, INP(I_W_OUT) + (size_t)2048 * D, 2048, D, WSP(bf16, WS_W4), 0);
#endif
        }
        __syncthreads();
        if (((FUSE_DOWN >> layer) & 1) && layer < DEPTH - 1 && F.G == 256) {
            { pg8::Gemm g{WSP(bf16, WS_U), layer == 1 ? WSP(bf16, WS_DOWN1) : WSP(bf16, WS_SLOT16) + (size_t)FF * D, M, D, FF}; pg8::StaticOrder S; S.init(M, D, F.G, F.bid);
              pg8::EpiResNorm<false> E{(const void*)F.out, (bf16*)F.out, WSP(bf16, WS_SLOT32), INP(I_POST_MLP) + layer * D, INP(I_PRE_MIX) + (layer + 1) * D,
                                       WSP(unsigned long long, WS_XBUF_B), (unsigned*)(F.ws + WS_CTL) + CW_PANEL + 4096, 32u * (unsigned)__builtin_popcount(FUSE_DOWN & ((2 << layer) - 1)), EPS};
              TPK_B(8); pg8::gemm_phase<pg8::EpiResNorm<false>, pg8::StaticOrder, true, true>(F.lds, g, S, E, F.tid); TPK_E(8); }
            __syncthreads();
#ifdef XTRA_BAR
            GRID_BAR();
#endif
#ifdef HN_SEP
            GRID_BAR();
            hn_from_h(F, (const bf16*)F.out, INP(I_PRE_MIX) + (layer + 1) * D, WSP(bf16, WS_SLOT32));
#endif
        } else {
        { pg8::Gemm g{WSP(bf16, WS_U), layer == 1 ? WSP(bf16, WS_DOWN1) : WSP(bf16, WS_SLOT16) + (size_t)FF * D, M, D, FF}; pg8::StaticOrder S; S.init(M, D, F.G, F.bid);
          pg8::EpiBf16 E{WSP(bf16, WS_M32B), D};
          if (layer < DEPTH - 1) TPK_B(9); pg8::gemm_phase<pg8::EpiBf16, pg8::StaticOrder, true, true>(F.lds, g, S, E, F.tid); if (layer < DEPTH - 1) TPK_E(9); }
#if REP_GEMM == 2 || defined(REP_G_DOWN)
            { PHASE(); pg8::Gemm g{WSP(bf16, WS_U), layer == 1 ? WSP(bf16, WS_DOWN1) : WSP(bf16, WS_SLOT16) + (size_t)FF * D, M, D, FF}; pg8::StaticOrder S; S.init(M, D, F.G, F.bid);
          pg8::EpiBf16 E{WSP(bf16, WS_M32B), D};
          pg8::gemm_phase<pg8::EpiBf16, pg8::StaticOrder, true, true>(F.lds, g, S, E, F.tid); }
#endif
        if (layer < DEPTH - 1) TPK_B(10); GRID_BAR(); if (layer < DEPTH - 1) TPK_E(10);
        if (layer < DEPTH - 1) { TPK_B(11); row_phase<false, false>(F, WSP(bf16, WS_M32B), F.out, F.out, INP(I_POST_MLP) + layer * D, INP(I_PRE_MIX) + (layer + 1) * D, WSP(bf16, WS_SLOT32)); TPK_E(11); }
        else row_phase<false, true>(F, WSP(bf16, WS_M32B), F.out, F.out, INP(I_POST_MLP) + layer * D, nullptr, nullptr);
        if (layer == 0 || layer == 2) GRID_BAR();
        }
        if (layer == 1 && CONV_OLD) {
            __syncthreads();
            convert_weight(F, INP(I_W_IN) + (size_t)D * INP, D, INP, WSP(bf16, WS_SLOT16), 0);
            zero_fill(F, WSP(bf16, WS_SLOT16) + (size_t)6688 * D, (size_t)(INP_PAD - 6688) * D * 2);
            convert_weight(F, INP(I_W_OUT) + (size_t)2048 * D, 2048, D, WSP(bf16, WS_W4), 0);
        }
        if (layer == 0 || layer == 2) {
            const S5Par P5{INP(I_LAM_RE) + j * 4096, INP(I_LAM_IM) + j * 4096, INP(I_LOG_STEP) + j * 64, INP(I_B_RE) + (size_t)j * 65536, INP(I_B_IM) + (size_t)j * 65536,
                           INP(I_C_RE) + (size_t)j * 65536, INP(I_C_IM) + (size_t)j * 65536, INP(I_D_S5) + j * 1024};
            for (int u = F.bid; u < 256; u += F.G) s5_build_unit(F, P5, u);
        }
        if (layer < DEPTH - 1) { TPK_B(7); TPK_B(12); GRID_BAR(); TPK_E(7); TPK_E(12); }

}

__global__ void __launch_bounds__(NTHR, 2) trunk_fwd(Args args) {
    extern __shared__ __attribute__((aligned(16))) unsigned char lds[];
#ifdef CODE_SHIFT
    asm volatile(".rept " CODE_SHIFT_STR "\n\ts_nop 0\n\t.endr" ::: "memory");
#endif
    Frame F;
    F.lds = (LAS unsigned char*)lds;
    F.G = gridDim.x; F.bid = blockIdx.x;
    { const int t = threadIdx.x;
      for (int u = t; u < (LDS_BYTES - MISC_OFF) / 4; u += NTHR) ((LAS unsigned*)(F.lds + MISC_OFF))[u] = 0u;
      __syncthreads();
      if (t < N_IN + 2) ((LAS unsigned long long*)(F.lds + MISC_OFF + 256))[t] = t < N_IN ? (unsigned long long)args.in[t] : (t == N_IN ? (unsigned long long)args.out : (unsigned long long)args.ws);
      __syncthreads(); }
    const int wave0 = __builtin_amdgcn_readfirstlane(threadIdx.x >> 6);
    PHASE();
    (void)xcd_barrier_post((unsigned*)(F.ws + WS_CTL) + CW_BAR, (volatile LAS unsigned*)(F.lds + MISC_OFF) + 8);

    build_rope(F);
    convert_weight(F, INP(I_W_IN), D, INP, WSP(bf16, WS_SLOT16), 0);
#if REP_CONV == 2
    convert_weight(F, INP(I_W_IN), D, INP, WSP(bf16, WS_SLOT16), 0);
#endif
    zero_fill(F, WSP(bf16, WS_SLOT16) + (size_t)6688 * D, (size_t)(INP_PAD - 6688) * D * 2);
    convert_weight(F, INP(I_W_OUT), 2048, D, WSP(bf16, WS_W4), 0);
#if REP_CONV == 2
    convert_weight(F, INP(I_W_OUT), 2048, D, WSP(bf16, WS_W4), 0);
#endif
    rms_rows_to_bf16(F, INP(I_X), INP(I_PRE_MIX), WSP(bf16, WS_SLOT32));
    GRID_BAR();

    run_layer<0>(F, wave0); run_layer<1>(F, wave0); run_layer<2>(F, wave0); run_layer<3>(F, wave0);
#ifdef TPROBE
    if (blockIdx.x == TP_CU && threadIdx.x == 0) {
        const unsigned long long t0_ = __builtin_amdgcn_s_memrealtime(); const unsigned long long w_ = 10ull * ((LAS unsigned*)(F.lds + 146432))[0];
        while (__builtin_amdgcn_s_memrealtime() - t0_ < w_) __builtin_amdgcn_s_sleep(8);
    }
#endif
}

extern "C" void kernel_launch(void* const* d_in, const int* in_sizes, int n_in, void* d_out, int out_size, void* d_ws, size_t ws_size, hipStream_t stream) {
    static int grid = 0;
    if (grid == 0) {
        if (n_in != N_IN || out_size != M * D || ws_size < WS_END) { fprintf(stderr, "kernel_launch: unexpected shapes (n_in %d, out %d, ws %zu)\n", n_in, out_size, ws_size); grid = -1; return; }
        int dev = 0, cus = 0, per_cu = 0;
        if (hipGetDevice(&dev) != hipSuccess || hipDeviceGetAttribute(&cus, hipDeviceAttributeMultiprocessorCount, dev) != hipSuccess) { grid = -1; return; }
        if (hipFuncSetAttribute((const void*)trunk_fwd, hipFuncAttributeMaxDynamicSharedMemorySize, LDS_BYTES) != hipSuccess) { fprintf(stderr, "kernel_launch: hipFuncSetAttribute failed\n"); grid = -1; return; }
        if (hipOccupancyMaxActiveBlocksPerMultiprocessor(&per_cu, (const void*)trunk_fwd, NTHR, LDS_BYTES) != hipSuccess || per_cu < 1)
            fprintf(stderr, "kernel_launch: note: occupancy query reports %d workgroups per CU\n", per_cu);
        (void)hipGetLastError();
        grid = cus;
    }
    if (grid < 0) return;
    if (hipMemsetAsync((char*)d_ws + WS_CTL, 0, CTL_ZERO_BYTES, stream) != hipSuccess) return;
#ifdef DBG_ZERO_MISC
    if (hipMemsetAsync((char*)d_ws + WS_MISC, 0, 512 * 1024, stream) != hipSuccess) return;
#endif
    Args a{};
    for (int i = 0; i < N_IN; ++i) a.in[i] = (const float*)d_in[i];
    a.out = (float*)d_out; a.ws = (unsigned char*)d_ws;
    hipLaunchKernelGGL(trunk_fwd, dim3(grid), dim3(NTHR), LDS_BYTES, stream, a);
}
```

```cpp
#include <hip/hip_runtime.h>
#include <cstdio>
#include <cstdint>
namespace pg8 {
#define PG8_LAS __attribute__((address_space(3)))
typedef unsigned short bf16_t;
typedef short bf16x8 __attribute__((ext_vector_type(8)));
typedef float f32x4 __attribute__((ext_vector_type(4)));
typedef unsigned u32x4 __attribute__((ext_vector_type(4)));
constexpr int BM = 256, BK = 64, HALF = 128, HTB = HALF * BK * 2  , STAGE_BYTES = 8 * HTB, NXCD = 8, WGM = 8;

__host__ __device__ __forceinline__ int lds_byte(int r, int c) { const int st = (r >> 4) * 2 + (c >> 5), rr = r & 15, cc = c & 31, ob = rr * 64 + cc * 2; return st * 1024 + (ob ^ (((ob >> 9) & 1) << 5)); }
__host__ __device__ __forceinline__ void stage_rc(int b, int& R, int& C) { const int st = b / 1024, sb = b % 1024, swz = sb ^ (((sb >> 9) & 1) << 5); R = (st >> 1) * 16 + swz / 64; C = (st & 1) * 32 + (swz % 64) / 2; }
__host__ __device__ __forceinline__ int perm32(int rho) { const int n = rho >> 4, i = rho & 15; return 8 * (i >> 2) + 4 * n + (i & 3); }

struct Unit { int pm, pn; };
struct Gemm { const bf16_t* A; const bf16_t* Bt; int M, N, K; };

struct StaticOrder {
    int nM, nN, nwg, G, c;
    __host__ __device__ void init(int M, int N, int G_, int c_) { nM = M / BM; nN = N / BM; nwg = nM * nN; G = G_; c = c_; }
    __host__ __device__ bool next(int i, Unit& u) const {
        const long L = (long)i * G + c; if (L >= nwg) return false;
        int wgid = (int)L; { const int q = nwg / NXCD, r = nwg % NXCD, xcd = wgid % NXCD, off = wgid / NXCD; wgid = (xcd < r ? xcd * (q + 1) : r * (q + 1) + (xcd - r) * q) + off; }
        const int nig = WGM * nN, gid = wgid / nig, fm = gid * WGM, gsz = (nM - fm) < WGM ? (nM - fm) : WGM;
        u.pm = fm + ((wgid % nig) % gsz); u.pn = (wgid % nig) / gsz; return true;
    }
    __device__ __forceinline__ void a_ready(const Unit&) const {}
    __device__ __forceinline__ void done(const Unit&) const {}
};

typedef __bf16 bf2_t __attribute__((ext_vector_type(2))); typedef float f32x2p __attribute__((ext_vector_type(2)));
__device__ __forceinline__ unsigned cvt_pk_bf16(float lo, float hi) { const f32x2p v = {lo, hi}; return __builtin_bit_cast(unsigned, __builtin_convertvector(v, bf2_t)); }
typedef float f32x2 __attribute__((ext_vector_type(2)));
struct EpiBf16 {
    static constexpr bool PERM = true, AFTER_DRAIN = false;
    bf16_t* O; int ldc;
    __device__ __forceinline__ void operator()(const f32x4 (&acc)[2][2][4][2], const Unit& u, int wr, int wc, int fr_in, int fq_in) const {
        int fr = fr_in, fq = fq_in; asm volatile("" : "+v"(fr), "+v"(fq));
        const int row0 = u.pm * BM + wr * 64 + fr, col0 = u.pn * BM + wc * 32 + 8 * fq;
#pragma unroll
        for (int ai = 0; ai < 2; ++ai)
#pragma unroll
            for (int m = 0; m < 4; ++m) { bf16_t* rowp = O + (size_t)(row0 + ai * HALF + m * 16) * ldc + col0;
#pragma unroll
                for (int bj = 0; bj < 2; ++bj) { const f32x4 v0 = acc[ai][bj][m][0], v1 = acc[ai][bj][m][1];
                    u32x4 w; w.x = cvt_pk_bf16(v0[0], v0[1]); w.y = cvt_pk_bf16(v0[2], v0[3]); w.z = cvt_pk_bf16(v1[0], v1[1]); w.w = cvt_pk_bf16(v1[2], v1[3]);
                    *(u32x4*)(rowp + bj * HALF) = w; } }
    }
};
struct EpiGlu {
    static constexpr bool PERM = true, AFTER_DRAIN = false;
    bf16_t* O; int ldc;
    __device__ __forceinline__ void operator()(const f32x4 (&acc)[2][2][4][2], const Unit& u, int wr, int wc, int fr_in, int fq_in) const {
        int fr = fr_in, fq = fq_in; asm volatile("" : "+v"(fr), "+v"(fq));
        const int row0 = u.pm * BM + wr * 64 + fr, col0 = u.pn * HALF + wc * 32 + 8 * fq;
#pragma unroll
        for (int ai = 0; ai < 2; ++ai)
#pragma unroll
            for (int m = 0; m < 4; ++m) { bf16_t* rowp = O + (size_t)(row0 + ai * HALF + m * 16) * ldc + col0;
                f32x4 o[2];
#pragma unroll
                for (int n = 0; n < 2; ++n) { const f32x4 a = acc[ai][0][m][n], b = acc[ai][1][m][n];
#pragma unroll
                    for (int j = 0; j < 4; ++j) o[n][j] = a[j] * __builtin_amdgcn_rcpf(1.0f + __expf(-b[j])); }
                u32x4 w; w.x = cvt_pk_bf16(o[0][0], o[0][1]); w.y = cvt_pk_bf16(o[0][2], o[0][3]); w.z = cvt_pk_bf16(o[1][0], o[1][1]); w.w = cvt_pk_bf16(o[1][2], o[1][3]);
                *(u32x4*)rowp = w; }
    }
};
struct EpiRelu2 {
    static constexpr bool PERM = true, AFTER_DRAIN = false;
    bf16_t* O; int ldc;
    __device__ __forceinline__ void operator()(const f32x4 (&acc)[2][2][4][2], const Unit& u, int wr, int wc, int fr_in, int fq_in) const {
        int fr = fr_in, fq = fq_in; asm volatile("" : "+v"(fr), "+v"(fq));
        const int row0 = u.pm * BM + wr * 64 + fr, col0 = u.pn * BM + wc * 32 + 8 * fq;
#pragma unroll
        for (int ai = 0; ai < 2; ++ai)
#pragma unroll
            for (int m = 0; m < 4; ++m) { bf16_t* rowp = O + (size_t)(row0 + ai * HALF + m * 16) * ldc + col0;
#pragma unroll
                for (int bj = 0; bj < 2; ++bj) { f32x4 v0 = acc[ai][bj][m][0], v1 = acc[ai][bj][m][1];
#pragma unroll
                    for (int j = 0; j < 4; ++j) { const float a = fmaxf(v0[j], 0.f), b = fmaxf(v1[j], 0.f); v0[j] = a * a; v1[j] = b * b; }
                    u32x4 w; w.x = cvt_pk_bf16(v0[0], v0[1]); w.y = cvt_pk_bf16(v0[2], v0[3]); w.z = cvt_pk_bf16(v1[0], v1[1]); w.w = cvt_pk_bf16(v1[2], v1[3]);
                    *(u32x4*)(rowp + bj * HALF) = w; } }
    }
};
struct EpiInProj {
    static constexpr bool PERM = true, AFTER_DRAIN = false;
    bf16_t* QKV; bf16_t* GZ; bf16_t* XBC; float* DT; const float* rope; const float* dt_bias;
    __device__ __forceinline__ void operator()(const f32x4 (&acc)[2][2][4][2], const Unit& u, int wr, int wc, int fr_in, int fq_in) const {
        int fr = fr_in, fq = fq_in; asm volatile("" : "+v"(fr), "+v"(fq));
        const int pn = u.pn, row0 = u.pm * BM + wr * 64 + fr, cin = wc * 32 + 8 * fq;
        if (pn < 8) {
            const int hd = pn & 3; const bool isk = pn >= 4;
            const float lg2 = __log2f(1.0f - exp2f(-5.0f - (float)hd));
#pragma unroll
            for (int ai = 0; ai < 2; ++ai)
#pragma unroll
                for (int m = 0; m < 4; ++m) { const int row = row0 + ai * HALF + m * 16, pos = row & 4095, r = pos & 127;
                    const float sc = isk ? exp2f(-(float)r * lg2) * 0.0625f : exp2f((float)r * lg2);
                    const f32x4* rp = (const f32x4*)(rope + ((size_t)pos * 128 + cin) * 2);
                    f32x4 o1[2], o2[2];
#pragma unroll
                    for (int n = 0; n < 2; ++n) { const f32x4 cs0 = rp[2 * n], cs1 = rp[2 * n + 1];
                        const f32x4 x1 = acc[ai][0][m][n], x2 = acc[ai][1][m][n];
                        const float c[4] = {cs0[0], cs0[2], cs1[0], cs1[2]}, s[4] = {cs0[1], cs0[3], cs1[1], cs1[3]};
#pragma unroll
                        for (int j = 0; j < 4; ++j) { o1[n][j] = (x1[j] * c[j] - x2[j] * s[j]) * sc; o2[n][j] = (x2[j] * c[j] + x1[j] * s[j]) * sc; } }
                    bf16_t* rowp = QKV + (size_t)row * 3072 + pn * 256 + cin;
                    u32x4 w; w.x = cvt_pk_bf16(o1[0][0], o1[0][1]); w.y = cvt_pk_bf16(o1[0][2], o1[0][3]); w.z = cvt_pk_bf16(o1[1][0], o1[1][1]); w.w = cvt_pk_bf16(o1[1][2], o1[1][3]);
                    *(u32x4*)rowp = w;
                    w.x = cvt_pk_bf16(o2[0][0], o2[0][1]); w.y = cvt_pk_bf16(o2[0][2], o2[0][3]); w.z = cvt_pk_bf16(o2[1][0], o2[1][1]); w.w = cvt_pk_bf16(o2[1][2], o2[1][3]);
                    *(u32x4*)(rowp + HALF) = w; }
        } else if (pn < 26) {
            bf16_t* base; int ldc, colt;
            if (pn < 12) { base = QKV; ldc = 3072; colt = pn * 256; } else if (pn < 20) { base = GZ; ldc = 2048; colt = (pn - 12) * 256; } else { base = XBC; ldc = 1536; colt = (pn - 20) * 256; }
#pragma unroll
            for (int ai = 0; ai < 2; ++ai)
#pragma unroll
                for (int m = 0; m < 4; ++m) { bf16_t* rowp = base + (size_t)(row0 + ai * HALF + m * 16) * ldc + colt + cin;
#pragma unroll
                    for (int bj = 0; bj < 2; ++bj) { const f32x4 v0 = acc[ai][bj][m][0], v1 = acc[ai][bj][m][1];
                        u32x4 w; w.x = cvt_pk_bf16(v0[0], v0[1]); w.y = cvt_pk_bf16(v0[2], v0[3]); w.z = cvt_pk_bf16(v1[0], v1[1]); w.w = cvt_pk_bf16(v1[2], v1[3]);
                        *(u32x4*)(rowp + bj * HALF) = w; } }
        } else {
            if (cin < 16) {
#pragma unroll
                for (int ai = 0; ai < 2; ++ai)
#pragma unroll
                    for (int m = 0; m < 4; ++m) { float* rowp = DT + (size_t)(row0 + ai * HALF + m * 16) * 16 + cin;
#pragma unroll
                        for (int n = 0; n < 2; ++n) { f32x4 o;
#pragma unroll
                            for (int j = 0; j < 4; ++j) { const float x = acc[ai][0][m][n][j] + dt_bias[cin + 4 * n + j]; o[j] = fmaxf(x > 20.f ? x : log1pf(__expf(x)), 1e-30f); }
                            *(f32x4*)(rowp + 4 * n) = o; } }
            }
        }
    }
};
template <bool IN_F32, bool OUT_F32 = false>
struct EpiResNorm {
    static constexpr bool PERM = true, AFTER_DRAIN = true;
    const void* hin; bf16_t* hout; bf16_t* hn; const float* w_post; const float* w_pre; unsigned long long* xbuf; unsigned* cnt; unsigned want; float eps;
    static __device__ __forceinline__ f32x4 up4(unsigned w0, unsigned w1) { return (f32x4){__builtin_bit_cast(float, w0 << 16), __builtin_bit_cast(float, w0 & 0xffff0000u), __builtin_bit_cast(float, w1 << 16), __builtin_bit_cast(float, w1 & 0xffff0000u)}; }
    __device__ __forceinline__ void fused(f32x4 (&acc)[2][2][4][2], const Unit& u, int wr, int wc, int fr_in, int fq_in, PG8_LAS unsigned char* lds, int wid, int lane_in) const {
        int fr = fr_in, fq = fq_in, lane = lane_in; asm volatile("" : "+v"(fr), "+v"(fq), "+v"(lane));
        typedef float f32x2v __attribute__((ext_vector_type(2)));
#ifdef TPROBE
        unsigned long long tp_t0 = 0ull;
#define TP_B(id) do { if (TPROBE == (id) && blockIdx.x == TP_CU && threadIdx.x == 0) tp_t0 = __builtin_amdgcn_s_memrealtime(); } while (0)
#define TP_E(id) do { if (TPROBE == (id) && blockIdx.x == TP_CU && threadIdx.x == 0) *(PG8_LAS unsigned*)(lds + 146432) += (unsigned)(__builtin_amdgcn_s_memrealtime() - tp_t0); } while (0)
#else
#define TP_B(id) do {} while (0)
#define TP_E(id) do {} while (0)
#endif
        TP_B(1); TP_B(2);
        PG8_LAS f32x4* P = (PG8_LAS f32x4*)lds;
        PG8_LAS f32x2v* S = (PG8_LAS f32x2v*)(lds + 16384);
        const int rowt = wr * 64 + fr, col0 = u.pn * BM + wc * 32 + 8 * fq;
        const size_t grow0 = (size_t)u.pm * BM + rowt;
        u32x4 wp[2][4][2];
        u32x4 hk[2][4][2];
        {   f32x4 wv[2][2];
#pragma unroll
            for (int bj = 0; bj < 2; ++bj)
#pragma unroll
                for (int n = 0; n < 2; ++n) wv[bj][n] = *(const f32x4*)(w_post + col0 + bj * HALF + 4 * n);
#pragma unroll
            for (int ai = 0; ai < 2; ++ai) {
                f32x4 hx[4][2][2];
                u32x4 hp[2][4][2];
                if (!IN_F32) {
#pragma unroll
                    for (int m = 0; m < 4; ++m)
#pragma unroll
                        for (int bj = 0; bj < 2; ++bj) { hp[ai][m][bj] = *(const u32x4*)((const bf16_t*)hin + (grow0 + ai * HALF + m * 16) * 2048 + col0 + bj * HALF); if (OUT_F32) hk[ai][m][bj] = hp[ai][m][bj]; }
                }
#pragma unroll
                for (int m = 0; m < 4; ++m) {
                    if (IN_F32 && (m & 1) == 0) {
#pragma unroll
                        for (int mm = m; mm < m + 2; ++mm)
#pragma unroll
                            for (int bj = 0; bj < 2; ++bj)
#pragma unroll
                                for (int n = 0; n < 2; ++n) hx[mm][bj][n] = *(const f32x4*)((const float*)hin + (grow0 + ai * HALF + mm * 16) * 1024 + col0 + bj * HALF + 4 * n);
                    }
                    float s1 = 0.f, s2 = 0.f, s3 = 0.f, s4 = 0.f;
#pragma unroll
                    for (int bj = 0; bj < 2; ++bj) { f32x4 wm[2];
#pragma unroll
                        for (int n = 0; n < 2; ++n) {
                            const f32x4 hv = IN_F32 ? hx[m][bj][n] : up4(hp[ai][m][bj][2 * n], hp[ai][m][bj][2 * n + 1]);
                            const f32x4 a = acc[ai][bj][m][n]; wm[n] = a * wv[bj][n];
                            s1 += (a[0] * a[0] + a[1] * a[1]) + (a[2] * a[2] + a[3] * a[3]);
                            if (!OUT_F32) {
                            s2 += (hv[0] * hv[0] + hv[1] * hv[1]) + (hv[2] * hv[2] + hv[3] * hv[3]);
                            s3 += (hv[0] * wm[n][0] + hv[1] * wm[n][1]) + (hv[2] * wm[n][2] + hv[3] * wm[n][3]);
                            s4 += (wm[n][0] * wm[n][0] + wm[n][1] * wm[n][1]) + (wm[n][2] * wm[n][2] + wm[n][3] * wm[n][3]); } }
                        u32x4 w; w.x = cvt_pk_bf16(wm[0][0], wm[0][1]); w.y = cvt_pk_bf16(wm[0][2], wm[0][3]); w.z = cvt_pk_bf16(wm[1][0], wm[1][1]); w.w = cvt_pk_bf16(wm[1][2], wm[1][3]);
                        asm volatile("" : "+v"(w));
                        wp[ai][m][bj] = w; }
                    s1 += __shfl_xor(s1, 16); s1 += __shfl_xor(s1, 32);
                    if (!OUT_F32) { s2 += __shfl_xor(s2, 16); s3 += __shfl_xor(s3, 16); s4 += __shfl_xor(s4, 16); s2 += __shfl_xor(s2, 32); s3 += __shfl_xor(s3, 32); s4 += __shfl_xor(s4, 32); }
                    if (fq == 0) P[(ai * HALF + rowt + m * 16) * 4 + wc] = (f32x4){s1, s2, s3, s4};
                    if (IN_F32 && (m & 1)) asm volatile("" ::: "memory");
                }
                asm volatile("" ::: "memory");
            }
        }
        asm volatile("s_waitcnt lgkmcnt(0)" ::: "memory"); __builtin_amdgcn_s_barrier(); asm volatile("" ::: "memory");
        TP_E(2); TP_B(3);
        const int row = wid * 32 + (lane & 31);
        if (lane < 32) {
            const f32x4 a = P[row * 4 + 0], b = P[row * 4 + 1], c = P[row * 4 + 2], d = P[row * 4 + 3];
            const f32x4 t = (a + b) + (c + d);
            const float t0 = t[0], t1 = t[1], t2 = t[2], t3 = t[3];
            unsigned long long* slot = xbuf + ((size_t)(u.pm * BM + row) * 4 + u.pn) * 2;
            __hip_atomic_store(slot, ((unsigned long long)__builtin_bit_cast(unsigned, t1) << 32) | __builtin_bit_cast(unsigned, t0), __ATOMIC_RELAXED, __HIP_MEMORY_SCOPE_AGENT);
            __hip_atomic_store(slot + 1, ((unsigned long long)__builtin_bit_cast(unsigned, t3) << 32) | __builtin_bit_cast(unsigned, t2), __ATOMIC_RELAXED, __HIP_MEMORY_SCOPE_AGENT);
        }
        asm volatile("s_waitcnt vmcnt(0)" ::: "memory");
        if (lane == 0) __hip_atomic_fetch_add(cnt + 64 * u.pm, 1u, __ATOMIC_RELAXED, __HIP_MEMORY_SCOPE_AGENT);
        TP_E(3); TP_B(4);
        if (wid == 0) {
            unsigned sp = 0u;
            for (;;) {
                if ((unsigned)__builtin_amdgcn_readfirstlane(__hip_atomic_load(cnt + 64 * u.pm, __ATOMIC_RELAXED, __HIP_MEMORY_SCOPE_AGENT)) >= want) break;
                if (++sp > (1u << 22)) break;
                __builtin_amdgcn_s_sleep(2);
            }
#ifdef XCH_FENCE
            __builtin_amdgcn_fence(__ATOMIC_ACQUIRE, "agent");
#endif
        }
        asm volatile("s_waitcnt vmcnt(0) lgkmcnt(0)" ::: "memory"); __builtin_amdgcn_s_barrier(); asm volatile("" ::: "memory");
        TP_E(4); TP_B(5);
        if (lane < 32) {
            const unsigned long long* slot = xbuf + (size_t)(u.pm * BM + row) * 8; float t1 = 0.f, t2 = 0.f, t3 = 0.f, t4 = 0.f;
#pragma unroll
            for (int t = 0; t < 4; ++t) { const unsigned long long w0 = __hip_atomic_load(slot + 2 * t, __ATOMIC_RELAXED, __HIP_MEMORY_SCOPE_AGENT), w1 = __hip_atomic_load(slot + 2 * t + 1, __ATOMIC_RELAXED, __HIP_MEMORY_SCOPE_AGENT);
                t1 += __builtin_bit_cast(float, (unsigned)w0); t2 += __builtin_bit_cast(float, (unsigned)(w0 >> 32)); t3 += __builtin_bit_cast(float, (unsigned)w1); t4 += __builtin_bit_cast(float, (unsigned)(w1 >> 32)); }
            const float r1 = rsqrtf(t1 * (1.0f / 1024.0f) + eps);
            const float q = fmaxf(t2 + r1 * (2.0f * t3 + r1 * t4), 0.f);
            S[row] = (f32x2v){r1, rsqrtf(q * (1.0f / 1024.0f) + eps)};
        }
        asm volatile("s_waitcnt lgkmcnt(0)" ::: "memory"); __builtin_amdgcn_s_barrier(); asm volatile("" ::: "memory");
        TP_E(5); TP_B(6);
        u32x4 hp[2][4][2];
        if (!IN_F32) {
#pragma unroll
            for (int ai = 0; ai < 2; ++ai)
#pragma unroll
                for (int m = 0; m < 4; ++m)
#pragma unroll
                    for (int bj = 0; bj < 2; ++bj) { if (OUT_F32) hp[ai][m][bj] = hk[ai][m][bj]; else hp[ai][m][bj] = *(const u32x4*)((const bf16_t*)hin + (grow0 + ai * HALF + m * 16) * 2048 + col0 + bj * HALF); }
        }
        f32x4 wq[2][2];
#pragma unroll
        for (int bj = 0; bj < 2; ++bj)
#pragma unroll
            for (int n = 0; n < 2; ++n) wq[bj][n] = OUT_F32 ? (f32x4){0.f, 0.f, 0.f, 0.f} : *(const f32x4*)(w_pre + col0 + bj * HALF + 4 * n);
#pragma unroll
        for (int ai = 0; ai < 2; ++ai) {
            f32x4 hx[4][2][2];
            if (IN_F32) {
#pragma unroll
                for (int m = 0; m < 4; ++m)
#pragma unroll
                    for (int bj = 0; bj < 2; ++bj)
#pragma unroll
                        for (int n = 0; n < 2; ++n) hx[m][bj][n] = *(const f32x4*)((const float*)hin + (grow0 + ai * HALF + m * 16) * 1024 + col0 + bj * HALF + 4 * n);
            }
#pragma unroll
            for (int m = 0; m < 4; ++m) { const int r = ai * HALF + rowt + m * 16; const f32x2v sr = S[r]; const size_t grow = (size_t)u.pm * BM + r;
#pragma unroll
                for (int bj = 0; bj < 2; ++bj) { f32x4 o[2];
#pragma unroll
                    for (int n = 0; n < 2; ++n) { const f32x4 hv = IN_F32 ? hx[m][bj][n] : up4(hp[ai][m][bj][2 * n], hp[ai][m][bj][2 * n + 1]);
                        o[n] = hv + up4(wp[ai][m][bj][2 * n], wp[ai][m][bj][2 * n + 1]) * sr.x; }
                    if (OUT_F32) { float* of = (float*)(void*)hout + grow * 1024 + col0 + bj * HALF; *(f32x4*)of = o[0]; *(f32x4*)(of + 4) = o[1]; }
                    else {
                    u32x4 w; w.x = cvt_pk_bf16(o[0][0], o[0][1]); w.y = cvt_pk_bf16(o[0][2], o[0][3]); w.z = cvt_pk_bf16(o[1][0], o[1][1]); w.w = cvt_pk_bf16(o[1][2], o[1][3]);
                    *(u32x4*)(hout + grow * 2048 + col0 + bj * HALF) = w;
                    const f32x4 y0 = o[0] * sr.y * wq[bj][0], y1 = o[1] * sr.y * wq[bj][1];
                    w.x = cvt_pk_bf16(y0[0], y0[1]); w.y = cvt_pk_bf16(y0[2], y0[3]); w.z = cvt_pk_bf16(y1[0], y1[1]); w.w = cvt_pk_bf16(y1[2], y1[3]);
                    *(u32x4*)(hn + grow * 1024 + col0 + bj * HALF) = w; } } }
            if (IN_F32) asm volatile("" ::: "memory");
        }
        TP_E(6); TP_E(1);
    }
};
template <class Epi, class Sched, bool ALIGN_EPI = false, bool SP2 = false>
__device__ __forceinline__ void gemm_phase(PG8_LAS unsigned char* lds, const Gemm g, const Sched& S, const Epi& E, const int tid) {
    const int wid = __builtin_amdgcn_readfirstlane(tid >> 6), lane = tid & 63, wr = wid >> 2, wc = wid & 3, fr = lane & 15, fq = lane >> 4;
    const int K = g.K, nt = K / BK;
    unsigned voffA[2], voffB[2];
#pragma unroll
    for (int i = 0; i < 2; ++i) { int R, C; stage_rc(tid * 16 + i * 8192, R, C); const int Rb = Epi::PERM ? ((R & ~31) + perm32(R & 31)) : R;
        voffA[i] = (unsigned)(R * K + C) * 2u; voffB[i] = (unsigned)(Rb * K + C) * 2u; }
    const size_t kstep = (size_t)(BK * 2);
    const size_t hstep = (size_t)HALF * K * 2;
    const size_t tstep = 2 * hstep;
    const unsigned ldsw = (unsigned)wid * 1024u;
    const int aoff = lds_byte(wr * 64 + fr, fq * 8), boff = lds_byte(wc * 32 + fr, fq * 8);
#define PG8_SA(b, h) (((b) * 2 + (h)) * HTB)
#define PG8_SB(b, h) ((4 + (b) * 2 + (h)) * HTB)
#define PG8_STAGE(bufoff, gbase, voff) do { _Pragma("unroll") for (int _i = 0; _i < 2; ++_i) \
        __builtin_amdgcn_global_load_lds((const unsigned*)((const char*)(gbase) + (voff)[_i]), (PG8_LAS unsigned*)(lds + (bufoff) + ldsw + _i * 8192), 16, 0, 0); } while (0)
#define PG8_LDA(dst, b, h) do { _Pragma("unroll") for (int m = 0; m < 4; ++m) _Pragma("unroll") for (int k = 0; k < 2; ++k) dst[m][k] = *(const PG8_LAS bf16x8*)(lds + PG8_SA(b, h) + aoff + m * 2048 + k * 1024); } while (0)
#define PG8_LDB(dst, b, h) do { _Pragma("unroll") for (int n = 0; n < 2; ++n) _Pragma("unroll") for (int k = 0; k < 2; ++k) dst[n][k] = *(const PG8_LAS bf16x8*)(lds + PG8_SB(b, h) + boff + n * 2048 + k * 1024); } while (0)
#define PG8_MMA(ai, bj, At, Bt) do { __builtin_amdgcn_s_setprio(1); _Pragma("unroll") for (int m = 0; m < 4; ++m) _Pragma("unroll") for (int n = 0; n < 2; ++n) _Pragma("unroll") for (int k = 0; k < 2; ++k) \
        acc[ai][bj][m][n] = __builtin_amdgcn_mfma_f32_16x16x32_bf16(Bt[n][k], At[m][k], acc[ai][bj][m][n], 0, 0, 0); __builtin_amdgcn_s_setprio(0); } while (0)
#define PG8_WAIT_V(n) asm volatile("s_waitcnt vmcnt(" #n ")" ::: "memory")
#define PG8_WAIT_L(n) asm volatile("s_waitcnt lgkmcnt(" #n ")" ::: "memory")
#define PG8_BAR __builtin_amdgcn_s_barrier()
#define PG8_SCHED __builtin_amdgcn_sched_barrier(0)
    Unit cur, nxt; int ui = 0;
    if (!S.next(0, cur)) return;
    f32x4 acc[2][2][4][2];
#pragma unroll
    for (int a = 0; a < 2; ++a)
#pragma unroll
        for (int b = 0; b < 2; ++b)
#pragma unroll
            for (int m = 0; m < 4; ++m)
#pragma unroll
                for (int n = 0; n < 2; ++n) acc[a][b][m][n] = (f32x4){0.f, 0.f, 0.f, 0.f};
    bf16x8 At[4][2], B0[2][2], B1[2][2];
    const char* cA = (const char*)g.A + (size_t)cur.pm * tstep; const char* cB = (const char*)g.Bt + (size_t)cur.pn * tstep;
    S.a_ready(cur);
    if constexpr (SP2) {
        PG8_STAGE(PG8_SB(0, 0), cB, voffB); PG8_STAGE(PG8_SB(0, 1), cB + hstep, voffB); PG8_STAGE(PG8_SA(0, 0), cA, voffA); PG8_STAGE(PG8_SA(0, 1), cA + hstep, voffA);
        if (wr == 1) PG8_BAR;
        PG8_WAIT_V(2); PG8_BAR;
        PG8_STAGE(PG8_SB(1, 0), cB + kstep, voffB); PG8_STAGE(PG8_SA(1, 0), cA + kstep, voffA); PG8_STAGE(PG8_SB(1, 1), cB + hstep + kstep, voffB);
        PG8_WAIT_V(6); PG8_BAR;
    } else {
        PG8_STAGE(PG8_SB(0, 0), cB, voffB); PG8_STAGE(PG8_SA(0, 0), cA, voffA); PG8_STAGE(PG8_SB(0, 1), cB + hstep, voffB); PG8_STAGE(PG8_SA(0, 1), cA + hstep, voffA);
        if (wr == 1) PG8_BAR;
        PG8_WAIT_V(4); PG8_BAR;
        PG8_STAGE(PG8_SB(1, 0), cB + kstep, voffB); PG8_STAGE(PG8_SA(1, 0), cA + kstep, voffA); PG8_STAGE(PG8_SB(1, 1), cB + hstep + kstep, voffB);
        PG8_WAIT_V(6); PG8_BAR;
    }
    for (;;) {
        const bool has_next = S.next(ui + 1, nxt);
        const char* nA = has_next ? (const char*)g.A + (size_t)nxt.pm * tstep : cA; const char* nB = has_next ? (const char*)g.Bt + (size_t)nxt.pn * tstep : cB;
        for (int t = 0; t < nt; t += 2) {
            const bool last = (t == nt - 2);
            const char* a1 = cA + (size_t)(t + 1) * kstep;
            const char* a2 = last ? nA : cA + (size_t)(t + 2) * kstep; const char* b2 = last ? nB : cB + (size_t)(t + 2) * kstep;
            const char* a3 = a2 + kstep; const char* b3 = b2 + kstep;
            if (last && has_next) S.a_ready(nxt);
            if constexpr (SP2) {
            PG8_LDB(B0, 0, 0); PG8_LDB(B1, 0, 1); PG8_SCHED; PG8_LDA(At, 0, 0); PG8_STAGE(PG8_SA(1, 1), a1 + hstep, voffA);
            PG8_WAIT_V(8); PG8_WAIT_L(0); PG8_BAR; PG8_MMA(0, 0, At, B0); PG8_MMA(0, 1, At, B1); PG8_BAR; PG8_SCHED;
            PG8_LDA(At, 0, 1); PG8_STAGE(PG8_SB(0, 0), b2, voffB); PG8_STAGE(PG8_SB(0, 1), b2 + hstep, voffB); PG8_STAGE(PG8_SA(0, 0), a2, voffA);
            PG8_WAIT_V(8); PG8_WAIT_L(0); PG8_BAR; PG8_MMA(1, 0, At, B0); PG8_MMA(1, 1, At, B1); PG8_BAR; PG8_SCHED;
            PG8_LDB(B0, 1, 0); PG8_LDB(B1, 1, 1); PG8_SCHED; PG8_LDA(At, 1, 0); PG8_STAGE(PG8_SA(0, 1), a2 + hstep, voffA);
            PG8_WAIT_V(8); PG8_WAIT_L(0); PG8_BAR; PG8_MMA(0, 0, At, B0); PG8_MMA(0, 1, At, B1); PG8_BAR; PG8_SCHED;
            PG8_LDA(At, 1, 1); PG8_STAGE(PG8_SB(1, 0), b3, voffB); PG8_STAGE(PG8_SB(1, 1), b3 + hstep, voffB); PG8_STAGE(PG8_SA(1, 0), a3, voffA);
            PG8_WAIT_V(8); PG8_WAIT_L(0); PG8_BAR; PG8_MMA(1, 0, At, B0); PG8_MMA(1, 1, At, B1); PG8_BAR; PG8_SCHED;
            } else {
            PG8_LDB(B0, 0, 0); PG8_SCHED; PG8_LDA(At, 0, 0); PG8_STAGE(PG8_SA(1, 1), a1 + hstep, voffA);
            PG8_WAIT_L(8); PG8_BAR; PG8_WAIT_L(0); PG8_MMA(0, 0, At, B0); PG8_BAR; PG8_SCHED;
            PG8_LDB(B1, 0, 1); PG8_STAGE(PG8_SB(0, 0), b2, voffB);
            PG8_BAR; PG8_WAIT_L(0); PG8_MMA(0, 1, At, B1); PG8_BAR;
            PG8_LDA(At, 0, 1); PG8_STAGE(PG8_SA(0, 0), a2, voffA);
            PG8_BAR; PG8_WAIT_L(0); PG8_MMA(1, 0, At, B0); PG8_BAR; PG8_SCHED;
            PG8_STAGE(PG8_SB(0, 1), b2 + hstep, voffB);
            PG8_WAIT_V(6); PG8_BAR; PG8_MMA(1, 1, At, B1); PG8_BAR;
            PG8_LDB(B0, 1, 0); PG8_SCHED; PG8_LDA(At, 1, 0); PG8_STAGE(PG8_SA(0, 1), a2 + hstep, voffA);
            PG8_WAIT_L(8); PG8_BAR; PG8_WAIT_L(0); PG8_MMA(0, 0, At, B0); PG8_BAR; PG8_SCHED;
            PG8_LDB(B1, 1, 1); PG8_STAGE(PG8_SB(1, 0), b3, voffB);
            PG8_BAR; PG8_WAIT_L(0); PG8_MMA(0, 1, At, B1); PG8_BAR;
            PG8_LDA(At, 1, 1); PG8_STAGE(PG8_SA(1, 0), a3, voffA);
            PG8_BAR; PG8_WAIT_L(0); PG8_MMA(1, 0, At, B0); PG8_BAR; PG8_SCHED;
            PG8_STAGE(PG8_SB(1, 1), b3 + hstep, voffB);
            PG8_WAIT_V(6); PG8_BAR; PG8_MMA(1, 1, At, B1); PG8_BAR;
            }
        }
        if constexpr (ALIGN_EPI) { if (wr == 0) PG8_BAR; }
        if constexpr (!Epi::AFTER_DRAIN) { E(acc, cur, wr, wc, fr, fq);
#if defined(REP_EPI) && REP_EPI == 2
            E(acc, cur, wr, wc, fr, fq);
#endif
            S.done(cur); }
        if (!has_next) break;
#pragma unroll
        for (int a = 0; a < 2; ++a)
#pragma unroll
            for (int b = 0; b < 2; ++b)
#pragma unroll
                for (int m = 0; m < 4; ++m)
#pragma unroll
                    for (int n = 0; n < 2; ++n) acc[a][b][m][n] = (f32x4){0.f, 0.f, 0.f, 0.f};
        cur = nxt; cA = nA; cB = nB; ++ui;
        if constexpr (ALIGN_EPI) { if (wr == 1) PG8_BAR; }
    }
    PG8_WAIT_V(0);
    if constexpr (!ALIGN_EPI) { if (wr == 0) PG8_BAR; }
    PG8_BAR;
    if constexpr (Epi::AFTER_DRAIN) { E.fused(acc, cur, wr, wc, fr, fq, lds, wid, lane); S.done(cur); }
#undef PG8_SA
#undef PG8_SB
#undef PG8_STAGE
#undef PG8_LDA
#undef PG8_LDB
#undef PG8_MMA
#undef PG8_WAIT_V
#undef PG8_WAIT_L
#undef PG8_BAR
#undef PG8_SCHED
}
}
constexpr int NWAVES = 8, NTHR = 512;
constexpr int BATCH = 4, SEQ = 4096, D = 1024, M = BATCH * SEQ, FF = 4096, DEPTH = 4;
constexpr int INP = 6672, INP_PAD = 6912;
constexpr float EPS = 1e-6f;
enum { I_X = 0, I_PRE_MIX, I_POST_MIX, I_PRE_MLP, I_POST_MLP, I_W_IN, I_CONV_W, I_CONV_B, I_DT_BIAS, I_A_LOG, I_D_SSD, I_SSD_NORM, I_W_OUT,
       I_LAM_RE, I_LAM_IM, I_LOG_STEP, I_B_RE, I_B_IM, I_C_RE, I_C_IM, I_D_S5, I_W_GLU_A, I_W_GLU_B, I_W_UP, I_W_DOWN, N_IN };
#ifndef DOWN1_MIB
#define DOWN1_MIB 249
#endif
#ifndef S5MAT_MIB
#define S5MAT_MIB 185
#endif
constexpr size_t MiB = 1u << 20;
constexpr size_t WS_CTL = 0, CTL_ZERO_BYTES = 64 * 1024;
constexpr size_t WS_MISC = 512 * 1024;
constexpr size_t WS_ROPE = 1 * MiB;
constexpr size_t WS_W4 = 5 * MiB;
constexpr size_t WS_SLOT16 = 9 * MiB;
constexpr size_t WS_SLOT32 = 25 * MiB;
constexpr size_t WS_QKV = 57 * MiB;
constexpr size_t WS_GZ = 153 * MiB;
constexpr size_t WS_XBC = 217 * MiB;
constexpr size_t WS_DT = 265 * MiB;
constexpr size_t WS_END = 268 * MiB;
constexpr size_t WS_M32A = 57 * MiB;
constexpr size_t WS_M32B = 185 * MiB;
constexpr size_t WS_U = 57 * MiB;
constexpr size_t WS_S5MAT = (S5MAT_MIB) * MiB;
constexpr size_t WS_S5E = 73 * MiB;
constexpr size_t WS_S5X = 105 * MiB;
constexpr size_t WS_Y = 121 * MiB;
constexpr size_t WS_DOWN1 = (DOWN1_MIB) * MiB;
constexpr size_t WS_XBUF_A = 266 * MiB, WS_XBUF_B = 267 * MiB;
constexpr int CW_PANEL = 8192;
constexpr int SCR_BYTES = 143360;
constexpr int MISC_OFF = SCR_BYTES;
constexpr int LDS_BYTES = 147456;

#define GAS __attribute__((address_space(1)))
#define LAS __attribute__((address_space(3)))
#define DI __device__ __forceinline__
typedef unsigned short bf16;
typedef unsigned v4u __attribute__((ext_vector_type(4)));
typedef unsigned v2u __attribute__((ext_vector_type(2)));
typedef float f32x4 __attribute__((ext_vector_type(4)));
typedef float f32x2v __attribute__((ext_vector_type(2)));
typedef short bf16x8 __attribute__((ext_vector_type(8)));
typedef short v4i16_t __attribute__((ext_vector_type(4)));
typedef GAS unsigned gu32;
#define RLX_AGENT __ATOMIC_RELAXED, __HIP_MEMORY_SCOPE_AGENT
#define LDS_WAIT() asm volatile("s_waitcnt lgkmcnt(0)" ::: "memory")
#define VM_WAIT() asm volatile("s_waitcnt vmcnt(0)" ::: "memory")
DI unsigned f2bf(float f) { unsigned u = __builtin_bit_cast(unsigned, f); return (u + 0x7fffu + ((u >> 16) & 1u)) >> 16; }
typedef __bf16 bf2_t __attribute__((ext_vector_type(2)));
DI unsigned pk2(float lo, float hi) { const f32x2v v = {lo, hi}; return __builtin_bit_cast(unsigned, __builtin_convertvector(v, bf2_t)); }
DI float bf2f(unsigned short b) { return __builtin_bit_cast(float, ((unsigned)b) << 16); }
DI float bflo(unsigned w) { return __builtin_bit_cast(float, w << 16); }
DI float bfhi(unsigned w) { return __builtin_bit_cast(float, w & 0xffff0000u); }
DI float wave_sum(float v) {
#pragma unroll
    for (int o = 1; o < 64; o <<= 1) v += __shfl_xor(v, o);
    return v;
}
DI float silu_f(float x) { return x * __builtin_amdgcn_rcpf(1.0f + __expf(-x)); }
DI void sincos_d(double x, double& s, double& c) {
    const double k = rint(x * 0.15915494309189533576888376337251);
    const double r = fma(-k, 6.283185307179586476925286766559, x), r2 = r * r;
    double ps = 1.0 / 1.0888869450418352e28, pc = 1.0 / 3.0488834461171384e29;
    const double fs[13] = {1.0 / 1.5511210043330986e25, 1.0 / 2.5852016738884978e22, 1.0 / 5.109094217170944e19, 1.0 / 1.21645100408832e17, 1.0 / 355687428096000.0, 1.0 / 1307674368000.0,
                           1.0 / 6227020800.0, 1.0 / 39916800.0, 1.0 / 362880.0, 1.0 / 5040.0, 1.0 / 120.0, 1.0 / 6.0, 1.0};
    const double fc[14] = {1.0 / 4.0329146112660565e26, 1.0 / 6.204484017332394e23, 1.0 / 1.1240007277776077e21, 1.0 / 2.43290200817664e18, 1.0 / 6402373705728000.0, 1.0 / 20922789888000.0,
                           1.0 / 87178291200.0, 1.0 / 479001600.0, 1.0 / 3628800.0, 1.0 / 40320.0, 1.0 / 720.0, 1.0 / 24.0, 1.0 / 2.0, 1.0};
#pragma unroll
    for (int i = 0; i < 13; ++i) ps = fs[i] - ps * r2;
#pragma unroll
    for (int i = 0; i < 14; ++i) pc = fc[i] - pc * r2;
    s = ps * r; c = pc;
}
#define XB_TMO      128
#define XB_XCNT(j)  (256  + 64 * (j))
#define XB_XSUB(j)  (1280 + 64 * (j))
#define XB_XGEN(j)  (2304 + 64 * (j))
#define XB_TOP      3328
#define XB_TOPGEN   3392
#define XCD_BAR_WORDS 3456
#define XB_SPIN_CAP (1u << 18)

__device__ __forceinline__ unsigned xb_ld(unsigned* p)              { return __hip_atomic_load(p, __ATOMIC_RELAXED, __HIP_MEMORY_SCOPE_AGENT); }
__device__ __forceinline__ unsigned xb_add(unsigned* p, unsigned v) { return __hip_atomic_fetch_add(p, v, __ATOMIC_RELAXED, __HIP_MEMORY_SCOPE_AGENT); }
__device__ __forceinline__ unsigned xb_xcc_id() { return (unsigned)__builtin_amdgcn_s_getreg((3 << 11) | 20) & 0xFu; }
#define XB_SPIN(cond, bar) do { unsigned _sp = 0; while (cond) { __builtin_amdgcn_s_sleep(1); \
    if ((++_sp & 255u) == 0u) { if (xb_ld(&(bar)[XB_TMO])) break; if (_sp > XB_SPIN_CAP) { atomicAdd(&(bar)[XB_TMO], 1u); break; } } } } while (0)

struct XcdBarrier {
    unsigned* bar; unsigned x; int tid;
    volatile LAS unsigned* st;
};

__device__ __forceinline__ XcdBarrier xcd_barrier_post(unsigned* bar, volatile LAS unsigned* st) {
    XcdBarrier b; b.bar = bar; b.x = xb_xcc_id(); b.st = st;
    if (threadIdx.x == 0) (void)xb_add(&bar[XB_XCNT(b.x)], 1u);
    return b;
}
__device__ __forceinline__ void xcd_barrier_complete(unsigned* bar, unsigned x, unsigned& nloc, unsigned& nx) {
    const unsigned G = gridDim.x * gridDim.y * gridDim.z;
    unsigned sum, cnt, mine, sp = 0u;
    for (;;) {
        sum = 0u; cnt = 0u; mine = 0u;
#pragma unroll
        for (unsigned j = 0; j < 16; ++j) { const unsigned c = xb_ld(&bar[XB_XCNT(j)]); sum += c; cnt += (c > 0u) ? 1u : 0u; mine = (j == x) ? c : mine; }
        if (sum == G) break;
        __builtin_amdgcn_s_sleep(1);
        if ((++sp & 255u) == 0u) { if (xb_ld(&bar[XB_TMO])) break; if (sp > XB_SPIN_CAP) { atomicAdd(&bar[XB_TMO], 1u); break; } }
    }
    nloc = mine > 0u ? mine : 1u; nx = cnt > 0u ? cnt : 1u;
}

__device__ __forceinline__ void xcd_barrier(const XcdBarrier& b) {
    asm volatile("s_waitcnt vmcnt(0)" ::: "memory");
    __syncthreads();
    if (b.tid == 0) {
        unsigned* bar = b.bar;
        __builtin_amdgcn_s_waitcnt(0);
        unsigned nloc = b.st[0], nx = b.st[1];
        if (nloc == 0u) { xcd_barrier_complete(bar, b.x, nloc, nx); b.st[0] = nloc; b.st[1] = nx; }
        const unsigned old = xb_add(&bar[XB_XSUB(b.x)], 1u);
        const unsigned gen = old / nloc;
        if (old + 1u == (gen + 1u) * nloc) {
            __builtin_amdgcn_fence(__ATOMIC_RELEASE, "agent");
            asm volatile("s_waitcnt vmcnt(0)" ::: "memory");
            const unsigned og = xb_add(&bar[XB_TOP], 1u);
            const unsigned tg = og / nx;
            if (og + 1u == (tg + 1u) * nx) xb_add(&bar[XB_TOPGEN], 1u);
            else XB_SPIN(xb_ld(&bar[XB_TOPGEN]) == tg, bar);
            __builtin_amdgcn_fence(__ATOMIC_ACQUIRE, "agent");
            xb_add(&bar[XB_XGEN(b.x)], 1u);
            asm volatile("s_waitcnt vmcnt(0)" ::: "memory");
        } else {
            XB_SPIN(xb_ld(&bar[XB_XGEN(b.x)]) == gen, bar);
            __builtin_amdgcn_fence(__ATOMIC_ACQUIRE, "agent");
            asm volatile("s_waitcnt vmcnt(0)" ::: "memory");
        }
    }
    __syncthreads();
}

struct Frame {
    LAS unsigned char* lds;
    int tid, lane, wave, G, bid, vcu;
    float* out; unsigned char* ws;
};
DI unsigned long long lds_ptr(const Frame& F, int i) {
    unsigned a_ = (unsigned)(size_t)(F.lds + MISC_OFF + 256) + 8u * (unsigned)i; asm volatile("" : "+v"(a_));
    const unsigned long long v = *(const volatile LAS unsigned long long*)a_;
    const unsigned lo = __builtin_amdgcn_readfirstlane((unsigned)v), hi = __builtin_amdgcn_readfirstlane((unsigned)(v >> 32));
    return ((unsigned long long)hi << 32) | lo;
}
#define INP(i) ((const float*)(const GAS float*)lds_ptr(F, (i)))
DI int gwave(const Frame& F) { return F.bid * NWAVES + F.wave; }

DI bf16x8 frag_rm(const LAS unsigned char* t, int S, int r0, int k0, int lane) { return *(const LAS bf16x8*)(t + (r0 + (lane & 15)) * S + (k0 + 8 * (lane >> 4)) * 2); }
DI bf16x8 frag_tr(const LAS unsigned char* t, int S, int r0, int k0, int lane) {
    const int g = lane >> 4, q = (lane & 15) >> 2, p = lane & 3;
    const LAS unsigned char* a = t + (k0 + 8 * g + q) * S + (r0 + 4 * p) * 2;
    const v4i16_t lo = __builtin_amdgcn_ds_read_tr16_b64_v4i16((LAS v4i16_t*)a);
    const v4i16_t hi = __builtin_amdgcn_ds_read_tr16_b64_v4i16((LAS v4i16_t*)(a + 4 * S));
    return __builtin_shufflevector(lo, hi, 0, 1, 2, 3, 4, 5, 6, 7);
}
DI f32x4 mma(bf16x8 a, bf16x8 b, f32x4 c) { return __builtin_amdgcn_mfma_f32_16x16x32_bf16(a, b, c, 0, 0, 0); }

DI void load_tile(LAS unsigned char* dst, int S, const bf16* src, size_t ld, int rows, int cols, int tid) {
    const int cpr = cols >> 3, n = rows * cpr;
    for (int i = tid; i < n; i += NTHR) { const int r = i / cpr, c = i - r * cpr;
        *(LAS v4u*)(dst + r * S + c * 16) = *(const v4u*)(src + (size_t)r * ld + c * 8); }
}

template <int COLS> DI unsigned tile_loff(int tid, unsigned ld) { constexpr int CPR = COLS / 8; return (unsigned)(tid / CPR) * ld + (unsigned)(tid % CPR) * 8u; }
template <int ROWS, int COLS> DI void tile_issue(v4u* r, const bf16* src, unsigned ld, unsigned loff) {
    constexpr int CPR = COLS / 8, N = ROWS * COLS / 4096, RSTEP = NTHR / CPR;
#pragma unroll
    for (int i = 0; i < N; ++i) r[i] = *(const v4u*)((src + (size_t)i * RSTEP * ld) + loff);
}
template <int ROWS, int COLS> DI void tile_commit(const v4u* r, LAS unsigned char* dst, int S, int tid) {
    constexpr int CPR = COLS / 8, N = ROWS * COLS / 4096, RSTEP = NTHR / CPR;
    LAS unsigned char* p = dst + (tid / CPR) * S + (tid % CPR) * 16;
#pragma unroll
    for (int i = 0; i < N; ++i) *(LAS v4u*)(p + i * RSTEP * S) = r[i];
}

DI void transpose_item(const float* W, int K, int N, bf16* WT, int mode, LAS float* scr, int item, int lane) {
    const int nblk = (N + 31) / 32, kb = item / nblk, nb = item % nblk, k0 = 64 * kb, n0 = 32 * nb;
    const int n4 = 4 * (lane & 7), nl = n0 + n4;
    f32x4 v[8];
#pragma unroll
    for (int i = 0; i < 8; ++i) v[i] = nl < N ? *(const f32x4*)(W + (size_t)(k0 + 8 * i + (lane >> 3)) * N + nl) : (f32x4){0.f, 0.f, 0.f, 0.f};
#pragma unroll
    for (int i = 0; i < 8; ++i) { LAS float* d = scr + (8 * i + (lane >> 3)) * 33 + n4; d[0] = v[i][0]; d[1] = v[i][1]; d[2] = v[i][2]; d[3] = v[i][3]; }
    LDS_WAIT(); asm volatile("" ::: "memory");
    const int c = lane & 7;
#pragma unroll
    for (int j = 0; j < 4; ++j) { const int n = (lane >> 3) + 8 * j; const LAS float* s = scr + (8 * c) * 33 + n;
        v4u o; o.x = pk2(s[0 * 33], s[1 * 33]); o.y = pk2(s[2 * 33], s[3 * 33]); o.z = pk2(s[4 * 33], s[5 * 33]); o.w = pk2(s[6 * 33], s[7 * 33]);
        const int ng = n0 + n; const int row = mode == 0 ? ng : (256 * (ng >> 7) + (ng & 127) + (mode == 2 ? 128 : 0));
        *(v4u*)(WT + (size_t)row * K + k0 + 8 * c) = o; }
    LDS_WAIT(); asm volatile("" ::: "memory");
}
DI void convert_weight(Frame& F, const float* W, int K, int N, bf16* WT, int mode, int w0 = 0) {
    if (F.wave < w0) return;
    LAS float* scr = (LAS float*)(F.lds + F.wave * 16384);
    const int nw = NWAVES - w0, nitems = (K / 64) * ((N + 31) / 32), NGW = F.G * nw;
    for (int it = F.bid * nw + (F.wave - w0); it < nitems; it += NGW) transpose_item(W, K, N, WT, mode, scr, it, F.lane);
}
DI void zero_fill(Frame& F, void* p, size_t bytes) {
    v4u* q = (v4u*)p; const size_t n = bytes / 16;
    for (size_t i = (size_t)F.bid * NTHR + F.tid; i < n; i += (size_t)F.G * NTHR) q[i] = (v4u){0u, 0u, 0u, 0u};
}

DI void build_rope(Frame& F) {
    float* rope = (float*)(F.ws + WS_ROPE);
    for (int i = F.bid * NTHR + F.tid; i < 4096 * 128; i += F.G * NTHR) { const int pos = i >> 7, d = i & 127;
        double inv = 1.0; { double r = 0.930572040929699; int e = d; while (e) { if (e & 1) inv *= r; r *= r; e >>= 1; } }
        const float ang = (float)pos * (float)inv;
        double s, c; sincos_d((double)ang, s, c);
        *(f32x2v*)(rope + 2 * (size_t)i) = (f32x2v){(float)c, (float)s}; }
}
DI void rms_rows_to_bf16(Frame& F, const float* src, const float* w, bf16* dst) {
    const int NGW = F.G * NWAVES;
    f32x4 wv[4];
#pragma unroll
    for (int j = 0; j < 4; ++j) wv[j] = ((const f32x4*)w)[F.lane + 64 * j];
    for (int m = gwave(F); m < M; m += NGW) { const f32x4* xr = (const f32x4*)(src + (size_t)m * D) + F.lane;
        f32x4 v[4]; float s = 0.f;
#pragma unroll
        for (int j = 0; j < 4; ++j) { v[j] = xr[64 * j]; s += (v[j].x * v[j].x + v[j].y * v[j].y) + (v[j].z * v[j].z + v[j].w * v[j].w); }
        const float rs = rsqrtf(wave_sum(s) * (1.f / D) + EPS);
        v2u* o8 = (v2u*)(dst + (size_t)m * D) + F.lane;
#pragma unroll
        for (int j = 0; j < 4; ++j) { const f32x4 y = v[j] * rs * wv[j]; o8[64 * j] = (v2u){pk2(y.x, y.y), pk2(y.z, y.w)}; } }
}
template <bool IN_F32, bool OUT_F32>
DI void row_phase(Frame& F, const bf16* mbuf, const void* hbase, void* hout, const float* w_post, const float* w_pre, bf16* hn) {
    const int NGW = F.G * NWAVES;
    f32x4 wp[4], wq[4];
#pragma unroll
    for (int j = 0; j < 4; ++j) { wp[j] = ((const f32x4*)w_post)[F.lane + 64 * j]; wq[j] = w_pre ? ((const f32x4*)w_pre)[F.lane + 64 * j] : (f32x4){0.f, 0.f, 0.f, 0.f}; }
    for (int m = gwave(F); m < M; m += NGW) {
        const v2u* mr = (const v2u*)(mbuf + (size_t)m * D) + F.lane;
        f32x4 v[4], h[4]; float s = 0.f;
#pragma unroll
        for (int j = 0; j < 4; ++j) { const v2u mv = mr[64 * j]; v[j] = (f32x4){bflo(mv.x), bfhi(mv.x), bflo(mv.y), bfhi(mv.y)};
            if (IN_F32) h[j] = ((const f32x4*)((const float*)hbase + (size_t)m * D) + F.lane)[64 * j];
            else { const v2u hv = ((const v2u*)((const bf16*)hbase + (size_t)m * 2048) + F.lane)[64 * j]; h[j] = (f32x4){bflo(hv.x), bfhi(hv.x), bflo(hv.y), bfhi(hv.y)}; }
            s += (v[j].x * v[j].x + v[j].y * v[j].y) + (v[j].z * v[j].z + v[j].w * v[j].w); }
#ifdef PERT_ROW
        const float rs = rsqrtf(wave_sum(s) * (1.f / D) + EPS) * PERT_ROW; float s2 = 0.f;
#else
        const float rs = rsqrtf(wave_sum(s) * (1.f / D) + EPS); float s2 = 0.f;
#endif
#ifdef ALG_Q
        float q2 = 0.f, q3 = 0.f, q4 = 0.f;
#pragma unroll
        for (int j = 0; j < 4; ++j) { const f32x4 wm = v[j] * wp[j]; q2 += (h[j].x * h[j].x + h[j].y * h[j].y) + (h[j].z * h[j].z + h[j].w * h[j].w);
            q3 += (h[j].x * wm.x + h[j].y * wm.y) + (h[j].z * wm.z + h[j].w * wm.w); q4 += (wm.x * wm.x + wm.y * wm.y) + (wm.z * wm.z + wm.w * wm.w); h[j] = h[j] + wm * rs; }
        q2 = wave_sum(q2); q3 = wave_sum(q3); q4 = wave_sum(q4);
        s2 = fmaxf(q2 + rs * (2.0f * q3 + rs * q4), 0.f) * (1.0f / 64.0f);
#else
#pragma unroll
        for (int j = 0; j < 4; ++j) { h[j] = h[j] + v[j] * rs * wp[j]; s2 += (h[j].x * h[j].x + h[j].y * h[j].y) + (h[j].z * h[j].z + h[j].w * h[j].w); }
#endif
        if (OUT_F32) { f32x4* ho = (f32x4*)((float*)hout + (size_t)m * D) + F.lane;
#pragma unroll
            for (int j = 0; j < 4; ++j) ho[64 * j] = h[j]; }
        else { v2u* ho = (v2u*)((bf16*)hout + (size_t)m * 2048) + F.lane;
#pragma unroll
            for (int j = 0; j < 4; ++j) ho[64 * j] = (v2u){pk2(h[j].x, h[j].y), pk2(h[j].z, h[j].w)}; }
        if (hn) { const float rs2 = rsqrtf(wave_sum(s2) * (1.f / D) + EPS);
            v2u* o8 = (v2u*)(hn + (size_t)m * D) + F.lane;
#pragma unroll
            for (int j = 0; j < 4; ++j) { const f32x4 y = h[j] * rs2 * wq[j]; o8[64 * j] = (v2u){pk2(y.x, y.y), pk2(y.z, y.w)}; } }
    }
}

DI void hn_from_h(Frame& F, const bf16* hbase, const float* w, bf16* hn) {
    const int NGW = F.G * NWAVES;
    f32x4 wq[4];
#pragma unroll
    for (int j = 0; j < 4; ++j) wq[j] = ((const f32x4*)w)[F.lane + 64 * j];
    for (int m = gwave(F); m < M; m += NGW) {
        f32x4 h[4]; float s2 = 0.f;
#pragma unroll
        for (int j = 0; j < 4; ++j) { const v2u hv = ((const v2u*)(hbase + (size_t)m * 2048) + F.lane)[64 * j]; h[j] = (f32x4){bflo(hv.x), bfhi(hv.x), bflo(hv.y), bfhi(hv.y)};
            s2 += (h[j].x * h[j].x + h[j].y * h[j].y) + (h[j].z * h[j].z + h[j].w * h[j].w); }
        const float rs2 = rsqrtf(wave_sum(s2) * (1.f / D) + EPS);
        v2u* o8 = (v2u*)(hn + (size_t)m * D) + F.lane;
#pragma unroll
        for (int j = 0; j < 4; ++j) { const f32x4 y = h[j] * rs2 * wq[j]; o8[64 * j] = (v2u){pk2(y.x, y.y), pk2(y.z, y.w)}; }
    }
}

DI float head_lg2(int h) { return __log2f(1.0f - exp2f(-5.0f - (float)h)); }

DI void ret_passA_unit(Frame& F, int unit) {
    const bf16* QKV = (const bf16*)(F.ws + WS_QKV); bf16* RST = (bf16*)(F.ws + WS_SLOT16);
    const int eh = unit & 1, sc = (unit >> 1) & 7, h = (unit >> 4) & 3, b = unit >> 6;
    const int lane = F.lane, w = F.wave, we = w >> 2, wd = w & 3;
    const float lg2 = head_lg2(h), g128 = exp2f(128.f * lg2), g127 = exp2f(127.f * lg2);
    LAS unsigned char* Kt = F.lds;
    LAS unsigned char* Vt = F.lds + 128 * 544;
    f32x4 acc[4][4];
#pragma unroll
    for (int a = 0; a < 4; ++a)
#pragma unroll
        for (int c = 0; c < 4; ++c) acc[a][c] = (f32x4){0.f, 0.f, 0.f, 0.f};
    v4u TK[8], TV[4];
    const unsigned lo_k = tile_loff<256>(F.tid, 3072), lo_v = tile_loff<128>(F.tid, 3072);
    const bf16* kbase = QKV + ((size_t)b * SEQ + sc * 512) * 3072 + 1024 + h * 256; const bf16* vbase = kbase + 1024 + eh * 128;
    tile_issue<128, 256>(TK, kbase, 3072, lo_k); tile_issue<128, 128>(TV, vbase, 3072, lo_v);
#pragma unroll 1
    for (int j = 0; j < 4; ++j) {
        if (j) {
#pragma unroll
            for (int a = 0; a < 4; ++a)
#pragma unroll
                for (int c = 0; c < 4; ++c) acc[a][c] *= g128; }
        __syncthreads();
        tile_commit<128, 256>(TK, Kt, 544, F.tid); tile_commit<128, 128>(TV, Vt, 288, F.tid);
        if (j < 3) { tile_issue<128, 256>(TK, kbase + (size_t)(j + 1) * 128 * 3072, 3072, lo_k); tile_issue<128, 128>(TV, vbase + (size_t)(j + 1) * 128 * 3072, 3072, lo_v); }
        __syncthreads();
#pragma unroll
        for (int ks = 0; ks < 4; ++ks) {
            bf16x8 vf[4], kf[4];
#pragma unroll
            for (int t = 0; t < 4; ++t) { vf[t] = frag_tr(Vt, 288, we * 64 + t * 16, ks * 32, lane); kf[t] = frag_tr(Kt, 544, wd * 64 + t * 16, ks * 32, lane); }
#pragma unroll
            for (int et = 0; et < 4; ++et)
#pragma unroll
                for (int dt = 0; dt < 4; ++dt) acc[et][dt] = mma(kf[dt], vf[et], acc[et][dt]);
        }
    }
    bf16* dst = RST + ((size_t)((b * 4 + h) * 8 + sc) * 256) * 256;
#pragma unroll
    for (int et = 0; et < 4; ++et)
#pragma unroll
        for (int dt = 0; dt < 4; ++dt) { const int e = eh * 128 + we * 64 + et * 16 + (lane & 15), d = wd * 64 + dt * 16 + 4 * (lane >> 4);
            const f32x4 v = acc[et][dt] * g127;
            *(v2u*)(dst + (size_t)e * 256 + d) = (v2u){pk2(v[0], v[1]), pk2(v[2], v[3])}; }
}

DI void ret_scan_item(Frame& F, int item) {
    bf16* RST = (bf16*)(F.ws + WS_SLOT16);
    const int bh = item >> 13, off = (item & 8191) * 8, h = bh & 3;
    const float g512 = exp2f(512.f * head_lg2(h));
    float run[8]; float zf = 0.f; asm volatile("" : "+v"(zf));
#pragma unroll
    for (int k = 0; k < 8; ++k) run[k] = zf;
    v4u* base = (v4u*)(RST + (size_t)(bh * 8) * 65536 + off);
    v4u in[8];
#pragma unroll
    for (int sc = 0; sc < 8; ++sc) in[sc] = base[(size_t)sc * 8192];
#pragma unroll
    for (int sc = 0; sc < 8; ++sc) {
        v4u o; o.x = pk2(run[0], run[1]); o.y = pk2(run[2], run[3]); o.z = pk2(run[4], run[5]); o.w = pk2(run[6], run[7]);
        base[(size_t)sc * 8192] = o;
        const unsigned cw[4] = {in[sc].x, in[sc].y, in[sc].z, in[sc].w};
#pragma unroll
        for (int k = 0; k < 4; ++k) { run[2 * k] = g512 * run[2 * k] + bflo(cw[k]); run[2 * k + 1] = g512 * run[2 * k + 1] + bfhi(cw[k]); }
    }
}

DI void ret_passC_unit(Frame& F, int unit, bf16* YO) {
    const bf16* QKV = (const bf16*)(F.ws + WS_QKV); const bf16* RST = (const bf16*)(F.ws + WS_SLOT16); const bf16* GZ = (const bf16*)(F.ws + WS_GZ);
    const int qp = unit & 1, sc = (unit >> 1) & 7, h = (unit >> 4) & 3, b = unit >> 6;
    const int lane = F.lane, w = F.wave, wn = w >> 1, wm = w & 1, wn2 = w >> 2, we = w & 3;
    const float lg2 = head_lg2(h), g1 = exp2f(lg2), g128 = exp2f(128.f * lg2);
    LAS unsigned char* Qt = F.lds;
    LAS unsigned char* KV = F.lds + 67584;
    LAS unsigned char* Pt = F.lds + 67584 + 36864;
    LAS float* red = (LAS float*)(F.lds + 67584 + 36864 + 18432);
    const size_t rowsc = (size_t)b * SEQ + sc * 512;
    const bf16* Rbase = RST + (size_t)((b * 4 + h) * 8 + sc) * 65536;
    const bf16* Kb = QKV + rowsc * 3072 + 1024 + h * 256; const bf16* Vb = Kb + 1024;
    v4u T[4];
    const unsigned lo_kv = tile_loff<256>(F.tid, 3072), lo_r = tile_loff<64>(F.tid, 256);
    tile_issue<256, 64>(T, Rbase, 256, lo_r);
#pragma unroll 1
    for (int qi = 0; qi < 2; ++qi) {
        const int i = qp == 0 ? (qi == 0 ? 0 : 3) : (qi == 0 ? 1 : 2);
        const size_t grow0 = rowsc + i * 128;
        f32x4 Y[4][4];
#pragma unroll
        for (int a = 0; a < 4; ++a)
#pragma unroll
            for (int c = 0; c < 4; ++c) Y[a][c] = (f32x4){0.f, 0.f, 0.f, 0.f};
        __syncthreads();
        load_tile(Qt, 528, QKV + grow0 * 3072 + h * 256, 3072, 128, 256, F.tid);
#pragma unroll 1
        for (int ds = 0; ds < 4; ++ds) {
            if (ds) __syncthreads();
            tile_commit<256, 64>(T, KV, 144, F.tid);
            if (ds < 3) tile_issue<256, 64>(T, Rbase + (ds + 1) * 64, 256, lo_r);
            else tile_issue<64, 256>(T, Kb, 3072, lo_kv);
            __syncthreads();
#pragma unroll
            for (int ks = 0; ks < 2; ++ks) {
                bf16x8 qf[4], rf[4];
#pragma unroll
                for (int t = 0; t < 4; ++t) { qf[t] = frag_rm(Qt, 528, wn2 * 64 + t * 16, ds * 64 + ks * 32, lane); rf[t] = frag_rm(KV, 144, we * 64 + t * 16, ks * 32, lane); }
#pragma unroll
                for (int nt = 0; nt < 4; ++nt)
#pragma unroll
                    for (int et = 0; et < 4; ++et) Y[nt][et] = mma(rf[et], qf[nt], Y[nt][et]);
            }
        }
#pragma unroll
        for (int a = 0; a < 4; ++a)
#pragma unroll
            for (int c = 0; c < 4; ++c) Y[a][c] *= g1;
#pragma unroll 1
        for (int kt = 0; kt < 2 * (i + 1); ++kt) {
            const int j = kt >> 1, kh = kt & 1;
            if (j && !kh) {
#pragma unroll
                for (int a = 0; a < 4; ++a)
#pragma unroll
                    for (int c = 0; c < 4; ++c) Y[a][c] *= g128; }
            const size_t krow = (size_t)kt * 64;
            __syncthreads();
            tile_commit<64, 256>(T, KV, 528, F.tid);
            tile_issue<64, 256>(T, Vb + krow * 3072, 3072, lo_kv);
            __syncthreads();
            f32x4 sa[2][2];
#pragma unroll
            for (int a = 0; a < 2; ++a)
#pragma unroll
                for (int c = 0; c < 2; ++c) sa[a][c] = (f32x4){0.f, 0.f, 0.f, 0.f};
#pragma unroll
            for (int ks = 0; ks < 8; ++ks) {
                bf16x8 qf[2], kf[2];
#pragma unroll
                for (int t = 0; t < 2; ++t) { qf[t] = frag_rm(Qt, 528, wn * 32 + t * 16, ks * 32, lane); kf[t] = frag_rm(KV, 528, wm * 32 + t * 16, ks * 32, lane); }
#pragma unroll
                for (int nt = 0; nt < 2; ++nt)
#pragma unroll
                    for (int mt = 0; mt < 2; ++mt) sa[nt][mt] = mma(kf[mt], qf[nt], sa[nt][mt]);
            }
#pragma unroll
            for (int nt = 0; nt < 2; ++nt)
#pragma unroll
                for (int mt = 0; mt < 2; ++mt) { const int n = wn * 32 + nt * 16 + (lane & 15), m = wm * 32 + mt * 16 + 4 * (lane >> 4);
                    f32x4 sv = sa[nt][mt];
                    if (j == i) { const int mk = kh * 64 + m;
#pragma unroll
                        for (int jj = 0; jj < 4; ++jj) sv[jj] = (mk + jj > n) ? 0.f : sv[jj]; }
                    *(LAS v2u*)(Pt + n * 144 + m * 2) = (v2u){pk2(sv[0], sv[1]), pk2(sv[2], sv[3])}; }
            __syncthreads();
            tile_commit<64, 256>(T, KV, 544, F.tid);
            if (kt + 1 < 2 * (i + 1)) tile_issue<64, 256>(T, Kb + (krow + 64) * 3072, 3072, lo_kv);
            else if (qi == 0) tile_issue<256, 64>(T, Rbase, 256, lo_r);
            __syncthreads();
#pragma unroll
            for (int ks = 0; ks < 2; ++ks) {
                bf16x8 pf[4], vf[4];
#pragma unroll
                for (int t = 0; t < 4; ++t) { pf[t] = frag_rm(Pt, 144, wn2 * 64 + t * 16, ks * 32, lane); vf[t] = frag_tr(KV, 544, we * 64 + t * 16, ks * 32, lane); }
#pragma unroll
                for (int nt = 0; nt < 4; ++nt)
#pragma unroll
                    for (int et = 0; et < 4; ++et) Y[nt][et] = mma(vf[et], pf[nt], Y[nt][et]);
            }
        }
        float mean[4], rstd[4];
#pragma unroll
        for (int nt = 0; nt < 4; ++nt) { float sm = 0.f;
#pragma unroll
            for (int et = 0; et < 4; ++et) sm += (Y[nt][et][0] + Y[nt][et][1]) + (Y[nt][et][2] + Y[nt][et][3]);
            sm += __shfl_xor(sm, 16); sm += __shfl_xor(sm, 32);
            if ((lane >> 4) == 0) red[(wn2 * 64 + nt * 16 + lane) * 4 + we] = sm; }
        __syncthreads();
#pragma unroll
        for (int nt = 0; nt < 4; ++nt) { const LAS float* r = red + (wn2 * 64 + nt * 16 + (lane & 15)) * 4; mean[nt] = ((r[0] + r[1]) + (r[2] + r[3])) * (1.f / 256.f); }
        __syncthreads();
#pragma unroll
        for (int nt = 0; nt < 4; ++nt) { float sm = 0.f;
#pragma unroll
            for (int et = 0; et < 4; ++et) { const f32x4 dv = Y[nt][et] - mean[nt]; sm += (dv[0] * dv[0] + dv[1] * dv[1]) + (dv[2] * dv[2] + dv[3] * dv[3]); }
            sm += __shfl_xor(sm, 16); sm += __shfl_xor(sm, 32);
            if ((lane >> 4) == 0) red[(wn2 * 64 + nt * 16 + lane) * 4 + we] = sm; }
        __syncthreads();
#pragma unroll
        for (int nt = 0; nt < 4; ++nt) { const LAS float* r = red + (wn2 * 64 + nt * 16 + (lane & 15)) * 4; rstd[nt] = rsqrtf(((r[0] + r[1]) + (r[2] + r[3])) * (1.f / 256.f) + EPS); }
#pragma unroll
        for (int nt = 0; nt < 4; ++nt)
#pragma unroll
            for (int et = 0; et < 4; ++et) { const int n = wn2 * 64 + nt * 16 + (lane & 15), e = we * 64 + et * 16 + 4 * (lane >> 4);
                const bf16* gp = GZ + (grow0 + n) * 2048 + h * 256 + e;
                const v2u gv = *(const v2u*)gp;
                const f32x4 y = (Y[nt][et] - mean[nt]) * rstd[nt];
                const float o0 = y[0] * silu_f(bflo(gv.x)), o1 = y[1] * silu_f(bfhi(gv.x)), o2 = y[2] * silu_f(bflo(gv.y)), o3 = y[3] * silu_f(bfhi(gv.y));
                *(v2u*)(YO + (gp - GZ)) = (v2u){pk2(o0, o1), pk2(o2, o3)}; }
    }
}

struct SsdPar { const float* conv_w; const float* conv_b; const float* a_log; const float* d_ssd; const float* ssd_norm; };

struct ConvW { f32x4 w[4][2]; f32x4 b[2]; };
DI ConvW load_convw(const float* cw, const float* cb, int col) { ConvW W;
#pragma unroll
    for (int k = 0; k < 4; ++k) { W.w[k][0] = *(const f32x4*)(cw + k * 1536 + col); W.w[k][1] = *(const f32x4*)(cw + k * 1536 + col + 4); }
    W.b[0] = *(const f32x4*)(cb + col); W.b[1] = *(const f32x4*)(cb + col + 4); return W; }
DI void conv8(const bf16* XBC, const ConvW& W, size_t row, int col, float (&o)[8]) {
    const int tin = (int)(row & 4095);
    o[0] = W.b[0][0]; o[1] = W.b[0][1]; o[2] = W.b[0][2]; o[3] = W.b[0][3]; o[4] = W.b[1][0]; o[5] = W.b[1][1]; o[6] = W.b[1][2]; o[7] = W.b[1][3];
#pragma unroll
    for (int k = 0; k < 4; ++k) {
        if (tin - 3 + k >= 0) {
            const v4u x = *(const v4u*)(XBC + (row - 3 + k) * 1536 + col);
            const f32x4 w0 = W.w[k][0], w1 = W.w[k][1];
            o[0] += w0[0] * bflo(x.x); o[1] += w0[1] * bfhi(x.x); o[2] += w0[2] * bflo(x.y); o[3] += w0[3] * bfhi(x.y);
            o[4] += w1[0] * bflo(x.z); o[5] += w1[1] * bfhi(x.z); o[6] += w1[2] * bflo(x.w); o[7] += w1[3] * bfhi(x.w);
        }
    }
#pragma unroll
    for (int k = 0; k < 8; ++k) o[k] = silu_f(o[k]);
}
DI void conv8r(const v4u (&x)[4], const ConvW& W, int tin, float (&o)[8]) {
    o[0] = W.b[0][0]; o[1] = W.b[0][1]; o[2] = W.b[0][2]; o[3] = W.b[0][3]; o[4] = W.b[1][0]; o[5] = W.b[1][1]; o[6] = W.b[1][2]; o[7] = W.b[1][3];
#pragma unroll
    for (int k = 0; k < 4; ++k) {
        if (tin - 3 + k >= 0) { const f32x4 w0 = W.w[k][0], w1 = W.w[k][1];
            o[0] += w0[0] * bflo(x[k].x); o[1] += w0[1] * bfhi(x[k].x); o[2] += w0[2] * bflo(x[k].y); o[3] += w0[3] * bfhi(x[k].y);
            o[4] += w1[0] * bflo(x[k].z); o[5] += w1[1] * bfhi(x[k].z); o[6] += w1[2] * bflo(x[k].w); o[7] += w1[3] * bfhi(x[k].w); }
    }
#pragma unroll
    for (int k = 0; k < 8; ++k) o[k] = silu_f(o[k]);
}
template <int NR, class Fn> DI void conv_rows(const bf16* XBC, const ConvW& W, size_t row0, int col, Fn&& emit) {
    const int tin0 = (int)(row0 & 4095);
    v4u x[NR + 3];
#pragma unroll
    for (int i = 0; i < NR + 3; ++i) x[i] = (tin0 + i - 3 >= 0) ? *(const v4u*)(XBC + (row0 + i - 3) * 1536 + col) : (v4u){0u, 0u, 0u, 0u};
#pragma unroll
    for (int r = 0; r < NR; ++r) { float o[8];
        o[0] = W.b[0][0]; o[1] = W.b[0][1]; o[2] = W.b[0][2]; o[3] = W.b[0][3]; o[4] = W.b[1][0]; o[5] = W.b[1][1]; o[6] = W.b[1][2]; o[7] = W.b[1][3];
#pragma unroll
        for (int k = 0; k < 4; ++k) { const v4u xv = x[r + k]; const f32x4 w0 = W.w[k][0], w1 = W.w[k][1];
            o[0] += w0[0] * bflo(xv.x); o[1] += w0[1] * bfhi(xv.x); o[2] += w0[2] * bflo(xv.y); o[3] += w0[3] * bfhi(xv.y);
            o[4] += w1[0] * bflo(xv.z); o[5] += w1[1] * bfhi(xv.z); o[6] += w1[2] * bflo(xv.w); o[7] += w1[3] * bfhi(xv.w); }
#pragma unroll
        for (int k = 0; k < 8; ++k) o[k] = silu_f(o[k]);
        emit(r, o); }
}
DI v4u pack8(const float (&o)[8], float s) { v4u r; r.x = pk2(o[0] * s, o[1] * s); r.y = pk2(o[2] * s, o[3] * s); r.z = pk2(o[4] * s, o[5] * s); r.w = pk2(o[6] * s, o[7] * s); return r; }

DI float ssd_cumsum(const float* DT, const float* a_log, size_t t0, int grp, int w, int lane, LAS float* cs, LAS float* dtl = nullptr) {
    const int head = grp * 8 + w; const float A = -__expf(a_log[head]);
    const float d0 = DT[(t0 + 2 * lane) * 16 + head], d1 = DT[(t0 + 2 * lane + 1) * 16 + head], v0 = d0 * A, v1 = d1 * A;
    if (dtl) { dtl[w * 128 + 2 * lane] = d0; dtl[w * 128 + 2 * lane + 1] = d1; }
    float x = v0 + v1;
#pragma unroll
    for (int o = 1; o < 64; o <<= 1) { const float t = __shfl_up(x, o); if (lane >= o) x += t; }
    cs[w * 128 + 2 * lane] = x - v1; cs[w * 128 + 2 * lane + 1] = x;
    return __shfl(x, 63);
}

DI void ssd_passA_unit(Frame& F, const SsdPar& P, int unit) {
    const bf16* XBC = (const bf16*)(F.ws + WS_XBC); const float* DT = (const float*)(F.ws + WS_DT);
    bf16* ST = (bf16*)(F.ws + WS_SLOT32); float* CDEC = (float*)(F.ws + WS_MISC);
    const int grp = unit & 1, c = (unit >> 1) & 31, b = unit >> 6;
    const int lane = F.lane, w = F.wave;
    const size_t t0 = (size_t)b * SEQ + c * 128;
    LAS float* cs = (LAS float*)F.lds;
    LAS float* csend = (LAS float*)(F.lds + 4096);
    LAS unsigned char* Bt = F.lds + 4352;
    LAS unsigned char* Xw = F.lds + 4352 + 36864;
    __syncthreads();
    { const float tot = ssd_cumsum(DT, P.a_log, t0, grp, w, lane, cs);
      if (lane == 0) { csend[w] = tot; CDEC[(b * 32 + c) * 16 + grp * 8 + w] = __expf(tot); } }
    { const int cc = F.tid & 15, rb = F.tid >> 4; const ConvW W = load_convw(P.conv_w, P.conv_b, 1024 + grp * 128 + cc * 8);
      conv_rows<4>(XBC, W, t0 + 4 * rb, 1024 + grp * 128 + cc * 8, [&](int r, const float (&o)[8]) { *(LAS v4u*)(Bt + (4 * rb + r) * 288 + cc * 16) = pack8(o, 1.0f); }); }
    for (int hg = 0; hg < 2; ++hg) {
        __syncthreads();
        { const int cc = F.tid & 31, rb = F.tid >> 5, hd = hg * 4 + (cc >> 3); const ConvW W = load_convw(P.conv_w, P.conv_b, grp * 512 + hg * 256 + cc * 8);
          conv_rows<8>(XBC, W, t0 + 8 * rb, grp * 512 + hg * 256 + cc * 8, [&](int r, const float (&o)[8]) { const int rr = 8 * rb + r;
              const float sc = DT[(t0 + rr) * 16 + grp * 8 + hd] * __expf(csend[hd] - cs[hd * 128 + rr]);
              *(LAS v4u*)(Xw + rr * 544 + cc * 16) = pack8(o, sc); }); }
        __syncthreads();
        const int hl = w >> 1, nh = w & 1;
        f32x4 acc[4][4];
#pragma unroll
        for (int a = 0; a < 4; ++a)
#pragma unroll
            for (int q = 0; q < 4; ++q) acc[a][q] = (f32x4){0.f, 0.f, 0.f, 0.f};
#pragma unroll
        for (int ks = 0; ks < 4; ++ks) {
            bf16x8 xf[4], bfr[4];
#pragma unroll
            for (int t = 0; t < 4; ++t) { xf[t] = frag_tr(Xw, 544, hl * 64 + t * 16, ks * 32, lane); bfr[t] = frag_tr(Bt, 288, nh * 64 + t * 16, ks * 32, lane); }
#pragma unroll
            for (int pt = 0; pt < 4; ++pt)
#pragma unroll
                for (int nt = 0; nt < 4; ++nt) acc[pt][nt] = mma(bfr[nt], xf[pt], acc[pt][nt]);
        }
        const int head = grp * 8 + hg * 4 + hl;
        bf16* dst = ST + (size_t)((b * 32 + c) * 16 + head) * 8192;
#pragma unroll
        for (int pt = 0; pt < 4; ++pt)
#pragma unroll
            for (int nt = 0; nt < 4; ++nt) { const int p = pt * 16 + (lane & 15), n = nh * 64 + nt * 16 + 4 * (lane >> 4); const f32x4 v = acc[pt][nt];
                *(v2u*)(dst + p * 128 + n) = (v2u){pk2(v[0], v[1]), pk2(v[2], v[3])}; }
    }
}

DI void ssd_scan_item(Frame& F, int item) {
    bf16* ST = (bf16*)(F.ws + WS_SLOT32); const float* CDEC = (const float*)(F.ws + WS_MISC);
    const int bh = item >> 11, b = bh >> 4, head = bh & 15, off = (item & 2047) * 4;
    float run[4]; float zf = 0.f; asm volatile("" : "+v"(zf));
#pragma unroll
    for (int k = 0; k < 4; ++k) run[k] = zf;
    v2u* base = (v2u*)(ST + (size_t)((b * 32) * 16 + head) * 8192 + off);
    const float* dbase = CDEC + (b * 32) * 16 + head;
    v2u cur[8], nxt[8]; float dc[8], dn[8];
#pragma unroll
    for (int q = 0; q < 8; ++q) { cur[q] = base[(size_t)q * 32768]; dc[q] = dbase[q * 16]; }
#pragma unroll 1
    for (int cb = 0; cb < 4; ++cb) {
        const int cn = cb < 3 ? cb + 1 : cb;
#pragma unroll
        for (int q = 0; q < 8; ++q) { nxt[q] = base[(size_t)(cn * 8 + q) * 32768]; dn[q] = dbase[(cn * 8 + q) * 16]; }
#pragma unroll
        for (int q = 0; q < 8; ++q) {
            base[(size_t)(cb * 8 + q) * 32768] = (v2u){pk2(run[0], run[1]), pk2(run[2], run[3])};
            run[0] = dc[q] * run[0] + bflo(cur[q].x); run[1] = dc[q] * run[1] + bfhi(cur[q].x); run[2] = dc[q] * run[2] + bflo(cur[q].y); run[3] = dc[q] * run[3] + bfhi(cur[q].y); }
#pragma unroll
        for (int q = 0; q < 8; ++q) { cur[q] = nxt[q]; dc[q] = dn[q]; }
    }
}

template <int DBG = 0> DI void ssd_passC_unit(Frame& F, const SsdPar& P, int unit, bf16* YO) {
    const bf16* XBC = (const bf16*)(F.ws + WS_XBC); const float* DT = (const float*)(F.ws + WS_DT);
    const bf16* ST = (const bf16*)(F.ws + WS_SLOT32); const bf16* GZ = (const bf16*)(F.ws + WS_GZ);
    const int grp = unit & 1, c = (unit >> 1) & 31, b = unit >> 6;
    const int lane = F.lane, w = F.wave;
    const size_t t0 = (size_t)b * SEQ + c * 128;
    LAS float* cs = (LAS float*)F.lds;
    LAS float* dtl = (LAS float*)(F.lds + 4096);
    LAS unsigned char* Ct = F.lds + 8192;
    LAS unsigned char* BM = F.lds + 43008;
    LAS unsigned char* Xd = F.lds + 77824;
    LAS unsigned char* Pv = F.lds + 98304;
    LAS float* rowss = (LAS float*)(F.lds + 115712);
    LAS float* wtab = (LAS float*)(F.lds + 123904);
    __syncthreads();
    (void)ssd_cumsum(DT, P.a_log, t0, grp, w, lane, cs, dtl);
    for (int i = F.tid; i < 5 * 128; i += NTHR) { const int k = i >> 7, c4 = (i & 127) * 4;
        *(LAS f32x4*)(wtab + k * 512 + c4) = *(const f32x4*)((k < 4 ? P.conv_w + k * 1536 : P.conv_b) + grp * 512 + c4); }
#pragma unroll 1
    for (int which = 0; which < 2; ++which) {
        const int cc = F.tid & 15, rb = F.tid >> 4; const ConvW W = load_convw(P.conv_w, P.conv_b, 1024 + which * 256 + grp * 128 + cc * 8);
        LAS unsigned char* dstt = which ? Ct : BM;
        conv_rows<4>(XBC, W, t0 + 4 * rb, 1024 + which * 256 + grp * 128 + cc * 8, [&](int r, const float (&o)[8]) { *(LAS v4u*)(dstt + (4 * rb + r) * 272 + cc * 16) = pack8(o, 1.0f); }); }
    const int r0 = F.tid >> 3, cc8 = (F.tid & 7) * 8, tin0 = (int)((t0 + r0) & 4095);
    const int wl = w >> 1, ws = w & 1, wp = w & 1;
    v4u XR[2][4], PVr[2]; v2u ZN[2][2], ZC[2][2];
    const unsigned lo_p = tile_loff<128>(F.tid, 128);
#define SSD_ISSUE(hd_) do { const int hcol_ = grp * 512 + (hd_) * 64 + cc8; \
        _Pragma("unroll") for (int it_ = 0; it_ < 2; ++it_) _Pragma("unroll") for (int k_ = 0; k_ < 4; ++k_) \
            if (tin0 + 64 * it_ - 3 + k_ >= 0) XR[it_][k_] = *(const v4u*)(XBC + (t0 + r0 + 64 * it_ - 3 + k_) * 1536 + hcol_); \
        tile_issue<64, 128>(PVr, ST + (size_t)((b * 32 + c) * 16 + grp * 8 + (hd_)) * 8192, 128, lo_p); \
        _Pragma("unroll") for (int lt_ = 0; lt_ < 2; ++lt_) _Pragma("unroll") for (int pt_ = 0; pt_ < 2; ++pt_) \
            ZN[lt_][pt_] = *(const v2u*)(GZ + (t0 + wl * 32 + lt_ * 16 + (lane & 15)) * 2048 + 1024 + (grp * 8 + (hd_)) * 64 + wp * 32 + pt_ * 16 + 4 * (lane >> 4)); } while (0)
    SSD_ISSUE(0);
    __syncthreads();
    f32x4 cb[2][4];
#pragma unroll
    for (int a = 0; a < 2; ++a)
#pragma unroll
        for (int q = 0; q < 4; ++q) cb[a][q] = (f32x4){0.f, 0.f, 0.f, 0.f};
#pragma unroll
    for (int ks = 0; ks < 4; ++ks) {
        bf16x8 cf[2], bfr[4];
#pragma unroll
        for (int t = 0; t < 2; ++t) cf[t] = frag_rm(Ct, 272, wl * 32 + t * 16, ks * 32, lane);
#pragma unroll
        for (int t = 0; t < 4; ++t) bfr[t] = frag_rm(BM, 272, ws * 64 + t * 16, ks * 32, lane);
#pragma unroll
        for (int lt = 0; lt < 2; ++lt)
#pragma unroll
            for (int st = 0; st < 4; ++st) cb[lt][st] = mma(bfr[st], cf[lt], cb[lt][st]);
    }
#pragma unroll 1
    for (int hd = 0; hd < 8; ++hd) {
        const int head = grp * 8 + hd;
        ConvW W;
#pragma unroll
        for (int k = 0; k < 4; ++k) { W.w[k][0] = *(const LAS f32x4*)(wtab + k * 512 + hd * 64 + cc8); W.w[k][1] = *(const LAS f32x4*)(wtab + k * 512 + hd * 64 + cc8 + 4); }
        W.b[0] = *(const LAS f32x4*)(wtab + 4 * 512 + hd * 64 + cc8); W.b[1] = *(const LAS f32x4*)(wtab + 4 * 512 + hd * 64 + cc8 + 4);
        const float dsk = P.d_ssd[head];
        __syncthreads();
        if (!(DBG & 1))
#pragma unroll
        for (int lt = 0; lt < 2; ++lt) { const int l = wl * 32 + lt * 16 + (lane & 15); const float csl = cs[hd * 128 + l], dgl = dsk * __builtin_amdgcn_rcpf(dtl[hd * 128 + l]);
#pragma unroll
            for (int st = 0; st < 4; ++st) { const int s = ws * 64 + st * 16 + 4 * (lane >> 4); f32x4 m;
                const f32x4 cs4 = *(const LAS f32x4*)(cs + hd * 128 + s);
#pragma unroll
                for (int jj = 0; jj < 4; ++jj) { const float e = __expf(fminf(csl - cs4[jj], 0.f)); m[jj] = (s + jj <= l) ? cb[lt][st][jj] * e : 0.f; m[jj] += (s + jj == l) ? dgl : 0.f; }
                *(LAS v2u*)(BM + l * 272 + s * 2) = (v2u){pk2(m[0], m[1]), pk2(m[2], m[3])}; } }
        if (!(DBG & 2))
#pragma unroll
        for (int it = 0; it < 2; ++it) { float o[8]; conv8r(XR[it], W, tin0 + 64 * it, o);
            *(LAS v4u*)(Xd + (r0 + 64 * it) * 160 + cc8 * 2) = pack8(o, dtl[hd * 128 + r0 + 64 * it]); }
        tile_commit<64, 128>(PVr, Pv, 272, F.tid);
#pragma unroll
        for (int lt = 0; lt < 2; ++lt)
#pragma unroll
            for (int pt = 0; pt < 2; ++pt) ZC[lt][pt] = ZN[lt][pt];
        if (hd < 7) SSD_ISSUE(hd + 1);
        __syncthreads();
        f32x4 yd[2][2], yo[2][2];
#pragma unroll
        for (int a2 = 0; a2 < 2; ++a2)
#pragma unroll
            for (int q = 0; q < 2; ++q) { yd[a2][q] = (f32x4){0.f, 0.f, 0.f, 0.f}; yo[a2][q] = (f32x4){0.f, 0.f, 0.f, 0.f}; }
        if (!(DBG & 4))
#pragma unroll
        for (int ks = 0; ks < 4; ++ks) {
            bf16x8 mf[2], xf[2], cf[2], pf[2];
#pragma unroll
            for (int t = 0; t < 2; ++t) { if (!(DBG & 8)) { mf[t] = frag_rm(BM, 272, wl * 32 + t * 16, ks * 32, lane); xf[t] = frag_tr(Xd, 160, wp * 32 + t * 16, ks * 32, lane); }
                                          if (!(DBG & 16)) { cf[t] = frag_rm(Ct, 272, wl * 32 + t * 16, ks * 32, lane); pf[t] = frag_rm(Pv, 272, wp * 32 + t * 16, ks * 32, lane); } }
#pragma unroll
            for (int lt = 0; lt < 2; ++lt)
#pragma unroll
                for (int pt = 0; pt < 2; ++pt) { if (!(DBG & 8)) yd[lt][pt] = mma(xf[pt], mf[lt], yd[lt][pt]); if (!(DBG & 16)) yo[lt][pt] = mma(pf[pt], cf[lt], yo[lt][pt]); }
        }
#pragma unroll
        for (int lt = 0; lt < 2; ++lt) { const int l = wl * 32 + lt * 16 + (lane & 15); const float ecs = __expf(cs[hd * 128 + l]); float ss = 0.f;
#pragma unroll
            for (int pt = 0; pt < 2; ++pt) { const int p = wp * 32 + pt * 16 + 4 * (lane >> 4);
                const v2u zv = ZC[lt][pt];
                f32x4 y = yd[lt][pt] + ecs * yo[lt][pt];
                y[0] *= silu_f(bflo(zv.x)); y[1] *= silu_f(bfhi(zv.x)); y[2] *= silu_f(bflo(zv.y)); y[3] *= silu_f(bfhi(zv.y));
                ss += (y[0] * y[0] + y[1] * y[1]) + (y[2] * y[2] + y[3] * y[3]);
                if (YO) *(v2u*)(YO + (t0 + l) * 2048 + 1024 + head * 64 + p) = (v2u){pk2(y[0], y[1]), pk2(y[2], y[3])}; }
            ss += __shfl_xor(ss, 16); ss += __shfl_xor(ss, 32);
            if ((lane >> 4) == 0) rowss[(hd * 2 + wp) * 128 + l] = ss; }
    }
#undef SSD_ISSUE
    if (!YO) return;
    asm volatile("s_waitcnt vmcnt(0)" ::: "memory");
    __syncthreads();
    LAS float* rst = (LAS float*)F.lds;
    if (F.tid < 128) { float t = 0.f;
#pragma unroll
        for (int q = 0; q < 16; ++q) t += rowss[q * 128 + F.tid];
        rst[F.tid] = rsqrtf(t * (1.f / 512.f) + EPS); }
    __syncthreads();
    { const int cc = F.tid & 63; const f32x4 n0 = *(const f32x4*)(P.ssd_norm + grp * 512 + cc * 8), n1 = *(const f32x4*)(P.ssd_norm + grp * 512 + cc * 8 + 4);
#pragma unroll 4
      for (int it = 0; it < 16; ++it) { const int r = (F.tid >> 6) + it * 8; const float rs = rst[r];
          v4u* gp = (v4u*)(YO + (t0 + r) * 2048 + 1024 + grp * 512 + cc * 8); const v4u v = *gp;
          v4u o; o.x = pk2(bflo(v.x) * rs * n0[0], bfhi(v.x) * rs * n0[1]); o.y = pk2(bflo(v.y) * rs * n0[2], bfhi(v.y) * rs * n0[3]);
          o.z = pk2(bflo(v.z) * rs * n1[0], bfhi(v.z) * rs * n1[1]); o.w = pk2(bflo(v.w) * rs * n1[2], bfhi(v.w) * rs * n1[3]);
          *gp = o; } }
}

struct S5Par { const float* lam_re; const float* lam_im; const float* log_step; const float* b_re; const float* b_im; const float* c_re; const float* c_im; const float* d_s5; };

DI void s5_build_unit(Frame& F, const S5Par& P, int unit) {
    const int g = unit >> 2, cq = unit & 3;
    bf16* AB = (bf16*)(F.ws + WS_S5MAT + (size_t)g * 262144); bf16* E = AB + 256 * 384;
    LAS f32x2v* pw = (LAS f32x2v*)F.lds;
    LAS f32x2v* Bb = (LAS f32x2v*)(F.lds + 8704);
    LAS f32x2v* Cc = (LAS f32x2v*)(F.lds + 16896);
    LAS float* Km = (LAS float*)(F.lds + 25088);
    LAS f32x2v* cf = (LAS f32x2v*)(F.lds + 29184);
    __syncthreads();
    for (int i = F.tid; i < 17 * 64; i += NTHR) { const int t = i >> 6, p = i & 63;
        const double lr = fmin((double)P.lam_re[g * 64 + p], -1e-4), li = (double)P.lam_im[g * 64 + p], dl = (double)expf(P.log_step[g]);
        const double mag = (double)expf((float)(t * lr * dl)); double sn, cs_; sincos_d(t * li * dl, sn, cs_);
        pw[i] = (f32x2v){(float)(mag * cs_), (float)(mag * sn)};
        if (t == 1) { const double den = lr * lr + li * li, nr = mag * cs_ - 1.0, ni = mag * sn; cf[p] = (f32x2v){(float)((nr * lr + ni * li) / den), (float)((ni * lr - nr * li) / den)}; } }
    __syncthreads();
    for (int i = F.tid; i < 1024; i += NTHR) { const int p = i >> 4; const f32x2v c = cf[p]; const float br = P.b_re[g * 1024 + i], bi = P.b_im[g * 1024 + i];
        Bb[i] = (f32x2v){c.x * br - c.y * bi, c.x * bi + c.y * br}; }
    for (int i = F.tid; i < 1024; i += NTHR) Cc[i] = (f32x2v){P.c_re[g * 1024 + i], P.c_im[g * 1024 + i]};
    __syncthreads();
    for (int i = F.tid; i < 1024; i += NTHR) { const int t = i >> 6, cl = (i >> 4) & 3, c2 = i & 15, c = cq * 4 + cl; float acc = 0.f;
        for (int p = 0; p < 64; ++p) { const f32x2v cc = Cc[c * 64 + p], a = pw[t * 64 + p], bb = Bb[p * 16 + c2];
            const float tr = cc.x * a.x - cc.y * a.y, ti = cc.x * a.y + cc.y * a.x; acc += tr * bb.x - ti * bb.y; }
        Km[i] = acc; }
    __syncthreads();
    for (int i = F.tid; i < 64 * 48; i += NTHR) { const int rl = i / 48, c8 = (i % 48) * 8, l = rl >> 2, cl = rl & 3, c = cq * 4 + cl, row = l * 16 + c; float v[8];
        if (c8 < 256) { const int s = c8 >> 4, c2 = c8 & 15;
#pragma unroll
            for (int k = 0; k < 8; ++k) v[k] = s <= l ? Km[((l - s) * 4 + cl) * 16 + c2 + k] : 0.f;
        } else { const bool im = c8 >= 320; const int p0 = c8 - (im ? 320 : 256);
#pragma unroll
            for (int k = 0; k < 8; ++k) { const f32x2v cc = Cc[c * 64 + p0 + k], a = pw[(l + 1) * 64 + p0 + k];
                v[k] = im ? -(cc.x * a.y + cc.y * a.x) : (cc.x * a.x - cc.y * a.y); } }
        *(v4u*)(AB + (size_t)row * 384 + c8) = (v4u){pk2(v[0], v[1]), pk2(v[2], v[3]), pk2(v[4], v[5]), pk2(v[6], v[7])}; }
    for (int i = F.tid; i < 32 * 32; i += NTHR) { const int rl = i >> 5, c8 = (i & 31) * 8, p = cq * 16 + (rl & 15), s = c8 >> 4, c2 = c8 & 15; const bool im = rl >= 16; const int row = (im ? 64 : 0) + p; float v[8];
        const f32x2v a = pw[(15 - s) * 64 + p];
#pragma unroll
        for (int k = 0; k < 8; ++k) { const f32x2v bb = Bb[p * 16 + c2 + k]; v[k] = im ? (a.x * bb.y + a.y * bb.x) : (a.x * bb.x - a.y * bb.y); }
        *(v4u*)(E + (size_t)row * 256 + c8) = (v4u){pk2(v[0], v[1]), pk2(v[2], v[3]), pk2(v[4], v[5]), pk2(v[6], v[7])}; }
}

DI void s5_gemmA_unit(Frame& F, int unit) {
    const bf16* HN = (const bf16*)(F.ws + WS_SLOT32); float* EO = (float*)(F.ws + WS_S5E);
    const int gp = unit >> 3, te = unit & 7, b = te >> 1, lane = F.lane, w = F.wave, g = 2 * gp + (w & 1), i = lane & 15, gq = lane >> 4;
    LAS unsigned char* Et = F.lds + (w & 1) * 67584;
    __syncthreads();
    load_tile(F.lds, 528, (const bf16*)(F.ws + WS_S5MAT + (size_t)(2 * gp) * 262144) + 256 * 384, 256, 128, 256, F.tid);
    load_tile(F.lds + 67584, 528, (const bf16*)(F.ws + WS_S5MAT + (size_t)(2 * gp + 1) * 262144) + 256 * 384, 256, 128, 256, F.tid);
    __syncthreads();
#pragma unroll 1
    for (int t = 0; t < 2; ++t) { const int k0 = (te & 1) * 128 + ((w >> 1) * 2 + t) * 16;
        const bf16* hp = HN + ((size_t)b * SEQ + 16 * (k0 + i) + (gq >> 1)) * D + 16 * g + 8 * (gq & 1);
        bf16x8 uf[8];
#pragma unroll
        for (int ks = 0; ks < 8; ++ks) uf[ks] = *(const bf16x8*)(hp + (size_t)(2 * ks) * D);
        f32x4 acc[8];
#pragma unroll
        for (int mt = 0; mt < 8; ++mt) acc[mt] = (f32x4){0.f, 0.f, 0.f, 0.f};
#pragma unroll
        for (int ks = 0; ks < 8; ++ks) {
#pragma unroll
            for (int mt = 0; mt < 8; ++mt) acc[mt] = mma(frag_rm(Et, 528, mt * 16, ks * 32, lane), uf[ks], acc[mt]);
            if (ks & 1) __builtin_amdgcn_sched_barrier(0); }
        float* dst = EO + ((size_t)((b * 256 + k0 + i) * 64 + g)) * 128 + 4 * gq;
#pragma unroll
        for (int mt = 0; mt < 8; ++mt) *(f32x4*)(dst + mt * 16) = acc[mt]; }
}

DI void s5_scan_task(Frame& F, const float* lam_re, const float* lam_im, const float* log_step, int task, int dbg) {
    const float* EO = (const float*)(F.ws + WS_S5E); bf16* XO = (bf16*)(F.ws + WS_S5X);
    const int b = task >> 6, g = task & 63, p = F.lane;
    f32x2v a;
    { const double lr = fmin((double)lam_re[g * 64 + p], -1e-4), li = (double)lam_im[g * 64 + p], dl = (double)expf(log_step[g]);
      const double mag = (double)expf((float)(16.0 * lr * dl)); double s, c; sincos_d(16.0 * li * dl, s, c); a = (f32x2v){(float)(mag * c), (float)(mag * s)}; }
    if (dbg == 6) a = (f32x2v){0.f, 0.f};
    float rr = 0.f, ri = 0.f;
    const float* ep = EO + ((size_t)(b * 256) * 64 + g) * 128 + p; bf16* xp = XO + ((size_t)(b * 256) * 64 + g) * 128 + p;
    float er[16], ei[16], fr_[16], fi_[16];
#pragma unroll
    for (int s2 = 0; s2 < 16; ++s2) { er[s2] = ep[(size_t)s2 * 8192]; ei[s2] = ep[(size_t)s2 * 8192 + 64]; }
#pragma unroll 1
    for (int kb = 0; kb < 16; ++kb) {
        const int kn = kb < 15 ? kb + 1 : kb;
#pragma unroll
        for (int s2 = 0; s2 < 16; ++s2) { fr_[s2] = ep[(size_t)(kn * 16 + s2) * 8192]; fi_[s2] = ep[(size_t)(kn * 16 + s2) * 8192 + 64]; }
#pragma unroll
        for (int s2 = 0; s2 < 16; ++s2) { bf16* xo = xp + (size_t)(kb * 16 + s2) * 8192;
            xo[0] = (bf16)f2bf(rr); xo[64] = (bf16)f2bf(ri);
            const float nr = a.x * rr - a.y * ri + er[s2], ni = a.x * ri + a.y * rr + ei[s2]; rr = nr; ri = ni; }
#pragma unroll
        for (int s2 = 0; s2 < 16; ++s2) { er[s2] = fr_[s2]; ei[s2] = fi_[s2]; }
    }
}

DI float gelu_tanh(float v) { const float u = 0.7978845608028654f * (v + 0.044715f * v * v * v); const float t = 1.0f - 2.0f * __builtin_amdgcn_rcpf(__expf(2.0f * u) + 1.0f); return 0.5f * v * (1.0f + t); }

DI void s5_gemmB_unit(Frame& F, const float* d_s5, int unit) {
    const bf16* HN = (const bf16*)(F.ws + WS_SLOT32); const bf16* XO = (const bf16*)(F.ws + WS_S5X); bf16* Y = (bf16*)(F.ws + WS_Y);
    const int g = unit >> 2, lh = (unit >> 1) & 1, th = unit & 1, lane = F.lane, w = F.wave, i = lane & 15, gq = lane >> 4;
    const bf16* AB = (const bf16*)(F.ws + WS_S5MAT + (size_t)g * 262144) + (size_t)(128 * lh) * 384;
    LAS unsigned char* A = F.lds;
    __syncthreads();
    load_tile(A, 784, AB, 384, 128, 384, F.tid);
    __syncthreads();
    const int colg = 16 * g + 4 * gq;
    const f32x4 dv = *(const f32x4*)(d_s5 + colg);
#pragma unroll 1
    for (int t = 0; t < 4; ++t) { const int nt = w * 4 + t, b = 2 * th + (nt >> 4), k0 = (nt & 15) * 16;
        const bf16* hp = HN + ((size_t)b * SEQ + 16 * (k0 + i) + (gq >> 1)) * D + 16 * g + 8 * (gq & 1);
        const bf16* xp = XO + ((size_t)((b * 256 + k0 + i) * 64 + g)) * 128 + 8 * gq;
        bf16x8 uf[12];
#pragma unroll
        for (int ks = 0; ks < 8; ++ks) uf[ks] = *(const bf16x8*)(hp + (size_t)(2 * ks) * D);
#pragma unroll
        for (int ks = 0; ks < 4; ++ks) uf[8 + ks] = *(const bf16x8*)(xp + ks * 32);
        f32x4 acc[8];
#pragma unroll
        for (int mt = 0; mt < 8; ++mt) acc[mt] = (f32x4){0.f, 0.f, 0.f, 0.f};
#pragma unroll
        for (int ks = 0; ks < 12; ++ks) {
#pragma unroll
            for (int mt = 0; mt < 8; ++mt) acc[mt] = mma(frag_rm(A, 784, mt * 16, ks * 32, lane), uf[ks], acc[mt]);
            __builtin_amdgcn_sched_barrier(0); }
#pragma unroll
        for (int mt = 0; mt < 8; ++mt) { const size_t tok = (size_t)b * SEQ + 16 * (k0 + i) + 8 * lh + mt;
            const v2u hv = *(const v2u*)(HN + tok * D + colg);
            const float y0 = gelu_tanh(acc[mt][0] + dv[0] * bflo(hv.x)), y1 = gelu_tanh(acc[mt][1] + dv[1] * bfhi(hv.x));
            const float y2 = gelu_tanh(acc[mt][2] + dv[2] * bflo(hv.y)), y3 = gelu_tanh(acc[mt][3] + dv[3] * bfhi(hv.y));
            *(v2u*)(Y + tok * D + colg) = (v2u){pk2(y0, y1), pk2(y2, y3)}; } }
}

#ifndef CONV_OLD
#define CONV_OLD 0
#endif
#ifndef FUSE_E5
#define FUSE_E5 1
#endif
#ifndef FUSE_DOWN
#define FUSE_DOWN 15
#endif
#ifndef REP_BAR
#define REP_BAR 1
#endif
#ifndef REP_CONV
#define REP_CONV 1
#endif
#ifndef REP_ROW
#define REP_ROW 1
#endif
#ifndef REP_RC
#define REP_RC 1
#endif
#ifndef REP_SC
#define REP_SC 1
#endif
#ifndef SC_DBG
#define SC_DBG 0
#endif
#ifndef REP_GEMM
#define REP_GEMM 1
#endif
#ifndef REP_S5A
#define REP_S5A 1
#endif
#ifndef REP_S5S
#define REP_S5S 1
#endif
#ifndef REP_S5B
#define REP_S5B 1
#endif
#ifndef REP_RA
#define REP_RA 1
#endif
#ifndef REP_SA
#define REP_SA 1
#endif
#ifndef SKIP_EVEN
#define SKIP_EVEN 0
#endif
#ifndef SKIP_ODD
#define SKIP_ODD 0
#endif
#ifdef TPROBE
#ifndef TP_CU
#define TP_CU 0
#endif
#define TPK_B(id) do { if (TPROBE == (id) && blockIdx.x == TP_CU && threadIdx.x == 0) { const unsigned long long t_ = __builtin_amdgcn_s_memrealtime(); ((LAS unsigned*)(F.lds + 146432))[2] = (unsigned)t_; } } while (0)
#define TPK_E(id) do { if (TPROBE == (id) && blockIdx.x == TP_CU && threadIdx.x == 0) { const unsigned long long t_ = __builtin_amdgcn_s_memrealtime(); ((LAS unsigned*)(F.lds + 146432))[0] += (unsigned)t_ - ((LAS unsigned*)(F.lds + 146432))[2]; } } while (0)
#else
#define TPK_B(id) do {} while (0)
#define TPK_E(id) do {} while (0)
#endif
DI int opq(int v) { asm volatile("" : "+s"(v)); return v; }
#define CS_STR2(x) #x
#define CS_STR(x) CS_STR2(x)
#ifdef CODE_SHIFT
#define CODE_SHIFT_STR CS_STR(CODE_SHIFT)
#endif
struct Args { const float* in[N_IN]; float* out; unsigned char* ws; };
constexpr int CW_BAR = 1024;

#define PHASE() do { unsigned z_ = 0u; asm volatile("" : "+s"(z_)); int l_ = __builtin_amdgcn_mbcnt_hi(~0u, __builtin_amdgcn_mbcnt_lo(~0u, z_)); int w_ = wave0; asm volatile("" : "+s"(w_)); \
        int g_ = gridDim.x, b_ = blockIdx.x; asm volatile("" : "+s"(g_), "+s"(b_)); F.G = g_; F.bid = b_; F.vcu = (g_ % 8 == 0) ? (b_ % 8) * (g_ / 8) + b_ / 8 : b_; F.lane = l_; F.wave = w_; F.tid = w_ * 64 + l_; F.out = (float*)(GAS float*)lds_ptr(F, N_IN); F.ws = (unsigned char*)(GAS unsigned char*)lds_ptr(F, N_IN + 1); } while (0)
#define WSP(T, off) ((T*)(F.ws + (off)))
#define GRID_BAR() do { PHASE(); TPK_B(50); XcdBarrier xb_; xb_.bar = (unsigned*)(F.ws + WS_CTL) + CW_BAR; xb_.x = xb_xcc_id(); xb_.tid = F.tid; xb_.st = (volatile LAS unsigned*)(F.lds + MISC_OFF) + 8; xcd_barrier(xb_); if (REP_BAR == 2) xcd_barrier(xb_); PHASE(); TPK_E(50); } while (0)
template <int layer> __device__ __forceinline__ void run_layer(Frame& F, const int wave0) {
        const int j = layer >> 1;
        if ((layer & 1) == 0) {
            if (!opq(SKIP_EVEN)) {
            { pg8::Gemm g{WSP(bf16, WS_SLOT32), WSP(bf16, WS_SLOT16), M, INP_PAD, D}; pg8::StaticOrder S; S.init(M, INP_PAD, F.G, F.bid);
              pg8::EpiInProj E{WSP(bf16, WS_QKV), WSP(bf16, WS_GZ), WSP(bf16, WS_XBC), WSP(float, WS_DT), (const float*)(F.ws + WS_ROPE), INP(I_DT_BIAS) + j * 16};
              pg8::gemm_phase<pg8::EpiInProj, pg8::StaticOrder, true, true>(F.lds, g, S, E, F.tid); }
#if REP_GEMM == 2 || defined(REP_G_INP)
            { PHASE(); pg8::Gemm g{WSP(bf16, WS_SLOT32), WSP(bf16, WS_SLOT16), M, INP_PAD, D}; pg8::StaticOrder S; S.init(M, INP_PAD, F.G, F.bid);
              pg8::EpiInProj E{WSP(bf16, WS_QKV), WSP(bf16, WS_GZ), WSP(bf16, WS_XBC), WSP(float, WS_DT), (const float*)(F.ws + WS_ROPE), INP(I_DT_BIAS) + j * 16};
              pg8::gemm_phase<pg8::EpiInProj, pg8::StaticOrder, true, true>(F.lds, g, S, E, F.tid); }
#endif
            GRID_BAR();
            for (int rep_ = 0; rep_ < REP_RA; ++rep_) for (int u = F.vcu; u < 256; u += F.G) ret_passA_unit(F, u);
            { const SsdPar SP{INP(I_CONV_W) + (size_t)j * 4 * 1536, INP(I_CONV_B) + j * 1536, INP(I_A_LOG) + j * 16, INP(I_D_SSD) + j * 16, INP(I_SSD_NORM) + j * 1024};
              for (int rep_ = 0; rep_ < REP_SA; ++rep_) for (int u = F.vcu; u < 256; u += F.G) ssd_passA_unit(F, SP, u); }
            GRID_BAR();
            for (int it = (F.bid * NTHR + F.tid); it < 131072; it += (F.G * NTHR)) ret_scan_item(F, it);
            for (int it = (F.bid * NTHR + F.tid); it < 131072; it += (F.G * NTHR)) ssd_scan_item(F, it);
            GRID_BAR();
#if REP_RC == 2
            if (layer == 0) for (int u = F.vcu; u < 256; u += F.G) ret_passC_unit(F, u, (bf16*)F.out);
#endif
            for (int u = F.vcu; u < 256; u += F.G) ret_passC_unit(F, u, WSP(bf16, WS_GZ));
            { const SsdPar SP{INP(I_CONV_W) + (size_t)j * 4 * 1536, INP(I_CONV_B) + j * 1536, INP(I_A_LOG) + j * 16, INP(I_D_SSD) + j * 16, INP(I_SSD_NORM) + j * 1024};
#if REP_SC >= 2
              if (layer == 0) for (int u = F.vcu; u < 256; u += F.G) ssd_passC_unit<SC_DBG>(F, SP, u, REP_SC == 2 ? (bf16*)F.out : (bf16*)nullptr);
#endif
              for (int u = F.vcu; u < 256; u += F.G) ssd_passC_unit(F, SP, u, WSP(bf16, WS_GZ)); }
            GRID_BAR();
            }
            __syncthreads();
            convert_weight(F, INP(I_W_UP) + (size_t)layer * D * FF, D, FF, WSP(bf16, WS_SLOT16), 0);
#if REP_CONV == 2
            convert_weight(F, INP(I_W_UP) + (size_t)layer * D * FF, D, FF, WSP(bf16, WS_SLOT16), 0);
#endif
            convert_weight(F, INP(I_W_DOWN) + (size_t)layer * FF * D, FF, D, WSP(bf16, WS_SLOT16) + (size_t)FF * D, 0);
#if REP_CONV == 2
            convert_weight(F, INP(I_W_DOWN) + (size_t)layer * FF * D, FF, D, WSP(bf16, WS_SLOT16) + (size_t)FF * D, 0);
#endif
            __syncthreads();
            if (FUSE_E5 && F.G == 256 && !opq(SKIP_EVEN)) {
            { pg8::Gemm g{WSP(bf16, WS_GZ), WSP(bf16, WS_W4), M, D, 2048}; pg8::StaticOrder S; S.init(M, D, F.G, F.bid);
              pg8::EpiResNorm<layer == 0> E{layer == 0 ? (const void*)INP(I_X) : (const void*)F.out, (bf16*)F.out, WSP(bf16, WS_SLOT32), INP(I_POST_MIX) + layer * D, INP(I_PRE_MLP) + layer * D,
                                            WSP(unsigned long long, WS_XBUF_A), (unsigned*)(F.ws + WS_CTL) + CW_PANEL, 32u * (unsigned)(layer / 2 + 1), EPS};
              TPK_B(8); pg8::gemm_phase<pg8::EpiResNorm<layer == 0>, pg8::StaticOrder, true, true>(F.lds, g, S, E, F.tid); TPK_E(8); }
            __syncthreads();
            TPK_B(7); GRID_BAR(); TPK_E(7);
            } else {
            if (!opq(SKIP_EVEN)) {
            { pg8::Gemm g{WSP(bf16, WS_GZ), WSP(bf16, WS_W4), M, D, 2048}; pg8::StaticOrder S; S.init(M, D, F.G, F.bid);
              pg8::EpiBf16 E{WSP(bf16, WS_M32A), D};
              TPK_B(9); pg8::gemm_phase<pg8::EpiBf16, pg8::StaticOrder, true, true>(F.lds, g, S, E, F.tid); TPK_E(9); }
            } else zero_fill(F, WSP(bf16, WS_M32A), (size_t)M * D * 2);
            TPK_B(10); GRID_BAR(); TPK_E(10);
            TPK_B(11);
            if (layer == 0) row_phase<true, false>(F, WSP(bf16, WS_M32A), INP(I_X), F.out, INP(I_POST_MIX) + layer * D, INP(I_PRE_MLP) + layer * D, WSP(bf16, WS_SLOT32));
            else row_phase<false, false>(F, WSP(bf16, WS_M32A), F.out, F.out, INP(I_POST_MIX) + layer * D, INP(I_PRE_MLP) + layer * D, WSP(bf16, WS_SLOT32));
            TPK_E(11);
            TPK_B(12); GRID_BAR(); TPK_E(12);
            }
        } else {
            if (opq(SKIP_ODD) == 2) {
                const v4u* s_ = (const v4u*)WSP(bf16, WS_SLOT32); v4u* d_ = (v4u*)WSP(bf16, WS_Y);
                for (size_t i_ = (size_t)F.bid * NTHR + F.tid; i_ < (size_t)M * D / 8; i_ += (size_t)F.G * NTHR) d_[i_] = s_[i_];
                GRID_BAR();
            }
            if (opq(SKIP_ODD) == 0 || opq(SKIP_ODD) >= 3) {
            for (int rep_ = 0; rep_ < REP_S5A; ++rep_) for (int u = F.vcu; u < 256; u += F.G) s5_gemmA_unit(F, u);
            GRID_BAR();
            for (int rep_ = 0; rep_ < REP_S5B; ++rep_) for (int u = F.vcu; u < 256; u += F.G) {
                __syncthreads();
                if (F.wave < 2) s5_scan_task(F, INP(I_LAM_RE) + j * 4096, INP(I_LAM_IM) + j * 4096, INP(I_LOG_STEP) + j * 64, (2 * (u & 1) + F.wave) * 64 + (u >> 2), 0);
                asm volatile("s_waitcnt vmcnt(0)" ::: "memory");
                s5_gemmB_unit(F, INP(I_D_S5) + j * 1024, u); }
            GRID_BAR();
            }
            __syncthreads();
            convert_weight(F, INP(I_W_UP) + (size_t)layer * D * FF, D, FF, WSP(bf16, WS_SLOT16), 0);
            convert_weight(F, INP(I_W_DOWN) + (size_t)layer * FF * D, FF, D, layer == 1 ? WSP(bf16, WS_DOWN1) : WSP(bf16, WS_SLOT16) + (size_t)FF * D, 0);
            __syncthreads();
            if (opq(SKIP_ODD) != 1) {
            { pg8::Gemm g{WSP(bf16, WS_Y), WSP(bf16, WS_W4), M, 2048, D}; pg8::StaticOrder S; S.init(M, 2048, F.G, F.bid);
              pg8::EpiGlu E{WSP(bf16, WS_M32B), D};
              pg8::gemm_phase<pg8::EpiGlu, pg8::StaticOrder, true, true>(F.lds, g, S, E, F.tid); }
#if REP_GEMM == 2 || defined(REP_G_GLU)
            { PHASE(); pg8::Gemm g{WSP(bf16, WS_Y), WSP(bf16, WS_W4), M, 2048, D}; pg8::StaticOrder S; S.init(M, 2048, F.G, F.bid);
              pg8::EpiGlu E{WSP(bf16, WS_M32B), D};
              pg8::gemm_phase<pg8::EpiGlu, pg8::StaticOrder, true, true>(F.lds, g, S, E, F.tid); }
#endif
            } else zero_fill(F, WSP(bf16, WS_M32B), (size_t)M * D * 2);
            GRID_BAR();
            row_phase<false, false>(F, WSP(bf16, WS_M32B), F.out, F.out, INP(I_POST_MIX) + layer * D, INP(I_PRE_MLP) + layer * D, WSP(bf16, WS_SLOT32));
            GRID_BAR();
        }
        { pg8::Gemm g{WSP(bf16, WS_SLOT32), WSP(bf16, WS_SLOT16), M, FF, D}; pg8::StaticOrder S; S.init(M, FF, F.G, F.bid);
          pg8::EpiRelu2 E{WSP(bf16, WS_U), FF};
          TPK_B(13); TPK_B(15); pg8::gemm_phase<pg8::EpiRelu2, pg8::StaticOrder, true, true>(F.lds, g, S, E, F.tid); TPK_E(13); }
#if REP_GEMM == 2 || defined(REP_G_UP)
            { PHASE(); pg8::Gemm g{WSP(bf16, WS_SLOT32), WSP(bf16, WS_SLOT16), M, FF, D}; pg8::StaticOrder S; S.init(M, FF, F.G, F.bid);
          pg8::EpiRelu2 E{WSP(bf16, WS_U), FF};
          pg8::gemm_phase<pg8::EpiRelu2, pg8::StaticOrder, true, true>(F.lds, g, S, E, F.tid); }
#endif
        TPK_B(14); GRID_BAR(); TPK_E(14); TPK_E(15);
        __syncthreads();
        if ((layer & 1) == 0) { convert_weight(F, INP(I_W_GLU_A) + (size_t)j * D * D, D, D, WSP(bf16, WS_W4), 1); convert_weight(F, INP(I_W_GLU_B) + (size_t)j * D * D, D, D, WSP(bf16, WS_W4), 2); }
#if REP_CONV == 2
        if ((layer & 1) == 0) { convert_weight(F, INP(I_W_GLU_A) + (size_t)j * D * D, D, D, WSP(bf16, WS_W4), 1); convert_weight(F, INP(I_W_GLU_B) + (size_t)j * D * D, D, D, WSP(bf16, WS_W4), 2); }
#endif
        if (layer == 1 && !CONV_OLD) {
            convert_weight(F, INP(I_W_IN) + (size_t)D * INP, D, INP, WSP(bf16, WS_SLOT16), 0);
#if REP_CONV == 2
            convert_weight(F, INP(I_W_IN) + (size_t)D * INP, D, INP, WSP(bf16, WS_SLOT16), 0);
#endif
            zero_fill(F, WSP(bf16, WS_SLOT16) + (size_t)6688 * D, (size_t)(INP_PAD - 6688) * D * 2);
            convert_weight(F, INP(I_W_OUT) + (size_t)2048 * D, 2048, D, WSP(bf16, WS_W4), 0);
#if REP_CONV == 2
            convert_weight(F, INP(I_W_OUT) + (size_t)2048 * D, 2048, D, WSP(bf16, WS_W4), 0);
#endif
        }
        __syncthreads();
        if (((FUSE_DOWN >> layer) & 1) && layer == DEPTH - 1 && F.G == 256) {
            { pg8::Gemm g{WSP(bf16, WS_U), WSP(bf16, WS_SLOT16) + (size_t)FF * D, M, D, FF}; pg8::StaticOrder S; S.init(M, D, F.G, F.bid);
              pg8::EpiResNorm<false, true> E{(const void*)F.out, (bf16*)F.out, nullptr, INP(I_POST_MLP) + layer * D, nullptr,
                                             WSP(unsigned long long, WS_XBUF_B), (unsigned*)(F.ws + WS_CTL) + CW_PANEL + 4096, 32u * (unsigned)__builtin_popcount(FUSE_DOWN & ((2 << layer) - 1)), EPS};
              pg8::gemm_phase<pg8::EpiResNorm<false, true>, pg8::StaticOrder, true, true>(F.lds, g, S, E, F.tid); }
        } else if (((FUSE_DOWN >> layer) & 1) && layer < DEPTH - 1 && F.G == 256) {
            { pg8::Gemm g{WSP(bf16, WS_U), layer == 1 ? WSP(bf16, WS_DOWN1) : WSP(bf16, WS_SLOT16) + (size_t)FF * D, M, D, FF}; pg8::StaticOrder S; S.init(M, D, F.G, F.bid);
              pg8::EpiResNorm<false> E{(const void*)F.out, (bf16*)F.out, WSP(bf16, WS_SLOT32), INP(I_POST_MLP) + layer * D, INP(I_PRE_MIX) + (layer + 1) * D,
                                       WSP(unsigned long long, WS_XBUF_B), (unsigned*)(F.ws + WS_CTL) + CW_PANEL + 4096, 32u * (unsigned)__builtin_popcount(FUSE_DOWN & ((2 << layer) - 1)), EPS};
              TPK_B(8); pg8::gemm_phase<pg8::EpiResNorm<false>, pg8::StaticOrder, true, true>(F.lds, g, S, E, F.tid); TPK_E(8); }
            __syncthreads();
#ifdef XTRA_BAR
            GRID_BAR();
#endif
#ifdef HN_SEP
            GRID_BAR();
            hn_from_h(F, (const bf16*)F.out, INP(I_PRE_MIX) + (layer + 1) * D, WSP(bf16, WS_SLOT32));
#endif
        } else {
        { pg8::Gemm g{WSP(bf16, WS_U), layer == 1 ? WSP(bf16, WS_DOWN1) : WSP(bf16, WS_SLOT16) + (size_t)FF * D, M, D, FF}; pg8::StaticOrder S; S.init(M, D, F.G, F.bid);
          pg8::EpiBf16 E{WSP(bf16, WS_M32B), D};
          if (layer < DEPTH - 1) TPK_B(9); pg8::gemm_phase<pg8::EpiBf16, pg8::StaticOrder, true, true>(F.lds, g, S, E, F.tid); if (layer < DEPTH - 1) TPK_E(9); }
#if REP_GEMM == 2 || defined(REP_G_DOWN)
            { PHASE(); pg8::Gemm g{WSP(bf16, WS_U), layer == 1 ? WSP(bf16, WS_DOWN1) : WSP(bf16, WS_SLOT16) + (size_t)FF * D, M, D, FF}; pg8::StaticOrder S; S.init(M, D, F.G, F.bid);
          pg8::EpiBf16 E{WSP(bf16, WS_M32B), D};
          pg8::gemm_phase<pg8::EpiBf16, pg8::StaticOrder, true, true>(F.lds, g, S, E, F.tid); }
#endif
        if (layer < DEPTH - 1) TPK_B(10); GRID_BAR(); if (layer < DEPTH - 1) TPK_E(10);
        if (layer < DEPTH - 1) { TPK_B(11); row_phase<false, false>(F, WSP(bf16, WS_M32B), F.out, F.out, INP(I_POST_MLP) + layer * D, INP(I_PRE_MIX) + (layer + 1) * D, WSP(bf16, WS_SLOT32)); TPK_E(11); }
        else row_phase<false, true>(F, WSP(bf16, WS_M32B), F.out, F.out, INP(I_POST_MLP) + layer * D, nullptr, nullptr);
        if (layer == 0 || layer == 2) GRID_BAR();
        }
        if (layer == 1 && CONV_OLD) {
            __syncthreads();
            convert_weight(F, INP(I_W_IN) + (size_t)D * INP, D, INP, WSP(bf16, WS_SLOT16), 0);
            zero_fill(F, WSP(bf16, WS_SLOT16) + (size_t)6688 * D, (size_t)(INP_PAD - 6688) * D * 2);
            convert_weight(F, INP(I_W_OUT) + (size_t)2048 * D, 2048, D, WSP(bf16, WS_W4), 0);
        }
        if (layer == 0 || layer == 2) {
            const S5Par P5{INP(I_LAM_RE) + j * 4096, INP(I_LAM_IM) + j * 4096, INP(I_LOG_STEP) + j * 64, INP(I_B_RE) + (size_t)j * 65536, INP(I_B_IM) + (size_t)j * 65536,
                           INP(I_C_RE) + (size_t)j * 65536, INP(I_C_IM) + (size_t)j * 65536, INP(I_D_S5) + j * 1024};
            for (int u = F.bid; u < 256; u += F.G) s5_build_unit(F, P5, u);
        }
        if (layer < DEPTH - 1) { TPK_B(7); TPK_B(12); GRID_BAR(); TPK_E(7); TPK_E(12); }

}

__global__ void __launch_bounds__(NTHR, 2) trunk_fwd(Args args) {
    extern __shared__ __attribute__((aligned(16))) unsigned char lds[];
#ifdef CODE_SHIFT
    asm volatile(".rept " CODE_SHIFT_STR "\n\ts_nop 0\n\t.endr" ::: "memory");
#endif
    Frame F;
    F.lds = (LAS unsigned char*)lds;
    F.G = gridDim.x; F.bid = blockIdx.x;
    { const int t = threadIdx.x;
      for (int u = t; u < (LDS_BYTES - MISC_OFF) / 4; u += NTHR) ((LAS unsigned*)(F.lds + MISC_OFF))[u] = 0u;
      __syncthreads();
      if (t < N_IN + 2) ((LAS unsigned long long*)(F.lds + MISC_OFF + 256))[t] = t < N_IN ? (unsigned long long)args.in[t] : (t == N_IN ? (unsigned long long)args.out : (unsigned long long)args.ws);
      __syncthreads(); }
    const int wave0 = __builtin_amdgcn_readfirstlane(threadIdx.x >> 6);
    PHASE();
    (void)xcd_barrier_post((unsigned*)(F.ws + WS_CTL) + CW_BAR, (volatile LAS unsigned*)(F.lds + MISC_OFF) + 8);

    build_rope(F);
    convert_weight(F, INP(I_W_IN), D, INP, WSP(bf16, WS_SLOT16), 0);
#if REP_CONV == 2
    convert_weight(F, INP(I_W_IN), D, INP, WSP(bf16, WS_SLOT16), 0);
#endif
    zero_fill(F, WSP(bf16, WS_SLOT16) + (size_t)6688 * D, (size_t)(INP_PAD - 6688) * D * 2);
    convert_weight(F, INP(I_W_OUT), 2048, D, WSP(bf16, WS_W4), 0);
#if REP_CONV == 2
    convert_weight(F, INP(I_W_OUT), 2048, D, WSP(bf16, WS_W4), 0);
#endif
    rms_rows_to_bf16(F, INP(I_X), INP(I_PRE_MIX), WSP(bf16, WS_SLOT32));
    GRID_BAR();

    run_layer<0>(F, wave0); run_layer<1>(F, wave0); run_layer<2>(F, wave0); run_layer<3>(F, wave0);
#ifdef TPROBE
    if (blockIdx.x == TP_CU && threadIdx.x == 0) {
        const unsigned long long t0_ = __builtin_amdgcn_s_memrealtime(); const unsigned long long w_ = 10ull * ((LAS unsigned*)(F.lds + 146432))[0];
        while (__builtin_amdgcn_s_memrealtime() - t0_ < w_) __builtin_amdgcn_s_sleep(8);
    }
#endif
}

extern "C" void kernel_launch(void* const* d_in, const int* in_sizes, int n_in, void* d_out, int out_size, void* d_ws, size_t ws_size, hipStream_t stream) {
    static int grid = 0;
    if (grid == 0) {
        if (n_in != N_IN || out_size != M * D || ws_size < WS_END) { fprintf(stderr, "kernel_launch: unexpected shapes (n_in %d, out %d, ws %zu)\n", n_in, out_size, ws_size); grid = -1; return; }
        int dev = 0, cus = 0, per_cu = 0;
        if (hipGetDevice(&dev) != hipSuccess || hipDeviceGetAttribute(&cus, hipDeviceAttributeMultiprocessorCount, dev) != hipSuccess) { grid = -1; return; }
        if (hipFuncSetAttribute((const void*)trunk_fwd, hipFuncAttributeMaxDynamicSharedMemorySize, LDS_BYTES) != hipSuccess) { fprintf(stderr, "kernel_launch: hipFuncSetAttribute failed\n"); grid = -1; return; }
        if (hipOccupancyMaxActiveBlocksPerMultiprocessor(&per_cu, (const void*)trunk_fwd, NTHR, LDS_BYTES) != hipSuccess || per_cu < 1)
            fprintf(stderr, "kernel_launch: note: occupancy query reports %d workgroups per CU\n", per_cu);
        (void)hipGetLastError();
        grid = cus;
    }
    if (grid < 0) return;
    if (hipMemsetAsync((char*)d_ws + WS_CTL, 0, CTL_ZERO_BYTES, stream) != hipSuccess) return;
#ifdef DBG_ZERO_MISC
    if (hipMemsetAsync((char*)d_ws + WS_MISC, 0, 512 * 1024, stream) != hipSuccess) return;
#endif
    Args a{};
    for (int i = 0; i < N_IN; ++i) a.in[i] = (const float*)d_in[i];
    a.out = (float*)d_out; a.ws = (unsigned char*)d_ws;
    hipLaunchKernelGGL(trunk_fwd, dim3(grid), dim3(NTHR), LDS_BYTES, stream, a);
}
```

```cpp
#include <hip/hip_runtime.h>
#include <cstdio>
#include <cstdint>
namespace pg8 {
#define PG8_LAS __attribute__((address_space(3)))
typedef unsigned short bf16_t;
typedef short bf16x8 __attribute__((ext_vector_type(8)));
typedef float f32x4 __attribute__((ext_vector_type(4)));
typedef unsigned u32x4 __attribute__((ext_vector_type(4)));
constexpr int BM = 256, BK = 64, HALF = 128, HTB = HALF * BK * 2  , STAGE_BYTES = 8 * HTB, NXCD = 8, WGM = 8;

__host__ __device__ __forceinline__ int lds_byte(int r, int c) { const int st = (r >> 4) * 2 + (c >> 5), rr = r & 15, cc = c & 31, ob = rr * 64 + cc * 2; return st * 1024 + (ob ^ (((ob >> 9) & 1) << 5)); }
__host__ __device__ __forceinline__ void stage_rc(int b, int& R, int& C) { const int st = b / 1024, sb = b % 1024, swz = sb ^ (((sb >> 9) & 1) << 5); R = (st >> 1) * 16 + swz / 64; C = (st & 1) * 32 + (swz % 64) / 2; }
__host__ __device__ __forceinline__ int perm32(int rho) { const int n = rho >> 4, i = rho & 15; return 8 * (i >> 2) + 4 * n + (i & 3); }

struct Unit { int pm, pn; };
struct Gemm { const bf16_t* A; const bf16_t* Bt; int M, N, K; };

struct StaticOrder {
    int nM, nN, nwg, G, c;
    __host__ __device__ void init(int M, int N, int G_, int c_) { nM = M / BM; nN = N / BM; nwg = nM * nN; G = G_; c = c_; }
    __host__ __device__ bool next(int i, Unit& u) const {
        const long L = (long)i * G + c; if (L >= nwg) return false;
        int wgid = (int)L; { const int q = nwg / NXCD, r = nwg % NXCD, xcd = wgid % NXCD, off = wgid / NXCD; wgid = (xcd < r ? xcd * (q + 1) : r * (q + 1) + (xcd - r) * q) + off; }
        const int nig = WGM * nN, gid = wgid / nig, fm = gid * WGM, gsz = (nM - fm) < WGM ? (nM - fm) : WGM;
        u.pm = fm + ((wgid % nig) % gsz); u.pn = (wgid % nig) / gsz; return true;
    }
    __device__ __forceinline__ void a_ready(const Unit&) const {}
    __device__ __forceinline__ void done(const Unit&) const {}
};

typedef __bf16 bf2_t __attribute__((ext_vector_type(2))); typedef float f32x2p __attribute__((ext_vector_type(2)));
__device__ __forceinline__ unsigned cvt_pk_bf16(float lo, float hi) { const f32x2p v = {lo, hi}; return __builtin_bit_cast(unsigned, __builtin_convertvector(v, bf2_t)); }
typedef float f32x2 __attribute__((ext_vector_type(2)));
struct EpiBf16 {
    static constexpr bool PERM = true, AFTER_DRAIN = false;
    bf16_t* O; int ldc;
    __device__ __forceinline__ void operator()(const f32x4 (&acc)[2][2][4][2], const Unit& u, int wr, int wc, int fr_in, int fq_in) const {
        int fr = fr_in, fq = fq_in; asm volatile("" : "+v"(fr), "+v"(fq));
        const int row0 = u.pm * BM + wr * 64 + fr, col0 = u.pn * BM + wc * 32 + 8 * fq;
#pragma unroll
        for (int ai = 0; ai < 2; ++ai)
#pragma unroll
            for (int m = 0; m < 4; ++m) { bf16_t* rowp = O + (size_t)(row0 + ai * HALF + m * 16) * ldc + col0;
#pragma unroll
                for (int bj = 0; bj < 2; ++bj) { const f32x4 v0 = acc[ai][bj][m][0], v1 = acc[ai][bj][m][1];
                    u32x4 w; w.x = cvt_pk_bf16(v0[0], v0[1]); w.y = cvt_pk_bf16(v0[2], v0[3]); w.z = cvt_pk_bf16(v1[0], v1[1]); w.w = cvt_pk_bf16(v1[2], v1[3]);
                    *(u32x4*)(rowp + bj * HALF) = w; } }
    }
};
struct EpiGlu {
    static constexpr bool PERM = true, AFTER_DRAIN = false;
    bf16_t* O; int ldc;
    __device__ __forceinline__ void operator()(const f32x4 (&acc)[2][2][4][2], const Unit& u, int wr, int wc, int fr_in, int fq_in) const {
        int fr = fr_in, fq = fq_in; asm volatile("" : "+v"(fr), "+v"(fq));
        const int row0 = u.pm * BM + wr * 64 + fr, col0 = u.pn * HALF + wc * 32 + 8 * fq;
#pragma unroll
        for (int ai = 0; ai < 2; ++ai)
#pragma unroll
            for (int m = 0; m < 4; ++m) { bf16_t* rowp = O + (size_t)(row0 + ai * HALF + m * 16) * ldc + col0;
                f32x4 o[2];
#pragma unroll
                for (int n = 0; n < 2; ++n) { const f32x4 a = acc[ai][0][m][n], b = acc[ai][1][m][n];
#pragma unroll
                    for (int j = 0; j < 4; ++j) o[n][j] = a[j] * __builtin_amdgcn_rcpf(1.0f + __expf(-b[j])); }
                u32x4 w; w.x = cvt_pk_bf16(o[0][0], o[0][1]); w.y = cvt_pk_bf16(o[0][2], o[0][3]); w.z = cvt_pk_bf16(o[1][0], o[1][1]); w.w = cvt_pk_bf16(o[1][2], o[1][3]);
                *(u32x4*)rowp = w; }
    }
};
struct EpiRelu2 {
    static constexpr bool PERM = true, AFTER_DRAIN = false;
    bf16_t* O; int ldc;
    __device__ __forceinline__ void operator()(const f32x4 (&acc)[2][2][4][2], const Unit& u, int wr, int wc, int fr_in, int fq_in) const {
        int fr = fr_in, fq = fq_in; asm volatile("" : "+v"(fr), "+v"(fq));
        const int row0 = u.pm * BM + wr * 64 + fr, col0 = u.pn * BM + wc * 32 + 8 * fq;
#pragma unroll
        for (int ai = 0; ai < 2; ++ai)
#pragma unroll
            for (int m = 0; m < 4; ++m) { bf16_t* rowp = O + (size_t)(row0 + ai * HALF + m * 16) * ldc + col0;
#pragma unroll
                for (int bj = 0; bj < 2; ++bj) { f32x4 v0 = acc[ai][bj][m][0], v1 = acc[ai][bj][m][1];
#pragma unroll
                    for (int j = 0; j < 4; ++j) { const float a = fmaxf(v0[j], 0.f), b = fmaxf(v1[j], 0.f); v0[j] = a * a; v1[j] = b * b; }
                    u32x4 w; w.x = cvt_pk_bf16(v0[0], v0[1]); w.y = cvt_pk_bf16(v0[2], v0[3]); w.z = cvt_pk_bf16(v1[0], v1[1]); w.w = cvt_pk_bf16(v1[2], v1[3]);
                    *(u32x4*)(rowp + bj * HALF) = w; } }
    }
};
struct EpiInProj {
    static constexpr bool PERM = true, AFTER_DRAIN = false;
    bf16_t* QKV; bf16_t* GZ; bf16_t* XBC; float* DT; const float* rope; const float* dt_bias;
    __device__ __forceinline__ void operator()(const f32x4 (&acc)[2][2][4][2], const Unit& u, int wr, int wc, int fr_in, int fq_in) const {
        int fr = fr_in, fq = fq_in; asm volatile("" : "+v"(fr), "+v"(fq));
#ifdef TPROBE
        unsigned long long tq0 = 0ull; const bool tq_on = (blockIdx.x == TP_CU && threadIdx.x == 0) && ((TPROBE == 70 && u.pn < 8) || (TPROBE == 71 && u.pn >= 8 && u.pn < 26) || (TPROBE == 72 && u.pn < 8) || (TPROBE == 73 && u.pn == 26));
        if (tq_on) tq0 = __builtin_amdgcn_s_memrealtime();
#endif
        const int pn = u.pn, row0 = u.pm * BM + wr * 64 + fr, cin = wc * 32 + 8 * fq;
        if (pn < 8) {
            const int hd = pn & 3; const bool isk = pn >= 4;
            const float lg2 = __log2f(1.0f - exp2f(-5.0f - (float)hd));
#pragma unroll
            for (int ai = 0; ai < 2; ++ai)
#pragma unroll
                for (int m = 0; m < 4; ++m) { const int row = row0 + ai * HALF + m * 16, pos = row & 4095, r = pos & 127;
                    const float sc = isk ? exp2f(-(float)r * lg2) * 0.0625f : exp2f((float)r * lg2);
                    const u32x4* rp = (const u32x4*)((const unsigned*)rope + (size_t)pos * 128 + cin);
                    f32x4 o1[2], o2[2];
#pragma unroll
                    for (int n = 0; n < 2; ++n) { const u32x4 cs = rp[n];
                        const f32x4 x1 = acc[ai][0][m][n], x2 = acc[ai][1][m][n];
                        const unsigned w0 = cs.x, w1 = cs.y, w2 = cs.z, w3 = cs.w;
                        const float c[4] = {(float)__builtin_bit_cast(_Float16, (unsigned short)(w0 & 0xffffu)), (float)__builtin_bit_cast(_Float16, (unsigned short)(w1 & 0xffffu)), (float)__builtin_bit_cast(_Float16, (unsigned short)(w2 & 0xffffu)), (float)__builtin_bit_cast(_Float16, (unsigned short)(w3 & 0xffffu))};
                        const float s[4] = {(float)__builtin_bit_cast(_Float16, (unsigned short)(w0 >> 16)), (float)__builtin_bit_cast(_Float16, (unsigned short)(w1 >> 16)), (float)__builtin_bit_cast(_Float16, (unsigned short)(w2 >> 16)), (float)__builtin_bit_cast(_Float16, (unsigned short)(w3 >> 16))};
#pragma unroll
                        for (int j = 0; j < 4; ++j) { o1[n][j] = (x1[j] * c[j] - x2[j] * s[j]) * sc; o2[n][j] = (x2[j] * c[j] + x1[j] * s[j]) * sc; } }
                    bf16_t* rowp = QKV + (size_t)row * 3072 + pn * 256 + cin;
                    u32x4 w; w.x = cvt_pk_bf16(o1[0][0], o1[0][1]); w.y = cvt_pk_bf16(o1[0][2], o1[0][3]); w.z = cvt_pk_bf16(o1[1][0], o1[1][1]); w.w = cvt_pk_bf16(o1[1][2], o1[1][3]);
                    *(u32x4*)rowp = w;
                    w.x = cvt_pk_bf16(o2[0][0], o2[0][1]); w.y = cvt_pk_bf16(o2[0][2], o2[0][3]); w.z = cvt_pk_bf16(o2[1][0], o2[1][1]); w.w = cvt_pk_bf16(o2[1][2], o2[1][3]);
                    *(u32x4*)(rowp + HALF) = w; }
        } else if (pn < 26) {
            bf16_t* base; int ldc, colt;
            if (pn < 12) { base = QKV; ldc = 3072; colt = pn * 256; } else if (pn < 20) { base = GZ; ldc = 2048; colt = (pn - 12) * 256; } else { base = XBC; ldc = 1536; colt = (pn - 20) * 256; }
#pragma unroll
            for (int ai = 0; ai < 2; ++ai)
#pragma unroll
                for (int m = 0; m < 4; ++m) { bf16_t* rowp = base + (size_t)(row0 + ai * HALF + m * 16) * ldc + colt + cin;
#pragma unroll
                    for (int bj = 0; bj < 2; ++bj) { const f32x4 v0 = acc[ai][bj][m][0], v1 = acc[ai][bj][m][1];
                        u32x4 w; w.x = cvt_pk_bf16(v0[0], v0[1]); w.y = cvt_pk_bf16(v0[2], v0[3]); w.z = cvt_pk_bf16(v1[0], v1[1]); w.w = cvt_pk_bf16(v1[2], v1[3]);
                        *(u32x4*)(rowp + bj * HALF) = w; } }
        } else {
            if (cin < 16) {
#pragma unroll
                for (int ai = 0; ai < 2; ++ai)
#pragma unroll
                    for (int m = 0; m < 4; ++m) { float* rowp = DT + (size_t)(row0 + ai * HALF + m * 16) * 16 + cin;
#pragma unroll
                        for (int n = 0; n < 2; ++n) { f32x4 o;
#pragma unroll
                            for (int j = 0; j < 4; ++j) { const float x = acc[ai][0][m][n][j] + dt_bias[cin + 4 * n + j];
                                const float e = __expf(fminf(x, 20.f)), sp = e < 0.03125f ? e * (1.0f - e * (0.5f - e * (0.33333334f - 0.25f * e))) : __logf(1.0f + e);
                                o[j] = fmaxf(x > 20.f ? x : sp, 1e-30f); }
                            *(f32x4*)(rowp + 4 * n) = o; } }
            }
        }
#ifdef TPROBE
        if (tq_on) { if (TPROBE == 72) *(PG8_LAS unsigned*)(unsigned)146432 += 100u; else { asm volatile("s_waitcnt vmcnt(0)" ::: "memory"); *(PG8_LAS unsigned*)(unsigned)146432 += (unsigned)(__builtin_amdgcn_s_memrealtime() - tq0); } }
#endif
    }
};
template <bool IN_F32, bool OUT_F32 = false>
struct EpiResNorm {
    static constexpr bool PERM = true, AFTER_DRAIN = true;
    const void* hin; bf16_t* hout; bf16_t* hn; const float* w_post; const float* w_pre; unsigned long long* xbuf; unsigned* cnt; unsigned want; float eps;
    static __device__ __forceinline__ f32x4 up4(unsigned w0, unsigned w1) { return (f32x4){__builtin_bit_cast(float, w0 << 16), __builtin_bit_cast(float, w0 & 0xffff0000u), __builtin_bit_cast(float, w1 << 16), __builtin_bit_cast(float, w1 & 0xffff0000u)}; }
    __device__ __forceinline__ void fused(f32x4 (&acc)[2][2][4][2], const Unit& u, int wr, int wc, int fr_in, int fq_in, PG8_LAS unsigned char* lds, int wid, int lane_in) const {
        int fr = fr_in, fq = fq_in, lane = lane_in; asm volatile("" : "+v"(fr), "+v"(fq), "+v"(lane));
        typedef float f32x2v __attribute__((ext_vector_type(2)));
#ifdef TPROBE
        unsigned long long tp_t0 = 0ull;
#define TP_B(id) do { if (TPROBE == (id) && blockIdx.x == TP_CU && threadIdx.x == 0) tp_t0 = __builtin_amdgcn_s_memrealtime(); } while (0)
#define TP_E(id) do { if (TPROBE == (id) && blockIdx.x == TP_CU && threadIdx.x == 0) *(PG8_LAS unsigned*)(lds + 146432) += (unsigned)(__builtin_amdgcn_s_memrealtime() - tp_t0); } while (0)
#else
#define TP_B(id) do {} while (0)
#define TP_E(id) do {} while (0)
#endif
        TP_B(1); TP_B(2);
        PG8_LAS f32x4* P = (PG8_LAS f32x4*)lds;
        PG8_LAS f32x2v* S = (PG8_LAS f32x2v*)(lds + 16384);
        const int rowt = wr * 64 + fr, col0 = u.pn * BM + wc * 32 + 8 * fq;
        const size_t grow0 = (size_t)u.pm * BM + rowt;
        u32x4 wp[2][4][2];
        u32x4 hk[2][4][2];
        {   f32x4 wv[2][2];
#pragma unroll
            for (int bj = 0; bj < 2; ++bj)
#pragma unroll
                for (int n = 0; n < 2; ++n) wv[bj][n] = *(const f32x4*)(w_post + col0 + bj * HALF + 4 * n);
#pragma unroll
            for (int ai = 0; ai < 2; ++ai) {
                f32x4 hx[4][2][2];
                u32x4 hp[2][4][2];
                if (!IN_F32) {
#pragma unroll
                    for (int m = 0; m < 4; ++m)
#pragma unroll
                        for (int bj = 0; bj < 2; ++bj) { hp[ai][m][bj] = *(const u32x4*)((const bf16_t*)hin + (grow0 + ai * HALF + m * 16) * 2048 + col0 + bj * HALF); if (OUT_F32) hk[ai][m][bj] = hp[ai][m][bj]; }
                }
#pragma unroll
                for (int m = 0; m < 4; ++m) {
                    if (IN_F32 && (m & 1) == 0) {
#pragma unroll
                        for (int mm = m; mm < m + 2; ++mm)
#pragma unroll
                            for (int bj = 0; bj < 2; ++bj)
#pragma unroll
                                for (int n = 0; n < 2; ++n) hx[mm][bj][n] = *(const f32x4*)((const float*)hin + (grow0 + ai * HALF + mm * 16) * 1024 + col0 + bj * HALF + 4 * n);
                    }
                    float s1 = 0.f, s2 = 0.f, s3 = 0.f, s4 = 0.f;
#pragma unroll
                    for (int bj = 0; bj < 2; ++bj) { f32x4 wm[2];
#pragma unroll
                        for (int n = 0; n < 2; ++n) {
                            const f32x4 hv = IN_F32 ? hx[m][bj][n] : up4(hp[ai][m][bj][2 * n], hp[ai][m][bj][2 * n + 1]);
                            const f32x4 a = acc[ai][bj][m][n]; wm[n] = a * wv[bj][n];
                            s1 += (a[0] * a[0] + a[1] * a[1]) + (a[2] * a[2] + a[3] * a[3]);
                            if (!OUT_F32) {
                            s2 += (hv[0] * hv[0] + hv[1] * hv[1]) + (hv[2] * hv[2] + hv[3] * hv[3]);
                            s3 += (hv[0] * wm[n][0] + hv[1] * wm[n][1]) + (hv[2] * wm[n][2] + hv[3] * wm[n][3]);
                            s4 += (wm[n][0] * wm[n][0] + wm[n][1] * wm[n][1]) + (wm[n][2] * wm[n][2] + wm[n][3] * wm[n][3]); } }
                        u32x4 w; w.x = cvt_pk_bf16(wm[0][0], wm[0][1]); w.y = cvt_pk_bf16(wm[0][2], wm[0][3]); w.z = cvt_pk_bf16(wm[1][0], wm[1][1]); w.w = cvt_pk_bf16(wm[1][2], wm[1][3]);
                        asm volatile("" : "+v"(w));
                        wp[ai][m][bj] = w; }
                    s1 += __shfl_xor(s1, 16); s1 += __shfl_xor(s1, 32);
                    if (!OUT_F32) { s2 += __shfl_xor(s2, 16); s3 += __shfl_xor(s3, 16); s4 += __shfl_xor(s4, 16); s2 += __shfl_xor(s2, 32); s3 += __shfl_xor(s3, 32); s4 += __shfl_xor(s4, 32); }
                    if (fq == 0) P[(ai * HALF + rowt + m * 16) * 4 + wc] = (f32x4){s1, s2, s3, s4};
                    if (IN_F32 && (m & 1)) asm volatile("" ::: "memory");
                }
                asm volatile("" ::: "memory");
            }
        }
        asm volatile("s_waitcnt lgkmcnt(0)" ::: "memory"); __builtin_amdgcn_s_barrier(); asm volatile("" ::: "memory");
        TP_E(2); TP_B(3);
        const int row = wid * 32 + (lane & 31);
        if (lane < 32) {
            const f32x4 a = P[row * 4 + 0], b = P[row * 4 + 1], c = P[row * 4 + 2], d = P[row * 4 + 3];
            const f32x4 t = (a + b) + (c + d);
            const float t0 = t[0], t1 = t[1], t2 = t[2], t3 = t[3];
            unsigned long long* slot = xbuf + ((size_t)(u.pm * BM + row) * 4 + u.pn) * 2;
            __hip_atomic_store(slot, ((unsigned long long)__builtin_bit_cast(unsigned, t1) << 32) | __builtin_bit_cast(unsigned, t0), __ATOMIC_RELAXED, __HIP_MEMORY_SCOPE_AGENT);
            __hip_atomic_store(slot + 1, ((unsigned long long)__builtin_bit_cast(unsigned, t3) << 32) | __builtin_bit_cast(unsigned, t2), __ATOMIC_RELAXED, __HIP_MEMORY_SCOPE_AGENT);
        }
        asm volatile("s_waitcnt vmcnt(0)" ::: "memory");
        if (lane == 0) __hip_atomic_fetch_add(cnt + 64 * u.pm, 1u, __ATOMIC_RELAXED, __HIP_MEMORY_SCOPE_AGENT);
        TP_E(3); TP_B(4);
        if (wid == 0) {
            unsigned sp = 0u;
            for (;;) {
                if ((unsigned)__builtin_amdgcn_readfirstlane(__hip_atomic_load(cnt + 64 * u.pm, __ATOMIC_RELAXED, __HIP_MEMORY_SCOPE_AGENT)) >= want) break;
                if (++sp > (1u << 22)) break;
                __builtin_amdgcn_s_sleep(2);
            }
#ifdef XCH_FENCE
            __builtin_amdgcn_fence(__ATOMIC_ACQUIRE, "agent");
#endif
        }
        asm volatile("s_waitcnt vmcnt(0) lgkmcnt(0)" ::: "memory"); __builtin_amdgcn_s_barrier(); asm volatile("" ::: "memory");
        TP_E(4); TP_B(5);
        if (lane < 32) {
            const unsigned long long* slot = xbuf + (size_t)(u.pm * BM + row) * 8; float t1 = 0.f, t2 = 0.f, t3 = 0.f, t4 = 0.f;
#pragma unroll
            for (int t = 0; t < 4; ++t) { const unsigned long long w0 = __hip_atomic_load(slot + 2 * t, __ATOMIC_RELAXED, __HIP_MEMORY_SCOPE_AGENT), w1 = __hip_atomic_load(slot + 2 * t + 1, __ATOMIC_RELAXED, __HIP_MEMORY_SCOPE_AGENT);
                t1 += __builtin_bit_cast(float, (unsigned)w0); t2 += __builtin_bit_cast(float, (unsigned)(w0 >> 32)); t3 += __builtin_bit_cast(float, (unsigned)w1); t4 += __builtin_bit_cast(float, (unsigned)(w1 >> 32)); }
            const float r1 = rsqrtf(t1 * (1.0f / 1024.0f) + eps);
            const float q = fmaxf(t2 + r1 * (2.0f * t3 + r1 * t4), 0.f);
            S[row] = (f32x2v){r1, rsqrtf(q * (1.0f / 1024.0f) + eps)};
        }
        asm volatile("s_waitcnt lgkmcnt(0)" ::: "memory"); __builtin_amdgcn_s_barrier(); asm volatile("" ::: "memory");
        TP_E(5); TP_B(6);
        u32x4 hp[2][4][2];
        if (!IN_F32) {
#pragma unroll
            for (int ai = 0; ai < 2; ++ai)
#pragma unroll
                for (int m = 0; m < 4; ++m)
#pragma unroll
                    for (int bj = 0; bj < 2; ++bj) { if (OUT_F32) hp[ai][m][bj] = hk[ai][m][bj]; else hp[ai][m][bj] = *(const u32x4*)((const bf16_t*)hin + (grow0 + ai * HALF + m * 16) * 2048 + col0 + bj * HALF); }
        }
        f32x4 wq[2][2];
#pragma unroll
        for (int bj = 0; bj < 2; ++bj)
#pragma unroll
            for (int n = 0; n < 2; ++n) wq[bj][n] = OUT_F32 ? (f32x4){0.f, 0.f, 0.f, 0.f} : *(const f32x4*)(w_pre + col0 + bj * HALF + 4 * n);
#pragma unroll
        for (int ai = 0; ai < 2; ++ai) {
            f32x4 hx[4][2][2];
            if (IN_F32) {
#pragma unroll
                for (int m = 0; m < 4; ++m)
#pragma unroll
                    for (int bj = 0; bj < 2; ++bj)
#pragma unroll
                        for (int n = 0; n < 2; ++n) hx[m][bj][n] = *(const f32x4*)((const float*)hin + (grow0 + ai * HALF + m * 16) * 1024 + col0 + bj * HALF + 4 * n);
            }
#pragma unroll
            for (int m = 0; m < 4; ++m) { const int r = ai * HALF + rowt + m * 16; const f32x2v sr = S[r]; const size_t grow = (size_t)u.pm * BM + r;
#pragma unroll
                for (int bj = 0; bj < 2; ++bj) { f32x4 o[2];
#pragma unroll
                    for (int n = 0; n < 2; ++n) { const f32x4 hv = IN_F32 ? hx[m][bj][n] : up4(hp[ai][m][bj][2 * n], hp[ai][m][bj][2 * n + 1]);
                        o[n] = hv + up4(wp[ai][m][bj][2 * n], wp[ai][m][bj][2 * n + 1]) * sr.x; }
                    if (OUT_F32) { float* of = (float*)(void*)hout + grow * 1024 + col0 + bj * HALF; __builtin_nontemporal_store(o[0], (f32x4*)of); __builtin_nontemporal_store(o[1], (f32x4*)(of + 4)); }
                    else {
                    u32x4 w; w.x = cvt_pk_bf16(o[0][0], o[0][1]); w.y = cvt_pk_bf16(o[0][2], o[0][3]); w.z = cvt_pk_bf16(o[1][0], o[1][1]); w.w = cvt_pk_bf16(o[1][2], o[1][3]);
                    *(u32x4*)(hout + grow * 2048 + col0 + bj * HALF) = w;
                    const f32x4 y0 = o[0] * sr.y * wq[bj][0], y1 = o[1] * sr.y * wq[bj][1];
                    w.x = cvt_pk_bf16(y0[0], y0[1]); w.y = cvt_pk_bf16(y0[2], y0[3]); w.z = cvt_pk_bf16(y1[0], y1[1]); w.w = cvt_pk_bf16(y1[2], y1[3]);
                    *(u32x4*)(hn + grow * 1024 + col0 + bj * HALF) = w; } } }
            if (IN_F32) asm volatile("" ::: "memory");
        }
        TP_E(6); TP_E(1);
    }
};
template <class Epi, class Sched, bool ALIGN_EPI = false, bool SP2 = false>
__device__ __forceinline__ void gemm_phase(PG8_LAS unsigned char* lds, const Gemm g, const Sched& S, const Epi& E, const int tid) {
    const int wid = __builtin_amdgcn_readfirstlane(tid >> 6), lane = tid & 63, wr = wid >> 2, wc = wid & 3, fr = lane & 15, fq = lane >> 4;
    const int K = g.K, nt = K / BK;
    unsigned voffA[2], voffB[2];
#pragma unroll
    for (int i = 0; i < 2; ++i) { int R, C; stage_rc(tid * 16 + i * 8192, R, C); const int Rb = Epi::PERM ? ((R & ~31) + perm32(R & 31)) : R;
        voffA[i] = (unsigned)(R * K + C) * 2u; voffB[i] = (unsigned)(Rb * K + C) * 2u; }
    const size_t kstep = (size_t)(BK * 2);
    const size_t hstep = (size_t)HALF * K * 2;
    const size_t tstep = 2 * hstep;
    const unsigned ldsw = (unsigned)wid * 1024u;
    const int aoff = lds_byte(wr * 64 + fr, fq * 8), boff = lds_byte(wc * 32 + fr, fq * 8);
#define PG8_SA(b, h) (((b) * 2 + (h)) * HTB)
#define PG8_SB(b, h) ((4 + (b) * 2 + (h)) * HTB)
#define PG8_STAGE(bufoff, gbase, voff) do { _Pragma("unroll") for (int _i = 0; _i < 2; ++_i) \
        __builtin_amdgcn_global_load_lds((const unsigned*)((const char*)(gbase) + (voff)[_i]), (PG8_LAS unsigned*)(lds + (bufoff) + ldsw + _i * 8192), 16, 0, 0); } while (0)
#define PG8_LDA(dst, b, h) do { _Pragma("unroll") for (int m = 0; m < 4; ++m) _Pragma("unroll") for (int k = 0; k < 2; ++k) dst[m][k] = *(const PG8_LAS bf16x8*)(lds + PG8_SA(b, h) + aoff + m * 2048 + k * 1024); } while (0)
#define PG8_LDB(dst, b, h) do { _Pragma("unroll") for (int n = 0; n < 2; ++n) _Pragma("unroll") for (int k = 0; k < 2; ++k) dst[n][k] = *(const PG8_LAS bf16x8*)(lds + PG8_SB(b, h) + boff + n * 2048 + k * 1024); } while (0)
#define PG8_MMA(ai, bj, At, Bt) do { __builtin_amdgcn_s_setprio(1); _Pragma("unroll") for (int m = 0; m < 4; ++m) _Pragma("unroll") for (int n = 0; n < 2; ++n) _Pragma("unroll") for (int k = 0; k < 2; ++k) \
        acc[ai][bj][m][n] = __builtin_amdgcn_mfma_f32_16x16x32_bf16(Bt[n][k], At[m][k], acc[ai][bj][m][n], 0, 0, 0); __builtin_amdgcn_s_setprio(0); } while (0)
#define PG8_WAIT_V(n) asm volatile("s_waitcnt vmcnt(" #n ")" ::: "memory")
#define PG8_WAIT_L(n) asm volatile("s_waitcnt lgkmcnt(" #n ")" ::: "memory")
#define PG8_BAR __builtin_amdgcn_s_barrier()
#define PG8_SCHED __builtin_amdgcn_sched_barrier(0)
    Unit cur, nxt; int ui = 0;
    if (!S.next(0, cur)) return;
    f32x4 acc[2][2][4][2];
#pragma unroll
    for (int a = 0; a < 2; ++a)
#pragma unroll
        for (int b = 0; b < 2; ++b)
#pragma unroll
            for (int m = 0; m < 4; ++m)
#pragma unroll
                for (int n = 0; n < 2; ++n) acc[a][b][m][n] = (f32x4){0.f, 0.f, 0.f, 0.f};
    bf16x8 At[4][2], B0[2][2], B1[2][2];
    const char* cA = (const char*)g.A + (size_t)cur.pm * tstep; const char* cB = (const char*)g.Bt + (size_t)cur.pn * tstep;
    S.a_ready(cur);
    if constexpr (SP2) {
        PG8_STAGE(PG8_SB(0, 0), cB, voffB); PG8_STAGE(PG8_SB(0, 1), cB + hstep, voffB); PG8_STAGE(PG8_SA(0, 0), cA, voffA); PG8_STAGE(PG8_SA(0, 1), cA + hstep, voffA);
        if (wr == 1) PG8_BAR;
        PG8_WAIT_V(2); PG8_BAR;
        PG8_STAGE(PG8_SB(1, 0), cB + kstep, voffB); PG8_STAGE(PG8_SA(1, 0), cA + kstep, voffA); PG8_STAGE(PG8_SB(1, 1), cB + hstep + kstep, voffB);
        PG8_WAIT_V(6); PG8_BAR;
    } else {
        PG8_STAGE(PG8_SB(0, 0), cB, voffB); PG8_STAGE(PG8_SA(0, 0), cA, voffA); PG8_STAGE(PG8_SB(0, 1), cB + hstep, voffB); PG8_STAGE(PG8_SA(0, 1), cA + hstep, voffA);
        if (wr == 1) PG8_BAR;
        PG8_WAIT_V(4); PG8_BAR;
        PG8_STAGE(PG8_SB(1, 0), cB + kstep, voffB); PG8_STAGE(PG8_SA(1, 0), cA + kstep, voffA); PG8_STAGE(PG8_SB(1, 1), cB + hstep + kstep, voffB);
        PG8_WAIT_V(6); PG8_BAR;
    }
    for (;;) {
        const bool has_next = S.next(ui + 1, nxt);
        const char* nA = has_next ? (const char*)g.A + (size_t)nxt.pm * tstep : cA; const char* nB = has_next ? (const char*)g.Bt + (size_t)nxt.pn * tstep : cB;
        for (int t = 0; t < nt; t += 2) {
            const bool last = (t == nt - 2);
            const char* a1 = cA + (size_t)(t + 1) * kstep;
            const char* a2 = last ? nA : cA + (size_t)(t + 2) * kstep; const char* b2 = last ? nB : cB + (size_t)(t + 2) * kstep;
            const char* a3 = a2 + kstep; const char* b3 = b2 + kstep;
            if (last && has_next) S.a_ready(nxt);
            if constexpr (SP2) {
            PG8_LDB(B0, 0, 0); PG8_LDB(B1, 0, 1); PG8_SCHED; PG8_LDA(At, 0, 0); PG8_STAGE(PG8_SA(1, 1), a1 + hstep, voffA);
            PG8_WAIT_V(8); PG8_WAIT_L(0); PG8_BAR; PG8_MMA(0, 0, At, B0); PG8_MMA(0, 1, At, B1); PG8_BAR; PG8_SCHED;
            PG8_LDA(At, 0, 1); PG8_STAGE(PG8_SB(0, 0), b2, voffB); PG8_STAGE(PG8_SB(0, 1), b2 + hstep, voffB); PG8_STAGE(PG8_SA(0, 0), a2, voffA);
            PG8_WAIT_V(8); PG8_WAIT_L(0); PG8_BAR; PG8_MMA(1, 0, At, B0); PG8_MMA(1, 1, At, B1); PG8_BAR; PG8_SCHED;
            PG8_LDB(B0, 1, 0); PG8_LDB(B1, 1, 1); PG8_SCHED; PG8_LDA(At, 1, 0); PG8_STAGE(PG8_SA(0, 1), a2 + hstep, voffA);
            PG8_WAIT_V(8); PG8_WAIT_L(0); PG8_BAR; PG8_MMA(0, 0, At, B0); PG8_MMA(0, 1, At, B1); PG8_BAR; PG8_SCHED;
            PG8_LDA(At, 1, 1); PG8_STAGE(PG8_SB(1, 0), b3, voffB); PG8_STAGE(PG8_SB(1, 1), b3 + hstep, voffB); PG8_STAGE(PG8_SA(1, 0), a3, voffA);
            PG8_WAIT_V(8); PG8_WAIT_L(0); PG8_BAR; PG8_MMA(1, 0, At, B0); PG8_MMA(1, 1, At, B1); PG8_BAR; PG8_SCHED;
            } else {
            PG8_LDB(B0, 0, 0); PG8_SCHED; PG8_LDA(At, 0, 0); PG8_STAGE(PG8_SA(1, 1), a1 + hstep, voffA);
            PG8_WAIT_L(8); PG8_BAR; PG8_WAIT_L(0); PG8_MMA(0, 0, At, B0); PG8_BAR; PG8_SCHED;
            PG8_LDB(B1, 0, 1); PG8_STAGE(PG8_SB(0, 0), b2, voffB);
            PG8_BAR; PG8_WAIT_L(0); PG8_MMA(0, 1, At, B1); PG8_BAR;
            PG8_LDA(At, 0, 1); PG8_STAGE(PG8_SA(0, 0), a2, voffA);
            PG8_BAR; PG8_WAIT_L(0); PG8_MMA(1, 0, At, B0); PG8_BAR; PG8_SCHED;
            PG8_STAGE(PG8_SB(0, 1), b2 + hstep, voffB);
            PG8_WAIT_V(6); PG8_BAR; PG8_MMA(1, 1, At, B1); PG8_BAR;
            PG8_LDB(B0, 1, 0); PG8_SCHED; PG8_LDA(At, 1, 0); PG8_STAGE(PG8_SA(0, 1), a2 + hstep, voffA);
            PG8_WAIT_L(8); PG8_BAR; PG8_WAIT_L(0); PG8_MMA(0, 0, At, B0); PG8_BAR; PG8_SCHED;
            PG8_LDB(B1, 1, 1); PG8_STAGE(PG8_SB(1, 0), b3, voffB);
            PG8_BAR; PG8_WAIT_L(0); PG8_MMA(0, 1, At, B1); PG8_BAR;
            PG8_LDA(At, 1, 1); PG8_STAGE(PG8_SA(1, 0), a3, voffA);
            PG8_BAR; PG8_WAIT_L(0); PG8_MMA(1, 0, At, B0); PG8_BAR; PG8_SCHED;
            PG8_STAGE(PG8_SB(1, 1), b3 + hstep, voffB);
            PG8_WAIT_V(6); PG8_BAR; PG8_MMA(1, 1, At, B1); PG8_BAR;
            }
        }
        if constexpr (ALIGN_EPI) { if (wr == 0) PG8_BAR; }
        if constexpr (!Epi::AFTER_DRAIN) { E(acc, cur, wr, wc, fr, fq);
#if defined(REP_EPI) && REP_EPI == 2
            E(acc, cur, wr, wc, fr, fq);
#endif
            S.done(cur); }
        if (!has_next) break;
#pragma unroll
        for (int a = 0; a < 2; ++a)
#pragma unroll
            for (int b = 0; b < 2; ++b)
#pragma unroll
                for (int m = 0; m < 4; ++m)
#pragma unroll
                    for (int n = 0; n < 2; ++n) acc[a][b][m][n] = (f32x4){0.f, 0.f, 0.f, 0.f};
        cur = nxt; cA = nA; cB = nB; ++ui;
        if constexpr (ALIGN_EPI) { if (wr == 1) PG8_BAR; }
    }
    PG8_WAIT_V(0);
    if constexpr (!ALIGN_EPI) { if (wr == 0) PG8_BAR; }
    PG8_BAR;
    if constexpr (Epi::AFTER_DRAIN) { E.fused(acc, cur, wr, wc, fr, fq, lds, wid, lane); S.done(cur); }
#undef PG8_SA
#undef PG8_SB
#undef PG8_STAGE
#undef PG8_LDA
#undef PG8_LDB
#undef PG8_MMA
#undef PG8_WAIT_V
#undef PG8_WAIT_L
#undef PG8_BAR
#undef PG8_SCHED
}
}
constexpr int NWAVES = 8, NTHR = 512;
constexpr int BATCH = 4, SEQ = 4096, D = 1024, M = BATCH * SEQ, FF = 4096, DEPTH = 4;
constexpr int INP = 6672, INP_PAD = 6912;
constexpr float EPS = 1e-6f;
enum { I_X = 0, I_PRE_MIX, I_POST_MIX, I_PRE_MLP, I_POST_MLP, I_W_IN, I_CONV_W, I_CONV_B, I_DT_BIAS, I_A_LOG, I_D_SSD, I_SSD_NORM, I_W_OUT,
       I_LAM_RE, I_LAM_IM, I_LOG_STEP, I_B_RE, I_B_IM, I_C_RE, I_C_IM, I_D_S5, I_W_GLU_A, I_W_GLU_B, I_W_UP, I_W_DOWN, N_IN };
#ifndef DOWN1_MIB
#define DOWN1_MIB 249
#endif
#ifndef S5MAT_MIB
#define S5MAT_MIB 185
#endif
constexpr size_t MiB = 1u << 20;
constexpr size_t WS_CTL = 0, CTL_ZERO_BYTES = 64 * 1024;
constexpr size_t WS_MISC = 512 * 1024;
constexpr size_t WS_ROPE = 1 * MiB;
constexpr size_t WS_W4 = 5 * MiB;
constexpr size_t WS_SLOT16 = 9 * MiB;
constexpr size_t WS_SLOT32 = 25 * MiB;
constexpr size_t WS_QKV = 57 * MiB;
constexpr size_t WS_GZ = 153 * MiB;
constexpr size_t WS_XBC = 217 * MiB;
constexpr size_t WS_DT = 265 * MiB;
constexpr size_t WS_END = 268 * MiB;
constexpr size_t WS_M32A = 57 * MiB;
constexpr size_t WS_M32B = 185 * MiB;
constexpr size_t WS_U = 57 * MiB;
constexpr size_t WS_S5MAT = (S5MAT_MIB) * MiB;
constexpr size_t WS_S5E = 73 * MiB;
constexpr size_t WS_S5X = 105 * MiB;
constexpr size_t WS_Y = 121 * MiB;
constexpr size_t WS_DOWN1 = (DOWN1_MIB) * MiB;
constexpr size_t WS_XBUF_A = 266 * MiB, WS_XBUF_B = 267 * MiB;
constexpr int CW_PANEL = 8192;
constexpr int SCR_BYTES = 143360;
constexpr int MISC_OFF = SCR_BYTES;
constexpr int LDS_BYTES = 147456;

#define GAS __attribute__((address_space(1)))
#define LAS __attribute__((address_space(3)))
#define DI __device__ __forceinline__
typedef unsigned short bf16;
typedef unsigned v4u __attribute__((ext_vector_type(4)));
typedef unsigned v2u __attribute__((ext_vector_type(2)));
typedef float f32x4 __attribute__((ext_vector_type(4)));
typedef float f32x2v __attribute__((ext_vector_type(2)));
typedef short bf16x8 __attribute__((ext_vector_type(8)));
typedef short v4i16_t __attribute__((ext_vector_type(4)));
typedef GAS unsigned gu32;
#define RLX_AGENT __ATOMIC_RELAXED, __HIP_MEMORY_SCOPE_AGENT
#define LDS_WAIT() asm volatile("s_waitcnt lgkmcnt(0)" ::: "memory")
#define VM_WAIT() asm volatile("s_waitcnt vmcnt(0)" ::: "memory")
DI unsigned f2bf(float f) { unsigned u = __builtin_bit_cast(unsigned, f); return (u + 0x7fffu + ((u >> 16) & 1u)) >> 16; }
typedef __bf16 bf2_t __attribute__((ext_vector_type(2)));
DI unsigned pk2(float lo, float hi) { const f32x2v v = {lo, hi}; return __builtin_bit_cast(unsigned, __builtin_convertvector(v, bf2_t)); }
DI float bf2f(unsigned short b) { return __builtin_bit_cast(float, ((unsigned)b) << 16); }
DI float bflo(unsigned w) { return __builtin_bit_cast(float, w << 16); }
DI float bfhi(unsigned w) { return __builtin_bit_cast(float, w & 0xffff0000u); }
DI float wave_sum(float v) {
#pragma unroll
    for (int o = 1; o < 64; o <<= 1) v += __shfl_xor(v, o);
    return v;
}
DI float silu_f(float x) { return x * __builtin_amdgcn_rcpf(1.0f + __expf(-x)); }
DI void sincos_d(double x, double& s, double& c) {
    const double k = rint(x * 0.15915494309189533576888376337251);
    const double r = fma(-k, 6.283185307179586476925286766559, x), r2 = r * r;
    double ps = 1.0 / 1.0888869450418352e28, pc = 1.0 / 3.0488834461171384e29;
    const double fs[13] = {1.0 / 1.5511210043330986e25, 1.0 / 2.5852016738884978e22, 1.0 / 5.109094217170944e19, 1.0 / 1.21645100408832e17, 1.0 / 355687428096000.0, 1.0 / 1307674368000.0,
                           1.0 / 6227020800.0, 1.0 / 39916800.0, 1.0 / 362880.0, 1.0 / 5040.0, 1.0 / 120.0, 1.0 / 6.0, 1.0};
    const double fc[14] = {1.0 / 4.0329146112660565e26, 1.0 / 6.204484017332394e23, 1.0 / 1.1240007277776077e21, 1.0 / 2.43290200817664e18, 1.0 / 6402373705728000.0, 1.0 / 20922789888000.0,
                           1.0 / 87178291200.0, 1.0 / 479001600.0, 1.0 / 3628800.0, 1.0 / 40320.0, 1.0 / 720.0, 1.0 / 24.0, 1.0 / 2.0, 1.0};
#pragma unroll
    for (int i = 0; i < 13; ++i) ps = fs[i] - ps * r2;
#pragma unroll
    for (int i = 0; i < 14; ++i) pc = fc[i] - pc * r2;
    s = ps * r; c = pc;
}
#define XB_TMO      128
#define XB_XCNT(j)  (256  + 64 * (j))
#define XB_XSUB(j)  (1280 + 64 * (j))
#define XB_XGEN(j)  (2304 + 64 * (j))
#define XB_TOP      3328
#define XB_TOPGEN   3392
#define XCD_BAR_WORDS 3456
#define XB_SPIN_CAP (1u << 18)

__device__ __forceinline__ unsigned xb_ld(unsigned* p)              { return __hip_atomic_load(p, __ATOMIC_RELAXED, __HIP_MEMORY_SCOPE_AGENT); }
__device__ __forceinline__ unsigned xb_add(unsigned* p, unsigned v) { return __hip_atomic_fetch_add(p, v, __ATOMIC_RELAXED, __HIP_MEMORY_SCOPE_AGENT); }
__device__ __forceinline__ unsigned xb_xcc_id() { return (unsigned)__builtin_amdgcn_s_getreg((3 << 11) | 20) & 0xFu; }
#define XB_SPIN(cond, bar) do { unsigned _sp = 0; while (cond) { __builtin_amdgcn_s_sleep(1); \
    if ((++_sp & 255u) == 0u) { if (xb_ld(&(bar)[XB_TMO])) break; if (_sp > XB_SPIN_CAP) { atomicAdd(&(bar)[XB_TMO], 1u); break; } } } } while (0)

struct XcdBarrier {
    unsigned* bar; unsigned x; int tid;
    volatile LAS unsigned* st;
};

__device__ __forceinline__ XcdBarrier xcd_barrier_post(unsigned* bar, volatile LAS unsigned* st) {
    XcdBarrier b; b.bar = bar; b.x = xb_xcc_id(); b.st = st;
    if (threadIdx.x == 0) (void)xb_add(&bar[XB_XCNT(b.x)], 1u);
    return b;
}
__device__ __forceinline__ void xcd_barrier_complete(unsigned* bar, unsigned x, unsigned& nloc, unsigned& nx) {
    const unsigned G = gridDim.x * gridDim.y * gridDim.z;
    unsigned sum, cnt, mine, sp = 0u;
    for (;;) {
        sum = 0u; cnt = 0u; mine = 0u;
#pragma unroll
        for (unsigned j = 0; j < 16; ++j) { const unsigned c = xb_ld(&bar[XB_XCNT(j)]); sum += c; cnt += (c > 0u) ? 1u : 0u; mine = (j == x) ? c : mine; }
        if (sum == G) break;
        __builtin_amdgcn_s_sleep(1);
        if ((++sp & 255u) == 0u) { if (xb_ld(&bar[XB_TMO])) break; if (sp > XB_SPIN_CAP) { atomicAdd(&bar[XB_TMO], 1u); break; } }
    }
    nloc = mine > 0u ? mine : 1u; nx = cnt > 0u ? cnt : 1u;
}

__device__ __forceinline__ void xcd_barrier(const XcdBarrier& b) {
    asm volatile("s_waitcnt vmcnt(0)" ::: "memory");
    __syncthreads();
    if (b.tid == 0) {
        unsigned* bar = b.bar;
        __builtin_amdgcn_s_waitcnt(0);
        unsigned nloc = b.st[0], nx = b.st[1];
        if (nloc == 0u) { xcd_barrier_complete(bar, b.x, nloc, nx); b.st[0] = nloc; b.st[1] = nx; }
        const unsigned old = xb_add(&bar[XB_XSUB(b.x)], 1u);
        const unsigned gen = old / nloc;
        if (old + 1u == (gen + 1u) * nloc) {
            __builtin_amdgcn_fence(__ATOMIC_RELEASE, "agent");
            asm volatile("s_waitcnt vmcnt(0)" ::: "memory");
            const unsigned og = xb_add(&bar[XB_TOP], 1u);
            const unsigned tg = og / nx;
            if (og + 1u == (tg + 1u) * nx) xb_add(&bar[XB_TOPGEN], 1u);
            else XB_SPIN(xb_ld(&bar[XB_TOPGEN]) == tg, bar);
            __builtin_amdgcn_fence(__ATOMIC_ACQUIRE, "agent");
            xb_add(&bar[XB_XGEN(b.x)], 1u);
            asm volatile("s_waitcnt vmcnt(0)" ::: "memory");
        } else {
            XB_SPIN(xb_ld(&bar[XB_XGEN(b.x)]) == gen, bar);
            __builtin_amdgcn_fence(__ATOMIC_ACQUIRE, "agent");
            asm volatile("s_waitcnt vmcnt(0)" ::: "memory");
        }
    }
    __syncthreads();
}
#ifdef TPROBE
#ifndef TP_CU
#define TP_CU 0
#endif
#define TPK_B(id) do { if (TPROBE == (id) && blockIdx.x == TP_CU && threadIdx.x == 0) { const unsigned long long t_ = __builtin_amdgcn_s_memrealtime(); ((LAS unsigned*)(F.lds + 146432))[2] = (unsigned)t_; } } while (0)
#define TPK_E(id) do { if (TPROBE == (id) && blockIdx.x == TP_CU && threadIdx.x == 0) { const unsigned long long t_ = __builtin_amdgcn_s_memrealtime(); ((LAS unsigned*)(F.lds + 146432))[0] += (unsigned)t_ - ((LAS unsigned*)(F.lds + 146432))[2]; } } while (0)
#else
#define TPK_B(id) do {} while (0)
#define TPK_E(id) do {} while (0)
#endif

struct Frame {
    LAS unsigned char* lds;
    int tid, lane, wave, G, bid, vcu;
    float* out; unsigned char* ws;
};
DI unsigned long long lds_ptr(const Frame& F, int i) {
    unsigned a_ = (unsigned)(size_t)(F.lds + MISC_OFF + 256) + 8u * (unsigned)i; asm volatile("" : "+v"(a_));
    const unsigned long long v = *(const volatile LAS unsigned long long*)a_;
    const unsigned lo = __builtin_amdgcn_readfirstlane((unsigned)v), hi = __builtin_amdgcn_readfirstlane((unsigned)(v >> 32));
    return ((unsigned long long)hi << 32) | lo;
}
#define INP(i) ((const float*)(const GAS float*)lds_ptr(F, (i)))
DI int gwave(const Frame& F) { return F.bid * NWAVES + F.wave; }

DI bf16x8 frag_rm(const LAS unsigned char* t, int S, int r0, int k0, int lane) { return *(const LAS bf16x8*)(t + (r0 + (lane & 15)) * S + (k0 + 8 * (lane >> 4)) * 2); }
DI bf16x8 frag_tr(const LAS unsigned char* t, int S, int r0, int k0, int lane) {
    const int g = lane >> 4, q = (lane & 15) >> 2, p = lane & 3;
    const LAS unsigned char* a = t + (k0 + 8 * g + q) * S + (r0 + 4 * p) * 2;
    const v4i16_t lo = __builtin_amdgcn_ds_read_tr16_b64_v4i16((LAS v4i16_t*)a);
    const v4i16_t hi = __builtin_amdgcn_ds_read_tr16_b64_v4i16((LAS v4i16_t*)(a + 4 * S));
    return __builtin_shufflevector(lo, hi, 0, 1, 2, 3, 4, 5, 6, 7);
}
DI f32x4 mma(bf16x8 a, bf16x8 b, f32x4 c) { return __builtin_amdgcn_mfma_f32_16x16x32_bf16(a, b, c, 0, 0, 0); }

DI void load_tile(LAS unsigned char* dst, int S, const bf16* src, size_t ld, int rows, int cols, int tid) {
    const int cpr = cols >> 3, n = rows * cpr;
    for (int i = tid; i < n; i += NTHR) { const int r = i / cpr, c = i - r * cpr;
        *(LAS v4u*)(dst + r * S + c * 16) = *(const v4u*)(src + (size_t)r * ld + c * 8); }
}

template <int COLS> DI unsigned tile_loff(int tid, unsigned ld) { constexpr int CPR = COLS / 8; return (unsigned)(tid / CPR) * ld + (unsigned)(tid % CPR) * 8u; }
template <int ROWS, int COLS, bool NT = false> DI void tile_issue(v4u* r, const bf16* src, unsigned ld, unsigned loff) {
    constexpr int CPR = COLS / 8, N = ROWS * COLS / 4096, RSTEP = NTHR / CPR;
#pragma unroll
    for (int i = 0; i < N; ++i) r[i] = NT ? __builtin_nontemporal_load((const v4u*)((src + (size_t)i * RSTEP * ld) + loff)) : *(const v4u*)((src + (size_t)i * RSTEP * ld) + loff);
}
template <int ROWS, int COLS> DI void tile_commit(const v4u* r, LAS unsigned char* dst, int S, int tid) {
    constexpr int CPR = COLS / 8, N = ROWS * COLS / 4096, RSTEP = NTHR / CPR;
    LAS unsigned char* p = dst + (tid / CPR) * S + (tid % CPR) * 16;
#pragma unroll
    for (int i = 0; i < N; ++i) *(LAS v4u*)(p + i * RSTEP * S) = r[i];
}

DI void transpose_item(const float* W, int K, int N, bf16* WT, int mode, LAS float* scr, int item, int lane) {
    const int nblk = (N + 31) / 32, kb = item / nblk, nb = item % nblk, k0 = 64 * kb, n0 = 32 * nb;
    const int n4 = 4 * (lane & 7), nl = n0 + n4;
    f32x4 v[8];
#pragma unroll
    for (int i = 0; i < 8; ++i) v[i] = nl < N ? __builtin_nontemporal_load((const f32x4*)(W + (size_t)(k0 + 8 * i + (lane >> 3)) * N + nl)) : (f32x4){0.f, 0.f, 0.f, 0.f};
#pragma unroll
    for (int i = 0; i < 8; ++i) { LAS float* d = scr + (8 * i + (lane >> 3)) * 33 + n4; d[0] = v[i][0]; d[1] = v[i][1]; d[2] = v[i][2]; d[3] = v[i][3]; }
    LDS_WAIT(); asm volatile("" ::: "memory");
    const int c = lane & 7;
#pragma unroll
    for (int j = 0; j < 4; ++j) { const int n = (lane >> 3) + 8 * j; const LAS float* s = scr + (8 * c) * 33 + n;
        v4u o; o.x = pk2(s[0 * 33], s[1 * 33]); o.y = pk2(s[2 * 33], s[3 * 33]); o.z = pk2(s[4 * 33], s[5 * 33]); o.w = pk2(s[6 * 33], s[7 * 33]);
        const int ng = n0 + n; const int row = mode == 0 ? ng : (256 * (ng >> 7) + (ng & 127) + (mode == 2 ? 128 : 0));
        *(v4u*)(WT + (size_t)row * K + k0 + 8 * c) = o; }
    LDS_WAIT(); asm volatile("" ::: "memory");
}
DI void convert_weight(Frame& F, const float* W, int K, int N, bf16* WT, int mode, int w0 = 0) {
    if (F.wave < w0) return;
    LAS float* scr = (LAS float*)(F.lds + F.wave * 16384);
    const int nw = NWAVES - w0, nitems = (K / 64) * ((N + 31) / 32), NGW = F.G * nw;
    for (int it = F.bid * nw + (F.wave - w0); it < nitems; it += NGW) transpose_item(W, K, N, WT, mode, scr, it, F.lane);
}
DI void zero_fill(Frame& F, void* p, size_t bytes) {
    v4u* q = (v4u*)p; const size_t n = bytes / 16;
    for (size_t i = (size_t)F.bid * NTHR + F.tid; i < n; i += (size_t)F.G * NTHR) q[i] = (v4u){0u, 0u, 0u, 0u};
}

DI void build_rope(Frame& F) {
    float* rope = (float*)(F.ws + WS_ROPE);
    for (int i = F.bid * NTHR + F.tid; i < 4096 * 128; i += F.G * NTHR) { const int pos = i >> 7, d = i & 127;
        double inv = 1.0; { double r = 0.930572040929699; int e = d; while (e) { if (e & 1) inv *= r; r *= r; e >>= 1; } }
        const float ang = (float)pos * (float)inv;
        double s, c; sincos_d((double)ang, s, c);
        const unsigned short hc = __builtin_bit_cast(unsigned short, (_Float16)(float)c), hs = __builtin_bit_cast(unsigned short, (_Float16)(float)s);
        ((unsigned*)rope)[i] = (unsigned)hc | ((unsigned)hs << 16); }
}
DI void rms_rows_to_bf16(Frame& F, const float* src, const float* w, bf16* dst) {
    const int NGW = F.G * NWAVES;
    f32x4 wv[4];
#pragma unroll
    for (int j = 0; j < 4; ++j) wv[j] = ((const f32x4*)w)[F.lane + 64 * j];
    for (int m = gwave(F); m < M; m += NGW) { const f32x4* xr = (const f32x4*)(src + (size_t)m * D) + F.lane;
        f32x4 v[4]; float s = 0.f;
#pragma unroll
        for (int j = 0; j < 4; ++j) { v[j] = __builtin_nontemporal_load(xr + 64 * j); s += (v[j].x * v[j].x + v[j].y * v[j].y) + (v[j].z * v[j].z + v[j].w * v[j].w); }
        const float rs = rsqrtf(wave_sum(s) * (1.f / D) + EPS);
        v2u* o8 = (v2u*)(dst + (size_t)m * D) + F.lane;
#pragma unroll
        for (int j = 0; j < 4; ++j) { const f32x4 y = v[j] * rs * wv[j]; o8[64 * j] = (v2u){pk2(y.x, y.y), pk2(y.z, y.w)}; } }
}
template <bool IN_F32, bool OUT_F32>
DI void row_phase(Frame& F, const bf16* mbuf, const void* hbase, void* hout, const float* w_post, const float* w_pre, bf16* hn) {
    const int NGW = F.G * NWAVES;
    f32x4 wp[4], wq[4];
#pragma unroll
    for (int j = 0; j < 4; ++j) { wp[j] = ((const f32x4*)w_post)[F.lane + 64 * j]; wq[j] = w_pre ? ((const f32x4*)w_pre)[F.lane + 64 * j] : (f32x4){0.f, 0.f, 0.f, 0.f}; }
    for (int m = gwave(F); m < M; m += NGW) {
        const v2u* mr = (const v2u*)(mbuf + (size_t)m * D) + F.lane;
        f32x4 v[4], h[4]; float s = 0.f;
#pragma unroll
        for (int j = 0; j < 4; ++j) { const v2u mv = __builtin_nontemporal_load(mr + 64 * j); v[j] = (f32x4){bflo(mv.x), bfhi(mv.x), bflo(mv.y), bfhi(mv.y)};
            if (IN_F32) h[j] = ((const f32x4*)((const float*)hbase + (size_t)m * D) + F.lane)[64 * j];
            else { const v2u* hq = (const v2u*)((const bf16*)hbase + (size_t)m * 2048) + F.lane + 64 * j; const v2u hv = OUT_F32 ? __builtin_nontemporal_load(hq) : *hq; h[j] = (f32x4){bflo(hv.x), bfhi(hv.x), bflo(hv.y), bfhi(hv.y)}; }
            s += (v[j].x * v[j].x + v[j].y * v[j].y) + (v[j].z * v[j].z + v[j].w * v[j].w); }
#ifdef PERT_ROW
        const float rs = rsqrtf(wave_sum(s) * (1.f / D) + EPS) * PERT_ROW; float s2 = 0.f;
#else
        const float rs = rsqrtf(wave_sum(s) * (1.f / D) + EPS); float s2 = 0.f;
#endif
#ifdef ALG_Q
        float q2 = 0.f, q3 = 0.f, q4 = 0.f;
#pragma unroll
        for (int j = 0; j < 4; ++j) { const f32x4 wm = v[j] * wp[j]; q2 += (h[j].x * h[j].x + h[j].y * h[j].y) + (h[j].z * h[j].z + h[j].w * h[j].w);
            q3 += (h[j].x * wm.x + h[j].y * wm.y) + (h[j].z * wm.z + h[j].w * wm.w); q4 += (wm.x * wm.x + wm.y * wm.y) + (wm.z * wm.z + wm.w * wm.w); h[j] = h[j] + wm * rs; }
        q2 = wave_sum(q2); q3 = wave_sum(q3); q4 = wave_sum(q4);
        s2 = fmaxf(q2 + rs * (2.0f * q3 + rs * q4), 0.f) * (1.0f / 64.0f);
#else
#pragma unroll
        for (int j = 0; j < 4; ++j) { h[j] = h[j] + v[j] * rs * wp[j]; s2 += (h[j].x * h[j].x + h[j].y * h[j].y) + (h[j].z * h[j].z + h[j].w * h[j].w); }
#endif
        if (OUT_F32) { f32x4* ho = (f32x4*)((float*)hout + (size_t)m * D) + F.lane;
#pragma unroll
            for (int j = 0; j < 4; ++j) __builtin_nontemporal_store(h[j], ho + 64 * j); }
        else { v2u* ho = (v2u*)((bf16*)hout + (size_t)m * 2048) + F.lane;
#pragma unroll
            for (int j = 0; j < 4; ++j) ho[64 * j] = (v2u){pk2(h[j].x, h[j].y), pk2(h[j].z, h[j].w)}; }
        if (hn) { const float rs2 = rsqrtf(wave_sum(s2) * (1.f / D) + EPS);
            v2u* o8 = (v2u*)(hn + (size_t)m * D) + F.lane;
#pragma unroll
            for (int j = 0; j < 4; ++j) { const f32x4 y = h[j] * rs2 * wq[j]; o8[64 * j] = (v2u){pk2(y.x, y.y), pk2(y.z, y.w)}; } }
    }
}

DI void hn_from_h(Frame& F, const bf16* hbase, const float* w, bf16* hn) {
    const int NGW = F.G * NWAVES;
    f32x4 wq[4];
#pragma unroll
    for (int j = 0; j < 4; ++j) wq[j] = ((const f32x4*)w)[F.lane + 64 * j];
    for (int m = gwave(F); m < M; m += NGW) {
        f32x4 h[4]; float s2 = 0.f;
#pragma unroll
        for (int j = 0; j < 4; ++j) { const v2u hv = ((const v2u*)(hbase + (size_t)m * 2048) + F.lane)[64 * j]; h[j] = (f32x4){bflo(hv.x), bfhi(hv.x), bflo(hv.y), bfhi(hv.y)};
            s2 += (h[j].x * h[j].x + h[j].y * h[j].y) + (h[j].z * h[j].z + h[j].w * h[j].w); }
        const float rs2 = rsqrtf(wave_sum(s2) * (1.f / D) + EPS);
        v2u* o8 = (v2u*)(hn + (size_t)m * D) + F.lane;
#pragma unroll
        for (int j = 0; j < 4; ++j) { const f32x4 y = h[j] * rs2 * wq[j]; o8[64 * j] = (v2u){pk2(y.x, y.y), pk2(y.z, y.w)}; }
    }
}

DI float head_lg2(int h) { return __log2f(1.0f - exp2f(-5.0f - (float)h)); }

DI void ret_passA_unit(Frame& F, int unit) {
    const bf16* QKV = (const bf16*)(F.ws + WS_QKV); bf16* RST = (bf16*)(F.ws + WS_SLOT16);
    const int eh = unit & 1, sc = (unit >> 1) & 7, h = (unit >> 4) & 3, b = unit >> 6;
    const int lane = F.lane, w = F.wave, we = w >> 2, wd = w & 3;
    const float lg2 = head_lg2(h), g128 = exp2f(128.f * lg2), g127 = exp2f(127.f * lg2);
    LAS unsigned char* Kt = F.lds;
    LAS unsigned char* Vt = F.lds + 128 * 544;
    f32x4 acc[4][4];
#pragma unroll
    for (int a = 0; a < 4; ++a)
#pragma unroll
        for (int c = 0; c < 4; ++c) acc[a][c] = (f32x4){0.f, 0.f, 0.f, 0.f};
    v4u TK[8], TV[4];
    const unsigned lo_k = tile_loff<256>(F.tid, 3072), lo_v = tile_loff<128>(F.tid, 3072);
    const bf16* kbase = QKV + ((size_t)b * SEQ + sc * 512) * 3072 + 1024 + h * 256; const bf16* vbase = kbase + 1024 + eh * 128;
    tile_issue<128, 256>(TK, kbase, 3072, lo_k); tile_issue<128, 128>(TV, vbase, 3072, lo_v);
#pragma unroll 1
    for (int j = 0; j < 4; ++j) {
        if (j) {
#pragma unroll
            for (int a = 0; a < 4; ++a)
#pragma unroll
                for (int c = 0; c < 4; ++c) acc[a][c] *= g128; }
        __syncthreads();
        tile_commit<128, 256>(TK, Kt, 544, F.tid); tile_commit<128, 128>(TV, Vt, 288, F.tid);
        if (j < 3) { tile_issue<128, 256>(TK, kbase + (size_t)(j + 1) * 128 * 3072, 3072, lo_k); tile_issue<128, 128>(TV, vbase + (size_t)(j + 1) * 128 * 3072, 3072, lo_v); }
        __syncthreads();
#pragma unroll
        for (int ks = 0; ks < 4; ++ks) {
            bf16x8 vf[4], kf[4];
#pragma unroll
            for (int t = 0; t < 4; ++t) { vf[t] = frag_tr(Vt, 288, we * 64 + t * 16, ks * 32, lane); kf[t] = frag_tr(Kt, 544, wd * 64 + t * 16, ks * 32, lane); }
#pragma unroll
            for (int et = 0; et < 4; ++et)
#pragma unroll
                for (int dt = 0; dt < 4; ++dt) acc[et][dt] = mma(kf[dt], vf[et], acc[et][dt]);
        }
    }
    bf16* dst = RST + ((size_t)((b * 4 + h) * 8 + sc) * 256) * 256;
#pragma unroll
    for (int et = 0; et < 4; ++et)
#pragma unroll
        for (int dt = 0; dt < 4; ++dt) { const int e = eh * 128 + we * 64 + et * 16 + (lane & 15), d = wd * 64 + dt * 16 + 4 * (lane >> 4);
            const f32x4 v = acc[et][dt] * g127;
            *(v2u*)(dst + (size_t)e * 256 + d) = (v2u){pk2(v[0], v[1]), pk2(v[2], v[3])}; }
}

DI void ret_scan_item(Frame& F, int item) {
    bf16* RST = (bf16*)(F.ws + WS_SLOT16);
    const int bh = item >> 13, off = (item & 8191) * 8, h = bh & 3;
    const float g512 = exp2f(512.f * head_lg2(h));
    float run[8]; float zf = 0.f; asm volatile("" : "+v"(zf));
#pragma unroll
    for (int k = 0; k < 8; ++k) run[k] = zf;
    v4u* base = (v4u*)(RST + (size_t)(bh * 8) * 65536 + off);
    v4u in[8];
#pragma unroll
    for (int sc = 0; sc < 8; ++sc) in[sc] = __builtin_nontemporal_load(base + (size_t)sc * 8192);
#pragma unroll
    for (int sc = 0; sc < 8; ++sc) {
        v4u o; o.x = pk2(run[0], run[1]); o.y = pk2(run[2], run[3]); o.z = pk2(run[4], run[5]); o.w = pk2(run[6], run[7]);
        base[(size_t)sc * 8192] = o;
        const unsigned cw[4] = {in[sc].x, in[sc].y, in[sc].z, in[sc].w};
#pragma unroll
        for (int k = 0; k < 4; ++k) { run[2 * k] = g512 * run[2 * k] + bflo(cw[k]); run[2 * k + 1] = g512 * run[2 * k + 1] + bfhi(cw[k]); }
    }
}

DI void ret_passC_unit(Frame& F, int unit, bf16* YO) {
    const bf16* QKV = (const bf16*)(F.ws + WS_QKV); const bf16* RST = (const bf16*)(F.ws + WS_SLOT16); const bf16* GZ = (const bf16*)(F.ws + WS_GZ);
    const int qp = unit & 1, sc = (unit >> 1) & 7, h = (unit >> 4) & 3, b = unit >> 6;
    const int lane = F.lane, w = F.wave, wn = w >> 1, wm = w & 1, wn2 = w >> 2, we = w & 3;
    const float lg2 = head_lg2(h), g1 = exp2f(lg2), g128 = exp2f(128.f * lg2);
    LAS unsigned char* Qt = F.lds;
    LAS unsigned char* KV = F.lds + 67584;
    LAS unsigned char* Pt = F.lds + 67584 + 36864;
    LAS float* red = (LAS float*)(F.lds + 67584 + 36864 + 18432);
    const size_t rowsc = (size_t)b * SEQ + sc * 512;
    const bf16* Rbase = RST + (size_t)((b * 4 + h) * 8 + sc) * 65536;
    const bf16* Kb = QKV + rowsc * 3072 + 1024 + h * 256; const bf16* Vb = Kb + 1024;
    v4u T[4];
    const unsigned lo_kv = tile_loff<256>(F.tid, 3072), lo_r = tile_loff<64>(F.tid, 256);
    tile_issue<256, 64>(T, Rbase, 256, lo_r);
#pragma unroll 1
    for (int qi = 0; qi < 2; ++qi) {
        const int i = qp == 0 ? (qi == 0 ? 0 : 3) : (qi == 0 ? 1 : 2);
        const size_t grow0 = rowsc + i * 128;
        f32x4 Y[4][4];
#pragma unroll
        for (int a = 0; a < 4; ++a)
#pragma unroll
            for (int c = 0; c < 4; ++c) Y[a][c] = (f32x4){0.f, 0.f, 0.f, 0.f};
        __syncthreads();
        load_tile(Qt, 528, QKV + grow0 * 3072 + h * 256, 3072, 128, 256, F.tid);
#pragma unroll 1
        for (int ds = 0; ds < 4; ++ds) {
            if (ds) __syncthreads();
            tile_commit<256, 64>(T, KV, 144, F.tid);
            if (ds < 3) tile_issue<256, 64>(T, Rbase + (ds + 1) * 64, 256, lo_r);
            else tile_issue<64, 256>(T, Kb, 3072, lo_kv);
            __syncthreads();
#pragma unroll
            for (int ks = 0; ks < 2; ++ks) {
                bf16x8 qf[4], rf[4];
#pragma unroll
                for (int t = 0; t < 4; ++t) { qf[t] = frag_rm(Qt, 528, wn2 * 64 + t * 16, ds * 64 + ks * 32, lane); rf[t] = frag_rm(KV, 144, we * 64 + t * 16, ks * 32, lane); }
#pragma unroll
                for (int nt = 0; nt < 4; ++nt)
#pragma unroll
                    for (int et = 0; et < 4; ++et) Y[nt][et] = mma(rf[et], qf[nt], Y[nt][et]);
            }
        }
#pragma unroll
        for (int a = 0; a < 4; ++a)
#pragma unroll
            for (int c = 0; c < 4; ++c) Y[a][c] *= g1;
#pragma unroll 1
        for (int kt = 0; kt < 2 * (i + 1); ++kt) {
            const int j = kt >> 1, kh = kt & 1;
            if (j && !kh) {
#pragma unroll
                for (int a = 0; a < 4; ++a)
#pragma unroll
                    for (int c = 0; c < 4; ++c) Y[a][c] *= g128; }
            const size_t krow = (size_t)kt * 64;
            __syncthreads();
            tile_commit<64, 256>(T, KV, 528, F.tid);
            tile_issue<64, 256>(T, Vb + krow * 3072, 3072, lo_kv);
            __syncthreads();
            f32x4 sa[2][2];
#pragma unroll
            for (int a = 0; a < 2; ++a)
#pragma unroll
                for (int c = 0; c < 2; ++c) sa[a][c] = (f32x4){0.f, 0.f, 0.f, 0.f};
#pragma unroll
            for (int ks = 0; ks < 8; ++ks) {
                bf16x8 qf[2], kf[2];
#pragma unroll
                for (int t = 0; t < 2; ++t) { qf[t] = frag_rm(Qt, 528, wn * 32 + t * 16, ks * 32, lane); kf[t] = frag_rm(KV, 528, wm * 32 + t * 16, ks * 32, lane); }
#pragma unroll
                for (int nt = 0; nt < 2; ++nt)
#pragma unroll
                    for (int mt = 0; mt < 2; ++mt) sa[nt][mt] = mma(kf[mt], qf[nt], sa[nt][mt]);
            }
#pragma unroll
            for (int nt = 0; nt < 2; ++nt)
#pragma unroll
                for (int mt = 0; mt < 2; ++mt) { const int n = wn * 32 + nt * 16 + (lane & 15), m = wm * 32 + mt * 16 + 4 * (lane >> 4);
                    f32x4 sv = sa[nt][mt];
                    if (j == i) { const int mk = kh * 64 + m;
#pragma unroll
                        for (int jj = 0; jj < 4; ++jj) sv[jj] = (mk + jj > n) ? 0.f : sv[jj]; }
                    *(LAS v2u*)(Pt + n * 144 + m * 2) = (v2u){pk2(sv[0], sv[1]), pk2(sv[2], sv[3])}; }
            __syncthreads();
            tile_commit<64, 256>(T, KV, 544, F.tid);
            if (kt + 1 < 2 * (i + 1)) tile_issue<64, 256>(T, Kb + (krow + 64) * 3072, 3072, lo_kv);
            else if (qi == 0) tile_issue<256, 64>(T, Rbase, 256, lo_r);
            __syncthreads();
#pragma unroll
            for (int ks = 0; ks < 2; ++ks) {
                bf16x8 pf[4], vf[4];
#pragma unroll
                for (int t = 0; t < 4; ++t) { pf[t] = frag_rm(Pt, 144, wn2 * 64 + t * 16, ks * 32, lane); vf[t] = frag_tr(KV, 544, we * 64 + t * 16, ks * 32, lane); }
#pragma unroll
                for (int nt = 0; nt < 4; ++nt)
#pragma unroll
                    for (int et = 0; et < 4; ++et) Y[nt][et] = mma(vf[et], pf[nt], Y[nt][et]);
            }
        }
        float mean[4], rstd[4];
#pragma unroll
        for (int nt = 0; nt < 4; ++nt) { float sm = 0.f;
#pragma unroll
            for (int et = 0; et < 4; ++et) sm += (Y[nt][et][0] + Y[nt][et][1]) + (Y[nt][et][2] + Y[nt][et][3]);
            sm += __shfl_xor(sm, 16); sm += __shfl_xor(sm, 32);
            if ((lane >> 4) == 0) red[(wn2 * 64 + nt * 16 + lane) * 4 + we] = sm; }
        __syncthreads();
#pragma unroll
        for (int nt = 0; nt < 4; ++nt) { const LAS float* r = red + (wn2 * 64 + nt * 16 + (lane & 15)) * 4; mean[nt] = ((r[0] + r[1]) + (r[2] + r[3])) * (1.f / 256.f); }
        __syncthreads();
#pragma unroll
        for (int nt = 0; nt < 4; ++nt) { float sm = 0.f;
#pragma unroll
            for (int et = 0; et < 4; ++et) { const f32x4 dv = Y[nt][et] - mean[nt]; sm += (dv[0] * dv[0] + dv[1] * dv[1]) + (dv[2] * dv[2] + dv[3] * dv[3]); }
            sm += __shfl_xor(sm, 16); sm += __shfl_xor(sm, 32);
            if ((lane >> 4) == 0) red[(wn2 * 64 + nt * 16 + lane) * 4 + we] = sm; }
        __syncthreads();
#pragma unroll
        for (int nt = 0; nt < 4; ++nt) { const LAS float* r = red + (wn2 * 64 + nt * 16 + (lane & 15)) * 4; rstd[nt] = rsqrtf(((r[0] + r[1]) + (r[2] + r[3])) * (1.f / 256.f) + EPS); }
#pragma unroll
        for (int nt = 0; nt < 4; ++nt)
#pragma unroll
            for (int et = 0; et < 4; ++et) { const int n = wn2 * 64 + nt * 16 + (lane & 15), e = we * 64 + et * 16 + 4 * (lane >> 4);
                const bf16* gp = GZ + (grow0 + n) * 2048 + h * 256 + e;
                const v2u gv = *(const v2u*)gp;
                const f32x4 y = (Y[nt][et] - mean[nt]) * rstd[nt];
                const float o0 = y[0] * silu_f(bflo(gv.x)), o1 = y[1] * silu_f(bfhi(gv.x)), o2 = y[2] * silu_f(bflo(gv.y)), o3 = y[3] * silu_f(bfhi(gv.y));
                *(v2u*)(YO + (gp - GZ)) = (v2u){pk2(o0, o1), pk2(o2, o3)}; }
    }
}

struct SsdPar { const float* conv_w; const float* conv_b; const float* a_log; const float* d_ssd; const float* ssd_norm; };

struct ConvW { f32x4 w[4][2]; f32x4 b[2]; };
DI ConvW load_convw(const float* cw, const float* cb, int col) { ConvW W;
#pragma unroll
    for (int k = 0; k < 4; ++k) { W.w[k][0] = *(const f32x4*)(cw + k * 1536 + col); W.w[k][1] = *(const f32x4*)(cw + k * 1536 + col + 4); }
    W.b[0] = *(const f32x4*)(cb + col); W.b[1] = *(const f32x4*)(cb + col + 4); return W; }
DI void conv8(const bf16* XBC, const ConvW& W, size_t row, int col, float (&o)[8]) {
    const int tin = (int)(row & 4095);
    o[0] = W.b[0][0]; o[1] = W.b[0][1]; o[2] = W.b[0][2]; o[3] = W.b[0][3]; o[4] = W.b[1][0]; o[5] = W.b[1][1]; o[6] = W.b[1][2]; o[7] = W.b[1][3];
#pragma unroll
    for (int k = 0; k < 4; ++k) {
        if (tin - 3 + k >= 0) {
            const v4u x = *(const v4u*)(XBC + (row - 3 + k) * 1536 + col);
            const f32x4 w0 = W.w[k][0], w1 = W.w[k][1];
            o[0] += w0[0] * bflo(x.x); o[1] += w0[1] * bfhi(x.x); o[2] += w0[2] * bflo(x.y); o[3] += w0[3] * bfhi(x.y);
            o[4] += w1[0] * bflo(x.z); o[5] += w1[1] * bfhi(x.z); o[6] += w1[2] * bflo(x.w); o[7] += w1[3] * bfhi(x.w);
        }
    }
#pragma unroll
    for (int k = 0; k < 8; ++k) o[k] = silu_f(o[k]);
}
DI void conv8r(const v4u (&x)[4], const ConvW& W, int tin, float (&o)[8]) {
    o[0] = W.b[0][0]; o[1] = W.b[0][1]; o[2] = W.b[0][2]; o[3] = W.b[0][3]; o[4] = W.b[1][0]; o[5] = W.b[1][1]; o[6] = W.b[1][2]; o[7] = W.b[1][3];
#pragma unroll
    for (int k = 0; k < 4; ++k) {
        if (tin - 3 + k >= 0) { const f32x4 w0 = W.w[k][0], w1 = W.w[k][1];
            o[0] += w0[0] * bflo(x[k].x); o[1] += w0[1] * bfhi(x[k].x); o[2] += w0[2] * bflo(x[k].y); o[3] += w0[3] * bfhi(x[k].y);
            o[4] += w1[0] * bflo(x[k].z); o[5] += w1[1] * bfhi(x[k].z); o[6] += w1[2] * bflo(x[k].w); o[7] += w1[3] * bfhi(x[k].w); }
    }
#pragma unroll
    for (int k = 0; k < 8; ++k) o[k] = silu_f(o[k]);
}
template <int NR, class Fn> DI void conv_rows(const bf16* XBC, const ConvW& W, size_t row0, int col, Fn&& emit) {
    const int tin0 = (int)(row0 & 4095);
    v4u x[NR + 3];
#pragma unroll
    for (int i = 0; i < NR + 3; ++i) x[i] = (tin0 + i - 3 >= 0) ? *(const v4u*)(XBC + (row0 + i - 3) * 1536 + col) : (v4u){0u, 0u, 0u, 0u};
#pragma unroll
    for (int r = 0; r < NR; ++r) { float o[8];
        o[0] = W.b[0][0]; o[1] = W.b[0][1]; o[2] = W.b[0][2]; o[3] = W.b[0][3]; o[4] = W.b[1][0]; o[5] = W.b[1][1]; o[6] = W.b[1][2]; o[7] = W.b[1][3];
#pragma unroll
        for (int k = 0; k < 4; ++k) { const v4u xv = x[r + k]; const f32x4 w0 = W.w[k][0], w1 = W.w[k][1];
            o[0] += w0[0] * bflo(xv.x); o[1] += w0[1] * bfhi(xv.x); o[2] += w0[2] * bflo(xv.y); o[3] += w0[3] * bfhi(xv.y);
            o[4] += w1[0] * bflo(xv.z); o[5] += w1[1] * bfhi(xv.z); o[6] += w1[2] * bflo(xv.w); o[7] += w1[3] * bfhi(xv.w); }
#pragma unroll
        for (int k = 0; k < 8; ++k) o[k] = silu_f(o[k]);
        emit(r, o); }
}
DI v4u pack8(const float (&o)[8], float s) { v4u r; r.x = pk2(o[0] * s, o[1] * s); r.y = pk2(o[2] * s, o[3] * s); r.z = pk2(o[4] * s, o[5] * s); r.w = pk2(o[6] * s, o[7] * s); return r; }

DI float ssd_cumsum(const float* DT, const float* a_log, size_t t0, int grp, int w, int lane, LAS float* cs, LAS float* dtl = nullptr) {
    const int head = grp * 8 + w; const float A = -__expf(a_log[head]);
    const float d0 = DT[(t0 + 2 * lane) * 16 + head], d1 = DT[(t0 + 2 * lane + 1) * 16 + head], v0 = d0 * A, v1 = d1 * A;
    if (dtl) { dtl[w * 128 + 2 * lane] = d0; dtl[w * 128 + 2 * lane + 1] = d1; }
    float x = v0 + v1;
#pragma unroll
    for (int o = 1; o < 64; o <<= 1) { const float t = __shfl_up(x, o); if (lane >= o) x += t; }
    cs[w * 128 + 2 * lane] = x - v1; cs[w * 128 + 2 * lane + 1] = x;
    return __shfl(x, 63);
}

DI void ssd_passA_unit(Frame& F, const SsdPar& P, int unit) {
    const bf16* XBC = (const bf16*)(F.ws + WS_XBC); const float* DT = (const float*)(F.ws + WS_DT);
    bf16* ST = (bf16*)(F.ws + WS_SLOT32); float* CDEC = (float*)(F.ws + WS_MISC);
    const int grp = unit & 1, c = (unit >> 1) & 31, b = unit >> 6;
    const int lane = F.lane, w = F.wave;
    const size_t t0 = (size_t)b * SEQ + c * 128;
    LAS float* cs = (LAS float*)F.lds;
    LAS float* csend = (LAS float*)(F.lds + 4096);
    LAS unsigned char* Bt = F.lds + 4352;
    LAS unsigned char* Xw = F.lds + 4352 + 36864;
    __syncthreads();
    { const float tot = ssd_cumsum(DT, P.a_log, t0, grp, w, lane, cs);
      if (lane == 0) { csend[w] = tot; CDEC[(b * 32 + c) * 16 + grp * 8 + w] = __expf(tot); } }
    { const int cc = F.tid & 15, rb = F.tid >> 4; const ConvW W = load_convw(P.conv_w, P.conv_b, 1024 + grp * 128 + cc * 8);
      conv_rows<4>(XBC, W, t0 + 4 * rb, 1024 + grp * 128 + cc * 8, [&](int r, const float (&o)[8]) { *(LAS v4u*)(Bt + (4 * rb + r) * 288 + cc * 16) = pack8(o, 1.0f); }); }
    for (int hg = 0; hg < 2; ++hg) {
        __syncthreads();
        { const int cc = F.tid & 31, rb = F.tid >> 5, hd = hg * 4 + (cc >> 3); const ConvW W = load_convw(P.conv_w, P.conv_b, grp * 512 + hg * 256 + cc * 8);
          conv_rows<8>(XBC, W, t0 + 8 * rb, grp * 512 + hg * 256 + cc * 8, [&](int r, const float (&o)[8]) { const int rr = 8 * rb + r;
              const float sc = DT[(t0 + rr) * 16 + grp * 8 + hd] * __expf(csend[hd] - cs[hd * 128 + rr]);
              *(LAS v4u*)(Xw + rr * 544 + cc * 16) = pack8(o, sc); }); }
        __syncthreads();
        const int hl = w >> 1, nh = w & 1;
        f32x4 acc[4][4];
#pragma unroll
        for (int a = 0; a < 4; ++a)
#pragma unroll
            for (int q = 0; q < 4; ++q) acc[a][q] = (f32x4){0.f, 0.f, 0.f, 0.f};
#pragma unroll
        for (int ks = 0; ks < 4; ++ks) {
            bf16x8 xf[4], bfr[4];
#pragma unroll
            for (int t = 0; t < 4; ++t) { xf[t] = frag_tr(Xw, 544, hl * 64 + t * 16, ks * 32, lane); bfr[t] = frag_tr(Bt, 288, nh * 64 + t * 16, ks * 32, lane); }
#pragma unroll
            for (int pt = 0; pt < 4; ++pt)
#pragma unroll
                for (int nt = 0; nt < 4; ++nt) acc[pt][nt] = mma(bfr[nt], xf[pt], acc[pt][nt]);
        }
        const int head = grp * 8 + hg * 4 + hl;
        bf16* dst = ST + (size_t)((b * 32 + c) * 16 + head) * 8192;
#pragma unroll
        for (int pt = 0; pt < 4; ++pt)
#pragma unroll
            for (int nt = 0; nt < 4; ++nt) { const int p = pt * 16 + (lane & 15), n = nh * 64 + nt * 16 + 4 * (lane >> 4); const f32x4 v = acc[pt][nt];
                *(v2u*)(dst + p * 128 + n) = (v2u){pk2(v[0], v[1]), pk2(v[2], v[3])}; }
    }
}

DI void ssd_scan_item(Frame& F, int item) {
    bf16* ST = (bf16*)(F.ws + WS_SLOT32); const float* CDEC = (const float*)(F.ws + WS_MISC);
    const int bh = item >> 11, b = bh >> 4, head = bh & 15, off = (item & 2047) * 4;
    float run[4]; float zf = 0.f; asm volatile("" : "+v"(zf));
#pragma unroll
    for (int k = 0; k < 4; ++k) run[k] = zf;
    v2u* base = (v2u*)(ST + (size_t)((b * 32) * 16 + head) * 8192 + off);
    const float* dbase = CDEC + (b * 32) * 16 + head;
    v2u cur[8], nxt[8]; float dc[8], dn[8];
#pragma unroll
    for (int q = 0; q < 8; ++q) { cur[q] = __builtin_nontemporal_load(base + (size_t)q * 32768); dc[q] = dbase[q * 16]; }
#pragma unroll 1
    for (int cb = 0; cb < 4; ++cb) {
        const int cn = cb < 3 ? cb + 1 : cb;
#pragma unroll
        for (int q = 0; q < 8; ++q) { nxt[q] = __builtin_nontemporal_load(base + (size_t)(cn * 8 + q) * 32768); dn[q] = dbase[(cn * 8 + q) * 16]; }
#pragma unroll
        for (int q = 0; q < 8; ++q) {
            base[(size_t)(cb * 8 + q) * 32768] = (v2u){pk2(run[0], run[1]), pk2(run[2], run[3])};
            run[0] = dc[q] * run[0] + bflo(cur[q].x); run[1] = dc[q] * run[1] + bfhi(cur[q].x); run[2] = dc[q] * run[2] + bflo(cur[q].y); run[3] = dc[q] * run[3] + bfhi(cur[q].y); }
#pragma unroll
        for (int q = 0; q < 8; ++q) { cur[q] = nxt[q]; dc[q] = dn[q]; }
    }
}

template <int DBG = 0> DI void ssd_passC_unit(Frame& F, const SsdPar& P, int unit, bf16* YO) {
    const bf16* XBC = (const bf16*)(F.ws + WS_XBC); const float* DT = (const float*)(F.ws + WS_DT);
    const bf16* ST = (const bf16*)(F.ws + WS_SLOT32); const bf16* GZ = (const bf16*)(F.ws + WS_GZ);
    const int grp = unit & 1, c = (unit >> 1) & 31, b = unit >> 6;
    const int lane = F.lane, w = F.wave;
    TPK_B(120);
    const size_t t0 = (size_t)b * SEQ + c * 128;
    LAS float* cs = (LAS float*)F.lds;
    LAS float* dtl = (LAS float*)(F.lds + 4096);
    LAS unsigned char* Ct = F.lds + 8192;
    LAS unsigned char* BM = F.lds + 43008;
    LAS unsigned char* Xd = F.lds + 77824;
    LAS unsigned char* Pv = F.lds + 98304;
    LAS float* rowss = (LAS float*)(F.lds + 115712);
    LAS float* wtab = (LAS float*)(F.lds + 123904);
    __syncthreads();
    (void)ssd_cumsum(DT, P.a_log, t0, grp, w, lane, cs, dtl);
    for (int i = F.tid; i < 5 * 128; i += NTHR) { const int k = i >> 7, c4 = (i & 127) * 4;
        *(LAS f32x4*)(wtab + k * 512 + c4) = *(const f32x4*)((k < 4 ? P.conv_w + k * 1536 : P.conv_b) + grp * 512 + c4); }
#pragma unroll
    for (int which = 0; which < 2; ++which) {
        const int cc = F.tid & 15, rb = F.tid >> 4; const ConvW W = load_convw(P.conv_w, P.conv_b, 1024 + which * 256 + grp * 128 + cc * 8);
        LAS unsigned char* dstt = which ? Ct : BM;
        conv_rows<4>(XBC, W, t0 + 4 * rb, 1024 + which * 256 + grp * 128 + cc * 8, [&](int r, const float (&o)[8]) { *(LAS v4u*)(dstt + (4 * rb + r) * 272 + cc * 16) = pack8(o, 1.0f); }); }
    const int r0 = F.tid >> 3, cc8 = (F.tid & 7) * 8, tin0 = (int)((t0 + r0) & 4095);
    const int wl = w >> 1, ws = w & 1, wp = w & 1;
    v4u XR[2][4], PVr[2]; v2u ZN[2][2], ZC[2][2];
    const unsigned lo_p = tile_loff<128>(F.tid, 128);
#define SSD_ISSUE(hd_) do { const int hcol_ = grp * 512 + (hd_) * 64 + cc8; \
        _Pragma("unroll") for (int it_ = 0; it_ < 2; ++it_) _Pragma("unroll") for (int k_ = 0; k_ < 4; ++k_) \
            if (tin0 + 64 * it_ - 3 + k_ >= 0) XR[it_][k_] = *(const v4u*)(XBC + (t0 + r0 + 64 * it_ - 3 + k_) * 1536 + hcol_); \
        tile_issue<64, 128>(PVr, ST + (size_t)((b * 32 + c) * 16 + grp * 8 + (hd_)) * 8192, 128, lo_p); \
        _Pragma("unroll") for (int lt_ = 0; lt_ < 2; ++lt_) _Pragma("unroll") for (int pt_ = 0; pt_ < 2; ++pt_) \
            ZN[lt_][pt_] = *(const v2u*)(GZ + (t0 + wl * 32 + lt_ * 16 + (lane & 15)) * 2048 + 1024 + (grp * 8 + (hd_)) * 64 + wp * 32 + pt_ * 16 + 4 * (lane >> 4)); } while (0)
    SSD_ISSUE(0);
    __syncthreads();
    f32x4 cb[2][4];
#pragma unroll
    for (int a = 0; a < 2; ++a)
#pragma unroll
        for (int q = 0; q < 4; ++q) cb[a][q] = (f32x4){0.f, 0.f, 0.f, 0.f};
#pragma unroll
    for (int ks = 0; ks < 4; ++ks) {
        bf16x8 cf[2], bfr[4];
#pragma unroll
        for (int t = 0; t < 2; ++t) cf[t] = frag_rm(Ct, 272, wl * 32 + t * 16, ks * 32, lane);
#pragma unroll
        for (int t = 0; t < 4; ++t) bfr[t] = frag_rm(BM, 272, ws * 64 + t * 16, ks * 32, lane);
#pragma unroll
        for (int lt = 0; lt < 2; ++lt)
#pragma unroll
            for (int st = 0; st < 4; ++st) cb[lt][st] = mma(bfr[st], cf[lt], cb[lt][st]);
    }
    TPK_E(120); TPK_B(121);
#pragma unroll 1
    for (int hd = 0; hd < 8; ++hd) {
        const int head = grp * 8 + hd;
        ConvW W;
#pragma unroll
        for (int k = 0; k < 4; ++k) { W.w[k][0] = *(const LAS f32x4*)(wtab + k * 512 + hd * 64 + cc8); W.w[k][1] = *(const LAS f32x4*)(wtab + k * 512 + hd * 64 + cc8 + 4); }
        W.b[0] = *(const LAS f32x4*)(wtab + 4 * 512 + hd * 64 + cc8); W.b[1] = *(const LAS f32x4*)(wtab + 4 * 512 + hd * 64 + cc8 + 4);
        const float dsk = P.d_ssd[head];
        __syncthreads();
        if (!(DBG & 1))
#pragma unroll
        for (int lt = 0; lt < 2; ++lt) { const int l = wl * 32 + lt * 16 + (lane & 15); const float csl = cs[hd * 128 + l], dgl = dsk * __builtin_amdgcn_rcpf(dtl[hd * 128 + l]);
#pragma unroll
            for (int st = 0; st < 4; ++st) { const int s = ws * 64 + st * 16 + 4 * (lane >> 4); f32x4 m;
                const f32x4 cs4 = *(const LAS f32x4*)(cs + hd * 128 + s);
#pragma unroll
                for (int jj = 0; jj < 4; ++jj) { const float e = __expf(fminf(csl - cs4[jj], 0.f)); m[jj] = (s + jj <= l) ? cb[lt][st][jj] * e : 0.f; m[jj] += (s + jj == l) ? dgl : 0.f; }
                *(LAS v2u*)(BM + l * 272 + s * 2) = (v2u){pk2(m[0], m[1]), pk2(m[2], m[3])}; } }
        if (!(DBG & 2))
#pragma unroll
        for (int it = 0; it < 2; ++it) { float o[8]; conv8r(XR[it], W, tin0 + 64 * it, o);
            *(LAS v4u*)(Xd + (r0 + 64 * it) * 160 + cc8 * 2) = pack8(o, dtl[hd * 128 + r0 + 64 * it]); }
        tile_commit<64, 128>(PVr, Pv, 272, F.tid);
#pragma unroll
        for (int lt = 0; lt < 2; ++lt)
#pragma unroll
            for (int pt = 0; pt < 2; ++pt) ZC[lt][pt] = ZN[lt][pt];
        if (hd < 7) SSD_ISSUE(hd + 1);
        __syncthreads();
        f32x4 yd[2][2], yo[2][2];
#pragma unroll
        for (int a2 = 0; a2 < 2; ++a2)
#pragma unroll
            for (int q = 0; q < 2; ++q) { yd[a2][q] = (f32x4){0.f, 0.f, 0.f, 0.f}; yo[a2][q] = (f32x4){0.f, 0.f, 0.f, 0.f}; }
        if (!(DBG & 4))
#pragma unroll
        for (int ks = 0; ks < 4; ++ks) {
            bf16x8 mf[2], xf[2], cf[2], pf[2];
#pragma unroll
            for (int t = 0; t < 2; ++t) { if (!(DBG & 8)) { mf[t] = frag_rm(BM, 272, wl * 32 + t * 16, ks * 32, lane); xf[t] = frag_tr(Xd, 160, wp * 32 + t * 16, ks * 32, lane); }
                                          if (!(DBG & 16)) { cf[t] = frag_rm(Ct, 272, wl * 32 + t * 16, ks * 32, lane); pf[t] = frag_rm(Pv, 272, wp * 32 + t * 16, ks * 32, lane); } }
#pragma unroll
            for (int lt = 0; lt < 2; ++lt)
#pragma unroll
                for (int pt = 0; pt < 2; ++pt) { if (!(DBG & 8)) yd[lt][pt] = mma(xf[pt], mf[lt], yd[lt][pt]); if (!(DBG & 16)) yo[lt][pt] = mma(pf[pt], cf[lt], yo[lt][pt]); }
        }
#pragma unroll
        for (int lt = 0; lt < 2; ++lt) { const int l = wl * 32 + lt * 16 + (lane & 15); const float ecs = __expf(cs[hd * 128 + l]); float ss = 0.f;
#pragma unroll
            for (int pt = 0; pt < 2; ++pt) { const int p = wp * 32 + pt * 16 + 4 * (lane >> 4);
                const v2u zv = ZC[lt][pt];
                f32x4 y = yd[lt][pt] + ecs * yo[lt][pt];
                y[0] *= silu_f(bflo(zv.x)); y[1] *= silu_f(bfhi(zv.x)); y[2] *= silu_f(bflo(zv.y)); y[3] *= silu_f(bfhi(zv.y));
                ss += (y[0] * y[0] + y[1] * y[1]) + (y[2] * y[2] + y[3] * y[3]);
                if (YO) *(v2u*)(YO + (t0 + l) * 2048 + 1024 + head * 64 + p) = (v2u){pk2(y[0], y[1]), pk2(y[2], y[3])}; }
            ss += __shfl_xor(ss, 16); ss += __shfl_xor(ss, 32);
            if ((lane >> 4) == 0) rowss[(hd * 2 + wp) * 128 + l] = ss; }
    }
    TPK_E(121); TPK_B(122);
#undef SSD_ISSUE
    if (!YO) return;
    asm volatile("s_waitcnt vmcnt(0)" ::: "memory");
    __syncthreads();
    LAS float* rst = (LAS float*)F.lds;
    if (F.tid < 128) { float t = 0.f;
#pragma unroll
        for (int q = 0; q < 16; ++q) t += rowss[q * 128 + F.tid];
        rst[F.tid] = rsqrtf(t * (1.f / 512.f) + EPS); }
    __syncthreads();
    { const int cc = F.tid & 63; const f32x4 n0 = *(const f32x4*)(P.ssd_norm + grp * 512 + cc * 8), n1 = *(const f32x4*)(P.ssd_norm + grp * 512 + cc * 8 + 4);
#pragma unroll 1
      for (int ib = 0; ib < 16; ib += 8) {
      v4u vv[8];
#pragma unroll
      for (int it = 0; it < 8; ++it) vv[it] = *(const v4u*)(YO + (t0 + (F.tid >> 6) + (ib + it) * 8) * 2048 + 1024 + grp * 512 + cc * 8);
#pragma unroll
      for (int it = 0; it < 8; ++it) { const int r = (F.tid >> 6) + (ib + it) * 8; const float rs = rst[r];
          v4u* gp = (v4u*)(YO + (t0 + r) * 2048 + 1024 + grp * 512 + cc * 8); const v4u v = vv[it];
          v4u o; o.x = pk2(bflo(v.x) * rs * n0[0], bfhi(v.x) * rs * n0[1]); o.y = pk2(bflo(v.y) * rs * n0[2], bfhi(v.y) * rs * n0[3]);
          o.z = pk2(bflo(v.z) * rs * n1[0], bfhi(v.z) * rs * n1[1]); o.w = pk2(bflo(v.w) * rs * n1[2], bfhi(v.w) * rs * n1[3]);
          *gp = o; } } }
    TPK_E(122);
}

struct S5Par { const float* lam_re; const float* lam_im; const float* log_step; const float* b_re; const float* b_im; const float* c_re; const float* c_im; const float* d_s5; };

DI void s5_build_unit(Frame& F, const S5Par& P, int unit) {
    const int g = unit >> 2, cq = unit & 3;
    bf16* AB = (bf16*)(F.ws + WS_S5MAT + (size_t)g * 262144); bf16* E = AB + 256 * 384;
    LAS f32x2v* pw = (LAS f32x2v*)F.lds;
    LAS f32x2v* Bb = (LAS f32x2v*)(F.lds + 8704);
    LAS f32x2v* Cc = (LAS f32x2v*)(F.lds + 16896);
    LAS float* Km = (LAS float*)(F.lds + 25088);
    LAS f32x2v* cf = (LAS f32x2v*)(F.lds + 29184);
    __syncthreads();
    for (int i = F.tid; i < 17 * 64; i += NTHR) { const int t = i >> 6, p = i & 63;
        const double lr = fmin((double)P.lam_re[g * 64 + p], -1e-4), li = (double)P.lam_im[g * 64 + p], dl = (double)expf(P.log_step[g]);
        const double mag = (double)expf((float)(t * lr * dl)); double sn, cs_; sincos_d(t * li * dl, sn, cs_);
        pw[i] = (f32x2v){(float)(mag * cs_), (float)(mag * sn)};
        if (t == 1) { const double den = lr * lr + li * li, nr = mag * cs_ - 1.0, ni = mag * sn; cf[p] = (f32x2v){(float)((nr * lr + ni * li) / den), (float)((ni * lr - nr * li) / den)}; } }
    __syncthreads();
    for (int i = F.tid; i < 1024; i += NTHR) { const int p = i >> 4; const f32x2v c = cf[p]; const float br = P.b_re[g * 1024 + i], bi = P.b_im[g * 1024 + i];
        Bb[i] = (f32x2v){c.x * br - c.y * bi, c.x * bi + c.y * br}; }
    for (int i = F.tid; i < 1024; i += NTHR) Cc[i] = (f32x2v){P.c_re[g * 1024 + i], P.c_im[g * 1024 + i]};
    __syncthreads();
    for (int i = F.tid; i < 1024; i += NTHR) { const int t = i >> 6, cl = (i >> 4) & 3, c2 = i & 15, c = cq * 4 + cl; float acc = 0.f;
        for (int p = 0; p < 64; ++p) { const f32x2v cc = Cc[c * 64 + p], a = pw[t * 64 + p], bb = Bb[p * 16 + c2];
            const float tr = cc.x * a.x - cc.y * a.y, ti = cc.x * a.y + cc.y * a.x; acc += tr * bb.x - ti * bb.y; }
        Km[i] = acc; }
    __syncthreads();
    for (int i = F.tid; i < 64 * 48; i += NTHR) { const int rl = i / 48, c8 = (i % 48) * 8, l = rl >> 2, cl = rl & 3, c = cq * 4 + cl, row = l * 16 + c; float v[8];
        if (c8 < 256) { const int s = c8 >> 4, c2 = c8 & 15;
#pragma unroll
            for (int k = 0; k < 8; ++k) v[k] = s <= l ? Km[((l - s) * 4 + cl) * 16 + c2 + k] : 0.f;
        } else { const bool im = c8 >= 320; const int p0 = c8 - (im ? 320 : 256);
#pragma unroll
            for (int k = 0; k < 8; ++k) { const f32x2v cc = Cc[c * 64 + p0 + k], a = pw[(l + 1) * 64 + p0 + k];
                v[k] = im ? -(cc.x * a.y + cc.y * a.x) : (cc.x * a.x - cc.y * a.y); } }
        *(v4u*)(AB + (size_t)row * 384 + c8) = (v4u){pk2(v[0], v[1]), pk2(v[2], v[3]), pk2(v[4], v[5]), pk2(v[6], v[7])}; }
    for (int i = F.tid; i < 32 * 32; i += NTHR) { const int rl = i >> 5, c8 = (i & 31) * 8, p = cq * 16 + (rl & 15), s = c8 >> 4, c2 = c8 & 15; const bool im = rl >= 16; const int row = (im ? 64 : 0) + p; float v[8];
        const f32x2v a = pw[(15 - s) * 64 + p];
#pragma unroll
        for (int k = 0; k < 8; ++k) { const f32x2v bb = Bb[p * 16 + c2 + k]; v[k] = im ? (a.x * bb.y + a.y * bb.x) : (a.x * bb.x - a.y * bb.y); }
        *(v4u*)(E + (size_t)row * 256 + c8) = (v4u){pk2(v[0], v[1]), pk2(v[2], v[3]), pk2(v[4], v[5]), pk2(v[6], v[7])}; }
}

DI void s5_gemmA_unit(Frame& F, int unit) {
    const bf16* HN = (const bf16*)(F.ws + WS_SLOT32); float* EO = (float*)(F.ws + WS_S5E);
    const int gp = unit >> 3, te = unit & 7, b = te >> 1, lane = F.lane, w = F.wave, g = 2 * gp + (w & 1), i = lane & 15, gq = lane >> 4;
    LAS unsigned char* Et = F.lds + (w & 1) * 67584;
    __syncthreads();
    load_tile(F.lds, 528, (const bf16*)(F.ws + WS_S5MAT + (size_t)(2 * gp) * 262144) + 256 * 384, 256, 128, 256, F.tid);
    load_tile(F.lds + 67584, 528, (const bf16*)(F.ws + WS_S5MAT + (size_t)(2 * gp + 1) * 262144) + 256 * 384, 256, 128, 256, F.tid);
    __syncthreads();
#pragma unroll 1
    for (int t = 0; t < 2; ++t) { const int k0 = (te & 1) * 128 + ((w >> 1) * 2 + t) * 16;
        const bf16* hp = HN + ((size_t)b * SEQ + 16 * (k0 + i) + (gq >> 1)) * D + 16 * g + 8 * (gq & 1);
        bf16x8 uf[8];
#pragma unroll
        for (int ks = 0; ks < 8; ++ks) uf[ks] = *(const bf16x8*)(hp + (size_t)(2 * ks) * D);
        f32x4 acc[8];
#pragma unroll
        for (int mt = 0; mt < 8; ++mt) acc[mt] = (f32x4){0.f, 0.f, 0.f, 0.f};
#pragma unroll
        for (int ks = 0; ks < 8; ++ks) {
#pragma unroll
            for (int mt = 0; mt < 8; ++mt) acc[mt] = mma(frag_rm(Et, 528, mt * 16, ks * 32, lane), uf[ks], acc[mt]);
            if (ks & 1) __builtin_amdgcn_sched_barrier(0); }
        float* dst = EO + ((size_t)((b * 256 + k0 + i) * 64 + g)) * 128 + 4 * gq;
#pragma unroll
        for (int mt = 0; mt < 8; ++mt) *(f32x4*)(dst + mt * 16) = acc[mt]; }
}

DI void s5_scan_task(Frame& F, const float* lam_re, const float* lam_im, const float* log_step, int task, int dbg) {
    const float* EO = (const float*)(F.ws + WS_S5E); bf16* XO = (bf16*)(F.ws + WS_S5X);
    const int b = task >> 6, g = task & 63, p = F.lane;
    f32x2v a;
    { const double lr = fmin((double)lam_re[g * 64 + p], -1e-4), li = (double)lam_im[g * 64 + p], dl = (double)expf(log_step[g]);
      const double mag = (double)expf((float)(16.0 * lr * dl)); double s, c; sincos_d(16.0 * li * dl, s, c); a = (f32x2v){(float)(mag * c), (float)(mag * s)}; }
    if (dbg == 6) a = (f32x2v){0.f, 0.f};
    float rr = 0.f, ri = 0.f;
    const float* ep = EO + ((size_t)(b * 256) * 64 + g) * 128 + p; bf16* xp = XO + ((size_t)(b * 256) * 64 + g) * 128 + p;
    float er[16], ei[16], fr_[16], fi_[16];
#pragma unroll
    for (int s2 = 0; s2 < 16; ++s2) { er[s2] = ep[(size_t)s2 * 8192]; ei[s2] = ep[(size_t)s2 * 8192 + 64]; }
#pragma unroll 1
    for (int kb = 0; kb < 16; ++kb) {
        const int kn = kb < 15 ? kb + 1 : kb;
#pragma unroll
        for (int s2 = 0; s2 < 16; ++s2) { fr_[s2] = ep[(size_t)(kn * 16 + s2) * 8192]; fi_[s2] = ep[(size_t)(kn * 16 + s2) * 8192 + 64]; }
#pragma unroll
        for (int s2 = 0; s2 < 16; ++s2) { bf16* xo = xp + (size_t)(kb * 16 + s2) * 8192;
            xo[0] = (bf16)f2bf(rr); xo[64] = (bf16)f2bf(ri);
            const float nr = a.x * rr - a.y * ri + er[s2], ni = a.x * ri + a.y * rr + ei[s2]; rr = nr; ri = ni; }
#pragma unroll
        for (int s2 = 0; s2 < 16; ++s2) { er[s2] = fr_[s2]; ei[s2] = fi_[s2]; }
    }
}

DI float gelu_tanh(float v) { const float u = 0.7978845608028654f * (v + 0.044715f * v * v * v); const float t = 1.0f - 2.0f * __builtin_amdgcn_rcpf(__expf(2.0f * u) + 1.0f); return 0.5f * v * (1.0f + t); }

DI void s5_gemmB_unit(Frame& F, const float* d_s5, int unit) {
    const bf16* HN = (const bf16*)(F.ws + WS_SLOT32); const bf16* XO = (const bf16*)(F.ws + WS_S5X); bf16* Y = (bf16*)(F.ws + WS_Y);
    const int g = unit >> 2, lh = (unit >> 1) & 1, th = unit & 1, lane = F.lane, w = F.wave, i = lane & 15, gq = lane >> 4;
    const bf16* AB = (const bf16*)(F.ws + WS_S5MAT + (size_t)g * 262144) + (size_t)(128 * lh) * 384;
    LAS unsigned char* A = F.lds;
    __syncthreads();
    load_tile(A, 784, AB, 384, 128, 384, F.tid);
    __syncthreads();
    const int colg = 16 * g + 4 * gq;
    const f32x4 dv = *(const f32x4*)(d_s5 + colg);
#pragma unroll 1
    for (int t = 0; t < 4; ++t) { const int nt = w * 4 + t, b = 2 * th + (nt >> 4), k0 = (nt & 15) * 16;
        const bf16* hp = HN + ((size_t)b * SEQ + 16 * (k0 + i) + (gq >> 1)) * D + 16 * g + 8 * (gq & 1);
        const bf16* xp = XO + ((size_t)((b * 256 + k0 + i) * 64 + g)) * 128 + 8 * gq;
        bf16x8 uf[12];
#pragma unroll
        for (int ks = 0; ks < 8; ++ks) uf[ks] = *(const bf16x8*)(hp + (size_t)(2 * ks) * D);
#pragma unroll
        for (int ks = 0; ks < 4; ++ks) uf[8 + ks] = *(const bf16x8*)(xp + ks * 32);
        f32x4 acc[8];
#pragma unroll
        for (int mt = 0; mt < 8; ++mt) acc[mt] = (f32x4){0.f, 0.f, 0.f, 0.f};
#pragma unroll
        for (int ks = 0; ks < 12; ++ks) {
#pragma unroll
            for (int mt = 0; mt < 8; ++mt) acc[mt] = mma(frag_rm(A, 784, mt * 16, ks * 32, lane), uf[ks], acc[mt]);
            __builtin_amdgcn_sched_barrier(0); }
#pragma unroll
        for (int mt = 0; mt < 8; ++mt) { const size_t tok = (size_t)b * SEQ + 16 * (k0 + i) + 8 * lh + mt;
            const v2u hv = *(const v2u*)(HN + tok * D + colg);
            const float y0 = gelu_tanh(acc[mt][0] + dv[0] * bflo(hv.x)), y1 = gelu_tanh(acc[mt][1] + dv[1] * bfhi(hv.x));
            const float y2 = gelu_tanh(acc[mt][2] + dv[2] * bflo(hv.y)), y3 = gelu_tanh(acc[mt][3] + dv[3] * bfhi(hv.y));
            *(v2u*)(Y + tok * D + colg) = (v2u){pk2(y0, y1), pk2(y2, y3)}; } }
}

#ifndef CONV_OLD
#define CONV_OLD 0
#endif
#ifndef FUSE_E5
#define FUSE_E5 1
#endif
#ifndef FUSE_DOWN
#define FUSE_DOWN 15
#endif
#ifndef REP_BAR
#define REP_BAR 1
#endif
#ifndef REP_CONV
#define REP_CONV 1
#endif
#ifndef REP_ROW
#define REP_ROW 1
#endif
#ifndef REP_RC
#define REP_RC 1
#endif
#ifndef REP_SC
#define REP_SC 1
#endif
#ifndef SC_DBG
#define SC_DBG 0
#endif
#ifndef REP_GEMM
#define REP_GEMM 1
#endif
#ifndef REP_S5A
#define REP_S5A 1
#endif
#ifndef REP_S5S
#define REP_S5S 1
#endif
#ifndef REP_S5B
#define REP_S5B 1
#endif
#ifndef REP_RA
#define REP_RA 1
#endif
#ifndef REP_SA
#define REP_SA 1
#endif
#ifndef SKIP_EVEN
#define SKIP_EVEN 0
#endif
#ifndef SKIP_ODD
#define SKIP_ODD 0
#endif
DI int opq(int v) { asm volatile("" : "+s"(v)); return v; }
#define CS_STR2(x) #x
#define CS_STR(x) CS_STR2(x)
#ifdef CODE_SHIFT
#define CODE_SHIFT_STR CS_STR(CODE_SHIFT)
#endif
struct Args { const float* in[N_IN]; float* out; unsigned char* ws; };
constexpr int CW_BAR = 1024;

#define PHASE() do { unsigned z_ = 0u; asm volatile("" : "+s"(z_)); int l_ = __builtin_amdgcn_mbcnt_hi(~0u, __builtin_amdgcn_mbcnt_lo(~0u, z_)); int w_ = wave0; asm volatile("" : "+s"(w_)); \
        int g_ = gridDim.x, b_ = blockIdx.x; asm volatile("" : "+s"(g_), "+s"(b_)); F.G = g_; F.bid = b_; F.vcu = (g_ % 8 == 0) ? (b_ % 8) * (g_ / 8) + b_ / 8 : b_; F.lane = l_; F.wave = w_; F.tid = w_ * 64 + l_; F.out = (float*)(GAS float*)lds_ptr(F, N_IN); F.ws = (unsigned char*)(GAS unsigned char*)lds_ptr(F, N_IN + 1); } while (0)
#define WSP(T, off) ((T*)(F.ws + (off)))
#ifdef TPROBE
#define TPB_B() do { if (TPROBE >= 100 && blockIdx.x == TP_CU && threadIdx.x == 0) { LAS unsigned* w_ = (LAS unsigned*)(F.lds + 146432); if (w_[3] == (unsigned)(TPROBE - 100)) w_[2] = (unsigned)__builtin_amdgcn_s_memrealtime(); } } while (0)
#define TPB_E() do { if (TPROBE >= 100 && blockIdx.x == TP_CU && threadIdx.x == 0) { LAS unsigned* w_ = (LAS unsigned*)(F.lds + 146432); if (w_[3] == (unsigned)(TPROBE - 100)) w_[0] += (unsigned)__builtin_amdgcn_s_memrealtime() - w_[2]; w_[3] += 1u; } } while (0)
#else
#define TPB_B() do {} while (0)
#define TPB_E() do {} while (0)
#endif
#define GRID_BAR() do { PHASE(); TPK_B(50); TPB_B(); XcdBarrier xb_; xb_.bar = (unsigned*)(F.ws + WS_CTL) + CW_BAR; xb_.x = xb_xcc_id(); xb_.tid = F.tid; xb_.st = (volatile LAS unsigned*)(F.lds + MISC_OFF) + 8; xcd_barrier(xb_); if (REP_BAR == 2) xcd_barrier(xb_); PHASE(); TPK_E(50); TPB_E(); } while (0)
template <int layer> __device__ __forceinline__ void run_layer(Frame& F, const int wave0) {
        const int j = layer >> 1;
        if ((layer & 1) == 0) {
            if (!opq(SKIP_EVEN)) {
            { pg8::Gemm g{WSP(bf16, WS_SLOT32), WSP(bf16, WS_SLOT16), M, INP_PAD, D}; pg8::StaticOrder S; S.init(M, INP_PAD, F.G, F.bid);
              pg8::EpiInProj E{WSP(bf16, WS_QKV), WSP(bf16, WS_GZ), WSP(bf16, WS_XBC), WSP(float, WS_DT), (const float*)(F.ws + WS_ROPE), INP(I_DT_BIAS) + j * 16};
              pg8::gemm_phase<pg8::EpiInProj, pg8::StaticOrder, true, true>(F.lds, g, S, E, F.tid); }
#if REP_GEMM == 2 || defined(REP_G_INP)
            { PHASE(); pg8::Gemm g{WSP(bf16, WS_SLOT32), WSP(bf16, WS_SLOT16), M, INP_PAD, D}; pg8::StaticOrder S; S.init(M, INP_PAD, F.G, F.bid);
              pg8::EpiInProj E{WSP(bf16, WS_QKV), WSP(bf16, WS_GZ), WSP(bf16, WS_XBC), WSP(float, WS_DT), (const float*)(F.ws + WS_ROPE), INP(I_DT_BIAS) + j * 16};
              pg8::gemm_phase<pg8::EpiInProj, pg8::StaticOrder, true, true>(F.lds, g, S, E, F.tid); }
#endif
            GRID_BAR();
            for (int rep_ = 0; rep_ < REP_RA; ++rep_) for (int u = F.vcu; u < 256; u += F.G) ret_passA_unit(F, u);
            { const SsdPar SP{INP(I_CONV_W) + (size_t)j * 4 * 1536, INP(I_CONV_B) + j * 1536, INP(I_A_LOG) + j * 16, INP(I_D_SSD) + j * 16, INP(I_SSD_NORM) + j * 1024};
              for (int rep_ = 0; rep_ < REP_SA; ++rep_) for (int u = F.vcu; u < 256; u += F.G) ssd_passA_unit(F, SP, u); }
            GRID_BAR();
            for (int it = (F.bid * NTHR + F.tid); it < 131072; it += (F.G * NTHR)) ret_scan_item(F, it);
            for (int it = (F.bid * NTHR + F.tid); it < 131072; it += (F.G * NTHR)) ssd_scan_item(F, it);
            GRID_BAR();
#if REP_RC == 2
            if (layer == 0) for (int u = F.vcu; u < 256; u += F.G) ret_passC_unit(F, u, (bf16*)F.out);
#endif
            for (int u = F.vcu; u < 256; u += F.G) ret_passC_unit(F, u, WSP(bf16, WS_GZ));
            { const SsdPar SP{INP(I_CONV_W) + (size_t)j * 4 * 1536, INP(I_CONV_B) + j * 1536, INP(I_A_LOG) + j * 16, INP(I_D_SSD) + j * 16, INP(I_SSD_NORM) + j * 1024};
#if REP_SC >= 2
              if (layer == 0) for (int u = F.vcu; u < 256; u += F.G) ssd_passC_unit<SC_DBG>(F, SP, u, REP_SC == 2 ? (bf16*)F.out : (bf16*)nullptr);
#endif
              for (int u = F.vcu; u < 256; u += F.G) ssd_passC_unit(F, SP, u, WSP(bf16, WS_GZ)); }
            GRID_BAR();
            }
            __syncthreads();
            TPK_B(28);
            convert_weight(F, INP(I_W_UP) + (size_t)layer * D * FF, D, FF, WSP(bf16, WS_SLOT16), 0);
#if REP_CONV == 2
            convert_weight(F, INP(I_W_UP) + (size_t)layer * D * FF, D, FF, WSP(bf16, WS_SLOT16), 0);
#endif
            convert_weight(F, INP(I_W_DOWN) + (size_t)layer * FF * D, FF, D, WSP(bf16, WS_SLOT16) + (size_t)FF * D, 0);
#if REP_CONV == 2
            convert_weight(F, INP(I_W_DOWN) + (size_t)layer * FF * D, FF, D, WSP(bf16, WS_SLOT16) + (size_t)FF * D, 0);
#endif
            __syncthreads();
            TPK_E(28);
            if (FUSE_E5 && F.G == 256 && !opq(SKIP_EVEN)) {
            { pg8::Gemm g{WSP(bf16, WS_GZ), WSP(bf16, WS_W4), M, D, 2048}; pg8::StaticOrder S; S.init(M, D, F.G, F.bid);
              pg8::EpiResNorm<layer == 0> E{layer == 0 ? (const void*)INP(I_X) : (const void*)F.out, (bf16*)F.out, WSP(bf16, WS_SLOT32), INP(I_POST_MIX) + layer * D, INP(I_PRE_MLP) + layer * D,
                                            WSP(unsigned long long, WS_XBUF_A), (unsigned*)(F.ws + WS_CTL) + CW_PANEL, 32u * (unsigned)(layer / 2 + 1), EPS};
              TPK_B(8); pg8::gemm_phase<pg8::EpiResNorm<layer == 0>, pg8::StaticOrder, true, true>(F.lds, g, S, E, F.tid); TPK_E(8); }
            __syncthreads();
            TPK_B(7); GRID_BAR(); TPK_E(7);
            } else {
            if (!opq(SKIP_EVEN)) {
            { pg8::Gemm g{WSP(bf16, WS_GZ), WSP(bf16, WS_W4), M, D, 2048}; pg8::StaticOrder S; S.init(M, D, F.G, F.bid);
              pg8::EpiBf16 E{WSP(bf16, WS_M32A), D};
              TPK_B(9); pg8::gemm_phase<pg8::EpiBf16, pg8::StaticOrder, true, true>(F.lds, g, S, E, F.tid); TPK_E(9); }
            } else zero_fill(F, WSP(bf16, WS_M32A), (size_t)M * D * 2);
            TPK_B(10); GRID_BAR(); TPK_E(10);
            TPK_B(11);
            if (layer == 0) row_phase<true, false>(F, WSP(bf16, WS_M32A), INP(I_X), F.out, INP(I_POST_MIX) + layer * D, INP(I_PRE_MLP) + layer * D, WSP(bf16, WS_SLOT32));
            else row_phase<false, false>(F, WSP(bf16, WS_M32A), F.out, F.out, INP(I_POST_MIX) + layer * D, INP(I_PRE_MLP) + layer * D, WSP(bf16, WS_SLOT32));
            TPK_E(11);
            TPK_B(12); GRID_BAR(); TPK_E(12);
            }
        } else {
            if (opq(SKIP_ODD) == 2) {
                const v4u* s_ = (const v4u*)WSP(bf16, WS_SLOT32); v4u* d_ = (v4u*)WSP(bf16, WS_Y);
                for (size_t i_ = (size_t)F.bid * NTHR + F.tid; i_ < (size_t)M * D / 8; i_ += (size_t)F.G * NTHR) d_[i_] = s_[i_];
                GRID_BAR();
            }
            if (opq(SKIP_ODD) == 0 || opq(SKIP_ODD) >= 3) {
            for (int rep_ = 0; rep_ < REP_S5A; ++rep_) for (int u = F.vcu; u < 256; u += F.G) s5_gemmA_unit(F, u);
            GRID_BAR();
            for (int rep_ = 0; rep_ < REP_S5B; ++rep_) for (int u = F.vcu; u < 256; u += F.G) {
                __syncthreads();
                if (F.wave < 2) s5_scan_task(F, INP(I_LAM_RE) + j * 4096, INP(I_LAM_IM) + j * 4096, INP(I_LOG_STEP) + j * 64, (2 * (u & 1) + F.wave) * 64 + (u >> 2), 0);
                asm volatile("s_waitcnt vmcnt(0)" ::: "memory");
                s5_gemmB_unit(F, INP(I_D_S5) + j * 1024, u); }
            GRID_BAR();
            }
            __syncthreads();
            convert_weight(F, INP(I_W_UP) + (size_t)layer * D * FF, D, FF, WSP(bf16, WS_SLOT16), 0);
            convert_weight(F, INP(I_W_DOWN) + (size_t)layer * FF * D, FF, D, layer == 1 ? WSP(bf16, WS_DOWN1) : WSP(bf16, WS_SLOT16) + (size_t)FF * D, 0);
            __syncthreads();
            if (opq(SKIP_ODD) != 1) {
            { pg8::Gemm g{WSP(bf16, WS_Y), WSP(bf16, WS_W4), M, 2048, D}; pg8::StaticOrder S; S.init(M, 2048, F.G, F.bid);
              pg8::EpiGlu E{WSP(bf16, WS_M32B), D};
              pg8::gemm_phase<pg8::EpiGlu, pg8::StaticOrder, true, true>(F.lds, g, S, E, F.tid); }
#if REP_GEMM == 2 || defined(REP_G_GLU)
            { PHASE(); pg8::Gemm g{WSP(bf16, WS_Y), WSP(bf16, WS_W4), M, 2048, D}; pg8::StaticOrder S; S.init(M, 2048, F.G, F.bid);
              pg8::EpiGlu E{WSP(bf16, WS_M32B), D};
              pg8::gemm_phase<pg8::EpiGlu, pg8::StaticOrder, true, true>(F.lds, g, S, E, F.tid); }
#endif
            } else zero_fill(F, WSP(bf16, WS_M32B), (size_t)M * D * 2);
            GRID_BAR();
            TPK_B(39); row_phase<false, false>(F, WSP(bf16, WS_M32B), F.out, F.out, INP(I_POST_MIX) + layer * D, INP(I_PRE_MLP) + layer * D, WSP(bf16, WS_SLOT32)); TPK_E(39);
            GRID_BAR();
        }
        { pg8::Gemm g{WSP(bf16, WS_SLOT32), WSP(bf16, WS_SLOT16), M, FF, D}; pg8::StaticOrder S; S.init(M, FF, F.G, F.bid);
          pg8::EpiRelu2 E{WSP(bf16, WS_U), FF};
          TPK_B(13); TPK_B(15); pg8::gemm_phase<pg8::EpiRelu2, pg8::StaticOrder, true, true>(F.lds, g, S, E, F.tid); TPK_E(13); }
#if REP_GEMM == 2 || defined(REP_G_UP)
            { PHASE(); pg8::Gemm g{WSP(bf16, WS_SLOT32), WSP(bf16, WS_SLOT16), M, FF, D}; pg8::StaticOrder S; S.init(M, FF, F.G, F.bid);
          pg8::EpiRelu2 E{WSP(bf16, WS_U), FF};
          pg8::gemm_phase<pg8::EpiRelu2, pg8::StaticOrder, true, true>(F.lds, g, S, E, F.tid); }
#endif
        TPK_B(14); GRID_BAR(); TPK_E(14); TPK_E(15);
        __syncthreads();
        if ((layer & 1) == 0) { convert_weight(F, INP(I_W_GLU_A) + (size_t)j * D * D, D, D, WSP(bf16, WS_W4), 1); convert_weight(F, INP(I_W_GLU_B) + (size_t)j * D * D, D, D, WSP(bf16, WS_W4), 2); }
#if REP_CONV == 2
        if ((layer & 1) == 0) { convert_weight(F, INP(I_W_GLU_A) + (size_t)j * D * D, D, D, WSP(bf16, WS_W4), 1); convert_weight(F, INP(I_W_GLU_B) + (size_t)j * D * D, D, D, WSP(bf16, WS_W4), 2); }
#endif
        if (layer == 1 && !CONV_OLD) {
            convert_weight(F, INP(I_W_IN) + (size_t)D * INP, D, INP, WSP(bf16, WS_SLOT16), 0);
#if REP_CONV == 2
            convert_weight(F, INP(I_W_IN) + (size_t)D * INP, D, INP, WSP(bf16, WS_SLOT16), 0);
#endif
            zero_fill(F, WSP(bf16, WS_SLOT16) + (size_t)6688 * D, (size_t)(INP_PAD - 6688) * D * 2);
            convert_weight(F, INP(I_W_OUT) + (size_t)2048 * D, 2048, D, WSP(bf16, WS_W4), 0);
#if REP_CONV == 2
            convert_weight(F, INP(I_W_OUT) + (size_t)2048 * D, 2048, D, WSP(bf16, WS_W4), 0);
#endif
        }
        __syncthreads();
        if (((FUSE_DOWN >> layer) & 1) && layer == DEPTH - 1 && F.G == 256) {
            { pg8::Gemm g{WSP(bf16, WS_U), WSP(bf16, WS_SLOT16) + (size_t)FF * D, M, D, FF}; pg8::StaticOrder S; S.init(M, D, F.G, F.bid);
              pg8::EpiResNorm<false, true> E{(const void*)F.out, (bf16*)F.out, nullptr, INP(I_POST_MLP) + layer * D, nullptr,
                                             WSP(unsigned long long, WS_XBUF_B), (unsigned*)(F.ws + WS_CTL) + CW_PANEL + 4096, 32u * (unsigned)__builtin_popcount(FUSE_DOWN & ((2 << layer) - 1)), EPS};
              pg8::gemm_phase<pg8::EpiResNorm<false, true>, pg8::StaticOrder, true, true>(F.lds, g, S, E, F.tid); }
        } else if (((FUSE_DOWN >> layer) & 1) && layer < DEPTH - 1 && F.G == 256) {
            { pg8::Gemm g{WSP(bf16, WS_U), layer == 1 ? WSP(bf16, WS_DOWN1) : WSP(bf16, WS_SLOT16) + (size_t)FF * D, M, D, FF}; pg8::StaticOrder S; S.init(M, D, F.G, F.bid);
              pg8::EpiResNorm<false> E{(const void*)F.out, (bf16*)F.out, WSP(bf16, WS_SLOT32), INP(I_POST_MLP) + layer * D, INP(I_PRE_MIX) + (layer + 1) * D,
                                       WSP(unsigned long long, WS_XBUF_B), (unsigned*)(F.ws + WS_CTL) + CW_PANEL + 4096, 32u * (unsigned)__builtin_popcount(FUSE_DOWN & ((2 << layer) - 1)), EPS};
              TPK_B(8); pg8::gemm_phase<pg8::EpiResNorm<false>, pg8::StaticOrder, true, true>(F.lds, g, S, E, F.tid); TPK_E(8); }
            __syncthreads();
#ifdef XTRA_BAR
            GRID_BAR();
#endif
#ifdef HN_SEP
            GRID_BAR();
            hn_from_h(F, (const bf16*)F.out, INP(I_PRE_MIX) + (layer + 1) * D, WSP(bf16, WS_SLOT32));
#endif
        } else {
        { pg8::Gemm g{WSP(bf16, WS_U), layer == 1 ? WSP(bf16, WS_DOWN1) : WSP(bf16, WS_SLOT16) + (size_t)FF * D, M, D, FF}; pg8::StaticOrder S; S.init(M, D, F.G, F.bid);
          pg8::EpiBf16 E{WSP(bf16, WS_M32B), D};
          if (layer < DEPTH - 1) TPK_B(9); pg8::gemm_phase<pg8::EpiBf16, pg8::StaticOrder, true, true>(F.lds, g, S, E, F.tid); if (layer < DEPTH - 1) TPK_E(9); }
#if REP_GEMM == 2 || defined(REP_G_DOWN)
            { PHASE(); pg8::Gemm g{WSP(bf16, WS_U), layer == 1 ? WSP(bf16, WS_DOWN1) : WSP(bf16, WS_SLOT16) + (size_t)FF * D, M, D, FF}; pg8::StaticOrder S; S.init(M, D, F.G, F.bid);
          pg8::EpiBf16 E{WSP(bf16, WS_M32B), D};
          pg8::gemm_phase<pg8::EpiBf16, pg8::StaticOrder, true, true>(F.lds, g, S, E, F.tid); }
#endif
        if (layer < DEPTH - 1) TPK_B(10); GRID_BAR(); if (layer < DEPTH - 1) TPK_E(10);
        if (layer < DEPTH - 1) { TPK_B(11); row_phase<false, false>(F, WSP(bf16, WS_M32B), F.out, F.out, INP(I_POST_MLP) + layer * D, INP(I_PRE_MIX) + (layer + 1) * D, WSP(bf16, WS_SLOT32)); TPK_E(11); }
        else row_phase<false, true>(F, WSP(bf16, WS_M32B), F.out, F.out, INP(I_POST_MLP) + layer * D, nullptr, nullptr);
        if (layer == 0 || layer == 2) GRID_BAR();
        }
        if (layer == 1 && CONV_OLD) {
            __syncthreads();
            convert_weight(F, INP(I_W_IN) + (size_t)D * INP, D, INP, WSP(bf16, WS_SLOT16), 0);
            zero_fill(F, WSP(bf16, WS_SLOT16) + (size_t)6688 * D, (size_t)(INP_PAD - 6688) * D * 2);
            convert_weight(F, INP(I_W_OUT) + (size_t)2048 * D, 2048, D, WSP(bf16, WS_W4), 0);
        }
        if (layer == 0 || layer == 2) {
            const S5Par P5{INP(I_LAM_RE) + j * 4096, INP(I_LAM_IM) + j * 4096, INP(I_LOG_STEP) + j * 64, INP(I_B_RE) + (size_t)j * 65536, INP(I_B_IM) + (size_t)j * 65536,
                           INP(I_C_RE) + (size_t)j * 65536, INP(I_C_IM) + (size_t)j * 65536, INP(I_D_S5) + j * 1024};
            for (int u = F.bid; u < 256; u += F.G) s5_build_unit(F, P5, u);
        }
        if (layer < DEPTH - 1) { TPK_B(7); TPK_B(12); GRID_BAR(); TPK_E(7); TPK_E(12); }

}

__global__ void __launch_bounds__(NTHR, 2) trunk_fwd(Args args) {
    extern __shared__ __attribute__((aligned(16))) unsigned char lds[];
#ifdef CODE_SHIFT
    asm volatile(".rept " CODE_SHIFT_STR "\n\ts_nop 0\n\t.endr" ::: "memory");
#endif
    Frame F;
    F.lds = (LAS unsigned char*)lds;
    F.G = gridDim.x; F.bid = blockIdx.x;
    { const int t = threadIdx.x;
      for (int u = t; u < (LDS_BYTES - MISC_OFF) / 4; u += NTHR) ((LAS unsigned*)(F.lds + MISC_OFF))[u] = 0u;
      __syncthreads();
      if (t < N_IN + 2) ((LAS unsigned long long*)(F.lds + MISC_OFF + 256))[t] = t < N_IN ? (unsigned long long)args.in[t] : (t == N_IN ? (unsigned long long)args.out : (unsigned long long)args.ws);
      __syncthreads(); }
    const int wave0 = __builtin_amdgcn_readfirstlane(threadIdx.x >> 6);
    PHASE();
    (void)xcd_barrier_post((unsigned*)(F.ws + WS_CTL) + CW_BAR, (volatile LAS unsigned*)(F.lds + MISC_OFF) + 8);

    build_rope(F);
    convert_weight(F, INP(I_W_IN), D, INP, WSP(bf16, WS_SLOT16), 0);
#if REP_CONV == 2
    convert_weight(F, INP(I_W_IN), D, INP, WSP(bf16, WS_SLOT16), 0);
#endif
    zero_fill(F, WSP(bf16, WS_SLOT16) + (size_t)6688 * D, (size_t)(INP_PAD - 6688) * D * 2);
    convert_weight(F, INP(I_W_OUT), 2048, D, WSP(bf16, WS_W4), 0);
#if REP_CONV == 2
    convert_weight(F, INP(I_W_OUT), 2048, D, WSP(bf16, WS_W4), 0);
#endif
    rms_rows_to_bf16(F, INP(I_X), INP(I_PRE_MIX), WSP(bf16, WS_SLOT32));
    GRID_BAR();

    run_layer<0>(F, wave0); run_layer<1>(F, wave0); run_layer<2>(F, wave0); run_layer<3>(F, wave0);
#ifdef TPROBE
    if (blockIdx.x == TP_CU && threadIdx.x == 0) {
        const unsigned long long t0_ = __builtin_amdgcn_s_memrealtime(); const unsigned long long w_ = 10ull * ((LAS unsigned*)(F.lds + 146432))[0];
        while (__builtin_amdgcn_s_memrealtime() - t0_ < w_) __builtin_amdgcn_s_sleep(8);
    }
#endif
}

extern "C" void kernel_launch(void* const* d_in, const int* in_sizes, int n_in, void* d_out, int out_size, void* d_ws, size_t ws_size, hipStream_t stream) {
    static int grid = 0;
    if (grid == 0) {
        if (n_in != N_IN || out_size != M * D || ws_size < WS_END) { fprintf(stderr, "kernel_launch: unexpected shapes (n_in %d, out %d, ws %zu)\n", n_in, out_size, ws_size); grid = -1; return; }
        int dev = 0, cus = 0, per_cu = 0;
        if (hipGetDevice(&dev) != hipSuccess || hipDeviceGetAttribute(&cus, hipDeviceAttributeMultiprocessorCount, dev) != hipSuccess) { grid = -1; return; }
        if (hipFuncSetAttribute((const void*)trunk_fwd, hipFuncAttributeMaxDynamicSharedMemorySize, LDS_BYTES) != hipSuccess) { fprintf(stderr, "kernel_launch: hipFuncSetAttribute failed\n"); grid = -1; return; }
        if (hipOccupancyMaxActiveBlocksPerMultiprocessor(&per_cu, (const void*)trunk_fwd, NTHR, LDS_BYTES) != hipSuccess || per_cu < 1)
            fprintf(stderr, "kernel_launch: note: occupancy query reports %d workgroups per CU\n", per_cu);
        (void)hipGetLastError();
        grid = cus;
    }
    if (grid < 0) return;
    if (hipMemsetAsync((char*)d_ws + WS_CTL, 0, CTL_ZERO_BYTES, stream) != hipSuccess) return;
#ifdef DBG_ZERO_MISC
    if (hipMemsetAsync((char*)d_ws + WS_MISC, 0, 512 * 1024, stream) != hipSuccess) return;
#endif
    Args a{};
    for (int i = 0; i < N_IN; ++i) a.in[i] = (const float*)d_in[i];
    a.out = (float*)d_out; a.ws = (unsigned char*)d_ws;
    hipLaunchKernelGGL(trunk_fwd, dim3(grid), dim3(NTHR), LDS_BYTES, stream, a);
}
```
